# Optimizing an MI355X kernel written in HIP

```python
import jax
import jax.numpy as jnp
from jax import lax
import numpy as np

D_MODEL = 2048
BATCH = 4
SEQ = 4096
DEPTH = 1

MLA_HEADS = 8
MLA_Q_RANK = 512
MLA_KV_RANK = 512
MLA_NOPE = 128
MLA_ROPE = 64
MLA_V = 128
MLA_QK = MLA_NOPE + MLA_ROPE
Q_BLOCK = 128
RET_HEADS = 8
RET_DK = D_MODEL // RET_HEADS
RET_DV = D_MODEL // RET_HEADS
RET_CHUNK = 128
N_EXPERTS = 32
TOP_K = 4
D_EXPERT = D_MODEL
SWIGLU_LIMIT = 7.0
SWIGLU_ALPHA = 1.702
MOE_BLOCK = 128
ROPE_THETA = 10000.0
RMS_EPS = 1e-6
GN_EPS = 1e-6
N_MOD = 6

IN_SPLITS = (MLA_Q_RANK, MLA_KV_RANK + MLA_ROPE,
             RET_HEADS * RET_DK, RET_HEADS * RET_DK, RET_HEADS * RET_DV, RET_HEADS * RET_DV,
             D_MODEL, D_MODEL)
D_IN = sum(IN_SPLITS)

kernel_name = 'hybrid_mla_retention_moe_encoder'


def split_cols(t, sizes):
    out, start = [], 0
    for s in sizes:
        out.append(t[..., start:start + s])
        start += s
    return out


def rms_norm(x, gain):
    xf = x.astype(jnp.float32)
    y = xf * lax.rsqrt(jnp.mean(xf * xf, axis=-1, keepdims=True) + RMS_EPS)
    return (y * gain.astype(jnp.float32)).astype(x.dtype)


def rotary(x, positions):
    half = x.shape[-1] // 2
    inv = 1.0 / (ROPE_THETA ** (jnp.arange(half, dtype=jnp.float32) / half))
    ang = positions.astype(jnp.float32)[:, None, :, None] * inv
    cos, sin = jnp.cos(ang), jnp.sin(ang)
    xf = x.astype(jnp.float32)
    x1, x2 = xf[..., :half], xf[..., half:]
    return jnp.concatenate([x1 * cos - x2 * sin, x1 * sin + x2 * cos], axis=-1).astype(x.dtype)


def mla_branch(q_lat, kv_lat, positions, q_a_norm, w_q_b, kv_a_norm, w_kv_b, w_mla_o):
    B, S, _ = q_lat.shape
    H = MLA_HEADS
    q = (rms_norm(q_lat, q_a_norm) @ w_q_b).reshape(B, S, H, MLA_QK).transpose(0, 2, 1, 3)
    q = jnp.concatenate([q[..., :MLA_NOPE], rotary(q[..., MLA_NOPE:], positions)], axis=-1)
    q = q * (MLA_QK ** -0.5)
    c_kv, k_rope = kv_lat[..., :MLA_KV_RANK], kv_lat[..., MLA_KV_RANK:]
    k_rope = rotary(k_rope[:, None], positions)
    kv = (rms_norm(c_kv, kv_a_norm) @ w_kv_b).reshape(B, S, H, MLA_NOPE + MLA_V).transpose(0, 2, 1, 3)
    k = jnp.concatenate([kv[..., :MLA_NOPE], jnp.broadcast_to(k_rope, (B, H, S, MLA_ROPE))], axis=-1)
    v = kv[..., MLA_NOPE:]
    nb = S // Q_BLOCK
    q_blocks = q.reshape(B, H, nb, Q_BLOCK, MLA_QK).transpose(2, 0, 1, 3, 4)

    def attend(qb):
        s = jnp.einsum('bhqd,bhkd->bhqk', qb, k).astype(jnp.float32)
        p = jax.nn.softmax(s, axis=-1).astype(v.dtype)
        return jnp.einsum('bhqk,bhkd->bhqd', p, v)

    o = lax.map(attend, q_blocks)
    o = o.transpose(1, 0, 3, 2, 4).reshape(B, S, H * MLA_V)
    return o @ w_mla_o


def retention_direction(q, k, v, gamma, include_diag):
    B, H, N, C, _ = q.shape
    dv = v.shape[-1]
    idx = jnp.arange(C, dtype=jnp.float32)
    log_g = jnp.log(gamma)[:, None]
    diff = idx[:, None] - idx[None, :]
    mask = (diff >= 0) if include_diag else (diff > 0)
    decay = jnp.where(mask, jnp.exp(log_g[..., None] * jnp.where(mask, diff, 0.0)), 0.0)
    scores = jnp.einsum('bhncd,bhnmd->bhncm', q, k) * decay[:, None]
    inner = jnp.einsum('bhncm,bhnmd->bhncd', scores, v)
    xi = jnp.exp(log_g * (idx + 1.0))
    zeta = jnp.exp(log_g * (C - 1.0 - idx))
    chunk_kv = jnp.einsum('bhnmk,bhnmv->bhnkv', k * zeta[:, None, :, None], v)
    g_chunk = jnp.exp(log_g[:, 0] * C)[None, :, None, None]

    def step(state, kv_i):
        return state * g_chunk + kv_i, state

    init = jnp.zeros((B, H, q.shape[-1], dv), jnp.float32)
    _, prev = lax.scan(step, init, chunk_kv.transpose(2, 0, 1, 3, 4))
    prev = prev.transpose(1, 2, 0, 3, 4)
    cross = jnp.einsum('bhnck,bhnkv->bhncv', q * xi[:, None, :, None], prev)
    return inner + cross


def retention_branch(rq, rk, rv, rg, positions, decay_fwd, decay_bwd, ret_gn, w_ret_o):
    B, S, _ = rq.shape
    H = RET_HEADS
    N = S // RET_CHUNK

    def heads(t, d):
        return t.reshape(B, S, H, d).transpose(0, 2, 1, 3)

    def chunks(t):
        return t.reshape(B, H, N, RET_CHUNK, t.shape[-1])

    def rev(t):
        return jnp.flip(t, axis=2)

    q = rotary(heads(rq, RET_DK), positions).astype(jnp.float32)
    k = rotary(heads(rk, RET_DK), positions).astype(jnp.float32) * (RET_DK ** -0.5)
    v = heads(rv, RET_DV).astype(jnp.float32)
    g_f = jax.nn.sigmoid(decay_fwd.astype(jnp.float32))
    g_b = jax.nn.sigmoid(decay_bwd.astype(jnp.float32))
    fwd = retention_direction(chunks(q), chunks(k), chunks(v), g_f, True)
    bwd = retention_direction(chunks(rev(q)), chunks(rev(k)), chunks(rev(v)), g_b, False)
    o = fwd.reshape(B, H, S, RET_DV) + rev(bwd.reshape(B, H, S, RET_DV))
    mu = jnp.mean(o, axis=-1, keepdims=True)
    var = jnp.mean(jnp.square(o - mu), axis=-1, keepdims=True)
    o = ((o - mu) * lax.rsqrt(var + GN_EPS)).transpose(0, 2, 1, 3).reshape(B, S, H * RET_DV)
    o = jax.nn.silu(rg.astype(jnp.float32)) * (o * ret_gn.astype(jnp.float32))
    return o.astype(rq.dtype) @ w_ret_o


def moe_ffn(h, w_router, b_router, w_gate_up, b_gate_up, w_down, b_down):
    B, S, D = h.shape
    T = B * S
    A = T * TOP_K
    xt = h.reshape(T, D)
    logits = (xt @ w_router + b_router).astype(jnp.float32)
    top_vals, top_idx = lax.top_k(logits, TOP_K)
    weights = jax.nn.softmax(top_vals, axis=-1)
    flat_e = top_idx.reshape(A).astype(jnp.int32)
    flat_t = jnp.arange(A, dtype=jnp.int32) // TOP_K
    flat_w = weights.reshape(A)
    order = jnp.argsort(flat_e)
    e_sorted = flat_e[order]
    counts = jnp.zeros((N_EXPERTS,), jnp.int32).at[flat_e].add(1)
    padded = ((counts + MOE_BLOCK - 1) // MOE_BLOCK) * MOE_BLOCK
    start = jnp.cumsum(counts) - counts
    pend = jnp.cumsum(padded)
    pstart = pend - padded
    dest = pstart[e_sorted] + (jnp.arange(A, dtype=jnp.int32) - start[e_sorted])
    n_blocks = (A + N_EXPERTS * (MOE_BLOCK - 1) + MOE_BLOCK - 1) // MOE_BLOCK
    P = n_blocks * MOE_BLOCK
    row_tok = jnp.zeros((P,), jnp.int32).at[dest].set(flat_t[order])
    row_w = jnp.zeros((P,), jnp.float32).at[dest].set(flat_w[order])
    block_e = jnp.clip(jnp.searchsorted(pend, jnp.arange(n_blocks, dtype=jnp.int32) * MOE_BLOCK,
                                        side='right'), 0, N_EXPERTS - 1)
    xs = xt[row_tok].reshape(n_blocks, MOE_BLOCK, D)

    def expert_block(args):
        xb, e = args
        gu = xb @ w_gate_up[e] + b_gate_up[e]
        gate = jnp.minimum(gu[..., :D_EXPERT], SWIGLU_LIMIT)
        up = jnp.clip(gu[..., D_EXPERT:], -SWIGLU_LIMIT, SWIGLU_LIMIT)
        glu = gate * jax.nn.sigmoid(SWIGLU_ALPHA * gate)
        return ((up + 1.0) * glu) @ w_down[e] + b_down[e]

    ys = lax.map(expert_block, (xs, block_e)).reshape(P, D)
    out = jnp.zeros((T, D), ys.dtype).at[row_tok].add(ys * row_w[:, None].astype(ys.dtype))
    return out.reshape(B, S, D)


def setup_inputs(seed: int = 0) -> dict:
    key = jax.random.key(seed)
    ks = jax.random.split(key, 32)
    L = DEPTH
    f32 = jnp.float32

    def nrm(k, shape, scale):
        return jax.random.normal(k, (L,) + shape, f32) * scale

    def gain(k, n):
        return 1.0 + 0.02 * jax.random.normal(k, (L, n), f32)

    base_logit = jnp.log(2.0 ** (5.0 + jnp.arange(RET_HEADS, dtype=f32)) - 1.0)
    x = jax.random.normal(ks[0], (BATCH, SEQ, D_MODEL), f32)
    c = jax.random.normal(ks[1], (BATCH, D_MODEL), f32)
    positions = (jnp.arange(SEQ, dtype=jnp.int32)[None, :]
                 + jax.random.randint(ks[2], (BATCH, 1), 0, 1024, dtype=jnp.int32))
    return {
        'x': x,
        'c': c,
        'positions': positions,
        'w_ada': nrm(ks[3], (D_MODEL, N_MOD * D_MODEL), 0.5 * D_MODEL ** -0.5),
        'b_ada': nrm(ks[4], (N_MOD * D_MODEL,), 0.01),
        'g_pre_mix': gain(ks[5], D_MODEL),
        'g_post_mix': gain(ks[6], D_MODEL),
        'g_pre_ffn': gain(ks[7], D_MODEL),
        'g_post_ffn': gain(ks[8], D_MODEL),
        'w_in': nrm(ks[9], (D_MODEL, D_IN), D_MODEL ** -0.5),
        'q_a_norm': gain(ks[10], MLA_Q_RANK),
        'w_q_b': nrm(ks[11], (MLA_Q_RANK, MLA_HEADS * MLA_QK), MLA_Q_RANK ** -0.5),
        'kv_a_norm': gain(ks[12], MLA_KV_RANK),
        'w_kv_b': nrm(ks[13], (MLA_KV_RANK, MLA_HEADS * (MLA_NOPE + MLA_V)), MLA_KV_RANK ** -0.5),
        'w_mla_o': nrm(ks[14], (MLA_HEADS * MLA_V, D_MODEL), (MLA_HEADS * MLA_V) ** -0.5),
        'ret_decay_fwd': base_logit[None, :] + nrm(ks[15], (RET_HEADS,), 0.01),
        'ret_decay_bwd': base_logit[None, :] + nrm(ks[16], (RET_HEADS,), 0.01),
        'ret_gn': gain(ks[17], RET_HEADS * RET_DV),
        'w_ret_o': nrm(ks[18], (RET_HEADS * RET_DV, D_MODEL), (RET_HEADS * RET_DV) ** -0.5),
        'w_out': nrm(ks[19], (D_MODEL, D_MODEL), D_MODEL ** -0.5),
        'w_router': nrm(ks[20], (D_MODEL, N_EXPERTS), D_MODEL ** -0.5),
        'b_router': nrm(ks[21], (N_EXPERTS,), 0.01),
        'w_gate_up': nrm(ks[22], (N_EXPERTS, D_MODEL, 2 * D_EXPERT), D_MODEL ** -0.5),
        'b_gate_up': nrm(ks[23], (N_EXPERTS, 2 * D_EXPERT), 0.01),
        'w_down': nrm(ks[24], (N_EXPERTS, D_EXPERT, D_MODEL), D_EXPERT ** -0.5),
        'b_down': nrm(ks[25], (N_EXPERTS, D_MODEL), 0.01),
    }


def reference(x, c, positions, w_ada, b_ada, g_pre_mix, g_post_mix, g_pre_ffn, g_post_ffn,
              w_in, q_a_norm, w_q_b, kv_a_norm, w_kv_b, w_mla_o, ret_decay_fwd, ret_decay_bwd,
              ret_gn, w_ret_o, w_out, w_router, b_router, w_gate_up, b_gate_up, w_down, b_down):
    for l in range(DEPTH):
        ada = (c @ w_ada[l] + b_ada[l])[:, None, :].astype(x.dtype)
        shift_m, scale_m, gate_m, shift_f, scale_f, gate_f = jnp.split(ada, N_MOD, axis=-1)
        h = rms_norm(x, g_pre_mix[l]) * (1.0 + scale_m) + shift_m
        q_lat, kv_lat, rq, rk, rv, rg, gate_a, gate_b = split_cols(h @ w_in[l], IN_SPLITS)
        y_a = mla_branch(q_lat, kv_lat, positions, q_a_norm[l], w_q_b[l], kv_a_norm[l],
                         w_kv_b[l], w_mla_o[l])
        y_b = retention_branch(rq, rk, rv, rg, positions, ret_decay_fwd[l], ret_decay_bwd[l],
                               ret_gn[l], w_ret_o[l])
        mix = (jax.nn.sigmoid(gate_a) * y_a + jax.nn.sigmoid(gate_b) * y_b) @ w_out[l]
        x = x + gate_m * rms_norm(mix, g_post_mix[l])
        h = rms_norm(x, g_pre_ffn[l]) * (1.0 + scale_f) + shift_f
        f = moe_ffn(h, w_router[l], b_router[l], w_gate_up[l], b_gate_up[l], w_down[l], b_down[l])
        x = x + gate_f * rms_norm(f, g_post_ffn[l])
    return x
```

```cpp
#include <hip/hip_runtime.h>
#include <cstdio>
#include <cstdint>

#ifndef MK_N_LAUNCHES
#define MK_N_LAUNCHES 20
#endif

#define LAS __attribute__((address_space(3)))
typedef unsigned short bf16_t;
typedef short bf16x8 __attribute__((ext_vector_type(8)));
typedef short s16x4 __attribute__((ext_vector_type(4)));
typedef float f32x4 __attribute__((ext_vector_type(4)));
typedef float f32x2 __attribute__((ext_vector_type(2)));
typedef float f32x16 __attribute__((ext_vector_type(16)));
typedef unsigned u32x4 __attribute__((ext_vector_type(4)));
typedef unsigned u32x2 __attribute__((ext_vector_type(2)));

constexpr int NB = 4, SEQ = 4096, T = NB * SEQ, D = 2048;
constexpr int CH = 256, NCH = SEQ / CH, NBLK = NB * 8 * NCH;
constexpr int N_IN_NAT = 11520;
constexpr int N_IN_ALL = N_IN_NAT + 2048;
constexpr int NE = 32, PMAX = 73728;
constexpr float RMS_EPS = 1e-6f, GN_EPS = 1e-6f;
constexpr float QSCALE = 0.07216878364870322f;

constexpr size_t MiB = 1u << 20;
constexpr size_t WS_CTL = 0, CTL_BYTES = 1 * MiB;
constexpr size_t WS_WT_IN = 1 * MiB;
constexpr size_t WS_WT_QB = WS_WT_IN + 54 * MiB;
constexpr size_t WS_WT_KVB = WS_WT_QB + 2 * MiB;
constexpr size_t WS_WT_MLAO = WS_WT_KVB + 2 * MiB;
constexpr size_t WS_WT_RETO = WS_WT_MLAO + 4 * MiB;
constexpr size_t WS_WT_OUT = WS_WT_RETO + 8 * MiB;
constexpr size_t WS_WT_GU = WS_WT_OUT + 8 * MiB;
constexpr size_t WS_WT_DOWN = WS_WT_GU + 512 * MiB;
constexpr size_t WS_CS_RET = WS_WT_DOWN + 256 * MiB;
constexpr size_t WS_CS_MLA = WS_CS_RET + 16 * MiB;
constexpr size_t WS_H = WS_CS_MLA + 4 * MiB;
constexpr size_t WS_QL = WS_H + 64 * MiB;
constexpr size_t WS_CKV = WS_QL + 16 * MiB;
constexpr size_t WS_KR = WS_CKV + 16 * MiB;
constexpr size_t WS_ACAT = WS_KR + 2 * MiB;
constexpr size_t WS_BCAT = WS_ACAT + 192 * MiB;
constexpr size_t WS_KROT = WS_BCAT + 192 * MiB;
constexpr size_t WS_KZTF = WS_KROT + 64 * MiB;
constexpr size_t WS_KZTB = WS_KZTF + 64 * MiB;
constexpr size_t WS_SG = WS_KZTB + 64 * MiB;
constexpr size_t WS_GA = WS_SG + 64 * MiB;
constexpr size_t WS_GB = WS_GA + 64 * MiB;
constexpr size_t WS_QN = WS_GB + 64 * MiB;
constexpr size_t WS_QR = WS_QN + 32 * MiB;
constexpr size_t WS_KN = WS_QR + 16 * MiB;
constexpr size_t WS_VV = WS_KN + 32 * MiB;
constexpr size_t WS_OA = WS_VV + 32 * MiB;
constexpr size_t WS_ORET = WS_OA + 32 * MiB;
constexpr size_t WS_OB = WS_ORET + 128 * MiB;
constexpr size_t WS_MIXP = WS_OB + 64 * MiB;
constexpr size_t WS_MIXIN = WS_MIXP + 64 * MiB;
constexpr size_t WS_MIX = WS_MIXIN + 64 * MiB;
constexpr size_t WS_H2 = WS_MIX + 128 * MiB;
constexpr size_t WS_TOPI = WS_H2 + 64 * MiB;
constexpr size_t WS_TOPW = WS_TOPI + 1 * MiB;
constexpr size_t WS_DEST = WS_TOPW + 1 * MiB;
constexpr size_t WS_TILE = WS_DEST + 1 * MiB;
constexpr size_t WS_YS_END = WS_TILE + 1 * MiB + 3 * 288 * MiB;
constexpr size_t WS_DECTAB = WS_TILE + 65536;
constexpr size_t WS_SSQP = WS_YS_END;
constexpr size_t WS_XS = WS_TILE + 1 * MiB;
constexpr size_t WS_ACT = WS_XS + 288 * MiB;
constexpr size_t WS_YS = WS_ACT + 288 * MiB;
constexpr size_t WS_END = WS_YS + 288 * MiB + 1 * MiB;
constexpr int CW_BAR = 4096;
constexpr int CW_QUEUE = 8192, CW_COUNTS = 8256, CW_CURSOR = 8320;
constexpr int CW_ADA = 16384;
constexpr int CW_SSQQ = 65536, CW_SSQKV = 81920;
static_assert((CW_SSQKV + T) * 4 <= (int)CTL_BYTES, "ctl");

constexpr int RING_BYTES = 131072, CTRL_OFF = 139264, MISC_OFF = CTRL_OFF, LARG_OFF = CTRL_OFF + 1024, LDS_BYTES = 147456;

__device__ __forceinline__ unsigned cvt_pk_bf16(float lo, float hi) { unsigned r; asm volatile("v_cvt_pk_bf16_f32 %0, %1, %2" : "=v"(r) : "v"(lo), "v"(hi)); return r; }
__device__ __forceinline__ u32x4 pack8(f32x4 a, f32x4 b) { u32x4 w; w.x = cvt_pk_bf16(a[0], a[1]); w.y = cvt_pk_bf16(a[2], a[3]); w.z = cvt_pk_bf16(b[0], b[1]); w.w = cvt_pk_bf16(b[2], b[3]); return w; }
__device__ __forceinline__ float bf_lo(unsigned w) { return __uint_as_float(w << 16); }
__device__ __forceinline__ float bf_hi(unsigned w) { return __uint_as_float(w & 0xffff0000u); }
__device__ __forceinline__ void unpack8(u32x4 w, f32x4& a, f32x4& b) { a = (f32x4){bf_lo(w.x), bf_hi(w.x), bf_lo(w.y), bf_hi(w.y)}; b = (f32x4){bf_lo(w.z), bf_hi(w.z), bf_lo(w.w), bf_hi(w.w)}; }
__device__ __forceinline__ float wave_sum(float v) {
#pragma unroll
    for (int o = 1; o < 64; o <<= 1) v += __shfl_xor(v, o);
    return v;
}
__device__ __forceinline__ float sigmoidf_(float x) { return __builtin_amdgcn_rcpf(1.0f + __expf(-x)); }
__device__ __forceinline__ float log2_sigmoid(float x) { return -log1pf(expf(-x)) * 1.4426950408889634f; }

#define XB_TMO      128
#define XB_XCNT(j)  (256  + 64 * (j))
#define XB_XSUB(j)  (1280 + 64 * (j))
#define XB_XGEN(j)  (2304 + 64 * (j))
#define XB_TOP      3328
#define XB_TOPGEN   3392
#define XCD_BAR_WORDS 3456
#define XB_SPIN_CAP (1u << 22)
__device__ __forceinline__ unsigned xb_ld(unsigned* p)              { return __hip_atomic_load(p, __ATOMIC_RELAXED, __HIP_MEMORY_SCOPE_AGENT); }
__device__ __forceinline__ unsigned xb_add(unsigned* p, unsigned v) { return __hip_atomic_fetch_add(p, v, __ATOMIC_RELAXED, __HIP_MEMORY_SCOPE_AGENT); }
__device__ __forceinline__ unsigned xb_xcc_id() { return (unsigned)__builtin_amdgcn_s_getreg((3 << 11) | 20) & 0xFu; }
#define XB_SPIN(cond, bar) do { unsigned _sp = 0; while (cond) { __builtin_amdgcn_s_sleep(1); \
    if ((++_sp & 255u) == 0u) { if (xb_ld(&(bar)[XB_TMO])) break; if (_sp > XB_SPIN_CAP) { atomicAdd(&(bar)[XB_TMO], 1u); break; } } } } while (0)
struct XcdBarrier { unsigned* bar; unsigned x; volatile LAS unsigned* st; };
__device__ __forceinline__ XcdBarrier xcd_barrier_post(unsigned* bar, volatile LAS unsigned* st) {
    XcdBarrier b; b.bar = bar; b.x = xb_xcc_id(); b.st = st;
    if (threadIdx.x == 0) (void)xb_add(&bar[XB_XCNT(b.x)], 1u);
    return b;
}
__device__ __forceinline__ void xcd_barrier_complete(unsigned* bar, unsigned x, unsigned& nloc, unsigned& nx) {
    const unsigned G = gridDim.x * gridDim.y * gridDim.z;
    unsigned sum, cnt, mine, sp = 0u;
    for (;;) {
        sum = 0u; cnt = 0u; mine = 0u;
#pragma unroll
        for (unsigned j = 0; j < 16; ++j) { const unsigned c = xb_ld(&bar[XB_XCNT(j)]); sum += c; cnt += (c > 0u) ? 1u : 0u; mine = (j == x) ? c : mine; }
        if (sum == G) break;
        __builtin_amdgcn_s_sleep(1);
        if ((++sp & 255u) == 0u) { if (xb_ld(&bar[XB_TMO])) break; if (sp > XB_SPIN_CAP) { atomicAdd(&bar[XB_TMO], 1u); break; } }
    }
    nloc = mine > 0u ? mine : 1u; nx = cnt > 0u ? cnt : 1u;
}
__device__ __forceinline__ void xcd_barrier(const XcdBarrier& b) {
    asm volatile("s_waitcnt vmcnt(0)" ::: "memory");
    __syncthreads();
    if (threadIdx.x == 0) {
        unsigned* bar = b.bar;
        __builtin_amdgcn_s_waitcnt(0);
        unsigned nloc = b.st[0], nx = b.st[1];
        if (nloc == 0u) { xcd_barrier_complete(bar, b.x, nloc, nx); b.st[0] = nloc; b.st[1] = nx; }
        const unsigned old = xb_add(&bar[XB_XSUB(b.x)], 1u);
        const unsigned gen = old / nloc;
        if (old + 1u == (gen + 1u) * nloc) {
            __builtin_amdgcn_fence(__ATOMIC_RELEASE, "agent");
            asm volatile("s_waitcnt vmcnt(0)" ::: "memory");
            const unsigned og = xb_add(&bar[XB_TOP], 1u);
            const unsigned tg = og / nx;
            if (og + 1u == (tg + 1u) * nx) xb_add(&bar[XB_TOPGEN], 1u);
            else XB_SPIN(xb_ld(&bar[XB_TOPGEN]) == tg, bar);
            __builtin_amdgcn_fence(__ATOMIC_ACQUIRE, "agent");
            xb_add(&bar[XB_XGEN(b.x)], 1u);
            asm volatile("s_waitcnt vmcnt(0)" ::: "memory");
        } else {
            XB_SPIN(xb_ld(&bar[XB_XGEN(b.x)]) == gen, bar);
            __builtin_amdgcn_fence(__ATOMIC_ACQUIRE, "agent");
            asm volatile("s_waitcnt vmcnt(0)" ::: "memory");
        }
    }
    __syncthreads();
}

namespace pg8 {
constexpr int BM = 256, BK = 64, HALF = 128, HTB = HALF * BK * 2, NXCD = 8, WGM = 8;
__host__ __device__ __forceinline__ int lds_byte(int r, int c) { const int st = (r >> 4) * 2 + (c >> 5), rr = r & 15, cc = c & 31, ob = rr * 64 + cc * 2; return st * 1024 + (ob ^ (((ob >> 9) & 1) << 5)); }
__host__ __device__ __forceinline__ void stage_rc(int b, int& R, int& C) { const int st = b / 1024, sb = b % 1024, swz = sb ^ (((sb >> 9) & 1) << 5); R = (st >> 1) * 16 + swz / 64; C = (st & 1) * 32 + (swz % 64) / 2; }
__host__ __device__ __forceinline__ int perm32(int rho) { const int n = rho >> 4, i = rho & 15; return 8 * (i >> 2) + 4 * n + (i & 3); }
struct Unit { const char* a; const char* b; int pm, pn, keep, aux; };
__device__ __forceinline__ void tile_order(int wgid, int nM, int nN, int& pm, int& pn) {
    const int nwg = nM * nN; { const int q = nwg / NXCD, r = nwg % NXCD, xcd = wgid % NXCD, off = wgid / NXCD; wgid = (xcd < r ? xcd * (q + 1) : r * (q + 1) + (xcd - r) * q) + off; }
    const int nig = WGM * nN, gid = wgid / nig, fm = gid * WGM, gsz = (nM - fm) < WGM ? (nM - fm) : WGM;
    pm = fm + ((wgid % nig) % gsz); pn = (wgid % nig) / gsz;
}
template <class Epi, class Sched>
__device__ __forceinline__ void gemm_phase(LAS unsigned char* lds, const int K, const int lda, const int ldb, const Sched& S, const Epi& E) {
    const int tid = threadIdx.x, wid = __builtin_amdgcn_readfirstlane(tid >> 6), lane = tid & 63, wr = wid >> 2, wc = wid & 3, fr = lane & 15, fq = lane >> 4;
    const int nt = K / BK;
    unsigned voffA[2], voffB[2];
#pragma unroll
    for (int i = 0; i < 2; ++i) { int R, C; stage_rc(tid * 16 + i * 8192, R, C); const int Rb = (R & ~31) + perm32(R & 31);
        voffA[i] = (unsigned)(R * lda + C) * 2u; voffB[i] = (unsigned)(Rb * ldb + C) * 2u; }
    const size_t kstep = (size_t)(BK * 2);
    const size_t hstepA = (size_t)HALF * lda * 2, hstepB = (size_t)HALF * ldb * 2;
    const unsigned ldsw = (unsigned)wid * 1024u;
    const int aoff = lds_byte(wr * 64 + fr, fq * 8), boff = lds_byte(wc * 32 + fr, fq * 8);
#define PG8_SA(b, h) (((b) * 2 + (h)) * HTB)
#define PG8_SB(b, h) ((4 + (b) * 2 + (h)) * HTB)
#define PG8_STAGE(bufoff, gbase, voff) do { _Pragma("unroll") for (int _i = 0; _i < 2; ++_i) \
        __builtin_amdgcn_global_load_lds((const unsigned*)((const char*)(gbase) + (voff)[_i]), (LAS unsigned*)(lds + (bufoff) + ldsw + _i * 8192), 16, 0, 0); } while (0)
#define PG8_LDA(dst, b, h) do { _Pragma("unroll") for (int m = 0; m < 4; ++m) _Pragma("unroll") for (int k = 0; k < 2; ++k) dst[m][k] = *(const LAS bf16x8*)(lds + PG8_SA(b, h) + aoff + m * 2048 + k * 1024); } while (0)
#define PG8_LDB(dst, b, h) do { _Pragma("unroll") for (int n = 0; n < 2; ++n) _Pragma("unroll") for (int k = 0; k < 2; ++k) dst[n][k] = *(const LAS bf16x8*)(lds + PG8_SB(b, h) + boff + n * 2048 + k * 1024); } while (0)
#define PG8_MMA(ai, bj, At, Bt) do { __builtin_amdgcn_s_setprio(1); _Pragma("unroll") for (int m = 0; m < 4; ++m) _Pragma("unroll") for (int n = 0; n < 2; ++n) _Pragma("unroll") for (int k = 0; k < 2; ++k) \
        acc[ai][bj][m][n] = __builtin_amdgcn_mfma_f32_16x16x32_bf16(Bt[n][k], At[m][k], acc[ai][bj][m][n], 0, 0, 0); __builtin_amdgcn_s_setprio(0); } while (0)
#define PG8_WAIT_V(n) asm volatile("s_waitcnt vmcnt(" #n ")" ::: "memory")
#define PG8_WAIT_L(n) asm volatile("s_waitcnt lgkmcnt(" #n ")" ::: "memory")
#define PG8_BAR __builtin_amdgcn_s_barrier()
#define PG8_SCHED __builtin_amdgcn_sched_barrier(0)
    Unit cur, nxt; int ui = 0;
    if (!S.next(0, cur)) return;
    f32x4 acc[2][2][4][2];
#pragma unroll
    for (int a = 0; a < 2; ++a)
#pragma unroll
        for (int b = 0; b < 2; ++b)
#pragma unroll
            for (int m = 0; m < 4; ++m)
#pragma unroll
                for (int n = 0; n < 2; ++n) acc[a][b][m][n] = (f32x4){0.f, 0.f, 0.f, 0.f};
    bf16x8 At[4][2], B0[2][2], B1[2][2];
    const char* cA = cur.a; const char* cB = cur.b;
    PG8_STAGE(PG8_SB(0, 0), cB, voffB); PG8_STAGE(PG8_SB(0, 1), cB + hstepB, voffB); PG8_STAGE(PG8_SA(0, 0), cA, voffA); PG8_STAGE(PG8_SA(0, 1), cA + hstepA, voffA);
    if (wr == 1) PG8_BAR;
    PG8_WAIT_V(2); PG8_BAR;
    PG8_STAGE(PG8_SB(1, 0), cB + kstep, voffB); PG8_STAGE(PG8_SA(1, 0), cA + kstep, voffA); PG8_STAGE(PG8_SB(1, 1), cB + hstepB + kstep, voffB);
    PG8_WAIT_V(6); PG8_BAR;
    for (;;) {
        const bool has_next = S.next(ui + 1, nxt);
        const char* nA = has_next ? nxt.a : cA; const char* nB = has_next ? nxt.b : cB;
#pragma nounroll
        for (int t = 0; t < nt; t += 2) {
            const bool last = (t == nt - 2);
            const char* a1 = cA + (size_t)(t + 1) * kstep;
            const char* a2 = last ? nA : cA + (size_t)(t + 2) * kstep; const char* b2 = last ? nB : cB + (size_t)(t + 2) * kstep;
            const char* a3 = a2 + kstep; const char* b3 = b2 + kstep;
            PG8_LDB(B0, 0, 0); PG8_LDB(B1, 0, 1); PG8_SCHED; PG8_LDA(At, 0, 0); PG8_STAGE(PG8_SA(1, 1), a1 + hstepA, voffA);
            PG8_WAIT_V(8); PG8_WAIT_L(0); PG8_BAR; PG8_MMA(0, 0, At, B0); PG8_MMA(0, 1, At, B1); PG8_BAR; PG8_SCHED;
            PG8_LDA(At, 0, 1); PG8_STAGE(PG8_SB(0, 0), b2, voffB); PG8_STAGE(PG8_SB(0, 1), b2 + hstepB, voffB); PG8_STAGE(PG8_SA(0, 0), a2, voffA);
            PG8_WAIT_V(8); PG8_WAIT_L(0); PG8_BAR; PG8_MMA(1, 0, At, B0); PG8_MMA(1, 1, At, B1); PG8_BAR; PG8_SCHED;
            PG8_LDB(B0, 1, 0); PG8_LDB(B1, 1, 1); PG8_SCHED; PG8_LDA(At, 1, 0); PG8_STAGE(PG8_SA(0, 1), a2 + hstepA, voffA);
            PG8_WAIT_V(8); PG8_WAIT_L(0); PG8_BAR; PG8_MMA(0, 0, At, B0); PG8_MMA(0, 1, At, B1); PG8_BAR; PG8_SCHED;
            PG8_LDA(At, 1, 1); PG8_STAGE(PG8_SB(1, 0), b3, voffB); PG8_STAGE(PG8_SB(1, 1), b3 + hstepB, voffB); PG8_STAGE(PG8_SA(1, 0), a3, voffA);
            PG8_WAIT_V(8); PG8_WAIT_L(0); PG8_BAR; PG8_MMA(1, 0, At, B0); PG8_MMA(1, 1, At, B1); PG8_BAR; PG8_SCHED;
        }
        if (wr == 0) PG8_BAR;
        E(acc, cur, wr, wc, fr, fq);
        if (!has_next) break;
        if (!cur.keep) {
#pragma unroll
            for (int a = 0; a < 2; ++a)
#pragma unroll
                for (int b = 0; b < 2; ++b)
#pragma unroll
                    for (int m = 0; m < 4; ++m)
#pragma unroll
                        for (int n = 0; n < 2; ++n) acc[a][b][m][n] = (f32x4){0.f, 0.f, 0.f, 0.f};
        }
        cur = nxt; cA = nA; cB = nB; ++ui;
        if (wr == 1) PG8_BAR;
    }
    PG8_WAIT_V(0);
    PG8_BAR;
#undef PG8_SA
#undef PG8_SB
#undef PG8_STAGE
#undef PG8_LDA
#undef PG8_LDB
#undef PG8_MMA
#undef PG8_WAIT_V
#undef PG8_WAIT_L
#undef PG8_BAR
#undef PG8_SCHED
}
struct GridSched {
    const char* A; const char* Bt; size_t astep, bstep; int nM, nN, G, c;
    __device__ __forceinline__ bool next(int i, Unit& u) const {
        const long L = (long)i * G + c; if (L >= (long)nM * nN) return false;
        int pm, pn; tile_order((int)L, nM, nN, pm, pn);
        u.a = A + (size_t)pm * astep; u.b = Bt + (size_t)pn * bstep; u.pm = pm; u.pn = pn; u.keep = 0; u.aux = 0; return true;
    }
};
struct BatchSched {
    const char* A; const char* Bt; size_t astep, bstep; int n, G, c;
    __device__ __forceinline__ bool next(int i, Unit& u) const {
        const int L = i * G + c; if (L >= n) return false;
        u.a = A + (size_t)L * astep; u.b = Bt + (size_t)L * bstep; u.pm = L; u.pn = 0; u.keep = 0; u.aux = 0; return true;
    }
};
struct ChainSched {
    const char* A; const char* Bt; int bh, dir;
    __device__ __forceinline__ bool next(int i, Unit& u) const {
        if (i >= NCH) return false;
        const int n = dir ? (NCH - 1 - i) : i, blk = bh * NCH + n;
        u.a = A + (size_t)blk * (256 * 768 * 2); u.b = Bt + (size_t)blk * (256 * 256 * 2); u.pm = blk; u.pn = i; u.keep = 1; u.aux = n; return true;
    }
};
struct MoeSched {
    const char* A; const char* Bt; const int* tile_e; size_t estride; int ntiles, nN, G, c;
    __device__ __forceinline__ bool next(int i, Unit& u) const {
        const long L = (long)i * G + c; if (L >= (long)ntiles * nN) return false;
        int pm, pn; tile_order((int)L, ntiles, nN, pm, pn);
        const int e = __builtin_amdgcn_readfirstlane(tile_e[pm]);
        u.a = A + (size_t)pm * (256 * 2048 * 2); u.b = Bt + (size_t)e * estride + (size_t)pn * (256 * 2048 * 2); u.pm = pm; u.pn = pn; u.keep = 0; u.aux = e; return true;
    }
};
}
using pg8::Unit;

#define EPI_LOOP _Pragma("unroll") for (int ai = 0; ai < 2; ++ai) _Pragma("unroll") for (int m = 0; m < 4; ++m)
#define EPI_ROW (ai * 128 + wr * 64 + m * 16 + fr)
#define EPI_FENCE asm volatile("" ::: "memory")
typedef f32x4 Acc[2][2][4][2];

__device__ __forceinline__ void rot4(const f32x4 x1, const f32x4 x2, const f32x4 csA, const f32x4 csB, f32x4& o1, f32x4& o2) {
    o1[0] = x1[0] * csA[0] - x2[0] * csA[1]; o2[0] = x1[0] * csA[1] + x2[0] * csA[0];
    o1[1] = x1[1] * csA[2] - x2[1] * csA[3]; o2[1] = x1[1] * csA[3] + x2[1] * csA[2];
    o1[2] = x1[2] * csB[0] - x2[2] * csB[1]; o2[2] = x1[2] * csB[1] + x2[2] * csB[0];
    o1[3] = x1[3] * csB[2] - x2[3] * csB[3]; o2[3] = x1[3] * csB[3] + x2[3] * csB[2];
}
__device__ __forceinline__ f32x4 rot_il(const f32x4 v, const f32x4 cs) {
    return (f32x4){v[0] * cs[0] - v[1] * cs[1], v[0] * cs[1] + v[1] * cs[0], v[2] * cs[2] - v[3] * cs[3], v[2] * cs[3] + v[3] * cs[2]};
}

struct EpiInproj {
    bf16_t *QL, *CKV, *KR, *ACAT, *KROT, *SG, *GA, *GB; float *ssqp; const float* cs_ret; const float* cs_mla; const float* dectab;
    __device__ __forceinline__ void operator()(Acc& acc, const Unit& u, int wr, int wc, int fr, int fq) const {
        asm volatile("" : "+v"(fr), "+v"(fq));
        const int pn = u.pn, tok0 = u.pm * 256, cb = wc * 32 + fq * 8;
        if (pn < 4) {
            bf16_t* dst = QL + (size_t)(pn >> 1) * ((WS_CKV - WS_QL) / 2); float* ssq = ssqp + (size_t)(pn * 4 + wc) * T; const int c0 = (pn & 1) * 256 + cb;
            EPI_LOOP { const int row = tok0 + EPI_ROW; float s = 0.f;
#pragma unroll
                for (int bj = 0; bj < 2; ++bj) { const f32x4 v0 = acc[ai][bj][m][0], v1 = acc[ai][bj][m][1];
                    s += (v0[0] * v0[0] + v0[1] * v0[1]) + (v0[2] * v0[2] + v0[3] * v0[3]) + (v1[0] * v1[0] + v1[1] * v1[1]) + (v1[2] * v1[2] + v1[3] * v1[3]);
                    *(u32x4*)(dst + (size_t)row * 512 + c0 + bj * 128) = pack8(v0, v1); }
                s += __shfl_xor(s, 16); s += __shfl_xor(s, 32);
                if (fq == 0) ssq[row] = s; EPI_FENCE; }
        } else if (pn == 4) {
            if (wc < 2) {
                EPI_LOOP { const int row = tok0 + EPI_ROW; const float* cs = cs_mla + (size_t)row * 64 + cb;
                    const f32x4 csA = *(const f32x4*)cs, csB = *(const f32x4*)(cs + 4);
                    *(u32x4*)(KR + (size_t)row * 64 + cb) = pack8(rot_il(acc[ai][0][m][0], csA), rot_il(acc[ai][0][m][1], csB)); EPI_FENCE; }
            }
        } else if (pn < 21) {
            const bool isq = pn < 13; const int h = isq ? pn - 5 : pn - 13;
            const int blk = ((u.pm >> 4) * 8 + h) * NCH + (u.pm & 15);
            const float lf = dectab[h], lb = dectab[8 + h];
            EPI_LOOP { const int c = EPI_ROW, row = tok0 + c; const float* cs = cs_ret + (size_t)row * 256 + cb * 2;
                f32x4 q1[2], q2[2];
#pragma unroll
                for (int n = 0; n < 2; ++n) { const f32x4 csA = *(const f32x4*)(cs + n * 8), csB = *(const f32x4*)(cs + n * 8 + 4); rot4(acc[ai][0][m][n], acc[ai][1][m][n], csA, csB, q1[n], q2[n]); }
                if (isq) {
                    const float xf = __builtin_amdgcn_exp2f((float)(c + 1) * lf), xb = __builtin_amdgcn_exp2f((float)(CH - c) * lb);
                    bf16_t* base = ACAT + ((size_t)blk * 256 + c) * 768 + cb;
                    *(u32x4*)(base + 256) = pack8(q1[0] * xf, q1[1] * xf); *(u32x4*)(base + 384) = pack8(q2[0] * xf, q2[1] * xf);
                    *(u32x4*)(base + 512) = pack8(q1[0] * xb, q1[1] * xb); *(u32x4*)(base + 640) = pack8(q2[0] * xb, q2[1] * xb);
                } else {
                    bf16_t* base = KROT + ((size_t)blk * 256 + c) * 256 + cb;
                    *(u32x4*)(base) = pack8(q1[0] * 0.0625f, q1[1] * 0.0625f); *(u32x4*)(base + 128) = pack8(q2[0] * 0.0625f, q2[1] * 0.0625f);
                }
                EPI_FENCE; }
        } else {
            const int g = (pn - 21) >> 3, ct = (pn - 21) & 7; bf16_t* dst = SG + (size_t)g * ((WS_GA - WS_SG) / 2);
            EPI_LOOP { const int row = tok0 + EPI_ROW;
#pragma unroll
                for (int bj = 0; bj < 2; ++bj) { f32x4 v[2];
#pragma unroll
                    for (int n = 0; n < 2; ++n)
#pragma unroll
                        for (int j = 0; j < 4; ++j) { const float x = acc[ai][bj][m][n][j]; const float sg = sigmoidf_(x); v[n][j] = g == 0 ? x * sg : sg; }
                    *(u32x4*)(dst + (size_t)row * 2048 + ct * 256 + bj * 128 + cb) = pack8(v[0], v[1]); }
                EPI_FENCE; }
        }
    }
};
struct EpiVT {
    bf16_t* BCAT;
    __device__ __forceinline__ void operator()(Acc& acc, const Unit& u, int wr, int wc, int fr, int fq) const {
        asm volatile("" : "+v"(fr), "+v"(fq));
        const int blk = ((u.pn >> 4) * 8 + u.pm) * NCH + (u.pn & 15), cb = wc * 32 + fq * 8;
        EPI_LOOP { bf16_t* base = BCAT + ((size_t)blk * 256 + EPI_ROW) * 768 + cb;
#pragma unroll
            for (int bj = 0; bj < 2; ++bj) *(u32x4*)(base + bj * 128) = pack8(acc[ai][bj][m][0], acc[ai][bj][m][1]); }
    }
};
struct EpiMlaQ {
    bf16_t *QN, *QR; const float* ssq; const float* cs_mla;
    __device__ __forceinline__ void operator()(Acc& acc, const Unit& u, int wr, int wc, int fr, int fq) const {
        asm volatile("" : "+v"(fr), "+v"(fq));
        const int pn = u.pn, tok0 = u.pm * 256, cb = wc * 32 + fq * 8;
        EPI_LOOP { const int row = tok0 + EPI_ROW; float ss = 0.f;
#pragma unroll
            for (int q = 0; q < 8; ++q) ss += ssq[(size_t)q * T + row];
            const float rs = rsqrtf(ss * (1.0f / 512.0f) + RMS_EPS) * QSCALE;
            if (pn < 4) {
#pragma unroll
                for (int bj = 0; bj < 2; ++bj) *(u32x4*)(QN + (size_t)row * 1024 + (2 * pn + bj) * 128 + cb) = pack8(acc[ai][bj][m][0] * rs, acc[ai][bj][m][1] * rs);
            } else {
                const int c0 = (wc & 1) * 32 + fq * 8; const float* cs = cs_mla + (size_t)row * 64 + c0;
                const f32x4 csA = *(const f32x4*)cs, csB = *(const f32x4*)(cs + 4);
#pragma unroll
                for (int bj = 0; bj < 2; ++bj) { const int head = 4 * (pn - 4) + 2 * bj + (wc >> 1);
                    *(u32x4*)(QR + (size_t)row * 512 + head * 64 + c0) = pack8(rot_il(acc[ai][bj][m][0], csA) * rs, rot_il(acc[ai][bj][m][1], csB) * rs); }
            }
            EPI_FENCE; }
    }
};
struct EpiMlaKV {
    bf16_t *KN, *VV; const float* ssq;
    __device__ __forceinline__ void operator()(Acc& acc, const Unit& u, int wr, int wc, int fr, int fq) const {
        asm volatile("" : "+v"(fr), "+v"(fq));
        const int pn = u.pn, tok0 = u.pm * 256, cb = wc * 32 + fq * 8; bf16_t* dst = KN + (size_t)(pn >> 2) * ((WS_VV - WS_KN) / 2); const int hb = 2 * (pn & 3);
        EPI_LOOP { const int row = tok0 + EPI_ROW; float ss = 0.f;
#pragma unroll
            for (int q = 0; q < 8; ++q) ss += ssq[(size_t)q * T + row];
            const float rs = rsqrtf(ss * (1.0f / 512.0f) + RMS_EPS);
#pragma unroll
            for (int bj = 0; bj < 2; ++bj) *(u32x4*)(dst + (size_t)row * 1024 + (hb + bj) * 128 + cb) = pack8(acc[ai][bj][m][0] * rs, acc[ai][bj][m][1] * rs); }
    }
};
struct EpiGa {
    bf16_t* ACAT; const float* dectab;
    __device__ __forceinline__ void operator()(Acc& acc, const Unit& u, int wr, int wc, int fr, int fq) const {
        asm volatile("" : "+v"(fr), "+v"(fq));
        const int blk = u.pm, h = (blk >> 4) & 7, cb = wc * 32 + fq * 8;
        const float lf = dectab[h], lb = dectab[8 + h];
        f32x4 colA[2][2], colB[2][2];
#pragma unroll
        for (int bj = 0; bj < 2; ++bj)
#pragma unroll
            for (int n = 0; n < 2; ++n)
#pragma unroll
                for (int j = 0; j < 4; ++j) { const int mm = bj * 128 + cb + n * 4 + j; colA[bj][n][j] = __builtin_amdgcn_exp2f(-(float)(mm + 1) * lf); colB[bj][n][j] = __builtin_amdgcn_exp2f((float)mm * lb); }
        EPI_LOOP { const int c = EPI_ROW; bf16_t* base = ACAT + ((size_t)blk * 256 + c) * 768 + cb;
            const float rowB = __builtin_amdgcn_exp2f(-(float)c * lb - (float)(c + 1) * lf);
#pragma unroll
            for (int bj = 0; bj < 2; ++bj) { f32x4 v[2];
#pragma unroll
                for (int n = 0; n < 2; ++n)
#pragma unroll
                    for (int j = 0; j < 4; ++j) { const int mm = bj * 128 + cb + n * 4 + j;
                        v[n][j] = acc[ai][bj][m][n][j] * ((c >= mm) ? colA[bj][n][j] : colB[bj][n][j] * rowB); }
                *(u32x4*)(base + bj * 128) = pack8(v[0], v[1]); }
            EPI_FENCE; }
    }
};
struct EpiGb {
    bf16_t* BCAT; const float* dectab; int dir;
    __device__ __forceinline__ void operator()(Acc& acc, const Unit& u, int wr, int wc, int fr, int fq) const {
        asm volatile("" : "+v"(fr), "+v"(fq));
        const int h = (u.pm >> 4) & 7, cb = wc * 32 + fq * 8;
        const float gC = __builtin_amdgcn_exp2f((float)CH * dectab[8 * dir + h]);
        const bool st = u.pn < NCH - 1; const int nblk = dir ? u.pm - 1 : u.pm + 1;
        EPI_LOOP { bf16_t* base = BCAT + ((size_t)nblk * 256 + EPI_ROW) * 768 + 256 + 256 * dir + cb;
#pragma unroll
            for (int bj = 0; bj < 2; ++bj) { if (st) *(u32x4*)(base + bj * 128) = pack8(acc[ai][bj][m][0], acc[ai][bj][m][1]);
                acc[ai][bj][m][0] *= gC; acc[ai][bj][m][1] *= gC; } }
    }
};
struct EpiGc {
    float* ORET;
    __device__ __forceinline__ void operator()(Acc& acc, const Unit& u, int wr, int wc, int fr, int fq) const {
        asm volatile("" : "+v"(fr), "+v"(fq));
        const int blk = u.pm, b = blk >> 7, h = (blk >> 4) & 7, n = blk & 15, cb = wc * 32 + fq * 8;
        EPI_LOOP { float* base = ORET + ((size_t)b * SEQ + n * 256 + EPI_ROW) * 2048 + h * 256 + cb;
#pragma unroll
            for (int bj = 0; bj < 2; ++bj) { *(f32x4*)(base + bj * 128) = acc[ai][bj][m][0]; *(f32x4*)(base + bj * 128 + 4) = acc[ai][bj][m][1]; } }
    }
};
struct EpiMixA {
    bf16_t* MIXP; const bf16_t* GA;
    __device__ __forceinline__ void operator()(Acc& acc, const Unit& u, int wr, int wc, int fr, int fq) const {
        asm volatile("" : "+v"(fr), "+v"(fq));
        const int cb = wc * 32 + fq * 8;
        EPI_LOOP { const size_t off = (size_t)(u.pm * 256 + EPI_ROW) * 2048 + u.pn * 256 + cb;
#pragma unroll
            for (int bj = 0; bj < 2; ++bj) { f32x4 g0, g1; unpack8(*(const u32x4*)(GA + off + bj * 128), g0, g1);
                *(u32x4*)(MIXP + off + bj * 128) = pack8(acc[ai][bj][m][0] * g0, acc[ai][bj][m][1] * g1); }
            EPI_FENCE; }
    }
};
struct EpiMixB {
    bf16_t* MIXIN; const bf16_t* MIXP; const bf16_t* GB;
    __device__ __forceinline__ void operator()(Acc& acc, const Unit& u, int wr, int wc, int fr, int fq) const {
        asm volatile("" : "+v"(fr), "+v"(fq));
        const int cb = wc * 32 + fq * 8;
        EPI_LOOP { const size_t off = (size_t)(u.pm * 256 + EPI_ROW) * 2048 + u.pn * 256 + cb;
#pragma unroll
            for (int bj = 0; bj < 2; ++bj) { f32x4 g0, g1, p0, p1; unpack8(*(const u32x4*)(GB + off + bj * 128), g0, g1); unpack8(*(const u32x4*)(MIXP + off + bj * 128), p0, p1);
                *(u32x4*)(MIXIN + off + bj * 128) = pack8(acc[ai][bj][m][0] * g0 + p0, acc[ai][bj][m][1] * g1 + p1); }
            EPI_FENCE; }
    }
};
struct EpiF32 {
    float* C;
    __device__ __forceinline__ void operator()(Acc& acc, const Unit& u, int wr, int wc, int fr, int fq) const {
        asm volatile("" : "+v"(fr), "+v"(fq));
        const int cb = wc * 32 + fq * 8;
        EPI_LOOP { float* base = C + (size_t)(u.pm * 256 + EPI_ROW) * 2048 + u.pn * 256 + cb;
#pragma unroll
            for (int bj = 0; bj < 2; ++bj) { *(f32x4*)(base + bj * 128) = acc[ai][bj][m][0]; *(f32x4*)(base + bj * 128 + 4) = acc[ai][bj][m][1]; } }
    }
};
struct EpiGU {
    bf16_t* ACT; const float* bgu;
    __device__ __forceinline__ void operator()(Acc& acc, const Unit& u, int wr, int wc, int fr, int fq) const {
        asm volatile("" : "+v"(fr), "+v"(fq));
        const int cb = wc * 32 + fq * 8, col = u.pn * 128 + cb; const float* bg = bgu + (size_t)u.aux * 4096 + col;
        const f32x4 bg0 = *(const f32x4*)bg, bg1 = *(const f32x4*)(bg + 4), bu0 = *(const f32x4*)(bg + 2048), bu1 = *(const f32x4*)(bg + 2052);
        EPI_LOOP { f32x4 v[2];
#pragma unroll
            for (int n = 0; n < 2; ++n)
#pragma unroll
                for (int j = 0; j < 4; ++j) { const float gt = fminf(acc[ai][0][m][n][j] + (n ? bg1[j] : bg0[j]), 7.0f); const float up = fminf(fmaxf(acc[ai][1][m][n][j] + (n ? bu1[j] : bu0[j]), -7.0f), 7.0f);
                    v[n][j] = (up + 1.0f) * gt * sigmoidf_(1.702f * gt); }
            *(u32x4*)(ACT + (size_t)(u.pm * 256 + EPI_ROW) * 2048 + col) = pack8(v[0], v[1]); EPI_FENCE; }
    }
};
struct EpiDown {
    bf16_t* YS; const float* bd;
    __device__ __forceinline__ void operator()(Acc& acc, const Unit& u, int wr, int wc, int fr, int fq) const {
        asm volatile("" : "+v"(fr), "+v"(fq));
        const int cb = wc * 32 + fq * 8; const float* bp = bd + (size_t)u.aux * 2048 + u.pn * 256 + cb;
        f32x4 bv[2][2];
#pragma unroll
        for (int bj = 0; bj < 2; ++bj) { bv[bj][0] = *(const f32x4*)(bp + bj * 128); bv[bj][1] = *(const f32x4*)(bp + bj * 128 + 4); }
        EPI_LOOP { bf16_t* base = YS + (size_t)(u.pm * 256 + EPI_ROW) * 2048 + u.pn * 256 + cb;
#pragma unroll
            for (int bj = 0; bj < 2; ++bj) *(u32x4*)(base + bj * 128) = pack8(acc[ai][bj][m][0] + bv[bj][0], acc[ai][bj][m][1] + bv[bj][1]); }
    }
};

namespace att {
constexpr int NW = 8, QBLK = 32, KVBLK = 64;
constexpr float THR = 8.f;
constexpr int SHM_V = KVBLK * 128 * 2, SHM_K = KVBLK * 192 * 2, SHM_ATTN = 2 * SHM_V + 2 * SHM_K + NW * 64 * 4;
#define KSWZ(row, colB) ((row) * 384 + ((colB) ^ (((row) & 7) << 4)))
#define SBAR() __builtin_amdgcn_sched_barrier(0)
__device__ __forceinline__ int crow(int r, int hi) { return (r & 3) + 8 * (r >> 2) + 4 * hi; }
__device__ __forceinline__ void partialSM(f32x16& p0, f32x16& p1, float& m_reg, float& mn, float& alpha) {
    constexpr float C = 1.4426950408889634f;
    float pmax = p0[0];
#pragma unroll
    for (int r = 1; r < 16; ++r) pmax = fmaxf(pmax, p0[r]);
#pragma unroll
    for (int r = 0; r < 16; ++r) pmax = fmaxf(pmax, p1[r]);
    { auto rr = __builtin_amdgcn_permlane32_swap(__float_as_uint(pmax), __float_as_uint(pmax), false, false);
      pmax = fmaxf(__uint_as_float(rr[0]), __uint_as_float(rr[1])); }
    if (__builtin_expect(__all(pmax - m_reg <= THR), 1)) { mn = m_reg; alpha = 1.f; }
    else { mn = fmaxf(m_reg, pmax); alpha = __builtin_amdgcn_exp2f((m_reg - mn) * C); m_reg = mn; }
    const float mnC = -mn * C;
#pragma unroll
    for (int r = 0; r < 16; ++r) p0[r] = fmaf(p0[r], C, mnC);
#pragma unroll
    for (int r = 0; r < 16; ++r) p1[r] = fmaf(p1[r], C, mnC);
#pragma unroll
    for (int r = 0; r < 16; ++r) p0[r] = __builtin_amdgcn_exp2f(p0[r]);
}
__device__ __forceinline__ void finishSM(f32x16& p0, f32x16& p1, float alpha, float& l_reg, bf16x8& pa0, bf16x8& pa1, bf16x8& pa2, bf16x8& pa3) {
#pragma unroll
    for (int r = 0; r < 16; ++r) p1[r] = __builtin_amdgcn_exp2f(p1[r]);
    float ps = 0;
#pragma unroll
    for (int r = 0; r < 16; ++r) ps += p0[r];
#pragma unroll
    for (int r = 0; r < 16; ++r) ps += p1[r];
    { auto rr = __builtin_amdgcn_permlane32_swap(__float_as_uint(ps), __float_as_uint(ps), false, false);
      ps = __uint_as_float(rr[0]) + __uint_as_float(rr[1]); }
    l_reg = l_reg * alpha + ps;
#define PK4(P, BASE, OUT) do { unsigned a0 = cvt_pk_bf16(P[BASE + 0], P[BASE + 1]), a1 = cvt_pk_bf16(P[BASE + 2], P[BASE + 3]);   \
    unsigned b0 = cvt_pk_bf16(P[BASE + 4], P[BASE + 5]), b1 = cvt_pk_bf16(P[BASE + 6], P[BASE + 7]);                              \
    auto r0 = __builtin_amdgcn_permlane32_swap(a0, b0, false, false); auto r1 = __builtin_amdgcn_permlane32_swap(a1, b1, false, false); \
    u32x4 w = {r0[0], r1[0], r0[1], r1[1]}; OUT = *reinterpret_cast<bf16x8*>(&w); } while (0)
    PK4(p0, 0, pa0); PK4(p0, 8, pa1); PK4(p1, 0, pa2); PK4(p1, 8, pa3);
#undef PK4
}
__device__ __forceinline__ void qkt(f32x16& p0, f32x16& p1, const char* Ks, const bf16x8* qr, int r32, int hi) {
    p0 = f32x16{}; p1 = f32x16{};
#pragma unroll
    for (int d0 = 0; d0 < 12; ++d0) { const int cb = (d0 * 16 + hi * 8) * 2;
        const bf16x8 b0 = *reinterpret_cast<const bf16x8*>(Ks + KSWZ(r32, cb));
        const bf16x8 b1 = *reinterpret_cast<const bf16x8*>(Ks + KSWZ(32 + r32, cb));
        p0 = __builtin_amdgcn_mfma_f32_32x32x16_bf16(b0, qr[d0], p0, 0, 0, 0);
        p1 = __builtin_amdgcn_mfma_f32_32x32x16_bf16(b1, qr[d0], p1, 0, 0, 0); }
}
__device__ __forceinline__ int v_st(int k, int c) { const int kk = (k & ~0xC) | ((k & 4) << 1) | ((k & 8) >> 1); return ((kk >> 3) * 4 + (c >> 5)) * 512 + ((kk & 7) * 32 + (c & 31)) * 2; }
__device__ __forceinline__ int v_rd_base(int lane) { return ((lane & 3) << 3) | (((lane >> 2) & 3) << 6) | (((lane >> 4) & 1) << 5) | (((lane >> 5) & 1) << 8); }
constexpr int v_rd_off(int d0, int ks, int half) { return d0 * 512 + ks * 4096 + half * 2048; }
template <int OFF> __device__ __forceinline__ s16x4 tr_read(int vb) {
    s16x4 r; asm volatile("ds_read_b64_tr_b16 %0, %1 offset:%2" : "=&v"(r) : "v"(vb), "i"(OFF) : "memory"); return r;
}
template <int D0> __device__ __forceinline__ void pv_one(f32x16& od, int vb, bf16x8 pa0, bf16x8 pa1, bf16x8 pa2, bf16x8 pa3) {
    const s16x4 l0 = tr_read<v_rd_off(D0, 0, 0)>(vb), h0 = tr_read<v_rd_off(D0, 0, 1)>(vb), l1 = tr_read<v_rd_off(D0, 1, 0)>(vb), h1 = tr_read<v_rd_off(D0, 1, 1)>(vb);
    const s16x4 l2 = tr_read<v_rd_off(D0, 2, 0)>(vb), h2 = tr_read<v_rd_off(D0, 2, 1)>(vb), l3 = tr_read<v_rd_off(D0, 3, 0)>(vb), h3 = tr_read<v_rd_off(D0, 3, 1)>(vb);
    asm volatile("s_waitcnt lgkmcnt(0)" ::: "memory"); SBAR();
#define PKV(L, H) (bf16x8){L[0], L[1], L[2], L[3], H[0], H[1], H[2], H[3]}
    od = __builtin_amdgcn_mfma_f32_32x32x16_bf16(pa0, PKV(l0, h0), od, 0, 0, 0);
    od = __builtin_amdgcn_mfma_f32_32x32x16_bf16(pa1, PKV(l1, h1), od, 0, 0, 0);
    od = __builtin_amdgcn_mfma_f32_32x32x16_bf16(pa2, PKV(l2, h2), od, 0, 0, 0);
    od = __builtin_amdgcn_mfma_f32_32x32x16_bf16(pa3, PKV(l3, h3), od, 0, 0, 0);
#undef PKV
}
__device__ __forceinline__ void pv_d0(f32x16* o, int vb, bf16x8 pa0, bf16x8 pa1, bf16x8 pa2, bf16x8 pa3) {
    pv_one<0>(o[0], vb, pa0, pa1, pa2, pa3); pv_one<1>(o[1], vb, pa0, pa1, pa2, pa3); pv_one<2>(o[2], vb, pa0, pa1, pa2, pa3); pv_one<3>(o[3], vb, pa0, pa1, pa2, pa3);
}
__device__ __forceinline__ void attn_unit(const bf16_t* __restrict__ Qn, const bf16_t* __restrict__ Qr, const bf16_t* __restrict__ Kn, const bf16_t* __restrict__ Kr,
                                          const bf16_t* __restrict__ Vh, bf16_t* __restrict__ Ob, int seq, char* lds) {
    const int tid = threadIdx.x, wid = tid >> 6, lane = tid & 63, r32 = lane & 31, hi = lane >> 5;
    char* V_lds = lds; char* K_lds = lds + 2 * SHM_V;
    float* ws = (float*)(lds + 2 * SHM_V + 2 * SHM_K) + wid * 64; float* li_l = ws; float* al_l = ws + 32;
    float m_reg = -1e30f, l_reg = 0; f32x16 o[4] = {}; bf16x8 qr[12];
    { const bf16_t* q0 = Qn + (long)(wid * QBLK + r32) * 1024 + hi * 8; const bf16_t* q1 = Qr + (long)(wid * QBLK + r32) * 512 + hi * 8;
#pragma unroll
      for (int d0 = 0; d0 < 8; ++d0) qr[d0] = *reinterpret_cast<const bf16x8*>(q0 + d0 * 16);
#pragma unroll
      for (int d0 = 0; d0 < 4; ++d0) qr[8 + d0] = *reinterpret_cast<const bf16x8*>(q1 + d0 * 16); }
    const int sr = tid >> 4, sc = (tid & 15) * 8, vst0 = v_st(sr, sc), vst1 = v_st(32 + sr, sc);
    const int rr = tid >> 3, rc = (tid & 7) * 8;
    const int vb0 = (int)(uintptr_t)V_lds + v_rd_base(lane);
    bf16x8 vs0, vs1, ks0, ks1, kr0;
#define SLOAD(k0) do { vs0 = *reinterpret_cast<const bf16x8*>(&Vh[(long)((k0) + sr) * 1024 + sc]); vs1 = *reinterpret_cast<const bf16x8*>(&Vh[(long)((k0) + 32 + sr) * 1024 + sc]); \
    ks0 = *reinterpret_cast<const bf16x8*>(&Kn[(long)((k0) + sr) * 1024 + sc]); ks1 = *reinterpret_cast<const bf16x8*>(&Kn[(long)((k0) + 32 + sr) * 1024 + sc]); \
    kr0 = *reinterpret_cast<const bf16x8*>(&Kr[(long)((k0) + rr) * 64 + rc]); } while (0)
#define SWRITE(b) do { *(bf16x8*)(V_lds + (b) * SHM_V + vst0) = vs0; *(bf16x8*)(V_lds + (b) * SHM_V + vst1) = vs1; const int kc = sc * 2;               \
    *(bf16x8*)(K_lds + (b) * SHM_K + KSWZ(sr, kc)) = ks0; *(bf16x8*)(K_lds + (b) * SHM_K + KSWZ(32 + sr, kc)) = ks1;                       \
    *(bf16x8*)(K_lds + (b) * SHM_K + KSWZ(rr, 256 + rc * 2)) = kr0; } while (0)
#define SWAIT() asm volatile("s_waitcnt vmcnt(0)" ::: "memory")
#define RESC(a) do { if (__any((a) < 1.f)) { if (hi == 0) al_l[r32] = (a); asm volatile("s_waitcnt lgkmcnt(0)" ::: "memory"); \
    _Pragma("unroll") for (int d = 0; d < 4; ++d) _Pragma("unroll") for (int r = 0; r < 16; ++r) o[d][r] *= al_l[crow(r, hi)]; } } while (0)
    f32x16 p0, p1; float mn, al; bf16x8 pa0, pa1, pa2, pa3; const int NT = seq / KVBLK;
    SLOAD(0); SWAIT(); SWRITE(0); __syncthreads();
    for (int j = 0; j < NT; ++j) {
        const int buf = j & 1;
        if (j + 1 < NT) SLOAD((j + 1) * KVBLK);
        SBAR(); qkt(p0, p1, K_lds + buf * SHM_K, qr, r32, hi);
        partialSM(p0, p1, m_reg, mn, al);
        RESC(al);
        finishSM(p0, p1, al, l_reg, pa0, pa1, pa2, pa3); SBAR();
        pv_d0(o, vb0 + buf * SHM_V, pa0, pa1, pa2, pa3);
        if (j + 1 < NT) { SWAIT(); SWRITE(buf ^ 1); }
        __syncthreads();
    }
    if (hi == 0) li_l[r32] = l_reg; asm volatile("s_waitcnt lgkmcnt(0)" ::: "memory");
    float rli[16];
#pragma unroll
    for (int r = 0; r < 16; ++r) rli[r] = __builtin_amdgcn_rcpf(li_l[crow(r, hi)]);
    bf16_t* Ow = Ob + (long)(wid * QBLK) * 1024;
#pragma unroll
    for (int r = 0; r < 16; ++r) { const int orow = crow(r, hi);
#pragma unroll
        for (int d0 = 0; d0 < 4; ++d0) Ow[(long)orow * 1024 + d0 * 32 + r32] = (bf16_t)(cvt_pk_bf16(o[d0][r] * rli[r], 0.f) & 0xffffu); }
#undef SLOAD
#undef SWRITE
#undef SWAIT
#undef RESC
}
}

struct Args { const float* in[26]; float* out; unsigned char* ws; int ph_lo, ph_hi; };
enum { PH_SETUP = 0, PH_H, PH_INPROJ, PH_INPROJ_V, PH_MLAQ, PH_MLAKV, PH_GA, PH_KT, PH_CHAIN, PH_ATTN, PH_GC, PH_MIXA, PH_GN, PH_MIXB, PH_MIX, PH_ROUTER, PH_DISPATCH, PH_GU, PH_DOWN, PH_COMBINE, NPH };
enum { I_X = 0, I_C, I_POS, I_WADA, I_BADA, I_GPREM, I_GPOSTM, I_GPREF, I_GPOSTF, I_WIN, I_QAN, I_WQB, I_KVAN, I_WKVB, I_WMLAO, I_DECF, I_DECB, I_RETGN, I_WRETO, I_WOUT, I_WROUTER, I_BROUTER, I_WGU, I_BGU, I_WDOWN, I_BDOWN };

__device__ __forceinline__ int src_in(int r) {
    if (r < 1024) return r;
    if (r < 1088) { const int j = r - 1024; return 1024 + (j >> 1) + 32 * (j & 1); }
    if (r < 1280) return -1;
    if (r < N_IN_NAT) { const int g = (r - 1280) >> 11, off = (r - 1280) & 2047; const int base = g == 0 ? 1088 : (g == 1 ? 3136 : (g == 2 ? 7232 : (g == 3 ? 9280 : 11328))); return base + off; }
    return 5184 + (r - N_IN_NAT);
}
__device__ __forceinline__ int src_qb(int r) { if (r < 1024) return (r >> 7) * 192 + (r & 127); const int j = r - 1024, h = j >> 6, jj = j & 63; return h * 192 + 128 + (jj >> 1) + 32 * (jj & 1); }
__device__ __forceinline__ int src_kvb(int r) { if (r < 1024) return (r >> 7) * 256 + (r & 127); const int j = r - 1024; return (j >> 7) * 256 + 128 + (j & 127); }
__device__ __forceinline__ int src_gu(int r) { const int t = r >> 8, rr = r & 255; return rr < 128 ? 128 * t + rr : 2048 + 128 * t + rr - 128; }

__device__ __forceinline__ void cvt_item(const float* __restrict__ W, int ldw, int K, bf16_t* __restrict__ WT, const float* __restrict__ kscale, int sc, int k0, int r0, LAS float* scr, int lane) {
    float v[64];
    const float* wp = W + (size_t)k0 * ldw + (sc >= 0 ? sc : 0);
#pragma unroll
    for (int i = 0; i < 64; ++i) v[i] = wp[(size_t)i * ldw];
    if (sc < 0) {
#pragma unroll
        for (int i = 0; i < 64; ++i) v[i] = 0.f;
    }
    if (kscale) {
#pragma unroll
        for (int i = 0; i < 64; ++i) v[i] *= kscale[k0 + i];
    }
#pragma unroll
    for (int i = 0; i < 64; ++i) scr[i * 65 + lane] = v[i];
    asm volatile("s_waitcnt lgkmcnt(0)" ::: "memory");
    const int c = lane & 7;
#pragma unroll
    for (int j = 0; j < 8; ++j) { const int n = (lane >> 3) + 8 * j; const LAS float* s = scr + (8 * c) * 65 + n;
        u32x4 o; o.x = cvt_pk_bf16(s[0 * 65], s[1 * 65]); o.y = cvt_pk_bf16(s[2 * 65], s[3 * 65]); o.z = cvt_pk_bf16(s[4 * 65], s[5 * 65]); o.w = cvt_pk_bf16(s[6 * 65], s[7 * 65]);
        *(u32x4*)(WT + (size_t)(r0 + n) * K + k0 + 8 * c) = o; }
    asm volatile("s_waitcnt lgkmcnt(0)" ::: "memory");
}

__device__ __forceinline__ const void* larg(volatile LAS unsigned long long* L, int i) {
    const unsigned long long v = L[i]; const unsigned l0 = __builtin_amdgcn_readfirstlane((unsigned)v), h0 = __builtin_amdgcn_readfirstlane((unsigned)(v >> 32));
    return (const void*)(const __attribute__((address_space(1))) void*)(((unsigned long long)h0 << 32) | l0);
}
__global__ void __launch_bounds__(512, 2) fwd_kernel(Args args) {
    extern __shared__ __attribute__((aligned(16))) unsigned char lds_raw[];
    LAS unsigned char* lds = (LAS unsigned char*)lds_raw;
    volatile LAS unsigned* MISC = (volatile LAS unsigned*)(lds + MISC_OFF);
    const int tid = threadIdx.x;
    const int G = gridDim.x, bx = blockIdx.x, NGW = G * 8;
    volatile LAS unsigned long long* LARG = (volatile LAS unsigned long long*)(lds + LARG_OFF);
    const int lo = args.ph_lo, hi = args.ph_hi;
    for (int u = tid; u < (LDS_BYTES - CTRL_OFF) / 4; u += 512) ((LAS unsigned*)(lds + CTRL_OFF))[u] = 0u;
    __syncthreads();
    if (tid == 0) {
#pragma unroll
        for (int i = 0; i < 26; ++i) LARG[i] = (unsigned long long)args.in[i];
        LARG[26] = (unsigned long long)args.out; LARG[27] = (unsigned long long)args.ws;
    }
    __syncthreads();
    XcdBarrier bar; bar.bar = (unsigned*)(args.ws + WS_CTL) + CW_BAR; bar.x = 0; bar.st = nullptr;
    if (hi - lo > 1) bar = xcd_barrier_post(bar.bar, MISC + 8);
#ifdef PH_ONLY
#define IN(k) ((k) == PH_ONLY && lo <= (k) && (k) < hi)
#else
#define IN(k) (lo <= (k) && (k) < hi)
#endif
#define SEAM(k) do { if (lo <= (k) && (k) + 1 < hi) xcd_barrier(bar); } while (0)
#define INP(i) ((const float*)larg(LARG, (i)))
#define PTRS \
    int tid = threadIdx.x; asm volatile("" : "+v"(tid)); const int lane = tid & 63, wave = __builtin_amdgcn_readfirstlane(tid >> 6), gw = bx * 8 + wave; (void)lane; (void)gw; \
    unsigned char* const ws = (unsigned char*)larg(LARG, 27); unsigned* const ctl = (unsigned*)(ws + WS_CTL); float* const outp = (float*)larg(LARG, 26); \
    float* const ada = (float*)(ctl + CW_ADA); float* const SSQP = (float*)(ws + WS_SSQP); \
    bf16_t* const WT_IN = (bf16_t*)(ws + WS_WT_IN); bf16_t* const WT_QB = (bf16_t*)(ws + WS_WT_QB); bf16_t* const WT_KVB = (bf16_t*)(ws + WS_WT_KVB); bf16_t* const WT_MLAO = (bf16_t*)(ws + WS_WT_MLAO); \
    bf16_t* const WT_RETO = (bf16_t*)(ws + WS_WT_RETO); bf16_t* const WT_OUT = (bf16_t*)(ws + WS_WT_OUT); bf16_t* const WT_GU = (bf16_t*)(ws + WS_WT_GU); bf16_t* const WT_DOWN = (bf16_t*)(ws + WS_WT_DOWN); \
    float* const CS_RET = (float*)(ws + WS_CS_RET); float* const CS_MLA = (float*)(ws + WS_CS_MLA); \
    bf16_t* const Hb = (bf16_t*)(ws + WS_H); bf16_t* const QL = (bf16_t*)(ws + WS_QL); bf16_t* const CKV = (bf16_t*)(ws + WS_CKV); bf16_t* const KR = (bf16_t*)(ws + WS_KR); \
    bf16_t* const ACAT = (bf16_t*)(ws + WS_ACAT); bf16_t* const BCAT = (bf16_t*)(ws + WS_BCAT); bf16_t* const KROT = (bf16_t*)(ws + WS_KROT); bf16_t* const KZTF = (bf16_t*)(ws + WS_KZTF); bf16_t* const KZTB = (bf16_t*)(ws + WS_KZTB); \
    bf16_t* const SG = (bf16_t*)(ws + WS_SG); bf16_t* const GA = (bf16_t*)(ws + WS_GA); bf16_t* const GB = (bf16_t*)(ws + WS_GB); \
    bf16_t* const QN = (bf16_t*)(ws + WS_QN); bf16_t* const QR = (bf16_t*)(ws + WS_QR); bf16_t* const KN = (bf16_t*)(ws + WS_KN); bf16_t* const VV = (bf16_t*)(ws + WS_VV); bf16_t* const OA = (bf16_t*)(ws + WS_OA); \
    float* const ORET = (float*)(ws + WS_ORET); bf16_t* const OB = (bf16_t*)(ws + WS_OB); bf16_t* const MIXP = (bf16_t*)(ws + WS_MIXP); bf16_t* const MIXIN = (bf16_t*)(ws + WS_MIXIN); float* const MIX = (float*)(ws + WS_MIX); \
    bf16_t* const H2 = (bf16_t*)(ws + WS_H2); int* const TOPI = (int*)(ws + WS_TOPI); float* const TOPW = (float*)(ws + WS_TOPW); int* const DEST = (int*)(ws + WS_DEST); int* const TILE = (int*)(ws + WS_TILE); float* const DECTAB = (float*)(ws + WS_DECTAB); \
    bf16_t* const XS = (bf16_t*)(ws + WS_XS); bf16_t* const ACT = (bf16_t*)(ws + WS_ACT); bf16_t* const YS = (bf16_t*)(ws + WS_YS); \
    (void)ctl; (void)outp; (void)ada; (void)SSQP; (void)WT_IN; (void)WT_QB; (void)WT_KVB; (void)WT_MLAO; (void)WT_RETO; (void)WT_OUT; (void)WT_GU; (void)WT_DOWN; (void)CS_RET; (void)CS_MLA; (void)Hb; (void)QL; (void)CKV; (void)KR; \
    (void)ACAT; (void)BCAT; (void)KROT; (void)KZTF; (void)KZTB; (void)SG; (void)GA; (void)GB; (void)QN; (void)QR; (void)KN; (void)VV; (void)OA; (void)ORET; (void)OB; (void)MIXP; (void)MIXIN; (void)MIX; (void)H2; (void)TOPI; (void)TOPW; (void)DEST; (void)TILE; (void)DECTAB; (void)XS; (void)ACT; (void)YS;

    if (IN(PH_SETUP)) {
        PTRS
        if (bx == 0 && tid < 16) DECTAB[tid] = log2_sigmoid(tid < 8 ? INP(I_DECF)[tid] : INP(I_DECB)[tid - 8]);
        {
            const float* wada = INP(I_WADA); const float* cvec = INP(I_C); const float* bada = INP(I_BADA);
            for (int it = gw; it < 192; it += NGW) {
                const int j = it * 64 + lane;
                float a0 = 0.f, a1 = 0.f, a2 = 0.f, a3 = 0.f;
#pragma nounroll
                for (int k0 = 0; k0 < 2048; k0 += 64) {
                    float w[64];
#pragma unroll
                    for (int i = 0; i < 64; ++i) w[i] = wada[(size_t)(k0 + i) * 12288 + j];
#pragma unroll
                    for (int i = 0; i < 64; ++i) { a0 += w[i] * cvec[k0 + i]; a1 += w[i] * cvec[2048 + k0 + i]; a2 += w[i] * cvec[4096 + k0 + i]; a3 += w[i] * cvec[6144 + k0 + i]; }
                }
                const float bb = bada[j];
                ada[j] = a0 + bb; ada[12288 + j] = a1 + bb; ada[24576 + j] = a2 + bb; ada[36864 + j] = a3 + bb;
            }
        }
        {
            const int* pos = (const int*)INP(I_POS);
            for (int i = bx * 512 + tid; i < T * 160; i += G * 512) {
                const int tok = i / 160, f = i % 160; const float p = (float)pos[tok];
                float inv; float* dst;
                if (f < 128) { inv = 1.0f / powf(10000.0f, (float)f / 128.0f); dst = CS_RET + (size_t)tok * 256 + f * 2; }
                else { inv = 1.0f / powf(10000.0f, (float)(f - 128) / 32.0f); dst = CS_MLA + (size_t)tok * 64 + (f - 128) * 2; }
                float s, c; sincosf(p * inv, &s, &c); dst[0] = c; dst[1] = s;
            }
        }
        {
            LAS float* scr = (LAS float*)(lds + wave * 16640);
            constexpr int I_IN = (N_IN_ALL / 64) * 32, I_QB = 24 * 8, I_KVB = 32 * 8, I_MLAO = 32 * 16, I_SQ = 32 * 32, I_GU = 32 * 64 * 32, I_DN = 32 * 32 * 32;
            constexpr int NITEMS = I_IN + I_QB + I_KVB + I_MLAO + 2 * I_SQ + I_GU + I_DN;
            for (int it = gw; it < NITEMS; it += NGW) {
                int r = it;
                if (r < I_IN) { const int nb = r / 32, kb = r % 32; cvt_item(INP(I_WIN), 13376, 2048, WT_IN, nullptr, src_in(nb * 64 + lane), kb * 64, nb * 64, scr, lane); continue; } r -= I_IN;
                if (r < I_QB) { const int nb = r / 8, kb = r % 8; cvt_item(INP(I_WQB), 1536, 512, WT_QB, INP(I_QAN), src_qb(nb * 64 + lane), kb * 64, nb * 64, scr, lane); continue; } r -= I_QB;
                if (r < I_KVB) { const int nb = r / 8, kb = r % 8; cvt_item(INP(I_WKVB), 2048, 512, WT_KVB, INP(I_KVAN), src_kvb(nb * 64 + lane), kb * 64, nb * 64, scr, lane); continue; } r -= I_KVB;
                if (r < I_MLAO) { const int nb = r / 16, kb = r % 16; cvt_item(INP(I_WMLAO), 2048, 1024, WT_MLAO, nullptr, nb * 64 + lane, kb * 64, nb * 64, scr, lane); continue; } r -= I_MLAO;
                if (r < I_SQ) { const int nb = r / 32, kb = r % 32; cvt_item(INP(I_WRETO), 2048, 2048, WT_RETO, nullptr, nb * 64 + lane, kb * 64, nb * 64, scr, lane); continue; } r -= I_SQ;
                if (r < I_SQ) { const int nb = r / 32, kb = r % 32; cvt_item(INP(I_WOUT), 2048, 2048, WT_OUT, nullptr, nb * 64 + lane, kb * 64, nb * 64, scr, lane); continue; } r -= I_SQ;
                if (r < I_GU) { const int e = r / 2048, q = r % 2048, nb = q / 32, kb = q % 32;
                    cvt_item(INP(I_WGU) + (size_t)e * 2048 * 4096, 4096, 2048, WT_GU + (size_t)e * 4096 * 2048, nullptr, src_gu(nb * 64 + lane), kb * 64, nb * 64, scr, lane); continue; } r -= I_GU;
                { const int e = r / 1024, q = r % 1024, nb = q / 32, kb = q % 32;
                    cvt_item(INP(I_WDOWN) + (size_t)e * 2048 * 2048, 2048, 2048, WT_DOWN + (size_t)e * 2048 * 2048, nullptr, nb * 64 + lane, kb * 64, nb * 64, scr, lane); }
            }
        }
    }
    SEAM(PH_SETUP);
    if (IN(PH_H)) {
        PTRS
        const float* g = INP(I_GPREM);
        for (int mrow = gw; mrow < T; mrow += NGW) {
            const int b = mrow / SEQ; const f32x4* xr = (const f32x4*)(INP(I_X) + (size_t)mrow * D) + lane;
            f32x4 v[8]; float s = 0.f;
#pragma unroll
            for (int j = 0; j < 8; ++j) { v[j] = xr[64 * j]; s += (v[j][0] * v[j][0] + v[j][1] * v[j][1]) + (v[j][2] * v[j][2] + v[j][3] * v[j][3]); }
            const float r = rsqrtf(wave_sum(s) * (1.0f / D) + RMS_EPS);
            u32x2* o8 = (u32x2*)(Hb + (size_t)mrow * D) + lane;
#pragma unroll
            for (int j = 0; j < 8; ++j) { const int col = 256 * j + 4 * lane; const f32x4 gg = *(const f32x4*)(g + col), sh = *(const f32x4*)(ada + b * 12288 + col), sc = *(const f32x4*)(ada + b * 12288 + 2048 + col);
                const f32x4 y = v[j] * r * gg * (sc + 1.0f) + sh; u32x2 w; w.x = cvt_pk_bf16(y[0], y[1]); w.y = cvt_pk_bf16(y[2], y[3]); o8[64 * j] = w; }
        }
    }
    SEAM(PH_H);
    if (IN(PH_INPROJ)) {
        PTRS
        {   pg8::GridSched S{(const char*)Hb, (const char*)WT_IN, (size_t)256 * 2048 * 2, (size_t)256 * 2048 * 2, T / 256, N_IN_NAT / 256, G, bx};
            EpiInproj E{QL, CKV, KR, ACAT, KROT, SG, GA, GB, SSQP, CS_RET, CS_MLA, DECTAB};
            pg8::gemm_phase(lds, 2048, 2048, 2048, S, E); }
    }
    if (IN(PH_INPROJ_V)) {
        PTRS
        {   pg8::GridSched S{(const char*)(WT_IN + (size_t)N_IN_NAT * 2048), (const char*)Hb, (size_t)256 * 2048 * 2, (size_t)256 * 2048 * 2, 8, T / 256, G, bx};
            EpiVT E{BCAT};
            pg8::gemm_phase(lds, 2048, 2048, 2048, S, E); }
    }
    SEAM(PH_INPROJ_V);
    if (IN(PH_MLAQ)) {
        PTRS
        {   pg8::GridSched S{(const char*)QL, (const char*)WT_QB, (size_t)256 * 512 * 2, (size_t)256 * 512 * 2, T / 256, 6, G, bx};
            EpiMlaQ E{QN, QR, SSQP, CS_MLA}; pg8::gemm_phase(lds, 512, 512, 512, S, E); }
    }
    if (IN(PH_MLAKV)) {
        PTRS
        {   pg8::GridSched S{(const char*)CKV, (const char*)WT_KVB, (size_t)256 * 512 * 2, (size_t)256 * 512 * 2, T / 256, 8, G, bx};
            EpiMlaKV E{KN, VV, SSQP + (size_t)8 * T}; pg8::gemm_phase(lds, 512, 512, 512, S, E); }
    }
    if (IN(PH_GA)) {
        PTRS
        {   pg8::BatchSched S{(const char*)(ACAT + 256), (const char*)KROT, (size_t)256 * 768 * 2, (size_t)256 * 256 * 2, NBLK, G, bx};
            EpiGa E{ACAT, DECTAB}; pg8::gemm_phase(lds, 256, 768, 256, S, E); }
    }
    if (IN(PH_KT)) {
        PTRS
        {
            LAS bf16_t* scr = (LAS bf16_t*)(lds + wave * 9216);
            for (int it = gw; it < NBLK * 16; it += NGW) {
                const int blk = it >> 4, sp = (it >> 2) & 3, sd = it & 3, h = (blk >> 4) & 7;
                const float lf = DECTAB[h], lb = DECTAB[8 + h];
                const bf16_t* src = KROT + ((size_t)blk * 256 + sp * 64 + lane) * 256 + sd * 64;
#pragma unroll
                for (int q = 0; q < 8; ++q) { const u32x4 w = *(const u32x4*)(src + q * 8);
#pragma unroll
                    for (int e = 0; e < 4; ++e) { const unsigned ww = w[e]; scr[(q * 8 + e * 2) * 72 + lane] = (bf16_t)(ww & 0xffffu); scr[(q * 8 + e * 2 + 1) * 72 + lane] = (bf16_t)(ww >> 16); } }
                asm volatile("s_waitcnt lgkmcnt(0)" ::: "memory");
                bf16_t* df = KZTF + ((size_t)blk * 256 + sd * 64 + lane) * 256 + sp * 64;
                bf16_t* db = KZTB + ((size_t)blk * 256 + sd * 64 + lane) * 256 + sp * 64;
#pragma unroll
                for (int q = 0; q < 8; ++q) { const u32x4 w = *(const LAS u32x4*)(scr + lane * 72 + q * 8); f32x4 a, b2; unpack8(w, a, b2);
                    f32x4 zf0, zf1, zb0, zb1;
#pragma unroll
                    for (int e = 0; e < 4; ++e) { const int p0 = sp * 64 + q * 8 + e, p1 = p0 + 4;
                        zf0[e] = __builtin_amdgcn_exp2f((float)(255 - p0) * lf); zf1[e] = __builtin_amdgcn_exp2f((float)(255 - p1) * lf); zb0[e] = __builtin_amdgcn_exp2f((float)p0 * lb); zb1[e] = __builtin_amdgcn_exp2f((float)p1 * lb); }
                    *(u32x4*)(df + q * 8) = pack8(a * zf0, b2 * zf1); *(u32x4*)(db + q * 8) = pack8(a * zb0, b2 * zb1); }
                asm volatile("s_waitcnt lgkmcnt(0)" ::: "memory");
            }
        }
    }
    SEAM(PH_KT);
    if (IN(PH_CHAIN)) {
        PTRS
        if (bx < 64) {
            const int bh = bx >> 1, dir = bx & 1;
            {
                const int blk0 = bh * NCH + (dir ? NCH - 1 : 0);
                bf16_t* z = BCAT + ((size_t)blk0 * 256 + (tid >> 1)) * 768 + 256 + 256 * dir + (tid & 1) * 128;
#pragma unroll
                for (int q = 0; q < 16; ++q) *(u32x4*)(z + q * 8) = (u32x4){0u, 0u, 0u, 0u};
            }
            pg8::ChainSched S{(const char*)BCAT, (const char*)(dir ? KZTB : KZTF), bh, dir};
            EpiGb E{BCAT, DECTAB, dir};
            pg8::gemm_phase(lds, 256, 768, 256, S, E);
        }
    }
    if (IN(PH_ATTN)) {
        PTRS
        unsigned* queue = ctl + CW_QUEUE;
        for (;;) {
            __syncthreads();
            if (tid == 0) MISC[0] = atomicAdd(queue, 1u);
            __syncthreads();
            const int a = (int)MISC[0];
            if (a >= 512) break;
            const int bh = a >> 4, qb = a & 15, b = bh >> 3, h = bh & 7;
            const size_t tok0 = (size_t)b * SEQ + qb * 256, kt0 = (size_t)b * SEQ;
            att::attn_unit(QN + tok0 * 1024 + h * 128, QR + tok0 * 512 + h * 64, KN + kt0 * 1024 + h * 128, KR + kt0 * 64, VV + kt0 * 1024 + h * 128, OA + tok0 * 1024 + h * 128, SEQ, (char*)lds_raw);
        }
    }
    SEAM(PH_ATTN);
    if (IN(PH_GC)) {
        PTRS
        {   pg8::BatchSched S{(const char*)ACAT, (const char*)BCAT, (size_t)256 * 768 * 2, (size_t)256 * 768 * 2, NBLK, G, bx};
            EpiGc E{ORET}; pg8::gemm_phase(lds, 768, 768, 768, S, E); }
    }
    if (IN(PH_MIXA)) {
        PTRS
        {   pg8::GridSched S{(const char*)OA, (const char*)WT_MLAO, (size_t)256 * 1024 * 2, (size_t)256 * 1024 * 2, T / 256, 8, G, bx};
            EpiMixA E{MIXP, GA}; pg8::gemm_phase(lds, 1024, 1024, 1024, S, E); }
    }
    SEAM(PH_MIXA);
    if (IN(PH_GN)) {
        PTRS
        const float* gn = INP(I_RETGN);
        for (int mrow = gw; mrow < T; mrow += NGW) {
            const f32x4* orow = (const f32x4*)(ORET + (size_t)mrow * D) + lane; const u32x2* sg = (const u32x2*)(SG + (size_t)mrow * D) + lane; u32x2* ob = (u32x2*)(OB + (size_t)mrow * D) + lane;
#pragma unroll
            for (int j = 0; j < 8; ++j) {
                const f32x4 v = orow[64 * j]; const float mu = wave_sum((v[0] + v[1]) + (v[2] + v[3])) * (1.0f / 256.0f);
                const f32x4 d = v - mu; const float var = wave_sum((d[0] * d[0] + d[1] * d[1]) + (d[2] * d[2] + d[3] * d[3])) * (1.0f / 256.0f);
                const float rs = rsqrtf(var + GN_EPS); const f32x4 gg = *(const f32x4*)(gn + 256 * j + 4 * lane); const u32x2 s2 = sg[64 * j];
                const f32x4 sv = (f32x4){bf_lo(s2.x), bf_hi(s2.x), bf_lo(s2.y), bf_hi(s2.y)};
                const f32x4 y = sv * (d * rs * gg); u32x2 w; w.x = cvt_pk_bf16(y[0], y[1]); w.y = cvt_pk_bf16(y[2], y[3]); ob[64 * j] = w; }
        }
    }
    SEAM(PH_GN);
    if (IN(PH_MIXB)) {
        PTRS
        pg8::GridSched S{(const char*)OB, (const char*)WT_RETO, (size_t)256 * 2048 * 2, (size_t)256 * 2048 * 2, T / 256, 8, G, bx};
        EpiMixB E{MIXIN, MIXP, GB}; pg8::gemm_phase(lds, 2048, 2048, 2048, S, E);
    }
    SEAM(PH_MIXB);
    if (IN(PH_MIX)) {
        PTRS
        pg8::GridSched S{(const char*)MIXIN, (const char*)WT_OUT, (size_t)256 * 2048 * 2, (size_t)256 * 2048 * 2, T / 256, 8, G, bx};
        EpiF32 E{MIX}; pg8::gemm_phase(lds, 2048, 2048, 2048, S, E);
    }
    SEAM(PH_MIX);
    if (IN(PH_ROUTER)) {
        PTRS
        const float* gpm = INP(I_GPOSTM); const float* gpf = INP(I_GPREF); const float* wr = INP(I_WROUTER); const float* brt = INP(I_BROUTER);
        LAS float* red = (LAS float*)(lds + wave * 8448);
        unsigned* counts = ctl + CW_COUNTS;
        for (int mrow = gw; mrow < T; mrow += NGW) {
            int lane = tid & 63; asm volatile("" : "+v"(lane));
            const int b = mrow / SEQ; const float* ad = ada + b * 12288;
            const f32x4* mr = (const f32x4*)(MIX + (size_t)mrow * D) + lane; const f32x4* xr = (const f32x4*)(INP(I_X) + (size_t)mrow * D) + lane;
            f32x4 v[8]; float s = 0.f;
#pragma unroll
            for (int j = 0; j < 8; ++j) { v[j] = mr[64 * j]; s += (v[j][0] * v[j][0] + v[j][1] * v[j][1]) + (v[j][2] * v[j][2] + v[j][3] * v[j][3]); }
            const float r1 = rsqrtf(wave_sum(s) * (1.0f / D) + RMS_EPS); float s2 = 0.f;
            f32x4* o4 = (f32x4*)(outp + (size_t)mrow * D) + lane;
#pragma unroll
            for (int j = 0; j < 8; ++j) { const int col = 256 * j + 4 * lane; const f32x4 gg = *(const f32x4*)(gpm + col), gm = *(const f32x4*)(ad + 4096 + col);
                v[j] = xr[64 * j] + gm * (v[j] * r1 * gg); o4[64 * j] = v[j]; s2 += (v[j][0] * v[j][0] + v[j][1] * v[j][1]) + (v[j][2] * v[j][2] + v[j][3] * v[j][3]); }
            const float r2 = rsqrtf(wave_sum(s2) * (1.0f / D) + RMS_EPS);
            u32x2* h8 = (u32x2*)(H2 + (size_t)mrow * D) + lane;
#pragma unroll
            for (int j = 0; j < 8; ++j) { const int col = 256 * j + 4 * lane; const f32x4 gg = *(const f32x4*)(gpf + col), sh = *(const f32x4*)(ad + 6144 + col), sc = *(const f32x4*)(ad + 8192 + col);
                v[j] = v[j] * r2 * gg * (sc + 1.0f) + sh; u32x2 w; w.x = cvt_pk_bf16(v[j][0], v[j][1]); w.y = cvt_pk_bf16(v[j][2], v[j][3]); h8[64 * j] = w; }
#pragma unroll
            for (int j = 0; j < 8; ++j) *(LAS f32x4*)(red + 256 * j + 4 * lane) = v[j];
            asm volatile("s_waitcnt lgkmcnt(0)" ::: "memory");
            f32x4 pa = (f32x4){0.f, 0.f, 0.f, 0.f};
            { const int eg = lane & 7, ks = lane >> 3; const f32x4* wk = (const f32x4*)(wr + (size_t)ks * 32 + eg * 4); const LAS float* hk = red + ks;
#pragma unroll 8
              for (int st = 0; st < 256; ++st) { const f32x4 w4 = wk[(size_t)st * 64]; const float hv = hk[st * 8]; pa += w4 * hv; } }
#pragma unroll
            for (int o = 8; o < 64; o <<= 1) { pa[0] += __shfl_xor(pa[0], o); pa[1] += __shfl_xor(pa[1], o); pa[2] += __shfl_xor(pa[2], o); pa[3] += __shfl_xor(pa[3], o); }
            asm volatile("s_waitcnt lgkmcnt(0)" ::: "memory");
            if (lane < 8) *(LAS f32x4*)(red + 2048 + 4 * lane) = pa;
            asm volatile("s_waitcnt lgkmcnt(0)" ::: "memory");
            const float lg = red[2048 + (lane & 31)] + brt[lane & 31];
            asm volatile("s_waitcnt lgkmcnt(0)" ::: "memory");
            float val = lane < 32 ? lg : -3.0e38f; float tv[4]; int ti[4];
#pragma unroll
            for (int r = 0; r < 4; ++r) { float bv = val; int bi = lane;
#pragma unroll
                for (int o = 32; o >= 1; o >>= 1) { const float ov = __shfl_xor(bv, o); const int oi = __shfl_xor(bi, o); if (ov > bv || (ov == bv && oi < bi)) { bv = ov; bi = oi; } }
                tv[r] = bv; ti[r] = bi; if (lane == bi) val = -3.0e38f; }
            const float e1 = __expf(tv[1] - tv[0]), e2 = __expf(tv[2] - tv[0]), e3 = __expf(tv[3] - tv[0]); const float inv = 1.0f / (1.0f + e1 + e2 + e3);
            if (lane < 4) { const int id = lane == 0 ? ti[0] : (lane == 1 ? ti[1] : (lane == 2 ? ti[2] : ti[3])); const float wv = (lane == 0 ? 1.0f : (lane == 1 ? e1 : (lane == 2 ? e2 : e3))) * inv;
                TOPI[mrow * 4 + lane] = id; TOPW[mrow * 4 + lane] = wv; atomicAdd(counts + id, 1u); }
        }
    }
    SEAM(PH_ROUTER);
    if (IN(PH_DISPATCH)) {
        PTRS
        unsigned* counts = ctl + CW_COUNTS; unsigned* cursor = ctl + CW_CURSOR;
        int pst = 0, pend = 0;
        { const int cnt = lane < 32 ? (int)__hip_atomic_load(counts + lane, __ATOMIC_RELAXED, __HIP_MEMORY_SCOPE_AGENT) : 0; const int pad = (cnt + 255) & ~255; int inc = pad;
#pragma unroll
          for (int o = 1; o < 32; o <<= 1) { const int t = __shfl_up(inc, o); if ((lane & 31) >= o) inc += t; }
          pend = inc; pst = inc - pad; }
        if (gw == 0) {
            const int ntiles = __shfl(pend, 31) >> 8; if (lane == 0) TILE[0] = ntiles;
            for (int t = lane; t < PMAX / 256; t += 64) { int e = 0;
                for (int q = 0; q < 32; ++q) { const int pe = __shfl(pend, q); e += (pe <= t * 256) ? 1 : 0; }
                TILE[16 + t] = e < 31 ? e : 31; }
        }
        for (int mrow = gw; mrow < T; mrow += NGW) {
            int slot = 0;
            const int e = lane < 4 ? TOPI[mrow * 4 + lane] : 0;
            const int ps = __shfl(pst, e);
            if (lane < 4) { slot = ps + (int)atomicAdd(cursor + e, 1u); DEST[mrow * 4 + lane] = slot; }
            const u32x4* src = (const u32x4*)(H2 + (size_t)mrow * D) + lane; u32x4 rw[4];
#pragma unroll
            for (int q = 0; q < 4; ++q) rw[q] = src[64 * q];
#pragma unroll
            for (int k = 0; k < 4; ++k) { const int sl = __shfl(slot, k); u32x4* dst = (u32x4*)(XS + (size_t)sl * D) + lane;
#pragma unroll
                for (int q = 0; q < 4; ++q) dst[64 * q] = rw[q]; }
        }
    }
    SEAM(PH_DISPATCH);
    if (IN(PH_GU)) {
        PTRS
        const int ntiles = __builtin_amdgcn_readfirstlane(TILE[0]);
        pg8::MoeSched S{(const char*)XS, (const char*)WT_GU, TILE + 16, (size_t)4096 * 2048 * 2, ntiles, 16, G, bx};
        EpiGU E{ACT, INP(I_BGU)}; pg8::gemm_phase(lds, 2048, 2048, 2048, S, E);
    }
    SEAM(PH_GU);
    if (IN(PH_DOWN)) {
        PTRS
        const int ntiles = __builtin_amdgcn_readfirstlane(TILE[0]);
        pg8::MoeSched S{(const char*)ACT, (const char*)WT_DOWN, TILE + 16, (size_t)2048 * 2048 * 2, ntiles, 8, G, bx};
        EpiDown E{YS, INP(I_BDOWN)}; pg8::gemm_phase(lds, 2048, 2048, 2048, S, E);
    }
    SEAM(PH_DOWN);
    if (IN(PH_COMBINE)) {
        PTRS
        const float* gpo = INP(I_GPOSTF);
        for (int mrow = gw; mrow < T; mrow += NGW) {
            const int b = mrow / SEQ; const float* ad = ada + b * 12288;
            int dk[4]; float wk[4];
#pragma unroll
            for (int k = 0; k < 4; ++k) { dk[k] = DEST[mrow * 4 + k]; wk[k] = TOPW[mrow * 4 + k]; }
            f32x4 f[8]; float s = 0.f;
#pragma unroll
            for (int j = 0; j < 8; ++j) f[j] = (f32x4){0.f, 0.f, 0.f, 0.f};
#pragma unroll
            for (int k = 0; k < 4; ++k) { const u32x2* yr = (const u32x2*)(YS + (size_t)dk[k] * D) + lane;
#pragma unroll
                for (int j = 0; j < 8; ++j) { const u32x2 w = yr[64 * j]; f[j] += (f32x4){bf_lo(w.x), bf_hi(w.x), bf_lo(w.y), bf_hi(w.y)} * wk[k]; } }
#pragma unroll
            for (int j = 0; j < 8; ++j) s += (f[j][0] * f[j][0] + f[j][1] * f[j][1]) + (f[j][2] * f[j][2] + f[j][3] * f[j][3]);
            const float r = rsqrtf(wave_sum(s) * (1.0f / D) + RMS_EPS);
            f32x4* o4 = (f32x4*)(outp + (size_t)mrow * D) + lane;
#pragma unroll
            for (int j = 0; j < 8; ++j) { const int col = 256 * j + 4 * lane; const f32x4 gg = *(const f32x4*)(gpo + col), gf = *(const f32x4*)(ad + 10240 + col);
                o4[64 * j] = o4[64 * j] + gf * (f[j] * r * gg); }
        }
    }
#undef IN
#undef SEAM
}

extern "C" void kernel_launch(void* const* d_in, const int* in_sizes, int n_in, void* d_out, int out_size, void* d_ws, size_t ws_size, hipStream_t stream) {
    static int grid = 0;
    if (grid == 0) {
        if (n_in != 26 || out_size != T * D || ws_size < WS_END) { fprintf(stderr, "kernel_launch: unexpected shapes: n_in %d out %d ws %zu (need %zu)\n", n_in, out_size, ws_size, (size_t)WS_END); grid = -1; return; }
        int dev = 0, cus = 0, per_cu = 0;
        if (hipGetDevice(&dev) != hipSuccess || hipDeviceGetAttribute(&cus, hipDeviceAttributeMultiprocessorCount, dev) != hipSuccess) { grid = -1; return; }
        if (hipFuncSetAttribute((const void*)fwd_kernel, hipFuncAttributeMaxDynamicSharedMemorySize, LDS_BYTES) != hipSuccess) { fprintf(stderr, "kernel_launch: hipFuncSetAttribute failed\n"); grid = -1; return; }
        if (hipOccupancyMaxActiveBlocksPerMultiprocessor(&per_cu, (const void*)fwd_kernel, 512, LDS_BYTES) != hipSuccess || per_cu < 1) fprintf(stderr, "kernel_launch: occupancy query says %d\n", per_cu);
        (void)hipGetLastError();
        grid = cus;
    }
    if (grid < 0) return;
    (void)hipMemsetAsync((char*)d_ws + WS_CTL, 0, CTL_BYTES, stream);
    Args a{};
    for (int i = 0; i < 26; ++i) a.in[i] = (const float*)d_in[i];
    a.out = (float*)d_out; a.ws = (unsigned char*)d_ws;
    if (MK_N_LAUNCHES == 1) { a.ph_lo = 0; a.ph_hi = NPH; hipLaunchKernelGGL(fwd_kernel, dim3(grid), dim3(512), LDS_BYTES, stream, a); }
    else for (int p = 0; p < NPH; ++p) { a.ph_lo = p; a.ph_hi = p + 1; hipLaunchKernelGGL(fwd_kernel, dim3(grid), dim3(512), LDS_BYTES, stream, a); }
    const hipError_t le = hipPeekAtLastError();
    if (le != hipSuccess) fprintf(stderr, "kernel_launch: launch failed: %s\n", hipGetErrorName(le));
}
```

```cpp
#include <hip/hip_runtime.h>
#include <cstdio>
#include <cstdint>

#ifndef MK_N_LAUNCHES
#define MK_N_LAUNCHES 1
#endif

#define LAS __attribute__((address_space(3)))
typedef unsigned short bf16_t;
typedef short bf16x8 __attribute__((ext_vector_type(8)));
typedef short s16x4 __attribute__((ext_vector_type(4)));
typedef float f32x4 __attribute__((ext_vector_type(4)));
typedef float f32x2 __attribute__((ext_vector_type(2)));
typedef float f32x16 __attribute__((ext_vector_type(16)));
typedef unsigned u32x4 __attribute__((ext_vector_type(4)));
typedef unsigned u32x2 __attribute__((ext_vector_type(2)));

constexpr int NB = 4, SEQ = 4096, T = NB * SEQ, D = 2048;
constexpr int CH = 256, NCH = SEQ / CH, NBLK = NB * 8 * NCH;
constexpr int N_IN_NAT = 11520;
constexpr int N_IN_ALL = N_IN_NAT + 2048;
constexpr int NE = 32, PMAX = 73728;
constexpr float RMS_EPS = 1e-6f, GN_EPS = 1e-6f;
constexpr float QSCALE = 0.07216878364870322f;

constexpr size_t MiB = 1u << 20;
constexpr size_t WS_CTL = 0, CTL_BYTES = 1 * MiB;
constexpr size_t WS_WT_IN = 1 * MiB;
constexpr size_t WS_WT_QB = WS_WT_IN + 54 * MiB;
constexpr size_t WS_WT_KVB = WS_WT_QB + 2 * MiB;
constexpr size_t WS_WT_MLAO = WS_WT_KVB + 2 * MiB;
constexpr size_t WS_WT_RETO = WS_WT_MLAO + 4 * MiB;
constexpr size_t WS_WT_OUT = WS_WT_RETO + 8 * MiB;
constexpr size_t WS_WT_GU = WS_WT_OUT + 8 * MiB;
constexpr size_t WS_WT_DOWN = WS_WT_GU + 512 * MiB;
constexpr size_t WS_CS_RET = WS_WT_DOWN + 256 * MiB;
constexpr size_t WS_CS_MLA = WS_CS_RET + 16 * MiB;
constexpr size_t WS_H = WS_CS_MLA + 4 * MiB;
constexpr size_t WS_QL = WS_H + 64 * MiB;
constexpr size_t WS_CKV = WS_QL + 16 * MiB;
constexpr size_t WS_KR = WS_CKV + 16 * MiB;
constexpr size_t WS_ACAT = WS_KR + 2 * MiB;
constexpr size_t WS_BCAT = WS_ACAT + 192 * MiB;
constexpr size_t WS_KROT = WS_BCAT + 192 * MiB;
constexpr size_t WS_KZTF = WS_KROT + 64 * MiB;
constexpr size_t WS_KZTB = WS_KZTF + 64 * MiB;
constexpr size_t WS_SG = WS_KZTB + 64 * MiB;
constexpr size_t WS_GA = WS_SG + 64 * MiB;
constexpr size_t WS_GB = WS_GA + 64 * MiB;
constexpr size_t WS_QN = WS_GB + 64 * MiB;
constexpr size_t WS_QR = WS_QN + 32 * MiB;
constexpr size_t WS_KN = WS_QR + 16 * MiB;
constexpr size_t WS_VV = WS_KN + 32 * MiB;
constexpr size_t WS_OA = WS_VV + 32 * MiB;
constexpr size_t WS_ORET = WS_OA + 32 * MiB;
constexpr size_t WS_OB = WS_ORET + 128 * MiB;
constexpr size_t WS_MIXP = WS_OB + 64 * MiB;
constexpr size_t WS_MIXIN = WS_MIXP + 64 * MiB;
constexpr size_t WS_MIX = WS_MIXIN + 64 * MiB;
constexpr size_t WS_H2 = WS_MIX + 128 * MiB;
constexpr size_t WS_TOPI = WS_H2 + 64 * MiB;
constexpr size_t WS_TOPW = WS_TOPI + 1 * MiB;
constexpr size_t WS_DEST = WS_TOPW + 1 * MiB;
constexpr size_t WS_TILE = WS_DEST + 1 * MiB;
constexpr size_t WS_YS_END = WS_TILE + 1 * MiB + 3 * 288 * MiB;
constexpr size_t WS_DECTAB = WS_TILE + 65536;
constexpr size_t WS_SSQP = WS_YS_END;
constexpr size_t WS_XS = WS_TILE + 1 * MiB;
constexpr size_t WS_ACT = WS_XS + 288 * MiB;
constexpr size_t WS_YS = WS_ACT + 288 * MiB;
constexpr size_t WS_END = WS_YS + 288 * MiB + 1 * MiB;
constexpr int CW_BAR = 4096;
constexpr int CW_QUEUE = 8192, CW_COUNTS = 8256, CW_CURSOR = 8320;
constexpr int CW_ADA = 16384;
constexpr int CW_SSQQ = 65536, CW_SSQKV = 81920;
static_assert((CW_SSQKV + T) * 4 <= (int)CTL_BYTES, "ctl");

constexpr int RING_BYTES = 131072, CTRL_OFF = 139264, MISC_OFF = CTRL_OFF, LARG_OFF = CTRL_OFF + 1024, LDS_BYTES = 147456;

__device__ __forceinline__ unsigned cvt_pk_bf16(float lo, float hi) { unsigned r; asm volatile("v_cvt_pk_bf16_f32 %0, %1, %2" : "=v"(r) : "v"(lo), "v"(hi)); return r; }
__device__ __forceinline__ u32x4 pack8(f32x4 a, f32x4 b) { u32x4 w; w.x = cvt_pk_bf16(a[0], a[1]); w.y = cvt_pk_bf16(a[2], a[3]); w.z = cvt_pk_bf16(b[0], b[1]); w.w = cvt_pk_bf16(b[2], b[3]); return w; }
__device__ __forceinline__ float bf_lo(unsigned w) { return __uint_as_float(w << 16); }
__device__ __forceinline__ float bf_hi(unsigned w) { return __uint_as_float(w & 0xffff0000u); }
__device__ __forceinline__ void unpack8(u32x4 w, f32x4& a, f32x4& b) { a = (f32x4){bf_lo(w.x), bf_hi(w.x), bf_lo(w.y), bf_hi(w.y)}; b = (f32x4){bf_lo(w.z), bf_hi(w.z), bf_lo(w.w), bf_hi(w.w)}; }
__device__ __forceinline__ float wave_sum(float v) {
#pragma unroll
    for (int o = 1; o < 64; o <<= 1) v += __shfl_xor(v, o);
    return v;
}
__device__ __forceinline__ float sigmoidf_(float x) { return __builtin_amdgcn_rcpf(1.0f + __expf(-x)); }
__device__ __forceinline__ float log2_sigmoid(float x) { return -log1pf(expf(-x)) * 1.4426950408889634f; }

#define XB_TMO      128
#define XB_XCNT(j)  (256  + 64 * (j))
#define XB_XSUB(j)  (1280 + 64 * (j))
#define XB_XGEN(j)  (2304 + 64 * (j))
#define XB_TOP      3328
#define XB_TOPGEN   3392
#define XCD_BAR_WORDS 3456
#define XB_SPIN_CAP (1u << 22)
__device__ __forceinline__ unsigned xb_ld(unsigned* p)              { return __hip_atomic_load(p, __ATOMIC_RELAXED, __HIP_MEMORY_SCOPE_AGENT); }
__device__ __forceinline__ unsigned xb_add(unsigned* p, unsigned v) { return __hip_atomic_fetch_add(p, v, __ATOMIC_RELAXED, __HIP_MEMORY_SCOPE_AGENT); }
__device__ __forceinline__ unsigned xb_xcc_id() { return (unsigned)__builtin_amdgcn_s_getreg((3 << 11) | 20) & 0xFu; }
#define XB_SPIN(cond, bar) do { unsigned _sp = 0; while (cond) { __builtin_amdgcn_s_sleep(1); \
    if ((++_sp & 255u) == 0u) { if (xb_ld(&(bar)[XB_TMO])) break; if (_sp > XB_SPIN_CAP) { atomicAdd(&(bar)[XB_TMO], 1u); break; } } } } while (0)
struct XcdBarrier { unsigned* bar; unsigned x; volatile LAS unsigned* st; };
__device__ __forceinline__ XcdBarrier xcd_barrier_post(unsigned* bar, volatile LAS unsigned* st) {
    XcdBarrier b; b.bar = bar; b.x = xb_xcc_id(); b.st = st;
    if (threadIdx.x == 0) (void)xb_add(&bar[XB_XCNT(b.x)], 1u);
    return b;
}
__device__ __forceinline__ void xcd_barrier_complete(unsigned* bar, unsigned x, unsigned& nloc, unsigned& nx) {
    const unsigned G = gridDim.x * gridDim.y * gridDim.z;
    unsigned sum, cnt, mine, sp = 0u;
    for (;;) {
        sum = 0u; cnt = 0u; mine = 0u;
#pragma unroll
        for (unsigned j = 0; j < 16; ++j) { const unsigned c = xb_ld(&bar[XB_XCNT(j)]); sum += c; cnt += (c > 0u) ? 1u : 0u; mine = (j == x) ? c : mine; }
        if (sum == G) break;
        __builtin_amdgcn_s_sleep(1);
        if ((++sp & 255u) == 0u) { if (xb_ld(&bar[XB_TMO])) break; if (sp > XB_SPIN_CAP) { atomicAdd(&bar[XB_TMO], 1u); break; } }
    }
    nloc = mine > 0u ? mine : 1u; nx = cnt > 0u ? cnt : 1u;
}
__device__ __forceinline__ void xcd_barrier(const XcdBarrier& b) {
    asm volatile("s_waitcnt vmcnt(0)" ::: "memory");
    __syncthreads();
    if (threadIdx.x == 0) {
        unsigned* bar = b.bar;
        __builtin_amdgcn_s_waitcnt(0);
        unsigned nloc = b.st[0], nx = b.st[1];
        if (nloc == 0u) { xcd_barrier_complete(bar, b.x, nloc, nx); b.st[0] = nloc; b.st[1] = nx; }
        const unsigned old = xb_add(&bar[XB_XSUB(b.x)], 1u);
        const unsigned gen = old / nloc;
        if (old + 1u == (gen + 1u) * nloc) {
            __builtin_amdgcn_fence(__ATOMIC_RELEASE, "agent");
            asm volatile("s_waitcnt vmcnt(0)" ::: "memory");
            const unsigned og = xb_add(&bar[XB_TOP], 1u);
            const unsigned tg = og / nx;
            if (og + 1u == (tg + 1u) * nx) xb_add(&bar[XB_TOPGEN], 1u);
            else XB_SPIN(xb_ld(&bar[XB_TOPGEN]) == tg, bar);
            __builtin_amdgcn_fence(__ATOMIC_ACQUIRE, "agent");
            xb_add(&bar[XB_XGEN(b.x)], 1u);
            asm volatile("s_waitcnt vmcnt(0)" ::: "memory");
        } else {
            XB_SPIN(xb_ld(&bar[XB_XGEN(b.x)]) == gen, bar);
            __builtin_amdgcn_fence(__ATOMIC_ACQUIRE, "agent");
            asm volatile("s_waitcnt vmcnt(0)" ::: "memory");
        }
    }
    __syncthreads();
}

namespace pg8 {
constexpr int BM = 256, BK = 64, HALF = 128, HTB = HALF * BK * 2, NXCD = 8, WGM = 8;
__host__ __device__ __forceinline__ int lds_byte(int r, int c) { const int st = (r >> 4) * 2 + (c >> 5), rr = r & 15, cc = c & 31, ob = rr * 64 + cc * 2; return st * 1024 + (ob ^ (((ob >> 9) & 1) << 5)); }
__host__ __device__ __forceinline__ void stage_rc(int b, int& R, int& C) { const int st = b / 1024, sb = b % 1024, swz = sb ^ (((sb >> 9) & 1) << 5); R = (st >> 1) * 16 + swz / 64; C = (st & 1) * 32 + (swz % 64) / 2; }
__host__ __device__ __forceinline__ int perm32(int rho) { const int n = rho >> 4, i = rho & 15; return 8 * (i >> 2) + 4 * n + (i & 3); }
struct Unit { const char* a; const char* b; int pm, pn, keep, aux; };
__device__ __forceinline__ void tile_order(int wgid, int nM, int nN, int& pm, int& pn) {
    const int nwg = nM * nN; { const int q = nwg / NXCD, r = nwg % NXCD, xcd = wgid % NXCD, off = wgid / NXCD; wgid = (xcd < r ? xcd * (q + 1) : r * (q + 1) + (xcd - r) * q) + off; }
    const int nig = WGM * nN, gid = wgid / nig, fm = gid * WGM, gsz = (nM - fm) < WGM ? (nM - fm) : WGM;
    pm = fm + ((wgid % nig) % gsz); pn = (wgid % nig) / gsz;
}
template <class Epi, class Sched>
__device__ __forceinline__ void gemm_phase(LAS unsigned char* lds, const int K, const int lda, const int ldb, const Sched& S, const Epi& E) {
    const int tid = threadIdx.x, wid = __builtin_amdgcn_readfirstlane(tid >> 6), lane = tid & 63, wr = wid >> 2, wc = wid & 3, fr = lane & 15, fq = lane >> 4;
    const int nt = K / BK;
    unsigned voffA[2], voffB[2];
#pragma unroll
    for (int i = 0; i < 2; ++i) { int R, C; stage_rc(tid * 16 + i * 8192, R, C); const int Rb = (R & ~31) + perm32(R & 31);
        voffA[i] = (unsigned)(R * lda + C) * 2u; voffB[i] = (unsigned)(Rb * ldb + C) * 2u; }
    const size_t kstep = (size_t)(BK * 2);
    const size_t hstepA = (size_t)HALF * lda * 2, hstepB = (size_t)HALF * ldb * 2;
    const unsigned ldsw = (unsigned)wid * 1024u;
    const int aoff = lds_byte(wr * 64 + fr, fq * 8), boff = lds_byte(wc * 32 + fr, fq * 8);
#define PG8_SA(b, h) (((b) * 2 + (h)) * HTB)
#define PG8_SB(b, h) ((4 + (b) * 2 + (h)) * HTB)
#define PG8_STAGE(bufoff, gbase, voff) do { _Pragma("unroll") for (int _i = 0; _i < 2; ++_i) \
        __builtin_amdgcn_global_load_lds((const unsigned*)((const char*)(gbase) + (voff)[_i]), (LAS unsigned*)(lds + (bufoff) + ldsw + _i * 8192), 16, 0, 0); } while (0)
#define PG8_LDA(dst, b, h) do { _Pragma("unroll") for (int m = 0; m < 4; ++m) _Pragma("unroll") for (int k = 0; k < 2; ++k) dst[m][k] = *(const LAS bf16x8*)(lds + PG8_SA(b, h) + aoff + m * 2048 + k * 1024); } while (0)
#define PG8_LDB(dst, b, h) do { _Pragma("unroll") for (int n = 0; n < 2; ++n) _Pragma("unroll") for (int k = 0; k < 2; ++k) dst[n][k] = *(const LAS bf16x8*)(lds + PG8_SB(b, h) + boff + n * 2048 + k * 1024); } while (0)
#define PG8_MMA(ai, bj, At, Bt) do { __builtin_amdgcn_s_setprio(1); _Pragma("unroll") for (int m = 0; m < 4; ++m) _Pragma("unroll") for (int n = 0; n < 2; ++n) _Pragma("unroll") for (int k = 0; k < 2; ++k) \
        acc[ai][bj][m][n] = __builtin_amdgcn_mfma_f32_16x16x32_bf16(Bt[n][k], At[m][k], acc[ai][bj][m][n], 0, 0, 0); __builtin_amdgcn_s_setprio(0); } while (0)
#define PG8_WAIT_V(n) asm volatile("s_waitcnt vmcnt(" #n ")" ::: "memory")
#define PG8_WAIT_L(n) asm volatile("s_waitcnt lgkmcnt(" #n ")" ::: "memory")
#define PG8_BAR __builtin_amdgcn_s_barrier()
#define PG8_SCHED __builtin_amdgcn_sched_barrier(0)
    Unit cur, nxt; int ui = 0;
    if (!S.next(0, cur)) return;
    f32x4 acc[2][2][4][2];
#pragma unroll
    for (int a = 0; a < 2; ++a)
#pragma unroll
        for (int b = 0; b < 2; ++b)
#pragma unroll
            for (int m = 0; m < 4; ++m)
#pragma unroll
                for (int n = 0; n < 2; ++n) acc[a][b][m][n] = (f32x4){0.f, 0.f, 0.f, 0.f};
    bf16x8 At[4][2], B0[2][2], B1[2][2];
    const char* cA = cur.a; const char* cB = cur.b;
    PG8_STAGE(PG8_SB(0, 0), cB, voffB); PG8_STAGE(PG8_SB(0, 1), cB + hstepB, voffB); PG8_STAGE(PG8_SA(0, 0), cA, voffA); PG8_STAGE(PG8_SA(0, 1), cA + hstepA, voffA);
    if (wr == 1) PG8_BAR;
    PG8_WAIT_V(2); PG8_BAR;
    PG8_STAGE(PG8_SB(1, 0), cB + kstep, voffB); PG8_STAGE(PG8_SA(1, 0), cA + kstep, voffA); PG8_STAGE(PG8_SB(1, 1), cB + hstepB + kstep, voffB);
    PG8_WAIT_V(6); PG8_BAR;
    for (;;) {
        const bool has_next = S.next(ui + 1, nxt);
        const char* nA = has_next ? nxt.a : cA; const char* nB = has_next ? nxt.b : cB;
#pragma nounroll
        for (int t = 0; t < nt; t += 2) {
            const bool last = (t == nt - 2);
            const char* a1 = cA + (size_t)(t + 1) * kstep;
            const char* a2 = last ? nA : cA + (size_t)(t + 2) * kstep; const char* b2 = last ? nB : cB + (size_t)(t + 2) * kstep;
            const char* a3 = a2 + kstep; const char* b3 = b2 + kstep;
            PG8_LDB(B0, 0, 0); PG8_LDB(B1, 0, 1); PG8_SCHED; PG8_LDA(At, 0, 0); PG8_STAGE(PG8_SA(1, 1), a1 + hstepA, voffA);
            PG8_WAIT_V(8); PG8_WAIT_L(0); PG8_BAR; PG8_MMA(0, 0, At, B0); PG8_MMA(0, 1, At, B1); PG8_BAR; PG8_SCHED;
            PG8_LDA(At, 0, 1); PG8_STAGE(PG8_SB(0, 0), b2, voffB); PG8_STAGE(PG8_SB(0, 1), b2 + hstepB, voffB); PG8_STAGE(PG8_SA(0, 0), a2, voffA);
            PG8_WAIT_V(8); PG8_WAIT_L(0); PG8_BAR; PG8_MMA(1, 0, At, B0); PG8_MMA(1, 1, At, B1); PG8_BAR; PG8_SCHED;
            PG8_LDB(B0, 1, 0); PG8_LDB(B1, 1, 1); PG8_SCHED; PG8_LDA(At, 1, 0); PG8_STAGE(PG8_SA(0, 1), a2 + hstepA, voffA);
            PG8_WAIT_V(8); PG8_WAIT_L(0); PG8_BAR; PG8_MMA(0, 0, At, B0); PG8_MMA(0, 1, At, B1); PG8_BAR; PG8_SCHED;
            PG8_LDA(At, 1, 1); PG8_STAGE(PG8_SB(1, 0), b3, voffB); PG8_STAGE(PG8_SB(1, 1), b3 + hstepB, voffB); PG8_STAGE(PG8_SA(1, 0), a3, voffA);
            PG8_WAIT_V(8); PG8_WAIT_L(0); PG8_BAR; PG8_MMA(1, 0, At, B0); PG8_MMA(1, 1, At, B1); PG8_BAR; PG8_SCHED;
        }
        if (wr == 0) PG8_BAR;
        E(acc, cur, wr, wc, fr, fq);
        if (!has_next) break;
        if (!cur.keep) {
#pragma unroll
            for (int a = 0; a < 2; ++a)
#pragma unroll
                for (int b = 0; b < 2; ++b)
#pragma unroll
                    for (int m = 0; m < 4; ++m)
#pragma unroll
                        for (int n = 0; n < 2; ++n) acc[a][b][m][n] = (f32x4){0.f, 0.f, 0.f, 0.f};
        }
        cur = nxt; cA = nA; cB = nB; ++ui;
        if (wr == 1) PG8_BAR;
    }
    PG8_WAIT_V(0);
    PG8_BAR;
#undef PG8_SA
#undef PG8_SB
#undef PG8_STAGE
#undef PG8_LDA
#undef PG8_LDB
#undef PG8_MMA
#undef PG8_WAIT_V
#undef PG8_WAIT_L
#undef PG8_BAR
#undef PG8_SCHED
}
struct GridSched {
    const char* A; const char* Bt; size_t astep, bstep; int nM, nN, G, c;
    __device__ __forceinline__ bool next(int i, Unit& u) const {
        const long L = (long)i * G + c; if (L >= (long)nM * nN) return false;
        int pm, pn; tile_order((int)L, nM, nN, pm, pn);
        u.a = A + (size_t)pm * astep; u.b = Bt + (size_t)pn * bstep; u.pm = pm; u.pn = pn; u.keep = 0; u.aux = 0; return true;
    }
};
struct BatchSched {
    const char* A; const char* Bt; size_t astep, bstep; int n, G, c;
    __device__ __forceinline__ bool next(int i, Unit& u) const {
        const int L = i * G + c; if (L >= n) return false;
        u.a = A + (size_t)L * astep; u.b = Bt + (size_t)L * bstep; u.pm = L; u.pn = 0; u.keep = 0; u.aux = 0; return true;
    }
};
struct ChainSched {
    const char* A; const char* Bt; int bh, dir;
    __device__ __forceinline__ bool next(int i, Unit& u) const {
        if (i >= NCH) return false;
        const int n = dir ? (NCH - 1 - i) : i, blk = bh * NCH + n;
        u.a = A + (size_t)blk * (256 * 768 * 2); u.b = Bt + (size_t)blk * (256 * 256 * 2); u.pm = blk; u.pn = i; u.keep = 1; u.aux = n; return true;
    }
};
struct MoeSched {
    const char* A; const char* Bt; const int* tile_e; size_t estride; int ntiles, nN, G, c;
    __device__ __forceinline__ bool next(int i, Unit& u) const {
        const long L = (long)i * G + c; if (L >= (long)ntiles * nN) return false;
        int pm, pn; tile_order((int)L, ntiles, nN, pm, pn);
        const int e = __builtin_amdgcn_readfirstlane(tile_e[pm]);
        u.a = A + (size_t)pm * (256 * 2048 * 2); u.b = Bt + (size_t)e * estride + (size_t)pn * (256 * 2048 * 2); u.pm = pm; u.pn = pn; u.keep = 0; u.aux = e; return true;
    }
};
}
using pg8::Unit;

#define EPI_LOOP _Pragma("unroll") for (int ai = 0; ai < 2; ++ai) _Pragma("unroll") for (int m = 0; m < 4; ++m)
#define EPI_ROW (ai * 128 + wr * 64 + m * 16 + fr)
#define EPI_FENCE asm volatile("" ::: "memory")
typedef f32x4 Acc[2][2][4][2];

__device__ __forceinline__ void rot4(const f32x4 x1, const f32x4 x2, const f32x4 csA, const f32x4 csB, f32x4& o1, f32x4& o2) {
    o1[0] = x1[0] * csA[0] - x2[0] * csA[1]; o2[0] = x1[0] * csA[1] + x2[0] * csA[0];
    o1[1] = x1[1] * csA[2] - x2[1] * csA[3]; o2[1] = x1[1] * csA[3] + x2[1] * csA[2];
    o1[2] = x1[2] * csB[0] - x2[2] * csB[1]; o2[2] = x1[2] * csB[1] + x2[2] * csB[0];
    o1[3] = x1[3] * csB[2] - x2[3] * csB[3]; o2[3] = x1[3] * csB[3] + x2[3] * csB[2];
}
__device__ __forceinline__ f32x4 rot_il(const f32x4 v, const f32x4 cs) {
    return (f32x4){v[0] * cs[0] - v[1] * cs[1], v[0] * cs[1] + v[1] * cs[0], v[2] * cs[2] - v[3] * cs[3], v[2] * cs[3] + v[3] * cs[2]};
}

struct EpiInproj {
    bf16_t *QL, *CKV, *KR, *ACAT, *KROT, *SG, *GA, *GB; float *ssqp; const float* cs_ret; const float* cs_mla; const float* dectab;
    __device__ __forceinline__ void operator()(Acc& acc, const Unit& u, int wr, int wc, int fr, int fq) const {
        asm volatile("" : "+v"(fr), "+v"(fq));
        const int pn = u.pn, tok0 = u.pm * 256, cb = wc * 32 + fq * 8;
        if (pn < 4) {
            bf16_t* dst = QL + (size_t)(pn >> 1) * ((WS_CKV - WS_QL) / 2); float* ssq = ssqp + (size_t)(pn * 4 + wc) * T; const int c0 = (pn & 1) * 256 + cb;
            EPI_LOOP { const int row = tok0 + EPI_ROW; float s = 0.f;
#pragma unroll
                for (int bj = 0; bj < 2; ++bj) { const f32x4 v0 = acc[ai][bj][m][0], v1 = acc[ai][bj][m][1];
                    s += (v0[0] * v0[0] + v0[1] * v0[1]) + (v0[2] * v0[2] + v0[3] * v0[3]) + (v1[0] * v1[0] + v1[1] * v1[1]) + (v1[2] * v1[2] + v1[3] * v1[3]);
                    *(u32x4*)(dst + (size_t)row * 512 + c0 + bj * 128) = pack8(v0, v1); }
                s += __shfl_xor(s, 16); s += __shfl_xor(s, 32);
                if (fq == 0) ssq[row] = s; EPI_FENCE; }
        } else if (pn == 4) {
            if (wc < 2) {
                EPI_LOOP { const int row = tok0 + EPI_ROW; const float* cs = cs_mla + (size_t)row * 64 + cb;
                    const f32x4 csA = *(const f32x4*)cs, csB = *(const f32x4*)(cs + 4);
                    *(u32x4*)(KR + (size_t)row * 64 + cb) = pack8(rot_il(acc[ai][0][m][0], csA), rot_il(acc[ai][0][m][1], csB)); EPI_FENCE; }
            }
        } else if (pn < 21) {
            const bool isq = pn < 13; const int h = isq ? pn - 5 : pn - 13;
            const int blk = ((u.pm >> 4) * 8 + h) * NCH + (u.pm & 15);
            const float lf = dectab[h], lb = dectab[8 + h];
            EPI_LOOP { const int c = EPI_ROW, row = tok0 + c; const float* cs = cs_ret + (size_t)row * 256 + cb * 2;
                f32x4 q1[2], q2[2];
#pragma unroll
                for (int n = 0; n < 2; ++n) { const f32x4 csA = *(const f32x4*)(cs + n * 8), csB = *(const f32x4*)(cs + n * 8 + 4); rot4(acc[ai][0][m][n], acc[ai][1][m][n], csA, csB, q1[n], q2[n]); }
                if (isq) {
                    const float xf = __builtin_amdgcn_exp2f((float)(c + 1) * lf), xb = __builtin_amdgcn_exp2f((float)(CH - c) * lb);
                    bf16_t* base = ACAT + ((size_t)blk * 256 + c) * 768 + cb;
                    *(u32x4*)(base + 256) = pack8(q1[0] * xf, q1[1] * xf); *(u32x4*)(base + 384) = pack8(q2[0] * xf, q2[1] * xf);
                    *(u32x4*)(base + 512) = pack8(q1[0] * xb, q1[1] * xb); *(u32x4*)(base + 640) = pack8(q2[0] * xb, q2[1] * xb);
                } else {
                    bf16_t* base = KROT + ((size_t)blk * 256 + c) * 256 + cb;
                    *(u32x4*)(base) = pack8(q1[0] * 0.0625f, q1[1] * 0.0625f); *(u32x4*)(base + 128) = pack8(q2[0] * 0.0625f, q2[1] * 0.0625f);
                }
                EPI_FENCE; }
        } else {
            const int g = (pn - 21) >> 3, ct = (pn - 21) & 7; bf16_t* dst = SG + (size_t)g * ((WS_GA - WS_SG) / 2);
            EPI_LOOP { const int row = tok0 + EPI_ROW;
#pragma unroll
                for (int bj = 0; bj < 2; ++bj) { f32x4 v[2];
#pragma unroll
                    for (int n = 0; n < 2; ++n)
#pragma unroll
                        for (int j = 0; j < 4; ++j) { const float x = acc[ai][bj][m][n][j]; const float sg = sigmoidf_(x); v[n][j] = g == 0 ? x * sg : sg; }
                    *(u32x4*)(dst + (size_t)row * 2048 + ct * 256 + bj * 128 + cb) = pack8(v[0], v[1]); }
                EPI_FENCE; }
        }
    }
};
struct EpiVT {
    bf16_t* BCAT;
    __device__ __forceinline__ void operator()(Acc& acc, const Unit& u, int wr, int wc, int fr, int fq) const {
        asm volatile("" : "+v"(fr), "+v"(fq));
        const int blk = ((u.pn >> 4) * 8 + u.pm) * NCH + (u.pn & 15), cb = wc * 32 + fq * 8;
        EPI_LOOP { bf16_t* base = BCAT + ((size_t)blk * 256 + EPI_ROW) * 768 + cb;
#pragma unroll
            for (int bj = 0; bj < 2; ++bj) *(u32x4*)(base + bj * 128) = pack8(acc[ai][bj][m][0], acc[ai][bj][m][1]); }
    }
};
struct EpiMlaQ {
    bf16_t *QN, *QR; const float* ssq; const float* cs_mla;
    __device__ __forceinline__ void operator()(Acc& acc, const Unit& u, int wr, int wc, int fr, int fq) const {
        asm volatile("" : "+v"(fr), "+v"(fq));
        const int pn = u.pn, tok0 = u.pm * 256, cb = wc * 32 + fq * 8;
        EPI_LOOP { const int row = tok0 + EPI_ROW; float ss = 0.f;
#pragma unroll
            for (int q = 0; q < 8; ++q) ss += ssq[(size_t)q * T + row];
            const float rs = rsqrtf(ss * (1.0f / 512.0f) + RMS_EPS) * QSCALE;
            if (pn < 4) {
#pragma unroll
                for (int bj = 0; bj < 2; ++bj) *(u32x4*)(QN + (size_t)row * 1024 + (2 * pn + bj) * 128 + cb) = pack8(acc[ai][bj][m][0] * rs, acc[ai][bj][m][1] * rs);
            } else {
                const int c0 = (wc & 1) * 32 + fq * 8; const float* cs = cs_mla + (size_t)row * 64 + c0;
                const f32x4 csA = *(const f32x4*)cs, csB = *(const f32x4*)(cs + 4);
#pragma unroll
                for (int bj = 0; bj < 2; ++bj) { const int head = 4 * (pn - 4) + 2 * bj + (wc >> 1);
                    *(u32x4*)(QR + (size_t)row * 512 + head * 64 + c0) = pack8(rot_il(acc[ai][bj][m][0], csA) * rs, rot_il(acc[ai][bj][m][1], csB) * rs); }
            }
            EPI_FENCE; }
    }
};
struct EpiMlaKV {
    bf16_t *KN, *VV; const float* ssq;
    __device__ __forceinline__ void operator()(Acc& acc, const Unit& u, int wr, int wc, int fr, int fq) const {
        asm volatile("" : "+v"(fr), "+v"(fq));
        const int pn = u.pn, tok0 = u.pm * 256, cb = wc * 32 + fq * 8; bf16_t* dst = KN + (size_t)(pn >> 2) * ((WS_VV - WS_KN) / 2); const int hb = 2 * (pn & 3);
        EPI_LOOP { const int row = tok0 + EPI_ROW; float ss = 0.f;
#pragma unroll
            for (int q = 0; q < 8; ++q) ss += ssq[(size_t)q * T + row];
            const float rs = rsqrtf(ss * (1.0f / 512.0f) + RMS_EPS);
#pragma unroll
            for (int bj = 0; bj < 2; ++bj) *(u32x4*)(dst + (size_t)row * 1024 + (hb + bj) * 128 + cb) = pack8(acc[ai][bj][m][0] * rs, acc[ai][bj][m][1] * rs); }
    }
};
struct EpiGa {
    bf16_t* ACAT; const float* dectab;
    __device__ __forceinline__ void operator()(Acc& acc, const Unit& u, int wr, int wc, int fr, int fq) const {
        asm volatile("" : "+v"(fr), "+v"(fq));
        const int blk = u.pm, h = (blk >> 4) & 7, cb = wc * 32 + fq * 8;
        const float lf = dectab[h], lb = dectab[8 + h];
        f32x4 colA[2][2], colB[2][2];
#pragma unroll
        for (int bj = 0; bj < 2; ++bj)
#pragma unroll
            for (int n = 0; n < 2; ++n)
#pragma unroll
                for (int j = 0; j < 4; ++j) { const int mm = bj * 128 + cb + n * 4 + j; colA[bj][n][j] = __builtin_amdgcn_exp2f(-(float)(mm + 1) * lf); colB[bj][n][j] = __builtin_amdgcn_exp2f((float)mm * lb); }
        EPI_LOOP { const int c = EPI_ROW; bf16_t* base = ACAT + ((size_t)blk * 256 + c) * 768 + cb;
            const float rowB = __builtin_amdgcn_exp2f(-(float)c * lb - (float)(c + 1) * lf);
#pragma unroll
            for (int bj = 0; bj < 2; ++bj) { f32x4 v[2];
#pragma unroll
                for (int n = 0; n < 2; ++n)
#pragma unroll
                    for (int j = 0; j < 4; ++j) { const int mm = bj * 128 + cb + n * 4 + j;
                        v[n][j] = acc[ai][bj][m][n][j] * ((c >= mm) ? colA[bj][n][j] : colB[bj][n][j] * rowB); }
                *(u32x4*)(base + bj * 128) = pack8(v[0], v[1]); }
            EPI_FENCE; }
    }
};
struct EpiGb {
    bf16_t* BCAT; const float* dectab; int dir;
    __device__ __forceinline__ void operator()(Acc& acc, const Unit& u, int wr, int wc, int fr, int fq) const {
        asm volatile("" : "+v"(fr), "+v"(fq));
        const int h = (u.pm >> 4) & 7, cb = wc * 32 + fq * 8;
        const float gC = __builtin_amdgcn_exp2f((float)CH * dectab[8 * dir + h]);
        const bool st = u.pn < NCH - 1; const int nblk = dir ? u.pm - 1 : u.pm + 1;
        EPI_LOOP { bf16_t* base = BCAT + ((size_t)nblk * 256 + EPI_ROW) * 768 + 256 + 256 * dir + cb;
#pragma unroll
            for (int bj = 0; bj < 2; ++bj) { if (st) *(u32x4*)(base + bj * 128) = pack8(acc[ai][bj][m][0], acc[ai][bj][m][1]);
                acc[ai][bj][m][0] *= gC; acc[ai][bj][m][1] *= gC; } }
    }
};
struct EpiGc {
    float* ORET;
    __device__ __forceinline__ void operator()(Acc& acc, const Unit& u, int wr, int wc, int fr, int fq) const {
        asm volatile("" : "+v"(fr), "+v"(fq));
        const int blk = u.pm, b = blk >> 7, h = (blk >> 4) & 7, n = blk & 15, cb = wc * 32 + fq * 8;
        EPI_LOOP { float* base = ORET + ((size_t)b * SEQ + n * 256 + EPI_ROW) * 2048 + h * 256 + cb;
#pragma unroll
            for (int bj = 0; bj < 2; ++bj) { *(f32x4*)(base + bj * 128) = acc[ai][bj][m][0]; *(f32x4*)(base + bj * 128 + 4) = acc[ai][bj][m][1]; } }
    }
};
struct EpiMixA {
    bf16_t* MIXP; const bf16_t* GA;
    __device__ __forceinline__ void operator()(Acc& acc, const Unit& u, int wr, int wc, int fr, int fq) const {
        asm volatile("" : "+v"(fr), "+v"(fq));
        const int cb = wc * 32 + fq * 8;
        EPI_LOOP { const size_t off = (size_t)(u.pm * 256 + EPI_ROW) * 2048 + u.pn * 256 + cb;
#pragma unroll
            for (int bj = 0; bj < 2; ++bj) { f32x4 g0, g1; unpack8(*(const u32x4*)(GA + off + bj * 128), g0, g1);
                *(u32x4*)(MIXP + off + bj * 128) = pack8(acc[ai][bj][m][0] * g0, acc[ai][bj][m][1] * g1); }
            EPI_FENCE; }
    }
};
struct EpiMixB {
    bf16_t* MIXIN; const bf16_t* MIXP; const bf16_t* GB;
    __device__ __forceinline__ void operator()(Acc& acc, const Unit& u, int wr, int wc, int fr, int fq) const {
        asm volatile("" : "+v"(fr), "+v"(fq));
        const int cb = wc * 32 + fq * 8;
        EPI_LOOP { const size_t off = (size_t)(u.pm * 256 + EPI_ROW) * 2048 + u.pn * 256 + cb;
#pragma unroll
            for (int bj = 0; bj < 2; ++bj) { f32x4 g0, g1, p0, p1; unpack8(*(const u32x4*)(GB + off + bj * 128), g0, g1); unpack8(*(const u32x4*)(MIXP + off + bj * 128), p0, p1);
                *(u32x4*)(MIXIN + off + bj * 128) = pack8(acc[ai][bj][m][0] * g0 + p0, acc[ai][bj][m][1] * g1 + p1); }
            EPI_FENCE; }
    }
};
struct EpiF32 {
    float* C;
    __device__ __forceinline__ void operator()(Acc& acc, const Unit& u, int wr, int wc, int fr, int fq) const {
        asm volatile("" : "+v"(fr), "+v"(fq));
        const int cb = wc * 32 + fq * 8;
        EPI_LOOP { float* base = C + (size_t)(u.pm * 256 + EPI_ROW) * 2048 + u.pn * 256 + cb;
#pragma unroll
            for (int bj = 0; bj < 2; ++bj) { *(f32x4*)(base + bj * 128) = acc[ai][bj][m][0]; *(f32x4*)(base + bj * 128 + 4) = acc[ai][bj][m][1]; } }
    }
};
struct EpiGU {
    bf16_t* ACT; const float* bgu;
    __device__ __forceinline__ void operator()(Acc& acc, const Unit& u, int wr, int wc, int fr, int fq) const {
        asm volatile("" : "+v"(fr), "+v"(fq));
        const int cb = wc * 32 + fq * 8, col = u.pn * 128 + cb; const float* bg = bgu + (size_t)u.aux * 4096 + col;
        const f32x4 bg0 = *(const f32x4*)bg, bg1 = *(const f32x4*)(bg + 4), bu0 = *(const f32x4*)(bg + 2048), bu1 = *(const f32x4*)(bg + 2052);
        EPI_LOOP { f32x4 v[2];
#pragma unroll
            for (int n = 0; n < 2; ++n)
#pragma unroll
                for (int j = 0; j < 4; ++j) { const float gt = fminf(acc[ai][0][m][n][j] + (n ? bg1[j] : bg0[j]), 7.0f); const float up = fminf(fmaxf(acc[ai][1][m][n][j] + (n ? bu1[j] : bu0[j]), -7.0f), 7.0f);
                    v[n][j] = (up + 1.0f) * gt * sigmoidf_(1.702f * gt); }
            *(u32x4*)(ACT + (size_t)(u.pm * 256 + EPI_ROW) * 2048 + col) = pack8(v[0], v[1]); EPI_FENCE; }
    }
};
struct EpiDown {
    bf16_t* YS; const float* bd;
    __device__ __forceinline__ void operator()(Acc& acc, const Unit& u, int wr, int wc, int fr, int fq) const {
        asm volatile("" : "+v"(fr), "+v"(fq));
        const int cb = wc * 32 + fq * 8; const float* bp = bd + (size_t)u.aux * 2048 + u.pn * 256 + cb;
        f32x4 bv[2][2];
#pragma unroll
        for (int bj = 0; bj < 2; ++bj) { bv[bj][0] = *(const f32x4*)(bp + bj * 128); bv[bj][1] = *(const f32x4*)(bp + bj * 128 + 4); }
        EPI_LOOP { bf16_t* base = YS + (size_t)(u.pm * 256 + EPI_ROW) * 2048 + u.pn * 256 + cb;
#pragma unroll
            for (int bj = 0; bj < 2; ++bj) *(u32x4*)(base + bj * 128) = pack8(acc[ai][bj][m][0] + bv[bj][0], acc[ai][bj][m][1] + bv[bj][1]); }
    }
};

namespace att {
constexpr int NW = 8, QBLK = 32, KVBLK = 64;
constexpr float THR = 8.f;
constexpr int SHM_V = KVBLK * 128 * 2, SHM_K = KVBLK * 192 * 2, SHM_ATTN = 2 * SHM_V + 2 * SHM_K + NW * 64 * 4;
#define KSWZ(row, colB) ((row) * 384 + ((colB) ^ (((row) & 7) << 4)))
#define SBAR() __builtin_amdgcn_sched_barrier(0)
__device__ __forceinline__ int crow(int r, int hi) { return (r & 3) + 8 * (r >> 2) + 4 * hi; }
__device__ __forceinline__ void partialSM(f32x16& p0, f32x16& p1, float& m_reg, float& mn, float& alpha) {
    constexpr float C = 1.4426950408889634f;
    float pmax = p0[0];
#pragma unroll
    for (int r = 1; r < 16; ++r) pmax = fmaxf(pmax, p0[r]);
#pragma unroll
    for (int r = 0; r < 16; ++r) pmax = fmaxf(pmax, p1[r]);
    { auto rr = __builtin_amdgcn_permlane32_swap(__float_as_uint(pmax), __float_as_uint(pmax), false, false);
      pmax = fmaxf(__uint_as_float(rr[0]), __uint_as_float(rr[1])); }
    if (__builtin_expect(__all(pmax - m_reg <= THR), 1)) { mn = m_reg; alpha = 1.f; }
    else { mn = fmaxf(m_reg, pmax); alpha = __builtin_amdgcn_exp2f((m_reg - mn) * C); m_reg = mn; }
    const float mnC = -mn * C;
#pragma unroll
    for (int r = 0; r < 16; ++r) p0[r] = fmaf(p0[r], C, mnC);
#pragma unroll
    for (int r = 0; r < 16; ++r) p1[r] = fmaf(p1[r], C, mnC);
#pragma unroll
    for (int r = 0; r < 16; ++r) p0[r] = __builtin_amdgcn_exp2f(p0[r]);
}
__device__ __forceinline__ void finishSM(f32x16& p0, f32x16& p1, float alpha, float& l_reg, bf16x8& pa0, bf16x8& pa1, bf16x8& pa2, bf16x8& pa3) {
#pragma unroll
    for (int r = 0; r < 16; ++r) p1[r] = __builtin_amdgcn_exp2f(p1[r]);
    float ps = 0;
#pragma unroll
    for (int r = 0; r < 16; ++r) ps += p0[r];
#pragma unroll
    for (int r = 0; r < 16; ++r) ps += p1[r];
    { auto rr = __builtin_amdgcn_permlane32_swap(__float_as_uint(ps), __float_as_uint(ps), false, false);
      ps = __uint_as_float(rr[0]) + __uint_as_float(rr[1]); }
    l_reg = l_reg * alpha + ps;
#define PK4(P, BASE, OUT) do { unsigned a0 = cvt_pk_bf16(P[BASE + 0], P[BASE + 1]), a1 = cvt_pk_bf16(P[BASE + 2], P[BASE + 3]);   \
    unsigned b0 = cvt_pk_bf16(P[BASE + 4], P[BASE + 5]), b1 = cvt_pk_bf16(P[BASE + 6], P[BASE + 7]);                              \
    auto r0 = __builtin_amdgcn_permlane32_swap(a0, b0, false, false); auto r1 = __builtin_amdgcn_permlane32_swap(a1, b1, false, false); \
    u32x4 w = {r0[0], r1[0], r0[1], r1[1]}; OUT = *reinterpret_cast<bf16x8*>(&w); } while (0)
    PK4(p0, 0, pa0); PK4(p0, 8, pa1); PK4(p1, 0, pa2); PK4(p1, 8, pa3);
#undef PK4
}
__device__ __forceinline__ void qkt(f32x16& p0, f32x16& p1, const char* Ks, const bf16x8* qr, int r32, int hi) {
    p0 = f32x16{}; p1 = f32x16{};
#pragma unroll
    for (int d0 = 0; d0 < 12; ++d0) { const int cb = (d0 * 16 + hi * 8) * 2;
        const bf16x8 b0 = *reinterpret_cast<const bf16x8*>(Ks + KSWZ(r32, cb));
        const bf16x8 b1 = *reinterpret_cast<const bf16x8*>(Ks + KSWZ(32 + r32, cb));
        p0 = __builtin_amdgcn_mfma_f32_32x32x16_bf16(b0, qr[d0], p0, 0, 0, 0);
        p1 = __builtin_amdgcn_mfma_f32_32x32x16_bf16(b1, qr[d0], p1, 0, 0, 0); }
}
__device__ __forceinline__ int v_st(int k, int c) { const int kk = (k & ~0xC) | ((k & 4) << 1) | ((k & 8) >> 1); return ((kk >> 3) * 4 + (c >> 5)) * 512 + ((kk & 7) * 32 + (c & 31)) * 2; }
__device__ __forceinline__ int v_rd_base(int lane) { return ((lane & 3) << 3) | (((lane >> 2) & 3) << 6) | (((lane >> 4) & 1) << 5) | (((lane >> 5) & 1) << 8); }
constexpr int v_rd_off(int d0, int ks, int half) { return d0 * 512 + ks * 4096 + half * 2048; }
template <int OFF> __device__ __forceinline__ s16x4 tr_read(int vb) {
    s16x4 r; asm volatile("ds_read_b64_tr_b16 %0, %1 offset:%2" : "=&v"(r) : "v"(vb), "i"(OFF) : "memory"); return r;
}
template <int D0> __device__ __forceinline__ void pv_one(f32x16& od, int vb, bf16x8 pa0, bf16x8 pa1, bf16x8 pa2, bf16x8 pa3) {
    const s16x4 l0 = tr_read<v_rd_off(D0, 0, 0)>(vb), h0 = tr_read<v_rd_off(D0, 0, 1)>(vb), l1 = tr_read<v_rd_off(D0, 1, 0)>(vb), h1 = tr_read<v_rd_off(D0, 1, 1)>(vb);
    const s16x4 l2 = tr_read<v_rd_off(D0, 2, 0)>(vb), h2 = tr_read<v_rd_off(D0, 2, 1)>(vb), l3 = tr_read<v_rd_off(D0, 3, 0)>(vb), h3 = tr_read<v_rd_off(D0, 3, 1)>(vb);
    asm volatile("s_waitcnt lgkmcnt(0)" ::: "memory"); SBAR();
#define PKV(L, H) (bf16x8){L[0], L[1], L[2], L[3], H[0], H[1], H[2], H[3]}
    od = __builtin_amdgcn_mfma_f32_32x32x16_bf16(pa0, PKV(l0, h0), od, 0, 0, 0);
    od = __builtin_amdgcn_mfma_f32_32x32x16_bf16(pa1, PKV(l1, h1), od, 0, 0, 0);
    od = __builtin_amdgcn_mfma_f32_32x32x16_bf16(pa2, PKV(l2, h2), od, 0, 0, 0);
    od = __builtin_amdgcn_mfma_f32_32x32x16_bf16(pa3, PKV(l3, h3), od, 0, 0, 0);
#undef PKV
}
__device__ __forceinline__ void pv_d0(f32x16* o, int vb, bf16x8 pa0, bf16x8 pa1, bf16x8 pa2, bf16x8 pa3) {
    pv_one<0>(o[0], vb, pa0, pa1, pa2, pa3); pv_one<1>(o[1], vb, pa0, pa1, pa2, pa3); pv_one<2>(o[2], vb, pa0, pa1, pa2, pa3); pv_one<3>(o[3], vb, pa0, pa1, pa2, pa3);
}
__device__ __forceinline__ void attn_unit(const bf16_t* __restrict__ Qn, const bf16_t* __restrict__ Qr, const bf16_t* __restrict__ Kn, const bf16_t* __restrict__ Kr,
                                          const bf16_t* __restrict__ Vh, bf16_t* __restrict__ Ob, int seq, char* lds) {
    const int tid = threadIdx.x, wid = tid >> 6, lane = tid & 63, r32 = lane & 31, hi = lane >> 5;
    char* V_lds = lds; char* K_lds = lds + 2 * SHM_V;
    float* ws = (float*)(lds + 2 * SHM_V + 2 * SHM_K) + wid * 64; float* li_l = ws; float* al_l = ws + 32;
    float m_reg = -1e30f, l_reg = 0; f32x16 o[4] = {}; bf16x8 qr[12];
    { const bf16_t* q0 = Qn + (long)(wid * QBLK + r32) * 1024 + hi * 8; const bf16_t* q1 = Qr + (long)(wid * QBLK + r32) * 512 + hi * 8;
#pragma unroll
      for (int d0 = 0; d0 < 8; ++d0) qr[d0] = *reinterpret_cast<const bf16x8*>(q0 + d0 * 16);
#pragma unroll
      for (int d0 = 0; d0 < 4; ++d0) qr[8 + d0] = *reinterpret_cast<const bf16x8*>(q1 + d0 * 16); }
    const int sr = tid >> 4, sc = (tid & 15) * 8, vst0 = v_st(sr, sc), vst1 = v_st(32 + sr, sc);
    const int rr = tid >> 3, rc = (tid & 7) * 8;
    const int vb0 = (int)(uintptr_t)V_lds + v_rd_base(lane);
    bf16x8 vs0, vs1, ks0, ks1, kr0;
#define SLOAD(k0) do { vs0 = *reinterpret_cast<const bf16x8*>(&Vh[(long)((k0) + sr) * 1024 + sc]); vs1 = *reinterpret_cast<const bf16x8*>(&Vh[(long)((k0) + 32 + sr) * 1024 + sc]); \
    ks0 = *reinterpret_cast<const bf16x8*>(&Kn[(long)((k0) + sr) * 1024 + sc]); ks1 = *reinterpret_cast<const bf16x8*>(&Kn[(long)((k0) + 32 + sr) * 1024 + sc]); \
    kr0 = *reinterpret_cast<const bf16x8*>(&Kr[(long)((k0) + rr) * 64 + rc]); } while (0)
#define SWRITE(b) do { *(bf16x8*)(V_lds + (b) * SHM_V + vst0) = vs0; *(bf16x8*)(V_lds + (b) * SHM_V + vst1) = vs1; const int kc = sc * 2;               \
    *(bf16x8*)(K_lds + (b) * SHM_K + KSWZ(sr, kc)) = ks0; *(bf16x8*)(K_lds + (b) * SHM_K + KSWZ(32 + sr, kc)) = ks1;                       \
    *(bf16x8*)(K_lds + (b) * SHM_K + KSWZ(rr, 256 + rc * 2)) = kr0; } while (0)
#define SWAIT() asm volatile("s_waitcnt vmcnt(0)" ::: "memory")
#define RESC(a) do { if (__any((a) < 1.f)) { if (hi == 0) al_l[r32] = (a); asm volatile("s_waitcnt lgkmcnt(0)" ::: "memory"); \
    _Pragma("unroll") for (int d = 0; d < 4; ++d) _Pragma("unroll") for (int r = 0; r < 16; ++r) o[d][r] *= al_l[crow(r, hi)]; } } while (0)
    f32x16 p0, p1; float mn, al; bf16x8 pa0, pa1, pa2, pa3; const int NT = seq / KVBLK;
    SLOAD(0); SWAIT(); SWRITE(0); __syncthreads();
    for (int j = 0; j < NT; ++j) {
        const int buf = j & 1;
        if (j + 1 < NT) SLOAD((j + 1) * KVBLK);
        SBAR(); qkt(p0, p1, K_lds + buf * SHM_K, qr, r32, hi);
        partialSM(p0, p1, m_reg, mn, al);
        RESC(al);
        finishSM(p0, p1, al, l_reg, pa0, pa1, pa2, pa3); SBAR();
        pv_d0(o, vb0 + buf * SHM_V, pa0, pa1, pa2, pa3);
        if (j + 1 < NT) { SWAIT(); SWRITE(buf ^ 1); }
        __syncthreads();
    }
    if (hi == 0) li_l[r32] = l_reg; asm volatile("s_waitcnt lgkmcnt(0)" ::: "memory");
    float rli[16];
#pragma unroll
    for (int r = 0; r < 16; ++r) rli[r] = __builtin_amdgcn_rcpf(li_l[crow(r, hi)]);
    bf16_t* Ow = Ob + (long)(wid * QBLK) * 1024;
#pragma unroll
    for (int r = 0; r < 16; ++r) { const int orow = crow(r, hi);
#pragma unroll
        for (int d0 = 0; d0 < 4; ++d0) Ow[(long)orow * 1024 + d0 * 32 + r32] = (bf16_t)(cvt_pk_bf16(o[d0][r] * rli[r], 0.f) & 0xffffu); }
#undef SLOAD
#undef SWRITE
#undef SWAIT
#undef RESC
}
}

struct Args { const float* in[26]; float* out; unsigned char* ws; int ph_lo, ph_hi; };
enum { PH_SETUP = 0, PH_H, PH_INPROJ, PH_INPROJ_V, PH_MLAQ, PH_MLAKV, PH_GA, PH_KT, PH_CHAIN, PH_ATTN, PH_GC, PH_MIXA, PH_GN, PH_MIXB, PH_MIX, PH_ROUTER, PH_DISPATCH, PH_GU, PH_DOWN, PH_COMBINE, NPH };
enum { I_X = 0, I_C, I_POS, I_WADA, I_BADA, I_GPREM, I_GPOSTM, I_GPREF, I_GPOSTF, I_WIN, I_QAN, I_WQB, I_KVAN, I_WKVB, I_WMLAO, I_DECF, I_DECB, I_RETGN, I_WRETO, I_WOUT, I_WROUTER, I_BROUTER, I_WGU, I_BGU, I_WDOWN, I_BDOWN };

__device__ __forceinline__ int src_in(int r) {
    if (r < 1024) return r;
    if (r < 1088) { const int j = r - 1024; return 1024 + (j >> 1) + 32 * (j & 1); }
    if (r < 1280) return -1;
    if (r < N_IN_NAT) { const int g = (r - 1280) >> 11, off = (r - 1280) & 2047; const int base = g == 0 ? 1088 : (g == 1 ? 3136 : (g == 2 ? 7232 : (g == 3 ? 9280 : 11328))); return base + off; }
    return 5184 + (r - N_IN_NAT);
}
__device__ __forceinline__ int src_qb(int r) { if (r < 1024) return (r >> 7) * 192 + (r & 127); const int j = r - 1024, h = j >> 6, jj = j & 63; return h * 192 + 128 + (jj >> 1) + 32 * (jj & 1); }
__device__ __forceinline__ int src_kvb(int r) { if (r < 1024) return (r >> 7) * 256 + (r & 127); const int j = r - 1024; return (j >> 7) * 256 + 128 + (j & 127); }
__device__ __forceinline__ int src_gu(int r) { const int t = r >> 8, rr = r & 255; return rr < 128 ? 128 * t + rr : 2048 + 128 * t + rr - 128; }

__device__ __forceinline__ void cvt_item(const float* __restrict__ W, int ldw, int K, bf16_t* __restrict__ WT, const float* __restrict__ kscale, int sc, int k0, int r0, LAS float* scr, int lane) {
    float v[64];
    const float* wp = W + (size_t)k0 * ldw + (sc >= 0 ? sc : 0);
#pragma unroll
    for (int i = 0; i < 64; ++i) v[i] = wp[(size_t)i * ldw];
    if (sc < 0) {
#pragma unroll
        for (int i = 0; i < 64; ++i) v[i] = 0.f;
    }
    if (kscale) {
#pragma unroll
        for (int i = 0; i < 64; ++i) v[i] *= kscale[k0 + i];
    }
#pragma unroll
    for (int i = 0; i < 64; ++i) scr[i * 65 + lane] = v[i];
    asm volatile("s_waitcnt lgkmcnt(0)" ::: "memory");
    const int c = lane & 7;
#pragma unroll
    for (int j = 0; j < 8; ++j) { const int n = (lane >> 3) + 8 * j; const LAS float* s = scr + (8 * c) * 65 + n;
        u32x4 o; o.x = cvt_pk_bf16(s[0 * 65], s[1 * 65]); o.y = cvt_pk_bf16(s[2 * 65], s[3 * 65]); o.z = cvt_pk_bf16(s[4 * 65], s[5 * 65]); o.w = cvt_pk_bf16(s[6 * 65], s[7 * 65]);
        *(u32x4*)(WT + (size_t)(r0 + n) * K + k0 + 8 * c) = o; }
    asm volatile("s_waitcnt lgkmcnt(0)" ::: "memory");
}

__device__ __forceinline__ const void* larg(volatile LAS unsigned long long* L, int i) {
    const unsigned long long v = L[i]; const unsigned l0 = __builtin_amdgcn_readfirstlane((unsigned)v), h0 = __builtin_amdgcn_readfirstlane((unsigned)(v >> 32));
    return (const void*)(const __attribute__((address_space(1))) void*)(((unsigned long long)h0 << 32) | l0);
}
__global__ void __launch_bounds__(512, 2) fwd_kernel(Args args) {
    extern __shared__ __attribute__((aligned(16))) unsigned char lds_raw[];
    LAS unsigned char* lds = (LAS unsigned char*)lds_raw;
    volatile LAS unsigned* MISC = (volatile LAS unsigned*)(lds + MISC_OFF);
    const int tid = threadIdx.x;
    const int G = gridDim.x, bx = blockIdx.x, NGW = G * 8;
    volatile LAS unsigned long long* LARG = (volatile LAS unsigned long long*)(lds + LARG_OFF);
    const int lo = args.ph_lo, hi = args.ph_hi;
    for (int u = tid; u < (LDS_BYTES - CTRL_OFF) / 4; u += 512) ((LAS unsigned*)(lds + CTRL_OFF))[u] = 0u;
    __syncthreads();
    if (tid == 0) {
#pragma unroll
        for (int i = 0; i < 26; ++i) LARG[i] = (unsigned long long)args.in[i];
        LARG[26] = (unsigned long long)args.out; LARG[27] = (unsigned long long)args.ws;
    }
    __syncthreads();
    XcdBarrier bar; bar.bar = (unsigned*)(args.ws + WS_CTL) + CW_BAR; bar.x = 0; bar.st = nullptr;
    if (hi - lo > 1) bar = xcd_barrier_post(bar.bar, MISC + 8);
#ifdef PH_ONLY
#define IN(k) ((k) == PH_ONLY && lo <= (k) && (k) < hi)
#else
#define IN(k) (lo <= (k) && (k) < hi)
#endif
#define SEAM(k) do { if (lo <= (k) && (k) + 1 < hi) xcd_barrier(bar); } while (0)
#define INP(i) ((const float*)larg(LARG, (i)))
#define PTRS \
    int tid = threadIdx.x; asm volatile("" : "+v"(tid)); const int lane = tid & 63, wave = __builtin_amdgcn_readfirstlane(tid >> 6), gw = bx * 8 + wave; (void)lane; (void)gw; \
    unsigned char* const ws = (unsigned char*)larg(LARG, 27); unsigned* const ctl = (unsigned*)(ws + WS_CTL); float* const outp = (float*)larg(LARG, 26); \
    float* const ada = (float*)(ctl + CW_ADA); float* const SSQP = (float*)(ws + WS_SSQP); \
    bf16_t* const WT_IN = (bf16_t*)(ws + WS_WT_IN); bf16_t* const WT_QB = (bf16_t*)(ws + WS_WT_QB); bf16_t* const WT_KVB = (bf16_t*)(ws + WS_WT_KVB); bf16_t* const WT_MLAO = (bf16_t*)(ws + WS_WT_MLAO); \
    bf16_t* const WT_RETO = (bf16_t*)(ws + WS_WT_RETO); bf16_t* const WT_OUT = (bf16_t*)(ws + WS_WT_OUT); bf16_t* const WT_GU = (bf16_t*)(ws + WS_WT_GU); bf16_t* const WT_DOWN = (bf16_t*)(ws + WS_WT_DOWN); \
    float* const CS_RET = (float*)(ws + WS_CS_RET); float* const CS_MLA = (float*)(ws + WS_CS_MLA); \
    bf16_t* const Hb = (bf16_t*)(ws + WS_H); bf16_t* const QL = (bf16_t*)(ws + WS_QL); bf16_t* const CKV = (bf16_t*)(ws + WS_CKV); bf16_t* const KR = (bf16_t*)(ws + WS_KR); \
    bf16_t* const ACAT = (bf16_t*)(ws + WS_ACAT); bf16_t* const BCAT = (bf16_t*)(ws + WS_BCAT); bf16_t* const KROT = (bf16_t*)(ws + WS_KROT); bf16_t* const KZTF = (bf16_t*)(ws + WS_KZTF); bf16_t* const KZTB = (bf16_t*)(ws + WS_KZTB); \
    bf16_t* const SG = (bf16_t*)(ws + WS_SG); bf16_t* const GA = (bf16_t*)(ws + WS_GA); bf16_t* const GB = (bf16_t*)(ws + WS_GB); \
    bf16_t* const QN = (bf16_t*)(ws + WS_QN); bf16_t* const QR = (bf16_t*)(ws + WS_QR); bf16_t* const KN = (bf16_t*)(ws + WS_KN); bf16_t* const VV = (bf16_t*)(ws + WS_VV); bf16_t* const OA = (bf16_t*)(ws + WS_OA); \
    float* const ORET = (float*)(ws + WS_ORET); bf16_t* const OB = (bf16_t*)(ws + WS_OB); bf16_t* const MIXP = (bf16_t*)(ws + WS_MIXP); bf16_t* const MIXIN = (bf16_t*)(ws + WS_MIXIN); float* const MIX = (float*)(ws + WS_MIX); \
    bf16_t* const H2 = (bf16_t*)(ws + WS_H2); int* const TOPI = (int*)(ws + WS_TOPI); float* const TOPW = (float*)(ws + WS_TOPW); int* const DEST = (int*)(ws + WS_DEST); int* const TILE = (int*)(ws + WS_TILE); float* const DECTAB = (float*)(ws + WS_DECTAB); \
    bf16_t* const XS = (bf16_t*)(ws + WS_XS); bf16_t* const ACT = (bf16_t*)(ws + WS_ACT); bf16_t* const YS = (bf16_t*)(ws + WS_YS); \
    (void)ctl; (void)outp; (void)ada; (void)SSQP; (void)WT_IN; (void)WT_QB; (void)WT_KVB; (void)WT_MLAO; (void)WT_RETO; (void)WT_OUT; (void)WT_GU; (void)WT_DOWN; (void)CS_RET; (void)CS_MLA; (void)Hb; (void)QL; (void)CKV; (void)KR; \
    (void)ACAT; (void)BCAT; (void)KROT; (void)KZTF; (void)KZTB; (void)SG; (void)GA; (void)GB; (void)QN; (void)QR; (void)KN; (void)VV; (void)OA; (void)ORET; (void)OB; (void)MIXP; (void)MIXIN; (void)MIX; (void)H2; (void)TOPI; (void)TOPW; (void)DEST; (void)TILE; (void)DECTAB; (void)XS; (void)ACT; (void)YS;

    if (IN(PH_SETUP)) {
        PTRS
        if (bx == 0 && tid < 16) DECTAB[tid] = log2_sigmoid(tid < 8 ? INP(I_DECF)[tid] : INP(I_DECB)[tid - 8]);
        {
            const float* wada = INP(I_WADA); const float* cvec = INP(I_C); const float* bada = INP(I_BADA);
            for (int it = gw; it < 192; it += NGW) {
                const int j = it * 64 + lane;
                float a0 = 0.f, a1 = 0.f, a2 = 0.f, a3 = 0.f;
#pragma nounroll
                for (int k0 = 0; k0 < 2048; k0 += 64) {
                    float w[64];
#pragma unroll
                    for (int i = 0; i < 64; ++i) w[i] = wada[(size_t)(k0 + i) * 12288 + j];
#pragma unroll
                    for (int i = 0; i < 64; ++i) { a0 += w[i] * cvec[k0 + i]; a1 += w[i] * cvec[2048 + k0 + i]; a2 += w[i] * cvec[4096 + k0 + i]; a3 += w[i] * cvec[6144 + k0 + i]; }
                }
                const float bb = bada[j];
                ada[j] = a0 + bb; ada[12288 + j] = a1 + bb; ada[24576 + j] = a2 + bb; ada[36864 + j] = a3 + bb;
            }
        }
        {
            const int* pos = (const int*)INP(I_POS);
            for (int i = bx * 512 + tid; i < T * 160; i += G * 512) {
                const int tok = i / 160, f = i % 160; const float p = (float)pos[tok];
                float inv; float* dst;
                if (f < 128) { inv = 1.0f / powf(10000.0f, (float)f / 128.0f); dst = CS_RET + (size_t)tok * 256 + f * 2; }
                else { inv = 1.0f / powf(10000.0f, (float)(f - 128) / 32.0f); dst = CS_MLA + (size_t)tok * 64 + (f - 128) * 2; }
                float s, c; sincosf(p * inv, &s, &c); dst[0] = c; dst[1] = s;
            }
        }
        {
            LAS float* scr = (LAS float*)(lds + wave * 16640);
            constexpr int I_IN = (N_IN_ALL / 64) * 32, I_QB = 24 * 8, I_KVB = 32 * 8, I_MLAO = 32 * 16, I_SQ = 32 * 32, I_GU = 32 * 64 * 32, I_DN = 32 * 32 * 32;
            constexpr int NITEMS = I_IN + I_QB + I_KVB + I_MLAO + 2 * I_SQ + I_GU + I_DN;
            for (int it = gw; it < NITEMS; it += NGW) {
                int r = it;
                if (r < I_IN) { const int nb = r / 32, kb = r % 32; cvt_item(INP(I_WIN), 13376, 2048, WT_IN, nullptr, src_in(nb * 64 + lane), kb * 64, nb * 64, scr, lane); continue; } r -= I_IN;
                if (r < I_QB) { const int nb = r / 8, kb = r % 8; cvt_item(INP(I_WQB), 1536, 512, WT_QB, INP(I_QAN), src_qb(nb * 64 + lane), kb * 64, nb * 64, scr, lane); continue; } r -= I_QB;
                if (r < I_KVB) { const int nb = r / 8, kb = r % 8; cvt_item(INP(I_WKVB), 2048, 512, WT_KVB, INP(I_KVAN), src_kvb(nb * 64 + lane), kb * 64, nb * 64, scr, lane); continue; } r -= I_KVB;
                if (r < I_MLAO) { const int nb = r / 16, kb = r % 16; cvt_item(INP(I_WMLAO), 2048, 1024, WT_MLAO, nullptr, nb * 64 + lane, kb * 64, nb * 64, scr, lane); continue; } r -= I_MLAO;
                if (r < I_SQ) { const int nb = r / 32, kb = r % 32; cvt_item(INP(I_WRETO), 2048, 2048, WT_RETO, nullptr, nb * 64 + lane, kb * 64, nb * 64, scr, lane); continue; } r -= I_SQ;
                if (r < I_SQ) { const int nb = r / 32, kb = r % 32; cvt_item(INP(I_WOUT), 2048, 2048, WT_OUT, nullptr, nb * 64 + lane, kb * 64, nb * 64, scr, lane); continue; } r -= I_SQ;
                if (r < I_GU) { const int e = r / 2048, q = r % 2048, nb = q / 32, kb = q % 32;
                    cvt_item(INP(I_WGU) + (size_t)e * 2048 * 4096, 4096, 2048, WT_GU + (size_t)e * 4096 * 2048, nullptr, src_gu(nb * 64 + lane), kb * 64, nb * 64, scr, lane); continue; } r -= I_GU;
                { const int e = r / 1024, q = r % 1024, nb = q / 32, kb = q % 32;
                    cvt_item(INP(I_WDOWN) + (size_t)e * 2048 * 2048, 2048, 2048, WT_DOWN + (size_t)e * 2048 * 2048, nullptr, nb * 64 + lane, kb * 64, nb * 64, scr, lane); }
            }
        }
    }
    SEAM(PH_SETUP);
    if (IN(PH_H)) {
        PTRS
        const float* g = INP(I_GPREM);
        for (int mrow = gw; mrow < T; mrow += NGW) {
            const int b = mrow / SEQ; const f32x4* xr = (const f32x4*)(INP(I_X) + (size_t)mrow * D) + lane;
            f32x4 v[8]; float s = 0.f;
#pragma unroll
            for (int j = 0; j < 8; ++j) { v[j] = xr[64 * j]; s += (v[j][0] * v[j][0] + v[j][1] * v[j][1]) + (v[j][2] * v[j][2] + v[j][3] * v[j][3]); }
            const float r = rsqrtf(wave_sum(s) * (1.0f / D) + RMS_EPS);
            u32x2* o8 = (u32x2*)(Hb + (size_t)mrow * D) + lane;
#pragma unroll
            for (int j = 0; j < 8; ++j) { const int col = 256 * j + 4 * lane; const f32x4 gg = *(const f32x4*)(g + col), sh = *(const f32x4*)(ada + b * 12288 + col), sc = *(const f32x4*)(ada + b * 12288 + 2048 + col);
                const f32x4 y = v[j] * r * gg * (sc + 1.0f) + sh; u32x2 w; w.x = cvt_pk_bf16(y[0], y[1]); w.y = cvt_pk_bf16(y[2], y[3]); o8[64 * j] = w; }
        }
    }
    SEAM(PH_H);
    if (IN(PH_INPROJ)) {
        PTRS
        {   pg8::GridSched S{(const char*)Hb, (const char*)WT_IN, (size_t)256 * 2048 * 2, (size_t)256 * 2048 * 2, T / 256, N_IN_NAT / 256, G, bx};
            EpiInproj E{QL, CKV, KR, ACAT, KROT, SG, GA, GB, SSQP, CS_RET, CS_MLA, DECTAB};
            pg8::gemm_phase(lds, 2048, 2048, 2048, S, E); }
    }
    if (IN(PH_INPROJ_V)) {
        PTRS
        {   pg8::GridSched S{(const char*)(WT_IN + (size_t)N_IN_NAT * 2048), (const char*)Hb, (size_t)256 * 2048 * 2, (size_t)256 * 2048 * 2, 8, T / 256, G, bx};
            EpiVT E{BCAT};
            pg8::gemm_phase(lds, 2048, 2048, 2048, S, E); }
    }
    SEAM(PH_INPROJ_V);
    if (IN(PH_MLAQ)) {
        PTRS
        {   pg8::GridSched S{(const char*)QL, (const char*)WT_QB, (size_t)256 * 512 * 2, (size_t)256 * 512 * 2, T / 256, 6, G, bx};
            EpiMlaQ E{QN, QR, SSQP, CS_MLA}; pg8::gemm_phase(lds, 512, 512, 512, S, E); }
    }
    if (IN(PH_MLAKV)) {
        PTRS
        {   pg8::GridSched S{(const char*)CKV, (const char*)WT_KVB, (size_t)256 * 512 * 2, (size_t)256 * 512 * 2, T / 256, 8, G, bx};
            EpiMlaKV E{KN, VV, SSQP + (size_t)8 * T}; pg8::gemm_phase(lds, 512, 512, 512, S, E); }
    }
    if (IN(PH_GA)) {
        PTRS
        {   pg8::BatchSched S{(const char*)(ACAT + 256), (const char*)KROT, (size_t)256 * 768 * 2, (size_t)256 * 256 * 2, NBLK, G, bx};
            EpiGa E{ACAT, DECTAB}; pg8::gemm_phase(lds, 256, 768, 256, S, E); }
    }
    if (IN(PH_KT)) {
        PTRS
        {
            LAS bf16_t* scr = (LAS bf16_t*)(lds + wave * 9216);
            for (int it = gw; it < NBLK * 16; it += NGW) {
                const int blk = it >> 4, sp = (it >> 2) & 3, sd = it & 3, h = (blk >> 4) & 7;
                const float lf = DECTAB[h], lb = DECTAB[8 + h];
                const bf16_t* src = KROT + ((size_t)blk * 256 + sp * 64 + lane) * 256 + sd * 64;
#pragma unroll
                for (int q = 0; q < 8; ++q) { const u32x4 w = *(const u32x4*)(src + q * 8);
#pragma unroll
                    for (int e = 0; e < 4; ++e) { const unsigned ww = w[e]; scr[(q * 8 + e * 2) * 72 + lane] = (bf16_t)(ww & 0xffffu); scr[(q * 8 + e * 2 + 1) * 72 + lane] = (bf16_t)(ww >> 16); } }
                asm volatile("s_waitcnt lgkmcnt(0)" ::: "memory");
                bf16_t* df = KZTF + ((size_t)blk * 256 + sd * 64 + lane) * 256 + sp * 64;
                bf16_t* db = KZTB + ((size_t)blk * 256 + sd * 64 + lane) * 256 + sp * 64;
#pragma unroll
                for (int q = 0; q < 8; ++q) { const u32x4 w = *(const LAS u32x4*)(scr + lane * 72 + q * 8); f32x4 a, b2; unpack8(w, a, b2);
                    f32x4 zf0, zf1, zb0, zb1;
#pragma unroll
                    for (int e = 0; e < 4; ++e) { const int p0 = sp * 64 + q * 8 + e, p1 = p0 + 4;
                        zf0[e] = __builtin_amdgcn_exp2f((float)(255 - p0) * lf); zf1[e] = __builtin_amdgcn_exp2f((float)(255 - p1) * lf); zb0[e] = __builtin_amdgcn_exp2f((float)p0 * lb); zb1[e] = __builtin_amdgcn_exp2f((float)p1 * lb); }
                    *(u32x4*)(df + q * 8) = pack8(a * zf0, b2 * zf1); *(u32x4*)(db + q * 8) = pack8(a * zb0, b2 * zb1); }
                asm volatile("s_waitcnt lgkmcnt(0)" ::: "memory");
            }
        }
    }
    SEAM(PH_KT);
    if (IN(PH_CHAIN)) {
        PTRS
        if (bx < 64) {
            const int bh = bx >> 1, dir = bx & 1;
            {
                const int blk0 = bh * NCH + (dir ? NCH - 1 : 0);
                bf16_t* z = BCAT + ((size_t)blk0 * 256 + (tid >> 1)) * 768 + 256 + 256 * dir + (tid & 1) * 128;
#pragma unroll
                for (int q = 0; q < 16; ++q) *(u32x4*)(z + q * 8) = (u32x4){0u, 0u, 0u, 0u};
            }
            pg8::ChainSched S{(const char*)BCAT, (const char*)(dir ? KZTB : KZTF), bh, dir};
            EpiGb E{BCAT, DECTAB, dir};
            pg8::gemm_phase(lds, 256, 768, 256, S, E);
        }
    }
    if (IN(PH_ATTN)) {
        PTRS
        unsigned* queue = ctl + CW_QUEUE;
        for (;;) {
            __syncthreads();
            if (tid == 0) MISC[0] = atomicAdd(queue, 1u);
            __syncthreads();
            const int a = (int)MISC[0];
            if (a >= 512) break;
            const int bh = a >> 4, qb = a & 15, b = bh >> 3, h = bh & 7;
            const size_t tok0 = (size_t)b * SEQ + qb * 256, kt0 = (size_t)b * SEQ;
            att::attn_unit(QN + tok0 * 1024 + h * 128, QR + tok0 * 512 + h * 64, KN + kt0 * 1024 + h * 128, KR + kt0 * 64, VV + kt0 * 1024 + h * 128, OA + tok0 * 1024 + h * 128, SEQ, (char*)lds_raw);
        }
    }
    SEAM(PH_ATTN);
    if (IN(PH_GC)) {
        PTRS
        {   pg8::BatchSched S{(const char*)ACAT, (const char*)BCAT, (size_t)256 * 768 * 2, (size_t)256 * 768 * 2, NBLK, G, bx};
            EpiGc E{ORET}; pg8::gemm_phase(lds, 768, 768, 768, S, E); }
    }
    if (IN(PH_MIXA)) {
        PTRS
        {   pg8::GridSched S{(const char*)OA, (const char*)WT_MLAO, (size_t)256 * 1024 * 2, (size_t)256 * 1024 * 2, T / 256, 8, G, bx};
            EpiMixA E{MIXP, GA}; pg8::gemm_phase(lds, 1024, 1024, 1024, S, E); }
    }
    SEAM(PH_MIXA);
    if (IN(PH_GN)) {
        PTRS
        const float* gn = INP(I_RETGN);
        for (int mrow = gw; mrow < T; mrow += NGW) {
            const f32x4* orow = (const f32x4*)(ORET + (size_t)mrow * D) + lane; const u32x2* sg = (const u32x2*)(SG + (size_t)mrow * D) + lane; u32x2* ob = (u32x2*)(OB + (size_t)mrow * D) + lane;
#pragma unroll
            for (int j = 0; j < 8; ++j) {
                const f32x4 v = orow[64 * j]; const float mu = wave_sum((v[0] + v[1]) + (v[2] + v[3])) * (1.0f / 256.0f);
                const f32x4 d = v - mu; const float var = wave_sum((d[0] * d[0] + d[1] * d[1]) + (d[2] * d[2] + d[3] * d[3])) * (1.0f / 256.0f);
                const float rs = rsqrtf(var + GN_EPS); const f32x4 gg = *(const f32x4*)(gn + 256 * j + 4 * lane); const u32x2 s2 = sg[64 * j];
                const f32x4 sv = (f32x4){bf_lo(s2.x), bf_hi(s2.x), bf_lo(s2.y), bf_hi(s2.y)};
                const f32x4 y = sv * (d * rs * gg); u32x2 w; w.x = cvt_pk_bf16(y[0], y[1]); w.y = cvt_pk_bf16(y[2], y[3]); ob[64 * j] = w; }
        }
    }
    SEAM(PH_GN);
    if (IN(PH_MIXB)) {
        PTRS
        pg8::GridSched S{(const char*)OB, (const char*)WT_RETO, (size_t)256 * 2048 * 2, (size_t)256 * 2048 * 2, T / 256, 8, G, bx};
        EpiMixB E{MIXIN, MIXP, GB}; pg8::gemm_phase(lds, 2048, 2048, 2048, S, E);
    }
    SEAM(PH_MIXB);
    if (IN(PH_MIX)) {
        PTRS
        pg8::GridSched S{(const char*)MIXIN, (const char*)WT_OUT, (size_t)256 * 2048 * 2, (size_t)256 * 2048 * 2, T / 256, 8, G, bx};
        EpiF32 E{MIX}; pg8::gemm_phase(lds, 2048, 2048, 2048, S, E);
    }
    SEAM(PH_MIX);
    if (IN(PH_ROUTER)) {
        PTRS
        const float* gpm = INP(I_GPOSTM); const float* gpf = INP(I_GPREF); const float* wr = INP(I_WROUTER); const float* brt = INP(I_BROUTER);
        LAS float* red = (LAS float*)(lds + wave * 8448);
        unsigned* counts = ctl + CW_COUNTS;
        for (int mrow = gw; mrow < T; mrow += NGW) {
            int lane = tid & 63; asm volatile("" : "+v"(lane));
            const int b = mrow / SEQ; const float* ad = ada + b * 12288;
            const f32x4* mr = (const f32x4*)(MIX + (size_t)mrow * D) + lane; const f32x4* xr = (const f32x4*)(INP(I_X) + (size_t)mrow * D) + lane;
            f32x4 v[8]; float s = 0.f;
#pragma unroll
            for (int j = 0; j < 8; ++j) { v[j] = mr[64 * j]; s += (v[j][0] * v[j][0] + v[j][1] * v[j][1]) + (v[j][2] * v[j][2] + v[j][3] * v[j][3]); }
            const float r1 = rsqrtf(wave_sum(s) * (1.0f / D) + RMS_EPS); float s2 = 0.f;
            f32x4* o4 = (f32x4*)(outp + (size_t)mrow * D) + lane;
#pragma unroll
            for (int j = 0; j < 8; ++j) { const int col = 256 * j + 4 * lane; const f32x4 gg = *(const f32x4*)(gpm + col), gm = *(const f32x4*)(ad + 4096 + col);
                v[j] = xr[64 * j] + gm * (v[j] * r1 * gg); o4[64 * j] = v[j]; s2 += (v[j][0] * v[j][0] + v[j][1] * v[j][1]) + (v[j][2] * v[j][2] + v[j][3] * v[j][3]); }
            const float r2 = rsqrtf(wave_sum(s2) * (1.0f / D) + RMS_EPS);
            u32x2* h8 = (u32x2*)(H2 + (size_t)mrow * D) + lane;
#pragma unroll
            for (int j = 0; j < 8; ++j) { const int col = 256 * j + 4 * lane; const f32x4 gg = *(const f32x4*)(gpf + col), sh = *(const f32x4*)(ad + 6144 + col), sc = *(const f32x4*)(ad + 8192 + col);
                v[j] = v[j] * r2 * gg * (sc + 1.0f) + sh; u32x2 w; w.x = cvt_pk_bf16(v[j][0], v[j][1]); w.y = cvt_pk_bf16(v[j][2], v[j][3]); h8[64 * j] = w; }
#pragma unroll
            for (int j = 0; j < 8; ++j) *(LAS f32x4*)(red + 256 * j + 4 * lane) = v[j];
            asm volatile("s_waitcnt lgkmcnt(0)" ::: "memory");
            f32x4 pa = (f32x4){0.f, 0.f, 0.f, 0.f};
            { const int eg = lane & 7, ks = lane >> 3; const f32x4* wk = (const f32x4*)(wr + (size_t)ks * 32 + eg * 4); const LAS float* hk = red + ks;
#pragma unroll 8
              for (int st = 0; st < 256; ++st) { const f32x4 w4 = wk[(size_t)st * 64]; const float hv = hk[st * 8]; pa += w4 * hv; } }
#pragma unroll
            for (int o = 8; o < 64; o <<= 1) { pa[0] += __shfl_xor(pa[0], o); pa[1] += __shfl_xor(pa[1], o); pa[2] += __shfl_xor(pa[2], o); pa[3] += __shfl_xor(pa[3], o); }
            asm volatile("s_waitcnt lgkmcnt(0)" ::: "memory");
            if (lane < 8) *(LAS f32x4*)(red + 2048 + 4 * lane) = pa;
            asm volatile("s_waitcnt lgkmcnt(0)" ::: "memory");
            const float lg = red[2048 + (lane & 31)] + brt[lane & 31];
            asm volatile("s_waitcnt lgkmcnt(0)" ::: "memory");
            float val = lane < 32 ? lg : -3.0e38f; float tv[4]; int ti[4];
#pragma unroll
            for (int r = 0; r < 4; ++r) { float bv = val; int bi = lane;
#pragma unroll
                for (int o = 32; o >= 1; o >>= 1) { const float ov = __shfl_xor(bv, o); const int oi = __shfl_xor(bi, o); if (ov > bv || (ov == bv && oi < bi)) { bv = ov; bi = oi; } }
                tv[r] = bv; ti[r] = bi; if (lane == bi) val = -3.0e38f; }
            const float e1 = __expf(tv[1] - tv[0]), e2 = __expf(tv[2] - tv[0]), e3 = __expf(tv[3] - tv[0]); const float inv = 1.0f / (1.0f + e1 + e2 + e3);
            if (lane < 4) { const int id = lane == 0 ? ti[0] : (lane == 1 ? ti[1] : (lane == 2 ? ti[2] : ti[3])); const float wv = (lane == 0 ? 1.0f : (lane == 1 ? e1 : (lane == 2 ? e2 : e3))) * inv;
                TOPI[mrow * 4 + lane] = id; TOPW[mrow * 4 + lane] = wv; atomicAdd(counts + id, 1u); }
        }
    }
    SEAM(PH_ROUTER);
    if (IN(PH_DISPATCH)) {
        PTRS
        unsigned* counts = ctl + CW_COUNTS; unsigned* cursor = ctl + CW_CURSOR;
        int pst = 0, pend = 0;
        { const int cnt = lane < 32 ? (int)__hip_atomic_load(counts + lane, __ATOMIC_RELAXED, __HIP_MEMORY_SCOPE_AGENT) : 0; const int pad = (cnt + 255) & ~255; int inc = pad;
#pragma unroll
          for (int o = 1; o < 32; o <<= 1) { const int t = __shfl_up(inc, o); if ((lane & 31) >= o) inc += t; }
          pend = inc; pst = inc - pad; }
        if (gw == 0) {
            const int ntiles = __shfl(pend, 31) >> 8; if (lane == 0) TILE[0] = ntiles;
            for (int t = lane; t < PMAX / 256; t += 64) { int e = 0;
                for (int q = 0; q < 32; ++q) { const int pe = __shfl(pend, q); e += (pe <= t * 256) ? 1 : 0; }
                TILE[16 + t] = e < 31 ? e : 31; }
        }
        for (int mrow = gw; mrow < T; mrow += NGW) {
            int slot = 0;
            const int e = lane < 4 ? TOPI[mrow * 4 + lane] : 0;
            const int ps = __shfl(pst, e);
            if (lane < 4) { slot = ps + (int)atomicAdd(cursor + e, 1u); DEST[mrow * 4 + lane] = slot; }
            const u32x4* src = (const u32x4*)(H2 + (size_t)mrow * D) + lane; u32x4 rw[4];
#pragma unroll
            for (int q = 0; q < 4; ++q) rw[q] = src[64 * q];
#pragma unroll
            for (int k = 0; k < 4; ++k) { const int sl = __shfl(slot, k); u32x4* dst = (u32x4*)(XS + (size_t)sl * D) + lane;
#pragma unroll
                for (int q = 0; q < 4; ++q) dst[64 * q] = rw[q]; }
        }
    }
    SEAM(PH_DISPATCH);
    if (IN(PH_GU)) {
        PTRS
        const int ntiles = __builtin_amdgcn_readfirstlane(TILE[0]);
        pg8::MoeSched S{(const char*)XS, (const char*)WT_GU, TILE + 16, (size_t)4096 * 2048 * 2, ntiles, 16, G, bx};
        EpiGU E{ACT, INP(I_BGU)}; pg8::gemm_phase(lds, 2048, 2048, 2048, S, E);
    }
    SEAM(PH_GU);
    if (IN(PH_DOWN)) {
        PTRS
        const int ntiles = __builtin_amdgcn_readfirstlane(TILE[0]);
        pg8::MoeSched S{(const char*)ACT, (const char*)WT_DOWN, TILE + 16, (size_t)2048 * 2048 * 2, ntiles, 8, G, bx};
        EpiDown E{YS, INP(I_BDOWN)}; pg8::gemm_phase(lds, 2048, 2048, 2048, S, E);
    }
    SEAM(PH_DOWN);
    if (IN(PH_COMBINE)) {
        PTRS
        const float* gpo = INP(I_GPOSTF);
        for (int mrow = gw; mrow < T; mrow += NGW) {
            const int b = mrow / SEQ; const float* ad = ada + b * 12288;
            int dk[4]; float wk[4];
#pragma unroll
            for (int k = 0; k < 4; ++k) { dk[k] = DEST[mrow * 4 + k]; wk[k] = TOPW[mrow * 4 + k]; }
            f32x4 f[8]; float s = 0.f;
#pragma unroll
            for (int j = 0; j < 8; ++j) f[j] = (f32x4){0.f, 0.f, 0.f, 0.f};
#pragma unroll
            for (int k = 0; k < 4; ++k) { const u32x2* yr = (const u32x2*)(YS + (size_t)dk[k] * D) + lane;
#pragma unroll
                for (int j = 0; j < 8; ++j) { const u32x2 w = yr[64 * j]; f[j] += (f32x4){bf_lo(w.x), bf_hi(w.x), bf_lo(w.y), bf_hi(w.y)} * wk[k]; } }
#pragma unroll
            for (int j = 0; j < 8; ++j) s += (f[j][0] * f[j][0] + f[j][1] * f[j][1]) + (f[j][2] * f[j][2] + f[j][3] * f[j][3]);
            const float r = rsqrtf(wave_sum(s) * (1.0f / D) + RMS_EPS);
            f32x4* o4 = (f32x4*)(outp + (size_t)mrow * D) + lane;
#pragma unroll
            for (int j = 0; j < 8; ++j) { const int col = 256 * j + 4 * lane; const f32x4 gg = *(const f32x4*)(gpo + col), gf = *(const f32x4*)(ad + 10240 + col);
                o4[64 * j] = o4[64 * j] + gf * (f[j] * r * gg); }
        }
    }
#undef IN
#undef SEAM
}

extern "C" void kernel_launch(void* const* d_in, const int* in_sizes, int n_in, void* d_out, int out_size, void* d_ws, size_t ws_size, hipStream_t stream) {
    static int grid = 0;
    if (grid == 0) {
        if (n_in != 26 || out_size != T * D || ws_size < WS_END) { fprintf(stderr, "kernel_launch: unexpected shapes: n_in %d out %d ws %zu (need %zu)\n", n_in, out_size, ws_size, (size_t)WS_END); grid = -1; return; }
        int dev = 0, cus = 0, per_cu = 0;
        if (hipGetDevice(&dev) != hipSuccess || hipDeviceGetAttribute(&cus, hipDeviceAttributeMultiprocessorCount, dev) != hipSuccess) { grid = -1; return; }
        if (hipFuncSetAttribute((const void*)fwd_kernel, hipFuncAttributeMaxDynamicSharedMemorySize, LDS_BYTES) != hipSuccess) { fprintf(stderr, "kernel_launch: hipFuncSetAttribute failed\n"); grid = -1; return; }
        if (hipOccupancyMaxActiveBlocksPerMultiprocessor(&per_cu, (const void*)fwd_kernel, 512, LDS_BYTES) != hipSuccess || per_cu < 1) fprintf(stderr, "kernel_launch: occupancy query says %d\n", per_cu);
        (void)hipGetLastError();
        grid = cus;
    }
    if (grid < 0) return;
    (void)hipMemsetAsync((char*)d_ws + WS_CTL, 0, CTL_BYTES, stream);
    Args a{};
    for (int i = 0; i < 26; ++i) a.in[i] = (const float*)d_in[i];
    a.out = (float*)d_out; a.ws = (unsigned char*)d_ws;
    if (MK_N_LAUNCHES == 1) { a.ph_lo = 0; a.ph_hi = NPH; hipLaunchKernelGGL(fwd_kernel, dim3(grid), dim3(512), LDS_BYTES, stream, a); }
    else for (int p = 0; p < NPH; ++p) { a.ph_lo = p; a.ph_hi = p + 1; hipLaunchKernelGGL(fwd_kernel, dim3(grid), dim3(512), LDS_BYTES, stream, a); }
    const hipError_t le = hipPeekAtLastError();
    if (le != hipSuccess) fprintf(stderr, "kernel_launch: launch failed: %s\n", hipGetErrorName(le));
}
```

```cpp
#include <hip/hip_runtime.h>
#include <cstdio>
#include <cstdint>

#ifndef MK_N_LAUNCHES
#define MK_N_LAUNCHES 1
#endif

#define LAS __attribute__((address_space(3)))
typedef unsigned short bf16_t;
typedef short bf16x8 __attribute__((ext_vector_type(8)));
typedef short s16x4 __attribute__((ext_vector_type(4)));
typedef float f32x4 __attribute__((ext_vector_type(4)));
typedef float f32x2 __attribute__((ext_vector_type(2)));
typedef float f32x16 __attribute__((ext_vector_type(16)));
typedef unsigned u32x4 __attribute__((ext_vector_type(4)));
typedef unsigned u32x2 __attribute__((ext_vector_type(2)));

constexpr int NB = 4, SEQ = 4096, T = NB * SEQ, D = 2048;
constexpr int CH = 256, NCH = SEQ / CH, NBLK = NB * 8 * NCH;
constexpr int N_IN_NAT = 11520;
constexpr int N_IN_ALL = N_IN_NAT + 2048;
constexpr int NE = 32, PMAX = 73728;
constexpr float RMS_EPS = 1e-6f, GN_EPS = 1e-6f;
constexpr float QSCALE = 0.07216878364870322f;
constexpr int CONV_WGS = 64;

constexpr size_t MiB = 1u << 20;
constexpr size_t WS_CTL = 0, CTL_BYTES = 1 * MiB;
constexpr size_t WS_WT_IN = 1 * MiB;
constexpr size_t WS_WT_QB = WS_WT_IN + 54 * MiB;
constexpr size_t WS_WT_KVB = WS_WT_QB + 2 * MiB;
constexpr size_t WS_WT_MLAO = WS_WT_KVB + 2 * MiB;
constexpr size_t WS_WT_RETO = WS_WT_MLAO + 4 * MiB;
constexpr size_t WS_WT_OUT = WS_WT_RETO + 8 * MiB;
constexpr size_t WS_WT_GU = WS_WT_OUT + 8 * MiB;
constexpr size_t WS_WT_DOWN = WS_WT_GU + 512 * MiB;
constexpr size_t WS_CS_RET = WS_WT_DOWN + 256 * MiB;
constexpr size_t WS_CS_MLA = WS_CS_RET + 16 * MiB;
constexpr size_t WS_H = WS_CS_MLA + 4 * MiB;
constexpr size_t WS_QL = WS_H + 64 * MiB;
constexpr size_t WS_CKV = WS_QL + 16 * MiB;
constexpr size_t WS_KR = WS_CKV + 16 * MiB;
constexpr size_t WS_ACAT = WS_KR + 2 * MiB;
constexpr size_t WS_BCAT = WS_ACAT + 192 * MiB;
constexpr size_t WS_KROT = WS_BCAT + 192 * MiB;
constexpr size_t WS_KZTF = WS_KROT + 64 * MiB;
constexpr size_t WS_KZTB = WS_KZTF + 64 * MiB;
constexpr size_t WS_SG = WS_KZTB + 64 * MiB;
constexpr size_t WS_GA = WS_SG + 64 * MiB;
constexpr size_t WS_GB = WS_GA + 64 * MiB;
constexpr size_t WS_QN = WS_GB + 64 * MiB;
constexpr size_t WS_QR = WS_QN + 32 * MiB;
constexpr size_t WS_KN = WS_QR + 16 * MiB;
constexpr size_t WS_VV = WS_KN + 32 * MiB;
constexpr size_t WS_OA = WS_VV + 32 * MiB;
constexpr size_t WS_ORET = WS_OA + 32 * MiB;
constexpr size_t WS_OB = WS_ORET + 128 * MiB;
constexpr size_t WS_MIXP = WS_OB + 64 * MiB;
constexpr size_t WS_MIXIN = WS_MIXP + 64 * MiB;
constexpr size_t WS_MIX = WS_MIXIN + 64 * MiB;
constexpr size_t WS_H2 = WS_MIX + 128 * MiB;
constexpr size_t WS_TOPI = WS_H2 + 64 * MiB;
constexpr size_t WS_TOPW = WS_TOPI + 1 * MiB;
constexpr size_t WS_DEST = WS_TOPW + 1 * MiB;
constexpr size_t WS_TILE = WS_DEST + 1 * MiB;
constexpr size_t WS_YS_END = WS_TILE + 1 * MiB + 3 * 288 * MiB;
constexpr size_t WS_DECTAB = WS_TILE + 65536;
constexpr size_t WS_SSQP = WS_YS_END;
constexpr size_t WS_XS = WS_TILE + 1 * MiB;
constexpr size_t WS_ACT = WS_XS + 288 * MiB;
constexpr size_t WS_YS = WS_ACT + 288 * MiB;
constexpr size_t WS_ADAP = WS_YS + 288 * MiB + 1 * MiB;
constexpr size_t WS_H8 = WS_ADAP + 2 * MiB;
constexpr size_t WS_WT8IN = WS_H8 + 32 * MiB;
constexpr size_t WS_VT8 = WS_WT8IN + 12 * MiB;
constexpr size_t WS_END = WS_VT8 + 32 * MiB;
constexpr int CW_BAR = 4096;
constexpr int CW_QUEUE = 8192, CW_CVTQ = 8384, CW_COUNTS = 10240, CW_CURSOR = 12288;
constexpr int CW_ADA = 16384;
constexpr int CW_SSQQ = 65536, CW_SSQKV = 81920;
static_assert((CW_SSQKV + T) * 4 <= (int)CTL_BYTES, "ctl");

constexpr int RING_BYTES = 131072, CTRL_OFF = 155648, MISC_OFF = CTRL_OFF, LARG_OFF = CTRL_OFF + 1024, LDS_BYTES = 163840;

__device__ __forceinline__ unsigned cvt_pk_bf16(float lo, float hi) { unsigned r; asm volatile("v_cvt_pk_bf16_f32 %0, %1, %2" : "=v"(r) : "v"(lo), "v"(hi)); return r; }
__device__ __forceinline__ u32x4 pack8(f32x4 a, f32x4 b) { u32x4 w; w.x = cvt_pk_bf16(a[0], a[1]); w.y = cvt_pk_bf16(a[2], a[3]); w.z = cvt_pk_bf16(b[0], b[1]); w.w = cvt_pk_bf16(b[2], b[3]); return w; }
__device__ __forceinline__ unsigned pk4_fp8(float a, float b, float c, float d, float sc) {
    a = __builtin_amdgcn_fmed3f(a * sc, -448.f, 448.f); b = __builtin_amdgcn_fmed3f(b * sc, -448.f, 448.f); c = __builtin_amdgcn_fmed3f(c * sc, -448.f, 448.f); d = __builtin_amdgcn_fmed3f(d * sc, -448.f, 448.f);
    int w = __builtin_amdgcn_cvt_pk_fp8_f32(a, b, 0, false); w = __builtin_amdgcn_cvt_pk_fp8_f32(c, d, w, true); return (unsigned)w;
}
constexpr float W8_SCALE = 1024.f, H8_SCALE = 16.f, A8_SCALE = 8.f;
constexpr float V8_SCALE = 16.f, K8_SCALE = 256.f, CH_UNSCALE = 1.0f / (V8_SCALE * K8_SCALE);
constexpr float GU_UNSCALE = 1.0f / (W8_SCALE * H8_SCALE), DN_UNSCALE = 1.0f / (W8_SCALE * A8_SCALE);
__device__ __forceinline__ float bf_lo(unsigned w) { return __uint_as_float(w << 16); }
__device__ __forceinline__ float bf_hi(unsigned w) { return __uint_as_float(w & 0xffff0000u); }
__device__ __forceinline__ void unpack8(u32x4 w, f32x4& a, f32x4& b) { a = (f32x4){bf_lo(w.x), bf_hi(w.x), bf_lo(w.y), bf_hi(w.y)}; b = (f32x4){bf_lo(w.z), bf_hi(w.z), bf_lo(w.w), bf_hi(w.w)}; }
__device__ __forceinline__ float wave_sum(float v) {
#pragma unroll
    for (int o = 1; o < 64; o <<= 1) v += __shfl_xor(v, o);
    return v;
}
__device__ __forceinline__ float sigmoidf_(float x) { return __builtin_amdgcn_rcpf(1.0f + __expf(-x)); }
__device__ __forceinline__ float log2_sigmoid(float x) { return -log1pf(expf(-x)) * 1.4426950408889634f; }

#define XB_TMO      128
#define XB_XCNT(j)  (256  + 64 * (j))
#define XB_XSUB(j)  (1280 + 64 * (j))
#define XB_XGEN(j)  (2304 + 64 * (j))
#define XB_TOP      3328
#define XB_TOPGEN   3392
#define XCD_BAR_WORDS 3456
#define XB_SPIN_CAP (1u << 22)
__device__ __forceinline__ unsigned xb_ld(unsigned* p)              { return __hip_atomic_load(p, __ATOMIC_RELAXED, __HIP_MEMORY_SCOPE_AGENT); }
__device__ __forceinline__ unsigned xb_add(unsigned* p, unsigned v) { return __hip_atomic_fetch_add(p, v, __ATOMIC_RELAXED, __HIP_MEMORY_SCOPE_AGENT); }
__device__ __forceinline__ unsigned xb_xcc_id() { return (unsigned)__builtin_amdgcn_s_getreg((3 << 11) | 20) & 0xFu; }
#define XB_SPIN(cond, bar) do { unsigned _sp = 0; while (cond) { __builtin_amdgcn_s_sleep(1); \
    if ((++_sp & 255u) == 0u) { if (xb_ld(&(bar)[XB_TMO])) break; if (_sp > XB_SPIN_CAP) { atomicAdd(&(bar)[XB_TMO], 1u); break; } } } } while (0)
struct XcdBarrier { unsigned* bar; unsigned x; volatile LAS unsigned* st; };
__device__ __forceinline__ XcdBarrier xcd_barrier_post(unsigned* bar, volatile LAS unsigned* st) {
    XcdBarrier b; b.bar = bar; b.x = xb_xcc_id(); b.st = st;
    if (threadIdx.x == 0) (void)xb_add(&bar[XB_XCNT(b.x)], 1u);
    return b;
}
__device__ __forceinline__ void xcd_barrier_complete(unsigned* bar, unsigned x, unsigned& nloc, unsigned& nx) {
    const unsigned G = gridDim.x * gridDim.y * gridDim.z;
    unsigned sum, cnt, mine, sp = 0u;
    for (;;) {
        sum = 0u; cnt = 0u; mine = 0u;
#pragma unroll
        for (unsigned j = 0; j < 16; ++j) { const unsigned c = xb_ld(&bar[XB_XCNT(j)]); sum += c; cnt += (c > 0u) ? 1u : 0u; mine = (j == x) ? c : mine; }
        if (sum == G) break;
        __builtin_amdgcn_s_sleep(1);
        if ((++sp & 255u) == 0u) { if (xb_ld(&bar[XB_TMO])) break; if (sp > XB_SPIN_CAP) { atomicAdd(&bar[XB_TMO], 1u); break; } }
    }
    nloc = mine > 0u ? mine : 1u; nx = cnt > 0u ? cnt : 1u;
}
__device__ __forceinline__ void xcd_barrier(const XcdBarrier& b) {
    asm volatile("s_waitcnt vmcnt(0)" ::: "memory");
    __syncthreads();
    if (threadIdx.x == 0) {
        unsigned* bar = b.bar;
        __builtin_amdgcn_s_waitcnt(0);
        unsigned nloc = b.st[0], nx = b.st[1];
        if (nloc == 0u) { xcd_barrier_complete(bar, b.x, nloc, nx); b.st[0] = nloc; b.st[1] = nx; }
        const unsigned old = xb_add(&bar[XB_XSUB(b.x)], 1u);
        const unsigned gen = old / nloc;
        if (old + 1u == (gen + 1u) * nloc) {
            __builtin_amdgcn_fence(__ATOMIC_RELEASE, "agent");
            asm volatile("s_waitcnt vmcnt(0)" ::: "memory");
            const unsigned og = xb_add(&bar[XB_TOP], 1u);
            const unsigned tg = og / nx;
            if (og + 1u == (tg + 1u) * nx) xb_add(&bar[XB_TOPGEN], 1u);
            else XB_SPIN(xb_ld(&bar[XB_TOPGEN]) == tg, bar);
            __builtin_amdgcn_fence(__ATOMIC_ACQUIRE, "agent");
            xb_add(&bar[XB_XGEN(b.x)], 1u);
            asm volatile("s_waitcnt vmcnt(0)" ::: "memory");
        } else {
            XB_SPIN(xb_ld(&bar[XB_XGEN(b.x)]) == gen, bar);
            __builtin_amdgcn_fence(__ATOMIC_ACQUIRE, "agent");
            asm volatile("s_waitcnt vmcnt(0)" ::: "memory");
        }
    }
    __syncthreads();
}

namespace pg8 {
constexpr int BM = 256, BK = 64, HALF = 128, HTB = HALF * BK * 2, NXCD = 8, WGM = 8;
__host__ __device__ __forceinline__ int lds_byte(int r, int c) { const int st = (r >> 4) * 2 + (c >> 5), rr = r & 15, cc = c & 31, ob = rr * 64 + cc * 2; return st * 1024 + (ob ^ (((ob >> 9) & 1) << 5)); }
__host__ __device__ __forceinline__ void stage_rc(int b, int& R, int& C) { const int st = b / 1024, sb = b % 1024, swz = sb ^ (((sb >> 9) & 1) << 5); R = (st >> 1) * 16 + swz / 64; C = (st & 1) * 32 + (swz % 64) / 2; }
__host__ __device__ __forceinline__ int perm32(int rho) { const int n = rho >> 4, i = rho & 15; return 8 * (i >> 2) + 4 * n + (i & 3); }
struct Unit { const char* a; const char* b; int pm, pn, keep, aux; };
__device__ __forceinline__ void tile_order(int wgid, int nM, int nN, int& pm, int& pn) {
    const int nwg = nM * nN; { const int q = nwg / NXCD, r = nwg % NXCD, xcd = wgid % NXCD, off = wgid / NXCD; wgid = (xcd < r ? xcd * (q + 1) : r * (q + 1) + (xcd - r) * q) + off; }
    const int nig = WGM * nN, gid = wgid / nig, fm = gid * WGM, gsz = (nM - fm) < WGM ? (nM - fm) : WGM;
    pm = fm + ((wgid % nig) % gsz); pn = (wgid % nig) / gsz;
}
typedef int v8i __attribute__((ext_vector_type(8)));
typedef int v4i __attribute__((ext_vector_type(4)));
template <class Epi, class Sched, bool F8 = false, bool REMAT = false>
__device__ __forceinline__ void gemm_phase(LAS unsigned char* lds, const int K, const int lda, const int ldb, const Sched& S, const Epi& E) {
    const int tid = threadIdx.x, wid = __builtin_amdgcn_readfirstlane(tid >> 6), lane = tid & 63, wr = wid >> 2, wc = wid & 3, fr = lane & 15, fq = lane >> 4;
    constexpr int ES = F8 ? 1 : 2;
    const int nt = K * ES / (BK * 2);
    unsigned voffA, voffB;
    { int R, C; stage_rc(tid * 16, R, C); const int Rb = (R & ~31) + perm32(R & 31); voffA = (unsigned)(R * lda * ES + C * 2); voffB = (unsigned)(Rb * ldb * ES + C * 2); }
    const size_t q64voffA = (size_t)64 * lda * ES, q64voffB = (size_t)64 * ldb * ES;
    const size_t kstep = (size_t)(BK * 2);
    const size_t hstepA = (size_t)HALF * lda * ES, hstepB = (size_t)HALF * ldb * ES;
    const unsigned ldsw = (unsigned)wid * 1024u;
    const int aoff = F8 ? lds_byte(wr * 64 + fr, fq * 16) : lds_byte(wr * 64 + fr, fq * 8), boff = F8 ? lds_byte(wc * 32 + fr, fq * 16) : lds_byte(wc * 32 + fr, fq * 8);
#define PG8_SA(b, h) (((b) * 2 + (h)) * HTB)
#define PG8_SB(b, h) ((4 + (b) * 2 + (h)) * HTB)
    constexpr bool isB_voffA = false, isB_voffB = true; const unsigned pitch_voffA = (unsigned)(lda * ES), pitch_voffB = (unsigned)(ldb * ES);
#define PG8_VOFF(isB, pitch) ({ unsigned _t = threadIdx.x; asm volatile("" : "+v"(_t)); const unsigned _l = _t & 63u, _w = _t >> 6, _sw = (_l * 16u) ^ ((_l >> 5) << 5); unsigned _R = (_w >> 1) * 16u + (_sw >> 6); \
        const unsigned _C = (_w & 1u) * 32u + ((_sw & 63u) >> 1); if (isB) _R = (_R & ~31u) + (unsigned)perm32((int)(_R & 31u)); _R * (pitch) + _C * 2u; })
#define PG8_STAGE(bufoff, gbase, voff) do { _Pragma("unroll") for (int _i = 0; _i < 2; ++_i) { unsigned _vo; if constexpr (REMAT) _vo = PG8_VOFF(isB_##voff, pitch_##voff); else { _vo = (voff); if constexpr (F8) asm volatile("" : "+v"(_vo)); } \
        __builtin_amdgcn_global_load_lds((const unsigned*)((const char*)(gbase) + (_i ? q64##voff : (size_t)0) + _vo), (LAS unsigned*)(lds + (bufoff) + ldsw + _i * 8192), 16, 0, 0); } } while (0)
#define PG8_LD1(addr) ({ v8i _r; if constexpr (F8) { _r = *(const LAS v8i*)(addr); } else { const v4i _lo = *(const LAS v4i*)(addr), _hi = *(const LAS v4i*)((addr) + 1024); _r = __builtin_shufflevector(_lo, _hi, 0, 1, 2, 3, 4, 5, 6, 7); } _r; })
#define PG8_LDA(dst, b, h) do { _Pragma("unroll") for (int m = 0; m < 4; ++m) dst[m] = PG8_LD1(lds + PG8_SA(b, h) + aoff + m * 2048); } while (0)
#define PG8_LDB(dst, b, h) do { _Pragma("unroll") for (int n = 0; n < 2; ++n) dst[n] = PG8_LD1(lds + PG8_SB(b, h) + boff + n * 2048); } while (0)
#define PG8_H0(x) __builtin_bit_cast(bf16x8, __builtin_shufflevector(x, x, 0, 1, 2, 3))
#define PG8_H1(x) __builtin_bit_cast(bf16x8, __builtin_shufflevector(x, x, 4, 5, 6, 7))
#define PG8_MMA(ai, bj, At, Bt) do { __builtin_amdgcn_s_setprio(1); _Pragma("unroll") for (int m = 0; m < 4; ++m) _Pragma("unroll") for (int n = 0; n < 2; ++n) { \
        if constexpr (F8) acc[ai][bj][m][n] = __builtin_amdgcn_mfma_scale_f32_16x16x128_f8f6f4(Bt[n], At[m], acc[ai][bj][m][n], 0, 0, 0, 0, 0, 0); \
        else { acc[ai][bj][m][n] = __builtin_amdgcn_mfma_f32_16x16x32_bf16(PG8_H0(Bt[n]), PG8_H0(At[m]), acc[ai][bj][m][n], 0, 0, 0); \
               acc[ai][bj][m][n] = __builtin_amdgcn_mfma_f32_16x16x32_bf16(PG8_H1(Bt[n]), PG8_H1(At[m]), acc[ai][bj][m][n], 0, 0, 0); } } \
        __builtin_amdgcn_s_setprio(0); } while (0)
#define PG8_WAIT_V(n) asm volatile("s_waitcnt vmcnt(" #n ")" ::: "memory")
#define PG8_WAIT_L(n) asm volatile("s_waitcnt lgkmcnt(" #n ")" ::: "memory")
#define PG8_BAR __builtin_amdgcn_s_barrier()
#define PG8_SCHED __builtin_amdgcn_sched_barrier(0)
    Unit cur, nxt; int ui = 0;
    if (!S.next(0, cur)) return;
    f32x4 acc[2][2][4][2];
#pragma unroll
    for (int a = 0; a < 2; ++a)
#pragma unroll
        for (int b = 0; b < 2; ++b)
#pragma unroll
            for (int m = 0; m < 4; ++m)
#pragma unroll
                for (int n = 0; n < 2; ++n) acc[a][b][m][n] = (f32x4){0.f, 0.f, 0.f, 0.f};
    v8i At[4], B0[2], B1[2];
    const char* cA = cur.a; const char* cB = cur.b;
    PG8_STAGE(PG8_SB(0, 0), cB, voffB); PG8_STAGE(PG8_SB(0, 1), cB + hstepB, voffB); PG8_STAGE(PG8_SA(0, 0), cA, voffA); PG8_STAGE(PG8_SA(0, 1), cA + hstepA, voffA);
    if (wr == 1) PG8_BAR;
    PG8_WAIT_V(2); PG8_BAR;
    PG8_STAGE(PG8_SB(1, 0), cB + kstep, voffB); PG8_STAGE(PG8_SA(1, 0), cA + kstep, voffA); PG8_STAGE(PG8_SB(1, 1), cB + hstepB + kstep, voffB);
    PG8_WAIT_V(6); PG8_BAR;
    for (;;) {
        const bool has_next = S.next(ui + 1, nxt);
        const char* nA = has_next ? nxt.a : cA; const char* nB = has_next ? nxt.b : cB;
#pragma nounroll
        for (int t = 0; t < nt; t += 2) {
            const bool last = (t == nt - 2);
            const char* a1 = cA + (size_t)(t + 1) * kstep;
            const char* a2 = last ? nA : cA + (size_t)(t + 2) * kstep; const char* b2 = last ? nB : cB + (size_t)(t + 2) * kstep;
            const char* a3 = a2 + kstep; const char* b3 = b2 + kstep;
            PG8_LDB(B0, 0, 0); PG8_LDB(B1, 0, 1); PG8_SCHED; PG8_LDA(At, 0, 0); PG8_STAGE(PG8_SA(1, 1), a1 + hstepA, voffA);
            PG8_WAIT_V(8); PG8_WAIT_L(0); PG8_BAR; PG8_MMA(0, 0, At, B0); PG8_MMA(0, 1, At, B1); PG8_BAR; PG8_SCHED;
            PG8_LDA(At, 0, 1); PG8_STAGE(PG8_SB(0, 0), b2, voffB); PG8_STAGE(PG8_SB(0, 1), b2 + hstepB, voffB); PG8_STAGE(PG8_SA(0, 0), a2, voffA);
            PG8_WAIT_V(8); PG8_WAIT_L(0); PG8_BAR; PG8_MMA(1, 0, At, B0); PG8_MMA(1, 1, At, B1); PG8_BAR; PG8_SCHED;
            PG8_LDB(B0, 1, 0); PG8_LDB(B1, 1, 1); PG8_SCHED; PG8_LDA(At, 1, 0); PG8_STAGE(PG8_SA(0, 1), a2 + hstepA, voffA);
            PG8_WAIT_V(8); PG8_WAIT_L(0); PG8_BAR; PG8_MMA(0, 0, At, B0); PG8_MMA(0, 1, At, B1); PG8_BAR; PG8_SCHED;
            PG8_LDA(At, 1, 1); PG8_STAGE(PG8_SB(1, 0), b3, voffB); PG8_STAGE(PG8_SB(1, 1), b3 + hstepB, voffB); PG8_STAGE(PG8_SA(1, 0), a3, voffA);
            PG8_WAIT_V(8); PG8_WAIT_L(0); PG8_BAR; PG8_MMA(1, 0, At, B0); PG8_MMA(1, 1, At, B1); PG8_BAR; PG8_SCHED;
        }
        if (wr == 0) PG8_BAR;
        { unsigned _t = threadIdx.x; if constexpr (F8) asm volatile("" : "+v"(_t)); E(acc, cur, wr, wc, (int)(_t & 15u), (int)((_t >> 4) & 3u)); }
        if (!has_next) break;
        if (!cur.keep) {
#pragma unroll
            for (int a = 0; a < 2; ++a)
#pragma unroll
                for (int b = 0; b < 2; ++b)
#pragma unroll
                    for (int m = 0; m < 4; ++m)
#pragma unroll
                        for (int n = 0; n < 2; ++n) acc[a][b][m][n] = (f32x4){0.f, 0.f, 0.f, 0.f};
        }
        cur = nxt; cA = nA; cB = nB; ++ui;
        if (wr == 1) PG8_BAR;
    }
    PG8_WAIT_V(0);
    PG8_BAR;
#undef PG8_SA
#undef PG8_SB
#undef PG8_STAGE
#undef PG8_VOFF
#undef PG8_LDA
#undef PG8_LDB
#undef PG8_LD1
#undef PG8_H0
#undef PG8_H1
#undef PG8_MMA
#undef PG8_WAIT_V
#undef PG8_WAIT_L
#undef PG8_BAR
#undef PG8_SCHED
}
struct GridSched {
    const char* A; const char* Bt; size_t astep, bstep; int nM, nN, G, c;
    __device__ __forceinline__ bool next(int i, Unit& u) const {
        const int L = i * G + c; if (L >= nM * nN) return false;
        int pm, pn; tile_order(L, nM, nN, pm, pn);
        u.a = A + (size_t)pm * astep; u.b = Bt + (size_t)pn * bstep; u.pm = pm; u.pn = pn; u.keep = 0; u.aux = 0; return true;
    }
};
struct InprojSched {
    const char* H; const char* W; int G, c;
    __device__ __forceinline__ bool next(int i, Unit& u) const {
        const int L = i * G + c; if (L >= 1792) return false;
        constexpr size_t TSB = (size_t)256 * 2048 * 2; int pm, pn;
        if (L < 1280) { tile_order(L, 64, 20, pm, pn); pn = pn < 4 ? pn : pn + 1; u.a = H + (size_t)pm * TSB; u.b = W + (size_t)pn * TSB; u.aux = 0; }
        else { tile_order(L - 1280, 8, 64, pm, pn); u.a = W + (size_t)(45 + pm) * TSB; u.b = H + (size_t)pn * TSB; u.aux = 1; }
        u.pm = pm; u.pn = pn; u.keep = 0; return true;
    }
};
struct GridSchedR {
    const char* A; const char* Bt; size_t astep, bstep; int nM, nN, G, c, L0, Lend;
    __device__ __forceinline__ bool next(int i, Unit& u) const {
        const int L = L0 + i * G + c; if (L >= Lend) return false;
        int pm, pn; tile_order(L, nM, nN, pm, pn);
        u.a = A + (size_t)pm * astep; u.b = Bt + (size_t)pn * bstep; u.pm = pm; u.pn = pn; u.keep = 0; u.aux = 0; return true;
    }
};
struct BatchSchedR {
    const char* A; const char* Bt; size_t astep, bstep; int G, c, L0, Lend;
    __device__ __forceinline__ bool next(int i, Unit& u) const {
        const int L = L0 + i * G + c; if (L >= Lend) return false;
        u.a = A + (size_t)L * astep; u.b = Bt + (size_t)L * bstep; u.pm = L; u.pn = 0; u.keep = 0; u.aux = 0; return true;
    }
};
struct BatchSched {
    const char* A; const char* Bt; size_t astep, bstep; int n, G, c;
    __device__ __forceinline__ bool next(int i, Unit& u) const {
        const int L = i * G + c; if (L >= n) return false;
        u.a = A + (size_t)L * astep; u.b = Bt + (size_t)L * bstep; u.pm = L; u.pn = 0; u.keep = 0; u.aux = 0; return true;
    }
};
struct ChainSched {
    const char* A; const char* Bt; int bh, dir;
    __device__ __forceinline__ bool next(int i, Unit& u) const {
        if (i >= NCH) return false;
        const int n = dir ? (NCH - 1 - i) : i, blk = bh * NCH + n;
        u.a = A + (size_t)blk * (256 * 256); u.b = Bt + (size_t)blk * (256 * 256); u.pm = blk; u.pn = i; u.keep = 1; u.aux = n; return true;
    }
};
struct MoeSched {
    const char* A; const char* Bt; const int* tile_e; int ntiles, nN, G, c;
    __device__ __forceinline__ bool next(int i, Unit& u) const {
        const int L = i * G + c; if (L >= ntiles * nN) return false;
        int pm, pn; tile_order(L, ntiles, nN, pm, pn);
        const int e = __builtin_amdgcn_readfirstlane(tile_e[pm]);
        u.a = A + (size_t)pm * (256 * 2048); u.b = Bt + ((size_t)e * nN + pn) * (256 * 2048); u.pm = pm; u.pn = pn; u.keep = 0; u.aux = e; return true;
    }
};
}
using pg8::Unit;

#define EPI_LOOP _Pragma("unroll") for (int ai = 0; ai < 2; ++ai) _Pragma("unroll") for (int m = 0; m < 4; ++m)
#define EPI_ROW (ai * 128 + wr * 64 + m * 16 + fr)
#define EPI_FENCE asm volatile("" ::: "memory")
typedef f32x4 Acc[2][2][4][2];

__device__ __forceinline__ void rot4(const f32x4 x1, const f32x4 x2, const f32x4 csA, const f32x4 csB, f32x4& o1, f32x4& o2) {
    o1[0] = x1[0] * csA[0] - x2[0] * csA[1]; o2[0] = x1[0] * csA[1] + x2[0] * csA[0];
    o1[1] = x1[1] * csA[2] - x2[1] * csA[3]; o2[1] = x1[1] * csA[3] + x2[1] * csA[2];
    o1[2] = x1[2] * csB[0] - x2[2] * csB[1]; o2[2] = x1[2] * csB[1] + x2[2] * csB[0];
    o1[3] = x1[3] * csB[2] - x2[3] * csB[3]; o2[3] = x1[3] * csB[3] + x2[3] * csB[2];
}
__device__ __forceinline__ f32x4 rot_il(const f32x4 v, const f32x4 cs) {
    return (f32x4){v[0] * cs[0] - v[1] * cs[1], v[0] * cs[1] + v[1] * cs[0], v[2] * cs[2] - v[3] * cs[3], v[2] * cs[3] + v[3] * cs[2]};
}

struct EpiInproj {
    bf16_t *QL, *CKV, *KR, *ACAT, *KROT, *SG, *GA, *GB; float *ssqp; const float* cs_ret; const float* cs_mla; const float* dectab; int pn_off; float unscale;
    __device__ __forceinline__ void operator()(Acc& acc, const Unit& u, int wr, int wc, int fr, int fq) const {
        asm volatile("" : "+v"(fr), "+v"(fq));
        const int pn = u.pn + pn_off, tok0 = u.pm * 256, cb = wc * 32 + fq * 8;
        if (pn < 4) {
            bf16_t* dst = QL + (size_t)(pn >> 1) * ((WS_CKV - WS_QL) / 2); float* ssq = ssqp + (size_t)(pn * 4 + wc) * T; const int c0 = (pn & 1) * 256 + cb;
            EPI_LOOP { const int row = tok0 + EPI_ROW; float s = 0.f;
#pragma unroll
                for (int bj = 0; bj < 2; ++bj) { const f32x4 v0 = acc[ai][bj][m][0], v1 = acc[ai][bj][m][1];
                    s += (v0[0] * v0[0] + v0[1] * v0[1]) + (v0[2] * v0[2] + v0[3] * v0[3]) + (v1[0] * v1[0] + v1[1] * v1[1]) + (v1[2] * v1[2] + v1[3] * v1[3]);
                    *(u32x4*)(dst + (size_t)row * 512 + c0 + bj * 128) = pack8(v0, v1); }
                s += __shfl_xor(s, 16); s += __shfl_xor(s, 32);
                if (fq == 0) ssq[row] = s; EPI_FENCE; }
        } else if (pn == 4) {
            if (wc < 2) {
                EPI_LOOP { const int row = tok0 + EPI_ROW; const float* cs = cs_mla + (size_t)row * 64 + cb;
                    const f32x4 csA = *(const f32x4*)cs, csB = *(const f32x4*)(cs + 4);
                    *(u32x4*)(KR + (size_t)row * 64 + cb) = pack8(rot_il(acc[ai][0][m][0], csA), rot_il(acc[ai][0][m][1], csB)); EPI_FENCE; }
            }
        } else if (pn < 21) {
            const bool isq = pn < 13; const int h = isq ? pn - 5 : pn - 13;
            const int blk = ((u.pm >> 4) * 8 + h) * NCH + (u.pm & 15);
            const float lf = dectab[h], lb = dectab[8 + h];
            EPI_LOOP { const int c = EPI_ROW, row = tok0 + c; const float* cs = cs_ret + (size_t)row * 256 + cb * 2;
                f32x4 q1[2], q2[2];
#pragma unroll
                for (int n = 0; n < 2; ++n) { const f32x4 csA = *(const f32x4*)(cs + n * 8), csB = *(const f32x4*)(cs + n * 8 + 4); rot4(acc[ai][0][m][n], acc[ai][1][m][n], csA, csB, q1[n], q2[n]); }
                if (isq) {
                    const float xf = __builtin_amdgcn_exp2f((float)(c + 1) * lf), xb = __builtin_amdgcn_exp2f((float)(CH - c) * lb);
                    bf16_t* base = ACAT + ((size_t)blk * 256 + c) * 768 + cb;
                    *(u32x4*)(base + 256) = pack8(q1[0] * xf, q1[1] * xf); *(u32x4*)(base + 384) = pack8(q2[0] * xf, q2[1] * xf);
                    *(u32x4*)(base + 512) = pack8(q1[0] * xb, q1[1] * xb); *(u32x4*)(base + 640) = pack8(q2[0] * xb, q2[1] * xb);
                } else {
                    bf16_t* base = KROT + ((size_t)blk * 256 + c) * 256 + cb;
                    *(u32x4*)(base) = pack8(q1[0] * 0.0625f, q1[1] * 0.0625f); *(u32x4*)(base + 128) = pack8(q2[0] * 0.0625f, q2[1] * 0.0625f);
                }
                EPI_FENCE; }
        } else {
            const int g = (pn - 21) >> 3, ct = (pn - 21) & 7; bf16_t* dst = SG + (size_t)g * ((WS_GA - WS_SG) / 2);
            EPI_LOOP { const int row = tok0 + EPI_ROW;
#pragma unroll
                for (int bj = 0; bj < 2; ++bj) { f32x4 v[2];
#pragma unroll
                    for (int n = 0; n < 2; ++n)
#pragma unroll
                        for (int j = 0; j < 4; ++j) { const float x = acc[ai][bj][m][n][j] * unscale; const float sg = sigmoidf_(x); v[n][j] = g == 0 ? x * sg : sg; }
                    *(u32x4*)(dst + (size_t)row * 2048 + ct * 256 + bj * 128 + cb) = pack8(v[0], v[1]); }
                EPI_FENCE; }
        }
    }
};
struct EpiVT {
    bf16_t* BCAT; unsigned char* VT8;
    __device__ __forceinline__ void operator()(Acc& acc, const Unit& u, int wr, int wc, int fr, int fq) const {
        asm volatile("" : "+v"(fr), "+v"(fq));
        const int blk = ((u.pn >> 4) * 8 + u.pm) * NCH + (u.pn & 15), cb = wc * 32 + fq * 8;
        EPI_LOOP { bf16_t* base = BCAT + ((size_t)blk * 256 + EPI_ROW) * 768 + cb; unsigned char* b8 = VT8 + ((size_t)blk * 256 + EPI_ROW) * 256 + cb;
#pragma unroll
            for (int bj = 0; bj < 2; ++bj) { const f32x4 v0 = acc[ai][bj][m][0], v1 = acc[ai][bj][m][1]; *(u32x4*)(base + bj * 128) = pack8(v0, v1);
                u32x2 w8; w8.x = pk4_fp8(v0[0], v0[1], v0[2], v0[3], V8_SCALE); w8.y = pk4_fp8(v1[0], v1[1], v1[2], v1[3], V8_SCALE); *(u32x2*)(b8 + bj * 128) = w8; } }
    }
};
struct EpiInprojAll {
    EpiInproj a; EpiVT b;
    __device__ __forceinline__ void operator()(Acc& acc, const Unit& u, int wr, int wc, int fr, int fq) const { if (u.aux) b(acc, u, wr, wc, fr, fq); else a(acc, u, wr, wc, fr, fq); }
};
struct EpiMlaQ {
    bf16_t *QN, *QR; const float* ssq; const float* cs_mla;
    __device__ __forceinline__ void operator()(Acc& acc, const Unit& u, int wr, int wc, int fr, int fq) const {
        asm volatile("" : "+v"(fr), "+v"(fq));
        const int pn = u.pn, tok0 = u.pm * 256, cb = wc * 32 + fq * 8;
        EPI_LOOP { const int row = tok0 + EPI_ROW; float ss = 0.f;
#pragma unroll
            for (int q = 0; q < 8; ++q) ss += ssq[(size_t)q * T + row];
            const float rs = rsqrtf(ss * (1.0f / 512.0f) + RMS_EPS) * QSCALE;
            if (pn < 4) {
#pragma unroll
                for (int bj = 0; bj < 2; ++bj) *(u32x4*)(QN + (size_t)row * 1024 + (2 * pn + bj) * 128 + cb) = pack8(acc[ai][bj][m][0] * rs, acc[ai][bj][m][1] * rs);
            } else {
                const int c0 = (wc & 1) * 32 + fq * 8; const float* cs = cs_mla + (size_t)row * 64 + c0;
                const f32x4 csA = *(const f32x4*)cs, csB = *(const f32x4*)(cs + 4);
#pragma unroll
                for (int bj = 0; bj < 2; ++bj) { const int head = 4 * (pn - 4) + 2 * bj + (wc >> 1);
                    *(u32x4*)(QR + (size_t)row * 512 + head * 64 + c0) = pack8(rot_il(acc[ai][bj][m][0], csA) * rs, rot_il(acc[ai][bj][m][1], csB) * rs); }
            }
            EPI_FENCE; }
    }
};
struct EpiMlaKV {
    bf16_t *KN, *VV; const float* ssq;
    __device__ __forceinline__ void operator()(Acc& acc, const Unit& u, int wr, int wc, int fr, int fq) const {
        asm volatile("" : "+v"(fr), "+v"(fq));
        const int pn = u.pn, tok0 = u.pm * 256, cb = wc * 32 + fq * 8; bf16_t* dst = KN + (size_t)(pn >> 2) * ((WS_VV - WS_KN) / 2); const int hb = 2 * (pn & 3);
        EPI_LOOP { const int row = tok0 + EPI_ROW; float ss = 0.f;
#pragma unroll
            for (int q = 0; q < 8; ++q) ss += ssq[(size_t)q * T + row];
            const float rs = rsqrtf(ss * (1.0f / 512.0f) + RMS_EPS);
#pragma unroll
            for (int bj = 0; bj < 2; ++bj) *(u32x4*)(dst + (size_t)row * 1024 + (hb + bj) * 128 + cb) = pack8(acc[ai][bj][m][0] * rs, acc[ai][bj][m][1] * rs); }
    }
};
struct EpiGa {
    bf16_t* ACAT; const float* dectab;
    __device__ __forceinline__ void operator()(Acc& acc, const Unit& u, int wr, int wc, int fr, int fq) const {
        asm volatile("" : "+v"(fr), "+v"(fq));
        const int blk = u.pm, h = (blk >> 4) & 7, cb = wc * 32 + fq * 8;
        const float lf = dectab[h], lb = dectab[8 + h];
        f32x4 colA[2][2], colB[2][2];
#pragma unroll
        for (int bj = 0; bj < 2; ++bj)
#pragma unroll
            for (int n = 0; n < 2; ++n)
#pragma unroll
                for (int j = 0; j < 4; ++j) { const int mm = bj * 128 + cb + n * 4 + j; colA[bj][n][j] = __builtin_amdgcn_exp2f(-(float)(mm + 1) * lf); colB[bj][n][j] = __builtin_amdgcn_exp2f((float)mm * lb); }
        EPI_LOOP { const int c = EPI_ROW; bf16_t* base = ACAT + ((size_t)blk * 256 + c) * 768 + cb;
            const float rowB = __builtin_amdgcn_exp2f(-(float)c * lb - (float)(c + 1) * lf);
#pragma unroll
            for (int bj = 0; bj < 2; ++bj) { f32x4 v[2];
#pragma unroll
                for (int n = 0; n < 2; ++n)
#pragma unroll
                    for (int j = 0; j < 4; ++j) { const int mm = bj * 128 + cb + n * 4 + j;
                        v[n][j] = acc[ai][bj][m][n][j] * ((c >= mm) ? colA[bj][n][j] : colB[bj][n][j] * rowB); }
                *(u32x4*)(base + bj * 128) = pack8(v[0], v[1]); }
            EPI_FENCE; }
    }
};
struct EpiGb {
    bf16_t* BCAT; const float* dectab; int dir;
    __device__ __forceinline__ void operator()(Acc& acc, const Unit& u, int wr, int wc, int fr, int fq) const {
        asm volatile("" : "+v"(fr), "+v"(fq));
        const int h = (u.pm >> 4) & 7;
        const float gC = __builtin_amdgcn_exp2f((float)CH * dectab[8 * dir + h]);
        if (u.pn < NCH - 1) {
            const int nblk = dir ? u.pm - 1 : u.pm + 1;
            bf16_t* base0 = BCAT + ((size_t)nblk * 256 + wr * 64 + fr) * 768 + 256 + 256 * dir + wc * 32 + fq * 8;
            EPI_LOOP { bf16_t* base = base0 + (size_t)(ai * 128 + m * 16) * 768;
#pragma unroll
                for (int bj = 0; bj < 2; ++bj) *(u32x4*)(base + bj * 128) = pack8(acc[ai][bj][m][0] * CH_UNSCALE, acc[ai][bj][m][1] * CH_UNSCALE); }
        }
        EPI_LOOP {
#pragma unroll
            for (int bj = 0; bj < 2; ++bj) { acc[ai][bj][m][0] *= gC; acc[ai][bj][m][1] *= gC; } }
    }
};
struct EpiGc {
    bf16_t* OB; const bf16_t* SG; const float* gn; LAS unsigned char* lds;
    __device__ __forceinline__ void operator()(Acc& acc, const Unit& u, int wr, int wc, int fr, int fq) const {
        asm volatile("" : "+v"(fr), "+v"(fq));
        const int blk = u.pm, b = blk >> 7, h = (blk >> 4) & 7, n = blk & 15, cb = wc * 32 + fq * 8;
        LAS f32x2* P = (LAS f32x2*)(lds + RING_BYTES);
        EPI_LOOP { float s = 0.f;
#pragma unroll
            for (int bj = 0; bj < 2; ++bj)
#pragma unroll
                for (int nn = 0; nn < 2; ++nn) { const f32x4 x = acc[ai][bj][m][nn]; s += (x[0] + x[1]) + (x[2] + x[3]); }
            s += __shfl_xor(s, 16); s += __shfl_xor(s, 32);
            const float mw = s * (1.0f / 64.0f); float q = 0.f;
#pragma unroll
            for (int bj = 0; bj < 2; ++bj)
#pragma unroll
                for (int nn = 0; nn < 2; ++nn) { const f32x4 d = acc[ai][bj][m][nn] - mw; q += (d[0] * d[0] + d[1] * d[1]) + (d[2] * d[2] + d[3] * d[3]); }
            q += __shfl_xor(q, 16); q += __shfl_xor(q, 32);
            if (fq == 0) P[EPI_ROW * 4 + wc] = (f32x2){mw, q}; }
        asm volatile("s_waitcnt lgkmcnt(0)" ::: "memory"); __builtin_amdgcn_s_barrier(); asm volatile("" ::: "memory");
        EPI_LOOP { const int row = EPI_ROW; const f32x4 p01 = *(const LAS f32x4*)(P + row * 4), p23 = *(const LAS f32x4*)(P + row * 4 + 2);
            const float mean = ((p01[0] + p01[2]) + (p23[0] + p23[2])) * 0.25f;
            const float d0 = p01[0] - mean, d1 = p01[2] - mean, d2 = p23[0] - mean, d3 = p23[2] - mean;
            const float m2 = ((p01[1] + p01[3]) + (p23[1] + p23[3])) + 64.0f * ((d0 * d0 + d1 * d1) + (d2 * d2 + d3 * d3));
            const float rstd = rsqrtf(m2 * (1.0f / 256.0f) + GN_EPS);
            const size_t off = ((size_t)b * SEQ + n * 256 + row) * 2048 + h * 256 + cb;
#pragma unroll
            for (int bj = 0; bj < 2; ++bj) { f32x4 s0, s1; unpack8(*(const u32x4*)(SG + off + bj * 128), s0, s1);
                const f32x4 g0 = *(const f32x4*)(gn + h * 256 + bj * 128 + cb), g1 = *(const f32x4*)(gn + h * 256 + bj * 128 + cb + 4);
                *(u32x4*)(OB + off + bj * 128) = pack8(s0 * ((acc[ai][bj][m][0] - mean) * rstd * g0), s1 * ((acc[ai][bj][m][1] - mean) * rstd * g1)); }
            EPI_FENCE; }
    }
};
struct EpiMixA {
    bf16_t* MIXP; const bf16_t* GA;
    __device__ __forceinline__ void operator()(Acc& acc, const Unit& u, int wr, int wc, int fr, int fq) const {
        asm volatile("" : "+v"(fr), "+v"(fq));
        const int cb = wc * 32 + fq * 8;
        EPI_LOOP { const size_t off = (size_t)(u.pm * 256 + EPI_ROW) * 2048 + u.pn * 256 + cb;
#pragma unroll
            for (int bj = 0; bj < 2; ++bj) { f32x4 g0, g1; unpack8(*(const u32x4*)(GA + off + bj * 128), g0, g1);
                *(u32x4*)(MIXP + off + bj * 128) = pack8(acc[ai][bj][m][0] * g0, acc[ai][bj][m][1] * g1); }
            EPI_FENCE; }
    }
};
struct EpiMixB {
    bf16_t* MIXIN; const bf16_t* MIXP; const bf16_t* GB;
    __device__ __forceinline__ void operator()(Acc& acc, const Unit& u, int wr, int wc, int fr, int fq) const {
        asm volatile("" : "+v"(fr), "+v"(fq));
        const int cb = wc * 32 + fq * 8;
        EPI_LOOP { const size_t off = (size_t)(u.pm * 256 + EPI_ROW) * 2048 + u.pn * 256 + cb;
#pragma unroll
            for (int bj = 0; bj < 2; ++bj) { f32x4 g0, g1, p0, p1; unpack8(*(const u32x4*)(GB + off + bj * 128), g0, g1); unpack8(*(const u32x4*)(MIXP + off + bj * 128), p0, p1);
                *(u32x4*)(MIXIN + off + bj * 128) = pack8(acc[ai][bj][m][0] * g0 + p0, acc[ai][bj][m][1] * g1 + p1); }
            EPI_FENCE; }
    }
};
struct EpiF32 {
    bf16_t* C;
    __device__ __forceinline__ void operator()(Acc& acc, const Unit& u, int wr, int wc, int fr, int fq) const {
        asm volatile("" : "+v"(fr), "+v"(fq));
        const int cb = wc * 32 + fq * 8;
        EPI_LOOP { bf16_t* base = C + (size_t)(u.pm * 256 + EPI_ROW) * 2048 + u.pn * 256 + cb;
#pragma unroll
            for (int bj = 0; bj < 2; ++bj) *(u32x4*)(base + bj * 128) = pack8(acc[ai][bj][m][0], acc[ai][bj][m][1]); }
    }
};
struct EpiGU {
    bf16_t* ACT; const float* bgu; int skip;
    __device__ __forceinline__ void operator()(Acc& acc, const Unit& u, int wr, int wc, int fr, int fq) const {
        asm volatile("" : "+v"(fr), "+v"(fq));
        if (skip) return;
        const int cb = wc * 32 + fq * 8, col = u.pn * 128 + cb; const float* bg = bgu + (size_t)u.aux * 4096 + col;
        const f32x4 bg0 = *(const f32x4*)bg, bg1 = *(const f32x4*)(bg + 4), bu0 = *(const f32x4*)(bg + 2048), bu1 = *(const f32x4*)(bg + 2052);
        EPI_LOOP { f32x4 v[2];
#pragma unroll
            for (int n = 0; n < 2; ++n)
#pragma unroll
                for (int j = 0; j < 4; ++j) { const float gt = fminf(acc[ai][0][m][n][j] * GU_UNSCALE + (n ? bg1[j] : bg0[j]), 7.0f); const float up = fminf(fmaxf(acc[ai][1][m][n][j] * GU_UNSCALE + (n ? bu1[j] : bu0[j]), -7.0f), 7.0f);
                    v[n][j] = (up + 1.0f) * gt * sigmoidf_(1.702f * gt); }
            u32x2 w8; w8.x = pk4_fp8(v[0][0], v[0][1], v[0][2], v[0][3], A8_SCALE); w8.y = pk4_fp8(v[1][0], v[1][1], v[1][2], v[1][3], A8_SCALE);
            *(u32x2*)((unsigned char*)ACT + (size_t)(u.pm * 256 + EPI_ROW) * 2048 + col) = w8; EPI_FENCE; }
    }
};
struct EpiDown {
    bf16_t* YS; const float* bd;
    __device__ __forceinline__ void operator()(Acc& acc, const Unit& u, int wr, int wc, int fr, int fq) const {
        asm volatile("" : "+v"(fr), "+v"(fq));
        const int cb = wc * 32 + fq * 8; const float* bp = bd + (size_t)u.aux * 2048 + u.pn * 256 + cb;
        f32x4 bv[2][2];
#pragma unroll
        for (int bj = 0; bj < 2; ++bj) { bv[bj][0] = *(const f32x4*)(bp + bj * 128); bv[bj][1] = *(const f32x4*)(bp + bj * 128 + 4); }
        EPI_LOOP { bf16_t* base = YS + (size_t)(u.pm * 256 + EPI_ROW) * 2048 + u.pn * 256 + cb;
#pragma unroll
            for (int bj = 0; bj < 2; ++bj) *(u32x4*)(base + bj * 128) = pack8(acc[ai][bj][m][0] * DN_UNSCALE + bv[bj][0], acc[ai][bj][m][1] * DN_UNSCALE + bv[bj][1]); }
    }
};

namespace att {
constexpr int NW = 8, QBLK = 32, KVBLK = 64;
constexpr float THR = 8.f;
constexpr int SHM_V = KVBLK * 128 * 2, SHM_KN = KVBLK * 128 * 2, SHM_KR = KVBLK * 64 * 2, NVB = 3, SHM_ATTN = NVB * SHM_V + 2 * SHM_KN + 2 * SHM_KR + NW * 64 * 4;
#define KSWZ(row, colB) ((row) * 256 + ((colB) ^ (((row) & 7) << 4)))
#define KSWZR(row, colB) ((row) * 128 + ((colB) ^ (((row) & 7) << 4)))
#define SBAR() __builtin_amdgcn_sched_barrier(0)
__device__ __forceinline__ int crow(int r, int hi) { return (r & 3) + 8 * (r >> 2) + 4 * hi; }
__device__ __forceinline__ void partialSM(f32x16& p0, f32x16& p1, float& m_reg, float& mn, float& alpha) {
    constexpr float C = 1.4426950408889634f;
    float pmax = p0[0];
#pragma unroll
    for (int r = 1; r < 16; ++r) pmax = fmaxf(pmax, p0[r]);
#pragma unroll
    for (int r = 0; r < 16; ++r) pmax = fmaxf(pmax, p1[r]);
    { auto rr = __builtin_amdgcn_permlane32_swap(__float_as_uint(pmax), __float_as_uint(pmax), false, false);
      pmax = fmaxf(__uint_as_float(rr[0]), __uint_as_float(rr[1])); }
    if (__builtin_expect(__all(pmax - m_reg <= THR), 1)) { mn = m_reg; alpha = 1.f; }
    else { mn = fmaxf(m_reg, pmax); alpha = __builtin_amdgcn_exp2f((m_reg - mn) * C); m_reg = mn; }
    const float mnC = -mn * C;
#pragma unroll
    for (int r = 0; r < 16; ++r) p0[r] = fmaf(p0[r], C, mnC);
#pragma unroll
    for (int r = 0; r < 16; ++r) p1[r] = fmaf(p1[r], C, mnC);
#pragma unroll
    for (int r = 0; r < 16; ++r) p0[r] = __builtin_amdgcn_exp2f(p0[r]);
}
__device__ __forceinline__ void finishSM(f32x16& p0, f32x16& p1, float alpha, float& l_reg, bf16x8& pa0, bf16x8& pa1, bf16x8& pa2, bf16x8& pa3) {
#pragma unroll
    for (int r = 0; r < 16; ++r) p1[r] = __builtin_amdgcn_exp2f(p1[r]);
    float ps = 0;
#pragma unroll
    for (int r = 0; r < 16; ++r) ps += p0[r];
#pragma unroll
    for (int r = 0; r < 16; ++r) ps += p1[r];
    { auto rr = __builtin_amdgcn_permlane32_swap(__float_as_uint(ps), __float_as_uint(ps), false, false);
      ps = __uint_as_float(rr[0]) + __uint_as_float(rr[1]); }
    l_reg = l_reg * alpha + ps;
#define PK4(P, BASE, OUT) do { unsigned a0 = cvt_pk_bf16(P[BASE + 0], P[BASE + 1]), a1 = cvt_pk_bf16(P[BASE + 2], P[BASE + 3]);   \
    unsigned b0 = cvt_pk_bf16(P[BASE + 4], P[BASE + 5]), b1 = cvt_pk_bf16(P[BASE + 6], P[BASE + 7]);                              \
    auto r0 = __builtin_amdgcn_permlane32_swap(a0, b0, false, false); auto r1 = __builtin_amdgcn_permlane32_swap(a1, b1, false, false); \
    u32x4 w = {r0[0], r1[0], r0[1], r1[1]}; OUT = *reinterpret_cast<bf16x8*>(&w); } while (0)
    PK4(p0, 0, pa0); PK4(p0, 8, pa1); PK4(p1, 0, pa2); PK4(p1, 8, pa3);
#undef PK4
}
__device__ __forceinline__ void qkt(f32x16& p0, f32x16& p1, const char* Kns, const char* Krs, const bf16x8* qr, int r32, int hi) {
    p0 = f32x16{}; p1 = f32x16{};
#pragma unroll
    for (int d0 = 0; d0 < 12; ++d0) { const int cb = ((d0 & 7) * 16 + hi * 8) * 2;
        const bf16x8 b0 = *reinterpret_cast<const bf16x8*>(d0 < 8 ? Kns + KSWZ(r32, cb) : Krs + KSWZR(r32, cb));
        const bf16x8 b1 = *reinterpret_cast<const bf16x8*>(d0 < 8 ? Kns + KSWZ(32 + r32, cb) : Krs + KSWZR(32 + r32, cb));
        p0 = __builtin_amdgcn_mfma_f32_32x32x16_bf16(b0, qr[d0], p0, 0, 0, 0);
        p1 = __builtin_amdgcn_mfma_f32_32x32x16_bf16(b1, qr[d0], p1, 0, 0, 0); }
}
__device__ __forceinline__ int v_st(int k, int c) { const int kk = (k & ~0xC) | ((k & 4) << 1) | ((k & 8) >> 1); return ((kk >> 3) * 4 + (c >> 5)) * 512 + ((kk & 7) * 32 + (c & 31)) * 2; }
__device__ __forceinline__ int v_rd_base(int lane) { return ((lane & 3) << 3) | (((lane >> 2) & 3) << 6) | (((lane >> 4) & 1) << 5) | (((lane >> 5) & 1) << 8); }
constexpr int v_rd_off(int d0, int ks, int half) { return d0 * 512 + ks * 4096 + half * 2048; }
template <int OFF> __device__ __forceinline__ s16x4 tr_read(int vb) {
    s16x4 r; asm volatile("ds_read_b64_tr_b16 %0, %1 offset:%2" : "=&v"(r) : "v"(vb), "i"(OFF) : "memory"); return r;
}
template <int D0> __device__ __forceinline__ void pv_one(f32x16& od, int vb, bf16x8 pa0, bf16x8 pa1, bf16x8 pa2, bf16x8 pa3) {
    const s16x4 l0 = tr_read<v_rd_off(D0, 0, 0)>(vb), h0 = tr_read<v_rd_off(D0, 0, 1)>(vb), l1 = tr_read<v_rd_off(D0, 1, 0)>(vb), h1 = tr_read<v_rd_off(D0, 1, 1)>(vb);
    const s16x4 l2 = tr_read<v_rd_off(D0, 2, 0)>(vb), h2 = tr_read<v_rd_off(D0, 2, 1)>(vb), l3 = tr_read<v_rd_off(D0, 3, 0)>(vb), h3 = tr_read<v_rd_off(D0, 3, 1)>(vb);
    asm volatile("s_waitcnt lgkmcnt(0)" ::: "memory"); SBAR();
#define PKV(L, H) (bf16x8){L[0], L[1], L[2], L[3], H[0], H[1], H[2], H[3]}
    od = __builtin_amdgcn_mfma_f32_32x32x16_bf16(pa0, PKV(l0, h0), od, 0, 0, 0);
    od = __builtin_amdgcn_mfma_f32_32x32x16_bf16(pa1, PKV(l1, h1), od, 0, 0, 0);
    od = __builtin_amdgcn_mfma_f32_32x32x16_bf16(pa2, PKV(l2, h2), od, 0, 0, 0);
    od = __builtin_amdgcn_mfma_f32_32x32x16_bf16(pa3, PKV(l3, h3), od, 0, 0, 0);
#undef PKV
}
__device__ __forceinline__ void pv_d0(f32x16* o, int vb, bf16x8 pa0, bf16x8 pa1, bf16x8 pa2, bf16x8 pa3) {
    pv_one<0>(o[0], vb, pa0, pa1, pa2, pa3); pv_one<1>(o[1], vb, pa0, pa1, pa2, pa3); pv_one<2>(o[2], vb, pa0, pa1, pa2, pa3); pv_one<3>(o[3], vb, pa0, pa1, pa2, pa3);
}
__device__ __forceinline__ void attn_unit(const bf16_t* __restrict__ Qn, const bf16_t* __restrict__ Qr, const bf16_t* __restrict__ Kn, const bf16_t* __restrict__ Kr,
                                          const bf16_t* __restrict__ Vh, bf16_t* __restrict__ Ob, int seq, char* lds) {
    const int tid = threadIdx.x, wid = __builtin_amdgcn_readfirstlane(tid >> 6), lane = tid & 63, r32 = lane & 31, hi = lane >> 5;
    char* V_lds = lds; char* Kn_lds = lds + NVB * SHM_V; char* Kr_lds = Kn_lds + 2 * SHM_KN;
    float* ws = (float*)(Kr_lds + 2 * SHM_KR) + wid * 64; float* li_l = ws; float* al_l = ws + 32;
    float m_reg = -1e30f, l_reg = 0; f32x16 o[4] = {}; bf16x8 qr[12];
    { const bf16_t* q0 = Qn + (long)(wid * QBLK + r32) * 1024 + hi * 8; const bf16_t* q1 = Qr + (long)(wid * QBLK + r32) * 512 + hi * 8;
#pragma unroll
      for (int d0 = 0; d0 < 8; ++d0) qr[d0] = *reinterpret_cast<const bf16x8*>(q0 + d0 * 16);
#pragma unroll
      for (int d0 = 0; d0 < 4; ++d0) qr[8 + d0] = *reinterpret_cast<const bf16x8*>(q1 + d0 * 16); }
    const int vb0 = (int)(uintptr_t)V_lds + v_rd_base(lane);
    unsigned offV[2], offKn[2], offKr;
#pragma unroll
    for (int t = 0; t < 2; ++t) {
        { const int sub = 2 * (2 * wid + t) + (lane >> 5), kk = (sub >> 2) * 8 + ((lane & 31) >> 2), k = (kk & ~0xC) | ((kk & 4) << 1) | ((kk & 8) >> 1), c = (sub & 3) * 32 + (lane & 3) * 8; offV[t] = (unsigned)(k * 1024 + c) * 2u; }
        { const int row = 4 * (2 * wid + t) + (lane >> 4), colB = ((lane & 15) * 16) ^ ((row & 7) << 4); offKn[t] = (unsigned)(row * 1024) * 2u + (unsigned)colB; } }
    { const int row = 8 * wid + (lane >> 3), colB = ((lane & 7) * 16) ^ ((row & 7) << 4); offKr = (unsigned)(row * 64) * 2u + (unsigned)colB; }
#define LASP(p) ((LAS unsigned*)(unsigned)(uintptr_t)(p))
#define SLOAD(k0, b, bv) do { _Pragma("unroll") for (int t = 0; t < 2; ++t) { \
        __builtin_amdgcn_global_load_lds((const unsigned*)((const char*)Vh + (size_t)(k0) * 2048 + offV[t]), LASP(V_lds + (bv) * SHM_V + (2 * wid + t) * 1024), 16, 0, 0); \
        __builtin_amdgcn_global_load_lds((const unsigned*)((const char*)Kn + (size_t)(k0) * 2048 + offKn[t]), LASP(Kn_lds + (b) * SHM_KN + (2 * wid + t) * 1024), 16, 0, 0); } \
        __builtin_amdgcn_global_load_lds((const unsigned*)((const char*)Kr + (size_t)(k0) * 128 + offKr), LASP(Kr_lds + (b) * SHM_KR + wid * 1024), 16, 0, 0); } while (0)
#define SWAIT() asm volatile("s_waitcnt vmcnt(0)" ::: "memory")
#define RESC(a) do { if (__any((a) < 1.f)) { if (hi == 0) al_l[r32] = (a); asm volatile("s_waitcnt lgkmcnt(0)" ::: "memory"); \
    _Pragma("unroll") for (int d = 0; d < 4; ++d) _Pragma("unroll") for (int r = 0; r < 16; ++r) o[d][r] *= al_l[crow(r, hi)]; } } while (0)
    f32x16 p0, p1; float mn, al; bf16x8 pa0, pa1, pa2, pa3; const int NT = seq / KVBLK;
    SLOAD(0, 0, 0); SWAIT(); __syncthreads();
    if (wid < 4) {
        int bv = 0;
        for (int j = 0; j < NT; ++j) {
            const int buf = j & 1, bvn = bv == NVB - 1 ? 0 : bv + 1;
            if (j + 1 < NT) SLOAD((j + 1) * KVBLK, buf ^ 1, bvn);
            SBAR(); qkt(p0, p1, Kn_lds + buf * SHM_KN, Kr_lds + buf * SHM_KR, qr, r32, hi);
            partialSM(p0, p1, m_reg, mn, al);
            RESC(al);
            finishSM(p0, p1, al, l_reg, pa0, pa1, pa2, pa3); SBAR();
            pv_d0(o, vb0 + bv * SHM_V, pa0, pa1, pa2, pa3);
            SWAIT();
            __syncthreads();
            bv = bvn;
        }
    } else {
        int bv = 0, bvp = 0;
        for (int j = 0; j < NT; ++j) {
            const int buf = j & 1, bvn = bv == NVB - 1 ? 0 : bv + 1;
            if (j + 1 < NT) SLOAD((j + 1) * KVBLK, buf ^ 1, bvn);
            if (j > 0) { SBAR(); pv_d0(o, vb0 + bvp * SHM_V, pa0, pa1, pa2, pa3); SBAR(); }
            SBAR(); qkt(p0, p1, Kn_lds + buf * SHM_KN, Kr_lds + buf * SHM_KR, qr, r32, hi);
            partialSM(p0, p1, m_reg, mn, al);
            RESC(al);
            finishSM(p0, p1, al, l_reg, pa0, pa1, pa2, pa3); SBAR();
            SWAIT();
            __syncthreads();
            bvp = bv; bv = bvn;
        }
        SBAR(); pv_d0(o, vb0 + bvp * SHM_V, pa0, pa1, pa2, pa3);
    }
    if (hi == 0) li_l[r32] = l_reg; asm volatile("s_waitcnt lgkmcnt(0)" ::: "memory");
    float rli[16];
#pragma unroll
    for (int r = 0; r < 16; ++r) rli[r] = __builtin_amdgcn_rcpf(li_l[crow(r, hi)]);
    bf16_t* Ow = Ob + (long)(wid * QBLK) * 1024;
#pragma unroll
    for (int r = 0; r < 16; ++r) { const int orow = crow(r, hi);
#pragma unroll
        for (int d0 = 0; d0 < 4; ++d0) Ow[(long)orow * 1024 + d0 * 32 + r32] = (bf16_t)(cvt_pk_bf16(o[d0][r] * rli[r], 0.f) & 0xffffu); }
#undef SLOAD
#undef LASP
#undef SWAIT
#undef RESC
}
}

struct Args { const float* in[26]; float* out; unsigned char* ws; int ph_lo, ph_hi; };
enum { PH_SETUP = 0, PH_H, PH_INPROJ, PH_INPROJ_V, PH_KT, PH_CHAIN, PH_MLAQ, PH_MLAKV, PH_GA, PH_ATTN, PH_GC, PH_MIXA, PH_GN, PH_MIXB, PH_MIX, PH_ROUTER, PH_DISPATCH, PH_GU, PH_DOWN, PH_COMBINE, NPH };
enum { I_X = 0, I_C, I_POS, I_WADA, I_BADA, I_GPREM, I_GPOSTM, I_GPREF, I_GPOSTF, I_WIN, I_QAN, I_WQB, I_KVAN, I_WKVB, I_WMLAO, I_DECF, I_DECB, I_RETGN, I_WRETO, I_WOUT, I_WROUTER, I_BROUTER, I_WGU, I_BGU, I_WDOWN, I_BDOWN };

__device__ __forceinline__ int src_in(int r) {
    if (r < 1024) return r;
    if (r < 1088) { const int j = r - 1024; return 1024 + (j >> 1) + 32 * (j & 1); }
    if (r < 1280) return -1;
    if (r < N_IN_NAT) { const int g = (r - 1280) >> 11, off = (r - 1280) & 2047; const int base = g == 0 ? 1088 : (g == 1 ? 3136 : (g == 2 ? 7232 : (g == 3 ? 9280 : 11328))); return base + off; }
    return 5184 + (r - N_IN_NAT);
}
__device__ __forceinline__ int src_qb(int r) { if (r < 1024) return (r >> 7) * 192 + (r & 127); const int j = r - 1024, h = j >> 6, jj = j & 63; return h * 192 + 128 + (jj >> 1) + 32 * (jj & 1); }
__device__ __forceinline__ int src_kvb(int r) { if (r < 1024) return (r >> 7) * 256 + (r & 127); const int j = r - 1024; return (j >> 7) * 256 + 128 + (j & 127); }
__device__ __forceinline__ int src_gu(int r) { const int t = r >> 8, rr = r & 255; return rr < 128 ? 128 * t + rr : 2048 + 128 * t + rr - 128; }

__device__ __forceinline__ void cvt_item(const float* __restrict__ W, int ldw, int K, bf16_t* __restrict__ WT, const float* __restrict__ kscale, int sc, int k0, int r0, LAS float* scr, int lane) {
    float v[64];
    const float* wp = W + (size_t)k0 * ldw + (sc >= 0 ? sc : 0);
#pragma unroll
    for (int i = 0; i < 64; ++i) v[i] = wp[(size_t)i * ldw];
    if (sc < 0) {
#pragma unroll
        for (int i = 0; i < 64; ++i) v[i] = 0.f;
    }
    if (kscale) {
#pragma unroll
        for (int i = 0; i < 64; ++i) v[i] *= kscale[k0 + i];
    }
#pragma unroll
    for (int i = 0; i < 64; ++i) scr[i * 65 + lane] = v[i];
    asm volatile("s_waitcnt lgkmcnt(0)" ::: "memory");
    const int c = lane & 7;
#pragma unroll
    for (int j = 0; j < 8; ++j) { const int n = (lane >> 3) + 8 * j; const LAS float* s = scr + (8 * c) * 65 + n;
        u32x4 o; o.x = cvt_pk_bf16(s[0 * 65], s[1 * 65]); o.y = cvt_pk_bf16(s[2 * 65], s[3 * 65]); o.z = cvt_pk_bf16(s[4 * 65], s[5 * 65]); o.w = cvt_pk_bf16(s[6 * 65], s[7 * 65]);
        *(u32x4*)(WT + (size_t)(r0 + n) * K + k0 + 8 * c) = o; }
    asm volatile("s_waitcnt lgkmcnt(0)" ::: "memory");
}

constexpr int XT_NT_GU = 32 * 16 * 16, XT_NT_ALL = XT_NT_GU + 32 * 16 * 8;
__device__ __forceinline__ void xt_convert_tiles(int q0, const int qs, const int qe, const float* __restrict__ wgu, const float* __restrict__ wdn, bf16_t* WT_GU, bf16_t* WT_DOWN, LAS unsigned char* lds, const int lane, const int wave) {
    constexpr int NT_GU = XT_NT_GU, TS = 144;
    f32x4 va[16], vb[16], vc[16];
#define XT_SRC(q_, kk_) ((q_) < NT_GU ? wgu + ((size_t)((q_) >> 8) * 2048 + (((q_) >> 4) & 15) * 128 + 16 * wave + (kk_)) * 4096 + (lane < 32 ? 128 * ((q_) & 15) + 4 * lane : 2048 + 128 * ((q_) & 15) + 4 * lane - 128) \
                                  : wdn + ((size_t)(((q_) - NT_GU) >> 7) * 2048 + ((((q_) - NT_GU) >> 3) & 15) * 128 + 16 * wave + (kk_)) * 2048 + 256 * (((q_) - NT_GU) & 7) + 4 * lane)
#define XT_LOAD(v_, q_) do { const float* _p = XT_SRC(q_, 0); const size_t _ld = (q_) < NT_GU ? 4096 : 2048; _Pragma("unroll") for (int kk = 0; kk < 16; ++kk) v_[kk] = __builtin_nontemporal_load((const f32x4*)(_p + kk * _ld)); } while (0)
#define XT_PROC(v_, q_, buf_) do { LAS unsigned char* _T = lds + (buf_) * (256 * TS); \
        _Pragma("unroll") for (int i = 0; i < 4; ++i) { u32x4 w0; \
            w0.x = pk4_fp8(v_[0][i], v_[1][i], v_[2][i], v_[3][i], W8_SCALE); w0.y = pk4_fp8(v_[4][i], v_[5][i], v_[6][i], v_[7][i], W8_SCALE); \
            w0.z = pk4_fp8(v_[8][i], v_[9][i], v_[10][i], v_[11][i], W8_SCALE); w0.w = pk4_fp8(v_[12][i], v_[13][i], v_[14][i], v_[15][i], W8_SCALE); \
            *(LAS u32x4*)(_T + (4 * lane + i) * TS + 16 * wave) = w0; } \
        __syncthreads(); \
        unsigned char* _d = (q_) < NT_GU ? (unsigned char*)WT_GU + ((size_t)((q_) >> 8) * 4096 + 256 * ((q_) & 15)) * 2048 + (((q_) >> 4) & 15) * 128 \
                 : (unsigned char*)WT_DOWN + ((size_t)(((q_) - NT_GU) >> 7) * 2048 + 256 * (((q_) - NT_GU) & 7)) * 2048 + ((((q_) - NT_GU) >> 3) & 15) * 128; \
        _Pragma("unroll") for (int j = 0; j < 4; ++j) { const int row = 32 * wave + 8 * j + (lane >> 3); \
            const u32x4 o = *(const LAS u32x4*)(_T + row * TS + (lane & 7) * 16); __builtin_nontemporal_store(o, (u32x4*)(_d + (size_t)row * 2048 + (lane & 7) * 16)); } } while (0)
    int q = q0;
    if (q < qe) XT_LOAD(va, q);
    if (q + qs < qe) XT_LOAD(vb, q + qs);
    while (q < qe) {
        const int q1 = q + qs, q2 = q1 + qs, q3 = q2 + qs, q4 = q3 + qs;
        if (q2 < qe) XT_LOAD(vc, q2);
        XT_PROC(va, q, 0);
        if (q1 >= qe) break;
        if (q3 < qe) XT_LOAD(va, q3);
        XT_PROC(vb, q1, 1);
        if (q2 >= qe) break;
        if (q4 < qe) XT_LOAD(vb, q4);
        XT_PROC(vc, q2, 2);
        q = q3;
    }
    __syncthreads();
#undef XT_SRC
#undef XT_LOAD
#undef XT_PROC
}
__host__ __device__ constexpr bool is_seam(int k) { return k == PH_SETUP || k == PH_H || k == PH_INPROJ_V || k == PH_KT || k == PH_GA || k == PH_ATTN || k == PH_MIXA || k == PH_MIXB || k == PH_MIX || k == PH_ROUTER || k == PH_DISPATCH || k == PH_GU || k == PH_DOWN; }
__host__ __device__ constexpr int seam_after(int ph) { int k = ph; while (k < NPH && !is_seam(k)) ++k; return k; }
__host__ __device__ constexpr int seam_before(int ph) { int k = ph - 1; while (k >= 0 && !is_seam(k)) --k; return k; }
__device__ __forceinline__ const void* larg(volatile LAS unsigned long long* L, int i) {
    const unsigned long long v = L[i]; const unsigned l0 = __builtin_amdgcn_readfirstlane((unsigned)v), h0 = __builtin_amdgcn_readfirstlane((unsigned)(v >> 32));
    return (const void*)(const __attribute__((address_space(1))) void*)(((unsigned long long)h0 << 32) | l0);
}
__global__ void __launch_bounds__(512, 2) fwd_kernel(Args args) {
    extern __shared__ __attribute__((aligned(16))) unsigned char lds_raw[];
    LAS unsigned char* lds = (LAS unsigned char*)lds_raw;
    volatile LAS unsigned* MISC = (volatile LAS unsigned*)(lds + MISC_OFF);
    const int tid = threadIdx.x;
    const int G = gridDim.x, bx = blockIdx.x, NGW = G * 8;
    volatile LAS unsigned long long* LARG = (volatile LAS unsigned long long*)(lds + LARG_OFF);
    const int lo = args.ph_lo, hi = args.ph_hi;
    for (int u = tid; u < (LDS_BYTES - CTRL_OFF) / 4; u += 512) ((LAS unsigned*)(lds + CTRL_OFF))[u] = 0u;
    __syncthreads();
    if (tid == 0) {
#pragma unroll
        for (int i = 0; i < 26; ++i) LARG[i] = (unsigned long long)args.in[i];
        LARG[26] = (unsigned long long)args.out; LARG[27] = (unsigned long long)args.ws;
    }
    __syncthreads();
    unsigned bar_x = 0u;
    if (hi - lo > 1) bar_x = xcd_barrier_post((unsigned*)(args.ws + WS_CTL) + CW_BAR, MISC + 8).x;
#ifdef PH_ONLY
#define IN(k) ((k) == PH_ONLY && lo <= (k) && (k) < hi)
#else
#define IN(k) (lo <= (k) && (k) < hi)
#endif
#define SEAM(k) do { if (lo <= (k) && (k) + 1 < hi) { XcdBarrier _b; _b.bar = (unsigned*)((unsigned char*)larg(LARG, 27) + WS_CTL) + CW_BAR; _b.x = bar_x; _b.st = MISC + 8; xcd_barrier(_b); } if (STAMP_PHASE >= 0) { const unsigned long long _t = __builtin_amdgcn_s_memrealtime(); if (seam_after(STAMP_PHASE) == (k)) st_dt = _t - st_t0; if (seam_before(STAMP_PHASE) == (k)) st_t0 = _t; } } while (0)
#define INP(i) ((const float*)larg(LARG, (i)))
#ifndef REP_PHASE
#define REP_PHASE (-1)
#endif
#define NREP(k) ((k) == REP_PHASE ? 2 : 1)
#ifndef STAMP_PHASE
#define STAMP_PHASE (-1)
#endif
#ifndef STAMP_MUL
#define STAMP_MUL 4
#endif
    unsigned long long st_t0 = (STAMP_PHASE >= 0 && seam_before(STAMP_PHASE) < 0) ? __builtin_amdgcn_s_memrealtime() : 0ull, st_dt = 0ull;
#define PTRS \
    int tid = threadIdx.x; asm volatile("" : "+v"(tid)); const int lane = tid & 63, wave = __builtin_amdgcn_readfirstlane(tid >> 6), gw = bx * 8 + wave; (void)lane; (void)gw; \
    unsigned char* const ws = (unsigned char*)larg(LARG, 27); unsigned* const ctl = (unsigned*)(ws + WS_CTL); float* const outp = (float*)larg(LARG, 26); \
    float* const ada = (float*)(ctl + CW_ADA); float* const SSQP = (float*)(ws + WS_SSQP); \
    bf16_t* const WT_IN = (bf16_t*)(ws + WS_WT_IN); bf16_t* const WT_QB = (bf16_t*)(ws + WS_WT_QB); bf16_t* const WT_KVB = (bf16_t*)(ws + WS_WT_KVB); bf16_t* const WT_MLAO = (bf16_t*)(ws + WS_WT_MLAO); \
    bf16_t* const WT_RETO = (bf16_t*)(ws + WS_WT_RETO); bf16_t* const WT_OUT = (bf16_t*)(ws + WS_WT_OUT); bf16_t* const WT_GU = (bf16_t*)(ws + WS_WT_GU); bf16_t* const WT_DOWN = (bf16_t*)(ws + WS_WT_DOWN); \
    float* const CS_RET = (float*)(ws + WS_CS_RET); float* const CS_MLA = (float*)(ws + WS_CS_MLA); \
    bf16_t* const Hb = (bf16_t*)(ws + WS_H); bf16_t* const QL = (bf16_t*)(ws + WS_QL); bf16_t* const CKV = (bf16_t*)(ws + WS_CKV); bf16_t* const KR = (bf16_t*)(ws + WS_KR); \
    bf16_t* const ACAT = (bf16_t*)(ws + WS_ACAT); bf16_t* const BCAT = (bf16_t*)(ws + WS_BCAT); bf16_t* const KROT = (bf16_t*)(ws + WS_KROT); bf16_t* const KZTF = (bf16_t*)(ws + WS_KZTF); bf16_t* const KZTB = (bf16_t*)(ws + WS_KZTB); \
    bf16_t* const SG = (bf16_t*)(ws + WS_SG); bf16_t* const GA = (bf16_t*)(ws + WS_GA); bf16_t* const GB = (bf16_t*)(ws + WS_GB); \
    bf16_t* const QN = (bf16_t*)(ws + WS_QN); bf16_t* const QR = (bf16_t*)(ws + WS_QR); bf16_t* const KN = (bf16_t*)(ws + WS_KN); bf16_t* const VV = (bf16_t*)(ws + WS_VV); bf16_t* const OA = (bf16_t*)(ws + WS_OA); \
    float* const ORET = (float*)(ws + WS_ORET); bf16_t* const OB = (bf16_t*)(ws + WS_OB); bf16_t* const MIXP = (bf16_t*)(ws + WS_MIXP); bf16_t* const MIXIN = (bf16_t*)(ws + WS_MIXIN); float* const MIX = (float*)(ws + WS_MIX); \
    bf16_t* const H2 = (bf16_t*)(ws + WS_H2); int* const TOPI = (int*)(ws + WS_TOPI); float* const TOPW = (float*)(ws + WS_TOPW); int* const DEST = (int*)(ws + WS_DEST); int* const TILE = (int*)(ws + WS_TILE); float* const DECTAB = (float*)(ws + WS_DECTAB); \
    bf16_t* const XS = (bf16_t*)(ws + WS_XS); bf16_t* const ACT = (bf16_t*)(ws + WS_ACT); bf16_t* const YS = (bf16_t*)(ws + WS_YS); \
    (void)ctl; (void)outp; (void)ada; (void)SSQP; (void)WT_IN; (void)WT_QB; (void)WT_KVB; (void)WT_MLAO; (void)WT_RETO; (void)WT_OUT; (void)WT_GU; (void)WT_DOWN; (void)CS_RET; (void)CS_MLA; (void)Hb; (void)QL; (void)CKV; (void)KR; \
    (void)ACAT; (void)BCAT; (void)KROT; (void)KZTF; (void)KZTB; (void)SG; (void)GA; (void)GB; (void)QN; (void)QR; (void)KN; (void)VV; (void)OA; (void)ORET; (void)OB; (void)MIXP; (void)MIXIN; (void)MIX; (void)H2; (void)TOPI; (void)TOPW; (void)DEST; (void)TILE; (void)DECTAB; (void)XS; (void)ACT; (void)YS;

    if (IN(PH_SETUP)) for (int rep = 0; rep < NREP(PH_SETUP); ++rep) {
        PTRS
        if (bx == 0 && tid < 16) DECTAB[tid] = log2_sigmoid(tid < 8 ? INP(I_DECF)[tid] : INP(I_DECB)[tid - 8]);
        {
            const float* wada = INP(I_WADA); const float* cvec = INP(I_C); float* adap = (float*)(ws + WS_ADAP);
            for (int it = gw; it < 192 * 8; it += NGW) {
                const int jb = it % 192, kp = it / 192, j = jb * 64 + lane;
                float a0 = 0.f, a1 = 0.f, a2 = 0.f, a3 = 0.f;
#pragma nounroll
                for (int k0 = kp * 256; k0 < kp * 256 + 256; k0 += 32) {
                    float w[32]; const float* wp = wada + (size_t)k0 * 12288 + j;
#pragma unroll
                    for (int i = 0; i < 32; ++i) { w[i] = __builtin_nontemporal_load(wp); wp += 12288; asm volatile("" : "+v"(wp)); }
#pragma unroll
                    for (int i = 0; i < 32; ++i) { a0 += w[i] * cvec[k0 + i]; a1 += w[i] * cvec[2048 + k0 + i]; a2 += w[i] * cvec[4096 + k0 + i]; a3 += w[i] * cvec[6144 + k0 + i]; }
                }
                float* o = adap + (size_t)kp * 49152 + j;
                o[0] = a0; o[12288] = a1; o[24576] = a2; o[36864] = a3;
            }
        }
        {
            const int* pos = (const int*)INP(I_POS);
            for (int i = bx * 512 + tid; i < T * 160; i += G * 512) {
                const int tok = i / 160, f = i % 160; const float p = (float)pos[tok];
                float inv; float* dst;
                if (f < 128) { inv = 1.0f / powf(10000.0f, (float)f / 128.0f); dst = CS_RET + (size_t)tok * 256 + f * 2; }
                else { inv = 1.0f / powf(10000.0f, (float)(f - 128) / 32.0f); dst = CS_MLA + (size_t)tok * 64 + (f - 128) * 2; }
                float s, c; sincosf(p * inv, &s, &c); dst[0] = c; dst[1] = s;
            }
        }
        {
            LAS float* scr = (LAS float*)(lds + wave * 16640);
            constexpr int I_IN = (N_IN_ALL / 64) * 32, I_QB = 24 * 8, I_KVB = 32 * 8, I_MLAO = 32 * 16, I_SQ = 32 * 32;
            constexpr int NITEMS = I_IN + I_QB + I_KVB + I_MLAO + 2 * I_SQ;
            unsigned* cq = ctl + CW_CVTQ + rep;
#define CVT_GRAB(dst) do { unsigned _v = 0u; if (lane == 0) _v = atomicAdd(cq, 8u); dst = (int)__builtin_amdgcn_readfirstlane(_v); } while (0)
#define CVT_DEC(r_, wp_, dst_, ks_, ldw_, K_, sc_) do { int r = (r_); const float* W_; bf16_t* WT_; const float* kq_ = nullptr; int nkb_, mat_; \
                if (r < I_IN) { W_ = INP(I_WIN); WT_ = WT_IN; ldw_ = 13376; K_ = 2048; nkb_ = 32; mat_ = 2; } \
                else if ((r -= I_IN) < I_QB) { W_ = INP(I_WQB); WT_ = WT_QB; kq_ = INP(I_QAN); ldw_ = 1536; K_ = 512; nkb_ = 8; mat_ = 3; } \
                else if ((r -= I_QB) < I_KVB) { W_ = INP(I_WKVB); WT_ = WT_KVB; kq_ = INP(I_KVAN); ldw_ = 2048; K_ = 512; nkb_ = 8; mat_ = 4; } \
                else if ((r -= I_KVB) < I_MLAO) { W_ = INP(I_WMLAO); WT_ = WT_MLAO; ldw_ = 2048; K_ = 1024; nkb_ = 16; mat_ = 1; } \
                else if ((r -= I_MLAO) < I_SQ) { W_ = INP(I_WRETO); WT_ = WT_RETO; ldw_ = 2048; K_ = 2048; nkb_ = 32; mat_ = 1; } \
                else { r -= I_SQ; W_ = INP(I_WOUT); WT_ = WT_OUT; ldw_ = 2048; K_ = 2048; nkb_ = 32; mat_ = 1; } \
                const int q4_ = r >> 2, kb_ = q4_ % nkb_, nb_ = (q4_ / nkb_) * 4 + (r & 3), rr_ = nb_ * 64 + lane; \
                sc_ = (mat_ == 1 ? rr_ : (mat_ == 2 ? src_in(rr_) : (mat_ == 3 ? src_qb(rr_) : src_kvb(rr_)))); \
                wp_ = W_ + (size_t)(kb_ * 64) * ldw_ + (sc_ >= 0 ? sc_ : 0); dst_ = WT_ + (size_t)(nb_ * 64) * K_ + kb_ * 64; ks_ = kq_ ? kq_ + kb_ * 64 : nullptr; \
                if (mat_ == 2 && nb_ >= 84 && nb_ < 180) { K_ = -1; dst_ = (bf16_t*)(ws + WS_WT8IN + (size_t)((nb_ - 84) * 64) * 2048 + kb_ * 64); } } while (0)
            float v[64];
            const float* wpc; bf16_t* dstc; const float* ksc; int ldwc, Kc, scc;
            const float* wpn = nullptr; bf16_t* dstn = nullptr; const float* ksn = nullptr; int ldwn = 0, Kn = 0, scn = 0;
            constexpr int QCH = 8; static_assert(NITEMS % QCH == 0, "queue chunk");
            int itc, itn, cend; CVT_GRAB(itc); itn = itc + 1; cend = itc + QCH;
            bool hc = itc < NITEMS;
            if (hc) { CVT_DEC(itc, wpc, dstc, ksc, ldwc, Kc, scc);
#pragma unroll
                for (int i = 0; i < 64; ++i) v[i] = __builtin_nontemporal_load(wpc + (size_t)i * ldwc); }
            while (hc) {
                const bool hn = itn < NITEMS;
                if (hn) CVT_DEC(itn, wpn, dstn, ksn, ldwn, Kn, scn);
                const bool need = (itn + 1 >= cend); unsigned raw_nn = 0u; if (need && lane == 0) raw_nn = atomicAdd(cq, (unsigned)QCH);
#pragma unroll
                for (int g = 0; g < 4; ++g) {
#pragma unroll
                    for (int i = 0; i < 16; ++i) { float x = scc >= 0 ? v[16 * g + i] : 0.f; if (ksc) x *= ksc[16 * g + i]; scr[(16 * g + i) * 65 + lane] = x; }
                    if (hn) {
#pragma unroll
                        for (int i = 0; i < 16; ++i) v[16 * g + i] = __builtin_nontemporal_load(wpn + (size_t)(16 * g + i) * ldwn); }
                }
                asm volatile("s_waitcnt lgkmcnt(0)" ::: "memory");
                const int c = lane & 7;
#pragma unroll
                for (int j = 0; j < 8; ++j) { const int n = (lane >> 3) + 8 * j; const LAS float* sp = scr + (8 * c) * 65 + n;
                    if (Kc < 0) { u32x2 o8; o8.x = pk4_fp8(sp[0 * 65], sp[1 * 65], sp[2 * 65], sp[3 * 65], W8_SCALE); o8.y = pk4_fp8(sp[4 * 65], sp[5 * 65], sp[6 * 65], sp[7 * 65], W8_SCALE);
                        *(u32x2*)((unsigned char*)dstc + (size_t)n * 2048 + 8 * c) = o8; }
                    else { u32x4 o; o.x = cvt_pk_bf16(sp[0 * 65], sp[1 * 65]); o.y = cvt_pk_bf16(sp[2 * 65], sp[3 * 65]); o.z = cvt_pk_bf16(sp[4 * 65], sp[5 * 65]); o.w = cvt_pk_bf16(sp[6 * 65], sp[7 * 65]);
                        __builtin_nontemporal_store(o, (u32x4*)(dstc + (size_t)n * Kc + 8 * c)); } }
                asm volatile("s_waitcnt lgkmcnt(0)" ::: "memory");
                wpc = wpn; dstc = dstn; ksc = ksn; ldwc = ldwn; Kc = Kn; scc = scn; hc = hn;
                if (need) { itn = (int)__builtin_amdgcn_readfirstlane(raw_nn); cend = itn + QCH; } else itn = itn + 1;
            }
#undef CVT_GRAB
#undef CVT_DEC
        }
    }
    SEAM(PH_SETUP);
    if (IN(PH_H)) for (int rep = 0; rep < NREP(PH_H); ++rep) {
        PTRS
        const float* g = INP(I_GPREM);
        {
            const float* adap = (const float*)(ws + WS_ADAP); const float* bada = INP(I_BADA); LAS float* AD = (LAS float*)lds;
            if (tid < 192) { const int idx = bx * 192 + tid; if (idx < 49152) { const int j = idx % 12288; float a = 0.f;
#pragma unroll
                for (int pq = 0; pq < 8; ++pq) a += adap[(size_t)pq * 49152 + idx];
                ada[idx] = a + bada[j]; } }
            for (int i = tid; i < 16384; i += 512) { const int b = i >> 12, col = i & 4095; float a = 0.f;
#pragma unroll
                for (int pq = 0; pq < 8; ++pq) a += adap[(size_t)pq * 49152 + b * 12288 + col];
                AD[i] = a + bada[col]; }
            __syncthreads();
        }
        const LAS float* AD = (const LAS float*)lds;
        f32x4 vn[8];
        if (gw < T) { const f32x4* xr = (const f32x4*)(INP(I_X) + (size_t)gw * D) + lane;
#pragma unroll
            for (int j = 0; j < 8; ++j) vn[j] = xr[64 * j]; }
        for (int mrow = gw; mrow < T; mrow += NGW) {
            const int b = mrow / SEQ;
            f32x4 v[8]; float s = 0.f;
#pragma unroll
            for (int j = 0; j < 8; ++j) { v[j] = vn[j]; s += (v[j][0] * v[j][0] + v[j][1] * v[j][1]) + (v[j][2] * v[j][2] + v[j][3] * v[j][3]); }
            if (mrow + NGW < T) { const f32x4* xr = (const f32x4*)(INP(I_X) + (size_t)(mrow + NGW) * D) + lane;
#pragma unroll
                for (int j = 0; j < 8; ++j) vn[j] = xr[64 * j]; }
            const float r = rsqrtf(wave_sum(s) * (1.0f / D) + RMS_EPS);
            u32x2* o8 = (u32x2*)(Hb + (size_t)mrow * D) + lane; unsigned* q8 = (unsigned*)(ws + WS_H8 + (size_t)mrow * D) + lane;
#pragma unroll
            for (int j = 0; j < 8; ++j) { const int col = 256 * j + 4 * lane; const f32x4 gg = *(const f32x4*)(g + col), sh = *(const LAS f32x4*)(AD + b * 4096 + col), sc = *(const LAS f32x4*)(AD + b * 4096 + 2048 + col);
                const f32x4 y = v[j] * r * gg * (sc + 1.0f) + sh; u32x2 w; w.x = cvt_pk_bf16(y[0], y[1]); w.y = cvt_pk_bf16(y[2], y[3]); o8[64 * j] = w; q8[64 * j] = pk4_fp8(y[0], y[1], y[2], y[3], H8_SCALE); }
        }
    }
    SEAM(PH_H);
    if (IN(PH_INPROJ)) for (int rep = 0; rep < NREP(PH_INPROJ); ++rep) {
        PTRS
        {   pg8::InprojSched S{(const char*)Hb, (const char*)WT_IN, G, bx};
            EpiInprojAll E{EpiInproj{QL, CKV, KR, ACAT, KROT, SG, GA, GB, SSQP, CS_RET, CS_MLA, DECTAB, 0, 1.0f}, EpiVT{BCAT, ws + WS_VT8}};
            pg8::gemm_phase(lds, 2048, 2048, 2048, S, E); }
        {
            pg8::GridSched S{(const char*)(ws + WS_H8), (const char*)(ws + WS_WT8IN), (size_t)256 * 2048, (size_t)256 * 2048, T / 256, 24, G, bx};
            EpiInproj E{QL, CKV, KR, ACAT, KROT, SG, GA, GB, SSQP, CS_RET, CS_MLA, DECTAB, 21, GU_UNSCALE};
            pg8::gemm_phase<EpiInproj, pg8::GridSched, true>(lds, 2048, 2048, 2048, S, E); }
    }
    SEAM(PH_INPROJ_V);
    if (IN(PH_KT)) for (int rep = 0; rep < NREP(PH_KT); ++rep) {
        PTRS
        {
            constexpr int TP = 528;
            u32x4 ra[16], rb[16];
#define KT_LOAD(r_, blk_) do { const bf16_t* _s = KROT + ((size_t)(blk_) * 256 + 32 * wave + 16 * (lane >> 5)) * 256 + 8 * (lane & 31); _Pragma("unroll") for (int i = 0; i < 16; ++i) r_[i] = *(const u32x4*)(_s + i * 256); } while (0)
#define KT_PROC(r_, blk_) do { const int _h = ((blk_) >> 4) & 7; const float _lf = DECTAB[_h], _lb = DECTAB[8 + _h]; \
                _Pragma("unroll") for (int e = 0; e < 8; ++e) { u32x4 w0, w1; \
                    _Pragma("unroll") for (int i2 = 0; i2 < 4; ++i2) { const unsigned a0 = r_[2 * i2][e >> 1], a1 = r_[2 * i2 + 1][e >> 1], c0 = r_[8 + 2 * i2][e >> 1], c1 = r_[8 + 2 * i2 + 1][e >> 1]; \
                        w0[i2] = (e & 1) ? ((a0 >> 16) | (a1 & 0xffff0000u)) : ((a0 & 0xffffu) | (a1 << 16)); w1[i2] = (e & 1) ? ((c0 >> 16) | (c1 & 0xffff0000u)) : ((c0 & 0xffffu) | (c1 << 16)); } \
                    LAS unsigned char* _t = lds + (8 * (lane & 31) + e) * TP + (32 * wave + 16 * (lane >> 5)) * 2; *(LAS u32x4*)_t = w0; *(LAS u32x4*)(_t + 16) = w1; } \
                __syncthreads(); \
                f32x4 zf0, zf1, zb0, zb1; \
                _Pragma("unroll") for (int t = 0; t < 4; ++t) { const int p0 = 8 * (lane & 31) + t, p1 = p0 + 4; \
                    zf0[t] = __builtin_amdgcn_exp2f((float)(255 - p0) * _lf); zf1[t] = __builtin_amdgcn_exp2f((float)(255 - p1) * _lf); zb0[t] = __builtin_amdgcn_exp2f((float)p0 * _lb); zb1[t] = __builtin_amdgcn_exp2f((float)p1 * _lb); } \
                _Pragma("unroll") for (int j = 0; j < 16; ++j) { const int row = 32 * wave + 2 * j + (lane >> 5); \
                    const u32x4 w = *(const LAS u32x4*)(lds + row * TP + (lane & 31) * 16); f32x4 x0, x1; unpack8(w, x0, x1); \
                    const size_t o = ((size_t)(blk_) * 256 + row) * 256 + 8 * (lane & 31); \
                    const f32x4 f0 = x0 * zf0, f1 = x1 * zf1, g0 = x0 * zb0, g1 = x1 * zb1; u32x2 wf, wb; \
                    wf.x = pk4_fp8(f0[0], f0[1], f0[2], f0[3], K8_SCALE); wf.y = pk4_fp8(f1[0], f1[1], f1[2], f1[3], K8_SCALE); wb.x = pk4_fp8(g0[0], g0[1], g0[2], g0[3], K8_SCALE); wb.y = pk4_fp8(g1[0], g1[1], g1[2], g1[3], K8_SCALE); \
                    *(u32x2*)((unsigned char*)KZTF + o) = wf; *(u32x2*)((unsigned char*)KZTB + o) = wb; } \
                __syncthreads(); } while (0)
            int blk = bx;
            if (blk < NBLK) KT_LOAD(ra, blk);
            while (blk < NBLK) {
                const int b1 = blk + G; if (b1 < NBLK) KT_LOAD(rb, b1);
                KT_PROC(ra, blk);
                if (b1 >= NBLK) break;
                const int b2 = b1 + G; if (b2 < NBLK) KT_LOAD(ra, b2);
                KT_PROC(rb, b1);
                blk = b2;
            }
#undef KT_LOAD
#undef KT_PROC
        }
    }
    SEAM(PH_KT);
    if (IN(PH_CHAIN)) for (int rep = 0; rep < NREP(PH_CHAIN); ++rep) {
        PTRS
        if (bx < 64) {
            const int bh = bx >> 1, dir = bx & 1;
            {
                const int blk0 = bh * NCH + (dir ? NCH - 1 : 0);
                bf16_t* z = BCAT + ((size_t)blk0 * 256 + (tid >> 1)) * 768 + 256 + 256 * dir + (tid & 1) * 128;
#pragma unroll
                for (int q = 0; q < 16; ++q) *(u32x4*)(z + q * 8) = (u32x4){0u, 0u, 0u, 0u};
            }
            pg8::ChainSched S{(const char*)(ws + WS_VT8), (const char*)(dir ? KZTB : KZTF), bh, dir};
            EpiGb E{BCAT, DECTAB, dir};
            pg8::gemm_phase<EpiGb, pg8::ChainSched, true, true>(lds, 256, 256, 256, S, E);
        }
    }
    if (IN(PH_MLAQ)) for (int rep = 0; rep < NREP(PH_MLAQ); ++rep) {
        PTRS
        if (bx >= 64) { const bool ca = bx < 128;
            pg8::GridSchedR S{(const char*)QL, (const char*)WT_QB, (size_t)256 * 512 * 2, (size_t)256 * 512 * 2, T / 256, 6, ca ? 64 : 128, ca ? bx - 64 : bx - 128, ca ? 0 : 128, ca ? 128 : 384};
            EpiMlaQ E{QN, QR, SSQP, CS_MLA}; pg8::gemm_phase(lds, 512, 512, 512, S, E); }
    }
    if (IN(PH_MLAKV)) for (int rep = 0; rep < NREP(PH_MLAKV); ++rep) {
        PTRS
        if (bx >= 128) {
            pg8::GridSchedR S{(const char*)CKV, (const char*)WT_KVB, (size_t)256 * 512 * 2, (size_t)256 * 512 * 2, T / 256, 8, 128, bx - 128, 0, 512};
            EpiMlaKV E{KN, VV, SSQP + (size_t)8 * T}; pg8::gemm_phase(lds, 512, 512, 512, S, E); }
    }
    if (IN(PH_GA)) for (int rep = 0; rep < NREP(PH_GA); ++rep) {
        PTRS
        if (bx >= 64) { const bool ca = bx < 128;
        {   pg8::BatchSchedR S{(const char*)(ACAT + 256), (const char*)KROT, (size_t)256 * 768 * 2, (size_t)256 * 256 * 2, ca ? 64 : 128, ca ? bx - 64 : bx - 128, ca ? 0 : 256, ca ? 256 : 512};
            EpiGa E{ACAT, DECTAB}; pg8::gemm_phase(lds, 256, 768, 256, S, E); }
        if (ca) {
            pg8::GridSchedR S{(const char*)Hb, (const char*)(WT_IN + (size_t)4 * 256 * 2048), (size_t)256 * 2048 * 2, (size_t)256 * 2048 * 2, T / 256, 1, 64, bx - 64, 0, 64};
            EpiInproj E{QL, CKV, KR, ACAT, KROT, SG, GA, GB, SSQP, CS_RET, CS_MLA, DECTAB, 4, 1.0f}; pg8::gemm_phase(lds, 2048, 2048, 2048, S, E); }
        }
    }
    SEAM(PH_GA);
    if (IN(PH_ATTN)) for (int rep = 0; rep < NREP(PH_ATTN); ++rep) {
        PTRS
        unsigned* queue = ctl + CW_QUEUE + rep; unsigned* cqueue = ctl + CW_QUEUE + 8;
        const float* wgu = INP(I_WGU); const float* wdn = INP(I_WDOWN);
#define CONV_LOOP() do { if (rep == 0) for (;;) { __syncthreads(); if (tid == 0) MISC[1] = atomicAdd(cqueue, 1u); __syncthreads(); const int c = (int)MISC[1]; if (c >= 768) break; \
            xt_convert_tiles(c * 16, 1, c * 16 + 16, wgu, wdn, WT_GU, WT_DOWN, lds, lane, wave); } } while (0)
        if (bx < CONV_WGS) CONV_LOOP();
        for (;;) {
            __syncthreads();
            if (tid == 0) MISC[0] = atomicAdd(queue, 1u);
            __syncthreads();
            const int a = (int)MISC[0];
            if (a >= 512) break;
            const int bh = a >> 4, qb = a & 15, b = bh >> 3, h = bh & 7;
            const size_t tok0 = (size_t)b * SEQ + qb * 256, kt0 = (size_t)b * SEQ;
            att::attn_unit(QN + tok0 * 1024 + h * 128, QR + tok0 * 512 + h * 64, KN + kt0 * 1024 + h * 128, KR + kt0 * 64, VV + kt0 * 1024 + h * 128, OA + tok0 * 1024 + h * 128, SEQ, (char*)lds_raw);
        }
        if (bx >= CONV_WGS) CONV_LOOP();
#undef CONV_LOOP
    }
    SEAM(PH_ATTN);
    if (IN(PH_GC)) for (int rep = 0; rep < NREP(PH_GC); ++rep) {
        PTRS
        {   pg8::BatchSched S{(const char*)ACAT, (const char*)BCAT, (size_t)256 * 768 * 2, (size_t)256 * 768 * 2, NBLK, G, bx};
            EpiGc E{OB, SG, INP(I_RETGN), lds}; pg8::gemm_phase(lds, 768, 768, 768, S, E); }
    }
    if (IN(PH_MIXA)) for (int rep = 0; rep < NREP(PH_MIXA); ++rep) {
        PTRS
        {   pg8::GridSched S{(const char*)OA, (const char*)WT_MLAO, (size_t)256 * 1024 * 2, (size_t)256 * 1024 * 2, T / 256, 8, G, bx};
            EpiMixA E{MIXP, GA}; pg8::gemm_phase(lds, 1024, 1024, 1024, S, E); }
    }
    SEAM(PH_MIXA);
    if (IN(PH_MIXB)) for (int rep = 0; rep < NREP(PH_MIXB); ++rep) {
        PTRS
        pg8::GridSched S{(const char*)OB, (const char*)WT_RETO, (size_t)256 * 2048 * 2, (size_t)256 * 2048 * 2, T / 256, 8, G, bx};
        EpiMixB E{MIXIN, MIXP, GB}; pg8::gemm_phase(lds, 2048, 2048, 2048, S, E);
    }
    SEAM(PH_MIXB);
    if (IN(PH_MIX)) for (int rep = 0; rep < NREP(PH_MIX); ++rep) {
        PTRS
        pg8::GridSched S{(const char*)MIXIN, (const char*)WT_OUT, (size_t)256 * 2048 * 2, (size_t)256 * 2048 * 2, T / 256, 8, G, bx};
        EpiF32 E{(bf16_t*)MIX}; pg8::gemm_phase(lds, 2048, 2048, 2048, S, E);
    }
    SEAM(PH_MIX);
    if (IN(PH_ROUTER)) for (int rep = 0; rep < NREP(PH_ROUTER); ++rep) {
        PTRS
        const float* gpm = INP(I_GPOSTM); const float* gpf = INP(I_GPREF); const float* wr = INP(I_WROUTER); const float* brt = INP(I_BROUTER);
        LAS float* HROW = (LAS float*)lds;
        LAS float* PART = (LAS float*)(lds + 16 * 2052 * 4);
        unsigned* counts = ctl + CW_COUNTS;
        volatile LAS unsigned* lhist = MISC + 64;
        if (tid < 32) lhist[tid] = 0u;
        __syncthreads();
        const float* wbp = wr + (size_t)(256 * wave + (lane >> 4)) * 32 + (lane & 15);
        f32x4 vA[8], vB[8], xA[8], xB[8];
#define RT_LOAD(base_) do { const int _m = (base_) + 2 * wave; const u32x2* _mr = (const u32x2*)((const bf16_t*)MIX + (size_t)_m * D) + lane; const f32x4* _xr = (const f32x4*)(INP(I_X) + (size_t)_m * D) + lane; \
            _Pragma("unroll") for (int j = 0; j < 8; ++j) { const u32x2 _a = _mr[64 * j], _b = _mr[64 * j + 512]; vA[j] = (f32x4){bf_lo(_a.x), bf_hi(_a.x), bf_lo(_a.y), bf_hi(_a.y)}; vB[j] = (f32x4){bf_lo(_b.x), bf_hi(_b.x), bf_lo(_b.y), bf_hi(_b.y)}; \
                xA[j] = _xr[64 * j]; xB[j] = _xr[64 * j + 512]; } } while (0)
        if (bx * 16 < T) RT_LOAD(bx * 16);
        for (int base = bx * 16; base < T; base += G * 16) {
            {
                const int rrA = 2 * wave, mrowA = base + rrA;
                const int b = mrowA / SEQ; const float* ad = ada + b * 12288;
                float sA = 0.f, sB = 0.f;
#pragma unroll
                for (int j = 0; j < 8; ++j) { sA += (vA[j][0] * vA[j][0] + vA[j][1] * vA[j][1]) + (vA[j][2] * vA[j][2] + vA[j][3] * vA[j][3]); sB += (vB[j][0] * vB[j][0] + vB[j][1] * vB[j][1]) + (vB[j][2] * vB[j][2] + vB[j][3] * vB[j][3]); }
#pragma unroll
                for (int o = 1; o < 64; o <<= 1) { sA += __shfl_xor(sA, o); sB += __shfl_xor(sB, o); }
                const float r1A = rsqrtf(sA * (1.0f / D) + RMS_EPS), r1B = rsqrtf(sB * (1.0f / D) + RMS_EPS); float tA = 0.f, tB = 0.f;
                f32x4* o4 = (f32x4*)(outp + (size_t)mrowA * D) + lane;
#pragma unroll
                for (int j = 0; j < 8; ++j) { const int col = 256 * j + 4 * lane; const f32x4 gg = *(const f32x4*)(gpm + col), gm = *(const f32x4*)(ad + 4096 + col);
                    vA[j] = xA[j] + gm * (vA[j] * r1A * gg); vB[j] = xB[j] + gm * (vB[j] * r1B * gg); o4[64 * j] = vA[j]; o4[64 * j + 512] = vB[j];
                    tA += (vA[j][0] * vA[j][0] + vA[j][1] * vA[j][1]) + (vA[j][2] * vA[j][2] + vA[j][3] * vA[j][3]); tB += (vB[j][0] * vB[j][0] + vB[j][1] * vB[j][1]) + (vB[j][2] * vB[j][2] + vB[j][3] * vB[j][3]); asm volatile("" ::: "memory"); }
#pragma unroll
                for (int o = 1; o < 64; o <<= 1) { tA += __shfl_xor(tA, o); tB += __shfl_xor(tB, o); }
                const float r2A = rsqrtf(tA * (1.0f / D) + RMS_EPS), r2B = rsqrtf(tB * (1.0f / D) + RMS_EPS);
                unsigned* h8 = (unsigned*)((unsigned char*)H2 + (size_t)mrowA * D) + lane;
#pragma unroll
                for (int j = 0; j < 8; ++j) { const int col = 256 * j + 4 * lane; const f32x4 gg = *(const f32x4*)(gpf + col), sh = *(const f32x4*)(ad + 6144 + col), sc = *(const f32x4*)(ad + 8192 + col);
                    const f32x4 hA = vA[j] * r2A * gg * (sc + 1.0f) + sh, hB = vB[j] * r2B * gg * (sc + 1.0f) + sh;
                    h8[64 * j] = pk4_fp8(hA[0], hA[1], hA[2], hA[3], H8_SCALE); h8[64 * j + 512] = pk4_fp8(hB[0], hB[1], hB[2], hB[3], H8_SCALE);
                    *(LAS f32x4*)(HROW + rrA * 2052 + col) = hA; *(LAS f32x4*)(HROW + (rrA + 1) * 2052 + col) = hB; asm volatile("" ::: "memory"); }
                if (base + G * 16 < T) RT_LOAD(base + G * 16);
            }
            __syncthreads();
            {   f32x4 c0 = (f32x4){0.f, 0.f, 0.f, 0.f}, c1 = (f32x4){0.f, 0.f, 0.f, 0.f};
                const LAS float* ap = HROW + (lane & 15) * 2052 + 256 * wave + (lane >> 4);
#pragma unroll 16
                for (int st = 0; st < 64; ++st) { const float a = ap[4 * st]; c0 = __builtin_amdgcn_mfma_f32_16x16x4f32(a, wbp[st * 128], c0, 0, 0, 0); c1 = __builtin_amdgcn_mfma_f32_16x16x4f32(a, wbp[st * 128 + 16], c1, 0, 0, 0); }
                LAS float* pp = PART + wave * 512 + (4 * (lane >> 4)) * 32 + (lane & 15);
#pragma unroll
                for (int r = 0; r < 4; ++r) { pp[r * 32] = c0[r]; pp[r * 32 + 16] = c1[r]; }
            }
            __syncthreads();
#pragma nounroll
            for (int q = 0; q < 2; ++q) {
                const int rr = 2 * wave + q, mrow = base + rr;
                float lg = 0.f;
                if (lane < 32) {
#pragma unroll
                    for (int w2 = 0; w2 < 8; ++w2) lg += PART[w2 * 512 + rr * 32 + lane];
                    lg += brt[lane]; }
                float val = lane < 32 ? lg : -3.0e38f; float tv[4]; int ti[4];
#pragma unroll
                for (int r = 0; r < 4; ++r) { float bv = val; int bi = lane;
#pragma unroll
                    for (int o = 32; o >= 1; o >>= 1) { const float ov = __shfl_xor(bv, o); const int oi = __shfl_xor(bi, o); if (ov > bv || (ov == bv && oi < bi)) { bv = ov; bi = oi; } }
                    tv[r] = bv; ti[r] = bi; if (lane == bi) val = -3.0e38f; }
                const float e1 = __expf(tv[1] - tv[0]), e2 = __expf(tv[2] - tv[0]), e3 = __expf(tv[3] - tv[0]); const float inv = 1.0f / (1.0f + e1 + e2 + e3);
                if (lane < 4) { const int id = lane == 0 ? ti[0] : (lane == 1 ? ti[1] : (lane == 2 ? ti[2] : ti[3])); const float wv = (lane == 0 ? 1.0f : (lane == 1 ? e1 : (lane == 2 ? e2 : e3))) * inv;
                    TOPI[mrow * 4 + lane] = id; TOPW[mrow * 4 + lane] = wv; if (rep == 0) __hip_atomic_fetch_add((LAS unsigned*)(lhist + id), 1u, __ATOMIC_RELAXED, __HIP_MEMORY_SCOPE_WORKGROUP); }
            }
            __syncthreads();
        }
        if (tid < 32 && rep == 0) { const unsigned c = lhist[tid]; if (c) atomicAdd(counts + 64 * tid, c); }
    }
    SEAM(PH_ROUTER);
    if (IN(PH_DISPATCH)) for (int rep = 0; rep < NREP(PH_DISPATCH); ++rep) {
        PTRS
        unsigned* counts = ctl + CW_COUNTS; unsigned* cursor = ctl + CW_CURSOR;
        volatile LAS unsigned* lhist = MISC + 64; volatile LAS unsigned* lbase = MISC + 96;
        if (tid < 32) lhist[tid] = 0u;
        int pst = 0, pend = 0;
        { const int cnt = lane < 32 ? (int)__hip_atomic_load(counts + 64 * lane, __ATOMIC_RELAXED, __HIP_MEMORY_SCOPE_AGENT) : 0; const int pad = (cnt + 255) & ~255; int inc = pad;
#pragma unroll
          for (int o = 1; o < 32; o <<= 1) { const int t = __shfl_up(inc, o); if ((lane & 31) >= o) inc += t; }
          pend = inc; pst = inc - pad; }
        if (gw == 0) {
            const int ntiles = __shfl(pend, 31) >> 8; if (lane == 0) TILE[0] = ntiles;
            for (int t = lane; t < PMAX / 256; t += 64) { int e = 0;
                for (int q = 0; q < 32; ++q) { const int pe = __shfl(pend, q); e += (pe <= t * 256) ? 1 : 0; }
                TILE[16 + t] = e < 31 ? e : 31; }
        }
        __syncthreads();
        int eid[8], loc[8];
#pragma unroll
        for (int i = 0; i < 8; ++i) { const int mrow = gw + NGW * i; eid[i] = 0; loc[i] = 0;
            if (mrow < T && lane < 4) { eid[i] = TOPI[mrow * 4 + lane]; loc[i] = (int)__hip_atomic_fetch_add((LAS unsigned*)(lhist + eid[i]), 1u, __ATOMIC_RELAXED, __HIP_MEMORY_SCOPE_WORKGROUP); } }
        __syncthreads();
        if (tid < 32) { const unsigned c = lhist[tid]; lbase[tid] = (unsigned)pst + (c ? atomicAdd(cursor + 64 * tid, c) : 0u); }
        __syncthreads();
#pragma unroll
        for (int i = 0; i < 8; ++i) { const int mrow = gw + NGW * i;
            if (mrow < T) {
                int slot = 0;
                if (lane < 4) { slot = (int)lbase[eid[i]] + loc[i]; DEST[mrow * 4 + lane] = slot; }
                const u32x4* src = (const u32x4*)((const unsigned char*)H2 + (size_t)mrow * D) + lane; u32x4 rw[2];
#pragma unroll
                for (int q = 0; q < 2; ++q) rw[q] = src[64 * q];
#pragma unroll
                for (int k = 0; k < 4; ++k) { const int sl = __shfl(slot, k); u32x4* dst = (u32x4*)((unsigned char*)XS + (size_t)sl * D) + lane;
#pragma unroll
                    for (int q = 0; q < 2; ++q) dst[64 * q] = rw[q]; } } }
    }
    SEAM(PH_DISPATCH);
    if (IN(PH_GU)) for (int rep = 0; rep < NREP(PH_GU); ++rep) {
        PTRS
        const int ntiles = __builtin_amdgcn_readfirstlane(TILE[0]);
        pg8::MoeSched S{(const char*)XS, (const char*)WT_GU, TILE + 16, ntiles, 16, G, bx};
        EpiGU E{ACT, INP(I_BGU), rep}; pg8::gemm_phase<EpiGU, pg8::MoeSched, true>(lds, 2048, 2048, 2048, S, E);
    }
    SEAM(PH_GU);
    if (IN(PH_DOWN)) for (int rep = 0; rep < NREP(PH_DOWN); ++rep) {
        PTRS
        const int ntiles = __builtin_amdgcn_readfirstlane(TILE[0]);
        pg8::MoeSched S{(const char*)ACT, (const char*)WT_DOWN, TILE + 16, ntiles, 8, G, bx};
        EpiDown E{YS, INP(I_BDOWN)}; pg8::gemm_phase<EpiDown, pg8::MoeSched, true>(lds, 2048, 2048, 2048, S, E);
    }
    SEAM(PH_DOWN);
    if (IN(PH_COMBINE)) for (int rep = 0; rep < NREP(PH_COMBINE); ++rep) {
        PTRS
        const float* gpo = INP(I_GPOSTF);
        for (int mrow = gw; mrow < T; mrow += NGW) {
            const int b = mrow / SEQ; const float* ad = ada + b * 12288;
            int dk[4]; float wk[4];
#pragma unroll
            for (int k = 0; k < 4; ++k) { dk[k] = DEST[mrow * 4 + k]; wk[k] = TOPW[mrow * 4 + k]; }
            f32x4 f[8]; float s = 0.f;
#pragma unroll
            for (int j = 0; j < 8; ++j) f[j] = (f32x4){0.f, 0.f, 0.f, 0.f};
#pragma unroll
            for (int k = 0; k < 4; ++k) { const u32x2* yr = (const u32x2*)(YS + (size_t)dk[k] * D) + lane;
#pragma unroll
                for (int j = 0; j < 8; ++j) { const u32x2 w = yr[64 * j]; f[j] += (f32x4){bf_lo(w.x), bf_hi(w.x), bf_lo(w.y), bf_hi(w.y)} * wk[k]; } }
#pragma unroll
            for (int j = 0; j < 8; ++j) s += (f[j][0] * f[j][0] + f[j][1] * f[j][1]) + (f[j][2] * f[j][2] + f[j][3] * f[j][3]);
            const float r = rsqrtf(wave_sum(s) * (1.0f / D) + RMS_EPS);
            f32x4* o4 = (f32x4*)(outp + (size_t)mrow * D) + lane;
#pragma unroll
            for (int j = 0; j < 8; ++j) { const int col = 256 * j + 4 * lane; const f32x4 gg = *(const f32x4*)(gpo + col), gf = *(const f32x4*)(ad + 10240 + col);
                o4[64 * j] = o4[64 * j] + gf * (f[j] * r * gg); }
        }
    }
    if (STAMP_PHASE >= 0 && bx == 0) {
        if (seam_after(STAMP_PHASE) >= NPH) st_dt = __builtin_amdgcn_s_memrealtime() - st_t0;
        const unsigned long long t1 = __builtin_amdgcn_s_memrealtime();
        while (__builtin_amdgcn_s_memrealtime() - t1 < st_dt * STAMP_MUL) __builtin_amdgcn_s_sleep(8);
    }
#undef IN
#undef SEAM
}

extern "C" void kernel_launch(void* const* d_in, const int* in_sizes, int n_in, void* d_out, int out_size, void* d_ws, size_t ws_size, hipStream_t stream) {
    static int grid = 0;
    if (grid == 0) {
        if (n_in != 26 || out_size != T * D || ws_size < WS_END) { fprintf(stderr, "kernel_launch: unexpected shapes: n_in %d out %d ws %zu (need %zu)\n", n_in, out_size, ws_size, (size_t)WS_END); grid = -1; return; }
        int dev = 0, cus = 0, per_cu = 0;
        if (hipGetDevice(&dev) != hipSuccess || hipDeviceGetAttribute(&cus, hipDeviceAttributeMultiprocessorCount, dev) != hipSuccess) { grid = -1; return; }
        if (hipFuncSetAttribute((const void*)fwd_kernel, hipFuncAttributeMaxDynamicSharedMemorySize, LDS_BYTES) != hipSuccess) { fprintf(stderr, "kernel_launch: hipFuncSetAttribute failed\n"); grid = -1; return; }
        if (hipOccupancyMaxActiveBlocksPerMultiprocessor(&per_cu, (const void*)fwd_kernel, 512, LDS_BYTES) != hipSuccess || per_cu < 1) fprintf(stderr, "kernel_launch: occupancy query says %d\n", per_cu);
        (void)hipGetLastError();
        grid = cus;
    }
    if (grid < 0) return;
    (void)hipMemsetAsync((char*)d_ws + WS_CTL, 0, CTL_BYTES, stream);
    Args a{};
    for (int i = 0; i < 26; ++i) a.in[i] = (const float*)d_in[i];
    a.out = (float*)d_out; a.ws = (unsigned char*)d_ws;
    if (MK_N_LAUNCHES == 1) { a.ph_lo = 0; a.ph_hi = NPH; hipLaunchKernelGGL(fwd_kernel, dim3(grid), dim3(512), LDS_BYTES, stream, a); }
    else for (int p = 0; p < NPH; ++p) { a.ph_lo = p; a.ph_hi = p + 1; hipLaunchKernelGGL(fwd_kernel, dim3(grid), dim3(512), LDS_BYTES, stream, a); }
    const hipError_t le = hipPeekAtLastError();
    if (le != hipSuccess) fprintf(stderr, "kernel_launch: launch failed: %s\n", hipGetErrorName(le));
}
```

```cpp
#include <hip/hip_runtime.h>
#include <cstdio>
#include <cstdint>

#ifndef MK_N_LAUNCHES
#define MK_N_LAUNCHES 1
#endif

#define LAS __attribute__((address_space(3)))
typedef unsigned short bf16_t;
typedef short bf16x8 __attribute__((ext_vector_type(8)));
typedef short s16x4 __attribute__((ext_vector_type(4)));
typedef float f32x4 __attribute__((ext_vector_type(4)));
typedef float f32x2 __attribute__((ext_vector_type(2)));
typedef float f32x16 __attribute__((ext_vector_type(16)));
typedef unsigned u32x4 __attribute__((ext_vector_type(4)));
typedef unsigned u32x2 __attribute__((ext_vector_type(2)));

constexpr int NB = 4, SEQ = 4096, T = NB * SEQ, D = 2048;
constexpr int CH = 256, NCH = SEQ / CH, NBLK = NB * 8 * NCH;
constexpr int N_IN_NAT = 11520;
constexpr int N_IN_ALL = N_IN_NAT + 2048;
constexpr int NE = 32, PMAX = 73728;
constexpr float RMS_EPS = 1e-6f, GN_EPS = 1e-6f;
constexpr float QSCALE = 0.07216878364870322f;
constexpr int CONV_WGS = 64;

constexpr size_t MiB = 1u << 20;
constexpr size_t WS_CTL = 0, CTL_BYTES = 1 * MiB;
constexpr size_t WS_WT_IN = 1 * MiB;
constexpr size_t WS_WT_QB = WS_WT_IN + 54 * MiB;
constexpr size_t WS_WT_KVB = WS_WT_QB + 2 * MiB;
constexpr size_t WS_WT_MLAO = WS_WT_KVB + 2 * MiB;
constexpr size_t WS_WT_RETO = WS_WT_MLAO + 4 * MiB;
constexpr size_t WS_WT_OUT = WS_WT_RETO + 8 * MiB;
constexpr size_t WS_WT_GU = WS_WT_OUT + 8 * MiB;
constexpr size_t WS_WT_DOWN = WS_WT_GU + 512 * MiB;
constexpr size_t WS_CS_RET = WS_WT_DOWN + 256 * MiB;
constexpr size_t WS_CS_MLA = WS_CS_RET + 16 * MiB;
constexpr size_t WS_H = WS_CS_MLA + 4 * MiB;
constexpr size_t WS_QL = WS_H + 64 * MiB;
constexpr size_t WS_CKV = WS_QL + 16 * MiB;
constexpr size_t WS_KR = WS_CKV + 16 * MiB;
constexpr size_t WS_ACAT = WS_KR + 2 * MiB;
constexpr size_t WS_BCAT = WS_ACAT + 192 * MiB;
constexpr size_t WS_KROT = WS_BCAT + 192 * MiB;
constexpr size_t WS_KZTF = WS_KROT + 64 * MiB;
constexpr size_t WS_KZTB = WS_KZTF + 64 * MiB;
constexpr size_t WS_SG = WS_KZTB + 64 * MiB;
constexpr size_t WS_GA = WS_SG + 64 * MiB;
constexpr size_t WS_GB = WS_GA + 64 * MiB;
constexpr size_t WS_QN = WS_GB + 64 * MiB;
constexpr size_t WS_QR = WS_QN + 32 * MiB;
constexpr size_t WS_KN = WS_QR + 16 * MiB;
constexpr size_t WS_VV = WS_KN + 32 * MiB;
constexpr size_t WS_OA = WS_VV + 32 * MiB;
constexpr size_t WS_ORET = WS_OA + 32 * MiB;
constexpr size_t WS_OB = WS_ORET + 128 * MiB;
constexpr size_t WS_MIXP = WS_OB + 64 * MiB;
constexpr size_t WS_MIXIN = WS_MIXP + 64 * MiB;
constexpr size_t WS_MIX = WS_MIXIN + 64 * MiB;
constexpr size_t WS_H2 = WS_MIX + 128 * MiB;
constexpr size_t WS_TOPI = WS_H2 + 64 * MiB;
constexpr size_t WS_TOPW = WS_TOPI + 1 * MiB;
constexpr size_t WS_DEST = WS_TOPW + 1 * MiB;
constexpr size_t WS_TILE = WS_DEST + 1 * MiB;
constexpr size_t WS_YS_END = WS_TILE + 1 * MiB + 3 * 288 * MiB;
constexpr size_t WS_DECTAB = WS_TILE + 65536;
constexpr size_t WS_SSQP = WS_YS_END;
constexpr size_t WS_XS = WS_TILE + 1 * MiB;
constexpr size_t WS_ACT = WS_XS + 288 * MiB;
constexpr size_t WS_YS = WS_ACT + 288 * MiB;
constexpr size_t WS_ADAP = WS_YS + 288 * MiB + 1 * MiB;
constexpr size_t WS_H8 = WS_ADAP + 2 * MiB;
constexpr size_t WS_WT8IN = WS_H8 + 32 * MiB;
constexpr size_t WS_VT8 = WS_WT8IN + 12 * MiB;
constexpr size_t WS_X1B = WS_VT8 + 32 * MiB;
constexpr size_t WS_END = WS_X1B + 64 * MiB;
constexpr int CW_BAR = 4096;
constexpr int CW_QUEUE = 8192, CW_CVTQ = 8384, CW_AQ = 9216  , CW_COUNTS = 10240, CW_CURSOR = 12288;
constexpr int CW_ADA = 16384;
constexpr int CW_SSQQ = 65536, CW_SSQKV = 81920;
static_assert((CW_SSQKV + T) * 4 <= (int)CTL_BYTES, "ctl");

constexpr int RING_BYTES = 131072, CTRL_OFF = 155648, MISC_OFF = CTRL_OFF, LARG_OFF = CTRL_OFF + 1024, LDS_BYTES = 163840;

__device__ __forceinline__ unsigned cvt_pk_bf16(float lo, float hi) { unsigned r; asm volatile("v_cvt_pk_bf16_f32 %0, %1, %2" : "=v"(r) : "v"(lo), "v"(hi)); return r; }
__device__ __forceinline__ u32x4 pack8(f32x4 a, f32x4 b) { u32x4 w; w.x = cvt_pk_bf16(a[0], a[1]); w.y = cvt_pk_bf16(a[2], a[3]); w.z = cvt_pk_bf16(b[0], b[1]); w.w = cvt_pk_bf16(b[2], b[3]); return w; }
__device__ __forceinline__ unsigned pk4_fp8(float a, float b, float c, float d, float sc) {
    a = __builtin_amdgcn_fmed3f(a * sc, -448.f, 448.f); b = __builtin_amdgcn_fmed3f(b * sc, -448.f, 448.f); c = __builtin_amdgcn_fmed3f(c * sc, -448.f, 448.f); d = __builtin_amdgcn_fmed3f(d * sc, -448.f, 448.f);
    int w = __builtin_amdgcn_cvt_pk_fp8_f32(a, b, 0, false); w = __builtin_amdgcn_cvt_pk_fp8_f32(c, d, w, true); return (unsigned)w;
}
constexpr float W8_SCALE = 1024.f, H8_SCALE = 16.f, A8_SCALE = 8.f;
constexpr float V8_SCALE = 16.f, K8_SCALE = 256.f, CH_UNSCALE = 1.0f / (V8_SCALE * K8_SCALE);
constexpr float GU_UNSCALE = 1.0f / (W8_SCALE * H8_SCALE), DN_UNSCALE = 1.0f / (W8_SCALE * A8_SCALE);
__device__ __forceinline__ float bf_lo(unsigned w) { return __uint_as_float(w << 16); }
__device__ __forceinline__ float bf_hi(unsigned w) { return __uint_as_float(w & 0xffff0000u); }
__device__ __forceinline__ void unpack8(u32x4 w, f32x4& a, f32x4& b) { a = (f32x4){bf_lo(w.x), bf_hi(w.x), bf_lo(w.y), bf_hi(w.y)}; b = (f32x4){bf_lo(w.z), bf_hi(w.z), bf_lo(w.w), bf_hi(w.w)}; }
__device__ __forceinline__ float wave_sum(float v) {
#pragma unroll
    for (int o = 1; o < 64; o <<= 1) v += __shfl_xor(v, o);
    return v;
}
__device__ __forceinline__ float sigmoidf_(float x) { return __builtin_amdgcn_rcpf(1.0f + __expf(-x)); }
__device__ __forceinline__ float log2_sigmoid(float x) { return -log1pf(expf(-x)) * 1.4426950408889634f; }

#define XB_TMO      128
#define XB_XCNT(j)  (256  + 64 * (j))
#define XB_XSUB(j)  (1280 + 64 * (j))
#define XB_XGEN(j)  (2304 + 64 * (j))
#define XB_TOP      3328
#define XB_TOPGEN   3392
#define XCD_BAR_WORDS 3456
#define XB_SPIN_CAP (1u << 22)
__device__ __forceinline__ unsigned xb_ld(unsigned* p)              { return __hip_atomic_load(p, __ATOMIC_RELAXED, __HIP_MEMORY_SCOPE_AGENT); }
__device__ __forceinline__ unsigned xb_add(unsigned* p, unsigned v) { return __hip_atomic_fetch_add(p, v, __ATOMIC_RELAXED, __HIP_MEMORY_SCOPE_AGENT); }
__device__ __forceinline__ unsigned xb_xcc_id() { return (unsigned)__builtin_amdgcn_s_getreg((3 << 11) | 20) & 0xFu; }
#define XB_SPIN(cond, bar) do { unsigned _sp = 0; while (cond) { __builtin_amdgcn_s_sleep(1); \
    if ((++_sp & 255u) == 0u) { if (xb_ld(&(bar)[XB_TMO])) break; if (_sp > XB_SPIN_CAP) { atomicAdd(&(bar)[XB_TMO], 1u); break; } } } } while (0)
struct XcdBarrier { unsigned* bar; unsigned x; volatile LAS unsigned* st; };
__device__ __forceinline__ XcdBarrier xcd_barrier_post(unsigned* bar, volatile LAS unsigned* st) {
    XcdBarrier b; b.bar = bar; b.x = xb_xcc_id(); b.st = st;
    if (threadIdx.x == 0) (void)xb_add(&bar[XB_XCNT(b.x)], 1u);
    return b;
}
__device__ __forceinline__ void xcd_barrier_complete(unsigned* bar, unsigned x, unsigned& nloc, unsigned& nx) {
    const unsigned G = gridDim.x * gridDim.y * gridDim.z;
    unsigned sum, cnt, mine, sp = 0u;
    for (;;) {
        sum = 0u; cnt = 0u; mine = 0u;
#pragma unroll
        for (unsigned j = 0; j < 16; ++j) { const unsigned c = xb_ld(&bar[XB_XCNT(j)]); sum += c; cnt += (c > 0u) ? 1u : 0u; mine = (j == x) ? c : mine; }
        if (sum == G) break;
        __builtin_amdgcn_s_sleep(1);
        if ((++sp & 255u) == 0u) { if (xb_ld(&bar[XB_TMO])) break; if (sp > XB_SPIN_CAP) { atomicAdd(&bar[XB_TMO], 1u); break; } }
    }
    nloc = mine > 0u ? mine : 1u; nx = cnt > 0u ? cnt : 1u;
}
__device__ __forceinline__ void xcd_barrier(const XcdBarrier& b) {
    asm volatile("s_waitcnt vmcnt(0)" ::: "memory");
    __syncthreads();
    if (threadIdx.x == 0) {
        unsigned* bar = b.bar;
        __builtin_amdgcn_s_waitcnt(0);
        unsigned nloc = b.st[0], nx = b.st[1];
        if (nloc == 0u) { xcd_barrier_complete(bar, b.x, nloc, nx); b.st[0] = nloc; b.st[1] = nx; }
        const unsigned old = xb_add(&bar[XB_XSUB(b.x)], 1u);
        const unsigned gen = old / nloc;
        if (old + 1u == (gen + 1u) * nloc) {
            __builtin_amdgcn_fence(__ATOMIC_RELEASE, "agent");
            asm volatile("s_waitcnt vmcnt(0)" ::: "memory");
            const unsigned og = xb_add(&bar[XB_TOP], 1u);
            const unsigned tg = og / nx;
            if (og + 1u == (tg + 1u) * nx) xb_add(&bar[XB_TOPGEN], 1u);
            else XB_SPIN(xb_ld(&bar[XB_TOPGEN]) == tg, bar);
            __builtin_amdgcn_fence(__ATOMIC_ACQUIRE, "agent");
            xb_add(&bar[XB_XGEN(b.x)], 1u);
            asm volatile("s_waitcnt vmcnt(0)" ::: "memory");
        } else {
            XB_SPIN(xb_ld(&bar[XB_XGEN(b.x)]) == gen, bar);
            __builtin_amdgcn_fence(__ATOMIC_ACQUIRE, "agent");
            asm volatile("s_waitcnt vmcnt(0)" ::: "memory");
        }
    }
    __syncthreads();
}

namespace pg8 {
constexpr int BM = 256, BK = 64, HALF = 128, HTB = HALF * BK * 2, NXCD = 8, WGM = 8;
__host__ __device__ __forceinline__ int lds_byte(int r, int c) { const int st = (r >> 4) * 2 + (c >> 5), rr = r & 15, cc = c & 31, ob = rr * 64 + cc * 2; return st * 1024 + (ob ^ (((ob >> 9) & 1) << 5)); }
__host__ __device__ __forceinline__ void stage_rc(int b, int& R, int& C) { const int st = b / 1024, sb = b % 1024, swz = sb ^ (((sb >> 9) & 1) << 5); R = (st >> 1) * 16 + swz / 64; C = (st & 1) * 32 + (swz % 64) / 2; }
__host__ __device__ __forceinline__ int perm32(int rho) { const int n = rho >> 4, i = rho & 15; return 8 * (i >> 2) + 4 * n + (i & 3); }
struct Unit { const char* a; const char* b; int pm, pn, keep, aux; };
__device__ __forceinline__ void tile_order(int wgid, int nM, int nN, int& pm, int& pn) {
    const int nwg = nM * nN; { const int q = nwg / NXCD, r = nwg % NXCD, xcd = wgid % NXCD, off = wgid / NXCD; wgid = (xcd < r ? xcd * (q + 1) : r * (q + 1) + (xcd - r) * q) + off; }
    const int nig = WGM * nN, gid = wgid / nig, fm = gid * WGM, gsz = (nM - fm) < WGM ? (nM - fm) : WGM;
    pm = fm + ((wgid % nig) % gsz); pn = (wgid % nig) / gsz;
}
typedef int v8i __attribute__((ext_vector_type(8)));
typedef int v4i __attribute__((ext_vector_type(4)));
template <class Epi, class Sched, bool F8 = false, bool REMAT = false>
__device__ __forceinline__ void gemm_phase(LAS unsigned char* lds, const int K, const int lda, const int ldb, const Sched& S, const Epi& E) {
    const int tid = threadIdx.x, wid = __builtin_amdgcn_readfirstlane(tid >> 6), lane = tid & 63, wr = wid >> 2, wc = wid & 3, fr = lane & 15, fq = lane >> 4;
    constexpr int ES = F8 ? 1 : 2;
    const int nt = K * ES / (BK * 2);
    unsigned voffA, voffB;
    { int R, C; stage_rc(tid * 16, R, C); const int Rb = (R & ~31) + perm32(R & 31); voffA = (unsigned)(R * lda * ES + C * 2); voffB = (unsigned)(Rb * ldb * ES + C * 2); }
    const size_t q64voffA = (size_t)64 * lda * ES, q64voffB = (size_t)64 * ldb * ES;
    const size_t kstep = (size_t)(BK * 2);
    const size_t hstepA = (size_t)HALF * lda * ES, hstepB = (size_t)HALF * ldb * ES;
    const unsigned ldsw = (unsigned)wid * 1024u;
    const int aoff = F8 ? lds_byte(wr * 64 + fr, fq * 16) : lds_byte(wr * 64 + fr, fq * 8), boff = F8 ? lds_byte(wc * 32 + fr, fq * 16) : lds_byte(wc * 32 + fr, fq * 8);
#define PG8_SA(b, h) (((b) * 2 + (h)) * HTB)
#define PG8_SB(b, h) ((4 + (b) * 2 + (h)) * HTB)
    constexpr bool isB_voffA = false, isB_voffB = true; const unsigned pitch_voffA = (unsigned)(lda * ES), pitch_voffB = (unsigned)(ldb * ES);
#define PG8_VOFF(isB, pitch) ({ unsigned _t = threadIdx.x; asm volatile("" : "+v"(_t)); const unsigned _l = _t & 63u, _w = _t >> 6, _sw = (_l * 16u) ^ ((_l >> 5) << 5); unsigned _R = (_w >> 1) * 16u + (_sw >> 6); \
        const unsigned _C = (_w & 1u) * 32u + ((_sw & 63u) >> 1); if (isB) _R = (_R & ~31u) + (unsigned)perm32((int)(_R & 31u)); _R * (pitch) + _C * 2u; })
#define PG8_STAGE(bufoff, gbase, voff) do { _Pragma("unroll") for (int _i = 0; _i < 2; ++_i) { unsigned _vo; if constexpr (REMAT) _vo = PG8_VOFF(isB_##voff, pitch_##voff); else { _vo = (voff); if constexpr (F8) asm volatile("" : "+v"(_vo)); } \
        __builtin_amdgcn_global_load_lds((const unsigned*)((const char*)(gbase) + (_i ? q64##voff : (size_t)0) + _vo), (LAS unsigned*)(lds + (bufoff) + ldsw + _i * 8192), 16, 0, 0); } } while (0)
#define PG8_LD1(addr) ({ v8i _r; if constexpr (F8) { _r = *(const LAS v8i*)(addr); } else { const v4i _lo = *(const LAS v4i*)(addr), _hi = *(const LAS v4i*)((addr) + 1024); _r = __builtin_shufflevector(_lo, _hi, 0, 1, 2, 3, 4, 5, 6, 7); } _r; })
#define PG8_LDA(dst, b, h) do { _Pragma("unroll") for (int m = 0; m < 4; ++m) dst[m] = PG8_LD1(lds + PG8_SA(b, h) + aoff + m * 2048); } while (0)
#define PG8_LDB(dst, b, h) do { _Pragma("unroll") for (int n = 0; n < 2; ++n) dst[n] = PG8_LD1(lds + PG8_SB(b, h) + boff + n * 2048); } while (0)
#define PG8_H0(x) __builtin_bit_cast(bf16x8, __builtin_shufflevector(x, x, 0, 1, 2, 3))
#define PG8_H1(x) __builtin_bit_cast(bf16x8, __builtin_shufflevector(x, x, 4, 5, 6, 7))
#define PG8_MMA(ai, bj, At, Bt) do { __builtin_amdgcn_s_setprio(1); _Pragma("unroll") for (int m = 0; m < 4; ++m) _Pragma("unroll") for (int n = 0; n < 2; ++n) { \
        if constexpr (F8) acc[ai][bj][m][n] = __builtin_amdgcn_mfma_scale_f32_16x16x128_f8f6f4(Bt[n], At[m], acc[ai][bj][m][n], 0, 0, 0, 0, 0, 0); \
        else { acc[ai][bj][m][n] = __builtin_amdgcn_mfma_f32_16x16x32_bf16(PG8_H0(Bt[n]), PG8_H0(At[m]), acc[ai][bj][m][n], 0, 0, 0); \
               acc[ai][bj][m][n] = __builtin_amdgcn_mfma_f32_16x16x32_bf16(PG8_H1(Bt[n]), PG8_H1(At[m]), acc[ai][bj][m][n], 0, 0, 0); } } \
        __builtin_amdgcn_s_setprio(0); } while (0)
#define PG8_WAIT_V(n) asm volatile("s_waitcnt vmcnt(" #n ")" ::: "memory")
#define PG8_WAIT_L(n) asm volatile("s_waitcnt lgkmcnt(" #n ")" ::: "memory")
#define PG8_BAR __builtin_amdgcn_s_barrier()
#define PG8_SCHED __builtin_amdgcn_sched_barrier(0)
    Unit cur, nxt; int ui = 0;
    if (!S.next(0, cur)) return;
    f32x4 acc[2][2][4][2];
#pragma unroll
    for (int a = 0; a < 2; ++a)
#pragma unroll
        for (int b = 0; b < 2; ++b)
#pragma unroll
            for (int m = 0; m < 4; ++m)
#pragma unroll
                for (int n = 0; n < 2; ++n) acc[a][b][m][n] = (f32x4){0.f, 0.f, 0.f, 0.f};
    v8i At[4], B0[2], B1[2];
    const char* cA = cur.a; const char* cB = cur.b;
    PG8_STAGE(PG8_SB(0, 0), cB, voffB); PG8_STAGE(PG8_SB(0, 1), cB + hstepB, voffB); PG8_STAGE(PG8_SA(0, 0), cA, voffA); PG8_STAGE(PG8_SA(0, 1), cA + hstepA, voffA);
    if (wr == 1) PG8_BAR;
    PG8_WAIT_V(2); PG8_BAR;
    PG8_STAGE(PG8_SB(1, 0), cB + kstep, voffB); PG8_STAGE(PG8_SA(1, 0), cA + kstep, voffA); PG8_STAGE(PG8_SB(1, 1), cB + hstepB + kstep, voffB);
    PG8_WAIT_V(6); PG8_BAR;
    for (;;) {
        const bool has_next = S.next(ui + 1, nxt);
        const char* nA = has_next ? nxt.a : cA; const char* nB = has_next ? nxt.b : cB;
#pragma nounroll
        for (int t = 0; t < nt; t += 2) {
            const bool last = (t == nt - 2);
            const char* a1 = cA + (size_t)(t + 1) * kstep;
            const char* a2 = last ? nA : cA + (size_t)(t + 2) * kstep; const char* b2 = last ? nB : cB + (size_t)(t + 2) * kstep;
            const char* a3 = a2 + kstep; const char* b3 = b2 + kstep;
            PG8_LDB(B0, 0, 0); PG8_LDB(B1, 0, 1); PG8_SCHED; PG8_LDA(At, 0, 0); PG8_STAGE(PG8_SA(1, 1), a1 + hstepA, voffA);
            PG8_WAIT_V(8); PG8_WAIT_L(0); PG8_BAR; PG8_MMA(0, 0, At, B0); PG8_MMA(0, 1, At, B1); PG8_BAR; PG8_SCHED;
            PG8_LDA(At, 0, 1); PG8_STAGE(PG8_SB(0, 0), b2, voffB); PG8_STAGE(PG8_SB(0, 1), b2 + hstepB, voffB); PG8_STAGE(PG8_SA(0, 0), a2, voffA);
            PG8_WAIT_V(8); PG8_WAIT_L(0); PG8_BAR; PG8_MMA(1, 0, At, B0); PG8_MMA(1, 1, At, B1); PG8_BAR; PG8_SCHED;
            PG8_LDB(B0, 1, 0); PG8_LDB(B1, 1, 1); PG8_SCHED; PG8_LDA(At, 1, 0); PG8_STAGE(PG8_SA(0, 1), a2 + hstepA, voffA);
            PG8_WAIT_V(8); PG8_WAIT_L(0); PG8_BAR; PG8_MMA(0, 0, At, B0); PG8_MMA(0, 1, At, B1); PG8_BAR; PG8_SCHED;
            PG8_LDA(At, 1, 1); PG8_STAGE(PG8_SB(1, 0), b3, voffB); PG8_STAGE(PG8_SB(1, 1), b3 + hstepB, voffB); PG8_STAGE(PG8_SA(1, 0), a3, voffA);
            PG8_WAIT_V(8); PG8_WAIT_L(0); PG8_BAR; PG8_MMA(1, 0, At, B0); PG8_MMA(1, 1, At, B1); PG8_BAR; PG8_SCHED;
        }
        if (wr == 0) PG8_BAR;
        { unsigned _t = threadIdx.x; if constexpr (F8) asm volatile("" : "+v"(_t)); E(acc, cur, wr, wc, (int)(_t & 15u), (int)((_t >> 4) & 3u)); }
        if (!has_next) break;
        if (!cur.keep) {
#pragma unroll
            for (int a = 0; a < 2; ++a)
#pragma unroll
                for (int b = 0; b < 2; ++b)
#pragma unroll
                    for (int m = 0; m < 4; ++m)
#pragma unroll
                        for (int n = 0; n < 2; ++n) acc[a][b][m][n] = (f32x4){0.f, 0.f, 0.f, 0.f};
        }
        cur = nxt; cA = nA; cB = nB; ++ui;
        if (wr == 1) PG8_BAR;
    }
    PG8_WAIT_V(0);
    PG8_BAR;
#undef PG8_SA
#undef PG8_SB
#undef PG8_STAGE
#undef PG8_VOFF
#undef PG8_LDA
#undef PG8_LDB
#undef PG8_LD1
#undef PG8_H0
#undef PG8_H1
#undef PG8_MMA
#undef PG8_WAIT_V
#undef PG8_WAIT_L
#undef PG8_BAR
#undef PG8_SCHED
}
struct GridSched {
    const char* A; const char* Bt; size_t astep, bstep; int nM, nN, G, c;
    __device__ __forceinline__ bool next(int i, Unit& u) const {
        const int L = i * G + c; if (L >= nM * nN) return false;
        int pm, pn; tile_order(L, nM, nN, pm, pn);
        u.a = A + (size_t)pm * astep; u.b = Bt + (size_t)pn * bstep; u.pm = pm; u.pn = pn; u.keep = 0; u.aux = 0; return true;
    }
};
struct InprojSched {
    const char* H; const char* W; int G, c;
    __device__ __forceinline__ bool next(int i, Unit& u) const {
        const int L = i * G + c; if (L >= 1792) return false;
        constexpr size_t TSB = (size_t)256 * 2048 * 2; int pm, pn;
        if (L < 1280) { tile_order(L, 64, 20, pm, pn); pn = pn < 4 ? pn : pn + 1; u.a = H + (size_t)pm * TSB; u.b = W + (size_t)pn * TSB; u.aux = 0; }
        else { tile_order(L - 1280, 8, 64, pm, pn); u.a = W + (size_t)(45 + pm) * TSB; u.b = H + (size_t)pn * TSB; u.aux = 1; }
        u.pm = pm; u.pn = pn; u.keep = 0; return true;
    }
};
struct GridSchedR {
    const char* A; const char* Bt; size_t astep, bstep; int nM, nN, G, c, L0, Lend;
    __device__ __forceinline__ bool next(int i, Unit& u) const {
        const int L = L0 + i * G + c; if (L >= Lend) return false;
        int pm, pn; tile_order(L, nM, nN, pm, pn);
        u.a = A + (size_t)pm * astep; u.b = Bt + (size_t)pn * bstep; u.pm = pm; u.pn = pn; u.keep = 0; u.aux = 0; return true;
    }
};
struct BatchSchedR {
    const char* A; const char* Bt; size_t astep, bstep; int G, c, L0, Lend;
    __device__ __forceinline__ bool next(int i, Unit& u) const {
        const int L = L0 + i * G + c; if (L >= Lend) return false;
        u.a = A + (size_t)L * astep; u.b = Bt + (size_t)L * bstep; u.pm = L; u.pn = 0; u.keep = 0; u.aux = 0; return true;
    }
};
struct BatchSched {
    const char* A; const char* Bt; size_t astep, bstep; int n, G, c;
    __device__ __forceinline__ bool next(int i, Unit& u) const {
        const int L = i * G + c; if (L >= n) return false;
        u.a = A + (size_t)L * astep; u.b = Bt + (size_t)L * bstep; u.pm = L; u.pn = 0; u.keep = 0; u.aux = 0; return true;
    }
};
struct ChainSched {
    const char* A; const char* Bt; int bh, dir;
    __device__ __forceinline__ bool next(int i, Unit& u) const {
        if (i >= NCH) return false;
        const int n = dir ? (NCH - 1 - i) : i, blk = bh * NCH + n;
        u.a = A + (size_t)blk * (256 * 256); u.b = Bt + (size_t)blk * (256 * 256); u.pm = blk; u.pn = i; u.keep = 1; u.aux = n; return true;
    }
};
struct MoeSched {
    const char* A; const char* Bt; const int* tile_e; int ntiles, nN, G, c;
    __device__ __forceinline__ bool next(int i, Unit& u) const {
        const int L = i * G + c; if (L >= ntiles * nN) return false;
        int pm, pn; tile_order(L, ntiles, nN, pm, pn);
        const int e = __builtin_amdgcn_readfirstlane(tile_e[pm]);
        u.a = A + (size_t)pm * (256 * 2048); u.b = Bt + ((size_t)e * nN + pn) * (256 * 2048); u.pm = pm; u.pn = pn; u.keep = 0; u.aux = e; return true;
    }
};
}
using pg8::Unit;

#define EPI_LOOP _Pragma("unroll") for (int ai = 0; ai < 2; ++ai) _Pragma("unroll") for (int m = 0; m < 4; ++m)
#define EPI_ROW (ai * 128 + wr * 64 + m * 16 + fr)
#define EPI_FENCE asm volatile("" ::: "memory")
typedef f32x4 Acc[2][2][4][2];

__device__ __forceinline__ void rot4(const f32x4 x1, const f32x4 x2, const f32x4 csA, const f32x4 csB, f32x4& o1, f32x4& o2) {
    o1[0] = x1[0] * csA[0] - x2[0] * csA[1]; o2[0] = x1[0] * csA[1] + x2[0] * csA[0];
    o1[1] = x1[1] * csA[2] - x2[1] * csA[3]; o2[1] = x1[1] * csA[3] + x2[1] * csA[2];
    o1[2] = x1[2] * csB[0] - x2[2] * csB[1]; o2[2] = x1[2] * csB[1] + x2[2] * csB[0];
    o1[3] = x1[3] * csB[2] - x2[3] * csB[3]; o2[3] = x1[3] * csB[3] + x2[3] * csB[2];
}
__device__ __forceinline__ f32x4 rot_il(const f32x4 v, const f32x4 cs) {
    return (f32x4){v[0] * cs[0] - v[1] * cs[1], v[0] * cs[1] + v[1] * cs[0], v[2] * cs[2] - v[3] * cs[3], v[2] * cs[3] + v[3] * cs[2]};
}

struct EpiInproj {
    bf16_t *QL, *CKV, *KR, *ACAT, *KROT, *SG, *GA, *GB; float *ssqp; const float* cs_ret; const float* cs_mla; const float* dectab; int pn_off; float unscale;
    __device__ __forceinline__ void operator()(Acc& acc, const Unit& u, int wr, int wc, int fr, int fq) const {
        asm volatile("" : "+v"(fr), "+v"(fq));
        const int pn = u.pn + pn_off, tok0 = u.pm * 256, cb = wc * 32 + fq * 8;
        if (pn < 4) {
            bf16_t* dst = QL + (size_t)(pn >> 1) * ((WS_CKV - WS_QL) / 2); float* ssq = ssqp + (size_t)(pn * 4 + wc) * T; const int c0 = (pn & 1) * 256 + cb;
            EPI_LOOP { const int row = tok0 + EPI_ROW; float s = 0.f;
#pragma unroll
                for (int bj = 0; bj < 2; ++bj) { const f32x4 v0 = acc[ai][bj][m][0], v1 = acc[ai][bj][m][1];
                    s += (v0[0] * v0[0] + v0[1] * v0[1]) + (v0[2] * v0[2] + v0[3] * v0[3]) + (v1[0] * v1[0] + v1[1] * v1[1]) + (v1[2] * v1[2] + v1[3] * v1[3]);
                    *(u32x4*)(dst + (size_t)row * 512 + c0 + bj * 128) = pack8(v0, v1); }
                s += __shfl_xor(s, 16); s += __shfl_xor(s, 32);
                if (fq == 0) ssq[row] = s; EPI_FENCE; }
        } else if (pn == 4) {
            if (wc < 2) {
                EPI_LOOP { const int row = tok0 + EPI_ROW; const float* cs = cs_mla + (size_t)row * 64 + cb;
                    const f32x4 csA = *(const f32x4*)cs, csB = *(const f32x4*)(cs + 4);
                    *(u32x4*)(KR + (size_t)row * 64 + cb) = pack8(rot_il(acc[ai][0][m][0], csA), rot_il(acc[ai][0][m][1], csB)); EPI_FENCE; }
            }
        } else if (pn < 21) {
            const bool isq = pn < 13; const int h = isq ? pn - 5 : pn - 13;
            const int blk = ((u.pm >> 4) * 8 + h) * NCH + (u.pm & 15);
            const float lf = dectab[h], lb = dectab[8 + h];
            EPI_LOOP { const int c = EPI_ROW, row = tok0 + c; const float* cs = cs_ret + (size_t)row * 256 + cb * 2;
                f32x4 q1[2], q2[2];
#pragma unroll
                for (int n = 0; n < 2; ++n) { const f32x4 csA = *(const f32x4*)(cs + n * 8), csB = *(const f32x4*)(cs + n * 8 + 4); rot4(acc[ai][0][m][n], acc[ai][1][m][n], csA, csB, q1[n], q2[n]); }
                if (isq) {
                    const float xf = __builtin_amdgcn_exp2f((float)(c + 1) * lf), xb = __builtin_amdgcn_exp2f((float)(CH - c) * lb);
                    bf16_t* base = ACAT + ((size_t)blk * 256 + c) * 768 + cb;
                    *(u32x4*)(base + 256) = pack8(q1[0] * xf, q1[1] * xf); *(u32x4*)(base + 384) = pack8(q2[0] * xf, q2[1] * xf);
                    *(u32x4*)(base + 512) = pack8(q1[0] * xb, q1[1] * xb); *(u32x4*)(base + 640) = pack8(q2[0] * xb, q2[1] * xb);
                } else {
                    bf16_t* base = KROT + ((size_t)blk * 256 + c) * 256 + cb;
                    *(u32x4*)(base) = pack8(q1[0] * 0.0625f, q1[1] * 0.0625f); *(u32x4*)(base + 128) = pack8(q2[0] * 0.0625f, q2[1] * 0.0625f);
                }
                EPI_FENCE; }
        } else {
            const int g = (pn - 21) >> 3, ct = (pn - 21) & 7; bf16_t* dst = SG + (size_t)g * ((WS_GA - WS_SG) / 2);
            EPI_LOOP { const int row = tok0 + EPI_ROW;
#pragma unroll
                for (int bj = 0; bj < 2; ++bj) { f32x4 v[2];
#pragma unroll
                    for (int n = 0; n < 2; ++n)
#pragma unroll
                        for (int j = 0; j < 4; ++j) { const float x = acc[ai][bj][m][n][j] * unscale; const float sg = sigmoidf_(x); v[n][j] = g == 0 ? x * sg : sg; }
                    *(u32x4*)(dst + (size_t)row * 2048 + ct * 256 + bj * 128 + cb) = pack8(v[0], v[1]); }
                EPI_FENCE; }
        }
    }
};
struct EpiVT {
    bf16_t* BCAT; unsigned char* VT8;
    __device__ __forceinline__ void operator()(Acc& acc, const Unit& u, int wr, int wc, int fr, int fq) const {
        asm volatile("" : "+v"(fr), "+v"(fq));
        const int blk = ((u.pn >> 4) * 8 + u.pm) * NCH + (u.pn & 15), cb = wc * 32 + fq * 8;
        EPI_LOOP { bf16_t* base = BCAT + ((size_t)blk * 256 + EPI_ROW) * 768 + cb; unsigned char* b8 = VT8 + ((size_t)blk * 256 + EPI_ROW) * 256 + cb;
#pragma unroll
            for (int bj = 0; bj < 2; ++bj) { const f32x4 v0 = acc[ai][bj][m][0], v1 = acc[ai][bj][m][1]; *(u32x4*)(base + bj * 128) = pack8(v0, v1);
                u32x2 w8; w8.x = pk4_fp8(v0[0], v0[1], v0[2], v0[3], V8_SCALE); w8.y = pk4_fp8(v1[0], v1[1], v1[2], v1[3], V8_SCALE); *(u32x2*)(b8 + bj * 128) = w8; } }
    }
};
struct EpiInprojAll {
    EpiInproj a; EpiVT b;
    __device__ __forceinline__ void operator()(Acc& acc, const Unit& u, int wr, int wc, int fr, int fq) const { if (u.aux) b(acc, u, wr, wc, fr, fq); else a(acc, u, wr, wc, fr, fq); }
};
struct EpiMlaQ {
    bf16_t *QN, *QR; const float* ssq; const float* cs_mla;
    __device__ __forceinline__ void operator()(Acc& acc, const Unit& u, int wr, int wc, int fr, int fq) const {
        asm volatile("" : "+v"(fr), "+v"(fq));
        const int pn = u.pn, tok0 = u.pm * 256, cb = wc * 32 + fq * 8;
        EPI_LOOP { const int row = tok0 + EPI_ROW; float ss = 0.f;
#pragma unroll
            for (int q = 0; q < 8; ++q) ss += ssq[(size_t)q * T + row];
            const float rs = rsqrtf(ss * (1.0f / 512.0f) + RMS_EPS) * QSCALE;
            if (pn < 4) {
#pragma unroll
                for (int bj = 0; bj < 2; ++bj) *(u32x4*)(QN + (size_t)row * 1024 + (2 * pn + bj) * 128 + cb) = pack8(acc[ai][bj][m][0] * rs, acc[ai][bj][m][1] * rs);
            } else {
                const int c0 = (wc & 1) * 32 + fq * 8; const float* cs = cs_mla + (size_t)row * 64 + c0;
                const f32x4 csA = *(const f32x4*)cs, csB = *(const f32x4*)(cs + 4);
#pragma unroll
                for (int bj = 0; bj < 2; ++bj) { const int head = 4 * (pn - 4) + 2 * bj + (wc >> 1);
                    *(u32x4*)(QR + (size_t)row * 512 + head * 64 + c0) = pack8(rot_il(acc[ai][bj][m][0], csA) * rs, rot_il(acc[ai][bj][m][1], csB) * rs); }
            }
            EPI_FENCE; }
    }
};
struct EpiMlaKV {
    bf16_t *KN, *VV; const float* ssq;
    __device__ __forceinline__ void operator()(Acc& acc, const Unit& u, int wr, int wc, int fr, int fq) const {
        asm volatile("" : "+v"(fr), "+v"(fq));
        const int pn = u.pn, tok0 = u.pm * 256, cb = wc * 32 + fq * 8; bf16_t* dst = KN + (size_t)(pn >> 2) * ((WS_VV - WS_KN) / 2); const int hb = 2 * (pn & 3);
        EPI_LOOP { const int row = tok0 + EPI_ROW; float ss = 0.f;
#pragma unroll
            for (int q = 0; q < 8; ++q) ss += ssq[(size_t)q * T + row];
            const float rs = rsqrtf(ss * (1.0f / 512.0f) + RMS_EPS);
#pragma unroll
            for (int bj = 0; bj < 2; ++bj) *(u32x4*)(dst + (size_t)row * 1024 + (hb + bj) * 128 + cb) = pack8(acc[ai][bj][m][0] * rs, acc[ai][bj][m][1] * rs); }
    }
};
struct EpiGa {
    bf16_t* ACAT; const float* dectab;
    __device__ __forceinline__ void operator()(Acc& acc, const Unit& u, int wr, int wc, int fr, int fq) const {
        asm volatile("" : "+v"(fr), "+v"(fq));
        const int blk = u.pm, h = (blk >> 4) & 7, cb = wc * 32 + fq * 8;
        const float lf = dectab[h], lb = dectab[8 + h];
        f32x4 colA[2][2], colB[2][2];
#pragma unroll
        for (int bj = 0; bj < 2; ++bj)
#pragma unroll
            for (int n = 0; n < 2; ++n)
#pragma unroll
                for (int j = 0; j < 4; ++j) { const int mm = bj * 128 + cb + n * 4 + j; colA[bj][n][j] = __builtin_amdgcn_exp2f(-(float)(mm + 1) * lf); colB[bj][n][j] = __builtin_amdgcn_exp2f((float)mm * lb); }
        EPI_LOOP { const int c = EPI_ROW; bf16_t* base = ACAT + ((size_t)blk * 256 + c) * 768 + cb;
            const float rowB = __builtin_amdgcn_exp2f(-(float)c * lb - (float)(c + 1) * lf);
#pragma unroll
            for (int bj = 0; bj < 2; ++bj) { f32x4 v[2];
#pragma unroll
                for (int n = 0; n < 2; ++n)
#pragma unroll
                    for (int j = 0; j < 4; ++j) { const int mm = bj * 128 + cb + n * 4 + j;
                        v[n][j] = acc[ai][bj][m][n][j] * ((c >= mm) ? colA[bj][n][j] : colB[bj][n][j] * rowB); }
                *(u32x4*)(base + bj * 128) = pack8(v[0], v[1]); }
            EPI_FENCE; }
    }
};
struct EpiGb {
    bf16_t* BCAT; const float* dectab; int dir;
    __device__ __forceinline__ void operator()(Acc& acc, const Unit& u, int wr, int wc, int fr, int fq) const {
        asm volatile("" : "+v"(fr), "+v"(fq));
        const int h = (u.pm >> 4) & 7;
        const float gC = __builtin_amdgcn_exp2f((float)CH * dectab[8 * dir + h]);
        if (u.pn < NCH - 1) {
            const int nblk = dir ? u.pm - 1 : u.pm + 1;
            bf16_t* base0 = BCAT + ((size_t)nblk * 256 + wr * 64 + fr) * 768 + 256 + 256 * dir + wc * 32 + fq * 8;
            EPI_LOOP { bf16_t* base = base0 + (size_t)(ai * 128 + m * 16) * 768;
#pragma unroll
                for (int bj = 0; bj < 2; ++bj) *(u32x4*)(base + bj * 128) = pack8(acc[ai][bj][m][0] * CH_UNSCALE, acc[ai][bj][m][1] * CH_UNSCALE); }
        }
        EPI_LOOP {
#pragma unroll
            for (int bj = 0; bj < 2; ++bj) { acc[ai][bj][m][0] *= gC; acc[ai][bj][m][1] *= gC; } }
    }
};
struct EpiGc {
    bf16_t* OB; const bf16_t* SG; const float* gn; LAS unsigned char* lds;
    __device__ __forceinline__ void operator()(Acc& acc, const Unit& u, int wr, int wc, int fr, int fq) const {
        asm volatile("" : "+v"(fr), "+v"(fq));
        const int blk = u.pm, b = blk >> 7, h = (blk >> 4) & 7, n = blk & 15, cb = wc * 32 + fq * 8;
        LAS f32x2* P = (LAS f32x2*)(lds + RING_BYTES);
        EPI_LOOP { float s = 0.f;
#pragma unroll
            for (int bj = 0; bj < 2; ++bj)
#pragma unroll
                for (int nn = 0; nn < 2; ++nn) { const f32x4 x = acc[ai][bj][m][nn]; s += (x[0] + x[1]) + (x[2] + x[3]); }
            s += __shfl_xor(s, 16); s += __shfl_xor(s, 32);
            const float mw = s * (1.0f / 64.0f); float q = 0.f;
#pragma unroll
            for (int bj = 0; bj < 2; ++bj)
#pragma unroll
                for (int nn = 0; nn < 2; ++nn) { const f32x4 d = acc[ai][bj][m][nn] - mw; q += (d[0] * d[0] + d[1] * d[1]) + (d[2] * d[2] + d[3] * d[3]); }
            q += __shfl_xor(q, 16); q += __shfl_xor(q, 32);
            if (fq == 0) P[EPI_ROW * 4 + wc] = (f32x2){mw, q}; }
        asm volatile("s_waitcnt lgkmcnt(0)" ::: "memory"); __builtin_amdgcn_s_barrier(); asm volatile("" ::: "memory");
        EPI_LOOP { const int row = EPI_ROW; const f32x4 p01 = *(const LAS f32x4*)(P + row * 4), p23 = *(const LAS f32x4*)(P + row * 4 + 2);
            const float mean = ((p01[0] + p01[2]) + (p23[0] + p23[2])) * 0.25f;
            const float d0 = p01[0] - mean, d1 = p01[2] - mean, d2 = p23[0] - mean, d3 = p23[2] - mean;
            const float m2 = ((p01[1] + p01[3]) + (p23[1] + p23[3])) + 64.0f * ((d0 * d0 + d1 * d1) + (d2 * d2 + d3 * d3));
            const float rstd = rsqrtf(m2 * (1.0f / 256.0f) + GN_EPS);
            const size_t off = ((size_t)b * SEQ + n * 256 + row) * 2048 + h * 256 + cb;
#pragma unroll
            for (int bj = 0; bj < 2; ++bj) { f32x4 s0, s1; unpack8(*(const u32x4*)(SG + off + bj * 128), s0, s1);
                const f32x4 g0 = *(const f32x4*)(gn + h * 256 + bj * 128 + cb), g1 = *(const f32x4*)(gn + h * 256 + bj * 128 + cb + 4);
                *(u32x4*)(OB + off + bj * 128) = pack8(s0 * ((acc[ai][bj][m][0] - mean) * rstd * g0), s1 * ((acc[ai][bj][m][1] - mean) * rstd * g1)); }
            EPI_FENCE; }
    }
};
struct EpiMixA {
    bf16_t* MIXP; const bf16_t* GA;
    __device__ __forceinline__ void operator()(Acc& acc, const Unit& u, int wr, int wc, int fr, int fq) const {
        asm volatile("" : "+v"(fr), "+v"(fq));
        const int cb = wc * 32 + fq * 8;
        EPI_LOOP { const size_t off = (size_t)(u.pm * 256 + EPI_ROW) * 2048 + u.pn * 256 + cb;
#pragma unroll
            for (int bj = 0; bj < 2; ++bj) { f32x4 g0, g1; unpack8(*(const u32x4*)(GA + off + bj * 128), g0, g1);
                *(u32x4*)(MIXP + off + bj * 128) = pack8(acc[ai][bj][m][0] * g0, acc[ai][bj][m][1] * g1); }
            EPI_FENCE; }
    }
};
struct EpiMixB {
    bf16_t* MIXIN; const bf16_t* MIXP; const bf16_t* GB;
    __device__ __forceinline__ void operator()(Acc& acc, const Unit& u, int wr, int wc, int fr, int fq) const {
        asm volatile("" : "+v"(fr), "+v"(fq));
        const int cb = wc * 32 + fq * 8;
        EPI_LOOP { const size_t off = (size_t)(u.pm * 256 + EPI_ROW) * 2048 + u.pn * 256 + cb;
#pragma unroll
            for (int bj = 0; bj < 2; ++bj) { f32x4 g0, g1, p0, p1; unpack8(*(const u32x4*)(GB + off + bj * 128), g0, g1); unpack8(*(const u32x4*)(MIXP + off + bj * 128), p0, p1);
                *(u32x4*)(MIXIN + off + bj * 128) = pack8(acc[ai][bj][m][0] * g0 + p0, acc[ai][bj][m][1] * g1 + p1); }
            EPI_FENCE; }
    }
};
struct EpiF32 {
    bf16_t* C;
    __device__ __forceinline__ void operator()(Acc& acc, const Unit& u, int wr, int wc, int fr, int fq) const {
        asm volatile("" : "+v"(fr), "+v"(fq));
        const int cb = wc * 32 + fq * 8;
        EPI_LOOP { bf16_t* base = C + (size_t)(u.pm * 256 + EPI_ROW) * 2048 + u.pn * 256 + cb;
#pragma unroll
            for (int bj = 0; bj < 2; ++bj) *(u32x4*)(base + bj * 128) = pack8(acc[ai][bj][m][0], acc[ai][bj][m][1]); }
    }
};
struct EpiGU {
    bf16_t* ACT; const float* bgu; int skip;
    __device__ __forceinline__ void operator()(Acc& acc, const Unit& u, int wr, int wc, int fr, int fq) const {
        asm volatile("" : "+v"(fr), "+v"(fq));
        if (skip) return;
        const int cb = wc * 32 + fq * 8, col = u.pn * 128 + cb; const float* bg = bgu + (size_t)u.aux * 4096 + col;
        const f32x4 bg0 = *(const f32x4*)bg, bg1 = *(const f32x4*)(bg + 4), bu0 = *(const f32x4*)(bg + 2048), bu1 = *(const f32x4*)(bg + 2052);
        EPI_LOOP { f32x4 v[2];
#pragma unroll
            for (int n = 0; n < 2; ++n)
#pragma unroll
                for (int j = 0; j < 4; ++j) { const float gt = fminf(acc[ai][0][m][n][j] * GU_UNSCALE + (n ? bg1[j] : bg0[j]), 7.0f); const float up = fminf(fmaxf(acc[ai][1][m][n][j] * GU_UNSCALE + (n ? bu1[j] : bu0[j]), -7.0f), 7.0f);
                    v[n][j] = (up + 1.0f) * gt * sigmoidf_(1.702f * gt); }
            u32x2 w8; w8.x = pk4_fp8(v[0][0], v[0][1], v[0][2], v[0][3], A8_SCALE); w8.y = pk4_fp8(v[1][0], v[1][1], v[1][2], v[1][3], A8_SCALE);
            *(u32x2*)((unsigned char*)ACT + (size_t)(u.pm * 256 + EPI_ROW) * 2048 + col) = w8; EPI_FENCE; }
    }
};
struct EpiDown {
    bf16_t* YS; const float* bd;
    __device__ __forceinline__ void operator()(Acc& acc, const Unit& u, int wr, int wc, int fr, int fq) const {
        asm volatile("" : "+v"(fr), "+v"(fq));
        const int cb = wc * 32 + fq * 8; const float* bp = bd + (size_t)u.aux * 2048 + u.pn * 256 + cb;
        f32x4 bv[2][2];
#pragma unroll
        for (int bj = 0; bj < 2; ++bj) { bv[bj][0] = *(const f32x4*)(bp + bj * 128); bv[bj][1] = *(const f32x4*)(bp + bj * 128 + 4); }
        EPI_LOOP { bf16_t* base = YS + (size_t)(u.pm * 256 + EPI_ROW) * 2048 + u.pn * 256 + cb;
#pragma unroll
            for (int bj = 0; bj < 2; ++bj) *(u32x4*)(base + bj * 128) = pack8(acc[ai][bj][m][0] * DN_UNSCALE + bv[bj][0], acc[ai][bj][m][1] * DN_UNSCALE + bv[bj][1]); }
    }
};

namespace att {
constexpr int NW = 8, QBLK = 32, KVBLK = 64;
constexpr float THR = 8.f;
constexpr int SHM_V = KVBLK * 128 * 2, SHM_KN = KVBLK * 128 * 2, SHM_KR = KVBLK * 64 * 2, NVB = 3, SHM_ATTN = NVB * SHM_V + 2 * SHM_KN + 2 * SHM_KR + NW * 64 * 4;
#define KSWZ(row, colB) ((row) * 256 + ((colB) ^ (((row) & 7) << 4)))
#define KSWZR(row, colB) ((row) * 128 + ((colB) ^ (((row) & 7) << 4)))
#define SBAR() __builtin_amdgcn_sched_barrier(0)
__device__ __forceinline__ int crow(int r, int hi) { return (r & 3) + 8 * (r >> 2) + 4 * hi; }
__device__ __forceinline__ void partialSM(f32x16& p0, f32x16& p1, float& m_reg, float& mn, float& alpha) {
    constexpr float C = 1.4426950408889634f;
    float pmax = p0[0];
#pragma unroll
    for (int r = 1; r < 16; ++r) pmax = fmaxf(pmax, p0[r]);
#pragma unroll
    for (int r = 0; r < 16; ++r) pmax = fmaxf(pmax, p1[r]);
    { auto rr = __builtin_amdgcn_permlane32_swap(__float_as_uint(pmax), __float_as_uint(pmax), false, false);
      pmax = fmaxf(__uint_as_float(rr[0]), __uint_as_float(rr[1])); }
    if (__builtin_expect(__all(pmax - m_reg <= THR), 1)) { mn = m_reg; alpha = 1.f; }
    else { mn = fmaxf(m_reg, pmax); alpha = __builtin_amdgcn_exp2f((m_reg - mn) * C); m_reg = mn; }
    const float mnC = -mn * C;
#pragma unroll
    for (int r = 0; r < 16; ++r) p0[r] = fmaf(p0[r], C, mnC);
#pragma unroll
    for (int r = 0; r < 16; ++r) p1[r] = fmaf(p1[r], C, mnC);
#pragma unroll
    for (int r = 0; r < 16; ++r) p0[r] = __builtin_amdgcn_exp2f(p0[r]);
}
__device__ __forceinline__ void finishSM(f32x16& p0, f32x16& p1, float alpha, float& l_reg, bf16x8& pa0, bf16x8& pa1, bf16x8& pa2, bf16x8& pa3) {
#pragma unroll
    for (int r = 0; r < 16; ++r) p1[r] = __builtin_amdgcn_exp2f(p1[r]);
    float ps = 0;
#pragma unroll
    for (int r = 0; r < 16; ++r) ps += p0[r];
#pragma unroll
    for (int r = 0; r < 16; ++r) ps += p1[r];
    { auto rr = __builtin_amdgcn_permlane32_swap(__float_as_uint(ps), __float_as_uint(ps), false, false);
      ps = __uint_as_float(rr[0]) + __uint_as_float(rr[1]); }
    l_reg = l_reg * alpha + ps;
#define PK4(P, BASE, OUT) do { unsigned a0 = cvt_pk_bf16(P[BASE + 0], P[BASE + 1]), a1 = cvt_pk_bf16(P[BASE + 2], P[BASE + 3]);   \
    unsigned b0 = cvt_pk_bf16(P[BASE + 4], P[BASE + 5]), b1 = cvt_pk_bf16(P[BASE + 6], P[BASE + 7]);                              \
    auto r0 = __builtin_amdgcn_permlane32_swap(a0, b0, false, false); auto r1 = __builtin_amdgcn_permlane32_swap(a1, b1, false, false); \
    u32x4 w = {r0[0], r1[0], r0[1], r1[1]}; OUT = *reinterpret_cast<bf16x8*>(&w); } while (0)
    PK4(p0, 0, pa0); PK4(p0, 8, pa1); PK4(p1, 0, pa2); PK4(p1, 8, pa3);
#undef PK4
}
__device__ __forceinline__ void qkt(f32x16& p0, f32x16& p1, const char* Kns, const char* Krs, const bf16x8* qr, int r32, int hi) {
    p0 = f32x16{}; p1 = f32x16{};
#pragma unroll
    for (int d0 = 0; d0 < 12; ++d0) { const int cb = ((d0 & 7) * 16 + hi * 8) * 2;
        const bf16x8 b0 = *reinterpret_cast<const bf16x8*>(d0 < 8 ? Kns + KSWZ(r32, cb) : Krs + KSWZR(r32, cb));
        const bf16x8 b1 = *reinterpret_cast<const bf16x8*>(d0 < 8 ? Kns + KSWZ(32 + r32, cb) : Krs + KSWZR(32 + r32, cb));
        p0 = __builtin_amdgcn_mfma_f32_32x32x16_bf16(b0, qr[d0], p0, 0, 0, 0);
        p1 = __builtin_amdgcn_mfma_f32_32x32x16_bf16(b1, qr[d0], p1, 0, 0, 0); }
}
__device__ __forceinline__ int v_st(int k, int c) { const int kk = (k & ~0xC) | ((k & 4) << 1) | ((k & 8) >> 1); return ((kk >> 3) * 4 + (c >> 5)) * 512 + ((kk & 7) * 32 + (c & 31)) * 2; }
__device__ __forceinline__ int v_rd_base(int lane) { return ((lane & 3) << 3) | (((lane >> 2) & 3) << 6) | (((lane >> 4) & 1) << 5) | (((lane >> 5) & 1) << 8); }
constexpr int v_rd_off(int d0, int ks, int half) { return d0 * 512 + ks * 4096 + half * 2048; }
template <int OFF> __device__ __forceinline__ s16x4 tr_read(int vb) {
    s16x4 r; asm volatile("ds_read_b64_tr_b16 %0, %1 offset:%2" : "=&v"(r) : "v"(vb), "i"(OFF) : "memory"); return r;
}
template <int D0> __device__ __forceinline__ void pv_one(f32x16& od, int vb, bf16x8 pa0, bf16x8 pa1, bf16x8 pa2, bf16x8 pa3) {
    const s16x4 l0 = tr_read<v_rd_off(D0, 0, 0)>(vb), h0 = tr_read<v_rd_off(D0, 0, 1)>(vb), l1 = tr_read<v_rd_off(D0, 1, 0)>(vb), h1 = tr_read<v_rd_off(D0, 1, 1)>(vb);
    const s16x4 l2 = tr_read<v_rd_off(D0, 2, 0)>(vb), h2 = tr_read<v_rd_off(D0, 2, 1)>(vb), l3 = tr_read<v_rd_off(D0, 3, 0)>(vb), h3 = tr_read<v_rd_off(D0, 3, 1)>(vb);
    asm volatile("s_waitcnt lgkmcnt(0)" ::: "memory"); SBAR();
#define PKV(L, H) (bf16x8){L[0], L[1], L[2], L[3], H[0], H[1], H[2], H[3]}
    od = __builtin_amdgcn_mfma_f32_32x32x16_bf16(pa0, PKV(l0, h0), od, 0, 0, 0);
    od = __builtin_amdgcn_mfma_f32_32x32x16_bf16(pa1, PKV(l1, h1), od, 0, 0, 0);
    od = __builtin_amdgcn_mfma_f32_32x32x16_bf16(pa2, PKV(l2, h2), od, 0, 0, 0);
    od = __builtin_amdgcn_mfma_f32_32x32x16_bf16(pa3, PKV(l3, h3), od, 0, 0, 0);
#undef PKV
}
__device__ __forceinline__ void pv_d0(f32x16* o, int vb, bf16x8 pa0, bf16x8 pa1, bf16x8 pa2, bf16x8 pa3) {
    pv_one<0>(o[0], vb, pa0, pa1, pa2, pa3); pv_one<1>(o[1], vb, pa0, pa1, pa2, pa3); pv_one<2>(o[2], vb, pa0, pa1, pa2, pa3); pv_one<3>(o[3], vb, pa0, pa1, pa2, pa3);
}
__device__ __forceinline__ void attn_unit(const bf16_t* __restrict__ Qn, const bf16_t* __restrict__ Qr, const bf16_t* __restrict__ Kn, const bf16_t* __restrict__ Kr,
                                          const bf16_t* __restrict__ Vh, bf16_t* __restrict__ Ob, int seq, char* lds) {
    const int tid = threadIdx.x, wid = __builtin_amdgcn_readfirstlane(tid >> 6), lane = tid & 63, r32 = lane & 31, hi = lane >> 5;
    char* V_lds = lds; char* Kn_lds = lds + NVB * SHM_V; char* Kr_lds = Kn_lds + 2 * SHM_KN;
    float* ws = (float*)(Kr_lds + 2 * SHM_KR) + wid * 64; float* li_l = ws; float* al_l = ws + 32;
    float m_reg = -1e30f, l_reg = 0; f32x16 o[4] = {}; bf16x8 qr[12];
    { const bf16_t* q0 = Qn + (long)(wid * QBLK + r32) * 1024 + hi * 8; const bf16_t* q1 = Qr + (long)(wid * QBLK + r32) * 512 + hi * 8;
#pragma unroll
      for (int d0 = 0; d0 < 8; ++d0) qr[d0] = *reinterpret_cast<const bf16x8*>(q0 + d0 * 16);
#pragma unroll
      for (int d0 = 0; d0 < 4; ++d0) qr[8 + d0] = *reinterpret_cast<const bf16x8*>(q1 + d0 * 16); }
    const int vb0 = (int)(uintptr_t)V_lds + v_rd_base(lane);
    unsigned offV[2], offKn[2], offKr;
#pragma unroll
    for (int t = 0; t < 2; ++t) {
        { const int sub = 2 * (2 * wid + t) + (lane >> 5), kk = (sub >> 2) * 8 + ((lane & 31) >> 2), k = (kk & ~0xC) | ((kk & 4) << 1) | ((kk & 8) >> 1), c = (sub & 3) * 32 + (lane & 3) * 8; offV[t] = (unsigned)(k * 1024 + c) * 2u; }
        { const int row = 4 * (2 * wid + t) + (lane >> 4), colB = ((lane & 15) * 16) ^ ((row & 7) << 4); offKn[t] = (unsigned)(row * 1024) * 2u + (unsigned)colB; } }
    { const int row = 8 * wid + (lane >> 3), colB = ((lane & 7) * 16) ^ ((row & 7) << 4); offKr = (unsigned)(row * 64) * 2u + (unsigned)colB; }
#define LASP(p) ((LAS unsigned*)(unsigned)(uintptr_t)(p))
#define SLOAD(k0, b, bv) do { _Pragma("unroll") for (int t = 0; t < 2; ++t) { \
        __builtin_amdgcn_global_load_lds((const unsigned*)((const char*)Vh + (size_t)(k0) * 2048 + offV[t]), LASP(V_lds + (bv) * SHM_V + (2 * wid + t) * 1024), 16, 0, 0); \
        __builtin_amdgcn_global_load_lds((const unsigned*)((const char*)Kn + (size_t)(k0) * 2048 + offKn[t]), LASP(Kn_lds + (b) * SHM_KN + (2 * wid + t) * 1024), 16, 0, 0); } \
        __builtin_amdgcn_global_load_lds((const unsigned*)((const char*)Kr + (size_t)(k0) * 128 + offKr), LASP(Kr_lds + (b) * SHM_KR + wid * 1024), 16, 0, 0); } while (0)
#define SWAIT() asm volatile("s_waitcnt vmcnt(0)" ::: "memory")
#define RESC(a) do { if (__any((a) < 1.f)) { if (hi == 0) al_l[r32] = (a); asm volatile("s_waitcnt lgkmcnt(0)" ::: "memory"); \
    _Pragma("unroll") for (int d = 0; d < 4; ++d) _Pragma("unroll") for (int r = 0; r < 16; ++r) o[d][r] *= al_l[crow(r, hi)]; } } while (0)
    f32x16 p0, p1; float mn, al; bf16x8 pa0, pa1, pa2, pa3; const int NT = seq / KVBLK;
    SLOAD(0, 0, 0); SWAIT(); __syncthreads();
    if (wid < 4) {
        int bv = 0;
        for (int j = 0; j < NT; ++j) {
            const int buf = j & 1, bvn = bv == NVB - 1 ? 0 : bv + 1;
            if (j + 1 < NT) SLOAD((j + 1) * KVBLK, buf ^ 1, bvn);
            SBAR(); qkt(p0, p1, Kn_lds + buf * SHM_KN, Kr_lds + buf * SHM_KR, qr, r32, hi);
            partialSM(p0, p1, m_reg, mn, al);
            RESC(al);
            finishSM(p0, p1, al, l_reg, pa0, pa1, pa2, pa3); SBAR();
            pv_d0(o, vb0 + bv * SHM_V, pa0, pa1, pa2, pa3);
            SWAIT();
            __syncthreads();
            bv = bvn;
        }
    } else {
        int bv = 0, bvp = 0;
        for (int j = 0; j < NT; ++j) {
            const int buf = j & 1, bvn = bv == NVB - 1 ? 0 : bv + 1;
            if (j + 1 < NT) SLOAD((j + 1) * KVBLK, buf ^ 1, bvn);
            if (j > 0) { SBAR(); pv_d0(o, vb0 + bvp * SHM_V, pa0, pa1, pa2, pa3); SBAR(); }
            SBAR(); qkt(p0, p1, Kn_lds + buf * SHM_KN, Kr_lds + buf * SHM_KR, qr, r32, hi);
            partialSM(p0, p1, m_reg, mn, al);
            RESC(al);
            finishSM(p0, p1, al, l_reg, pa0, pa1, pa2, pa3); SBAR();
            SWAIT();
            __syncthreads();
            bvp = bv; bv = bvn;
        }
        SBAR(); pv_d0(o, vb0 + bvp * SHM_V, pa0, pa1, pa2, pa3);
    }
    if (hi == 0) li_l[r32] = l_reg; asm volatile("s_waitcnt lgkmcnt(0)" ::: "memory");
    float rli[16];
#pragma unroll
    for (int r = 0; r < 16; ++r) rli[r] = __builtin_amdgcn_rcpf(li_l[crow(r, hi)]);
    bf16_t* Ow = Ob + (long)(wid * QBLK) * 1024;
#pragma unroll
    for (int r = 0; r < 16; ++r) { const int orow = crow(r, hi);
#pragma unroll
        for (int d0 = 0; d0 < 4; ++d0) Ow[(long)orow * 1024 + d0 * 32 + r32] = (bf16_t)(cvt_pk_bf16(o[d0][r] * rli[r], 0.f) & 0xffffu); }
#undef SLOAD
#undef LASP
#undef SWAIT
#undef RESC
}
}

struct Args { const float* in[26]; float* out; unsigned char* ws; int ph_lo, ph_hi; };
enum { PH_SETUP = 0, PH_H, PH_INPROJ, PH_INPROJ_V, PH_KT, PH_CHAIN, PH_MLAQ, PH_MLAKV, PH_GA, PH_ATTN, PH_GC, PH_MIXA, PH_GN, PH_MIXB, PH_MIX, PH_ROUTER, PH_DISPATCH, PH_GU, PH_DOWN, PH_COMBINE, NPH };
enum { I_X = 0, I_C, I_POS, I_WADA, I_BADA, I_GPREM, I_GPOSTM, I_GPREF, I_GPOSTF, I_WIN, I_QAN, I_WQB, I_KVAN, I_WKVB, I_WMLAO, I_DECF, I_DECB, I_RETGN, I_WRETO, I_WOUT, I_WROUTER, I_BROUTER, I_WGU, I_BGU, I_WDOWN, I_BDOWN };

__device__ __forceinline__ int src_in(int r) {
    if (r < 1024) return r;
    if (r < 1088) { const int j = r - 1024; return 1024 + (j >> 1) + 32 * (j & 1); }
    if (r < 1280) return -1;
    if (r < N_IN_NAT) { const int g = (r - 1280) >> 11, off = (r - 1280) & 2047; const int base = g == 0 ? 1088 : (g == 1 ? 3136 : (g == 2 ? 7232 : (g == 3 ? 9280 : 11328))); return base + off; }
    return 5184 + (r - N_IN_NAT);
}
__device__ __forceinline__ int src_qb(int r) { if (r < 1024) return (r >> 7) * 192 + (r & 127); const int j = r - 1024, h = j >> 6, jj = j & 63; return h * 192 + 128 + (jj >> 1) + 32 * (jj & 1); }
__device__ __forceinline__ int src_kvb(int r) { if (r < 1024) return (r >> 7) * 256 + (r & 127); const int j = r - 1024; return (j >> 7) * 256 + 128 + (j & 127); }
__device__ __forceinline__ int src_gu(int r) { const int t = r >> 8, rr = r & 255; return rr < 128 ? 128 * t + rr : 2048 + 128 * t + rr - 128; }

__device__ __forceinline__ void cvt_item(const float* __restrict__ W, int ldw, int K, bf16_t* __restrict__ WT, const float* __restrict__ kscale, int sc, int k0, int r0, LAS float* scr, int lane) {
    float v[64];
    const float* wp = W + (size_t)k0 * ldw + (sc >= 0 ? sc : 0);
#pragma unroll
    for (int i = 0; i < 64; ++i) v[i] = wp[(size_t)i * ldw];
    if (sc < 0) {
#pragma unroll
        for (int i = 0; i < 64; ++i) v[i] = 0.f;
    }
    if (kscale) {
#pragma unroll
        for (int i = 0; i < 64; ++i) v[i] *= kscale[k0 + i];
    }
#pragma unroll
    for (int i = 0; i < 64; ++i) scr[i * 65 + lane] = v[i];
    asm volatile("s_waitcnt lgkmcnt(0)" ::: "memory");
    const int c = lane & 7;
#pragma unroll
    for (int j = 0; j < 8; ++j) { const int n = (lane >> 3) + 8 * j; const LAS float* s = scr + (8 * c) * 65 + n;
        u32x4 o; o.x = cvt_pk_bf16(s[0 * 65], s[1 * 65]); o.y = cvt_pk_bf16(s[2 * 65], s[3 * 65]); o.z = cvt_pk_bf16(s[4 * 65], s[5 * 65]); o.w = cvt_pk_bf16(s[6 * 65], s[7 * 65]);
        *(u32x4*)(WT + (size_t)(r0 + n) * K + k0 + 8 * c) = o; }
    asm volatile("s_waitcnt lgkmcnt(0)" ::: "memory");
}

constexpr int XT_NT_GU = 32 * 16 * 16, XT_NT_ALL = XT_NT_GU + 32 * 16 * 8;
__device__ __forceinline__ void xt_convert_tiles(int q0, const int qs, const int qe, const float* __restrict__ wgu, const float* __restrict__ wdn, bf16_t* WT_GU, bf16_t* WT_DOWN, LAS unsigned char* lds, const int lane, const int wave) {
    constexpr int NT_GU = XT_NT_GU, TS = 144;
    f32x4 va[16], vb[16], vc[16];
#define XT_SRC(q_, kk_) ((q_) < NT_GU ? wgu + ((size_t)((q_) >> 8) * 2048 + (((q_) >> 4) & 15) * 128 + 16 * wave + (kk_)) * 4096 + (lane < 32 ? 128 * ((q_) & 15) + 4 * lane : 2048 + 128 * ((q_) & 15) + 4 * lane - 128) \
                                  : wdn + ((size_t)(((q_) - NT_GU) >> 7) * 2048 + ((((q_) - NT_GU) >> 3) & 15) * 128 + 16 * wave + (kk_)) * 2048 + 256 * (((q_) - NT_GU) & 7) + 4 * lane)
#define XT_LOAD(v_, q_) do { const float* _p = XT_SRC(q_, 0); const size_t _ld = (q_) < NT_GU ? 4096 : 2048; _Pragma("unroll") for (int kk = 0; kk < 16; ++kk) v_[kk] = __builtin_nontemporal_load((const f32x4*)(_p + kk * _ld)); } while (0)
#define XT_PROC(v_, q_, buf_) do { LAS unsigned char* _T = lds + (buf_) * (256 * TS); \
        _Pragma("unroll") for (int i = 0; i < 4; ++i) { u32x4 w0; \
            w0.x = pk4_fp8(v_[0][i], v_[1][i], v_[2][i], v_[3][i], W8_SCALE); w0.y = pk4_fp8(v_[4][i], v_[5][i], v_[6][i], v_[7][i], W8_SCALE); \
            w0.z = pk4_fp8(v_[8][i], v_[9][i], v_[10][i], v_[11][i], W8_SCALE); w0.w = pk4_fp8(v_[12][i], v_[13][i], v_[14][i], v_[15][i], W8_SCALE); \
            *(LAS u32x4*)(_T + (4 * lane + i) * TS + 16 * wave) = w0; } \
        __syncthreads(); \
        unsigned char* _d = (q_) < NT_GU ? (unsigned char*)WT_GU + ((size_t)((q_) >> 8) * 4096 + 256 * ((q_) & 15)) * 2048 + (((q_) >> 4) & 15) * 128 \
                 : (unsigned char*)WT_DOWN + ((size_t)(((q_) - NT_GU) >> 7) * 2048 + 256 * (((q_) - NT_GU) & 7)) * 2048 + ((((q_) - NT_GU) >> 3) & 15) * 128; \
        _Pragma("unroll") for (int j = 0; j < 4; ++j) { const int row = 32 * wave + 8 * j + (lane >> 3); \
            const u32x4 o = *(const LAS u32x4*)(_T + row * TS + (lane & 7) * 16); __builtin_nontemporal_store(o, (u32x4*)(_d + (size_t)row * 2048 + (lane & 7) * 16)); } } while (0)
    int q = q0;
    if (q < qe) XT_LOAD(va, q);
    if (q + qs < qe) XT_LOAD(vb, q + qs);
    while (q < qe) {
        const int q1 = q + qs, q2 = q1 + qs, q3 = q2 + qs, q4 = q3 + qs;
        if (q2 < qe) XT_LOAD(vc, q2);
        XT_PROC(va, q, 0);
        if (q1 >= qe) break;
        if (q3 < qe) XT_LOAD(va, q3);
        XT_PROC(vb, q1, 1);
        if (q2 >= qe) break;
        if (q4 < qe) XT_LOAD(vb, q4);
        XT_PROC(vc, q2, 2);
        q = q3;
    }
    __syncthreads();
#undef XT_SRC
#undef XT_LOAD
#undef XT_PROC
}
__host__ __device__ constexpr bool is_seam(int k) { return k == PH_SETUP || k == PH_H || k == PH_INPROJ_V || k == PH_KT || k == PH_GA || k == PH_ATTN || k == PH_MIXA || k == PH_MIXB || k == PH_MIX || k == PH_ROUTER || k == PH_DISPATCH || k == PH_GU || k == PH_DOWN; }
__host__ __device__ constexpr int seam_after(int ph) { int k = ph; while (k < NPH && !is_seam(k)) ++k; return k; }
__host__ __device__ constexpr int seam_before(int ph) { int k = ph - 1; while (k >= 0 && !is_seam(k)) --k; return k; }
__device__ __forceinline__ const void* larg(volatile LAS unsigned long long* L, int i) {
    const unsigned long long v = L[i]; const unsigned l0 = __builtin_amdgcn_readfirstlane((unsigned)v), h0 = __builtin_amdgcn_readfirstlane((unsigned)(v >> 32));
    return (const void*)(const __attribute__((address_space(1))) void*)(((unsigned long long)h0 << 32) | l0);
}
__global__ void __launch_bounds__(512, 2) fwd_kernel(Args args) {
    extern __shared__ __attribute__((aligned(16))) unsigned char lds_raw[];
    LAS unsigned char* lds = (LAS unsigned char*)lds_raw;
    volatile LAS unsigned* MISC = (volatile LAS unsigned*)(lds + MISC_OFF);
    const int tid = threadIdx.x;
    const int G = gridDim.x, bx = blockIdx.x, NGW = G * 8;
    volatile LAS unsigned long long* LARG = (volatile LAS unsigned long long*)(lds + LARG_OFF);
    const int lo = args.ph_lo, hi = args.ph_hi;
    for (int u = tid; u < (LDS_BYTES - CTRL_OFF) / 4; u += 512) ((LAS unsigned*)(lds + CTRL_OFF))[u] = 0u;
    __syncthreads();
    if (tid == 0) {
#pragma unroll
        for (int i = 0; i < 26; ++i) LARG[i] = (unsigned long long)args.in[i];
        LARG[26] = (unsigned long long)args.out; LARG[27] = (unsigned long long)args.ws;
    }
    __syncthreads();
    unsigned bar_x = 0u;
    if (hi - lo > 1) bar_x = xcd_barrier_post((unsigned*)(args.ws + WS_CTL) + CW_BAR, MISC + 8).x;
#ifdef PH_ONLY
#define IN(k) ((k) == PH_ONLY && lo <= (k) && (k) < hi)
#else
#define IN(k) (lo <= (k) && (k) < hi)
#endif
#define SEAM(k) do { if (lo <= (k) && (k) + 1 < hi) { XcdBarrier _b; _b.bar = (unsigned*)((unsigned char*)larg(LARG, 27) + WS_CTL) + CW_BAR; _b.x = bar_x; _b.st = MISC + 8; xcd_barrier(_b); } if (STAMP_PHASE >= 0) { const unsigned long long _t = __builtin_amdgcn_s_memrealtime(); if (seam_after(STAMP_PHASE) == (k)) st_dt = _t - st_t0; if (seam_before(STAMP_PHASE) == (k)) st_t0 = _t; } } while (0)
#define INP(i) ((const float*)larg(LARG, (i)))
#ifndef REP_PHASE
#define REP_PHASE (-1)
#endif
#define NREP(k) ((k) == REP_PHASE ? 2 : 1)
#ifndef STAMP_PHASE
#define STAMP_PHASE (-1)
#endif
#ifndef STAMP_MUL
#define STAMP_MUL 4
#endif
    unsigned long long st_t0 = (STAMP_PHASE >= 0 && seam_before(STAMP_PHASE) < 0) ? __builtin_amdgcn_s_memrealtime() : 0ull, st_dt = 0ull;
#define PTRS \
    int tid = threadIdx.x; asm volatile("" : "+v"(tid)); const int lane = tid & 63, wave = __builtin_amdgcn_readfirstlane(tid >> 6), gw = bx * 8 + wave; (void)lane; (void)gw; \
    unsigned char* const ws = (unsigned char*)larg(LARG, 27); unsigned* const ctl = (unsigned*)(ws + WS_CTL); float* const outp = (float*)larg(LARG, 26); \
    float* const ada = (float*)(ctl + CW_ADA); float* const SSQP = (float*)(ws + WS_SSQP); \
    bf16_t* const WT_IN = (bf16_t*)(ws + WS_WT_IN); bf16_t* const WT_QB = (bf16_t*)(ws + WS_WT_QB); bf16_t* const WT_KVB = (bf16_t*)(ws + WS_WT_KVB); bf16_t* const WT_MLAO = (bf16_t*)(ws + WS_WT_MLAO); \
    bf16_t* const WT_RETO = (bf16_t*)(ws + WS_WT_RETO); bf16_t* const WT_OUT = (bf16_t*)(ws + WS_WT_OUT); bf16_t* const WT_GU = (bf16_t*)(ws + WS_WT_GU); bf16_t* const WT_DOWN = (bf16_t*)(ws + WS_WT_DOWN); \
    float* const CS_RET = (float*)(ws + WS_CS_RET); float* const CS_MLA = (float*)(ws + WS_CS_MLA); \
    bf16_t* const Hb = (bf16_t*)(ws + WS_H); bf16_t* const QL = (bf16_t*)(ws + WS_QL); bf16_t* const CKV = (bf16_t*)(ws + WS_CKV); bf16_t* const KR = (bf16_t*)(ws + WS_KR); \
    bf16_t* const ACAT = (bf16_t*)(ws + WS_ACAT); bf16_t* const BCAT = (bf16_t*)(ws + WS_BCAT); bf16_t* const KROT = (bf16_t*)(ws + WS_KROT); bf16_t* const KZTF = (bf16_t*)(ws + WS_KZTF); bf16_t* const KZTB = (bf16_t*)(ws + WS_KZTB); \
    bf16_t* const SG = (bf16_t*)(ws + WS_SG); bf16_t* const GA = (bf16_t*)(ws + WS_GA); bf16_t* const GB = (bf16_t*)(ws + WS_GB); \
    bf16_t* const QN = (bf16_t*)(ws + WS_QN); bf16_t* const QR = (bf16_t*)(ws + WS_QR); bf16_t* const KN = (bf16_t*)(ws + WS_KN); bf16_t* const VV = (bf16_t*)(ws + WS_VV); bf16_t* const OA = (bf16_t*)(ws + WS_OA); \
    float* const ORET = (float*)(ws + WS_ORET); bf16_t* const OB = (bf16_t*)(ws + WS_OB); bf16_t* const MIXP = (bf16_t*)(ws + WS_MIXP); bf16_t* const MIXIN = (bf16_t*)(ws + WS_MIXIN); float* const MIX = (float*)(ws + WS_MIX); \
    bf16_t* const H2 = (bf16_t*)(ws + WS_H2); int* const TOPI = (int*)(ws + WS_TOPI); float* const TOPW = (float*)(ws + WS_TOPW); int* const DEST = (int*)(ws + WS_DEST); int* const TILE = (int*)(ws + WS_TILE); float* const DECTAB = (float*)(ws + WS_DECTAB); \
    bf16_t* const XS = (bf16_t*)(ws + WS_XS); bf16_t* const ACT = (bf16_t*)(ws + WS_ACT); bf16_t* const YS = (bf16_t*)(ws + WS_YS); \
    (void)ctl; (void)outp; (void)ada; (void)SSQP; (void)WT_IN; (void)WT_QB; (void)WT_KVB; (void)WT_MLAO; (void)WT_RETO; (void)WT_OUT; (void)WT_GU; (void)WT_DOWN; (void)CS_RET; (void)CS_MLA; (void)Hb; (void)QL; (void)CKV; (void)KR; \
    (void)ACAT; (void)BCAT; (void)KROT; (void)KZTF; (void)KZTB; (void)SG; (void)GA; (void)GB; (void)QN; (void)QR; (void)KN; (void)VV; (void)OA; (void)ORET; (void)OB; (void)MIXP; (void)MIXIN; (void)MIX; (void)H2; (void)TOPI; (void)TOPW; (void)DEST; (void)TILE; (void)DECTAB; (void)XS; (void)ACT; (void)YS;

    if (IN(PH_SETUP)) for (int rep = 0; rep < NREP(PH_SETUP); ++rep) {
        PTRS
        if (bx == 0 && tid < 16) DECTAB[tid] = log2_sigmoid(tid < 8 ? INP(I_DECF)[tid] : INP(I_DECB)[tid - 8]);
        {
            const float* wada = INP(I_WADA); const float* cvec = INP(I_C); float* adap = (float*)(ws + WS_ADAP);
            for (int it = gw; it < 192 * 8; it += NGW) {
                const int jb = it % 192, kp = it / 192, j = jb * 64 + lane;
                float a0 = 0.f, a1 = 0.f, a2 = 0.f, a3 = 0.f;
#pragma nounroll
                for (int k0 = kp * 256; k0 < kp * 256 + 256; k0 += 32) {
                    float w[32]; const float* wp = wada + (size_t)k0 * 12288 + j;
#pragma unroll
                    for (int i = 0; i < 32; ++i) { w[i] = __builtin_nontemporal_load(wp); wp += 12288; asm volatile("" : "+v"(wp)); }
#pragma unroll
                    for (int i = 0; i < 32; ++i) { a0 += w[i] * cvec[k0 + i]; a1 += w[i] * cvec[2048 + k0 + i]; a2 += w[i] * cvec[4096 + k0 + i]; a3 += w[i] * cvec[6144 + k0 + i]; }
                }
                float* o = adap + (size_t)kp * 49152 + j;
                o[0] = a0; o[12288] = a1; o[24576] = a2; o[36864] = a3;
            }
        }
        {
            const int* pos = (const int*)INP(I_POS);
            for (int i = bx * 512 + tid; i < T * 160; i += G * 512) {
                const int tok = i / 160, f = i % 160; const float p = (float)pos[tok];
                float inv; float* dst;
                if (f < 128) { inv = 1.0f / powf(10000.0f, (float)f / 128.0f); dst = CS_RET + (size_t)tok * 256 + f * 2; }
                else { inv = 1.0f / powf(10000.0f, (float)(f - 128) / 32.0f); dst = CS_MLA + (size_t)tok * 64 + (f - 128) * 2; }
                float s, c; sincosf(p * inv, &s, &c); dst[0] = c; dst[1] = s;
            }
        }
        {
            LAS float* scr = (LAS float*)(lds + wave * 16640);
            constexpr int I_IN = (N_IN_ALL / 64) * 32, I_QB = 24 * 8, I_KVB = 32 * 8, I_MLAO = 32 * 16, I_SQ = 32 * 32;
            constexpr int NITEMS = I_IN + I_QB + I_KVB + I_MLAO + 2 * I_SQ;
            unsigned* cq = ctl + CW_CVTQ + rep;
#define CVT_GRAB(dst) do { unsigned _v = 0u; if (lane == 0) _v = atomicAdd(cq, 8u); dst = (int)__builtin_amdgcn_readfirstlane(_v); } while (0)
#define CVT_DEC(r_, wp_, dst_, ks_, ldw_, K_, sc_) do { int r = (r_); const float* W_; bf16_t* WT_; const float* kq_ = nullptr; int nkb_, mat_; \
                if (r < I_IN) { W_ = INP(I_WIN); WT_ = WT_IN; ldw_ = 13376; K_ = 2048; nkb_ = 32; mat_ = 2; } \
                else if ((r -= I_IN) < I_QB) { W_ = INP(I_WQB); WT_ = WT_QB; kq_ = INP(I_QAN); ldw_ = 1536; K_ = 512; nkb_ = 8; mat_ = 3; } \
                else if ((r -= I_QB) < I_KVB) { W_ = INP(I_WKVB); WT_ = WT_KVB; kq_ = INP(I_KVAN); ldw_ = 2048; K_ = 512; nkb_ = 8; mat_ = 4; } \
                else if ((r -= I_KVB) < I_MLAO) { W_ = INP(I_WMLAO); WT_ = WT_MLAO; ldw_ = 2048; K_ = 1024; nkb_ = 16; mat_ = 1; } \
                else if ((r -= I_MLAO) < I_SQ) { W_ = INP(I_WRETO); WT_ = WT_RETO; ldw_ = 2048; K_ = 2048; nkb_ = 32; mat_ = 1; } \
                else { r -= I_SQ; W_ = INP(I_WOUT); WT_ = WT_OUT; ldw_ = 2048; K_ = 2048; nkb_ = 32; mat_ = 1; } \
                const int q4_ = r >> 2, kb_ = q4_ % nkb_, nb_ = (q4_ / nkb_) * 4 + (r & 3), rr_ = nb_ * 64 + lane; \
                sc_ = (mat_ == 1 ? rr_ : (mat_ == 2 ? src_in(rr_) : (mat_ == 3 ? src_qb(rr_) : src_kvb(rr_)))); \
                wp_ = W_ + (size_t)(kb_ * 64) * ldw_ + (sc_ >= 0 ? sc_ : 0); dst_ = WT_ + (size_t)(nb_ * 64) * K_ + kb_ * 64; ks_ = kq_ ? kq_ + kb_ * 64 : nullptr; \
                if (mat_ == 2 && nb_ >= 84 && nb_ < 180) { K_ = -1; dst_ = (bf16_t*)(ws + WS_WT8IN + (size_t)((nb_ - 84) * 64) * 2048 + kb_ * 64); } } while (0)
            float v[64];
            const float* wpc; bf16_t* dstc; const float* ksc; int ldwc, Kc, scc;
            const float* wpn = nullptr; bf16_t* dstn = nullptr; const float* ksn = nullptr; int ldwn = 0, Kn = 0, scn = 0;
            constexpr int QCH = 8; static_assert(NITEMS % QCH == 0, "queue chunk");
            int itc, itn, cend; CVT_GRAB(itc); itn = itc + 1; cend = itc + QCH;
            bool hc = itc < NITEMS;
            if (hc) { CVT_DEC(itc, wpc, dstc, ksc, ldwc, Kc, scc);
#pragma unroll
                for (int i = 0; i < 64; ++i) v[i] = __builtin_nontemporal_load(wpc + (size_t)i * ldwc); }
            while (hc) {
                const bool hn = itn < NITEMS;
                if (hn) CVT_DEC(itn, wpn, dstn, ksn, ldwn, Kn, scn);
                const bool need = (itn + 1 >= cend); unsigned raw_nn = 0u; if (need && lane == 0) raw_nn = atomicAdd(cq, (unsigned)QCH);
#pragma unroll
                for (int g = 0; g < 4; ++g) {
#pragma unroll
                    for (int i = 0; i < 16; ++i) { float x = scc >= 0 ? v[16 * g + i] : 0.f; if (ksc) x *= ksc[16 * g + i]; scr[(16 * g + i) * 65 + lane] = x; }
                    if (hn) {
#pragma unroll
                        for (int i = 0; i < 16; ++i) v[16 * g + i] = __builtin_nontemporal_load(wpn + (size_t)(16 * g + i) * ldwn); }
                }
                asm volatile("s_waitcnt lgkmcnt(0)" ::: "memory");
                const int c = lane & 7;
#pragma unroll
                for (int j = 0; j < 8; ++j) { const int n = (lane >> 3) + 8 * j; const LAS float* sp = scr + (8 * c) * 65 + n;
                    if (Kc < 0) { u32x2 o8; o8.x = pk4_fp8(sp[0 * 65], sp[1 * 65], sp[2 * 65], sp[3 * 65], W8_SCALE); o8.y = pk4_fp8(sp[4 * 65], sp[5 * 65], sp[6 * 65], sp[7 * 65], W8_SCALE);
                        *(u32x2*)((unsigned char*)dstc + (size_t)n * 2048 + 8 * c) = o8; }
                    else { u32x4 o; o.x = cvt_pk_bf16(sp[0 * 65], sp[1 * 65]); o.y = cvt_pk_bf16(sp[2 * 65], sp[3 * 65]); o.z = cvt_pk_bf16(sp[4 * 65], sp[5 * 65]); o.w = cvt_pk_bf16(sp[6 * 65], sp[7 * 65]);
                        __builtin_nontemporal_store(o, (u32x4*)(dstc + (size_t)n * Kc + 8 * c)); } }
                asm volatile("s_waitcnt lgkmcnt(0)" ::: "memory");
                wpc = wpn; dstc = dstn; ksc = ksn; ldwc = ldwn; Kc = Kn; scc = scn; hc = hn;
                if (need) { itn = (int)__builtin_amdgcn_readfirstlane(raw_nn); cend = itn + QCH; } else itn = itn + 1;
            }
#undef CVT_GRAB
#undef CVT_DEC
        }
    }
    SEAM(PH_SETUP);
    if (IN(PH_H)) for (int rep = 0; rep < NREP(PH_H); ++rep) {
        PTRS
        const float* g = INP(I_GPREM);
        {
            const float* adap = (const float*)(ws + WS_ADAP); const float* bada = INP(I_BADA); LAS float* AD = (LAS float*)lds;
            if (tid < 192) { const int idx = bx * 192 + tid; if (idx < 49152) { const int j = idx % 12288; float a = 0.f;
#pragma unroll
                for (int pq = 0; pq < 8; ++pq) a += adap[(size_t)pq * 49152 + idx];
                ada[idx] = a + bada[j]; } }
            for (int i = tid; i < 16384; i += 512) { const int b = i >> 12, col = i & 4095; float a = 0.f;
#pragma unroll
                for (int pq = 0; pq < 8; ++pq) a += adap[(size_t)pq * 49152 + b * 12288 + col];
                AD[i] = a + bada[col]; }
            __syncthreads();
        }
        const LAS float* AD = (const LAS float*)lds;
        f32x4 vn[8];
        if (gw < T) { const f32x4* xr = (const f32x4*)(INP(I_X) + (size_t)gw * D) + lane;
#pragma unroll
            for (int j = 0; j < 8; ++j) vn[j] = xr[64 * j]; }
        for (int mrow = gw; mrow < T; mrow += NGW) {
            const int b = mrow / SEQ;
            f32x4 v[8]; float s = 0.f;
#pragma unroll
            for (int j = 0; j < 8; ++j) { v[j] = vn[j]; s += (v[j][0] * v[j][0] + v[j][1] * v[j][1]) + (v[j][2] * v[j][2] + v[j][3] * v[j][3]); }
            if (mrow + NGW < T) { const f32x4* xr = (const f32x4*)(INP(I_X) + (size_t)(mrow + NGW) * D) + lane;
#pragma unroll
                for (int j = 0; j < 8; ++j) vn[j] = xr[64 * j]; }
            const float r = rsqrtf(wave_sum(s) * (1.0f / D) + RMS_EPS);
            u32x2* o8 = (u32x2*)(Hb + (size_t)mrow * D) + lane; unsigned* q8 = (unsigned*)(ws + WS_H8 + (size_t)mrow * D) + lane;
#pragma unroll
            for (int j = 0; j < 8; ++j) { const int col = 256 * j + 4 * lane; const f32x4 gg = *(const f32x4*)(g + col), sh = *(const LAS f32x4*)(AD + b * 4096 + col), sc = *(const LAS f32x4*)(AD + b * 4096 + 2048 + col);
                const f32x4 y = v[j] * r * gg * (sc + 1.0f) + sh; u32x2 w; w.x = cvt_pk_bf16(y[0], y[1]); w.y = cvt_pk_bf16(y[2], y[3]); o8[64 * j] = w; q8[64 * j] = pk4_fp8(y[0], y[1], y[2], y[3], H8_SCALE); }
        }
    }
    SEAM(PH_H);
    if (IN(PH_INPROJ)) for (int rep = 0; rep < NREP(PH_INPROJ); ++rep) {
        PTRS
        {   pg8::InprojSched S{(const char*)Hb, (const char*)WT_IN, G, bx};
            EpiInprojAll E{EpiInproj{QL, CKV, KR, ACAT, KROT, SG, GA, GB, SSQP, CS_RET, CS_MLA, DECTAB, 0, 1.0f}, EpiVT{BCAT, ws + WS_VT8}};
            pg8::gemm_phase(lds, 2048, 2048, 2048, S, E); }
        {
            pg8::GridSched S{(const char*)(ws + WS_H8), (const char*)(ws + WS_WT8IN), (size_t)256 * 2048, (size_t)256 * 2048, T / 256, 24, G, bx};
            EpiInproj E{QL, CKV, KR, ACAT, KROT, SG, GA, GB, SSQP, CS_RET, CS_MLA, DECTAB, 21, GU_UNSCALE};
            pg8::gemm_phase<EpiInproj, pg8::GridSched, true>(lds, 2048, 2048, 2048, S, E); }
    }
    SEAM(PH_INPROJ_V);
    if (IN(PH_KT)) for (int rep = 0; rep < NREP(PH_KT); ++rep) {
        PTRS
        {
            constexpr int TP = 528;
            u32x4 ra[16], rb[16];
#define KT_LOAD(r_, blk_) do { const bf16_t* _s = KROT + ((size_t)(blk_) * 256 + 32 * wave + 16 * (lane >> 5)) * 256 + 8 * (lane & 31); _Pragma("unroll") for (int i = 0; i < 16; ++i) r_[i] = *(const u32x4*)(_s + i * 256); } while (0)
#define KT_PROC(r_, blk_) do { const int _h = ((blk_) >> 4) & 7; const float _lf = DECTAB[_h], _lb = DECTAB[8 + _h]; \
                _Pragma("unroll") for (int e = 0; e < 8; ++e) { u32x4 w0, w1; \
                    _Pragma("unroll") for (int i2 = 0; i2 < 4; ++i2) { const unsigned a0 = r_[2 * i2][e >> 1], a1 = r_[2 * i2 + 1][e >> 1], c0 = r_[8 + 2 * i2][e >> 1], c1 = r_[8 + 2 * i2 + 1][e >> 1]; \
                        w0[i2] = (e & 1) ? ((a0 >> 16) | (a1 & 0xffff0000u)) : ((a0 & 0xffffu) | (a1 << 16)); w1[i2] = (e & 1) ? ((c0 >> 16) | (c1 & 0xffff0000u)) : ((c0 & 0xffffu) | (c1 << 16)); } \
                    LAS unsigned char* _t = lds + (8 * (lane & 31) + e) * TP + (32 * wave + 16 * (lane >> 5)) * 2; *(LAS u32x4*)_t = w0; *(LAS u32x4*)(_t + 16) = w1; } \
                __syncthreads(); \
                f32x4 zf0, zf1, zb0, zb1; \
                _Pragma("unroll") for (int t = 0; t < 4; ++t) { const int p0 = 8 * (lane & 31) + t, p1 = p0 + 4; \
                    zf0[t] = __builtin_amdgcn_exp2f((float)(255 - p0) * _lf); zf1[t] = __builtin_amdgcn_exp2f((float)(255 - p1) * _lf); zb0[t] = __builtin_amdgcn_exp2f((float)p0 * _lb); zb1[t] = __builtin_amdgcn_exp2f((float)p1 * _lb); } \
                _Pragma("unroll") for (int j = 0; j < 16; ++j) { const int row = 32 * wave + 2 * j + (lane >> 5); \
                    const u32x4 w = *(const LAS u32x4*)(lds + row * TP + (lane & 31) * 16); f32x4 x0, x1; unpack8(w, x0, x1); \
                    const size_t o = ((size_t)(blk_) * 256 + row) * 256 + 8 * (lane & 31); \
                    const f32x4 f0 = x0 * zf0, f1 = x1 * zf1, g0 = x0 * zb0, g1 = x1 * zb1; u32x2 wf, wb; \
                    wf.x = pk4_fp8(f0[0], f0[1], f0[2], f0[3], K8_SCALE); wf.y = pk4_fp8(f1[0], f1[1], f1[2], f1[3], K8_SCALE); wb.x = pk4_fp8(g0[0], g0[1], g0[2], g0[3], K8_SCALE); wb.y = pk4_fp8(g1[0], g1[1], g1[2], g1[3], K8_SCALE); \
                    *(u32x2*)((unsigned char*)KZTF + o) = wf; *(u32x2*)((unsigned char*)KZTB + o) = wb; } \
                __syncthreads(); } while (0)
            int blk = bx;
            if (blk < NBLK) KT_LOAD(ra, blk);
            while (blk < NBLK) {
                const int b1 = blk + G; if (b1 < NBLK) KT_LOAD(rb, b1);
                KT_PROC(ra, blk);
                if (b1 >= NBLK) break;
                const int b2 = b1 + G; if (b2 < NBLK) KT_LOAD(ra, b2);
                KT_PROC(rb, b1);
                blk = b2;
            }
#undef KT_LOAD
#undef KT_PROC
        }
    }
    SEAM(PH_KT);
    if (IN(PH_CHAIN)) for (int rep = 0; rep < NREP(PH_CHAIN); ++rep) {
        PTRS
        if (bx < 64) {
            const int bh = bx >> 1, dir = bx & 1;
            {
                const int blk0 = bh * NCH + (dir ? NCH - 1 : 0);
                bf16_t* z = BCAT + ((size_t)blk0 * 256 + (tid >> 1)) * 768 + 256 + 256 * dir + (tid & 1) * 128;
#pragma unroll
                for (int q = 0; q < 16; ++q) *(u32x4*)(z + q * 8) = (u32x4){0u, 0u, 0u, 0u};
            }
            pg8::ChainSched S{(const char*)(ws + WS_VT8), (const char*)(dir ? KZTB : KZTF), bh, dir};
            EpiGb E{BCAT, DECTAB, dir};
            pg8::gemm_phase<EpiGb, pg8::ChainSched, true, true>(lds, 256, 256, 256, S, E);
        }
    }
    if (IN(PH_MLAQ)) for (int rep = 0; rep < NREP(PH_MLAQ); ++rep) {
        PTRS
        if (bx >= 64) { const bool ca = bx < 128;
            pg8::GridSchedR S{(const char*)QL, (const char*)WT_QB, (size_t)256 * 512 * 2, (size_t)256 * 512 * 2, T / 256, 6, ca ? 64 : 128, ca ? bx - 64 : bx - 128, ca ? 0 : 128, ca ? 128 : 384};
            EpiMlaQ E{QN, QR, SSQP, CS_MLA}; pg8::gemm_phase(lds, 512, 512, 512, S, E); }
    }
    if (IN(PH_MLAKV)) for (int rep = 0; rep < NREP(PH_MLAKV); ++rep) {
        PTRS
        if (bx >= 128) {
            pg8::GridSchedR S{(const char*)CKV, (const char*)WT_KVB, (size_t)256 * 512 * 2, (size_t)256 * 512 * 2, T / 256, 8, 128, bx - 128, 0, 512};
            EpiMlaKV E{KN, VV, SSQP + (size_t)8 * T}; pg8::gemm_phase(lds, 512, 512, 512, S, E); }
    }
    if (IN(PH_GA)) for (int rep = 0; rep < NREP(PH_GA); ++rep) {
        PTRS
        if (bx >= 64) { const bool ca = bx < 128;
        {   pg8::BatchSchedR S{(const char*)(ACAT + 256), (const char*)KROT, (size_t)256 * 768 * 2, (size_t)256 * 256 * 2, ca ? 64 : 128, ca ? bx - 64 : bx - 128, ca ? 0 : 256, ca ? 256 : 512};
            EpiGa E{ACAT, DECTAB}; pg8::gemm_phase(lds, 256, 768, 256, S, E); }
        if (ca) {
            pg8::GridSchedR S{(const char*)Hb, (const char*)(WT_IN + (size_t)4 * 256 * 2048), (size_t)256 * 2048 * 2, (size_t)256 * 2048 * 2, T / 256, 1, 64, bx - 64, 0, 64};
            EpiInproj E{QL, CKV, KR, ACAT, KROT, SG, GA, GB, SSQP, CS_RET, CS_MLA, DECTAB, 4, 1.0f}; pg8::gemm_phase(lds, 2048, 2048, 2048, S, E); }
        }
    }
    SEAM(PH_GA);
    if (IN(PH_ATTN)) for (int rep = 0; rep < NREP(PH_ATTN); ++rep) {
        PTRS
        unsigned* queue = ctl + CW_QUEUE + rep; unsigned* cqueue = ctl + CW_QUEUE + 8;
        const float* wgu = INP(I_WGU); const float* wdn = INP(I_WDOWN);
#define CONV_LOOP() do { if (rep == 0) for (;;) { __syncthreads(); if (tid == 0) MISC[1] = atomicAdd(cqueue, 1u); __syncthreads(); const int c = (int)MISC[1]; if (c >= 768) break; \
            xt_convert_tiles(c * 16, 1, c * 16 + 16, wgu, wdn, WT_GU, WT_DOWN, lds, lane, wave); } } while (0)
        if (bx < CONV_WGS) CONV_LOOP();
        int xq = (int)(xb_xcc_id() & 7u), tries = 0;
        for (;;) {
            __syncthreads();
            if (tid == 0) { int a = -1;
                while (tries < 8) { const unsigned v = atomicAdd(ctl + CW_AQ + 64 * xq + rep, 1u); if (v < 64u) { a = xq * 64 + (int)v; break; } xq = (xq + 1) & 7; ++tries; }
                MISC[0] = (unsigned)a; }
            __syncthreads();
            const int a = (int)MISC[0];
            if (a < 0) break;
            const int bh = a >> 4, qb = a & 15, b = bh >> 3, h = bh & 7;
            const size_t tok0 = (size_t)b * SEQ + qb * 256, kt0 = (size_t)b * SEQ;
            att::attn_unit(QN + tok0 * 1024 + h * 128, QR + tok0 * 512 + h * 64, KN + kt0 * 1024 + h * 128, KR + kt0 * 64, VV + kt0 * 1024 + h * 128, OA + tok0 * 1024 + h * 128, SEQ, (char*)lds_raw);
        }
        if (bx >= CONV_WGS) CONV_LOOP();
#undef CONV_LOOP
    }
    SEAM(PH_ATTN);
    if (IN(PH_GC)) for (int rep = 0; rep < NREP(PH_GC); ++rep) {
        PTRS
        {   pg8::BatchSched S{(const char*)ACAT, (const char*)BCAT, (size_t)256 * 768 * 2, (size_t)256 * 768 * 2, NBLK, G, bx};
            EpiGc E{OB, SG, INP(I_RETGN), lds}; pg8::gemm_phase(lds, 768, 768, 768, S, E); }
    }
    if (IN(PH_MIXA)) for (int rep = 0; rep < NREP(PH_MIXA); ++rep) {
        PTRS
        {   pg8::GridSched S{(const char*)OA, (const char*)WT_MLAO, (size_t)256 * 1024 * 2, (size_t)256 * 1024 * 2, T / 256, 8, G, bx};
            EpiMixA E{MIXP, GA}; pg8::gemm_phase(lds, 1024, 1024, 1024, S, E); }
    }
    SEAM(PH_MIXA);
    if (IN(PH_MIXB)) for (int rep = 0; rep < NREP(PH_MIXB); ++rep) {
        PTRS
        pg8::GridSched S{(const char*)OB, (const char*)WT_RETO, (size_t)256 * 2048 * 2, (size_t)256 * 2048 * 2, T / 256, 8, G, bx};
        EpiMixB E{MIXIN, MIXP, GB}; pg8::gemm_phase(lds, 2048, 2048, 2048, S, E);
    }
    SEAM(PH_MIXB);
    if (IN(PH_MIX)) for (int rep = 0; rep < NREP(PH_MIX); ++rep) {
        PTRS
        pg8::GridSched S{(const char*)MIXIN, (const char*)WT_OUT, (size_t)256 * 2048 * 2, (size_t)256 * 2048 * 2, T / 256, 8, G, bx};
        EpiF32 E{(bf16_t*)MIX}; pg8::gemm_phase(lds, 2048, 2048, 2048, S, E);
    }
    SEAM(PH_MIX);
    if (IN(PH_ROUTER)) for (int rep = 0; rep < NREP(PH_ROUTER); ++rep) {
        PTRS
        const float* gpm = INP(I_GPOSTM); const float* gpf = INP(I_GPREF); const float* wr = INP(I_WROUTER); const float* brt = INP(I_BROUTER);
        LAS float* HROW = (LAS float*)lds;
        LAS float* PART = (LAS float*)(lds + 16 * 2052 * 4);
        unsigned* counts = ctl + CW_COUNTS;
        volatile LAS unsigned* lhist = MISC + 64;
        if (tid < 32) lhist[tid] = 0u;
        __syncthreads();
        const float* wbp = wr + (size_t)(256 * wave + (lane >> 4)) * 32 + (lane & 15);
        f32x4 vA[8], vB[8], xA[8], xB[8];
#define RT_LOAD(base_) do { const int _m = (base_) + 2 * wave; const u32x2* _mr = (const u32x2*)((const bf16_t*)MIX + (size_t)_m * D) + lane; const f32x4* _xr = (const f32x4*)(INP(I_X) + (size_t)_m * D) + lane; \
            _Pragma("unroll") for (int j = 0; j < 8; ++j) { const u32x2 _a = _mr[64 * j], _b = _mr[64 * j + 512]; vA[j] = (f32x4){bf_lo(_a.x), bf_hi(_a.x), bf_lo(_a.y), bf_hi(_a.y)}; vB[j] = (f32x4){bf_lo(_b.x), bf_hi(_b.x), bf_lo(_b.y), bf_hi(_b.y)}; \
                xA[j] = _xr[64 * j]; xB[j] = _xr[64 * j + 512]; } } while (0)
        if (bx * 16 < T) RT_LOAD(bx * 16);
        for (int base = bx * 16; base < T; base += G * 16) {
            {
                const int rrA = 2 * wave, mrowA = base + rrA;
                const int b = mrowA / SEQ; const float* ad = ada + b * 12288;
                float sA = 0.f, sB = 0.f;
#pragma unroll
                for (int j = 0; j < 8; ++j) { sA += (vA[j][0] * vA[j][0] + vA[j][1] * vA[j][1]) + (vA[j][2] * vA[j][2] + vA[j][3] * vA[j][3]); sB += (vB[j][0] * vB[j][0] + vB[j][1] * vB[j][1]) + (vB[j][2] * vB[j][2] + vB[j][3] * vB[j][3]); }
#pragma unroll
                for (int o = 1; o < 64; o <<= 1) { sA += __shfl_xor(sA, o); sB += __shfl_xor(sB, o); }
                const float r1A = rsqrtf(sA * (1.0f / D) + RMS_EPS), r1B = rsqrtf(sB * (1.0f / D) + RMS_EPS); float tA = 0.f, tB = 0.f;
                u32x2* o4 = (u32x2*)((bf16_t*)(ws + WS_X1B) + (size_t)mrowA * D) + lane;
#pragma unroll
                for (int j = 0; j < 8; ++j) { const int col = 256 * j + 4 * lane; const f32x4 gg = *(const f32x4*)(gpm + col), gm = *(const f32x4*)(ad + 4096 + col);
                    vA[j] = xA[j] + gm * (vA[j] * r1A * gg); vB[j] = xB[j] + gm * (vB[j] * r1B * gg);
                    { u32x2 wa, wb; wa.x = cvt_pk_bf16(vA[j][0], vA[j][1]); wa.y = cvt_pk_bf16(vA[j][2], vA[j][3]); wb.x = cvt_pk_bf16(vB[j][0], vB[j][1]); wb.y = cvt_pk_bf16(vB[j][2], vB[j][3]); o4[64 * j] = wa; o4[64 * j + 512] = wb; }
                    tA += (vA[j][0] * vA[j][0] + vA[j][1] * vA[j][1]) + (vA[j][2] * vA[j][2] + vA[j][3] * vA[j][3]); tB += (vB[j][0] * vB[j][0] + vB[j][1] * vB[j][1]) + (vB[j][2] * vB[j][2] + vB[j][3] * vB[j][3]); asm volatile("" ::: "memory"); }
#pragma unroll
                for (int o = 1; o < 64; o <<= 1) { tA += __shfl_xor(tA, o); tB += __shfl_xor(tB, o); }
                const float r2A = rsqrtf(tA * (1.0f / D) + RMS_EPS), r2B = rsqrtf(tB * (1.0f / D) + RMS_EPS);
                unsigned* h8 = (unsigned*)((unsigned char*)H2 + (size_t)mrowA * D) + lane;
#pragma unroll
                for (int j = 0; j < 8; ++j) { const int col = 256 * j + 4 * lane; const f32x4 gg = *(const f32x4*)(gpf + col), sh = *(const f32x4*)(ad + 6144 + col), sc = *(const f32x4*)(ad + 8192 + col);
                    const f32x4 hA = vA[j] * r2A * gg * (sc + 1.0f) + sh, hB = vB[j] * r2B * gg * (sc + 1.0f) + sh;
                    h8[64 * j] = pk4_fp8(hA[0], hA[1], hA[2], hA[3], H8_SCALE); h8[64 * j + 512] = pk4_fp8(hB[0], hB[1], hB[2], hB[3], H8_SCALE);
                    *(LAS f32x4*)(HROW + rrA * 2052 + col) = hA; *(LAS f32x4*)(HROW + (rrA + 1) * 2052 + col) = hB; asm volatile("" ::: "memory"); }
                if (base + G * 16 < T) RT_LOAD(base + G * 16);
            }
            __syncthreads();
            {   f32x4 c0 = (f32x4){0.f, 0.f, 0.f, 0.f}, c1 = (f32x4){0.f, 0.f, 0.f, 0.f};
                const LAS float* ap = HROW + (lane & 15) * 2052 + 256 * wave + (lane >> 4);
#pragma unroll 16
                for (int st = 0; st < 64; ++st) { const float a = ap[4 * st]; c0 = __builtin_amdgcn_mfma_f32_16x16x4f32(a, wbp[st * 128], c0, 0, 0, 0); c1 = __builtin_amdgcn_mfma_f32_16x16x4f32(a, wbp[st * 128 + 16], c1, 0, 0, 0); }
                LAS float* pp = PART + wave * 512 + (4 * (lane >> 4)) * 32 + (lane & 15);
#pragma unroll
                for (int r = 0; r < 4; ++r) { pp[r * 32] = c0[r]; pp[r * 32 + 16] = c1[r]; }
            }
            __syncthreads();
#pragma nounroll
            for (int q = 0; q < 2; ++q) {
                const int rr = 2 * wave + q, mrow = base + rr;
                float lg = 0.f;
                if (lane < 32) {
#pragma unroll
                    for (int w2 = 0; w2 < 8; ++w2) lg += PART[w2 * 512 + rr * 32 + lane];
                    lg += brt[lane]; }
                float val = lane < 32 ? lg : -3.0e38f; float tv[4]; int ti[4];
#pragma unroll
                for (int r = 0; r < 4; ++r) { float bv = val; int bi = lane;
#pragma unroll
                    for (int o = 32; o >= 1; o >>= 1) { const float ov = __shfl_xor(bv, o); const int oi = __shfl_xor(bi, o); if (ov > bv || (ov == bv && oi < bi)) { bv = ov; bi = oi; } }
                    tv[r] = bv; ti[r] = bi; if (lane == bi) val = -3.0e38f; }
                const float e1 = __expf(tv[1] - tv[0]), e2 = __expf(tv[2] - tv[0]), e3 = __expf(tv[3] - tv[0]); const float inv = 1.0f / (1.0f + e1 + e2 + e3);
                if (lane < 4) { const int id = lane == 0 ? ti[0] : (lane == 1 ? ti[1] : (lane == 2 ? ti[2] : ti[3])); const float wv = (lane == 0 ? 1.0f : (lane == 1 ? e1 : (lane == 2 ? e2 : e3))) * inv;
                    TOPI[mrow * 4 + lane] = id; TOPW[mrow * 4 + lane] = wv; if (rep == 0) __hip_atomic_fetch_add((LAS unsigned*)(lhist + id), 1u, __ATOMIC_RELAXED, __HIP_MEMORY_SCOPE_WORKGROUP); }
            }
            __syncthreads();
        }
        if (tid < 32 && rep == 0) { const unsigned c = lhist[tid]; if (c) atomicAdd(counts + 64 * tid, c); }
    }
    SEAM(PH_ROUTER);
    if (IN(PH_DISPATCH)) for (int rep = 0; rep < NREP(PH_DISPATCH); ++rep) {
        PTRS
        unsigned* counts = ctl + CW_COUNTS; unsigned* cursor = ctl + CW_CURSOR;
        volatile LAS unsigned* lhist = MISC + 64; volatile LAS unsigned* lbase = MISC + 96;
        if (tid < 32) lhist[tid] = 0u;
        int pst = 0, pend = 0;
        { const int cnt = lane < 32 ? (int)__hip_atomic_load(counts + 64 * lane, __ATOMIC_RELAXED, __HIP_MEMORY_SCOPE_AGENT) : 0; const int pad = (cnt + 255) & ~255; int inc = pad;
#pragma unroll
          for (int o = 1; o < 32; o <<= 1) { const int t = __shfl_up(inc, o); if ((lane & 31) >= o) inc += t; }
          pend = inc; pst = inc - pad; }
        if (gw == 0) {
            const int ntiles = __shfl(pend, 31) >> 8; if (lane == 0) TILE[0] = ntiles;
            for (int t = lane; t < PMAX / 256; t += 64) { int e = 0;
                for (int q = 0; q < 32; ++q) { const int pe = __shfl(pend, q); e += (pe <= t * 256) ? 1 : 0; }
                TILE[16 + t] = e < 31 ? e : 31; }
        }
        __syncthreads();
        int eid[8], loc[8];
#pragma unroll
        for (int i = 0; i < 8; ++i) { const int mrow = gw + NGW * i; eid[i] = 0; loc[i] = 0;
            if (mrow < T && lane < 4) { eid[i] = TOPI[mrow * 4 + lane]; loc[i] = (int)__hip_atomic_fetch_add((LAS unsigned*)(lhist + eid[i]), 1u, __ATOMIC_RELAXED, __HIP_MEMORY_SCOPE_WORKGROUP); } }
        __syncthreads();
        if (tid < 32) { const unsigned c = lhist[tid]; lbase[tid] = (unsigned)pst + (c ? atomicAdd(cursor + 64 * tid, c) : 0u); }
        __syncthreads();
#pragma unroll
        for (int i = 0; i < 8; ++i) { const int mrow = gw + NGW * i;
            if (mrow < T) {
                int slot = 0;
                if (lane < 4) { slot = (int)lbase[eid[i]] + loc[i]; DEST[mrow * 4 + lane] = slot; }
                const u32x4* src = (const u32x4*)((const unsigned char*)H2 + (size_t)mrow * D) + lane; u32x4 rw[2];
#pragma unroll
                for (int q = 0; q < 2; ++q) rw[q] = src[64 * q];
#pragma unroll
                for (int k = 0; k < 4; ++k) { const int sl = __shfl(slot, k); u32x4* dst = (u32x4*)((unsigned char*)XS + (size_t)sl * D) + lane;
#pragma unroll
                    for (int q = 0; q < 2; ++q) dst[64 * q] = rw[q]; } } }
    }
    SEAM(PH_DISPATCH);
    if (IN(PH_GU)) for (int rep = 0; rep < NREP(PH_GU); ++rep) {
        PTRS
        const int ntiles = __builtin_amdgcn_readfirstlane(TILE[0]);
        pg8::MoeSched S{(const char*)XS, (const char*)WT_GU, TILE + 16, ntiles, 16, G, bx};
        EpiGU E{ACT, INP(I_BGU), rep}; pg8::gemm_phase<EpiGU, pg8::MoeSched, true>(lds, 2048, 2048, 2048, S, E);
    }
    SEAM(PH_GU);
    if (IN(PH_DOWN)) for (int rep = 0; rep < NREP(PH_DOWN); ++rep) {
        PTRS
        const int ntiles = __builtin_amdgcn_readfirstlane(TILE[0]);
        pg8::MoeSched S{(const char*)ACT, (const char*)WT_DOWN, TILE + 16, ntiles, 8, G, bx};
        EpiDown E{YS, INP(I_BDOWN)}; pg8::gemm_phase<EpiDown, pg8::MoeSched, true>(lds, 2048, 2048, 2048, S, E);
    }
    SEAM(PH_DOWN);
    if (IN(PH_COMBINE)) for (int rep = 0; rep < NREP(PH_COMBINE); ++rep) {
        PTRS
        const float* gpo = INP(I_GPOSTF);
        for (int mrow = gw; mrow < T; mrow += NGW) {
            const int b = mrow / SEQ; const float* ad = ada + b * 12288;
            int dk[4]; float wk[4];
#pragma unroll
            for (int k = 0; k < 4; ++k) { dk[k] = DEST[mrow * 4 + k]; wk[k] = TOPW[mrow * 4 + k]; }
            f32x4 f[8]; float s = 0.f;
#pragma unroll
            for (int j = 0; j < 8; ++j) f[j] = (f32x4){0.f, 0.f, 0.f, 0.f};
#pragma unroll
            for (int k = 0; k < 4; ++k) { const u32x2* yr = (const u32x2*)(YS + (size_t)dk[k] * D) + lane;
#pragma unroll
                for (int j = 0; j < 8; ++j) { const u32x2 w = yr[64 * j]; f[j] += (f32x4){bf_lo(w.x), bf_hi(w.x), bf_lo(w.y), bf_hi(w.y)} * wk[k]; } }
#pragma unroll
            for (int j = 0; j < 8; ++j) s += (f[j][0] * f[j][0] + f[j][1] * f[j][1]) + (f[j][2] * f[j][2] + f[j][3] * f[j][3]);
            const float r = rsqrtf(wave_sum(s) * (1.0f / D) + RMS_EPS);
            f32x4* o4 = (f32x4*)(outp + (size_t)mrow * D) + lane; const u32x2* x1 = (const u32x2*)((const bf16_t*)(ws + WS_X1B) + (size_t)mrow * D) + lane;
#pragma unroll
            for (int j = 0; j < 8; ++j) { const int col = 256 * j + 4 * lane; const f32x4 gg = *(const f32x4*)(gpo + col), gf = *(const f32x4*)(ad + 10240 + col); const u32x2 xw = x1[64 * j];
                o4[64 * j] = (f32x4){bf_lo(xw.x), bf_hi(xw.x), bf_lo(xw.y), bf_hi(xw.y)} + gf * (f[j] * r * gg); }
        }
    }
    if (STAMP_PHASE >= 0 && bx == 0) {
        if (seam_after(STAMP_PHASE) >= NPH) st_dt = __builtin_amdgcn_s_memrealtime() - st_t0;
        const unsigned long long t1 = __builtin_amdgcn_s_memrealtime();
        while (__builtin_amdgcn_s_memrealtime() - t1 < st_dt * STAMP_MUL) __builtin_amdgcn_s_sleep(8);
    }
#undef IN
#undef SEAM
}

extern "C" void kernel_launch(void* const* d_in, const int* in_sizes, int n_in, void* d_out, int out_size, void* d_ws, size_t ws_size, hipStream_t stream) {
    static int grid = 0;
    if (grid == 0) {
        if (n_in != 26 || out_size != T * D || ws_size < WS_END) { fprintf(stderr, "kernel_launch: unexpected shapes: n_in %d out %d ws %zu (need %zu)\n", n_in, out_size, ws_size, (size_t)WS_END); grid = -1; return; }
        int dev = 0, cus = 0, per_cu = 0;
        if (hipGetDevice(&dev) != hipSuccess || hipDeviceGetAttribute(&cus, hipDeviceAttributeMultiprocessorCount, dev) != hipSuccess) { grid = -1; return; }
        if (hipFuncSetAttribute((const void*)fwd_kernel, hipFuncAttributeMaxDynamicSharedMemorySize, LDS_BYTES) != hipSuccess) { fprintf(stderr, "kernel_launch: hipFuncSetAttribute failed\n"); grid = -1; return; }
        if (hipOccupancyMaxActiveBlocksPerMultiprocessor(&per_cu, (const void*)fwd_kernel, 512, LDS_BYTES) != hipSuccess || per_cu < 1) fprintf(stderr, "kernel_launch: occupancy query says %d\n", per_cu);
        (void)hipGetLastError();
        grid = cus;
    }
    if (grid < 0) return;
    (void)hipMemsetAsync((char*)d_ws + WS_CTL, 0, CTL_BYTES, stream);
    Args a{};
    for (int i = 0; i < 26; ++i) a.in[i] = (const float*)d_in[i];
    a.out = (float*)d_out; a.ws = (unsigned char*)d_ws;
    if (MK_N_LAUNCHES == 1) { a.ph_lo = 0; a.ph_hi = NPH; hipLaunchKernelGGL(fwd_kernel, dim3(grid), dim3(512), LDS_BYTES, stream, a); }
    else for (int p = 0; p < NPH; ++p) { a.ph_lo = p; a.ph_hi = p + 1; hipLaunchKernelGGL(fwd_kernel, dim3(grid), dim3(512), LDS_BYTES, stream, a); }
    const hipError_t le = hipPeekAtLastError();
    if (le != hipSuccess) fprintf(stderr, "kernel_launch: launch failed: %s\n", hipGetErrorName(le));
}
```

```cpp
#include <hip/hip_runtime.h>
#include <cstdio>
#include <cstdint>

#ifndef MK_N_LAUNCHES
#define MK_N_LAUNCHES 1
#endif

#define LAS __attribute__((address_space(3)))
typedef unsigned short bf16_t;
typedef short bf16x8 __attribute__((ext_vector_type(8)));
typedef short s16x4 __attribute__((ext_vector_type(4)));
typedef float f32x4 __attribute__((ext_vector_type(4)));
typedef float f32x2 __attribute__((ext_vector_type(2)));
typedef float f32x16 __attribute__((ext_vector_type(16)));
typedef unsigned u32x4 __attribute__((ext_vector_type(4)));
typedef unsigned u32x2 __attribute__((ext_vector_type(2)));

constexpr int NB = 4, SEQ = 4096, T = NB * SEQ, D = 2048;
constexpr int CH = 256, NCH = SEQ / CH, NBLK = NB * 8 * NCH;
constexpr int N_IN_NAT = 11520;
constexpr int N_IN_ALL = N_IN_NAT + 2048;
constexpr int NE = 32, PMAX = 73728;
constexpr float RMS_EPS = 1e-6f, GN_EPS = 1e-6f;
constexpr float QSCALE = 0.07216878364870322f;
constexpr int CONV_WGS = 64;

constexpr size_t MiB = 1u << 20;
constexpr size_t WS_CTL = 0, CTL_BYTES = 1 * MiB;
constexpr size_t WS_WT_IN = 1 * MiB;
constexpr size_t WS_WT_QB = WS_WT_IN + 54 * MiB;
constexpr size_t WS_WT_KVB = WS_WT_QB + 2 * MiB;
constexpr size_t WS_WT_MLAO = WS_WT_KVB + 2 * MiB;
constexpr size_t WS_WT_RETO = WS_WT_MLAO + 4 * MiB;
constexpr size_t WS_WT_OUT = WS_WT_RETO + 8 * MiB;
constexpr size_t WS_WT_GU = WS_WT_OUT + 8 * MiB;
constexpr size_t WS_WT_DOWN = WS_WT_GU + 512 * MiB;
constexpr size_t WS_CS_RET = WS_WT_DOWN + 256 * MiB;
constexpr size_t WS_CS_MLA = WS_CS_RET + 16 * MiB;
constexpr size_t WS_H = WS_CS_MLA + 4 * MiB;
constexpr size_t WS_QL = WS_H + 64 * MiB;
constexpr size_t WS_CKV = WS_QL + 16 * MiB;
constexpr size_t WS_KR = WS_CKV + 16 * MiB;
constexpr size_t WS_ACAT = WS_KR + 2 * MiB;
constexpr size_t WS_BCAT = WS_ACAT + 192 * MiB;
constexpr size_t WS_KROT = WS_BCAT + 192 * MiB;
constexpr size_t WS_KZTF = WS_KROT + 64 * MiB;
constexpr size_t WS_KZTB = WS_KZTF + 64 * MiB;
constexpr size_t WS_SG = WS_KZTB + 64 * MiB;
constexpr size_t WS_GA = WS_SG + 64 * MiB;
constexpr size_t WS_GB = WS_GA + 64 * MiB;
constexpr size_t WS_QN = WS_GB + 64 * MiB;
constexpr size_t WS_QR = WS_QN + 32 * MiB;
constexpr size_t WS_KN = WS_QR + 16 * MiB;
constexpr size_t WS_VV = WS_KN + 32 * MiB;
constexpr size_t WS_OA = WS_VV + 32 * MiB;
constexpr size_t WS_ORET = WS_OA + 32 * MiB;
constexpr size_t WS_OB = WS_ORET + 128 * MiB;
constexpr size_t WS_MIXP = WS_OB + 64 * MiB;
constexpr size_t WS_MIXIN = WS_MIXP + 64 * MiB;
constexpr size_t WS_MIX = WS_MIXIN + 64 * MiB;
constexpr size_t WS_H2 = WS_MIX + 128 * MiB;
constexpr size_t WS_TOPI = WS_H2 + 64 * MiB;
constexpr size_t WS_TOPW = WS_TOPI + 1 * MiB;
constexpr size_t WS_DEST = WS_TOPW + 1 * MiB;
constexpr size_t WS_TILE = WS_DEST + 1 * MiB;
constexpr size_t WS_YS_END = WS_TILE + 1 * MiB + 3 * 288 * MiB;
constexpr size_t WS_DECTAB = WS_TILE + 65536;
constexpr size_t WS_SSQP = WS_YS_END;
constexpr size_t WS_XS = WS_TILE + 1 * MiB;
constexpr size_t WS_ACT = WS_XS + 288 * MiB;
constexpr size_t WS_YS = WS_ACT + 288 * MiB;
constexpr size_t WS_ADAP = WS_YS + 288 * MiB + 1 * MiB;
constexpr size_t WS_H8 = WS_ADAP + 2 * MiB;
constexpr size_t WS_WT8IN = WS_H8 + 32 * MiB;
constexpr size_t WS_VT8 = WS_WT8IN + 12 * MiB;
constexpr size_t WS_X1B = WS_VT8 + 32 * MiB;
constexpr size_t WS_END = WS_X1B + 64 * MiB;
constexpr int CW_BAR = 4096;
constexpr int CW_QUEUE = 8192, CW_CVTQ = 8384, CW_AQ = 9216  , CW_COUNTS = 10240, CW_CURSOR = 12288;
constexpr int CW_ADA = 16384;
constexpr int CW_SSQQ = 65536, CW_SSQKV = 81920;
static_assert((CW_SSQKV + T) * 4 <= (int)CTL_BYTES, "ctl");

constexpr int RING_BYTES = 131072, CTRL_OFF = 155648, MISC_OFF = CTRL_OFF, LARG_OFF = CTRL_OFF + 1024, LDS_BYTES = 163840;

__device__ __forceinline__ unsigned cvt_pk_bf16(float lo, float hi) { unsigned r; asm volatile("v_cvt_pk_bf16_f32 %0, %1, %2" : "=v"(r) : "v"(lo), "v"(hi)); return r; }
__device__ __forceinline__ u32x4 pack8(f32x4 a, f32x4 b) { u32x4 w; w.x = cvt_pk_bf16(a[0], a[1]); w.y = cvt_pk_bf16(a[2], a[3]); w.z = cvt_pk_bf16(b[0], b[1]); w.w = cvt_pk_bf16(b[2], b[3]); return w; }
__device__ __forceinline__ unsigned pk4_fp8(float a, float b, float c, float d, float sc) {
    a = __builtin_amdgcn_fmed3f(a * sc, -448.f, 448.f); b = __builtin_amdgcn_fmed3f(b * sc, -448.f, 448.f); c = __builtin_amdgcn_fmed3f(c * sc, -448.f, 448.f); d = __builtin_amdgcn_fmed3f(d * sc, -448.f, 448.f);
    int w = __builtin_amdgcn_cvt_pk_fp8_f32(a, b, 0, false); w = __builtin_amdgcn_cvt_pk_fp8_f32(c, d, w, true); return (unsigned)w;
}
constexpr float W8_SCALE = 1024.f, H8_SCALE = 16.f, A8_SCALE = 8.f;
constexpr float V8_SCALE = 16.f, K8_SCALE = 256.f, CH_UNSCALE = 1.0f / (V8_SCALE * K8_SCALE);
constexpr float GU_UNSCALE = 1.0f / (W8_SCALE * H8_SCALE), DN_UNSCALE = 1.0f / (W8_SCALE * A8_SCALE);
__device__ __forceinline__ float bf_lo(unsigned w) { return __uint_as_float(w << 16); }
__device__ __forceinline__ float bf_hi(unsigned w) { return __uint_as_float(w & 0xffff0000u); }
__device__ __forceinline__ void unpack8(u32x4 w, f32x4& a, f32x4& b) { a = (f32x4){bf_lo(w.x), bf_hi(w.x), bf_lo(w.y), bf_hi(w.y)}; b = (f32x4){bf_lo(w.z), bf_hi(w.z), bf_lo(w.w), bf_hi(w.w)}; }
__device__ __forceinline__ float wave_sum(float v) {
#pragma unroll
    for (int o = 1; o < 64; o <<= 1) v += __shfl_xor(v, o);
    return v;
}
__device__ __forceinline__ float sigmoidf_(float x) { return __builtin_amdgcn_rcpf(1.0f + __expf(-x)); }
__device__ __forceinline__ float log2_sigmoid(float x) { return -log1pf(expf(-x)) * 1.4426950408889634f; }

#define XB_TMO      128
#define XB_XCNT(j)  (256  + 64 * (j))
#define XB_XSUB(j)  (1280 + 64 * (j))
#define XB_XGEN(j)  (2304 + 64 * (j))
#define XB_TOP      3328
#define XB_TOPGEN   3392
#define XCD_BAR_WORDS 3456
#define XB_SPIN_CAP (1u << 22)
__device__ __forceinline__ unsigned xb_ld(unsigned* p)              { return __hip_atomic_load(p, __ATOMIC_RELAXED, __HIP_MEMORY_SCOPE_AGENT); }
__device__ __forceinline__ unsigned xb_add(unsigned* p, unsigned v) { return __hip_atomic_fetch_add(p, v, __ATOMIC_RELAXED, __HIP_MEMORY_SCOPE_AGENT); }
__device__ __forceinline__ unsigned xb_xcc_id() { return (unsigned)__builtin_amdgcn_s_getreg((3 << 11) | 20) & 0xFu; }
#define XB_SPIN(cond, bar) do { unsigned _sp = 0; while (cond) { __builtin_amdgcn_s_sleep(1); \
    if ((++_sp & 255u) == 0u) { if (xb_ld(&(bar)[XB_TMO])) break; if (_sp > XB_SPIN_CAP) { atomicAdd(&(bar)[XB_TMO], 1u); break; } } } } while (0)
struct XcdBarrier { unsigned* bar; unsigned x; volatile LAS unsigned* st; };
__device__ __forceinline__ XcdBarrier xcd_barrier_post(unsigned* bar, volatile LAS unsigned* st) {
    XcdBarrier b; b.bar = bar; b.x = xb_xcc_id(); b.st = st;
    if (threadIdx.x == 0) (void)xb_add(&bar[XB_XCNT(b.x)], 1u);
    return b;
}
__device__ __forceinline__ void xcd_barrier_complete(unsigned* bar, unsigned x, unsigned& nloc, unsigned& nx) {
    const unsigned G = gridDim.x * gridDim.y * gridDim.z;
    unsigned sum, cnt, mine, sp = 0u;
    for (;;) {
        sum = 0u; cnt = 0u; mine = 0u;
#pragma unroll
        for (unsigned j = 0; j < 16; ++j) { const unsigned c = xb_ld(&bar[XB_XCNT(j)]); sum += c; cnt += (c > 0u) ? 1u : 0u; mine = (j == x) ? c : mine; }
        if (sum == G) break;
        __builtin_amdgcn_s_sleep(1);
        if ((++sp & 255u) == 0u) { if (xb_ld(&bar[XB_TMO])) break; if (sp > XB_SPIN_CAP) { atomicAdd(&bar[XB_TMO], 1u); break; } }
    }
    nloc = mine > 0u ? mine : 1u; nx = cnt > 0u ? cnt : 1u;
}
__device__ __forceinline__ void xcd_barrier(const XcdBarrier& b) {
    asm volatile("s_waitcnt vmcnt(0)" ::: "memory");
    __syncthreads();
    if (threadIdx.x == 0) {
        unsigned* bar = b.bar;
        __builtin_amdgcn_s_waitcnt(0);
        unsigned nloc = b.st[0], nx = b.st[1];
        if (nloc == 0u) { xcd_barrier_complete(bar, b.x, nloc, nx); b.st[0] = nloc; b.st[1] = nx; }
        const unsigned old = xb_add(&bar[XB_XSUB(b.x)], 1u);
        const unsigned gen = old / nloc;
        if (old + 1u == (gen + 1u) * nloc) {
            __builtin_amdgcn_fence(__ATOMIC_RELEASE, "agent");
            asm volatile("s_waitcnt vmcnt(0)" ::: "memory");
            const unsigned og = xb_add(&bar[XB_TOP], 1u);
            const unsigned tg = og / nx;
            if (og + 1u == (tg + 1u) * nx) xb_add(&bar[XB_TOPGEN], 1u);
            else XB_SPIN(xb_ld(&bar[XB_TOPGEN]) == tg, bar);
            __builtin_amdgcn_fence(__ATOMIC_ACQUIRE, "agent");
            xb_add(&bar[XB_XGEN(b.x)], 1u);
            asm volatile("s_waitcnt vmcnt(0)" ::: "memory");
        } else {
            XB_SPIN(xb_ld(&bar[XB_XGEN(b.x)]) == gen, bar);
            __builtin_amdgcn_fence(__ATOMIC_ACQUIRE, "agent");
            asm volatile("s_waitcnt vmcnt(0)" ::: "memory");
        }
    }
    __syncthreads();
}

namespace pg8 {
constexpr int BM = 256, BK = 64, HALF = 128, HTB = HALF * BK * 2, NXCD = 8, WGM = 8;
__host__ __device__ __forceinline__ int lds_byte(int r, int c) { const int st = (r >> 4) * 2 + (c >> 5), rr = r & 15, cc = c & 31, ob = rr * 64 + cc * 2; return st * 1024 + (ob ^ (((ob >> 9) & 1) << 5)); }
__host__ __device__ __forceinline__ void stage_rc(int b, int& R, int& C) { const int st = b / 1024, sb = b % 1024, swz = sb ^ (((sb >> 9) & 1) << 5); R = (st >> 1) * 16 + swz / 64; C = (st & 1) * 32 + (swz % 64) / 2; }
__host__ __device__ __forceinline__ int perm32(int rho) { const int n = rho >> 4, i = rho & 15; return 8 * (i >> 2) + 4 * n + (i & 3); }
struct Unit { const char* a; const char* b; int pm, pn, keep, aux; };
__device__ __forceinline__ void tile_order(int wgid, int nM, int nN, int& pm, int& pn) {
    const int nwg = nM * nN; { const int q = nwg / NXCD, r = nwg % NXCD, xcd = wgid % NXCD, off = wgid / NXCD; wgid = (xcd < r ? xcd * (q + 1) : r * (q + 1) + (xcd - r) * q) + off; }
    const int nig = WGM * nN, gid = wgid / nig, fm = gid * WGM, gsz = (nM - fm) < WGM ? (nM - fm) : WGM;
    pm = fm + ((wgid % nig) % gsz); pn = (wgid % nig) / gsz;
}
typedef int v8i __attribute__((ext_vector_type(8)));
typedef int v4i __attribute__((ext_vector_type(4)));
template <class Epi, class Sched, bool F8 = false, bool REMAT = false>
__device__ __forceinline__ void gemm_phase(LAS unsigned char* lds, const int K, const int lda, const int ldb, const Sched& S, const Epi& E) {
    const int tid = threadIdx.x, wid = __builtin_amdgcn_readfirstlane(tid >> 6), lane = tid & 63, wr = wid >> 2, wc = wid & 3, fr = lane & 15, fq = lane >> 4;
    constexpr int ES = F8 ? 1 : 2;
    const int nt = K * ES / (BK * 2);
    unsigned voffA, voffB;
    { int R, C; stage_rc(tid * 16, R, C); const int Rb = (R & ~31) + perm32(R & 31); voffA = (unsigned)(R * lda * ES + C * 2); voffB = (unsigned)(Rb * ldb * ES + C * 2); }
    const size_t q64voffA = (size_t)64 * lda * ES, q64voffB = (size_t)64 * ldb * ES;
    const size_t kstep = (size_t)(BK * 2);
    const size_t hstepA = (size_t)HALF * lda * ES, hstepB = (size_t)HALF * ldb * ES;
    const unsigned ldsw = (unsigned)wid * 1024u;
    const int aoff = F8 ? lds_byte(wr * 64 + fr, fq * 16) : lds_byte(wr * 64 + fr, fq * 8), boff = F8 ? lds_byte(wc * 32 + fr, fq * 16) : lds_byte(wc * 32 + fr, fq * 8);
#define PG8_SA(b, h) (((b) * 2 + (h)) * HTB)
#define PG8_SB(b, h) ((4 + (b) * 2 + (h)) * HTB)
    constexpr bool isB_voffA = false, isB_voffB = true; const unsigned pitch_voffA = (unsigned)(lda * ES), pitch_voffB = (unsigned)(ldb * ES);
#define PG8_VOFF(isB, pitch) ({ unsigned _t = threadIdx.x; asm volatile("" : "+v"(_t)); const unsigned _l = _t & 63u, _w = _t >> 6, _sw = (_l * 16u) ^ ((_l >> 5) << 5); unsigned _R = (_w >> 1) * 16u + (_sw >> 6); \
        const unsigned _C = (_w & 1u) * 32u + ((_sw & 63u) >> 1); if (isB) _R = (_R & ~31u) + (unsigned)perm32((int)(_R & 31u)); _R * (pitch) + _C * 2u; })
#define PG8_STAGE(bufoff, gbase, voff) do { _Pragma("unroll") for (int _i = 0; _i < 2; ++_i) { unsigned _vo; if constexpr (REMAT) _vo = PG8_VOFF(isB_##voff, pitch_##voff); else { _vo = (voff); if constexpr (F8) asm volatile("" : "+v"(_vo)); } \
        __builtin_amdgcn_global_load_lds((const unsigned*)((const char*)(gbase) + (_i ? q64##voff : (size_t)0) + _vo), (LAS unsigned*)(lds + (bufoff) + ldsw + _i * 8192), 16, 0, 0); } } while (0)
#define PG8_LD1(addr) ({ v8i _r; if constexpr (F8) { _r = *(const LAS v8i*)(addr); } else { const v4i _lo = *(const LAS v4i*)(addr), _hi = *(const LAS v4i*)((addr) + 1024); _r = __builtin_shufflevector(_lo, _hi, 0, 1, 2, 3, 4, 5, 6, 7); } _r; })
#define PG8_LDA(dst, b, h) do { _Pragma("unroll") for (int m = 0; m < 4; ++m) dst[m] = PG8_LD1(lds + PG8_SA(b, h) + aoff + m * 2048); } while (0)
#define PG8_LDB(dst, b, h) do { _Pragma("unroll") for (int n = 0; n < 2; ++n) dst[n] = PG8_LD1(lds + PG8_SB(b, h) + boff + n * 2048); } while (0)
#define PG8_H0(x) __builtin_bit_cast(bf16x8, __builtin_shufflevector(x, x, 0, 1, 2, 3))
#define PG8_H1(x) __builtin_bit_cast(bf16x8, __builtin_shufflevector(x, x, 4, 5, 6, 7))
#define PG8_MMA(ai, bj, At, Bt) do { __builtin_amdgcn_s_setprio(1); _Pragma("unroll") for (int m = 0; m < 4; ++m) _Pragma("unroll") for (int n = 0; n < 2; ++n) { \
        if constexpr (F8) acc[ai][bj][m][n] = __builtin_amdgcn_mfma_scale_f32_16x16x128_f8f6f4(Bt[n], At[m], acc[ai][bj][m][n], 0, 0, 0, 0, 0, 0); \
        else { acc[ai][bj][m][n] = __builtin_amdgcn_mfma_f32_16x16x32_bf16(PG8_H0(Bt[n]), PG8_H0(At[m]), acc[ai][bj][m][n], 0, 0, 0); \
               acc[ai][bj][m][n] = __builtin_amdgcn_mfma_f32_16x16x32_bf16(PG8_H1(Bt[n]), PG8_H1(At[m]), acc[ai][bj][m][n], 0, 0, 0); } } \
        __builtin_amdgcn_s_setprio(0); } while (0)
#define PG8_WAIT_V(n) asm volatile("s_waitcnt vmcnt(" #n ")" ::: "memory")
#define PG8_WAIT_L(n) asm volatile("s_waitcnt lgkmcnt(" #n ")" ::: "memory")
#define PG8_BAR __builtin_amdgcn_s_barrier()
#define PG8_SCHED __builtin_amdgcn_sched_barrier(0)
    Unit cur, nxt; int ui = 0;
    if (!S.next(0, cur)) return;
    f32x4 acc[2][2][4][2];
#pragma unroll
    for (int a = 0; a < 2; ++a)
#pragma unroll
        for (int b = 0; b < 2; ++b)
#pragma unroll
            for (int m = 0; m < 4; ++m)
#pragma unroll
                for (int n = 0; n < 2; ++n) acc[a][b][m][n] = (f32x4){0.f, 0.f, 0.f, 0.f};
    v8i At[4], B0[2], B1[2];
    const char* cA = cur.a; const char* cB = cur.b;
    PG8_STAGE(PG8_SB(0, 0), cB, voffB); PG8_STAGE(PG8_SB(0, 1), cB + hstepB, voffB); PG8_STAGE(PG8_SA(0, 0), cA, voffA); PG8_STAGE(PG8_SA(0, 1), cA + hstepA, voffA);
    if (wr == 1) PG8_BAR;
    PG8_WAIT_V(2); PG8_BAR;
    PG8_STAGE(PG8_SB(1, 0), cB + kstep, voffB); PG8_STAGE(PG8_SA(1, 0), cA + kstep, voffA); PG8_STAGE(PG8_SB(1, 1), cB + hstepB + kstep, voffB);
    PG8_WAIT_V(6); PG8_BAR;
    for (;;) {
        const bool has_next = S.next(ui + 1, nxt);
        const char* nA = has_next ? nxt.a : cA; const char* nB = has_next ? nxt.b : cB;
#pragma nounroll
        for (int t = 0; t < nt; t += 2) {
            const bool last = (t == nt - 2);
            const char* a1 = cA + (size_t)(t + 1) * kstep;
            const char* a2 = last ? nA : cA + (size_t)(t + 2) * kstep; const char* b2 = last ? nB : cB + (size_t)(t + 2) * kstep;
            const char* a3 = a2 + kstep; const char* b3 = b2 + kstep;
            PG8_LDB(B0, 0, 0); PG8_LDB(B1, 0, 1); PG8_SCHED; PG8_LDA(At, 0, 0); PG8_STAGE(PG8_SA(1, 1), a1 + hstepA, voffA);
            PG8_WAIT_V(8); PG8_WAIT_L(0); PG8_BAR; PG8_MMA(0, 0, At, B0); PG8_MMA(0, 1, At, B1); PG8_BAR; PG8_SCHED;
            PG8_LDA(At, 0, 1); PG8_STAGE(PG8_SB(0, 0), b2, voffB); PG8_STAGE(PG8_SB(0, 1), b2 + hstepB, voffB); PG8_STAGE(PG8_SA(0, 0), a2, voffA);
            PG8_WAIT_V(8); PG8_WAIT_L(0); PG8_BAR; PG8_MMA(1, 0, At, B0); PG8_MMA(1, 1, At, B1); PG8_BAR; PG8_SCHED;
            PG8_LDB(B0, 1, 0); PG8_LDB(B1, 1, 1); PG8_SCHED; PG8_LDA(At, 1, 0); PG8_STAGE(PG8_SA(0, 1), a2 + hstepA, voffA);
            PG8_WAIT_V(8); PG8_WAIT_L(0); PG8_BAR; PG8_MMA(0, 0, At, B0); PG8_MMA(0, 1, At, B1); PG8_BAR; PG8_SCHED;
            PG8_LDA(At, 1, 1); PG8_STAGE(PG8_SB(1, 0), b3, voffB); PG8_STAGE(PG8_SB(1, 1), b3 + hstepB, voffB); PG8_STAGE(PG8_SA(1, 0), a3, voffA);
            PG8_WAIT_V(8); PG8_WAIT_L(0); PG8_BAR; PG8_MMA(1, 0, At, B0); PG8_MMA(1, 1, At, B1); PG8_BAR; PG8_SCHED;
        }
        if (wr == 0) PG8_BAR;
        { unsigned _t = threadIdx.x; if constexpr (F8) asm volatile("" : "+v"(_t)); E(acc, cur, wr, wc, (int)(_t & 15u), (int)((_t >> 4) & 3u)); }
        if (!has_next) break;
        if (!cur.keep) {
#pragma unroll
            for (int a = 0; a < 2; ++a)
#pragma unroll
                for (int b = 0; b < 2; ++b)
#pragma unroll
                    for (int m = 0; m < 4; ++m)
#pragma unroll
                        for (int n = 0; n < 2; ++n) acc[a][b][m][n] = (f32x4){0.f, 0.f, 0.f, 0.f};
        }
        cur = nxt; cA = nA; cB = nB; ++ui;
        if (wr == 1) PG8_BAR;
    }
    PG8_WAIT_V(0);
    PG8_BAR;
#undef PG8_SA
#undef PG8_SB
#undef PG8_STAGE
#undef PG8_VOFF
#undef PG8_LDA
#undef PG8_LDB
#undef PG8_LD1
#undef PG8_H0
#undef PG8_H1
#undef PG8_MMA
#undef PG8_WAIT_V
#undef PG8_WAIT_L
#undef PG8_BAR
#undef PG8_SCHED
}
struct GridSched {
    const char* A; const char* Bt; size_t astep, bstep; int nM, nN, G, c;
    __device__ __forceinline__ bool next(int i, Unit& u) const {
        const int L = i * G + c; if (L >= nM * nN) return false;
        int pm, pn; tile_order(L, nM, nN, pm, pn);
        u.a = A + (size_t)pm * astep; u.b = Bt + (size_t)pn * bstep; u.pm = pm; u.pn = pn; u.keep = 0; u.aux = 0; return true;
    }
};
struct InprojSched {
    const char* H; const char* W; int G, c;
    __device__ __forceinline__ bool next(int i, Unit& u) const {
        const int L = i * G + c; if (L >= 1792) return false;
        constexpr size_t TSB = (size_t)256 * 2048 * 2; int pm, pn;
        if (L < 1280) { tile_order(L, 64, 20, pm, pn); pn = pn < 4 ? pn : pn + 1; u.a = H + (size_t)pm * TSB; u.b = W + (size_t)pn * TSB; u.aux = 0; }
        else { tile_order(L - 1280, 8, 64, pm, pn); u.a = W + (size_t)(45 + pm) * TSB; u.b = H + (size_t)pn * TSB; u.aux = 1; }
        u.pm = pm; u.pn = pn; u.keep = 0; return true;
    }
};
struct GridSchedR {
    const char* A; const char* Bt; size_t astep, bstep; int nM, nN, G, c, L0, Lend;
    __device__ __forceinline__ bool next(int i, Unit& u) const {
        const int L = L0 + i * G + c; if (L >= Lend) return false;
        int pm, pn; tile_order(L, nM, nN, pm, pn);
        u.a = A + (size_t)pm * astep; u.b = Bt + (size_t)pn * bstep; u.pm = pm; u.pn = pn; u.keep = 0; u.aux = 0; return true;
    }
};
struct BatchSchedR {
    const char* A; const char* Bt; size_t astep, bstep; int G, c, L0, Lend;
    __device__ __forceinline__ bool next(int i, Unit& u) const {
        const int L = L0 + i * G + c; if (L >= Lend) return false;
        u.a = A + (size_t)L * astep; u.b = Bt + (size_t)L * bstep; u.pm = L; u.pn = 0; u.keep = 0; u.aux = 0; return true;
    }
};
struct BatchSched {
    const char* A; const char* Bt; size_t astep, bstep; int n, G, c;
    __device__ __forceinline__ bool next(int i, Unit& u) const {
        const int L = i * G + c; if (L >= n) return false;
        u.a = A + (size_t)L * astep; u.b = Bt + (size_t)L * bstep; u.pm = L; u.pn = 0; u.keep = 0; u.aux = 0; return true;
    }
};
struct ChainSched {
    const char* A; const char* Bt; int bh, dir;
    __device__ __forceinline__ bool next(int i, Unit& u) const {
        if (i >= NCH) return false;
        const int n = dir ? (NCH - 1 - i) : i, blk = bh * NCH + n;
        u.a = A + (size_t)blk * (256 * 256); u.b = Bt + (size_t)blk * (256 * 256); u.pm = blk; u.pn = i; u.keep = 1; u.aux = n; return true;
    }
};
struct MoeSched {
    const char* A; const char* Bt; const int* tile_e; int ntiles, nN, G, c;
    __device__ __forceinline__ bool next(int i, Unit& u) const {
        const int L = i * G + c; if (L >= ntiles * nN) return false;
        int pm, pn; tile_order(L, ntiles, nN, pm, pn);
        const int e = __builtin_amdgcn_readfirstlane(tile_e[pm]);
        u.a = A + (size_t)pm * (256 * 2048); u.b = Bt + ((size_t)e * nN + pn) * (256 * 2048); u.pm = pm; u.pn = pn; u.keep = 0; u.aux = e; return true;
    }
};
}
using pg8::Unit;

#define EPI_LOOP _Pragma("unroll") for (int ai = 0; ai < 2; ++ai) _Pragma("unroll") for (int m = 0; m < 4; ++m)
#define EPI_ROW (ai * 128 + wr * 64 + m * 16 + fr)
#define EPI_FENCE asm volatile("" ::: "memory")
typedef f32x4 Acc[2][2][4][2];

__device__ __forceinline__ void rot4(const f32x4 x1, const f32x4 x2, const f32x4 csA, const f32x4 csB, f32x4& o1, f32x4& o2) {
    o1[0] = x1[0] * csA[0] - x2[0] * csA[1]; o2[0] = x1[0] * csA[1] + x2[0] * csA[0];
    o1[1] = x1[1] * csA[2] - x2[1] * csA[3]; o2[1] = x1[1] * csA[3] + x2[1] * csA[2];
    o1[2] = x1[2] * csB[0] - x2[2] * csB[1]; o2[2] = x1[2] * csB[1] + x2[2] * csB[0];
    o1[3] = x1[3] * csB[2] - x2[3] * csB[3]; o2[3] = x1[3] * csB[3] + x2[3] * csB[2];
}
__device__ __forceinline__ f32x4 rot_il(const f32x4 v, const f32x4 cs) {
    return (f32x4){v[0] * cs[0] - v[1] * cs[1], v[0] * cs[1] + v[1] * cs[0], v[2] * cs[2] - v[3] * cs[3], v[2] * cs[3] + v[3] * cs[2]};
}

struct EpiInproj {
    bf16_t *QL, *CKV, *KR, *ACAT, *KROT, *SG, *GA, *GB; float *ssqp; const float* cs_ret; const float* cs_mla; const float* dectab; int pn_off; float unscale;
    __device__ __forceinline__ void operator()(Acc& acc, const Unit& u, int wr, int wc, int fr, int fq) const {
        asm volatile("" : "+v"(fr), "+v"(fq));
        const int pn = u.pn + pn_off, tok0 = u.pm * 256, cb = wc * 32 + fq * 8;
        if (pn < 4) {
            bf16_t* dst = QL + (size_t)(pn >> 1) * ((WS_CKV - WS_QL) / 2); float* ssq = ssqp + (size_t)(pn * 4 + wc) * T; const int c0 = (pn & 1) * 256 + cb;
            EPI_LOOP { const int row = tok0 + EPI_ROW; float s = 0.f;
#pragma unroll
                for (int bj = 0; bj < 2; ++bj) { const f32x4 v0 = acc[ai][bj][m][0], v1 = acc[ai][bj][m][1];
                    s += (v0[0] * v0[0] + v0[1] * v0[1]) + (v0[2] * v0[2] + v0[3] * v0[3]) + (v1[0] * v1[0] + v1[1] * v1[1]) + (v1[2] * v1[2] + v1[3] * v1[3]);
                    *(u32x4*)(dst + (size_t)row * 512 + c0 + bj * 128) = pack8(v0, v1); }
                s += __shfl_xor(s, 16); s += __shfl_xor(s, 32);
                if (fq == 0) ssq[row] = s; EPI_FENCE; }
        } else if (pn == 4) {
            if (wc < 2) {
                EPI_LOOP { const int row = tok0 + EPI_ROW; const float* cs = cs_mla + (size_t)row * 64 + cb;
                    const f32x4 csA = *(const f32x4*)cs, csB = *(const f32x4*)(cs + 4);
                    *(u32x4*)(KR + (size_t)row * 64 + cb) = pack8(rot_il(acc[ai][0][m][0], csA), rot_il(acc[ai][0][m][1], csB)); EPI_FENCE; }
            }
        } else if (pn < 21) {
            const bool isq = pn < 13; const int h = isq ? pn - 5 : pn - 13;
            const int blk = ((u.pm >> 4) * 8 + h) * NCH + (u.pm & 15);
            const float lf = dectab[h], lb = dectab[8 + h];
            EPI_LOOP { const int c = EPI_ROW, row = tok0 + c; const float* cs = cs_ret + (size_t)row * 256 + cb * 2;
                f32x4 q1[2], q2[2];
#pragma unroll
                for (int n = 0; n < 2; ++n) { const f32x4 csA = *(const f32x4*)(cs + n * 8), csB = *(const f32x4*)(cs + n * 8 + 4); rot4(acc[ai][0][m][n], acc[ai][1][m][n], csA, csB, q1[n], q2[n]); }
                if (isq) {
                    const float xf = __builtin_amdgcn_exp2f((float)(c + 1) * lf), xb = __builtin_amdgcn_exp2f((float)(CH - c) * lb);
                    bf16_t* base = ACAT + ((size_t)blk * 256 + c) * 768 + cb;
                    *(u32x4*)(base + 256) = pack8(q1[0] * xf, q1[1] * xf); *(u32x4*)(base + 384) = pack8(q2[0] * xf, q2[1] * xf);
                    *(u32x4*)(base + 512) = pack8(q1[0] * xb, q1[1] * xb); *(u32x4*)(base + 640) = pack8(q2[0] * xb, q2[1] * xb);
                } else {
                    bf16_t* base = KROT + ((size_t)blk * 256 + c) * 256 + cb;
                    *(u32x4*)(base) = pack8(q1[0] * 0.0625f, q1[1] * 0.0625f); *(u32x4*)(base + 128) = pack8(q2[0] * 0.0625f, q2[1] * 0.0625f);
                }
                EPI_FENCE; }
        } else {
            const int g = (pn - 21) >> 3, ct = (pn - 21) & 7; bf16_t* dst = SG + (size_t)g * ((WS_GA - WS_SG) / 2);
            EPI_LOOP { const int row = tok0 + EPI_ROW;
#pragma unroll
                for (int bj = 0; bj < 2; ++bj) { f32x4 v[2];
#pragma unroll
                    for (int n = 0; n < 2; ++n)
#pragma unroll
                        for (int j = 0; j < 4; ++j) { const float x = acc[ai][bj][m][n][j] * unscale; const float sg = sigmoidf_(x); v[n][j] = g == 0 ? x * sg : sg; }
                    *(u32x4*)(dst + (size_t)row * 2048 + ct * 256 + bj * 128 + cb) = pack8(v[0], v[1]); }
                EPI_FENCE; }
        }
    }
};
struct EpiVT {
    bf16_t* BCAT; unsigned char* VT8;
    __device__ __forceinline__ void operator()(Acc& acc, const Unit& u, int wr, int wc, int fr, int fq) const {
        asm volatile("" : "+v"(fr), "+v"(fq));
        const int blk = ((u.pn >> 4) * 8 + u.pm) * NCH + (u.pn & 15), cb = wc * 32 + fq * 8;
        EPI_LOOP { bf16_t* base = BCAT + ((size_t)blk * 256 + EPI_ROW) * 768 + cb; unsigned char* b8 = VT8 + ((size_t)blk * 256 + EPI_ROW) * 256 + cb;
#pragma unroll
            for (int bj = 0; bj < 2; ++bj) { const f32x4 v0 = acc[ai][bj][m][0], v1 = acc[ai][bj][m][1]; *(u32x4*)(base + bj * 128) = pack8(v0, v1);
                u32x2 w8; w8.x = pk4_fp8(v0[0], v0[1], v0[2], v0[3], V8_SCALE); w8.y = pk4_fp8(v1[0], v1[1], v1[2], v1[3], V8_SCALE); *(u32x2*)(b8 + bj * 128) = w8; } }
    }
};
struct EpiInprojAll {
    EpiInproj a; EpiVT b;
    __device__ __forceinline__ void operator()(Acc& acc, const Unit& u, int wr, int wc, int fr, int fq) const { if (u.aux) b(acc, u, wr, wc, fr, fq); else a(acc, u, wr, wc, fr, fq); }
};
struct EpiMlaQ {
    bf16_t *QN, *QR; const float* ssq; const float* cs_mla;
    __device__ __forceinline__ void operator()(Acc& acc, const Unit& u, int wr, int wc, int fr, int fq) const {
        asm volatile("" : "+v"(fr), "+v"(fq));
        const int pn = u.pn, tok0 = u.pm * 256, cb = wc * 32 + fq * 8;
        EPI_LOOP { const int row = tok0 + EPI_ROW; float ss = 0.f;
#pragma unroll
            for (int q = 0; q < 8; ++q) ss += ssq[(size_t)q * T + row];
            const float rs = rsqrtf(ss * (1.0f / 512.0f) + RMS_EPS) * QSCALE;
            if (pn < 4) {
#pragma unroll
                for (int bj = 0; bj < 2; ++bj) *(u32x4*)(QN + (size_t)row * 1024 + (2 * pn + bj) * 128 + cb) = pack8(acc[ai][bj][m][0] * rs, acc[ai][bj][m][1] * rs);
            } else {
                const int c0 = (wc & 1) * 32 + fq * 8; const float* cs = cs_mla + (size_t)row * 64 + c0;
                const f32x4 csA = *(const f32x4*)cs, csB = *(const f32x4*)(cs + 4);
#pragma unroll
                for (int bj = 0; bj < 2; ++bj) { const int head = 4 * (pn - 4) + 2 * bj + (wc >> 1);
                    *(u32x4*)(QR + (size_t)row * 512 + head * 64 + c0) = pack8(rot_il(acc[ai][bj][m][0], csA) * rs, rot_il(acc[ai][bj][m][1], csB) * rs); }
            }
            EPI_FENCE; }
    }
};
struct EpiMlaKV {
    bf16_t *KN, *VV; const float* ssq;
    __device__ __forceinline__ void operator()(Acc& acc, const Unit& u, int wr, int wc, int fr, int fq) const {
        asm volatile("" : "+v"(fr), "+v"(fq));
        const int pn = u.pn, tok0 = u.pm * 256, cb = wc * 32 + fq * 8; bf16_t* dst = KN + (size_t)(pn >> 2) * ((WS_VV - WS_KN) / 2); const int hb = 2 * (pn & 3);
        EPI_LOOP { const int row = tok0 + EPI_ROW; float ss = 0.f;
#pragma unroll
            for (int q = 0; q < 8; ++q) ss += ssq[(size_t)q * T + row];
            const float rs = rsqrtf(ss * (1.0f / 512.0f) + RMS_EPS);
#pragma unroll
            for (int bj = 0; bj < 2; ++bj) *(u32x4*)(dst + (size_t)row * 1024 + (hb + bj) * 128 + cb) = pack8(acc[ai][bj][m][0] * rs, acc[ai][bj][m][1] * rs); }
    }
};
struct EpiGa {
    bf16_t* ACAT; const float* dectab;
    __device__ __forceinline__ void operator()(Acc& acc, const Unit& u, int wr, int wc, int fr, int fq) const {
        asm volatile("" : "+v"(fr), "+v"(fq));
        const int blk = u.pm, h = (blk >> 4) & 7, cb = wc * 32 + fq * 8;
        const float lf = dectab[h], lb = dectab[8 + h];
        f32x4 colA[2][2], colB[2][2];
#pragma unroll
        for (int bj = 0; bj < 2; ++bj)
#pragma unroll
            for (int n = 0; n < 2; ++n)
#pragma unroll
                for (int j = 0; j < 4; ++j) { const int mm = bj * 128 + cb + n * 4 + j; colA[bj][n][j] = __builtin_amdgcn_exp2f(-(float)(mm + 1) * lf); colB[bj][n][j] = __builtin_amdgcn_exp2f((float)mm * lb); }
        EPI_LOOP { const int c = EPI_ROW; bf16_t* base = ACAT + ((size_t)blk * 256 + c) * 768 + cb;
            const float rowB = __builtin_amdgcn_exp2f(-(float)c * lb - (float)(c + 1) * lf);
#pragma unroll
            for (int bj = 0; bj < 2; ++bj) { f32x4 v[2];
#pragma unroll
                for (int n = 0; n < 2; ++n)
#pragma unroll
                    for (int j = 0; j < 4; ++j) { const int mm = bj * 128 + cb + n * 4 + j;
                        v[n][j] = acc[ai][bj][m][n][j] * ((c >= mm) ? colA[bj][n][j] : colB[bj][n][j] * rowB); }
                *(u32x4*)(base + bj * 128) = pack8(v[0], v[1]); }
            EPI_FENCE; }
    }
};
struct EpiGb {
    bf16_t* BCAT; const float* dectab; int dir;
    __device__ __forceinline__ void operator()(Acc& acc, const Unit& u, int wr, int wc, int fr, int fq) const {
        asm volatile("" : "+v"(fr), "+v"(fq));
        const int h = (u.pm >> 4) & 7;
        const float gC = __builtin_amdgcn_exp2f((float)CH * dectab[8 * dir + h]);
        if (u.pn < NCH - 1) {
            const int nblk = dir ? u.pm - 1 : u.pm + 1;
            bf16_t* base0 = BCAT + ((size_t)nblk * 256 + wr * 64 + fr) * 768 + 256 + 256 * dir + wc * 32 + fq * 8;
            EPI_LOOP { bf16_t* base = base0 + (size_t)(ai * 128 + m * 16) * 768;
#pragma unroll
                for (int bj = 0; bj < 2; ++bj) *(u32x4*)(base + bj * 128) = pack8(acc[ai][bj][m][0] * CH_UNSCALE, acc[ai][bj][m][1] * CH_UNSCALE); }
        }
        EPI_LOOP {
#pragma unroll
            for (int bj = 0; bj < 2; ++bj) { acc[ai][bj][m][0] *= gC; acc[ai][bj][m][1] *= gC; } }
    }
};
struct EpiGc {
    bf16_t* OB; const bf16_t* SG; const float* gn; LAS unsigned char* lds;
    __device__ __forceinline__ void operator()(Acc& acc, const Unit& u, int wr, int wc, int fr, int fq) const {
        asm volatile("" : "+v"(fr), "+v"(fq));
        const int blk = u.pm, b = blk >> 7, h = (blk >> 4) & 7, n = blk & 15, cb = wc * 32 + fq * 8;
        LAS f32x2* P = (LAS f32x2*)(lds + RING_BYTES);
        EPI_LOOP { float s = 0.f;
#pragma unroll
            for (int bj = 0; bj < 2; ++bj)
#pragma unroll
                for (int nn = 0; nn < 2; ++nn) { const f32x4 x = acc[ai][bj][m][nn]; s += (x[0] + x[1]) + (x[2] + x[3]); }
            s += __shfl_xor(s, 16); s += __shfl_xor(s, 32);
            const float mw = s * (1.0f / 64.0f); float q = 0.f;
#pragma unroll
            for (int bj = 0; bj < 2; ++bj)
#pragma unroll
                for (int nn = 0; nn < 2; ++nn) { const f32x4 d = acc[ai][bj][m][nn] - mw; q += (d[0] * d[0] + d[1] * d[1]) + (d[2] * d[2] + d[3] * d[3]); }
            q += __shfl_xor(q, 16); q += __shfl_xor(q, 32);
            if (fq == 0) P[EPI_ROW * 4 + wc] = (f32x2){mw, q}; }
        asm volatile("s_waitcnt lgkmcnt(0)" ::: "memory"); __builtin_amdgcn_s_barrier(); asm volatile("" ::: "memory");
        EPI_LOOP { const int row = EPI_ROW; const f32x4 p01 = *(const LAS f32x4*)(P + row * 4), p23 = *(const LAS f32x4*)(P + row * 4 + 2);
            const float mean = ((p01[0] + p01[2]) + (p23[0] + p23[2])) * 0.25f;
            const float d0 = p01[0] - mean, d1 = p01[2] - mean, d2 = p23[0] - mean, d3 = p23[2] - mean;
            const float m2 = ((p01[1] + p01[3]) + (p23[1] + p23[3])) + 64.0f * ((d0 * d0 + d1 * d1) + (d2 * d2 + d3 * d3));
            const float rstd = rsqrtf(m2 * (1.0f / 256.0f) + GN_EPS);
            const size_t off = ((size_t)b * SEQ + n * 256 + row) * 2048 + h * 256 + cb;
#pragma unroll
            for (int bj = 0; bj < 2; ++bj) { f32x4 s0, s1; unpack8(*(const u32x4*)(SG + off + bj * 128), s0, s1);
                const f32x4 g0 = *(const f32x4*)(gn + h * 256 + bj * 128 + cb), g1 = *(const f32x4*)(gn + h * 256 + bj * 128 + cb + 4);
                *(u32x4*)(OB + off + bj * 128) = pack8(s0 * ((acc[ai][bj][m][0] - mean) * rstd * g0), s1 * ((acc[ai][bj][m][1] - mean) * rstd * g1)); }
            EPI_FENCE; }
    }
};
struct EpiMixA {
    bf16_t* MIXP; const bf16_t* GA;
    __device__ __forceinline__ void operator()(Acc& acc, const Unit& u, int wr, int wc, int fr, int fq) const {
        asm volatile("" : "+v"(fr), "+v"(fq));
        const int cb = wc * 32 + fq * 8;
        EPI_LOOP { const size_t off = (size_t)(u.pm * 256 + EPI_ROW) * 2048 + u.pn * 256 + cb;
#pragma unroll
            for (int bj = 0; bj < 2; ++bj) { f32x4 g0, g1; unpack8(*(const u32x4*)(GA + off + bj * 128), g0, g1);
                *(u32x4*)(MIXP + off + bj * 128) = pack8(acc[ai][bj][m][0] * g0, acc[ai][bj][m][1] * g1); }
            EPI_FENCE; }
    }
};
struct EpiMixB {
    bf16_t* MIXIN; const bf16_t* MIXP; const bf16_t* GB;
    __device__ __forceinline__ void operator()(Acc& acc, const Unit& u, int wr, int wc, int fr, int fq) const {
        asm volatile("" : "+v"(fr), "+v"(fq));
        const int cb = wc * 32 + fq * 8;
        EPI_LOOP { const size_t off = (size_t)(u.pm * 256 + EPI_ROW) * 2048 + u.pn * 256 + cb;
#pragma unroll
            for (int bj = 0; bj < 2; ++bj) { f32x4 g0, g1, p0, p1; unpack8(*(const u32x4*)(GB + off + bj * 128), g0, g1); unpack8(*(const u32x4*)(MIXP + off + bj * 128), p0, p1);
                *(u32x4*)(MIXIN + off + bj * 128) = pack8(acc[ai][bj][m][0] * g0 + p0, acc[ai][bj][m][1] * g1 + p1); }
            EPI_FENCE; }
    }
};
struct EpiF32 {
    bf16_t* C;
    __device__ __forceinline__ void operator()(Acc& acc, const Unit& u, int wr, int wc, int fr, int fq) const {
        asm volatile("" : "+v"(fr), "+v"(fq));
        const int cb = wc * 32 + fq * 8;
        EPI_LOOP { bf16_t* base = C + (size_t)(u.pm * 256 + EPI_ROW) * 2048 + u.pn * 256 + cb;
#pragma unroll
            for (int bj = 0; bj < 2; ++bj) *(u32x4*)(base + bj * 128) = pack8(acc[ai][bj][m][0], acc[ai][bj][m][1]); }
    }
};
struct EpiGU {
    bf16_t* ACT; const float* bgu; int skip;
    __device__ __forceinline__ void operator()(Acc& acc, const Unit& u, int wr, int wc, int fr, int fq) const {
        asm volatile("" : "+v"(fr), "+v"(fq));
        if (skip) return;
        const int cb = wc * 32 + fq * 8, col = u.pn * 128 + cb; const float* bg = bgu + (size_t)u.aux * 4096 + col;
        const f32x4 bg0 = *(const f32x4*)bg, bg1 = *(const f32x4*)(bg + 4), bu0 = *(const f32x4*)(bg + 2048), bu1 = *(const f32x4*)(bg + 2052);
        EPI_LOOP { f32x4 v[2];
#pragma unroll
            for (int n = 0; n < 2; ++n)
#pragma unroll
                for (int j = 0; j < 4; ++j) { const float gt = fminf(acc[ai][0][m][n][j] * GU_UNSCALE + (n ? bg1[j] : bg0[j]), 7.0f); const float up = fminf(fmaxf(acc[ai][1][m][n][j] * GU_UNSCALE + (n ? bu1[j] : bu0[j]), -7.0f), 7.0f);
                    v[n][j] = (up + 1.0f) * gt * sigmoidf_(1.702f * gt); }
            u32x2 w8; w8.x = pk4_fp8(v[0][0], v[0][1], v[0][2], v[0][3], A8_SCALE); w8.y = pk4_fp8(v[1][0], v[1][1], v[1][2], v[1][3], A8_SCALE);
            *(u32x2*)((unsigned char*)ACT + (size_t)(u.pm * 256 + EPI_ROW) * 2048 + col) = w8; EPI_FENCE; }
    }
};
struct EpiDown {
    bf16_t* YS; const float* bd;
    __device__ __forceinline__ void operator()(Acc& acc, const Unit& u, int wr, int wc, int fr, int fq) const {
        asm volatile("" : "+v"(fr), "+v"(fq));
        const int cb = wc * 32 + fq * 8; const float* bp = bd + (size_t)u.aux * 2048 + u.pn * 256 + cb;
        f32x4 bv[2][2];
#pragma unroll
        for (int bj = 0; bj < 2; ++bj) { bv[bj][0] = *(const f32x4*)(bp + bj * 128); bv[bj][1] = *(const f32x4*)(bp + bj * 128 + 4); }
        EPI_LOOP { bf16_t* base = YS + (size_t)(u.pm * 256 + EPI_ROW) * 2048 + u.pn * 256 + cb;
#pragma unroll
            for (int bj = 0; bj < 2; ++bj) *(u32x4*)(base + bj * 128) = pack8(acc[ai][bj][m][0] * DN_UNSCALE + bv[bj][0], acc[ai][bj][m][1] * DN_UNSCALE + bv[bj][1]); }
    }
};

namespace att {
constexpr int NW = 8, QBLK = 32, KVBLK = 64;
constexpr float THR = 8.f;
constexpr int SHM_V = KVBLK * 128 * 2, SHM_KN = KVBLK * 128 * 2, SHM_KR = KVBLK * 64 * 2, NVB = 3, SHM_ATTN = NVB * SHM_V + 2 * SHM_KN + 2 * SHM_KR + NW * 64 * 4;
#define KSWZ(row, colB) ((row) * 256 + ((colB) ^ (((row) & 15) << 4)))
#define KSWZR(row, colB) ((row) * 128 + ((colB) ^ ((((row) >> 1) & 7) << 4)))
#define SBAR() __builtin_amdgcn_sched_barrier(0)
__device__ __forceinline__ int crow(int r, int hi) { return (r & 3) + 8 * (r >> 2) + 4 * hi; }
__device__ __forceinline__ void partialSM(f32x16& p0, f32x16& p1, float& m_reg, float& mn, float& alpha) {
    constexpr float C = 1.4426950408889634f;
    float pmax = p0[0];
#pragma unroll
    for (int r = 1; r < 16; ++r) pmax = fmaxf(pmax, p0[r]);
#pragma unroll
    for (int r = 0; r < 16; ++r) pmax = fmaxf(pmax, p1[r]);
    { auto rr = __builtin_amdgcn_permlane32_swap(__float_as_uint(pmax), __float_as_uint(pmax), false, false);
      pmax = fmaxf(__uint_as_float(rr[0]), __uint_as_float(rr[1])); }
    if (__builtin_expect(__all(pmax - m_reg <= THR), 1)) { mn = m_reg; alpha = 1.f; }
    else { mn = fmaxf(m_reg, pmax); alpha = __builtin_amdgcn_exp2f((m_reg - mn) * C); m_reg = mn; }
    const float mnC = -mn * C;
#pragma unroll
    for (int r = 0; r < 16; ++r) p0[r] = fmaf(p0[r], C, mnC);
#pragma unroll
    for (int r = 0; r < 16; ++r) p1[r] = fmaf(p1[r], C, mnC);
#pragma unroll
    for (int r = 0; r < 16; ++r) p0[r] = __builtin_amdgcn_exp2f(p0[r]);
}
__device__ __forceinline__ void finishSM(f32x16& p0, f32x16& p1, float alpha, float& l_reg, bf16x8& pa0, bf16x8& pa1, bf16x8& pa2, bf16x8& pa3) {
#pragma unroll
    for (int r = 0; r < 16; ++r) p1[r] = __builtin_amdgcn_exp2f(p1[r]);
    float ps = 0;
#pragma unroll
    for (int r = 0; r < 16; ++r) ps += p0[r];
#pragma unroll
    for (int r = 0; r < 16; ++r) ps += p1[r];
    { auto rr = __builtin_amdgcn_permlane32_swap(__float_as_uint(ps), __float_as_uint(ps), false, false);
      ps = __uint_as_float(rr[0]) + __uint_as_float(rr[1]); }
    l_reg = l_reg * alpha + ps;
#define PK4(P, BASE, OUT) do { unsigned a0 = cvt_pk_bf16(P[BASE + 0], P[BASE + 1]), a1 = cvt_pk_bf16(P[BASE + 2], P[BASE + 3]);   \
    unsigned b0 = cvt_pk_bf16(P[BASE + 4], P[BASE + 5]), b1 = cvt_pk_bf16(P[BASE + 6], P[BASE + 7]);                              \
    auto r0 = __builtin_amdgcn_permlane32_swap(a0, b0, false, false); auto r1 = __builtin_amdgcn_permlane32_swap(a1, b1, false, false); \
    u32x4 w = {r0[0], r1[0], r0[1], r1[1]}; OUT = *reinterpret_cast<bf16x8*>(&w); } while (0)
    PK4(p0, 0, pa0); PK4(p0, 8, pa1); PK4(p1, 0, pa2); PK4(p1, 8, pa3);
#undef PK4
}
__device__ __forceinline__ void qkt(f32x16& p0, f32x16& p1, const char* Kns, const char* Krs, const bf16x8* qr, int r32, int hi) {
    p0 = f32x16{}; p1 = f32x16{};
#pragma unroll
    for (int d0 = 0; d0 < 12; ++d0) { const int cb = ((d0 & 7) * 16 + hi * 8) * 2;
        const bf16x8 b0 = *reinterpret_cast<const bf16x8*>(d0 < 8 ? Kns + KSWZ(r32, cb) : Krs + KSWZR(r32, cb));
        const bf16x8 b1 = *reinterpret_cast<const bf16x8*>(d0 < 8 ? Kns + KSWZ(32 + r32, cb) : Krs + KSWZR(32 + r32, cb));
        p0 = __builtin_amdgcn_mfma_f32_32x32x16_bf16(b0, qr[d0], p0, 0, 0, 0);
        p1 = __builtin_amdgcn_mfma_f32_32x32x16_bf16(b1, qr[d0], p1, 0, 0, 0); }
}
__device__ __forceinline__ int v_st(int k, int c) { const int kk = (k & ~0xC) | ((k & 4) << 1) | ((k & 8) >> 1); return ((kk >> 3) * 4 + (c >> 5)) * 512 + ((kk & 7) * 32 + (c & 31)) * 2; }
__device__ __forceinline__ int v_rd_base(int lane) { return ((lane & 3) << 3) | (((lane >> 2) & 3) << 6) | (((lane >> 4) & 1) << 5) | (((lane >> 5) & 1) << 8); }
constexpr int v_rd_off(int d0, int ks, int half) { return d0 * 512 + ks * 4096 + half * 2048; }
template <int OFF> __device__ __forceinline__ s16x4 tr_read(int vb) {
    s16x4 r; asm volatile("ds_read_b64_tr_b16 %0, %1 offset:%2" : "=&v"(r) : "v"(vb), "i"(OFF) : "memory"); return r;
}
template <int D0> __device__ __forceinline__ void pv_one(f32x16& od, int vb, bf16x8 pa0, bf16x8 pa1, bf16x8 pa2, bf16x8 pa3) {
    const s16x4 l0 = tr_read<v_rd_off(D0, 0, 0)>(vb), h0 = tr_read<v_rd_off(D0, 0, 1)>(vb), l1 = tr_read<v_rd_off(D0, 1, 0)>(vb), h1 = tr_read<v_rd_off(D0, 1, 1)>(vb);
    const s16x4 l2 = tr_read<v_rd_off(D0, 2, 0)>(vb), h2 = tr_read<v_rd_off(D0, 2, 1)>(vb), l3 = tr_read<v_rd_off(D0, 3, 0)>(vb), h3 = tr_read<v_rd_off(D0, 3, 1)>(vb);
    asm volatile("s_waitcnt lgkmcnt(0)" ::: "memory"); SBAR();
#define PKV(L, H) (bf16x8){L[0], L[1], L[2], L[3], H[0], H[1], H[2], H[3]}
    od = __builtin_amdgcn_mfma_f32_32x32x16_bf16(pa0, PKV(l0, h0), od, 0, 0, 0);
    od = __builtin_amdgcn_mfma_f32_32x32x16_bf16(pa1, PKV(l1, h1), od, 0, 0, 0);
    od = __builtin_amdgcn_mfma_f32_32x32x16_bf16(pa2, PKV(l2, h2), od, 0, 0, 0);
    od = __builtin_amdgcn_mfma_f32_32x32x16_bf16(pa3, PKV(l3, h3), od, 0, 0, 0);
#undef PKV
}
__device__ __forceinline__ void pv_d0(f32x16* o, int vb, bf16x8 pa0, bf16x8 pa1, bf16x8 pa2, bf16x8 pa3) {
    pv_one<0>(o[0], vb, pa0, pa1, pa2, pa3); pv_one<1>(o[1], vb, pa0, pa1, pa2, pa3); pv_one<2>(o[2], vb, pa0, pa1, pa2, pa3); pv_one<3>(o[3], vb, pa0, pa1, pa2, pa3);
}
__device__ __forceinline__ void attn_unit(const bf16_t* __restrict__ Qn, const bf16_t* __restrict__ Qr, const bf16_t* __restrict__ Kn, const bf16_t* __restrict__ Kr,
                                          const bf16_t* __restrict__ Vh, bf16_t* __restrict__ Ob, int seq, char* lds) {
    const int tid = threadIdx.x, wid = __builtin_amdgcn_readfirstlane(tid >> 6), lane = tid & 63, r32 = lane & 31, hi = lane >> 5;
    char* V_lds = lds; char* Kn_lds = lds + NVB * SHM_V; char* Kr_lds = Kn_lds + 2 * SHM_KN;
    float* ws = (float*)(Kr_lds + 2 * SHM_KR) + wid * 64; float* li_l = ws; float* al_l = ws + 32;
    float m_reg = -1e30f, l_reg = 0; f32x16 o[4] = {}; bf16x8 qr[12];
    { const bf16_t* q0 = Qn + (long)(wid * QBLK + r32) * 1024 + hi * 8; const bf16_t* q1 = Qr + (long)(wid * QBLK + r32) * 512 + hi * 8;
#pragma unroll
      for (int d0 = 0; d0 < 8; ++d0) qr[d0] = *reinterpret_cast<const bf16x8*>(q0 + d0 * 16);
#pragma unroll
      for (int d0 = 0; d0 < 4; ++d0) qr[8 + d0] = *reinterpret_cast<const bf16x8*>(q1 + d0 * 16); }
    const int vb0 = (int)(uintptr_t)V_lds + v_rd_base(lane);
    unsigned offV[2], offKn[2], offKr;
#pragma unroll
    for (int t = 0; t < 2; ++t) {
        { const int sub = 2 * (2 * wid + t) + (lane >> 5), kk = (sub >> 2) * 8 + ((lane & 31) >> 2), k = (kk & ~0xC) | ((kk & 4) << 1) | ((kk & 8) >> 1), c = (sub & 3) * 32 + (lane & 3) * 8; offV[t] = (unsigned)(k * 1024 + c) * 2u; }
        { const int row = 4 * (2 * wid + t) + (lane >> 4), colB = ((lane & 15) * 16) ^ ((row & 15) << 4); offKn[t] = (unsigned)(row * 1024) * 2u + (unsigned)colB; } }
    { const int row = 8 * wid + (lane >> 3), colB = ((lane & 7) * 16) ^ (((row >> 1) & 7) << 4); offKr = (unsigned)(row * 64) * 2u + (unsigned)colB; }
#define LASP(p) ((LAS unsigned*)(unsigned)(uintptr_t)(p))
#define SLOAD(k0, b, bv) do { _Pragma("unroll") for (int t = 0; t < 2; ++t) { \
        __builtin_amdgcn_global_load_lds((const unsigned*)((const char*)Vh + (size_t)(k0) * 2048 + offV[t]), LASP(V_lds + (bv) * SHM_V + (2 * wid + t) * 1024), 16, 0, 0); \
        __builtin_amdgcn_global_load_lds((const unsigned*)((const char*)Kn + (size_t)(k0) * 2048 + offKn[t]), LASP(Kn_lds + (b) * SHM_KN + (2 * wid + t) * 1024), 16, 0, 0); } \
        __builtin_amdgcn_global_load_lds((const unsigned*)((const char*)Kr + (size_t)(k0) * 128 + offKr), LASP(Kr_lds + (b) * SHM_KR + wid * 1024), 16, 0, 0); } while (0)
#define SWAIT() asm volatile("s_waitcnt vmcnt(0)" ::: "memory")
#define RESC(a) do { if (__any((a) < 1.f)) { if (hi == 0) al_l[r32] = (a); asm volatile("s_waitcnt lgkmcnt(0)" ::: "memory"); \
    _Pragma("unroll") for (int d = 0; d < 4; ++d) _Pragma("unroll") for (int r = 0; r < 16; ++r) o[d][r] *= al_l[crow(r, hi)]; } } while (0)
    f32x16 p0, p1; float mn, al; bf16x8 pa0, pa1, pa2, pa3; const int NT = seq / KVBLK;
    SLOAD(0, 0, 0); SWAIT(); __syncthreads();
    if (wid < 4) {
        int bv = 0;
        for (int j = 0; j < NT; ++j) {
            const int buf = j & 1, bvn = bv == NVB - 1 ? 0 : bv + 1;
            if (j + 1 < NT) SLOAD((j + 1) * KVBLK, buf ^ 1, bvn);
            SBAR(); qkt(p0, p1, Kn_lds + buf * SHM_KN, Kr_lds + buf * SHM_KR, qr, r32, hi);
            partialSM(p0, p1, m_reg, mn, al);
            RESC(al);
            finishSM(p0, p1, al, l_reg, pa0, pa1, pa2, pa3); SBAR();
            pv_d0(o, vb0 + bv * SHM_V, pa0, pa1, pa2, pa3);
            SWAIT();
            __syncthreads();
            bv = bvn;
        }
    } else {
        int bv = 0, bvp = 0;
        for (int j = 0; j < NT; ++j) {
            const int buf = j & 1, bvn = bv == NVB - 1 ? 0 : bv + 1;
            if (j + 1 < NT) SLOAD((j + 1) * KVBLK, buf ^ 1, bvn);
            if (j > 0) { SBAR(); pv_d0(o, vb0 + bvp * SHM_V, pa0, pa1, pa2, pa3); SBAR(); }
            SBAR(); qkt(p0, p1, Kn_lds + buf * SHM_KN, Kr_lds + buf * SHM_KR, qr, r32, hi);
            partialSM(p0, p1, m_reg, mn, al);
            RESC(al);
            finishSM(p0, p1, al, l_reg, pa0, pa1, pa2, pa3); SBAR();
            SWAIT();
            __syncthreads();
            bvp = bv; bv = bvn;
        }
        SBAR(); pv_d0(o, vb0 + bvp * SHM_V, pa0, pa1, pa2, pa3);
    }
    if (hi == 0) li_l[r32] = l_reg; asm volatile("s_waitcnt lgkmcnt(0)" ::: "memory");
    float rli[16];
#pragma unroll
    for (int r = 0; r < 16; ++r) rli[r] = __builtin_amdgcn_rcpf(li_l[crow(r, hi)]);
    bf16_t* Ow = Ob + (long)(wid * QBLK) * 1024;
#pragma unroll
    for (int r = 0; r < 16; ++r) { const int orow = crow(r, hi);
#pragma unroll
        for (int d0 = 0; d0 < 4; ++d0) Ow[(long)orow * 1024 + d0 * 32 + r32] = (bf16_t)(cvt_pk_bf16(o[d0][r] * rli[r], 0.f) & 0xffffu); }
#undef SLOAD
#undef LASP
#undef SWAIT
#undef RESC
}
}

struct Args { const float* in[26]; float* out; unsigned char* ws; int ph_lo, ph_hi; };
enum { PH_SETUP = 0, PH_H, PH_INPROJ, PH_INPROJ_V, PH_KT, PH_CHAIN, PH_MLAQ, PH_MLAKV, PH_GA, PH_ATTN, PH_GC, PH_MIXA, PH_GN, PH_MIXB, PH_MIX, PH_ROUTER, PH_DISPATCH, PH_GU, PH_DOWN, PH_COMBINE, NPH };
enum { I_X = 0, I_C, I_POS, I_WADA, I_BADA, I_GPREM, I_GPOSTM, I_GPREF, I_GPOSTF, I_WIN, I_QAN, I_WQB, I_KVAN, I_WKVB, I_WMLAO, I_DECF, I_DECB, I_RETGN, I_WRETO, I_WOUT, I_WROUTER, I_BROUTER, I_WGU, I_BGU, I_WDOWN, I_BDOWN };

__device__ __forceinline__ int src_in(int r) {
    if (r < 1024) return r;
    if (r < 1088) { const int j = r - 1024; return 1024 + (j >> 1) + 32 * (j & 1); }
    if (r < 1280) return -1;
    if (r < N_IN_NAT) { const int g = (r - 1280) >> 11, off = (r - 1280) & 2047; const int base = g == 0 ? 1088 : (g == 1 ? 3136 : (g == 2 ? 7232 : (g == 3 ? 9280 : 11328))); return base + off; }
    return 5184 + (r - N_IN_NAT);
}
__device__ __forceinline__ int src_qb(int r) { if (r < 1024) return (r >> 7) * 192 + (r & 127); const int j = r - 1024, h = j >> 6, jj = j & 63; return h * 192 + 128 + (jj >> 1) + 32 * (jj & 1); }
__device__ __forceinline__ int src_kvb(int r) { if (r < 1024) return (r >> 7) * 256 + (r & 127); const int j = r - 1024; return (j >> 7) * 256 + 128 + (j & 127); }
__device__ __forceinline__ int src_gu(int r) { const int t = r >> 8, rr = r & 255; return rr < 128 ? 128 * t + rr : 2048 + 128 * t + rr - 128; }

__device__ __forceinline__ void cvt_item(const float* __restrict__ W, int ldw, int K, bf16_t* __restrict__ WT, const float* __restrict__ kscale, int sc, int k0, int r0, LAS float* scr, int lane) {
    float v[64];
    const float* wp = W + (size_t)k0 * ldw + (sc >= 0 ? sc : 0);
#pragma unroll
    for (int i = 0; i < 64; ++i) v[i] = wp[(size_t)i * ldw];
    if (sc < 0) {
#pragma unroll
        for (int i = 0; i < 64; ++i) v[i] = 0.f;
    }
    if (kscale) {
#pragma unroll
        for (int i = 0; i < 64; ++i) v[i] *= kscale[k0 + i];
    }
#pragma unroll
    for (int i = 0; i < 64; ++i) scr[i * 65 + lane] = v[i];
    asm volatile("s_waitcnt lgkmcnt(0)" ::: "memory");
    const int c = lane & 7;
#pragma unroll
    for (int j = 0; j < 8; ++j) { const int n = (lane >> 3) + 8 * j; const LAS float* s = scr + (8 * c) * 65 + n;
        u32x4 o; o.x = cvt_pk_bf16(s[0 * 65], s[1 * 65]); o.y = cvt_pk_bf16(s[2 * 65], s[3 * 65]); o.z = cvt_pk_bf16(s[4 * 65], s[5 * 65]); o.w = cvt_pk_bf16(s[6 * 65], s[7 * 65]);
        *(u32x4*)(WT + (size_t)(r0 + n) * K + k0 + 8 * c) = o; }
    asm volatile("s_waitcnt lgkmcnt(0)" ::: "memory");
}

constexpr int XT_NT_GU = 32 * 16 * 16, XT_NT_ALL = XT_NT_GU + 32 * 16 * 8;
__device__ __forceinline__ void xt_convert_tiles(int q0, const int qs, const int qe, const float* __restrict__ wgu, const float* __restrict__ wdn, bf16_t* WT_GU, bf16_t* WT_DOWN, LAS unsigned char* lds, const int lane, const int wave) {
    constexpr int NT_GU = XT_NT_GU, TS = 144;
    f32x4 va[16], vb[16], vc[16];
#define XT_SRC(q_, kk_) ((q_) < NT_GU ? wgu + ((size_t)((q_) >> 8) * 2048 + (((q_) >> 4) & 15) * 128 + 16 * wave + (kk_)) * 4096 + (lane < 32 ? 128 * ((q_) & 15) + 4 * lane : 2048 + 128 * ((q_) & 15) + 4 * lane - 128) \
                                  : wdn + ((size_t)(((q_) - NT_GU) >> 7) * 2048 + ((((q_) - NT_GU) >> 3) & 15) * 128 + 16 * wave + (kk_)) * 2048 + 256 * (((q_) - NT_GU) & 7) + 4 * lane)
#define XT_LOAD(v_, q_) do { const float* _p = XT_SRC(q_, 0); const size_t _ld = (q_) < NT_GU ? 4096 : 2048; _Pragma("unroll") for (int kk = 0; kk < 16; ++kk) v_[kk] = __builtin_nontemporal_load((const f32x4*)(_p + kk * _ld)); } while (0)
#define XT_PROC(v_, q_, buf_) do { LAS unsigned char* _T = lds + (buf_) * (256 * TS); \
        _Pragma("unroll") for (int i = 0; i < 4; ++i) { u32x4 w0; \
            w0.x = pk4_fp8(v_[0][i], v_[1][i], v_[2][i], v_[3][i], W8_SCALE); w0.y = pk4_fp8(v_[4][i], v_[5][i], v_[6][i], v_[7][i], W8_SCALE); \
            w0.z = pk4_fp8(v_[8][i], v_[9][i], v_[10][i], v_[11][i], W8_SCALE); w0.w = pk4_fp8(v_[12][i], v_[13][i], v_[14][i], v_[15][i], W8_SCALE); \
            *(LAS u32x4*)(_T + (4 * lane + i) * TS + 16 * wave) = w0; } \
        __syncthreads(); \
        unsigned char* _d = (q_) < NT_GU ? (unsigned char*)WT_GU + ((size_t)((q_) >> 8) * 4096 + 256 * ((q_) & 15)) * 2048 + (((q_) >> 4) & 15) * 128 \
                 : (unsigned char*)WT_DOWN + ((size_t)(((q_) - NT_GU) >> 7) * 2048 + 256 * (((q_) - NT_GU) & 7)) * 2048 + ((((q_) - NT_GU) >> 3) & 15) * 128; \
        _Pragma("unroll") for (int j = 0; j < 4; ++j) { const int row = 32 * wave + 8 * j + (lane >> 3); \
            const u32x4 o = *(const LAS u32x4*)(_T + row * TS + (lane & 7) * 16); __builtin_nontemporal_store(o, (u32x4*)(_d + (size_t)row * 2048 + (lane & 7) * 16)); } } while (0)
    int q = q0;
    if (q < qe) XT_LOAD(va, q);
    if (q + qs < qe) XT_LOAD(vb, q + qs);
    while (q < qe) {
        const int q1 = q + qs, q2 = q1 + qs, q3 = q2 + qs, q4 = q3 + qs;
        if (q2 < qe) XT_LOAD(vc, q2);
        XT_PROC(va, q, 0);
        if (q1 >= qe) break;
        if (q3 < qe) XT_LOAD(va, q3);
        XT_PROC(vb, q1, 1);
        if (q2 >= qe) break;
        if (q4 < qe) XT_LOAD(vb, q4);
        XT_PROC(vc, q2, 2);
        q = q3;
    }
    __syncthreads();
#undef XT_SRC
#undef XT_LOAD
#undef XT_PROC
}
__host__ __device__ constexpr bool is_seam(int k) { return k == PH_SETUP || k == PH_H || k == PH_INPROJ_V || k == PH_KT || k == PH_GA || k == PH_ATTN || k == PH_MIXA || k == PH_MIXB || k == PH_MIX || k == PH_ROUTER || k == PH_DISPATCH || k == PH_GU || k == PH_DOWN; }
__host__ __device__ constexpr int seam_after(int ph) { int k = ph; while (k < NPH && !is_seam(k)) ++k; return k; }
__host__ __device__ constexpr int seam_before(int ph) { int k = ph - 1; while (k >= 0 && !is_seam(k)) --k; return k; }
__device__ __forceinline__ const void* larg(volatile LAS unsigned long long* L, int i) {
    const unsigned long long v = L[i]; const unsigned l0 = __builtin_amdgcn_readfirstlane((unsigned)v), h0 = __builtin_amdgcn_readfirstlane((unsigned)(v >> 32));
    return (const void*)(const __attribute__((address_space(1))) void*)(((unsigned long long)h0 << 32) | l0);
}
__global__ void __launch_bounds__(512, 2) fwd_kernel(Args args) {
    extern __shared__ __attribute__((aligned(16))) unsigned char lds_raw[];
    LAS unsigned char* lds = (LAS unsigned char*)lds_raw;
    volatile LAS unsigned* MISC = (volatile LAS unsigned*)(lds + MISC_OFF);
    const int tid = threadIdx.x;
    const int G = gridDim.x, bx = blockIdx.x, NGW = G * 8;
    volatile LAS unsigned long long* LARG = (volatile LAS unsigned long long*)(lds + LARG_OFF);
    const int lo = args.ph_lo, hi = args.ph_hi;
    for (int u = tid; u < (LDS_BYTES - CTRL_OFF) / 4; u += 512) ((LAS unsigned*)(lds + CTRL_OFF))[u] = 0u;
    __syncthreads();
    if (tid == 0) {
#pragma unroll
        for (int i = 0; i < 26; ++i) LARG[i] = (unsigned long long)args.in[i];
        LARG[26] = (unsigned long long)args.out; LARG[27] = (unsigned long long)args.ws;
    }
    __syncthreads();
    unsigned bar_x = 0u;
    if (hi - lo > 1) bar_x = xcd_barrier_post((unsigned*)(args.ws + WS_CTL) + CW_BAR, MISC + 8).x;
#ifdef PH_ONLY
#define IN(k) ((k) == PH_ONLY && lo <= (k) && (k) < hi)
#else
#define IN(k) (lo <= (k) && (k) < hi)
#endif
#define SEAM(k) do { if (lo <= (k) && (k) + 1 < hi) { XcdBarrier _b; _b.bar = (unsigned*)((unsigned char*)larg(LARG, 27) + WS_CTL) + CW_BAR; _b.x = bar_x; _b.st = MISC + 8; xcd_barrier(_b); } if (STAMP_PHASE >= 0) { const unsigned long long _t = __builtin_amdgcn_s_memrealtime(); if (seam_after(STAMP_PHASE) == (k)) st_dt = _t - st_t0; if (seam_before(STAMP_PHASE) == (k)) st_t0 = _t; } } while (0)
#define INP(i) ((const float*)larg(LARG, (i)))
#ifndef REP_PHASE
#define REP_PHASE (-1)
#endif
#define NREP(k) ((k) == REP_PHASE ? 2 : 1)
#ifndef STAMP_PHASE
#define STAMP_PHASE (-1)
#endif
#ifndef STAMP_MUL
#define STAMP_MUL 4
#endif
    unsigned long long st_t0 = (STAMP_PHASE >= 0 && seam_before(STAMP_PHASE) < 0) ? __builtin_amdgcn_s_memrealtime() : 0ull, st_dt = 0ull;
#define PTRS \
    int tid = threadIdx.x; asm volatile("" : "+v"(tid)); const int lane = tid & 63, wave = __builtin_amdgcn_readfirstlane(tid >> 6), gw = bx * 8 + wave; (void)lane; (void)gw; \
    unsigned char* const ws = (unsigned char*)larg(LARG, 27); unsigned* const ctl = (unsigned*)(ws + WS_CTL); float* const outp = (float*)larg(LARG, 26); \
    float* const ada = (float*)(ctl + CW_ADA); float* const SSQP = (float*)(ws + WS_SSQP); \
    bf16_t* const WT_IN = (bf16_t*)(ws + WS_WT_IN); bf16_t* const WT_QB = (bf16_t*)(ws + WS_WT_QB); bf16_t* const WT_KVB = (bf16_t*)(ws + WS_WT_KVB); bf16_t* const WT_MLAO = (bf16_t*)(ws + WS_WT_MLAO); \
    bf16_t* const WT_RETO = (bf16_t*)(ws + WS_WT_RETO); bf16_t* const WT_OUT = (bf16_t*)(ws + WS_WT_OUT); bf16_t* const WT_GU = (bf16_t*)(ws + WS_WT_GU); bf16_t* const WT_DOWN = (bf16_t*)(ws + WS_WT_DOWN); \
    float* const CS_RET = (float*)(ws + WS_CS_RET); float* const CS_MLA = (float*)(ws + WS_CS_MLA); \
    bf16_t* const Hb = (bf16_t*)(ws + WS_H); bf16_t* const QL = (bf16_t*)(ws + WS_QL); bf16_t* const CKV = (bf16_t*)(ws + WS_CKV); bf16_t* const KR = (bf16_t*)(ws + WS_KR); \
    bf16_t* const ACAT = (bf16_t*)(ws + WS_ACAT); bf16_t* const BCAT = (bf16_t*)(ws + WS_BCAT); bf16_t* const KROT = (bf16_t*)(ws + WS_KROT); bf16_t* const KZTF = (bf16_t*)(ws + WS_KZTF); bf16_t* const KZTB = (bf16_t*)(ws + WS_KZTB); \
    bf16_t* const SG = (bf16_t*)(ws + WS_SG); bf16_t* const GA = (bf16_t*)(ws + WS_GA); bf16_t* const GB = (bf16_t*)(ws + WS_GB); \
    bf16_t* const QN = (bf16_t*)(ws + WS_QN); bf16_t* const QR = (bf16_t*)(ws + WS_QR); bf16_t* const KN = (bf16_t*)(ws + WS_KN); bf16_t* const VV = (bf16_t*)(ws + WS_VV); bf16_t* const OA = (bf16_t*)(ws + WS_OA); \
    float* const ORET = (float*)(ws + WS_ORET); bf16_t* const OB = (bf16_t*)(ws + WS_OB); bf16_t* const MIXP = (bf16_t*)(ws + WS_MIXP); bf16_t* const MIXIN = (bf16_t*)(ws + WS_MIXIN); float* const MIX = (float*)(ws + WS_MIX); \
    bf16_t* const H2 = (bf16_t*)(ws + WS_H2); int* const TOPI = (int*)(ws + WS_TOPI); float* const TOPW = (float*)(ws + WS_TOPW); int* const DEST = (int*)(ws + WS_DEST); int* const TILE = (int*)(ws + WS_TILE); float* const DECTAB = (float*)(ws + WS_DECTAB); \
    bf16_t* const XS = (bf16_t*)(ws + WS_XS); bf16_t* const ACT = (bf16_t*)(ws + WS_ACT); bf16_t* const YS = (bf16_t*)(ws + WS_YS); \
    (void)ctl; (void)outp; (void)ada; (void)SSQP; (void)WT_IN; (void)WT_QB; (void)WT_KVB; (void)WT_MLAO; (void)WT_RETO; (void)WT_OUT; (void)WT_GU; (void)WT_DOWN; (void)CS_RET; (void)CS_MLA; (void)Hb; (void)QL; (void)CKV; (void)KR; \
    (void)ACAT; (void)BCAT; (void)KROT; (void)KZTF; (void)KZTB; (void)SG; (void)GA; (void)GB; (void)QN; (void)QR; (void)KN; (void)VV; (void)OA; (void)ORET; (void)OB; (void)MIXP; (void)MIXIN; (void)MIX; (void)H2; (void)TOPI; (void)TOPW; (void)DEST; (void)TILE; (void)DECTAB; (void)XS; (void)ACT; (void)YS;

    if (IN(PH_SETUP)) for (int rep = 0; rep < NREP(PH_SETUP); ++rep) {
        PTRS
        if (bx == 0 && tid < 16) DECTAB[tid] = log2_sigmoid(tid < 8 ? INP(I_DECF)[tid] : INP(I_DECB)[tid - 8]);
        {
            const float* wada = INP(I_WADA); const float* cvec = INP(I_C); float* adap = (float*)(ws + WS_ADAP);
            for (int it = gw; it < 192 * 8; it += NGW) {
                const int jb = it % 192, kp = it / 192, j = jb * 64 + lane;
                float a0 = 0.f, a1 = 0.f, a2 = 0.f, a3 = 0.f;
#pragma nounroll
                for (int k0 = kp * 256; k0 < kp * 256 + 256; k0 += 32) {
                    float w[32]; const float* wp = wada + (size_t)k0 * 12288 + j;
#pragma unroll
                    for (int i = 0; i < 32; ++i) { w[i] = __builtin_nontemporal_load(wp); wp += 12288; asm volatile("" : "+v"(wp)); }
#pragma unroll
                    for (int i = 0; i < 32; ++i) { a0 += w[i] * cvec[k0 + i]; a1 += w[i] * cvec[2048 + k0 + i]; a2 += w[i] * cvec[4096 + k0 + i]; a3 += w[i] * cvec[6144 + k0 + i]; }
                }
                float* o = adap + (size_t)kp * 49152 + j;
                o[0] = a0; o[12288] = a1; o[24576] = a2; o[36864] = a3;
            }
        }
        {
            const int* pos = (const int*)INP(I_POS);
            for (int i = bx * 512 + tid; i < T * 160; i += G * 512) {
                const int tok = i / 160, f = i % 160; const float p = (float)pos[tok];
                float inv; float* dst;
                if (f < 128) { inv = 1.0f / powf(10000.0f, (float)f / 128.0f); dst = CS_RET + (size_t)tok * 256 + f * 2; }
                else { inv = 1.0f / powf(10000.0f, (float)(f - 128) / 32.0f); dst = CS_MLA + (size_t)tok * 64 + (f - 128) * 2; }
                float s, c; sincosf(p * inv, &s, &c); dst[0] = c; dst[1] = s;
            }
        }
        {
            LAS float* scr = (LAS float*)(lds + wave * 16640);
            constexpr int I_IN = (N_IN_ALL / 64) * 32, I_QB = 24 * 8, I_KVB = 32 * 8, I_MLAO = 32 * 16, I_SQ = 32 * 32;
            constexpr int NITEMS = I_IN + I_QB + I_KVB + I_MLAO + 2 * I_SQ;
            unsigned* cq = ctl + CW_CVTQ + rep;
#define CVT_GRAB(dst) do { unsigned _v = 0u; if (lane == 0) _v = atomicAdd(cq, 8u); dst = (int)__builtin_amdgcn_readfirstlane(_v); } while (0)
#define CVT_DEC(r_, wp_, dst_, ks_, ldw_, K_, sc_) do { int r = (r_); const float* W_; bf16_t* WT_; const float* kq_ = nullptr; int nkb_, mat_; \
                if (r < I_IN) { W_ = INP(I_WIN); WT_ = WT_IN; ldw_ = 13376; K_ = 2048; nkb_ = 32; mat_ = 2; } \
                else if ((r -= I_IN) < I_QB) { W_ = INP(I_WQB); WT_ = WT_QB; kq_ = INP(I_QAN); ldw_ = 1536; K_ = 512; nkb_ = 8; mat_ = 3; } \
                else if ((r -= I_QB) < I_KVB) { W_ = INP(I_WKVB); WT_ = WT_KVB; kq_ = INP(I_KVAN); ldw_ = 2048; K_ = 512; nkb_ = 8; mat_ = 4; } \
                else if ((r -= I_KVB) < I_MLAO) { W_ = INP(I_WMLAO); WT_ = WT_MLAO; ldw_ = 2048; K_ = 1024; nkb_ = 16; mat_ = 1; } \
                else if ((r -= I_MLAO) < I_SQ) { W_ = INP(I_WRETO); WT_ = WT_RETO; ldw_ = 2048; K_ = 2048; nkb_ = 32; mat_ = 1; } \
                else { r -= I_SQ; W_ = INP(I_WOUT); WT_ = WT_OUT; ldw_ = 2048; K_ = 2048; nkb_ = 32; mat_ = 1; } \
                const int q4_ = r >> 2, kb_ = q4_ % nkb_, nb_ = (q4_ / nkb_) * 4 + (r & 3), rr_ = nb_ * 64 + lane; \
                sc_ = (mat_ == 1 ? rr_ : (mat_ == 2 ? src_in(rr_) : (mat_ == 3 ? src_qb(rr_) : src_kvb(rr_)))); \
                wp_ = W_ + (size_t)(kb_ * 64) * ldw_ + (sc_ >= 0 ? sc_ : 0); dst_ = WT_ + (size_t)(nb_ * 64) * K_ + kb_ * 64; ks_ = kq_ ? kq_ + kb_ * 64 : nullptr; \
                if (mat_ == 2 && nb_ >= 84 && nb_ < 180) { K_ = -1; dst_ = (bf16_t*)(ws + WS_WT8IN + (size_t)((nb_ - 84) * 64) * 2048 + kb_ * 64); } } while (0)
            float v[64];
            const float* wpc; bf16_t* dstc; const float* ksc; int ldwc, Kc, scc;
            const float* wpn = nullptr; bf16_t* dstn = nullptr; const float* ksn = nullptr; int ldwn = 0, Kn = 0, scn = 0;
            constexpr int QCH = 8; static_assert(NITEMS % QCH == 0, "queue chunk");
            int itc, itn, cend; CVT_GRAB(itc); itn = itc + 1; cend = itc + QCH;
            bool hc = itc < NITEMS;
            if (hc) { CVT_DEC(itc, wpc, dstc, ksc, ldwc, Kc, scc);
#pragma unroll
                for (int i = 0; i < 64; ++i) v[i] = __builtin_nontemporal_load(wpc + (size_t)i * ldwc); }
            while (hc) {
                const bool hn = itn < NITEMS;
                if (hn) CVT_DEC(itn, wpn, dstn, ksn, ldwn, Kn, scn);
                const bool need = (itn + 1 >= cend); unsigned raw_nn = 0u; if (need && lane == 0) raw_nn = atomicAdd(cq, (unsigned)QCH);
#pragma unroll
                for (int g = 0; g < 4; ++g) {
#pragma unroll
                    for (int i = 0; i < 16; ++i) { float x = scc >= 0 ? v[16 * g + i] : 0.f; if (ksc) x *= ksc[16 * g + i]; scr[(16 * g + i) * 65 + lane] = x; }
                    if (hn) {
#pragma unroll
                        for (int i = 0; i < 16; ++i) v[16 * g + i] = __builtin_nontemporal_load(wpn + (size_t)(16 * g + i) * ldwn); }
                }
                asm volatile("s_waitcnt lgkmcnt(0)" ::: "memory");
                const int c = lane & 7;
#pragma unroll
                for (int j = 0; j < 8; ++j) { const int n = (lane >> 3) + 8 * j; const LAS float* sp = scr + (8 * c) * 65 + n;
                    if (Kc < 0) { u32x2 o8; o8.x = pk4_fp8(sp[0 * 65], sp[1 * 65], sp[2 * 65], sp[3 * 65], W8_SCALE); o8.y = pk4_fp8(sp[4 * 65], sp[5 * 65], sp[6 * 65], sp[7 * 65], W8_SCALE);
                        *(u32x2*)((unsigned char*)dstc + (size_t)n * 2048 + 8 * c) = o8; }
                    else { u32x4 o; o.x = cvt_pk_bf16(sp[0 * 65], sp[1 * 65]); o.y = cvt_pk_bf16(sp[2 * 65], sp[3 * 65]); o.z = cvt_pk_bf16(sp[4 * 65], sp[5 * 65]); o.w = cvt_pk_bf16(sp[6 * 65], sp[7 * 65]);
                        __builtin_nontemporal_store(o, (u32x4*)(dstc + (size_t)n * Kc + 8 * c)); } }
                asm volatile("s_waitcnt lgkmcnt(0)" ::: "memory");
                wpc = wpn; dstc = dstn; ksc = ksn; ldwc = ldwn; Kc = Kn; scc = scn; hc = hn;
                if (need) { itn = (int)__builtin_amdgcn_readfirstlane(raw_nn); cend = itn + QCH; } else itn = itn + 1;
            }
#undef CVT_GRAB
#undef CVT_DEC
        }
    }
    SEAM(PH_SETUP);
    if (IN(PH_H)) for (int rep = 0; rep < NREP(PH_H); ++rep) {
        PTRS
        const float* g = INP(I_GPREM);
        {
            const float* adap = (const float*)(ws + WS_ADAP); const float* bada = INP(I_BADA); LAS float* AD = (LAS float*)lds;
            if (tid < 192) { const int idx = bx * 192 + tid; if (idx < 49152) { const int j = idx % 12288; float a = 0.f;
#pragma unroll
                for (int pq = 0; pq < 8; ++pq) a += adap[(size_t)pq * 49152 + idx];
                ada[idx] = a + bada[j]; } }
            for (int i = tid; i < 16384; i += 512) { const int b = i >> 12, col = i & 4095; float a = 0.f;
#pragma unroll
                for (int pq = 0; pq < 8; ++pq) a += adap[(size_t)pq * 49152 + b * 12288 + col];
                AD[i] = a + bada[col]; }
            __syncthreads();
        }
        const LAS float* AD = (const LAS float*)lds;
        f32x4 vn[8];
        if (gw < T) { const f32x4* xr = (const f32x4*)(INP(I_X) + (size_t)gw * D) + lane;
#pragma unroll
            for (int j = 0; j < 8; ++j) vn[j] = xr[64 * j]; }
        for (int mrow = gw; mrow < T; mrow += NGW) {
            const int b = mrow / SEQ;
            f32x4 v[8]; float s = 0.f;
#pragma unroll
            for (int j = 0; j < 8; ++j) { v[j] = vn[j]; s += (v[j][0] * v[j][0] + v[j][1] * v[j][1]) + (v[j][2] * v[j][2] + v[j][3] * v[j][3]); }
            if (mrow + NGW < T) { const f32x4* xr = (const f32x4*)(INP(I_X) + (size_t)(mrow + NGW) * D) + lane;
#pragma unroll
                for (int j = 0; j < 8; ++j) vn[j] = xr[64 * j]; }
            const float r = rsqrtf(wave_sum(s) * (1.0f / D) + RMS_EPS);
            u32x2* o8 = (u32x2*)(Hb + (size_t)mrow * D) + lane; unsigned* q8 = (unsigned*)(ws + WS_H8 + (size_t)mrow * D) + lane;
#pragma unroll
            for (int j = 0; j < 8; ++j) { const int col = 256 * j + 4 * lane; const f32x4 gg = *(const f32x4*)(g + col), sh = *(const LAS f32x4*)(AD + b * 4096 + col), sc = *(const LAS f32x4*)(AD + b * 4096 + 2048 + col);
                const f32x4 y = v[j] * r * gg * (sc + 1.0f) + sh; u32x2 w; w.x = cvt_pk_bf16(y[0], y[1]); w.y = cvt_pk_bf16(y[2], y[3]); o8[64 * j] = w; q8[64 * j] = pk4_fp8(y[0], y[1], y[2], y[3], H8_SCALE); }
        }
    }
    SEAM(PH_H);
    if (IN(PH_INPROJ)) for (int rep = 0; rep < NREP(PH_INPROJ); ++rep) {
        PTRS
        {   pg8::InprojSched S{(const char*)Hb, (const char*)WT_IN, G, bx};
            EpiInprojAll E{EpiInproj{QL, CKV, KR, ACAT, KROT, SG, GA, GB, SSQP, CS_RET, CS_MLA, DECTAB, 0, 1.0f}, EpiVT{BCAT, ws + WS_VT8}};
            pg8::gemm_phase(lds, 2048, 2048, 2048, S, E); }
        {
            pg8::GridSched S{(const char*)(ws + WS_H8), (const char*)(ws + WS_WT8IN), (size_t)256 * 2048, (size_t)256 * 2048, T / 256, 24, G, bx};
            EpiInproj E{QL, CKV, KR, ACAT, KROT, SG, GA, GB, SSQP, CS_RET, CS_MLA, DECTAB, 21, GU_UNSCALE};
            pg8::gemm_phase<EpiInproj, pg8::GridSched, true>(lds, 2048, 2048, 2048, S, E); }
    }
    SEAM(PH_INPROJ_V);
    if (IN(PH_KT)) for (int rep = 0; rep < NREP(PH_KT); ++rep) {
        PTRS
        {
            constexpr int TP = 528;
            u32x4 ra[16], rb[16];
#define KT_LOAD(r_, blk_) do { const bf16_t* _s = KROT + ((size_t)(blk_) * 256 + 32 * wave + 16 * (lane >> 5)) * 256 + 8 * (lane & 31); _Pragma("unroll") for (int i = 0; i < 16; ++i) r_[i] = *(const u32x4*)(_s + i * 256); } while (0)
#define KT_PROC(r_, blk_) do { const int _h = ((blk_) >> 4) & 7; const float _lf = DECTAB[_h], _lb = DECTAB[8 + _h]; \
                _Pragma("unroll") for (int e = 0; e < 8; ++e) { u32x4 w0, w1; \
                    _Pragma("unroll") for (int i2 = 0; i2 < 4; ++i2) { const unsigned a0 = r_[2 * i2][e >> 1], a1 = r_[2 * i2 + 1][e >> 1], c0 = r_[8 + 2 * i2][e >> 1], c1 = r_[8 + 2 * i2 + 1][e >> 1]; \
                        w0[i2] = (e & 1) ? ((a0 >> 16) | (a1 & 0xffff0000u)) : ((a0 & 0xffffu) | (a1 << 16)); w1[i2] = (e & 1) ? ((c0 >> 16) | (c1 & 0xffff0000u)) : ((c0 & 0xffffu) | (c1 << 16)); } \
                    LAS unsigned char* _t = lds + (8 * (lane & 31) + e) * TP + (32 * wave + 16 * (lane >> 5)) * 2; *(LAS u32x4*)_t = w0; *(LAS u32x4*)(_t + 16) = w1; } \
                __syncthreads(); \
                f32x4 zf0, zf1, zb0, zb1; \
                _Pragma("unroll") for (int t = 0; t < 4; ++t) { const int p0 = 8 * (lane & 31) + t, p1 = p0 + 4; \
                    zf0[t] = __builtin_amdgcn_exp2f((float)(255 - p0) * _lf); zf1[t] = __builtin_amdgcn_exp2f((float)(255 - p1) * _lf); zb0[t] = __builtin_amdgcn_exp2f((float)p0 * _lb); zb1[t] = __builtin_amdgcn_exp2f((float)p1 * _lb); } \
                _Pragma("unroll") for (int j = 0; j < 16; ++j) { const int row = 32 * wave + 2 * j + (lane >> 5); \
                    const u32x4 w = *(const LAS u32x4*)(lds + row * TP + (lane & 31) * 16); f32x4 x0, x1; unpack8(w, x0, x1); \
                    const size_t o = ((size_t)(blk_) * 256 + row) * 256 + 8 * (lane & 31); \
                    const f32x4 f0 = x0 * zf0, f1 = x1 * zf1, g0 = x0 * zb0, g1 = x1 * zb1; u32x2 wf, wb; \
                    wf.x = pk4_fp8(f0[0], f0[1], f0[2], f0[3], K8_SCALE); wf.y = pk4_fp8(f1[0], f1[1], f1[2], f1[3], K8_SCALE); wb.x = pk4_fp8(g0[0], g0[1], g0[2], g0[3], K8_SCALE); wb.y = pk4_fp8(g1[0], g1[1], g1[2], g1[3], K8_SCALE); \
                    *(u32x2*)((unsigned char*)KZTF + o) = wf; *(u32x2*)((unsigned char*)KZTB + o) = wb; } \
                __syncthreads(); } while (0)
            int blk = bx;
            if (blk < NBLK) KT_LOAD(ra, blk);
            while (blk < NBLK) {
                const int b1 = blk + G; if (b1 < NBLK) KT_LOAD(rb, b1);
                KT_PROC(ra, blk);
                if (b1 >= NBLK) break;
                const int b2 = b1 + G; if (b2 < NBLK) KT_LOAD(ra, b2);
                KT_PROC(rb, b1);
                blk = b2;
            }
#undef KT_LOAD
#undef KT_PROC
        }
    }
    SEAM(PH_KT);
    if (IN(PH_CHAIN)) for (int rep = 0; rep < NREP(PH_CHAIN); ++rep) {
        PTRS
        if (bx < 64) {
            const int bh = bx >> 1, dir = bx & 1;
            {
                const int blk0 = bh * NCH + (dir ? NCH - 1 : 0);
                bf16_t* z = BCAT + ((size_t)blk0 * 256 + (tid >> 1)) * 768 + 256 + 256 * dir + (tid & 1) * 128;
#pragma unroll
                for (int q = 0; q < 16; ++q) *(u32x4*)(z + q * 8) = (u32x4){0u, 0u, 0u, 0u};
            }
            pg8::ChainSched S{(const char*)(ws + WS_VT8), (const char*)(dir ? KZTB : KZTF), bh, dir};
            EpiGb E{BCAT, DECTAB, dir};
            pg8::gemm_phase<EpiGb, pg8::ChainSched, true, true>(lds, 256, 256, 256, S, E);
        }
    }
    if (IN(PH_MLAQ)) for (int rep = 0; rep < NREP(PH_MLAQ); ++rep) {
        PTRS
        if (bx >= 64) { const bool ca = bx < 128;
            pg8::GridSchedR S{(const char*)QL, (const char*)WT_QB, (size_t)256 * 512 * 2, (size_t)256 * 512 * 2, T / 256, 6, ca ? 64 : 128, ca ? bx - 64 : bx - 128, ca ? 0 : 128, ca ? 128 : 384};
            EpiMlaQ E{QN, QR, SSQP, CS_MLA}; pg8::gemm_phase(lds, 512, 512, 512, S, E); }
    }
    if (IN(PH_MLAKV)) for (int rep = 0; rep < NREP(PH_MLAKV); ++rep) {
        PTRS
        if (bx >= 128) {
            pg8::GridSchedR S{(const char*)CKV, (const char*)WT_KVB, (size_t)256 * 512 * 2, (size_t)256 * 512 * 2, T / 256, 8, 128, bx - 128, 0, 512};
            EpiMlaKV E{KN, VV, SSQP + (size_t)8 * T}; pg8::gemm_phase(lds, 512, 512, 512, S, E); }
    }
    if (IN(PH_GA)) for (int rep = 0; rep < NREP(PH_GA); ++rep) {
        PTRS
        if (bx >= 64) { const bool ca = bx < 128;
        {   pg8::BatchSchedR S{(const char*)(ACAT + 256), (const char*)KROT, (size_t)256 * 768 * 2, (size_t)256 * 256 * 2, ca ? 64 : 128, ca ? bx - 64 : bx - 128, ca ? 0 : 256, ca ? 256 : 512};
            EpiGa E{ACAT, DECTAB}; pg8::gemm_phase(lds, 256, 768, 256, S, E); }
        if (ca) {
            pg8::GridSchedR S{(const char*)Hb, (const char*)(WT_IN + (size_t)4 * 256 * 2048), (size_t)256 * 2048 * 2, (size_t)256 * 2048 * 2, T / 256, 1, 64, bx - 64, 0, 64};
            EpiInproj E{QL, CKV, KR, ACAT, KROT, SG, GA, GB, SSQP, CS_RET, CS_MLA, DECTAB, 4, 1.0f}; pg8::gemm_phase(lds, 2048, 2048, 2048, S, E); }
        }
    }
    SEAM(PH_GA);
    if (IN(PH_ATTN)) for (int rep = 0; rep < NREP(PH_ATTN); ++rep) {
        PTRS
        unsigned* queue = ctl + CW_QUEUE + rep; unsigned* cqueue = ctl + CW_QUEUE + 8;
        const float* wgu = INP(I_WGU); const float* wdn = INP(I_WDOWN);
#define CONV_LOOP() do { if (rep == 0) for (;;) { __syncthreads(); if (tid == 0) MISC[1] = atomicAdd(cqueue, 1u); __syncthreads(); const int c = (int)MISC[1]; if (c >= 768) break; \
            xt_convert_tiles(c * 16, 1, c * 16 + 16, wgu, wdn, WT_GU, WT_DOWN, lds, lane, wave); } } while (0)
        if (bx < CONV_WGS) CONV_LOOP();
        int xq = (int)(xb_xcc_id() & 7u), tries = 0;
        for (;;) {
            __syncthreads();
            if (tid == 0) { int a = -1;
                while (tries < 8) { const unsigned v = atomicAdd(ctl + CW_AQ + 64 * xq + rep, 1u); if (v < 64u) { a = xq * 64 + (int)v; break; } xq = (xq + 1) & 7; ++tries; }
                MISC[0] = (unsigned)a; }
            __syncthreads();
            const int a = (int)MISC[0];
            if (a < 0) break;
            const int bh = a >> 4, qb = a & 15, b = bh >> 3, h = bh & 7;
            const size_t tok0 = (size_t)b * SEQ + qb * 256, kt0 = (size_t)b * SEQ;
            att::attn_unit(QN + tok0 * 1024 + h * 128, QR + tok0 * 512 + h * 64, KN + kt0 * 1024 + h * 128, KR + kt0 * 64, VV + kt0 * 1024 + h * 128, OA + tok0 * 1024 + h * 128, SEQ, (char*)lds_raw);
        }
        if (bx >= CONV_WGS) CONV_LOOP();
#undef CONV_LOOP
    }
    SEAM(PH_ATTN);
    if (IN(PH_GC)) for (int rep = 0; rep < NREP(PH_GC); ++rep) {
        PTRS
        {   pg8::BatchSched S{(const char*)ACAT, (const char*)BCAT, (size_t)256 * 768 * 2, (size_t)256 * 768 * 2, NBLK, G, bx};
            EpiGc E{OB, SG, INP(I_RETGN), lds}; pg8::gemm_phase(lds, 768, 768, 768, S, E); }
    }
    if (IN(PH_MIXA)) for (int rep = 0; rep < NREP(PH_MIXA); ++rep) {
        PTRS
        {   pg8::GridSched S{(const char*)OA, (const char*)WT_MLAO, (size_t)256 * 1024 * 2, (size_t)256 * 1024 * 2, T / 256, 8, G, bx};
            EpiMixA E{MIXP, GA}; pg8::gemm_phase(lds, 1024, 1024, 1024, S, E); }
    }
    SEAM(PH_MIXA);
    if (IN(PH_MIXB)) for (int rep = 0; rep < NREP(PH_MIXB); ++rep) {
        PTRS
        pg8::GridSched S{(const char*)OB, (const char*)WT_RETO, (size_t)256 * 2048 * 2, (size_t)256 * 2048 * 2, T / 256, 8, G, bx};
        EpiMixB E{MIXIN, MIXP, GB}; pg8::gemm_phase(lds, 2048, 2048, 2048, S, E);
    }
    SEAM(PH_MIXB);
    if (IN(PH_MIX)) for (int rep = 0; rep < NREP(PH_MIX); ++rep) {
        PTRS
        pg8::GridSched S{(const char*)MIXIN, (const char*)WT_OUT, (size_t)256 * 2048 * 2, (size_t)256 * 2048 * 2, T / 256, 8, G, bx};
        EpiF32 E{(bf16_t*)MIX}; pg8::gemm_phase(lds, 2048, 2048, 2048, S, E);
    }
    SEAM(PH_MIX);
    if (IN(PH_ROUTER)) for (int rep = 0; rep < NREP(PH_ROUTER); ++rep) {
        PTRS
        const float* gpm = INP(I_GPOSTM); const float* gpf = INP(I_GPREF); const float* wr = INP(I_WROUTER); const float* brt = INP(I_BROUTER);
        LAS float* HROW = (LAS float*)lds;
        LAS float* PART = (LAS float*)(lds + 16 * 2052 * 4);
        unsigned* counts = ctl + CW_COUNTS;
        volatile LAS unsigned* lhist = MISC + 64;
        if (tid < 32) lhist[tid] = 0u;
        __syncthreads();
        const float* wbp = wr + (size_t)(256 * wave + (lane >> 4)) * 32 + (lane & 15);
        f32x4 vA[8], vB[8], xA[8], xB[8];
#define RT_LOAD(base_) do { const int _m = (base_) + 2 * wave; const u32x2* _mr = (const u32x2*)((const bf16_t*)MIX + (size_t)_m * D) + lane; const f32x4* _xr = (const f32x4*)(INP(I_X) + (size_t)_m * D) + lane; \
            _Pragma("unroll") for (int j = 0; j < 8; ++j) { const u32x2 _a = _mr[64 * j], _b = _mr[64 * j + 512]; vA[j] = (f32x4){bf_lo(_a.x), bf_hi(_a.x), bf_lo(_a.y), bf_hi(_a.y)}; vB[j] = (f32x4){bf_lo(_b.x), bf_hi(_b.x), bf_lo(_b.y), bf_hi(_b.y)}; \
                xA[j] = _xr[64 * j]; xB[j] = _xr[64 * j + 512]; } } while (0)
        if (bx * 16 < T) RT_LOAD(bx * 16);
        for (int base = bx * 16; base < T; base += G * 16) {
            {
                const int rrA = 2 * wave, mrowA = base + rrA;
                const int b = mrowA / SEQ; const float* ad = ada + b * 12288;
                float sA = 0.f, sB = 0.f;
#pragma unroll
                for (int j = 0; j < 8; ++j) { sA += (vA[j][0] * vA[j][0] + vA[j][1] * vA[j][1]) + (vA[j][2] * vA[j][2] + vA[j][3] * vA[j][3]); sB += (vB[j][0] * vB[j][0] + vB[j][1] * vB[j][1]) + (vB[j][2] * vB[j][2] + vB[j][3] * vB[j][3]); }
#pragma unroll
                for (int o = 1; o < 64; o <<= 1) { sA += __shfl_xor(sA, o); sB += __shfl_xor(sB, o); }
                const float r1A = rsqrtf(sA * (1.0f / D) + RMS_EPS), r1B = rsqrtf(sB * (1.0f / D) + RMS_EPS); float tA = 0.f, tB = 0.f;
                u32x2* o4 = (u32x2*)((bf16_t*)(ws + WS_X1B) + (size_t)mrowA * D) + lane;
#pragma unroll
                for (int j = 0; j < 8; ++j) { const int col = 256 * j + 4 * lane; const f32x4 gg = *(const f32x4*)(gpm + col), gm = *(const f32x4*)(ad + 4096 + col);
                    vA[j] = xA[j] + gm * (vA[j] * r1A * gg); vB[j] = xB[j] + gm * (vB[j] * r1B * gg);
                    { u32x2 wa, wb; wa.x = cvt_pk_bf16(vA[j][0], vA[j][1]); wa.y = cvt_pk_bf16(vA[j][2], vA[j][3]); wb.x = cvt_pk_bf16(vB[j][0], vB[j][1]); wb.y = cvt_pk_bf16(vB[j][2], vB[j][3]); o4[64 * j] = wa; o4[64 * j + 512] = wb; }
                    tA += (vA[j][0] * vA[j][0] + vA[j][1] * vA[j][1]) + (vA[j][2] * vA[j][2] + vA[j][3] * vA[j][3]); tB += (vB[j][0] * vB[j][0] + vB[j][1] * vB[j][1]) + (vB[j][2] * vB[j][2] + vB[j][3] * vB[j][3]); asm volatile("" ::: "memory"); }
#pragma unroll
                for (int o = 1; o < 64; o <<= 1) { tA += __shfl_xor(tA, o); tB += __shfl_xor(tB, o); }
                const float r2A = rsqrtf(tA * (1.0f / D) + RMS_EPS), r2B = rsqrtf(tB * (1.0f / D) + RMS_EPS);
                unsigned* h8 = (unsigned*)((unsigned char*)H2 + (size_t)mrowA * D) + lane;
#pragma unroll
                for (int j = 0; j < 8; ++j) { const int col = 256 * j + 4 * lane; const f32x4 gg = *(const f32x4*)(gpf + col), sh = *(const f32x4*)(ad + 6144 + col), sc = *(const f32x4*)(ad + 8192 + col);
                    const f32x4 hA = vA[j] * r2A * gg * (sc + 1.0f) + sh, hB = vB[j] * r2B * gg * (sc + 1.0f) + sh;
                    h8[64 * j] = pk4_fp8(hA[0], hA[1], hA[2], hA[3], H8_SCALE); h8[64 * j + 512] = pk4_fp8(hB[0], hB[1], hB[2], hB[3], H8_SCALE);
                    *(LAS f32x4*)(HROW + rrA * 2052 + col) = hA; *(LAS f32x4*)(HROW + (rrA + 1) * 2052 + col) = hB; asm volatile("" ::: "memory"); }
                if (base + G * 16 < T) RT_LOAD(base + G * 16);
            }
            __syncthreads();
            {   f32x4 c0 = (f32x4){0.f, 0.f, 0.f, 0.f}, c1 = (f32x4){0.f, 0.f, 0.f, 0.f};
                const LAS float* ap = HROW + (lane & 15) * 2052 + 256 * wave + (lane >> 4);
#pragma unroll 16
                for (int st = 0; st < 64; ++st) { const float a = ap[4 * st]; c0 = __builtin_amdgcn_mfma_f32_16x16x4f32(a, wbp[st * 128], c0, 0, 0, 0); c1 = __builtin_amdgcn_mfma_f32_16x16x4f32(a, wbp[st * 128 + 16], c1, 0, 0, 0); }
                LAS float* pp = PART + wave * 512 + (4 * (lane >> 4)) * 32 + (lane & 15);
#pragma unroll
                for (int r = 0; r < 4; ++r) { pp[r * 32] = c0[r]; pp[r * 32 + 16] = c1[r]; }
            }
            __syncthreads();
#pragma nounroll
            for (int q = 0; q < 2; ++q) {
                const int rr = 2 * wave + q, mrow = base + rr;
                float lg = 0.f;
                if (lane < 32) {
#pragma unroll
                    for (int w2 = 0; w2 < 8; ++w2) lg += PART[w2 * 512 + rr * 32 + lane];
                    lg += brt[lane]; }
                float val = lane < 32 ? lg : -3.0e38f; float tv[4]; int ti[4];
#pragma unroll
                for (int r = 0; r < 4; ++r) { float bv = val; int bi = lane;
#pragma unroll
                    for (int o = 32; o >= 1; o >>= 1) { const float ov = __shfl_xor(bv, o); const int oi = __shfl_xor(bi, o); if (ov > bv || (ov == bv && oi < bi)) { bv = ov; bi = oi; } }
                    tv[r] = bv; ti[r] = bi; if (lane == bi) val = -3.0e38f; }
                const float e1 = __expf(tv[1] - tv[0]), e2 = __expf(tv[2] - tv[0]), e3 = __expf(tv[3] - tv[0]); const float inv = 1.0f / (1.0f + e1 + e2 + e3);
                if (lane < 4) { const int id = lane == 0 ? ti[0] : (lane == 1 ? ti[1] : (lane == 2 ? ti[2] : ti[3])); const float wv = (lane == 0 ? 1.0f : (lane == 1 ? e1 : (lane == 2 ? e2 : e3))) * inv;
                    TOPI[mrow * 4 + lane] = id; TOPW[mrow * 4 + lane] = wv; if (rep == 0) __hip_atomic_fetch_add((LAS unsigned*)(lhist + id), 1u, __ATOMIC_RELAXED, __HIP_MEMORY_SCOPE_WORKGROUP); }
            }
            __syncthreads();
        }
        if (tid < 32 && rep == 0) { const unsigned c = lhist[tid]; if (c) atomicAdd(counts + 64 * tid, c); }
    }
    SEAM(PH_ROUTER);
    if (IN(PH_DISPATCH)) for (int rep = 0; rep < NREP(PH_DISPATCH); ++rep) {
        PTRS
        unsigned* counts = ctl + CW_COUNTS; unsigned* cursor = ctl + CW_CURSOR;
        volatile LAS unsigned* lhist = MISC + 64; volatile LAS unsigned* lbase = MISC + 96;
        if (tid < 32) lhist[tid] = 0u;
        int pst = 0, pend = 0;
        { const int cnt = lane < 32 ? (int)__hip_atomic_load(counts + 64 * lane, __ATOMIC_RELAXED, __HIP_MEMORY_SCOPE_AGENT) : 0; const int pad = (cnt + 255) & ~255; int inc = pad;
#pragma unroll
          for (int o = 1; o < 32; o <<= 1) { const int t = __shfl_up(inc, o); if ((lane & 31) >= o) inc += t; }
          pend = inc; pst = inc - pad; }
        if (gw == 0) {
            const int ntiles = __shfl(pend, 31) >> 8; if (lane == 0) TILE[0] = ntiles;
            for (int t = lane; t < PMAX / 256; t += 64) { int e = 0;
                for (int q = 0; q < 32; ++q) { const int pe = __shfl(pend, q); e += (pe <= t * 256) ? 1 : 0; }
                TILE[16 + t] = e < 31 ? e : 31; }
        }
        __syncthreads();
        int eid[8], loc[8];
#pragma unroll
        for (int i = 0; i < 8; ++i) { const int mrow = gw + NGW * i; eid[i] = 0; loc[i] = 0;
            if (mrow < T && lane < 4) { eid[i] = TOPI[mrow * 4 + lane]; loc[i] = (int)__hip_atomic_fetch_add((LAS unsigned*)(lhist + eid[i]), 1u, __ATOMIC_RELAXED, __HIP_MEMORY_SCOPE_WORKGROUP); } }
        __syncthreads();
        if (tid < 32) { const unsigned c = lhist[tid]; lbase[tid] = (unsigned)pst + (c ? atomicAdd(cursor + 64 * tid, c) : 0u); }
        __syncthreads();
#pragma unroll
        for (int i = 0; i < 8; ++i) { const int mrow = gw + NGW * i;
            if (mrow < T) {
                int slot = 0;
                if (lane < 4) { slot = (int)lbase[eid[i]] + loc[i]; DEST[mrow * 4 + lane] = slot; }
                const u32x4* src = (const u32x4*)((const unsigned char*)H2 + (size_t)mrow * D) + lane; u32x4 rw[2];
#pragma unroll
                for (int q = 0; q < 2; ++q) rw[q] = src[64 * q];
#pragma unroll
                for (int k = 0; k < 4; ++k) { const int sl = __shfl(slot, k); u32x4* dst = (u32x4*)((unsigned char*)XS + (size_t)sl * D) + lane;
#pragma unroll
                    for (int q = 0; q < 2; ++q) dst[64 * q] = rw[q]; } } }
    }
    SEAM(PH_DISPATCH);
    if (IN(PH_GU)) for (int rep = 0; rep < NREP(PH_GU); ++rep) {
        PTRS
        const int ntiles = __builtin_amdgcn_readfirstlane(TILE[0]);
        pg8::MoeSched S{(const char*)XS, (const char*)WT_GU, TILE + 16, ntiles, 16, G, bx};
        EpiGU E{ACT, INP(I_BGU), rep}; pg8::gemm_phase<EpiGU, pg8::MoeSched, true>(lds, 2048, 2048, 2048, S, E);
    }
    SEAM(PH_GU);
    if (IN(PH_DOWN)) for (int rep = 0; rep < NREP(PH_DOWN); ++rep) {
        PTRS
        const int ntiles = __builtin_amdgcn_readfirstlane(TILE[0]);
        pg8::MoeSched S{(const char*)ACT, (const char*)WT_DOWN, TILE + 16, ntiles, 8, G, bx};
        EpiDown E{YS, INP(I_BDOWN)}; pg8::gemm_phase<EpiDown, pg8::MoeSched, true>(lds, 2048, 2048, 2048, S, E);
    }
    SEAM(PH_DOWN);
    if (IN(PH_COMBINE)) for (int rep = 0; rep < NREP(PH_COMBINE); ++rep) {
        PTRS
        const float* gpo = INP(I_GPOSTF);
        for (int mrow = gw; mrow < T; mrow += NGW) {
            const int b = mrow / SEQ; const float* ad = ada + b * 12288;
            int dk[4]; float wk[4];
#pragma unroll
            for (int k = 0; k < 4; ++k) { dk[k] = DEST[mrow * 4 + k]; wk[k] = TOPW[mrow * 4 + k]; }
            f32x4 f[8]; float s = 0.f;
#pragma unroll
            for (int j = 0; j < 8; ++j) f[j] = (f32x4){0.f, 0.f, 0.f, 0.f};
#pragma unroll
            for (int k = 0; k < 4; ++k) { const u32x2* yr = (const u32x2*)(YS + (size_t)dk[k] * D) + lane;
#pragma unroll
                for (int j = 0; j < 8; ++j) { const u32x2 w = yr[64 * j]; f[j] += (f32x4){bf_lo(w.x), bf_hi(w.x), bf_lo(w.y), bf_hi(w.y)} * wk[k]; } }
#pragma unroll
            for (int j = 0; j < 8; ++j) s += (f[j][0] * f[j][0] + f[j][1] * f[j][1]) + (f[j][2] * f[j][2] + f[j][3] * f[j][3]);
            const float r = rsqrtf(wave_sum(s) * (1.0f / D) + RMS_EPS);
            f32x4* o4 = (f32x4*)(outp + (size_t)mrow * D) + lane; const u32x2* x1 = (const u32x2*)((const bf16_t*)(ws + WS_X1B) + (size_t)mrow * D) + lane;
#pragma unroll
            for (int j = 0; j < 8; ++j) { const int col = 256 * j + 4 * lane; const f32x4 gg = *(const f32x4*)(gpo + col), gf = *(const f32x4*)(ad + 10240 + col); const u32x2 xw = x1[64 * j];
                o4[64 * j] = (f32x4){bf_lo(xw.x), bf_hi(xw.x), bf_lo(xw.y), bf_hi(xw.y)} + gf * (f[j] * r * gg); }
        }
    }
    if (STAMP_PHASE >= 0 && bx == 0) {
        if (seam_after(STAMP_PHASE) >= NPH) st_dt = __builtin_amdgcn_s_memrealtime() - st_t0;
        const unsigned long long t1 = __builtin_amdgcn_s_memrealtime();
        while (__builtin_amdgcn_s_memrealtime() - t1 < st_dt * STAMP_MUL) __builtin_amdgcn_s_sleep(8);
    }
#undef IN
#undef SEAM
}

extern "C" void kernel_launch(void* const* d_in, const int* in_sizes, int n_in, void* d_out, int out_size, void* d_ws, size_t ws_size, hipStream_t stream) {
    static int grid = 0;
    if (grid == 0) {
        if (n_in != 26 || out_size != T * D || ws_size < WS_END) { fprintf(stderr, "kernel_launch: unexpected shapes: n_in %d out %d ws %zu (need %zu)\n", n_in, out_size, ws_size, (size_t)WS_END); grid = -1; return; }
        int dev = 0, cus = 0, per_cu = 0;
        if (hipGetDevice(&dev) != hipSuccess || hipDeviceGetAttribute(&cus, hipDeviceAttributeMultiprocessorCount, dev) != hipSuccess) { grid = -1; return; }
        if (hipFuncSetAttribute((const void*)fwd_kernel, hipFuncAttributeMaxDynamicSharedMemorySize, LDS_BYTES) != hipSuccess) { fprintf(stderr, "kernel_launch: hipFuncSetAttribute failed\n"); grid = -1; return; }
        if (hipOccupancyMaxActiveBlocksPerMultiprocessor(&per_cu, (const void*)fwd_kernel, 512, LDS_BYTES) != hipSuccess || per_cu < 1) fprintf(stderr, "kernel_launch: occupancy query says %d\n", per_cu);
        (void)hipGetLastError();
        grid = cus;
    }
    if (grid < 0) return;
    (void)hipMemsetAsync((char*)d_ws + WS_CTL, 0, CTL_BYTES, stream);
    Args a{};
    for (int i = 0; i < 26; ++i) a.in[i] = (const float*)d_in[i];
    a.out = (float*)d_out; a.ws = (unsigned char*)d_ws;
    if (MK_N_LAUNCHES == 1) { a.ph_lo = 0; a.ph_hi = NPH; hipLaunchKernelGGL(fwd_kernel, dim3(grid), dim3(512), LDS_BYTES, stream, a); }
    else for (int p = 0; p < NPH; ++p) { a.ph_lo = p; a.ph_hi = p + 1; hipLaunchKernelGGL(fwd_kernel, dim3(grid), dim3(512), LDS_BYTES, stream, a); }
    const hipError_t le = hipPeekAtLastError();
    if (le != hipSuccess) fprintf(stderr, "kernel_launch: launch failed: %s\n", hipGetErrorName(le));
}
```

```cpp
#include <hip/hip_runtime.h>
#include <cstdio>
#include <cstdint>

#ifndef MK_N_LAUNCHES
#define MK_N_LAUNCHES 1
#endif

#define LAS __attribute__((address_space(3)))
typedef unsigned short bf16_t;
typedef short bf16x8 __attribute__((ext_vector_type(8)));
typedef short s16x4 __attribute__((ext_vector_type(4)));
typedef float f32x4 __attribute__((ext_vector_type(4)));
typedef float f32x2 __attribute__((ext_vector_type(2)));
typedef float f32x16 __attribute__((ext_vector_type(16)));
typedef unsigned u32x4 __attribute__((ext_vector_type(4)));
typedef unsigned u32x2 __attribute__((ext_vector_type(2)));

constexpr int NB = 4, SEQ = 4096, T = NB * SEQ, D = 2048;
constexpr int CH = 256, NCH = SEQ / CH, NBLK = NB * 8 * NCH;
constexpr int N_IN_NAT = 11520;
constexpr int N_IN_ALL = N_IN_NAT + 2048;
constexpr int NE = 32, PMAX = 73728;
constexpr float RMS_EPS = 1e-6f, GN_EPS = 1e-6f;
constexpr float QSCALE = 0.07216878364870322f;
constexpr int CONV_WGS = 64;

constexpr size_t MiB = 1u << 20;
constexpr size_t WS_CTL = 0, CTL_BYTES = 1 * MiB;
constexpr size_t WS_WT_IN = 1 * MiB;
constexpr size_t WS_WT_QB = WS_WT_IN + 54 * MiB;
constexpr size_t WS_WT_KVB = WS_WT_QB + 2 * MiB;
constexpr size_t WS_WT_MLAO = WS_WT_KVB + 2 * MiB;
constexpr size_t WS_WT_RETO = WS_WT_MLAO + 4 * MiB;
constexpr size_t WS_WT_OUT = WS_WT_RETO + 8 * MiB;
constexpr size_t WS_WT_GU = WS_WT_OUT + 8 * MiB;
constexpr size_t WS_WT_DOWN = WS_WT_GU + 512 * MiB;
constexpr size_t WS_CS_RET = WS_WT_DOWN + 256 * MiB;
constexpr size_t WS_CS_MLA = WS_CS_RET + 16 * MiB;
constexpr size_t WS_H = WS_CS_MLA + 4 * MiB;
constexpr size_t WS_QL = WS_H + 64 * MiB;
constexpr size_t WS_CKV = WS_QL + 16 * MiB;
constexpr size_t WS_KR = WS_CKV + 16 * MiB;
constexpr size_t WS_ACAT = WS_KR + 2 * MiB;
constexpr size_t WS_BCAT = WS_ACAT + 192 * MiB;
constexpr size_t WS_KROT = WS_BCAT + 192 * MiB;
constexpr size_t WS_KZTF = WS_KROT + 64 * MiB;
constexpr size_t WS_KZTB = WS_KZTF + 64 * MiB;
constexpr size_t WS_SG = WS_KZTB + 64 * MiB;
constexpr size_t WS_GA = WS_SG + 64 * MiB;
constexpr size_t WS_GB = WS_GA + 64 * MiB;
constexpr size_t WS_QN = WS_GB + 64 * MiB;
constexpr size_t WS_QR = WS_QN + 32 * MiB;
constexpr size_t WS_KN = WS_QR + 16 * MiB;
constexpr size_t WS_VV = WS_KN + 32 * MiB;
constexpr size_t WS_OA = WS_VV + 32 * MiB;
constexpr size_t WS_ORET = WS_OA + 32 * MiB;
constexpr size_t WS_OB = WS_ORET + 128 * MiB;
constexpr size_t WS_MIXP = WS_OB + 64 * MiB;
constexpr size_t WS_MIXIN = WS_MIXP + 64 * MiB;
constexpr size_t WS_MIX = WS_MIXIN + 64 * MiB;
constexpr size_t WS_H2 = WS_MIX + 128 * MiB;
constexpr size_t WS_TOPI = WS_H2 + 64 * MiB;
constexpr size_t WS_TOPW = WS_TOPI + 1 * MiB;
constexpr size_t WS_DEST = WS_TOPW + 1 * MiB;
constexpr size_t WS_TILE = WS_DEST + 1 * MiB;
constexpr size_t WS_YS_END = WS_TILE + 1 * MiB + 3 * 288 * MiB;
constexpr size_t WS_DECTAB = WS_TILE + 65536;
constexpr size_t WS_SSQP = WS_YS_END;
constexpr size_t WS_XS = WS_TILE + 1 * MiB;
constexpr size_t WS_ACT = WS_XS + 288 * MiB;
constexpr size_t WS_YS = WS_ACT + 288 * MiB;
constexpr size_t WS_ADAP = WS_YS + 288 * MiB + 1 * MiB;
constexpr size_t WS_H8 = WS_ADAP + 2 * MiB;
constexpr size_t WS_WT8IN = WS_H8 + 32 * MiB;
constexpr size_t WS_VT8 = WS_WT8IN + 12 * MiB;
constexpr size_t WS_X1B = WS_VT8 + 32 * MiB;
constexpr size_t WS_END = WS_X1B + 64 * MiB;
constexpr int CW_BAR = 4096;
constexpr int CW_QUEUE = 8192, CW_CVTQ = 8384, CW_AQ = 9216  , CW_COUNTS = 10240, CW_CURSOR = 12288;
constexpr int CW_ADA = 16384;
constexpr int CW_SSQQ = 65536, CW_SSQKV = 81920;
static_assert((CW_SSQKV + T) * 4 <= (int)CTL_BYTES, "ctl");

constexpr int RING_BYTES = 131072, CTRL_OFF = 155648, MISC_OFF = CTRL_OFF, LARG_OFF = CTRL_OFF + 1024, LDS_BYTES = 163840;

__device__ __forceinline__ unsigned cvt_pk_bf16(float lo, float hi) { unsigned r; asm volatile("v_cvt_pk_bf16_f32 %0, %1, %2" : "=v"(r) : "v"(lo), "v"(hi)); return r; }
__device__ __forceinline__ u32x4 pack8(f32x4 a, f32x4 b) { u32x4 w; w.x = cvt_pk_bf16(a[0], a[1]); w.y = cvt_pk_bf16(a[2], a[3]); w.z = cvt_pk_bf16(b[0], b[1]); w.w = cvt_pk_bf16(b[2], b[3]); return w; }
__device__ __forceinline__ unsigned pk4_fp8(float a, float b, float c, float d, float sc) {
    a = __builtin_amdgcn_fmed3f(a * sc, -448.f, 448.f); b = __builtin_amdgcn_fmed3f(b * sc, -448.f, 448.f); c = __builtin_amdgcn_fmed3f(c * sc, -448.f, 448.f); d = __builtin_amdgcn_fmed3f(d * sc, -448.f, 448.f);
    int w = __builtin_amdgcn_cvt_pk_fp8_f32(a, b, 0, false); w = __builtin_amdgcn_cvt_pk_fp8_f32(c, d, w, true); return (unsigned)w;
}
constexpr float W8_SCALE = 1024.f, H8_SCALE = 16.f, A8_SCALE = 8.f;
constexpr float V8_SCALE = 16.f, K8_SCALE = 256.f, CH_UNSCALE = 1.0f / (V8_SCALE * K8_SCALE);
constexpr float GU_UNSCALE = 1.0f / (W8_SCALE * H8_SCALE), DN_UNSCALE = 1.0f / (W8_SCALE * A8_SCALE);
__device__ __forceinline__ float bf_lo(unsigned w) { return __uint_as_float(w << 16); }
__device__ __forceinline__ float bf_hi(unsigned w) { return __uint_as_float(w & 0xffff0000u); }
__device__ __forceinline__ void unpack8(u32x4 w, f32x4& a, f32x4& b) { a = (f32x4){bf_lo(w.x), bf_hi(w.x), bf_lo(w.y), bf_hi(w.y)}; b = (f32x4){bf_lo(w.z), bf_hi(w.z), bf_lo(w.w), bf_hi(w.w)}; }
__device__ __forceinline__ float wave_sum(float v) {
#pragma unroll
    for (int o = 1; o < 64; o <<= 1) v += __shfl_xor(v, o);
    return v;
}
__device__ __forceinline__ float sigmoidf_(float x) { return __builtin_amdgcn_rcpf(1.0f + __expf(-x)); }
__device__ __forceinline__ float log2_sigmoid(float x) { return -log1pf(expf(-x)) * 1.4426950408889634f; }

#define XB_TMO      128
#define XB_XCNT(j)  (256  + 64 * (j))
#define XB_XSUB(j)  (1280 + 64 * (j))
#define XB_XGEN(j)  (2304 + 64 * (j))
#define XB_TOP      3328
#define XB_TOPGEN   3392
#define XCD_BAR_WORDS 3456
#define XB_SPIN_CAP (1u << 22)
__device__ __forceinline__ unsigned xb_ld(unsigned* p)              { return __hip_atomic_load(p, __ATOMIC_RELAXED, __HIP_MEMORY_SCOPE_AGENT); }
__device__ __forceinline__ unsigned xb_add(unsigned* p, unsigned v) { return __hip_atomic_fetch_add(p, v, __ATOMIC_RELAXED, __HIP_MEMORY_SCOPE_AGENT); }
__device__ __forceinline__ unsigned xb_xcc_id() { return (unsigned)__builtin_amdgcn_s_getreg((3 << 11) | 20) & 0xFu; }
#define XB_SPIN(cond, bar) do { unsigned _sp = 0; while (cond) { __builtin_amdgcn_s_sleep(1); \
    if ((++_sp & 255u) == 0u) { if (xb_ld(&(bar)[XB_TMO])) break; if (_sp > XB_SPIN_CAP) { atomicAdd(&(bar)[XB_TMO], 1u); break; } } } } while (0)
struct XcdBarrier { unsigned* bar; unsigned x; volatile LAS unsigned* st; };
__device__ __forceinline__ XcdBarrier xcd_barrier_post(unsigned* bar, volatile LAS unsigned* st) {
    XcdBarrier b; b.bar = bar; b.x = xb_xcc_id(); b.st = st;
    if (threadIdx.x == 0) (void)xb_add(&bar[XB_XCNT(b.x)], 1u);
    return b;
}
__device__ __forceinline__ void xcd_barrier_complete(unsigned* bar, unsigned x, unsigned& nloc, unsigned& nx) {
    const unsigned G = gridDim.x * gridDim.y * gridDim.z;
    unsigned sum, cnt, mine, sp = 0u;
    for (;;) {
        sum = 0u; cnt = 0u; mine = 0u;
#pragma unroll
        for (unsigned j = 0; j < 16; ++j) { const unsigned c = xb_ld(&bar[XB_XCNT(j)]); sum += c; cnt += (c > 0u) ? 1u : 0u; mine = (j == x) ? c : mine; }
        if (sum == G) break;
        __builtin_amdgcn_s_sleep(1);
        if ((++sp & 255u) == 0u) { if (xb_ld(&bar[XB_TMO])) break; if (sp > XB_SPIN_CAP) { atomicAdd(&bar[XB_TMO], 1u); break; } }
    }
    nloc = mine > 0u ? mine : 1u; nx = cnt > 0u ? cnt : 1u;
}
__device__ __forceinline__ void xcd_barrier(const XcdBarrier& b) {
    asm volatile("s_waitcnt vmcnt(0)" ::: "memory");
    __syncthreads();
    if (threadIdx.x == 0) {
        unsigned* bar = b.bar;
        __builtin_amdgcn_s_waitcnt(0);
        unsigned nloc = b.st[0], nx = b.st[1];
        if (nloc == 0u) { xcd_barrier_complete(bar, b.x, nloc, nx); b.st[0] = nloc; b.st[1] = nx; }
        const unsigned old = xb_add(&bar[XB_XSUB(b.x)], 1u);
        const unsigned gen = old / nloc;
        if (old + 1u == (gen + 1u) * nloc) {
            __builtin_amdgcn_fence(__ATOMIC_RELEASE, "agent");
            asm volatile("s_waitcnt vmcnt(0)" ::: "memory");
            const unsigned og = xb_add(&bar[XB_TOP], 1u);
            const unsigned tg = og / nx;
            if (og + 1u == (tg + 1u) * nx) xb_add(&bar[XB_TOPGEN], 1u);
            else XB_SPIN(xb_ld(&bar[XB_TOPGEN]) == tg, bar);
            __builtin_amdgcn_fence(__ATOMIC_ACQUIRE, "agent");
            xb_add(&bar[XB_XGEN(b.x)], 1u);
            asm volatile("s_waitcnt vmcnt(0)" ::: "memory");
        } else {
            XB_SPIN(xb_ld(&bar[XB_XGEN(b.x)]) == gen, bar);
            __builtin_amdgcn_fence(__ATOMIC_ACQUIRE, "agent");
            asm volatile("s_waitcnt vmcnt(0)" ::: "memory");
        }
    }
    __syncthreads();
}

namespace pg8 {
constexpr int BM = 256, BK = 64, HALF = 128, HTB = HALF * BK * 2, NXCD = 8, WGM = 8;
__host__ __device__ __forceinline__ int lds_byte(int r, int c, int SW = 5) { const int st = (r >> 4) * 2 + (c >> 5), rr = r & 15, cc = c & 31, ob = rr * 64 + cc * 2; return st * 1024 + (ob ^ (((ob >> 9) & 1) << SW)); }
__host__ __device__ __forceinline__ void stage_rc(int b, int& R, int& C, int SW = 5) { const int st = b / 1024, sb = b % 1024, swz = sb ^ (((sb >> 9) & 1) << SW); R = (st >> 1) * 16 + swz / 64; C = (st & 1) * 32 + (swz % 64) / 2; }
__host__ __device__ __forceinline__ int perm32(int rho) { const int n = rho >> 4, i = rho & 15; return 8 * (i >> 2) + 4 * n + (i & 3); }
struct Unit { const char* a; const char* b; int pm, pn, keep, aux; };
__device__ __forceinline__ void tile_order(int wgid, int nM, int nN, int& pm, int& pn) {
    const int nwg = nM * nN; { const int q = nwg / NXCD, r = nwg % NXCD, xcd = wgid % NXCD, off = wgid / NXCD; wgid = (xcd < r ? xcd * (q + 1) : r * (q + 1) + (xcd - r) * q) + off; }
    const int nig = WGM * nN, gid = wgid / nig, fm = gid * WGM, gsz = (nM - fm) < WGM ? (nM - fm) : WGM;
    pm = fm + ((wgid % nig) % gsz); pn = (wgid % nig) / gsz;
}
typedef int v8i __attribute__((ext_vector_type(8)));
typedef int v4i __attribute__((ext_vector_type(4)));
template <class Epi, class Sched, bool F8 = false, bool REMAT = false>
__device__ __forceinline__ void gemm_phase(LAS unsigned char* lds, const int K, const int lda, const int ldb, const Sched& S, const Epi& E) {
    const int tid = threadIdx.x, wid = __builtin_amdgcn_readfirstlane(tid >> 6), lane = tid & 63, wr = wid >> 2, wc = wid & 3, fr = lane & 15, fq = lane >> 4;
    constexpr int ES = F8 ? 1 : 2;
    const int nt = K * ES / (BK * 2);
    unsigned voffA, voffB;
    constexpr bool X4 = F8 && !REMAT;
    constexpr int SW = X4 ? 4 : 5;
    { int R, C; stage_rc(tid * 16, R, C, SW); const int Rb = (R & ~31) + perm32(R & 31); voffA = (unsigned)(R * lda * ES + C * 2); voffB = (unsigned)(Rb * ldb * ES + C * 2); }
    const size_t q64voffA = (size_t)64 * lda * ES, q64voffB = (size_t)64 * ldb * ES;
    const size_t kstep = (size_t)(BK * 2);
    const size_t hstepA = (size_t)HALF * lda * ES, hstepB = (size_t)HALF * ldb * ES;
    const unsigned ldsw = (unsigned)wid * 1024u;
    const int aoff = F8 ? lds_byte(wr * 64 + fr, fq * 16, SW) : lds_byte(wr * 64 + fr, fq * 8), boff = F8 ? lds_byte(wc * 32 + fr, fq * 16, SW) : lds_byte(wc * 32 + fr, fq * 8);
#define PG8_SA(b, h) (((b) * 2 + (h)) * HTB)
#define PG8_SB(b, h) ((4 + (b) * 2 + (h)) * HTB)
    constexpr bool isB_voffA = false, isB_voffB = true; const unsigned pitch_voffA = (unsigned)(lda * ES), pitch_voffB = (unsigned)(ldb * ES);
#define PG8_VOFF(isB, pitch) ({ unsigned _t = threadIdx.x; asm volatile("" : "+v"(_t)); const unsigned _l = _t & 63u, _w = _t >> 6, _sw = (_l * 16u) ^ ((_l >> 5) << SW); unsigned _R = (_w >> 1) * 16u + (_sw >> 6); \
        const unsigned _C = (_w & 1u) * 32u + ((_sw & 63u) >> 1); if (isB) _R = (_R & ~31u) + (unsigned)perm32((int)(_R & 31u)); _R * (pitch) + _C * 2u; })
#define PG8_STAGE(bufoff, gbase, voff) do { _Pragma("unroll") for (int _i = 0; _i < 2; ++_i) { unsigned _vo; if constexpr (REMAT) _vo = PG8_VOFF(isB_##voff, pitch_##voff); else { _vo = (voff); if constexpr (F8) asm volatile("" : "+v"(_vo)); } \
        __builtin_amdgcn_global_load_lds((const unsigned*)((const char*)(gbase) + (_i ? q64##voff : (size_t)0) + _vo), (LAS unsigned*)(lds + (bufoff) + ldsw + _i * 8192), 16, 0, 0); } } while (0)
#define PG8_LD1(addr) ({ v8i _r; if constexpr (F8 && !X4) { _r = *(const LAS v8i*)(addr); } else if constexpr (X4) { const v4i _lo = *(const LAS v4i*)(addr), _hi = *(const LAS v4i*)((addr) + _x16); _r = __builtin_shufflevector(_lo, _hi, 0, 1, 2, 3, 4, 5, 6, 7); } else { const v4i _lo = *(const LAS v4i*)(addr), _hi = *(const LAS v4i*)((addr) + 1024); _r = __builtin_shufflevector(_lo, _hi, 0, 1, 2, 3, 4, 5, 6, 7); } _r; })
#define PG8_X16(off) int _x16 = 0; if constexpr (X4) { int _o = (off); asm volatile("" : "+v"(_o)); _x16 = (_o ^ 16) - _o; }
#define PG8_LDA(dst, b, h) do { PG8_X16(aoff) _Pragma("unroll") for (int m = 0; m < 4; ++m) dst[m] = PG8_LD1(lds + PG8_SA(b, h) + aoff + m * 2048); } while (0)
#define PG8_LDB(dst, b, h) do { PG8_X16(boff) _Pragma("unroll") for (int n = 0; n < 2; ++n) dst[n] = PG8_LD1(lds + PG8_SB(b, h) + boff + n * 2048); } while (0)
#define PG8_H0(x) __builtin_bit_cast(bf16x8, __builtin_shufflevector(x, x, 0, 1, 2, 3))
#define PG8_H1(x) __builtin_bit_cast(bf16x8, __builtin_shufflevector(x, x, 4, 5, 6, 7))
#define PG8_MMA(ai, bj, At, Bt) do { __builtin_amdgcn_s_setprio(1); _Pragma("unroll") for (int m = 0; m < 4; ++m) _Pragma("unroll") for (int n = 0; n < 2; ++n) { \
        if constexpr (F8) acc[ai][bj][m][n] = __builtin_amdgcn_mfma_scale_f32_16x16x128_f8f6f4(Bt[n], At[m], acc[ai][bj][m][n], 0, 0, 0, 0, 0, 0); \
        else { acc[ai][bj][m][n] = __builtin_amdgcn_mfma_f32_16x16x32_bf16(PG8_H0(Bt[n]), PG8_H0(At[m]), acc[ai][bj][m][n], 0, 0, 0); \
               acc[ai][bj][m][n] = __builtin_amdgcn_mfma_f32_16x16x32_bf16(PG8_H1(Bt[n]), PG8_H1(At[m]), acc[ai][bj][m][n], 0, 0, 0); } } \
        __builtin_amdgcn_s_setprio(0); } while (0)
#define PG8_WAIT_V(n) asm volatile("s_waitcnt vmcnt(" #n ")" ::: "memory")
#define PG8_WAIT_L(n) asm volatile("s_waitcnt lgkmcnt(" #n ")" ::: "memory")
#define PG8_BAR __builtin_amdgcn_s_barrier()
#define PG8_SCHED __builtin_amdgcn_sched_barrier(0)
    Unit cur, nxt; int ui = 0;
    if (!S.next(0, cur)) return;
    f32x4 acc[2][2][4][2];
#pragma unroll
    for (int a = 0; a < 2; ++a)
#pragma unroll
        for (int b = 0; b < 2; ++b)
#pragma unroll
            for (int m = 0; m < 4; ++m)
#pragma unroll
                for (int n = 0; n < 2; ++n) acc[a][b][m][n] = (f32x4){0.f, 0.f, 0.f, 0.f};
    v8i At[4], B0[2], B1[2];
    const char* cA = cur.a; const char* cB = cur.b;
    PG8_STAGE(PG8_SB(0, 0), cB, voffB); PG8_STAGE(PG8_SB(0, 1), cB + hstepB, voffB); PG8_STAGE(PG8_SA(0, 0), cA, voffA); PG8_STAGE(PG8_SA(0, 1), cA + hstepA, voffA);
    if (wr == 1) PG8_BAR;
    PG8_WAIT_V(2); PG8_BAR;
    PG8_STAGE(PG8_SB(1, 0), cB + kstep, voffB); PG8_STAGE(PG8_SA(1, 0), cA + kstep, voffA); PG8_STAGE(PG8_SB(1, 1), cB + hstepB + kstep, voffB);
    PG8_WAIT_V(6); PG8_BAR;
    for (;;) {
        const bool has_next = S.next(ui + 1, nxt);
        const char* nA = has_next ? nxt.a : cA; const char* nB = has_next ? nxt.b : cB;
#pragma nounroll
        for (int t = 0; t < nt; t += 2) {
            const bool last = (t == nt - 2);
            const char* a1 = cA + (size_t)(t + 1) * kstep;
            const char* a2 = last ? nA : cA + (size_t)(t + 2) * kstep; const char* b2 = last ? nB : cB + (size_t)(t + 2) * kstep;
            const char* a3 = a2 + kstep; const char* b3 = b2 + kstep;
            PG8_LDB(B0, 0, 0); PG8_LDB(B1, 0, 1); PG8_SCHED; PG8_LDA(At, 0, 0); PG8_STAGE(PG8_SA(1, 1), a1 + hstepA, voffA);
            PG8_WAIT_V(8); PG8_WAIT_L(0); PG8_BAR; PG8_MMA(0, 0, At, B0); PG8_MMA(0, 1, At, B1); PG8_BAR; PG8_SCHED;
            PG8_LDA(At, 0, 1); PG8_STAGE(PG8_SB(0, 0), b2, voffB); PG8_STAGE(PG8_SB(0, 1), b2 + hstepB, voffB); PG8_STAGE(PG8_SA(0, 0), a2, voffA);
            PG8_WAIT_V(8); PG8_WAIT_L(0); PG8_BAR; PG8_MMA(1, 0, At, B0); PG8_MMA(1, 1, At, B1); PG8_BAR; PG8_SCHED;
            PG8_LDB(B0, 1, 0); PG8_LDB(B1, 1, 1); PG8_SCHED; PG8_LDA(At, 1, 0); PG8_STAGE(PG8_SA(0, 1), a2 + hstepA, voffA);
            PG8_WAIT_V(8); PG8_WAIT_L(0); PG8_BAR; PG8_MMA(0, 0, At, B0); PG8_MMA(0, 1, At, B1); PG8_BAR; PG8_SCHED;
            PG8_LDA(At, 1, 1); PG8_STAGE(PG8_SB(1, 0), b3, voffB); PG8_STAGE(PG8_SB(1, 1), b3 + hstepB, voffB); PG8_STAGE(PG8_SA(1, 0), a3, voffA);
            PG8_WAIT_V(8); PG8_WAIT_L(0); PG8_BAR; PG8_MMA(1, 0, At, B0); PG8_MMA(1, 1, At, B1); PG8_BAR; PG8_SCHED;
        }
        if (wr == 0) PG8_BAR;
        { unsigned _t = threadIdx.x; if constexpr (F8) asm volatile("" : "+v"(_t)); E(acc, cur, wr, wc, (int)(_t & 15u), (int)((_t >> 4) & 3u)); }
        if (!has_next) break;
        if (!cur.keep) {
#pragma unroll
            for (int a = 0; a < 2; ++a)
#pragma unroll
                for (int b = 0; b < 2; ++b)
#pragma unroll
                    for (int m = 0; m < 4; ++m)
#pragma unroll
                        for (int n = 0; n < 2; ++n) acc[a][b][m][n] = (f32x4){0.f, 0.f, 0.f, 0.f};
        }
        cur = nxt; cA = nA; cB = nB; ++ui;
        if (wr == 1) PG8_BAR;
    }
    PG8_WAIT_V(0);
    PG8_BAR;
#undef PG8_SA
#undef PG8_SB
#undef PG8_STAGE
#undef PG8_VOFF
#undef PG8_LDA
#undef PG8_LDB
#undef PG8_LD1
#undef PG8_X16
#undef PG8_H0
#undef PG8_H1
#undef PG8_MMA
#undef PG8_WAIT_V
#undef PG8_WAIT_L
#undef PG8_BAR
#undef PG8_SCHED
}
struct GridSched {
    const char* A; const char* Bt; size_t astep, bstep; int nM, nN, G, c;
    __device__ __forceinline__ bool next(int i, Unit& u) const {
        const int L = i * G + c; if (L >= nM * nN) return false;
        int pm, pn; tile_order(L, nM, nN, pm, pn);
        u.a = A + (size_t)pm * astep; u.b = Bt + (size_t)pn * bstep; u.pm = pm; u.pn = pn; u.keep = 0; u.aux = 0; return true;
    }
};
struct InprojSched {
    const char* H; const char* W; int G, c;
    __device__ __forceinline__ bool next(int i, Unit& u) const {
        const int L = i * G + c; if (L >= 1792) return false;
        constexpr size_t TSB = (size_t)256 * 2048 * 2; int pm, pn;
        if (L < 1280) { tile_order(L, 64, 20, pm, pn); pn = pn < 4 ? pn : pn + 1; u.a = H + (size_t)pm * TSB; u.b = W + (size_t)pn * TSB; u.aux = 0; }
        else { tile_order(L - 1280, 8, 64, pm, pn); u.a = W + (size_t)(45 + pm) * TSB; u.b = H + (size_t)pn * TSB; u.aux = 1; }
        u.pm = pm; u.pn = pn; u.keep = 0; return true;
    }
};
struct GridSchedR {
    const char* A; const char* Bt; size_t astep, bstep; int nM, nN, G, c, L0, Lend;
    __device__ __forceinline__ bool next(int i, Unit& u) const {
        const int L = L0 + i * G + c; if (L >= Lend) return false;
        int pm, pn; tile_order(L, nM, nN, pm, pn);
        u.a = A + (size_t)pm * astep; u.b = Bt + (size_t)pn * bstep; u.pm = pm; u.pn = pn; u.keep = 0; u.aux = 0; return true;
    }
};
struct BatchSchedR {
    const char* A; const char* Bt; size_t astep, bstep; int G, c, L0, Lend;
    __device__ __forceinline__ bool next(int i, Unit& u) const {
        const int L = L0 + i * G + c; if (L >= Lend) return false;
        u.a = A + (size_t)L * astep; u.b = Bt + (size_t)L * bstep; u.pm = L; u.pn = 0; u.keep = 0; u.aux = 0; return true;
    }
};
struct BatchSched {
    const char* A; const char* Bt; size_t astep, bstep; int n, G, c;
    __device__ __forceinline__ bool next(int i, Unit& u) const {
        const int L = i * G + c; if (L >= n) return false;
        u.a = A + (size_t)L * astep; u.b = Bt + (size_t)L * bstep; u.pm = L; u.pn = 0; u.keep = 0; u.aux = 0; return true;
    }
};
struct ChainSched {
    const char* A; const char* Bt; int bh, dir;
    __device__ __forceinline__ bool next(int i, Unit& u) const {
        if (i >= NCH) return false;
        const int n = dir ? (NCH - 1 - i) : i, blk = bh * NCH + n;
        u.a = A + (size_t)blk * (256 * 256); u.b = Bt + (size_t)blk * (256 * 256); u.pm = blk; u.pn = i; u.keep = 1; u.aux = n; return true;
    }
};
struct MoeSched {
    const char* A; const char* Bt; const int* tile_e; int ntiles, nN, G, c;
    __device__ __forceinline__ bool next(int i, Unit& u) const {
        const int L = i * G + c; if (L >= ntiles * nN) return false;
        int pm, pn; tile_order(L, ntiles, nN, pm, pn);
        const int e = __builtin_amdgcn_readfirstlane(tile_e[pm]);
        u.a = A + (size_t)pm * (256 * 2048); u.b = Bt + ((size_t)e * nN + pn) * (256 * 2048); u.pm = pm; u.pn = pn; u.keep = 0; u.aux = e; return true;
    }
};
}
using pg8::Unit;

#define EPI_LOOP _Pragma("unroll") for (int ai = 0; ai < 2; ++ai) _Pragma("unroll") for (int m = 0; m < 4; ++m)
#define EPI_ROW (ai * 128 + wr * 64 + m * 16 + fr)
#define EPI_FENCE asm volatile("" ::: "memory")
typedef f32x4 Acc[2][2][4][2];

__device__ __forceinline__ void rot4(const f32x4 x1, const f32x4 x2, const f32x4 csA, const f32x4 csB, f32x4& o1, f32x4& o2) {
    o1[0] = x1[0] * csA[0] - x2[0] * csA[1]; o2[0] = x1[0] * csA[1] + x2[0] * csA[0];
    o1[1] = x1[1] * csA[2] - x2[1] * csA[3]; o2[1] = x1[1] * csA[3] + x2[1] * csA[2];
    o1[2] = x1[2] * csB[0] - x2[2] * csB[1]; o2[2] = x1[2] * csB[1] + x2[2] * csB[0];
    o1[3] = x1[3] * csB[2] - x2[3] * csB[3]; o2[3] = x1[3] * csB[3] + x2[3] * csB[2];
}
__device__ __forceinline__ f32x4 rot_il(const f32x4 v, const f32x4 cs) {
    return (f32x4){v[0] * cs[0] - v[1] * cs[1], v[0] * cs[1] + v[1] * cs[0], v[2] * cs[2] - v[3] * cs[3], v[2] * cs[3] + v[3] * cs[2]};
}

struct EpiInproj {
    bf16_t *QL, *CKV, *KR, *ACAT, *KROT, *SG, *GA, *GB; float *ssqp; const float* cs_ret; const float* cs_mla; const float* dectab; int pn_off; float unscale;
    __device__ __forceinline__ void operator()(Acc& acc, const Unit& u, int wr, int wc, int fr, int fq) const {
        asm volatile("" : "+v"(fr), "+v"(fq));
        const int pn = u.pn + pn_off, tok0 = u.pm * 256, cb = wc * 32 + fq * 8;
        if (pn < 4) {
            bf16_t* dst = QL + (size_t)(pn >> 1) * ((WS_CKV - WS_QL) / 2); float* ssq = ssqp + (size_t)(pn * 4 + wc) * T; const int c0 = (pn & 1) * 256 + cb;
            EPI_LOOP { const int row = tok0 + EPI_ROW; float s = 0.f;
#pragma unroll
                for (int bj = 0; bj < 2; ++bj) { const f32x4 v0 = acc[ai][bj][m][0], v1 = acc[ai][bj][m][1];
                    s += (v0[0] * v0[0] + v0[1] * v0[1]) + (v0[2] * v0[2] + v0[3] * v0[3]) + (v1[0] * v1[0] + v1[1] * v1[1]) + (v1[2] * v1[2] + v1[3] * v1[3]);
                    *(u32x4*)(dst + (size_t)row * 512 + c0 + bj * 128) = pack8(v0, v1); }
                s += __shfl_xor(s, 16); s += __shfl_xor(s, 32);
                if (fq == 0) ssq[row] = s; EPI_FENCE; }
        } else if (pn == 4) {
            if (wc < 2) {
                EPI_LOOP { const int row = tok0 + EPI_ROW; const float* cs = cs_mla + (size_t)row * 64 + cb;
                    const f32x4 csA = *(const f32x4*)cs, csB = *(const f32x4*)(cs + 4);
                    *(u32x4*)(KR + (size_t)row * 64 + cb) = pack8(rot_il(acc[ai][0][m][0], csA), rot_il(acc[ai][0][m][1], csB)); EPI_FENCE; }
            }
        } else if (pn < 21) {
            const bool isq = pn < 13; const int h = isq ? pn - 5 : pn - 13;
            const int blk = ((u.pm >> 4) * 8 + h) * NCH + (u.pm & 15);
            const float lf = dectab[h], lb = dectab[8 + h];
            EPI_LOOP { const int c = EPI_ROW, row = tok0 + c; const float* cs = cs_ret + (size_t)row * 256 + cb * 2;
                f32x4 q1[2], q2[2];
#pragma unroll
                for (int n = 0; n < 2; ++n) { const f32x4 csA = *(const f32x4*)(cs + n * 8), csB = *(const f32x4*)(cs + n * 8 + 4); rot4(acc[ai][0][m][n], acc[ai][1][m][n], csA, csB, q1[n], q2[n]); }
                if (isq) {
                    const float xf = __builtin_amdgcn_exp2f((float)(c + 1) * lf), xb = __builtin_amdgcn_exp2f((float)(CH - c) * lb);
                    bf16_t* base = ACAT + ((size_t)blk * 256 + c) * 768 + cb;
                    *(u32x4*)(base + 256) = pack8(q1[0] * xf, q1[1] * xf); *(u32x4*)(base + 384) = pack8(q2[0] * xf, q2[1] * xf);
                    *(u32x4*)(base + 512) = pack8(q1[0] * xb, q1[1] * xb); *(u32x4*)(base + 640) = pack8(q2[0] * xb, q2[1] * xb);
                } else {
                    bf16_t* base = KROT + ((size_t)blk * 256 + c) * 256 + cb;
                    *(u32x4*)(base) = pack8(q1[0] * 0.0625f, q1[1] * 0.0625f); *(u32x4*)(base + 128) = pack8(q2[0] * 0.0625f, q2[1] * 0.0625f);
                }
                EPI_FENCE; }
        } else {
            const int g = (pn - 21) >> 3, ct = (pn - 21) & 7; bf16_t* dst = SG + (size_t)g * ((WS_GA - WS_SG) / 2);
            EPI_LOOP { const int row = tok0 + EPI_ROW;
#pragma unroll
                for (int bj = 0; bj < 2; ++bj) { f32x4 v[2];
#pragma unroll
                    for (int n = 0; n < 2; ++n)
#pragma unroll
                        for (int j = 0; j < 4; ++j) { const float x = acc[ai][bj][m][n][j] * unscale; const float sg = sigmoidf_(x); v[n][j] = g == 0 ? x * sg : sg; }
                    *(u32x4*)(dst + (size_t)row * 2048 + ct * 256 + bj * 128 + cb) = pack8(v[0], v[1]); }
                EPI_FENCE; }
        }
    }
};
struct EpiVT {
    bf16_t* BCAT; unsigned char* VT8;
    __device__ __forceinline__ void operator()(Acc& acc, const Unit& u, int wr, int wc, int fr, int fq) const {
        asm volatile("" : "+v"(fr), "+v"(fq));
        const int blk = ((u.pn >> 4) * 8 + u.pm) * NCH + (u.pn & 15), cb = wc * 32 + fq * 8;
        EPI_LOOP { bf16_t* base = BCAT + ((size_t)blk * 256 + EPI_ROW) * 768 + cb; unsigned char* b8 = VT8 + ((size_t)blk * 256 + EPI_ROW) * 256 + cb;
#pragma unroll
            for (int bj = 0; bj < 2; ++bj) { const f32x4 v0 = acc[ai][bj][m][0], v1 = acc[ai][bj][m][1]; *(u32x4*)(base + bj * 128) = pack8(v0, v1);
                u32x2 w8; w8.x = pk4_fp8(v0[0], v0[1], v0[2], v0[3], V8_SCALE); w8.y = pk4_fp8(v1[0], v1[1], v1[2], v1[3], V8_SCALE); *(u32x2*)(b8 + bj * 128) = w8; } }
    }
};
struct EpiInprojAll {
    EpiInproj a; EpiVT b;
    __device__ __forceinline__ void operator()(Acc& acc, const Unit& u, int wr, int wc, int fr, int fq) const { if (u.aux) b(acc, u, wr, wc, fr, fq); else a(acc, u, wr, wc, fr, fq); }
};
struct EpiMlaQ {
    bf16_t *QN, *QR; const float* ssq; const float* cs_mla;
    __device__ __forceinline__ void operator()(Acc& acc, const Unit& u, int wr, int wc, int fr, int fq) const {
        asm volatile("" : "+v"(fr), "+v"(fq));
        const int pn = u.pn, tok0 = u.pm * 256, cb = wc * 32 + fq * 8;
        EPI_LOOP { const int row = tok0 + EPI_ROW; float ss = 0.f;
#pragma unroll
            for (int q = 0; q < 8; ++q) ss += ssq[(size_t)q * T + row];
            const float rs = rsqrtf(ss * (1.0f / 512.0f) + RMS_EPS) * QSCALE;
            if (pn < 4) {
#pragma unroll
                for (int bj = 0; bj < 2; ++bj) *(u32x4*)(QN + (size_t)row * 1024 + (2 * pn + bj) * 128 + cb) = pack8(acc[ai][bj][m][0] * rs, acc[ai][bj][m][1] * rs);
            } else {
                const int c0 = (wc & 1) * 32 + fq * 8; const float* cs = cs_mla + (size_t)row * 64 + c0;
                const f32x4 csA = *(const f32x4*)cs, csB = *(const f32x4*)(cs + 4);
#pragma unroll
                for (int bj = 0; bj < 2; ++bj) { const int head = 4 * (pn - 4) + 2 * bj + (wc >> 1);
                    *(u32x4*)(QR + (size_t)row * 512 + head * 64 + c0) = pack8(rot_il(acc[ai][bj][m][0], csA) * rs, rot_il(acc[ai][bj][m][1], csB) * rs); }
            }
            EPI_FENCE; }
    }
};
struct EpiMlaKV {
    bf16_t *KN, *VV; const float* ssq;
    __device__ __forceinline__ void operator()(Acc& acc, const Unit& u, int wr, int wc, int fr, int fq) const {
        asm volatile("" : "+v"(fr), "+v"(fq));
        const int pn = u.pn, tok0 = u.pm * 256, cb = wc * 32 + fq * 8; bf16_t* dst = KN + (size_t)(pn >> 2) * ((WS_VV - WS_KN) / 2); const int hb = 2 * (pn & 3);
        EPI_LOOP { const int row = tok0 + EPI_ROW; float ss = 0.f;
#pragma unroll
            for (int q = 0; q < 8; ++q) ss += ssq[(size_t)q * T + row];
            const float rs = rsqrtf(ss * (1.0f / 512.0f) + RMS_EPS);
#pragma unroll
            for (int bj = 0; bj < 2; ++bj) *(u32x4*)(dst + (size_t)row * 1024 + (hb + bj) * 128 + cb) = pack8(acc[ai][bj][m][0] * rs, acc[ai][bj][m][1] * rs); }
    }
};
struct EpiGa {
    bf16_t* ACAT; const float* dectab;
    __device__ __forceinline__ void operator()(Acc& acc, const Unit& u, int wr, int wc, int fr, int fq) const {
        asm volatile("" : "+v"(fr), "+v"(fq));
        const int blk = u.pm, h = (blk >> 4) & 7, cb = wc * 32 + fq * 8;
        const float lf = dectab[h], lb = dectab[8 + h];
        f32x4 colA[2][2], colB[2][2];
#pragma unroll
        for (int bj = 0; bj < 2; ++bj)
#pragma unroll
            for (int n = 0; n < 2; ++n)
#pragma unroll
                for (int j = 0; j < 4; ++j) { const int mm = bj * 128 + cb + n * 4 + j; colA[bj][n][j] = __builtin_amdgcn_exp2f(-(float)(mm + 1) * lf); colB[bj][n][j] = __builtin_amdgcn_exp2f((float)mm * lb); }
        EPI_LOOP { const int c = EPI_ROW; bf16_t* base = ACAT + ((size_t)blk * 256 + c) * 768 + cb;
            const float rowB = __builtin_amdgcn_exp2f(-(float)c * lb - (float)(c + 1) * lf);
#pragma unroll
            for (int bj = 0; bj < 2; ++bj) { f32x4 v[2];
#pragma unroll
                for (int n = 0; n < 2; ++n)
#pragma unroll
                    for (int j = 0; j < 4; ++j) { const int mm = bj * 128 + cb + n * 4 + j;
                        v[n][j] = acc[ai][bj][m][n][j] * ((c >= mm) ? colA[bj][n][j] : colB[bj][n][j] * rowB); }
                *(u32x4*)(base + bj * 128) = pack8(v[0], v[1]); }
            EPI_FENCE; }
    }
};
struct EpiGb {
    bf16_t* BCAT; const float* dectab; int dir;
    __device__ __forceinline__ void operator()(Acc& acc, const Unit& u, int wr, int wc, int fr, int fq) const {
        asm volatile("" : "+v"(fr), "+v"(fq));
        const int h = (u.pm >> 4) & 7;
        const float gC = __builtin_amdgcn_exp2f((float)CH * dectab[8 * dir + h]);
        if (u.pn < NCH - 1) {
            const int nblk = dir ? u.pm - 1 : u.pm + 1;
            bf16_t* base0 = BCAT + ((size_t)nblk * 256 + wr * 64 + fr) * 768 + 256 + 256 * dir + wc * 32 + fq * 8;
            EPI_LOOP { bf16_t* base = base0 + (size_t)(ai * 128 + m * 16) * 768;
#pragma unroll
                for (int bj = 0; bj < 2; ++bj) *(u32x4*)(base + bj * 128) = pack8(acc[ai][bj][m][0] * CH_UNSCALE, acc[ai][bj][m][1] * CH_UNSCALE); }
        }
        EPI_LOOP {
#pragma unroll
            for (int bj = 0; bj < 2; ++bj) { acc[ai][bj][m][0] *= gC; acc[ai][bj][m][1] *= gC; } }
    }
};
struct EpiGc {
    bf16_t* OB; const bf16_t* SG; const float* gn; LAS unsigned char* lds;
    __device__ __forceinline__ void operator()(Acc& acc, const Unit& u, int wr, int wc, int fr, int fq) const {
        asm volatile("" : "+v"(fr), "+v"(fq));
        const int blk = u.pm, b = blk >> 7, h = (blk >> 4) & 7, n = blk & 15, cb = wc * 32 + fq * 8;
        LAS f32x2* P = (LAS f32x2*)(lds + RING_BYTES);
        EPI_LOOP { float s = 0.f;
#pragma unroll
            for (int bj = 0; bj < 2; ++bj)
#pragma unroll
                for (int nn = 0; nn < 2; ++nn) { const f32x4 x = acc[ai][bj][m][nn]; s += (x[0] + x[1]) + (x[2] + x[3]); }
            s += __shfl_xor(s, 16); s += __shfl_xor(s, 32);
            const float mw = s * (1.0f / 64.0f); float q = 0.f;
#pragma unroll
            for (int bj = 0; bj < 2; ++bj)
#pragma unroll
                for (int nn = 0; nn < 2; ++nn) { const f32x4 d = acc[ai][bj][m][nn] - mw; q += (d[0] * d[0] + d[1] * d[1]) + (d[2] * d[2] + d[3] * d[3]); }
            q += __shfl_xor(q, 16); q += __shfl_xor(q, 32);
            if (fq == 0) P[EPI_ROW * 4 + wc] = (f32x2){mw, q}; }
        asm volatile("s_waitcnt lgkmcnt(0)" ::: "memory"); __builtin_amdgcn_s_barrier(); asm volatile("" ::: "memory");
        EPI_LOOP { const int row = EPI_ROW; const f32x4 p01 = *(const LAS f32x4*)(P + row * 4), p23 = *(const LAS f32x4*)(P + row * 4 + 2);
            const float mean = ((p01[0] + p01[2]) + (p23[0] + p23[2])) * 0.25f;
            const float d0 = p01[0] - mean, d1 = p01[2] - mean, d2 = p23[0] - mean, d3 = p23[2] - mean;
            const float m2 = ((p01[1] + p01[3]) + (p23[1] + p23[3])) + 64.0f * ((d0 * d0 + d1 * d1) + (d2 * d2 + d3 * d3));
            const float rstd = rsqrtf(m2 * (1.0f / 256.0f) + GN_EPS);
            const size_t off = ((size_t)b * SEQ + n * 256 + row) * 2048 + h * 256 + cb;
#pragma unroll
            for (int bj = 0; bj < 2; ++bj) { f32x4 s0, s1; unpack8(*(const u32x4*)(SG + off + bj * 128), s0, s1);
                const f32x4 g0 = *(const f32x4*)(gn + h * 256 + bj * 128 + cb), g1 = *(const f32x4*)(gn + h * 256 + bj * 128 + cb + 4);
                *(u32x4*)(OB + off + bj * 128) = pack8(s0 * ((acc[ai][bj][m][0] - mean) * rstd * g0), s1 * ((acc[ai][bj][m][1] - mean) * rstd * g1)); }
            EPI_FENCE; }
    }
};
struct EpiMixA {
    bf16_t* MIXP; const bf16_t* GA;
    __device__ __forceinline__ void operator()(Acc& acc, const Unit& u, int wr, int wc, int fr, int fq) const {
        asm volatile("" : "+v"(fr), "+v"(fq));
        const int cb = wc * 32 + fq * 8;
        EPI_LOOP { const size_t off = (size_t)(u.pm * 256 + EPI_ROW) * 2048 + u.pn * 256 + cb;
#pragma unroll
            for (int bj = 0; bj < 2; ++bj) { f32x4 g0, g1; unpack8(*(const u32x4*)(GA + off + bj * 128), g0, g1);
                *(u32x4*)(MIXP + off + bj * 128) = pack8(acc[ai][bj][m][0] * g0, acc[ai][bj][m][1] * g1); }
            EPI_FENCE; }
    }
};
struct EpiMixB {
    bf16_t* MIXIN; const bf16_t* MIXP; const bf16_t* GB;
    __device__ __forceinline__ void operator()(Acc& acc, const Unit& u, int wr, int wc, int fr, int fq) const {
        asm volatile("" : "+v"(fr), "+v"(fq));
        const int cb = wc * 32 + fq * 8;
        EPI_LOOP { const size_t off = (size_t)(u.pm * 256 + EPI_ROW) * 2048 + u.pn * 256 + cb;
#pragma unroll
            for (int bj = 0; bj < 2; ++bj) { f32x4 g0, g1, p0, p1; unpack8(*(const u32x4*)(GB + off + bj * 128), g0, g1); unpack8(*(const u32x4*)(MIXP + off + bj * 128), p0, p1);
                *(u32x4*)(MIXIN + off + bj * 128) = pack8(acc[ai][bj][m][0] * g0 + p0, acc[ai][bj][m][1] * g1 + p1); }
            EPI_FENCE; }
    }
};
struct EpiF32 {
    bf16_t* C;
    __device__ __forceinline__ void operator()(Acc& acc, const Unit& u, int wr, int wc, int fr, int fq) const {
        asm volatile("" : "+v"(fr), "+v"(fq));
        const int cb = wc * 32 + fq * 8;
        EPI_LOOP { bf16_t* base = C + (size_t)(u.pm * 256 + EPI_ROW) * 2048 + u.pn * 256 + cb;
#pragma unroll
            for (int bj = 0; bj < 2; ++bj) *(u32x4*)(base + bj * 128) = pack8(acc[ai][bj][m][0], acc[ai][bj][m][1]); }
    }
};
struct EpiGU {
    bf16_t* ACT; const float* bgu; int skip;
    __device__ __forceinline__ void operator()(Acc& acc, const Unit& u, int wr, int wc, int fr, int fq) const {
        asm volatile("" : "+v"(fr), "+v"(fq));
        if (skip) return;
        const int cb = wc * 32 + fq * 8, col = u.pn * 128 + cb; const float* bg = bgu + (size_t)u.aux * 4096 + col;
        const f32x4 bg0 = *(const f32x4*)bg, bg1 = *(const f32x4*)(bg + 4), bu0 = *(const f32x4*)(bg + 2048), bu1 = *(const f32x4*)(bg + 2052);
        EPI_LOOP { f32x4 v[2];
#pragma unroll
            for (int n = 0; n < 2; ++n)
#pragma unroll
                for (int j = 0; j < 4; ++j) { const float gt = fminf(acc[ai][0][m][n][j] * GU_UNSCALE + (n ? bg1[j] : bg0[j]), 7.0f); const float up = fminf(fmaxf(acc[ai][1][m][n][j] * GU_UNSCALE + (n ? bu1[j] : bu0[j]), -7.0f), 7.0f);
                    v[n][j] = (up + 1.0f) * gt * sigmoidf_(1.702f * gt); }
            u32x2 w8; w8.x = pk4_fp8(v[0][0], v[0][1], v[0][2], v[0][3], A8_SCALE); w8.y = pk4_fp8(v[1][0], v[1][1], v[1][2], v[1][3], A8_SCALE);
            *(u32x2*)((unsigned char*)ACT + (size_t)(u.pm * 256 + EPI_ROW) * 2048 + col) = w8; EPI_FENCE; }
    }
};
struct EpiDown {
    bf16_t* YS; const float* bd;
    __device__ __forceinline__ void operator()(Acc& acc, const Unit& u, int wr, int wc, int fr, int fq) const {
        asm volatile("" : "+v"(fr), "+v"(fq));
        const int cb = wc * 32 + fq * 8; const float* bp = bd + (size_t)u.aux * 2048 + u.pn * 256 + cb;
        f32x4 bv[2][2];
#pragma unroll
        for (int bj = 0; bj < 2; ++bj) { bv[bj][0] = *(const f32x4*)(bp + bj * 128); bv[bj][1] = *(const f32x4*)(bp + bj * 128 + 4); }
        EPI_LOOP { bf16_t* base = YS + (size_t)(u.pm * 256 + EPI_ROW) * 2048 + u.pn * 256 + cb;
#pragma unroll
            for (int bj = 0; bj < 2; ++bj) *(u32x4*)(base + bj * 128) = pack8(acc[ai][bj][m][0] * DN_UNSCALE + bv[bj][0], acc[ai][bj][m][1] * DN_UNSCALE + bv[bj][1]); }
    }
};

namespace att {
constexpr int NW = 8, QBLK = 32, KVBLK = 64;
constexpr float THR = 8.f;
constexpr int SHM_V = KVBLK * 128 * 2, SHM_KN = KVBLK * 128 * 2, SHM_KR = KVBLK * 64 * 2, NVB = 3, SHM_ATTN = NVB * SHM_V + 2 * SHM_KN + 2 * SHM_KR + NW * 64 * 4;
#define KSWZ(row, colB) ((row) * 256 + ((colB) ^ (((row) & 15) << 4)))
#define KSWZR(row, colB) ((row) * 128 + ((colB) ^ ((((row) >> 1) & 7) << 4)))
#define SBAR() __builtin_amdgcn_sched_barrier(0)
__device__ __forceinline__ int crow(int r, int hi) { return (r & 3) + 8 * (r >> 2) + 4 * hi; }
__device__ __forceinline__ void partialSM(f32x16& p0, f32x16& p1, float& m_reg, float& mn, float& alpha) {
    constexpr float C = 1.4426950408889634f;
    float pmax = p0[0];
#pragma unroll
    for (int r = 1; r < 16; ++r) pmax = fmaxf(pmax, p0[r]);
#pragma unroll
    for (int r = 0; r < 16; ++r) pmax = fmaxf(pmax, p1[r]);
    { auto rr = __builtin_amdgcn_permlane32_swap(__float_as_uint(pmax), __float_as_uint(pmax), false, false);
      pmax = fmaxf(__uint_as_float(rr[0]), __uint_as_float(rr[1])); }
    if (__builtin_expect(__all(pmax - m_reg <= THR), 1)) { mn = m_reg; alpha = 1.f; }
    else { mn = fmaxf(m_reg, pmax); alpha = __builtin_amdgcn_exp2f((m_reg - mn) * C); m_reg = mn; }
    const float mnC = -mn * C;
#pragma unroll
    for (int r = 0; r < 16; ++r) p0[r] = fmaf(p0[r], C, mnC);
#pragma unroll
    for (int r = 0; r < 16; ++r) p1[r] = fmaf(p1[r], C, mnC);
#pragma unroll
    for (int r = 0; r < 16; ++r) p0[r] = __builtin_amdgcn_exp2f(p0[r]);
}
__device__ __forceinline__ void finishSM(f32x16& p0, f32x16& p1, float alpha, float& l_reg, bf16x8& pa0, bf16x8& pa1, bf16x8& pa2, bf16x8& pa3) {
#pragma unroll
    for (int r = 0; r < 16; ++r) p1[r] = __builtin_amdgcn_exp2f(p1[r]);
    float ps = 0;
#pragma unroll
    for (int r = 0; r < 16; ++r) ps += p0[r];
#pragma unroll
    for (int r = 0; r < 16; ++r) ps += p1[r];
    { auto rr = __builtin_amdgcn_permlane32_swap(__float_as_uint(ps), __float_as_uint(ps), false, false);
      ps = __uint_as_float(rr[0]) + __uint_as_float(rr[1]); }
    l_reg = l_reg * alpha + ps;
#define PK4(P, BASE, OUT) do { unsigned a0 = cvt_pk_bf16(P[BASE + 0], P[BASE + 1]), a1 = cvt_pk_bf16(P[BASE + 2], P[BASE + 3]);   \
    unsigned b0 = cvt_pk_bf16(P[BASE + 4], P[BASE + 5]), b1 = cvt_pk_bf16(P[BASE + 6], P[BASE + 7]);                              \
    auto r0 = __builtin_amdgcn_permlane32_swap(a0, b0, false, false); auto r1 = __builtin_amdgcn_permlane32_swap(a1, b1, false, false); \
    u32x4 w = {r0[0], r1[0], r0[1], r1[1]}; OUT = *reinterpret_cast<bf16x8*>(&w); } while (0)
    PK4(p0, 0, pa0); PK4(p0, 8, pa1); PK4(p1, 0, pa2); PK4(p1, 8, pa3);
#undef PK4
}
__device__ __forceinline__ void qkt(f32x16& p0, f32x16& p1, const char* Kns, const char* Krs, const bf16x8* qr, int r32, int hi) {
    p0 = f32x16{}; p1 = f32x16{};
#pragma unroll
    for (int d0 = 0; d0 < 12; ++d0) { const int cb = ((d0 & 7) * 16 + hi * 8) * 2;
        const bf16x8 b0 = *reinterpret_cast<const bf16x8*>(d0 < 8 ? Kns + KSWZ(r32, cb) : Krs + KSWZR(r32, cb));
        const bf16x8 b1 = *reinterpret_cast<const bf16x8*>(d0 < 8 ? Kns + KSWZ(32 + r32, cb) : Krs + KSWZR(32 + r32, cb));
        p0 = __builtin_amdgcn_mfma_f32_32x32x16_bf16(b0, qr[d0], p0, 0, 0, 0);
        p1 = __builtin_amdgcn_mfma_f32_32x32x16_bf16(b1, qr[d0], p1, 0, 0, 0); }
}
__device__ __forceinline__ int v_st(int k, int c) { const int kk = (k & ~0xC) | ((k & 4) << 1) | ((k & 8) >> 1); return ((kk >> 3) * 4 + (c >> 5)) * 512 + ((kk & 7) * 32 + (c & 31)) * 2; }
__device__ __forceinline__ int v_rd_base(int lane) { return ((lane & 3) << 3) | (((lane >> 2) & 3) << 6) | (((lane >> 4) & 1) << 5) | (((lane >> 5) & 1) << 8); }
constexpr int v_rd_off(int d0, int ks, int half) { return d0 * 512 + ks * 4096 + half * 2048; }
template <int OFF> __device__ __forceinline__ s16x4 tr_read(int vb) {
    s16x4 r; asm volatile("ds_read_b64_tr_b16 %0, %1 offset:%2" : "=&v"(r) : "v"(vb), "i"(OFF) : "memory"); return r;
}
template <int D0> __device__ __forceinline__ void pv_one(f32x16& od, int vb, bf16x8 pa0, bf16x8 pa1, bf16x8 pa2, bf16x8 pa3) {
    const s16x4 l0 = tr_read<v_rd_off(D0, 0, 0)>(vb), h0 = tr_read<v_rd_off(D0, 0, 1)>(vb), l1 = tr_read<v_rd_off(D0, 1, 0)>(vb), h1 = tr_read<v_rd_off(D0, 1, 1)>(vb);
    const s16x4 l2 = tr_read<v_rd_off(D0, 2, 0)>(vb), h2 = tr_read<v_rd_off(D0, 2, 1)>(vb), l3 = tr_read<v_rd_off(D0, 3, 0)>(vb), h3 = tr_read<v_rd_off(D0, 3, 1)>(vb);
    asm volatile("s_waitcnt lgkmcnt(0)" ::: "memory"); SBAR();
#define PKV(L, H) (bf16x8){L[0], L[1], L[2], L[3], H[0], H[1], H[2], H[3]}
    od = __builtin_amdgcn_mfma_f32_32x32x16_bf16(pa0, PKV(l0, h0), od, 0, 0, 0);
    od = __builtin_amdgcn_mfma_f32_32x32x16_bf16(pa1, PKV(l1, h1), od, 0, 0, 0);
    od = __builtin_amdgcn_mfma_f32_32x32x16_bf16(pa2, PKV(l2, h2), od, 0, 0, 0);
    od = __builtin_amdgcn_mfma_f32_32x32x16_bf16(pa3, PKV(l3, h3), od, 0, 0, 0);
#undef PKV
}
__device__ __forceinline__ void pv_d0(f32x16* o, int vb, bf16x8 pa0, bf16x8 pa1, bf16x8 pa2, bf16x8 pa3) {
    pv_one<0>(o[0], vb, pa0, pa1, pa2, pa3); pv_one<1>(o[1], vb, pa0, pa1, pa2, pa3); pv_one<2>(o[2], vb, pa0, pa1, pa2, pa3); pv_one<3>(o[3], vb, pa0, pa1, pa2, pa3);
}
__device__ __forceinline__ void attn_unit(const bf16_t* __restrict__ Qn, const bf16_t* __restrict__ Qr, const bf16_t* __restrict__ Kn, const bf16_t* __restrict__ Kr,
                                          const bf16_t* __restrict__ Vh, bf16_t* __restrict__ Ob, int seq, char* lds) {
    const int tid = threadIdx.x, wid = __builtin_amdgcn_readfirstlane(tid >> 6), lane = tid & 63, r32 = lane & 31, hi = lane >> 5;
    char* V_lds = lds; char* Kn_lds = lds + NVB * SHM_V; char* Kr_lds = Kn_lds + 2 * SHM_KN;
    float* ws = (float*)(Kr_lds + 2 * SHM_KR) + wid * 64; float* li_l = ws; float* al_l = ws + 32;
    float m_reg = -1e30f, l_reg = 0; f32x16 o[4] = {}; bf16x8 qr[12];
    { const bf16_t* q0 = Qn + (long)(wid * QBLK + r32) * 1024 + hi * 8; const bf16_t* q1 = Qr + (long)(wid * QBLK + r32) * 512 + hi * 8;
#pragma unroll
      for (int d0 = 0; d0 < 8; ++d0) qr[d0] = *reinterpret_cast<const bf16x8*>(q0 + d0 * 16);
#pragma unroll
      for (int d0 = 0; d0 < 4; ++d0) qr[8 + d0] = *reinterpret_cast<const bf16x8*>(q1 + d0 * 16); }
    const int vb0 = (int)(uintptr_t)V_lds + v_rd_base(lane);
    unsigned offV[2], offKn[2], offKr;
#pragma unroll
    for (int t = 0; t < 2; ++t) {
        { const int sub = 2 * (2 * wid + t) + (lane >> 5), kk = (sub >> 2) * 8 + ((lane & 31) >> 2), k = (kk & ~0xC) | ((kk & 4) << 1) | ((kk & 8) >> 1), c = (sub & 3) * 32 + (lane & 3) * 8; offV[t] = (unsigned)(k * 1024 + c) * 2u; }
        { const int row = 4 * (2 * wid + t) + (lane >> 4), colB = ((lane & 15) * 16) ^ ((row & 15) << 4); offKn[t] = (unsigned)(row * 1024) * 2u + (unsigned)colB; } }
    { const int row = 8 * wid + (lane >> 3), colB = ((lane & 7) * 16) ^ (((row >> 1) & 7) << 4); offKr = (unsigned)(row * 64) * 2u + (unsigned)colB; }
#define LASP(p) ((LAS unsigned*)(unsigned)(uintptr_t)(p))
#define SLOAD(k0, b, bv) do { _Pragma("unroll") for (int t = 0; t < 2; ++t) { \
        __builtin_amdgcn_global_load_lds((const unsigned*)((const char*)Vh + (size_t)(k0) * 2048 + offV[t]), LASP(V_lds + (bv) * SHM_V + (2 * wid + t) * 1024), 16, 0, 0); \
        __builtin_amdgcn_global_load_lds((const unsigned*)((const char*)Kn + (size_t)(k0) * 2048 + offKn[t]), LASP(Kn_lds + (b) * SHM_KN + (2 * wid + t) * 1024), 16, 0, 0); } \
        __builtin_amdgcn_global_load_lds((const unsigned*)((const char*)Kr + (size_t)(k0) * 128 + offKr), LASP(Kr_lds + (b) * SHM_KR + wid * 1024), 16, 0, 0); } while (0)
#define SWAIT() asm volatile("s_waitcnt vmcnt(0)" ::: "memory")
#define RESC(a) do { if (__any((a) < 1.f)) { if (hi == 0) al_l[r32] = (a); asm volatile("s_waitcnt lgkmcnt(0)" ::: "memory"); \
    _Pragma("unroll") for (int d = 0; d < 4; ++d) _Pragma("unroll") for (int r = 0; r < 16; ++r) o[d][r] *= al_l[crow(r, hi)]; } } while (0)
    f32x16 p0, p1; float mn, al; bf16x8 pa0, pa1, pa2, pa3; const int NT = seq / KVBLK;
    SLOAD(0, 0, 0); SWAIT(); __syncthreads();
    if (wid < 4) {
        int bv = 0;
        for (int j = 0; j < NT; ++j) {
            const int buf = j & 1, bvn = bv == NVB - 1 ? 0 : bv + 1;
            if (j + 1 < NT) SLOAD((j + 1) * KVBLK, buf ^ 1, bvn);
            SBAR(); qkt(p0, p1, Kn_lds + buf * SHM_KN, Kr_lds + buf * SHM_KR, qr, r32, hi);
            partialSM(p0, p1, m_reg, mn, al);
            RESC(al);
            finishSM(p0, p1, al, l_reg, pa0, pa1, pa2, pa3); SBAR();
            pv_d0(o, vb0 + bv * SHM_V, pa0, pa1, pa2, pa3);
            SWAIT();
            __syncthreads();
            bv = bvn;
        }
    } else {
        int bv = 0, bvp = 0;
        for (int j = 0; j < NT; ++j) {
            const int buf = j & 1, bvn = bv == NVB - 1 ? 0 : bv + 1;
            if (j + 1 < NT) SLOAD((j + 1) * KVBLK, buf ^ 1, bvn);
            if (j > 0) { SBAR(); pv_d0(o, vb0 + bvp * SHM_V, pa0, pa1, pa2, pa3); SBAR(); }
            SBAR(); qkt(p0, p1, Kn_lds + buf * SHM_KN, Kr_lds + buf * SHM_KR, qr, r32, hi);
            partialSM(p0, p1, m_reg, mn, al);
            RESC(al);
            finishSM(p0, p1, al, l_reg, pa0, pa1, pa2, pa3); SBAR();
            SWAIT();
            __syncthreads();
            bvp = bv; bv = bvn;
        }
        SBAR(); pv_d0(o, vb0 + bvp * SHM_V, pa0, pa1, pa2, pa3);
    }
    if (hi == 0) li_l[r32] = l_reg; asm volatile("s_waitcnt lgkmcnt(0)" ::: "memory");
    float rli[16];
#pragma unroll
    for (int r = 0; r < 16; ++r) rli[r] = __builtin_amdgcn_rcpf(li_l[crow(r, hi)]);
    bf16_t* Ow = Ob + (long)(wid * QBLK) * 1024;
#pragma unroll
    for (int r = 0; r < 16; ++r) { const int orow = crow(r, hi);
#pragma unroll
        for (int d0 = 0; d0 < 4; ++d0) Ow[(long)orow * 1024 + d0 * 32 + r32] = (bf16_t)(cvt_pk_bf16(o[d0][r] * rli[r], 0.f) & 0xffffu); }
#undef SLOAD
#undef LASP
#undef SWAIT
#undef RESC
}
}

struct Args { const float* in[26]; float* out; unsigned char* ws; int ph_lo, ph_hi; };
enum { PH_SETUP = 0, PH_H, PH_INPROJ, PH_INPROJ_V, PH_KT, PH_CHAIN, PH_MLAQ, PH_MLAKV, PH_GA, PH_ATTN, PH_GC, PH_MIXA, PH_GN, PH_MIXB, PH_MIX, PH_ROUTER, PH_DISPATCH, PH_GU, PH_DOWN, PH_COMBINE, NPH };
enum { I_X = 0, I_C, I_POS, I_WADA, I_BADA, I_GPREM, I_GPOSTM, I_GPREF, I_GPOSTF, I_WIN, I_QAN, I_WQB, I_KVAN, I_WKVB, I_WMLAO, I_DECF, I_DECB, I_RETGN, I_WRETO, I_WOUT, I_WROUTER, I_BROUTER, I_WGU, I_BGU, I_WDOWN, I_BDOWN };

__device__ __forceinline__ int src_in(int r) {
    if (r < 1024) return r;
    if (r < 1088) { const int j = r - 1024; return 1024 + (j >> 1) + 32 * (j & 1); }
    if (r < 1280) return -1;
    if (r < N_IN_NAT) { const int g = (r - 1280) >> 11, off = (r - 1280) & 2047; const int base = g == 0 ? 1088 : (g == 1 ? 3136 : (g == 2 ? 7232 : (g == 3 ? 9280 : 11328))); return base + off; }
    return 5184 + (r - N_IN_NAT);
}
__device__ __forceinline__ int src_qb(int r) { if (r < 1024) return (r >> 7) * 192 + (r & 127); const int j = r - 1024, h = j >> 6, jj = j & 63; return h * 192 + 128 + (jj >> 1) + 32 * (jj & 1); }
__device__ __forceinline__ int src_kvb(int r) { if (r < 1024) return (r >> 7) * 256 + (r & 127); const int j = r - 1024; return (j >> 7) * 256 + 128 + (j & 127); }
__device__ __forceinline__ int src_gu(int r) { const int t = r >> 8, rr = r & 255; return rr < 128 ? 128 * t + rr : 2048 + 128 * t + rr - 128; }

__device__ __forceinline__ void cvt_item(const float* __restrict__ W, int ldw, int K, bf16_t* __restrict__ WT, const float* __restrict__ kscale, int sc, int k0, int r0, LAS float* scr, int lane) {
    float v[64];
    const float* wp = W + (size_t)k0 * ldw + (sc >= 0 ? sc : 0);
#pragma unroll
    for (int i = 0; i < 64; ++i) v[i] = wp[(size_t)i * ldw];
    if (sc < 0) {
#pragma unroll
        for (int i = 0; i < 64; ++i) v[i] = 0.f;
    }
    if (kscale) {
#pragma unroll
        for (int i = 0; i < 64; ++i) v[i] *= kscale[k0 + i];
    }
#pragma unroll
    for (int i = 0; i < 64; ++i) scr[i * 65 + lane] = v[i];
    asm volatile("s_waitcnt lgkmcnt(0)" ::: "memory");
    const int c = lane & 7;
#pragma unroll
    for (int j = 0; j < 8; ++j) { const int n = (lane >> 3) + 8 * j; const LAS float* s = scr + (8 * c) * 65 + n;
        u32x4 o; o.x = cvt_pk_bf16(s[0 * 65], s[1 * 65]); o.y = cvt_pk_bf16(s[2 * 65], s[3 * 65]); o.z = cvt_pk_bf16(s[4 * 65], s[5 * 65]); o.w = cvt_pk_bf16(s[6 * 65], s[7 * 65]);
        *(u32x4*)(WT + (size_t)(r0 + n) * K + k0 + 8 * c) = o; }
    asm volatile("s_waitcnt lgkmcnt(0)" ::: "memory");
}

constexpr int XT_NT_GU = 32 * 16 * 16, XT_NT_ALL = XT_NT_GU + 32 * 16 * 8;
__device__ __forceinline__ void xt_convert_tiles(int q0, const int qs, const int qe, const float* __restrict__ wgu, const float* __restrict__ wdn, bf16_t* WT_GU, bf16_t* WT_DOWN, LAS unsigned char* lds, const int lane, const int wave) {
    constexpr int NT_GU = XT_NT_GU, TS = 144;
    f32x4 va[16], vb[16], vc[16];
#define XT_SRC(q_, kk_) ((q_) < NT_GU ? wgu + ((size_t)((q_) >> 8) * 2048 + (((q_) >> 4) & 15) * 128 + 16 * wave + (kk_)) * 4096 + (lane < 32 ? 128 * ((q_) & 15) + 4 * lane : 2048 + 128 * ((q_) & 15) + 4 * lane - 128) \
                                  : wdn + ((size_t)(((q_) - NT_GU) >> 7) * 2048 + ((((q_) - NT_GU) >> 3) & 15) * 128 + 16 * wave + (kk_)) * 2048 + 256 * (((q_) - NT_GU) & 7) + 4 * lane)
#define XT_LOAD(v_, q_) do { const float* _p = XT_SRC(q_, 0); const size_t _ld = (q_) < NT_GU ? 4096 : 2048; _Pragma("unroll") for (int kk = 0; kk < 16; ++kk) v_[kk] = __builtin_nontemporal_load((const f32x4*)(_p + kk * _ld)); } while (0)
#define XT_PROC(v_, q_, buf_) do { LAS unsigned char* _T = lds + (buf_) * (256 * TS); \
        _Pragma("unroll") for (int i = 0; i < 4; ++i) { u32x4 w0; \
            w0.x = pk4_fp8(v_[0][i], v_[1][i], v_[2][i], v_[3][i], W8_SCALE); w0.y = pk4_fp8(v_[4][i], v_[5][i], v_[6][i], v_[7][i], W8_SCALE); \
            w0.z = pk4_fp8(v_[8][i], v_[9][i], v_[10][i], v_[11][i], W8_SCALE); w0.w = pk4_fp8(v_[12][i], v_[13][i], v_[14][i], v_[15][i], W8_SCALE); \
            *(LAS u32x4*)(_T + (4 * lane + i) * TS + 16 * wave) = w0; } \
        __syncthreads(); \
        unsigned char* _d = (q_) < NT_GU ? (unsigned char*)WT_GU + ((size_t)((q_) >> 8) * 4096 + 256 * ((q_) & 15)) * 2048 + (((q_) >> 4) & 15) * 128 \
                 : (unsigned char*)WT_DOWN + ((size_t)(((q_) - NT_GU) >> 7) * 2048 + 256 * (((q_) - NT_GU) & 7)) * 2048 + ((((q_) - NT_GU) >> 3) & 15) * 128; \
        _Pragma("unroll") for (int j = 0; j < 4; ++j) { const int row = 32 * wave + 8 * j + (lane >> 3); \
            const u32x4 o = *(const LAS u32x4*)(_T + row * TS + (lane & 7) * 16); __builtin_nontemporal_store(o, (u32x4*)(_d + (size_t)row * 2048 + (lane & 7) * 16)); } } while (0)
    int q = q0;
    if (q < qe) XT_LOAD(va, q);
    if (q + qs < qe) XT_LOAD(vb, q + qs);
    while (q < qe) {
        const int q1 = q + qs, q2 = q1 + qs, q3 = q2 + qs, q4 = q3 + qs;
        if (q2 < qe) XT_LOAD(vc, q2);
        XT_PROC(va, q, 0);
        if (q1 >= qe) break;
        if (q3 < qe) XT_LOAD(va, q3);
        XT_PROC(vb, q1, 1);
        if (q2 >= qe) break;
        if (q4 < qe) XT_LOAD(vb, q4);
        XT_PROC(vc, q2, 2);
        q = q3;
    }
    __syncthreads();
#undef XT_SRC
#undef XT_LOAD
#undef XT_PROC
}
__host__ __device__ constexpr bool is_seam(int k) { return k == PH_SETUP || k == PH_H || k == PH_INPROJ_V || k == PH_KT || k == PH_GA || k == PH_ATTN || k == PH_MIXA || k == PH_MIXB || k == PH_MIX || k == PH_ROUTER || k == PH_DISPATCH || k == PH_GU || k == PH_DOWN; }
__host__ __device__ constexpr int seam_after(int ph) { int k = ph; while (k < NPH && !is_seam(k)) ++k; return k; }
__host__ __device__ constexpr int seam_before(int ph) { int k = ph - 1; while (k >= 0 && !is_seam(k)) --k; return k; }
__device__ __forceinline__ const void* larg(volatile LAS unsigned long long* L, int i) {
    const unsigned long long v = L[i]; const unsigned l0 = __builtin_amdgcn_readfirstlane((unsigned)v), h0 = __builtin_amdgcn_readfirstlane((unsigned)(v >> 32));
    return (const void*)(const __attribute__((address_space(1))) void*)(((unsigned long long)h0 << 32) | l0);
}
__global__ void __launch_bounds__(512, 2) fwd_kernel(Args args) {
    extern __shared__ __attribute__((aligned(16))) unsigned char lds_raw[];
    LAS unsigned char* lds = (LAS unsigned char*)lds_raw;
    volatile LAS unsigned* MISC = (volatile LAS unsigned*)(lds + MISC_OFF);
    const int tid = threadIdx.x;
    const int G = gridDim.x, bx = blockIdx.x, NGW = G * 8;
    volatile LAS unsigned long long* LARG = (volatile LAS unsigned long long*)(lds + LARG_OFF);
    const int lo = args.ph_lo, hi = args.ph_hi;
    for (int u = tid; u < (LDS_BYTES - CTRL_OFF) / 4; u += 512) ((LAS unsigned*)(lds + CTRL_OFF))[u] = 0u;
    __syncthreads();
    if (tid == 0) {
#pragma unroll
        for (int i = 0; i < 26; ++i) LARG[i] = (unsigned long long)args.in[i];
        LARG[26] = (unsigned long long)args.out; LARG[27] = (unsigned long long)args.ws;
    }
    __syncthreads();
    unsigned bar_x = 0u;
    if (hi - lo > 1) bar_x = xcd_barrier_post((unsigned*)(args.ws + WS_CTL) + CW_BAR, MISC + 8).x;
#ifdef PH_ONLY
#define IN(k) ((k) == PH_ONLY && lo <= (k) && (k) < hi)
#else
#define IN(k) (lo <= (k) && (k) < hi)
#endif
#define SEAM(k) do { if (lo <= (k) && (k) + 1 < hi) { XcdBarrier _b; _b.bar = (unsigned*)((unsigned char*)larg(LARG, 27) + WS_CTL) + CW_BAR; _b.x = bar_x; _b.st = MISC + 8; xcd_barrier(_b); } if (STAMP_PHASE >= 0) { const unsigned long long _t = __builtin_amdgcn_s_memrealtime(); if (seam_after(STAMP_PHASE) == (k)) st_dt = _t - st_t0; if (seam_before(STAMP_PHASE) == (k)) st_t0 = _t; } } while (0)
#define INP(i) ((const float*)larg(LARG, (i)))
#ifndef REP_PHASE
#define REP_PHASE (-1)
#endif
#define NREP(k) ((k) == REP_PHASE ? 2 : 1)
#ifndef STAMP_PHASE
#define STAMP_PHASE (-1)
#endif
#ifndef STAMP_MUL
#define STAMP_MUL 4
#endif
    unsigned long long st_t0 = (STAMP_PHASE >= 0 && seam_before(STAMP_PHASE) < 0) ? __builtin_amdgcn_s_memrealtime() : 0ull, st_dt = 0ull;
#define PTRS \
    int tid = threadIdx.x; asm volatile("" : "+v"(tid)); const int lane = tid & 63, wave = __builtin_amdgcn_readfirstlane(tid >> 6), gw = bx * 8 + wave; (void)lane; (void)gw; \
    unsigned char* const ws = (unsigned char*)larg(LARG, 27); unsigned* const ctl = (unsigned*)(ws + WS_CTL); float* const outp = (float*)larg(LARG, 26); \
    float* const ada = (float*)(ctl + CW_ADA); float* const SSQP = (float*)(ws + WS_SSQP); \
    bf16_t* const WT_IN = (bf16_t*)(ws + WS_WT_IN); bf16_t* const WT_QB = (bf16_t*)(ws + WS_WT_QB); bf16_t* const WT_KVB = (bf16_t*)(ws + WS_WT_KVB); bf16_t* const WT_MLAO = (bf16_t*)(ws + WS_WT_MLAO); \
    bf16_t* const WT_RETO = (bf16_t*)(ws + WS_WT_RETO); bf16_t* const WT_OUT = (bf16_t*)(ws + WS_WT_OUT); bf16_t* const WT_GU = (bf16_t*)(ws + WS_WT_GU); bf16_t* const WT_DOWN = (bf16_t*)(ws + WS_WT_DOWN); \
    float* const CS_RET = (float*)(ws + WS_CS_RET); float* const CS_MLA = (float*)(ws + WS_CS_MLA); \
    bf16_t* const Hb = (bf16_t*)(ws + WS_H); bf16_t* const QL = (bf16_t*)(ws + WS_QL); bf16_t* const CKV = (bf16_t*)(ws + WS_CKV); bf16_t* const KR = (bf16_t*)(ws + WS_KR); \
    bf16_t* const ACAT = (bf16_t*)(ws + WS_ACAT); bf16_t* const BCAT = (bf16_t*)(ws + WS_BCAT); bf16_t* const KROT = (bf16_t*)(ws + WS_KROT); bf16_t* const KZTF = (bf16_t*)(ws + WS_KZTF); bf16_t* const KZTB = (bf16_t*)(ws + WS_KZTB); \
    bf16_t* const SG = (bf16_t*)(ws + WS_SG); bf16_t* const GA = (bf16_t*)(ws + WS_GA); bf16_t* const GB = (bf16_t*)(ws + WS_GB); \
    bf16_t* const QN = (bf16_t*)(ws + WS_QN); bf16_t* const QR = (bf16_t*)(ws + WS_QR); bf16_t* const KN = (bf16_t*)(ws + WS_KN); bf16_t* const VV = (bf16_t*)(ws + WS_VV); bf16_t* const OA = (bf16_t*)(ws + WS_OA); \
    float* const ORET = (float*)(ws + WS_ORET); bf16_t* const OB = (bf16_t*)(ws + WS_OB); bf16_t* const MIXP = (bf16_t*)(ws + WS_MIXP); bf16_t* const MIXIN = (bf16_t*)(ws + WS_MIXIN); float* const MIX = (float*)(ws + WS_MIX); \
    bf16_t* const H2 = (bf16_t*)(ws + WS_H2); int* const TOPI = (int*)(ws + WS_TOPI); float* const TOPW = (float*)(ws + WS_TOPW); int* const DEST = (int*)(ws + WS_DEST); int* const TILE = (int*)(ws + WS_TILE); float* const DECTAB = (float*)(ws + WS_DECTAB); \
    bf16_t* const XS = (bf16_t*)(ws + WS_XS); bf16_t* const ACT = (bf16_t*)(ws + WS_ACT); bf16_t* const YS = (bf16_t*)(ws + WS_YS); \
    (void)ctl; (void)outp; (void)ada; (void)SSQP; (void)WT_IN; (void)WT_QB; (void)WT_KVB; (void)WT_MLAO; (void)WT_RETO; (void)WT_OUT; (void)WT_GU; (void)WT_DOWN; (void)CS_RET; (void)CS_MLA; (void)Hb; (void)QL; (void)CKV; (void)KR; \
    (void)ACAT; (void)BCAT; (void)KROT; (void)KZTF; (void)KZTB; (void)SG; (void)GA; (void)GB; (void)QN; (void)QR; (void)KN; (void)VV; (void)OA; (void)ORET; (void)OB; (void)MIXP; (void)MIXIN; (void)MIX; (void)H2; (void)TOPI; (void)TOPW; (void)DEST; (void)TILE; (void)DECTAB; (void)XS; (void)ACT; (void)YS;

    if (IN(PH_SETUP)) for (int rep = 0; rep < NREP(PH_SETUP); ++rep) {
        PTRS
        if (bx == 0 && tid < 16) DECTAB[tid] = log2_sigmoid(tid < 8 ? INP(I_DECF)[tid] : INP(I_DECB)[tid - 8]);
        {
            const float* wada = INP(I_WADA); const float* cvec = INP(I_C); float* adap = (float*)(ws + WS_ADAP);
            for (int it = gw; it < 192 * 8; it += NGW) {
                const int jb = it % 192, kp = it / 192, j = jb * 64 + lane;
                float a0 = 0.f, a1 = 0.f, a2 = 0.f, a3 = 0.f;
#pragma nounroll
                for (int k0 = kp * 256; k0 < kp * 256 + 256; k0 += 32) {
                    float w[32]; const float* wp = wada + (size_t)k0 * 12288 + j;
#pragma unroll
                    for (int i = 0; i < 32; ++i) { w[i] = __builtin_nontemporal_load(wp); wp += 12288; asm volatile("" : "+v"(wp)); }
#pragma unroll
                    for (int i = 0; i < 32; ++i) { a0 += w[i] * cvec[k0 + i]; a1 += w[i] * cvec[2048 + k0 + i]; a2 += w[i] * cvec[4096 + k0 + i]; a3 += w[i] * cvec[6144 + k0 + i]; }
                }
                float* o = adap + (size_t)kp * 49152 + j;
                o[0] = a0; o[12288] = a1; o[24576] = a2; o[36864] = a3;
            }
        }
        {
            const int* pos = (const int*)INP(I_POS);
            for (int i = bx * 512 + tid; i < T * 160; i += G * 512) {
                const int tok = i / 160, f = i % 160; const float p = (float)pos[tok];
                float inv; float* dst;
                if (f < 128) { inv = 1.0f / powf(10000.0f, (float)f / 128.0f); dst = CS_RET + (size_t)tok * 256 + f * 2; }
                else { inv = 1.0f / powf(10000.0f, (float)(f - 128) / 32.0f); dst = CS_MLA + (size_t)tok * 64 + (f - 128) * 2; }
                float s, c; sincosf(p * inv, &s, &c); dst[0] = c; dst[1] = s;
            }
        }
        {
            LAS float* scr = (LAS float*)(lds + wave * 16640);
            constexpr int I_IN = (N_IN_ALL / 64) * 32, I_QB = 24 * 8, I_KVB = 32 * 8, I_MLAO = 32 * 16, I_SQ = 32 * 32;
            constexpr int NITEMS = I_IN + I_QB + I_KVB + I_MLAO + 2 * I_SQ;
            unsigned* cq = ctl + CW_CVTQ + rep;
#define CVT_GRAB(dst) do { unsigned _v = 0u; if (lane == 0) _v = atomicAdd(cq, 8u); dst = (int)__builtin_amdgcn_readfirstlane(_v); } while (0)
#define CVT_DEC(r_, wp_, dst_, ks_, ldw_, K_, sc_) do { int r = (r_); const float* W_; bf16_t* WT_; const float* kq_ = nullptr; int nkb_, mat_; \
                if (r < I_IN) { W_ = INP(I_WIN); WT_ = WT_IN; ldw_ = 13376; K_ = 2048; nkb_ = 32; mat_ = 2; } \
                else if ((r -= I_IN) < I_QB) { W_ = INP(I_WQB); WT_ = WT_QB; kq_ = INP(I_QAN); ldw_ = 1536; K_ = 512; nkb_ = 8; mat_ = 3; } \
                else if ((r -= I_QB) < I_KVB) { W_ = INP(I_WKVB); WT_ = WT_KVB; kq_ = INP(I_KVAN); ldw_ = 2048; K_ = 512; nkb_ = 8; mat_ = 4; } \
                else if ((r -= I_KVB) < I_MLAO) { W_ = INP(I_WMLAO); WT_ = WT_MLAO; ldw_ = 2048; K_ = 1024; nkb_ = 16; mat_ = 1; } \
                else if ((r -= I_MLAO) < I_SQ) { W_ = INP(I_WRETO); WT_ = WT_RETO; ldw_ = 2048; K_ = 2048; nkb_ = 32; mat_ = 1; } \
                else { r -= I_SQ; W_ = INP(I_WOUT); WT_ = WT_OUT; ldw_ = 2048; K_ = 2048; nkb_ = 32; mat_ = 1; } \
                const int q4_ = r >> 2, kb_ = q4_ % nkb_, nb_ = (q4_ / nkb_) * 4 + (r & 3), rr_ = nb_ * 64 + lane; \
                sc_ = (mat_ == 1 ? rr_ : (mat_ == 2 ? src_in(rr_) : (mat_ == 3 ? src_qb(rr_) : src_kvb(rr_)))); \
                wp_ = W_ + (size_t)(kb_ * 64) * ldw_ + (sc_ >= 0 ? sc_ : 0); dst_ = WT_ + (size_t)(nb_ * 64) * K_ + kb_ * 64; ks_ = kq_ ? kq_ + kb_ * 64 : nullptr; \
                if (mat_ == 2 && nb_ >= 84 && nb_ < 180) { K_ = -1; dst_ = (bf16_t*)(ws + WS_WT8IN + (size_t)((nb_ - 84) * 64) * 2048 + kb_ * 64); } } while (0)
            float v[64];
            const float* wpc; bf16_t* dstc; const float* ksc; int ldwc, Kc, scc;
            const float* wpn = nullptr; bf16_t* dstn = nullptr; const float* ksn = nullptr; int ldwn = 0, Kn = 0, scn = 0;
            constexpr int QCH = 8; static_assert(NITEMS % QCH == 0, "queue chunk");
            int itc, itn, cend; CVT_GRAB(itc); itn = itc + 1; cend = itc + QCH;
            bool hc = itc < NITEMS;
            if (hc) { CVT_DEC(itc, wpc, dstc, ksc, ldwc, Kc, scc);
#pragma unroll
                for (int i = 0; i < 64; ++i) v[i] = __builtin_nontemporal_load(wpc + (size_t)i * ldwc); }
            while (hc) {
                const bool hn = itn < NITEMS;
                if (hn) CVT_DEC(itn, wpn, dstn, ksn, ldwn, Kn, scn);
                const bool need = (itn + 1 >= cend); unsigned raw_nn = 0u; if (need && lane == 0) raw_nn = atomicAdd(cq, (unsigned)QCH);
#pragma unroll
                for (int g = 0; g < 4; ++g) {
#pragma unroll
                    for (int i = 0; i < 16; ++i) { float x = scc >= 0 ? v[16 * g + i] : 0.f; if (ksc) x *= ksc[16 * g + i]; scr[(16 * g + i) * 65 + lane] = x; }
                    if (hn) {
#pragma unroll
                        for (int i = 0; i < 16; ++i) v[16 * g + i] = __builtin_nontemporal_load(wpn + (size_t)(16 * g + i) * ldwn); }
                }
                asm volatile("s_waitcnt lgkmcnt(0)" ::: "memory");
                const int c = lane & 7;
#pragma unroll
                for (int j = 0; j < 8; ++j) { const int n = (lane >> 3) + 8 * j; const LAS float* sp = scr + (8 * c) * 65 + n;
                    if (Kc < 0) { u32x2 o8; o8.x = pk4_fp8(sp[0 * 65], sp[1 * 65], sp[2 * 65], sp[3 * 65], W8_SCALE); o8.y = pk4_fp8(sp[4 * 65], sp[5 * 65], sp[6 * 65], sp[7 * 65], W8_SCALE);
                        *(u32x2*)((unsigned char*)dstc + (size_t)n * 2048 + 8 * c) = o8; }
                    else { u32x4 o; o.x = cvt_pk_bf16(sp[0 * 65], sp[1 * 65]); o.y = cvt_pk_bf16(sp[2 * 65], sp[3 * 65]); o.z = cvt_pk_bf16(sp[4 * 65], sp[5 * 65]); o.w = cvt_pk_bf16(sp[6 * 65], sp[7 * 65]);
                        __builtin_nontemporal_store(o, (u32x4*)(dstc + (size_t)n * Kc + 8 * c)); } }
                asm volatile("s_waitcnt lgkmcnt(0)" ::: "memory");
                wpc = wpn; dstc = dstn; ksc = ksn; ldwc = ldwn; Kc = Kn; scc = scn; hc = hn;
                if (need) { itn = (int)__builtin_amdgcn_readfirstlane(raw_nn); cend = itn + QCH; } else itn = itn + 1;
            }
#undef CVT_GRAB
#undef CVT_DEC
        }
    }
    SEAM(PH_SETUP);
    if (IN(PH_H)) for (int rep = 0; rep < NREP(PH_H); ++rep) {
        PTRS
        const float* g = INP(I_GPREM);
        {
            const float* adap = (const float*)(ws + WS_ADAP); const float* bada = INP(I_BADA); LAS float* AD = (LAS float*)lds;
            if (tid < 192) { const int idx = bx * 192 + tid; if (idx < 49152) { const int j = idx % 12288; float a = 0.f;
#pragma unroll
                for (int pq = 0; pq < 8; ++pq) a += adap[(size_t)pq * 49152 + idx];
                ada[idx] = a + bada[j]; } }
            for (int i = tid; i < 16384; i += 512) { const int b = i >> 12, col = i & 4095; float a = 0.f;
#pragma unroll
                for (int pq = 0; pq < 8; ++pq) a += adap[(size_t)pq * 49152 + b * 12288 + col];
                AD[i] = a + bada[col]; }
            __syncthreads();
        }
        const LAS float* AD = (const LAS float*)lds;
        f32x4 vn[8];
        if (gw < T) { const f32x4* xr = (const f32x4*)(INP(I_X) + (size_t)gw * D) + lane;
#pragma unroll
            for (int j = 0; j < 8; ++j) vn[j] = xr[64 * j]; }
        for (int mrow = gw; mrow < T; mrow += NGW) {
            const int b = mrow / SEQ;
            f32x4 v[8]; float s = 0.f;
#pragma unroll
            for (int j = 0; j < 8; ++j) { v[j] = vn[j]; s += (v[j][0] * v[j][0] + v[j][1] * v[j][1]) + (v[j][2] * v[j][2] + v[j][3] * v[j][3]); }
            if (mrow + NGW < T) { const f32x4* xr = (const f32x4*)(INP(I_X) + (size_t)(mrow + NGW) * D) + lane;
#pragma unroll
                for (int j = 0; j < 8; ++j) vn[j] = xr[64 * j]; }
            const float r = rsqrtf(wave_sum(s) * (1.0f / D) + RMS_EPS);
            u32x2* o8 = (u32x2*)(Hb + (size_t)mrow * D) + lane; unsigned* q8 = (unsigned*)(ws + WS_H8 + (size_t)mrow * D) + lane;
#pragma unroll
            for (int j = 0; j < 8; ++j) { const int col = 256 * j + 4 * lane; const f32x4 gg = *(const f32x4*)(g + col), sh = *(const LAS f32x4*)(AD + b * 4096 + col), sc = *(const LAS f32x4*)(AD + b * 4096 + 2048 + col);
                const f32x4 y = v[j] * r * gg * (sc + 1.0f) + sh; u32x2 w; w.x = cvt_pk_bf16(y[0], y[1]); w.y = cvt_pk_bf16(y[2], y[3]); o8[64 * j] = w; q8[64 * j] = pk4_fp8(y[0], y[1], y[2], y[3], H8_SCALE); }
        }
    }
    SEAM(PH_H);
    if (IN(PH_INPROJ)) for (int rep = 0; rep < NREP(PH_INPROJ); ++rep) {
        PTRS
        {   pg8::InprojSched S{(const char*)Hb, (const char*)WT_IN, G, bx};
            EpiInprojAll E{EpiInproj{QL, CKV, KR, ACAT, KROT, SG, GA, GB, SSQP, CS_RET, CS_MLA, DECTAB, 0, 1.0f}, EpiVT{BCAT, ws + WS_VT8}};
            pg8::gemm_phase(lds, 2048, 2048, 2048, S, E); }
        {
            pg8::GridSched S{(const char*)(ws + WS_H8), (const char*)(ws + WS_WT8IN), (size_t)256 * 2048, (size_t)256 * 2048, T / 256, 24, G, bx};
            EpiInproj E{QL, CKV, KR, ACAT, KROT, SG, GA, GB, SSQP, CS_RET, CS_MLA, DECTAB, 21, GU_UNSCALE};
            pg8::gemm_phase<EpiInproj, pg8::GridSched, true>(lds, 2048, 2048, 2048, S, E); }
    }
    SEAM(PH_INPROJ_V);
    if (IN(PH_KT)) for (int rep = 0; rep < NREP(PH_KT); ++rep) {
        PTRS
        {
            constexpr int TP = 528;
            u32x4 ra[16], rb[16];
#define KT_LOAD(r_, blk_) do { const bf16_t* _s = KROT + ((size_t)(blk_) * 256 + 32 * wave + 16 * (lane >> 5)) * 256 + 8 * (lane & 31); _Pragma("unroll") for (int i = 0; i < 16; ++i) r_[i] = *(const u32x4*)(_s + i * 256); } while (0)
#define KT_PROC(r_, blk_) do { const int _h = ((blk_) >> 4) & 7; const float _lf = DECTAB[_h], _lb = DECTAB[8 + _h]; \
                _Pragma("unroll") for (int e = 0; e < 8; ++e) { u32x4 w0, w1; \
                    _Pragma("unroll") for (int i2 = 0; i2 < 4; ++i2) { const unsigned a0 = r_[2 * i2][e >> 1], a1 = r_[2 * i2 + 1][e >> 1], c0 = r_[8 + 2 * i2][e >> 1], c1 = r_[8 + 2 * i2 + 1][e >> 1]; \
                        w0[i2] = (e & 1) ? ((a0 >> 16) | (a1 & 0xffff0000u)) : ((a0 & 0xffffu) | (a1 << 16)); w1[i2] = (e & 1) ? ((c0 >> 16) | (c1 & 0xffff0000u)) : ((c0 & 0xffffu) | (c1 << 16)); } \
                    LAS unsigned char* _t = lds + (8 * (lane & 31) + e) * TP + (32 * wave + 16 * (lane >> 5)) * 2; *(LAS u32x4*)_t = w0; *(LAS u32x4*)(_t + 16) = w1; } \
                __syncthreads(); \
                f32x4 zf0, zf1, zb0, zb1; \
                _Pragma("unroll") for (int t = 0; t < 4; ++t) { const int p0 = 8 * (lane & 31) + t, p1 = p0 + 4; \
                    zf0[t] = __builtin_amdgcn_exp2f((float)(255 - p0) * _lf); zf1[t] = __builtin_amdgcn_exp2f((float)(255 - p1) * _lf); zb0[t] = __builtin_amdgcn_exp2f((float)p0 * _lb); zb1[t] = __builtin_amdgcn_exp2f((float)p1 * _lb); } \
                _Pragma("unroll") for (int j = 0; j < 16; ++j) { const int row = 32 * wave + 2 * j + (lane >> 5); \
                    const u32x4 w = *(const LAS u32x4*)(lds + row * TP + (lane & 31) * 16); f32x4 x0, x1; unpack8(w, x0, x1); \
                    const size_t o = ((size_t)(blk_) * 256 + row) * 256 + 8 * (lane & 31); \
                    const f32x4 f0 = x0 * zf0, f1 = x1 * zf1, g0 = x0 * zb0, g1 = x1 * zb1; u32x2 wf, wb; \
                    wf.x = pk4_fp8(f0[0], f0[1], f0[2], f0[3], K8_SCALE); wf.y = pk4_fp8(f1[0], f1[1], f1[2], f1[3], K8_SCALE); wb.x = pk4_fp8(g0[0], g0[1], g0[2], g0[3], K8_SCALE); wb.y = pk4_fp8(g1[0], g1[1], g1[2], g1[3], K8_SCALE); \
                    *(u32x2*)((unsigned char*)KZTF + o) = wf; *(u32x2*)((unsigned char*)KZTB + o) = wb; } \
                __syncthreads(); } while (0)
            int blk = bx;
            if (blk < NBLK) KT_LOAD(ra, blk);
            while (blk < NBLK) {
                const int b1 = blk + G; if (b1 < NBLK) KT_LOAD(rb, b1);
                KT_PROC(ra, blk);
                if (b1 >= NBLK) break;
                const int b2 = b1 + G; if (b2 < NBLK) KT_LOAD(ra, b2);
                KT_PROC(rb, b1);
                blk = b2;
            }
#undef KT_LOAD
#undef KT_PROC
        }
    }
    SEAM(PH_KT);
    if (IN(PH_CHAIN)) for (int rep = 0; rep < NREP(PH_CHAIN); ++rep) {
        PTRS
        if (bx < 64) {
            const int bh = bx >> 1, dir = bx & 1;
            {
                const int blk0 = bh * NCH + (dir ? NCH - 1 : 0);
                bf16_t* z = BCAT + ((size_t)blk0 * 256 + (tid >> 1)) * 768 + 256 + 256 * dir + (tid & 1) * 128;
#pragma unroll
                for (int q = 0; q < 16; ++q) *(u32x4*)(z + q * 8) = (u32x4){0u, 0u, 0u, 0u};
            }
            pg8::ChainSched S{(const char*)(ws + WS_VT8), (const char*)(dir ? KZTB : KZTF), bh, dir};
            EpiGb E{BCAT, DECTAB, dir};
            pg8::gemm_phase<EpiGb, pg8::ChainSched, true, true>(lds, 256, 256, 256, S, E);
        }
    }
    if (IN(PH_MLAQ)) for (int rep = 0; rep < NREP(PH_MLAQ); ++rep) {
        PTRS
        if (bx >= 64) { const bool ca = bx < 128;
            pg8::GridSchedR S{(const char*)QL, (const char*)WT_QB, (size_t)256 * 512 * 2, (size_t)256 * 512 * 2, T / 256, 6, ca ? 64 : 128, ca ? bx - 64 : bx - 128, ca ? 0 : 128, ca ? 128 : 384};
            EpiMlaQ E{QN, QR, SSQP, CS_MLA}; pg8::gemm_phase(lds, 512, 512, 512, S, E); }
    }
    if (IN(PH_MLAKV)) for (int rep = 0; rep < NREP(PH_MLAKV); ++rep) {
        PTRS
        if (bx >= 128) {
            pg8::GridSchedR S{(const char*)CKV, (const char*)WT_KVB, (size_t)256 * 512 * 2, (size_t)256 * 512 * 2, T / 256, 8, 128, bx - 128, 0, 512};
            EpiMlaKV E{KN, VV, SSQP + (size_t)8 * T}; pg8::gemm_phase(lds, 512, 512, 512, S, E); }
    }
    if (IN(PH_GA)) for (int rep = 0; rep < NREP(PH_GA); ++rep) {
        PTRS
        if (bx >= 64) { const bool ca = bx < 128;
        {   pg8::BatchSchedR S{(const char*)(ACAT + 256), (const char*)KROT, (size_t)256 * 768 * 2, (size_t)256 * 256 * 2, ca ? 64 : 128, ca ? bx - 64 : bx - 128, ca ? 0 : 256, ca ? 256 : 512};
            EpiGa E{ACAT, DECTAB}; pg8::gemm_phase(lds, 256, 768, 256, S, E); }
        if (ca) {
            pg8::GridSchedR S{(const char*)Hb, (const char*)(WT_IN + (size_t)4 * 256 * 2048), (size_t)256 * 2048 * 2, (size_t)256 * 2048 * 2, T / 256, 1, 64, bx - 64, 0, 64};
            EpiInproj E{QL, CKV, KR, ACAT, KROT, SG, GA, GB, SSQP, CS_RET, CS_MLA, DECTAB, 4, 1.0f}; pg8::gemm_phase(lds, 2048, 2048, 2048, S, E); }
        }
    }
    SEAM(PH_GA);
    if (IN(PH_ATTN)) for (int rep = 0; rep < NREP(PH_ATTN); ++rep) {
        PTRS
        unsigned* queue = ctl + CW_QUEUE + rep; unsigned* cqueue = ctl + CW_QUEUE + 8;
        const float* wgu = INP(I_WGU); const float* wdn = INP(I_WDOWN);
#define CONV_LOOP() do { if (rep == 0) for (;;) { __syncthreads(); if (tid == 0) MISC[1] = atomicAdd(cqueue, 1u); __syncthreads(); const int c = (int)MISC[1]; if (c >= 768) break; \
            xt_convert_tiles(c * 16, 1, c * 16 + 16, wgu, wdn, WT_GU, WT_DOWN, lds, lane, wave); } } while (0)
        if (bx < CONV_WGS) CONV_LOOP();
        int xq = (int)(xb_xcc_id() & 7u), tries = 0;
        for (;;) {
            __syncthreads();
            if (tid == 0) { int a = -1;
                while (tries < 8) { const unsigned v = atomicAdd(ctl + CW_AQ + 64 * xq + rep, 1u); if (v < 64u) { a = xq * 64 + (int)v; break; } xq = (xq + 1) & 7; ++tries; }
                MISC[0] = (unsigned)a; }
            __syncthreads();
            const int a = (int)MISC[0];
            if (a < 0) break;
            const int bh = a >> 4, qb = a & 15, b = bh >> 3, h = bh & 7;
            const size_t tok0 = (size_t)b * SEQ + qb * 256, kt0 = (size_t)b * SEQ;
            att::attn_unit(QN + tok0 * 1024 + h * 128, QR + tok0 * 512 + h * 64, KN + kt0 * 1024 + h * 128, KR + kt0 * 64, VV + kt0 * 1024 + h * 128, OA + tok0 * 1024 + h * 128, SEQ, (char*)lds_raw);
        }
        if (bx >= CONV_WGS) CONV_LOOP();
#undef CONV_LOOP
    }
    SEAM(PH_ATTN);
    if (IN(PH_GC)) for (int rep = 0; rep < NREP(PH_GC); ++rep) {
        PTRS
        {   pg8::BatchSched S{(const char*)ACAT, (const char*)BCAT, (size_t)256 * 768 * 2, (size_t)256 * 768 * 2, NBLK, G, bx};
            EpiGc E{OB, SG, INP(I_RETGN), lds}; pg8::gemm_phase(lds, 768, 768, 768, S, E); }
    }
    if (IN(PH_MIXA)) for (int rep = 0; rep < NREP(PH_MIXA); ++rep) {
        PTRS
        {   pg8::GridSched S{(const char*)OA, (const char*)WT_MLAO, (size_t)256 * 1024 * 2, (size_t)256 * 1024 * 2, T / 256, 8, G, bx};
            EpiMixA E{MIXP, GA}; pg8::gemm_phase(lds, 1024, 1024, 1024, S, E); }
    }
    SEAM(PH_MIXA);
    if (IN(PH_MIXB)) for (int rep = 0; rep < NREP(PH_MIXB); ++rep) {
        PTRS
        pg8::GridSched S{(const char*)OB, (const char*)WT_RETO, (size_t)256 * 2048 * 2, (size_t)256 * 2048 * 2, T / 256, 8, G, bx};
        EpiMixB E{MIXIN, MIXP, GB}; pg8::gemm_phase(lds, 2048, 2048, 2048, S, E);
    }
    SEAM(PH_MIXB);
    if (IN(PH_MIX)) for (int rep = 0; rep < NREP(PH_MIX); ++rep) {
        PTRS
        pg8::GridSched S{(const char*)MIXIN, (const char*)WT_OUT, (size_t)256 * 2048 * 2, (size_t)256 * 2048 * 2, T / 256, 8, G, bx};
        EpiF32 E{(bf16_t*)MIX}; pg8::gemm_phase(lds, 2048, 2048, 2048, S, E);
    }
    SEAM(PH_MIX);
    if (IN(PH_ROUTER)) for (int rep = 0; rep < NREP(PH_ROUTER); ++rep) {
        PTRS
        const float* gpm = INP(I_GPOSTM); const float* gpf = INP(I_GPREF); const float* wr = INP(I_WROUTER); const float* brt = INP(I_BROUTER);
        LAS float* HROW = (LAS float*)lds;
        LAS float* PART = (LAS float*)(lds + 16 * 2052 * 4);
        unsigned* counts = ctl + CW_COUNTS;
        volatile LAS unsigned* lhist = MISC + 64;
        if (tid < 32) lhist[tid] = 0u;
        __syncthreads();
        const float* wbp = wr + (size_t)(256 * wave + (lane >> 4)) * 32 + (lane & 15);
        f32x4 vA[8], vB[8], xA[8], xB[8];
#define RT_LOAD(base_) do { const int _m = (base_) + 2 * wave; const u32x2* _mr = (const u32x2*)((const bf16_t*)MIX + (size_t)_m * D) + lane; const f32x4* _xr = (const f32x4*)(INP(I_X) + (size_t)_m * D) + lane; \
            _Pragma("unroll") for (int j = 0; j < 8; ++j) { const u32x2 _a = _mr[64 * j], _b = _mr[64 * j + 512]; vA[j] = (f32x4){bf_lo(_a.x), bf_hi(_a.x), bf_lo(_a.y), bf_hi(_a.y)}; vB[j] = (f32x4){bf_lo(_b.x), bf_hi(_b.x), bf_lo(_b.y), bf_hi(_b.y)}; \
                xA[j] = _xr[64 * j]; xB[j] = _xr[64 * j + 512]; } } while (0)
        if (bx * 16 < T) RT_LOAD(bx * 16);
        for (int base = bx * 16; base < T; base += G * 16) {
            {
                const int rrA = 2 * wave, mrowA = base + rrA;
                const int b = mrowA / SEQ; const float* ad = ada + b * 12288;
                float sA = 0.f, sB = 0.f;
#pragma unroll
                for (int j = 0; j < 8; ++j) { sA += (vA[j][0] * vA[j][0] + vA[j][1] * vA[j][1]) + (vA[j][2] * vA[j][2] + vA[j][3] * vA[j][3]); sB += (vB[j][0] * vB[j][0] + vB[j][1] * vB[j][1]) + (vB[j][2] * vB[j][2] + vB[j][3] * vB[j][3]); }
#pragma unroll
                for (int o = 1; o < 64; o <<= 1) { sA += __shfl_xor(sA, o); sB += __shfl_xor(sB, o); }
                const float r1A = rsqrtf(sA * (1.0f / D) + RMS_EPS), r1B = rsqrtf(sB * (1.0f / D) + RMS_EPS); float tA = 0.f, tB = 0.f;
                u32x2* o4 = (u32x2*)((bf16_t*)(ws + WS_X1B) + (size_t)mrowA * D) + lane;
#pragma unroll
                for (int j = 0; j < 8; ++j) { const int col = 256 * j + 4 * lane; const f32x4 gg = *(const f32x4*)(gpm + col), gm = *(const f32x4*)(ad + 4096 + col);
                    vA[j] = xA[j] + gm * (vA[j] * r1A * gg); vB[j] = xB[j] + gm * (vB[j] * r1B * gg);
                    { u32x2 wa, wb; wa.x = cvt_pk_bf16(vA[j][0], vA[j][1]); wa.y = cvt_pk_bf16(vA[j][2], vA[j][3]); wb.x = cvt_pk_bf16(vB[j][0], vB[j][1]); wb.y = cvt_pk_bf16(vB[j][2], vB[j][3]); o4[64 * j] = wa; o4[64 * j + 512] = wb; }
                    tA += (vA[j][0] * vA[j][0] + vA[j][1] * vA[j][1]) + (vA[j][2] * vA[j][2] + vA[j][3] * vA[j][3]); tB += (vB[j][0] * vB[j][0] + vB[j][1] * vB[j][1]) + (vB[j][2] * vB[j][2] + vB[j][3] * vB[j][3]); asm volatile("" ::: "memory"); }
#pragma unroll
                for (int o = 1; o < 64; o <<= 1) { tA += __shfl_xor(tA, o); tB += __shfl_xor(tB, o); }
                const float r2A = rsqrtf(tA * (1.0f / D) + RMS_EPS), r2B = rsqrtf(tB * (1.0f / D) + RMS_EPS);
                unsigned* h8 = (unsigned*)((unsigned char*)H2 + (size_t)mrowA * D) + lane;
#pragma unroll
                for (int j = 0; j < 8; ++j) { const int col = 256 * j + 4 * lane; const f32x4 gg = *(const f32x4*)(gpf + col), sh = *(const f32x4*)(ad + 6144 + col), sc = *(const f32x4*)(ad + 8192 + col);
                    const f32x4 hA = vA[j] * r2A * gg * (sc + 1.0f) + sh, hB = vB[j] * r2B * gg * (sc + 1.0f) + sh;
                    h8[64 * j] = pk4_fp8(hA[0], hA[1], hA[2], hA[3], H8_SCALE); h8[64 * j + 512] = pk4_fp8(hB[0], hB[1], hB[2], hB[3], H8_SCALE);
                    *(LAS f32x4*)(HROW + rrA * 2052 + col) = hA; *(LAS f32x4*)(HROW + (rrA + 1) * 2052 + col) = hB; asm volatile("" ::: "memory"); }
                if (base + G * 16 < T) RT_LOAD(base + G * 16);
            }
            __syncthreads();
            {   f32x4 c0 = (f32x4){0.f, 0.f, 0.f, 0.f}, c1 = (f32x4){0.f, 0.f, 0.f, 0.f};
                const LAS float* ap = HROW + (lane & 15) * 2052 + 256 * wave + (lane >> 4);
#pragma unroll 16
                for (int st = 0; st < 64; ++st) { const float a = ap[4 * st]; c0 = __builtin_amdgcn_mfma_f32_16x16x4f32(a, wbp[st * 128], c0, 0, 0, 0); c1 = __builtin_amdgcn_mfma_f32_16x16x4f32(a, wbp[st * 128 + 16], c1, 0, 0, 0); }
                LAS float* pp = PART + wave * 512 + (4 * (lane >> 4)) * 32 + (lane & 15);
#pragma unroll
                for (int r = 0; r < 4; ++r) { pp[r * 32] = c0[r]; pp[r * 32 + 16] = c1[r]; }
            }
            __syncthreads();
#pragma nounroll
            for (int q = 0; q < 2; ++q) {
                const int rr = 2 * wave + q, mrow = base + rr;
                float lg = 0.f;
                if (lane < 32) {
#pragma unroll
                    for (int w2 = 0; w2 < 8; ++w2) lg += PART[w2 * 512 + rr * 32 + lane];
                    lg += brt[lane]; }
                float val = lane < 32 ? lg : -3.0e38f; float tv[4]; int ti[4];
#pragma unroll
                for (int r = 0; r < 4; ++r) { float bv = val; int bi = lane;
#pragma unroll
                    for (int o = 32; o >= 1; o >>= 1) { const float ov = __shfl_xor(bv, o); const int oi = __shfl_xor(bi, o); if (ov > bv || (ov == bv && oi < bi)) { bv = ov; bi = oi; } }
                    tv[r] = bv; ti[r] = bi; if (lane == bi) val = -3.0e38f; }
                const float e1 = __expf(tv[1] - tv[0]), e2 = __expf(tv[2] - tv[0]), e3 = __expf(tv[3] - tv[0]); const float inv = 1.0f / (1.0f + e1 + e2 + e3);
                if (lane < 4) { const int id = lane == 0 ? ti[0] : (lane == 1 ? ti[1] : (lane == 2 ? ti[2] : ti[3])); const float wv = (lane == 0 ? 1.0f : (lane == 1 ? e1 : (lane == 2 ? e2 : e3))) * inv;
                    TOPI[mrow * 4 + lane] = id; TOPW[mrow * 4 + lane] = wv; if (rep == 0) __hip_atomic_fetch_add((LAS unsigned*)(lhist + id), 1u, __ATOMIC_RELAXED, __HIP_MEMORY_SCOPE_WORKGROUP); }
            }
            __syncthreads();
        }
        if (tid < 32 && rep == 0) { const unsigned c = lhist[tid]; if (c) atomicAdd(counts + 64 * tid, c); }
    }
    SEAM(PH_ROUTER);
    if (IN(PH_DISPATCH)) for (int rep = 0; rep < NREP(PH_DISPATCH); ++rep) {
        PTRS
        unsigned* counts = ctl + CW_COUNTS; unsigned* cursor = ctl + CW_CURSOR;
        volatile LAS unsigned* lhist = MISC + 64; volatile LAS unsigned* lbase = MISC + 96;
        if (tid < 32) lhist[tid] = 0u;
        int pst = 0, pend = 0;
        { const int cnt = lane < 32 ? (int)__hip_atomic_load(counts + 64 * lane, __ATOMIC_RELAXED, __HIP_MEMORY_SCOPE_AGENT) : 0; const int pad = (cnt + 255) & ~255; int inc = pad;
#pragma unroll
          for (int o = 1; o < 32; o <<= 1) { const int t = __shfl_up(inc, o); if ((lane & 31) >= o) inc += t; }
          pend = inc; pst = inc - pad; }
        if (gw == 0) {
            const int ntiles = __shfl(pend, 31) >> 8; if (lane == 0) TILE[0] = ntiles;
            for (int t = lane; t < PMAX / 256; t += 64) { int e = 0;
                for (int q = 0; q < 32; ++q) { const int pe = __shfl(pend, q); e += (pe <= t * 256) ? 1 : 0; }
                TILE[16 + t] = e < 31 ? e : 31; }
        }
        __syncthreads();
        int eid[8], loc[8];
#pragma unroll
        for (int i = 0; i < 8; ++i) { const int mrow = gw + NGW * i; eid[i] = 0; loc[i] = 0;
            if (mrow < T && lane < 4) { eid[i] = TOPI[mrow * 4 + lane]; loc[i] = (int)__hip_atomic_fetch_add((LAS unsigned*)(lhist + eid[i]), 1u, __ATOMIC_RELAXED, __HIP_MEMORY_SCOPE_WORKGROUP); } }
        __syncthreads();
        if (tid < 32) { const unsigned c = lhist[tid]; lbase[tid] = (unsigned)pst + (c ? atomicAdd(cursor + 64 * tid, c) : 0u); }
        __syncthreads();
#pragma unroll
        for (int i = 0; i < 8; ++i) { const int mrow = gw + NGW * i;
            if (mrow < T) {
                int slot = 0;
                if (lane < 4) { slot = (int)lbase[eid[i]] + loc[i]; DEST[mrow * 4 + lane] = slot; }
                const u32x4* src = (const u32x4*)((const unsigned char*)H2 + (size_t)mrow * D) + lane; u32x4 rw[2];
#pragma unroll
                for (int q = 0; q < 2; ++q) rw[q] = src[64 * q];
#pragma unroll
                for (int k = 0; k < 4; ++k) { const int sl = __shfl(slot, k); u32x4* dst = (u32x4*)((unsigned char*)XS + (size_t)sl * D) + lane;
#pragma unroll
                    for (int q = 0; q < 2; ++q) dst[64 * q] = rw[q]; } } }
    }
    SEAM(PH_DISPATCH);
    if (IN(PH_GU)) for (int rep = 0; rep < NREP(PH_GU); ++rep) {
        PTRS
        const int ntiles = __builtin_amdgcn_readfirstlane(TILE[0]);
        pg8::MoeSched S{(const char*)XS, (const char*)WT_GU, TILE + 16, ntiles, 16, G, bx};
        EpiGU E{ACT, INP(I_BGU), rep}; pg8::gemm_phase<EpiGU, pg8::MoeSched, true>(lds, 2048, 2048, 2048, S, E);
    }
    SEAM(PH_GU);
    if (IN(PH_DOWN)) for (int rep = 0; rep < NREP(PH_DOWN); ++rep) {
        PTRS
        const int ntiles = __builtin_amdgcn_readfirstlane(TILE[0]);
        pg8::MoeSched S{(const char*)ACT, (const char*)WT_DOWN, TILE + 16, ntiles, 8, G, bx};
        EpiDown E{YS, INP(I_BDOWN)}; pg8::gemm_phase<EpiDown, pg8::MoeSched, true>(lds, 2048, 2048, 2048, S, E);
    }
    SEAM(PH_DOWN);
    if (IN(PH_COMBINE)) for (int rep = 0; rep < NREP(PH_COMBINE); ++rep) {
        PTRS
        const float* gpo = INP(I_GPOSTF);
        for (int mrow = gw; mrow < T; mrow += NGW) {
            const int b = mrow / SEQ; const float* ad = ada + b * 12288;
            int dk[4]; float wk[4];
#pragma unroll
            for (int k = 0; k < 4; ++k) { dk[k] = DEST[mrow * 4 + k]; wk[k] = TOPW[mrow * 4 + k]; }
            f32x4 f[8]; float s = 0.f;
#pragma unroll
            for (int j = 0; j < 8; ++j) f[j] = (f32x4){0.f, 0.f, 0.f, 0.f};
#pragma unroll
            for (int k = 0; k < 4; ++k) { const u32x2* yr = (const u32x2*)(YS + (size_t)dk[k] * D) + lane;
#pragma unroll
                for (int j = 0; j < 8; ++j) { const u32x2 w = yr[64 * j]; f[j] += (f32x4){bf_lo(w.x), bf_hi(w.x), bf_lo(w.y), bf_hi(w.y)} * wk[k]; } }
#pragma unroll
            for (int j = 0; j < 8; ++j) s += (f[j][0] * f[j][0] + f[j][1] * f[j][1]) + (f[j][2] * f[j][2] + f[j][3] * f[j][3]);
            const float r = rsqrtf(wave_sum(s) * (1.0f / D) + RMS_EPS);
            f32x4* o4 = (f32x4*)(outp + (size_t)mrow * D) + lane; const u32x2* x1 = (const u32x2*)((const bf16_t*)(ws + WS_X1B) + (size_t)mrow * D) + lane;
#pragma unroll
            for (int j = 0; j < 8; ++j) { const int col = 256 * j + 4 * lane; const f32x4 gg = *(const f32x4*)(gpo + col), gf = *(const f32x4*)(ad + 10240 + col); const u32x2 xw = x1[64 * j];
                o4[64 * j] = (f32x4){bf_lo(xw.x), bf_hi(xw.x), bf_lo(xw.y), bf_hi(xw.y)} + gf * (f[j] * r * gg); }
        }
    }
    if (STAMP_PHASE >= 0 && bx == 0) {
        if (seam_after(STAMP_PHASE) >= NPH) st_dt = __builtin_amdgcn_s_memrealtime() - st_t0;
        const unsigned long long t1 = __builtin_amdgcn_s_memrealtime();
        while (__builtin_amdgcn_s_memrealtime() - t1 < st_dt * STAMP_MUL) __builtin_amdgcn_s_sleep(8);
    }
#undef IN
#undef SEAM
}

extern "C" void kernel_launch(void* const* d_in, const int* in_sizes, int n_in, void* d_out, int out_size, void* d_ws, size_t ws_size, hipStream_t stream) {
    static int grid = 0;
    if (grid == 0) {
        if (n_in != 26 || out_size != T * D || ws_size < WS_END) { fprintf(stderr, "kernel_launch: unexpected shapes: n_in %d out %d ws %zu (need %zu)\n", n_in, out_size, ws_size, (size_t)WS_END); grid = -1; return; }
        int dev = 0, cus = 0, per_cu = 0;
        if (hipGetDevice(&dev) != hipSuccess || hipDeviceGetAttribute(&cus, hipDeviceAttributeMultiprocessorCount, dev) != hipSuccess) { grid = -1; return; }
        if (hipFuncSetAttribute((const void*)fwd_kernel, hipFuncAttributeMaxDynamicSharedMemorySize, LDS_BYTES) != hipSuccess) { fprintf(stderr, "kernel_launch: hipFuncSetAttribute failed\n"); grid = -1; return; }
        if (hipOccupancyMaxActiveBlocksPerMultiprocessor(&per_cu, (const void*)fwd_kernel, 512, LDS_BYTES) != hipSuccess || per_cu < 1) fprintf(stderr, "kernel_launch: occupancy query says %d\n", per_cu);
        (void)hipGetLastError();
        grid = cus;
    }
    if (grid < 0) return;
    (void)hipMemsetAsync((char*)d_ws + WS_CTL, 0, CTL_BYTES, stream);
    Args a{};
    for (int i = 0; i < 26; ++i) a.in[i] = (const float*)d_in[i];
    a.out = (float*)d_out; a.ws = (unsigned char*)d_ws;
    if (MK_N_LAUNCHES == 1) { a.ph_lo = 0; a.ph_hi = NPH; hipLaunchKernelGGL(fwd_kernel, dim3(grid), dim3(512), LDS_BYTES, stream, a); }
    else for (int p = 0; p < NPH; ++p) { a.ph_lo = p; a.ph_hi = p + 1; hipLaunchKernelGGL(fwd_kernel, dim3(grid), dim3(512), LDS_BYTES, stream, a); }
    const hipError_t le = hipPeekAtLastError();
    if (le != hipSuccess) fprintf(stderr, "kernel_launch: launch failed: %s\n", hipGetErrorName(le));
}
```

```cpp
#include <hip/hip_runtime.h>
#include <cstdio>
#include <cstdint>

#ifndef MK_N_LAUNCHES
#define MK_N_LAUNCHES 1
#endif

#define LAS __attribute__((address_space(3)))
typedef unsigned short bf16_t;
typedef short bf16x8 __attribute__((ext_vector_type(8)));
typedef short s16x4 __attribute__((ext_vector_type(4)));
typedef float f32x4 __attribute__((ext_vector_type(4)));
typedef float f32x2 __attribute__((ext_vector_type(2)));
typedef float f32x16 __attribute__((ext_vector_type(16)));
typedef unsigned u32x4 __attribute__((ext_vector_type(4)));
typedef unsigned u32x2 __attribute__((ext_vector_type(2)));

constexpr int NB = 4, SEQ = 4096, T = NB * SEQ, D = 2048;
constexpr int CH = 256, NCH = SEQ / CH, NBLK = NB * 8 * NCH;
constexpr int N_IN_NAT = 11520;
constexpr int N_IN_ALL = N_IN_NAT + 2048;
constexpr int NE = 32, PMAX = 73728;
constexpr float RMS_EPS = 1e-6f, GN_EPS = 1e-6f;
constexpr float QSCALE = 0.07216878364870322f;
constexpr int CONV_WGS = 64;

constexpr size_t MiB = 1u << 20;
constexpr size_t WS_CTL = 0, CTL_BYTES = 1 * MiB;
constexpr size_t WS_WT_IN = 1 * MiB;
constexpr size_t WS_WT_QB = WS_WT_IN + 54 * MiB;
constexpr size_t WS_WT_KVB = WS_WT_QB + 2 * MiB;
constexpr size_t WS_WT_MLAO = WS_WT_KVB + 2 * MiB;
constexpr size_t WS_WT_RETO = WS_WT_MLAO + 4 * MiB;
constexpr size_t WS_WT_OUT = WS_WT_RETO + 8 * MiB;
constexpr size_t WS_WT_GU = WS_WT_OUT + 8 * MiB;
constexpr size_t WS_WT_DOWN = WS_WT_GU + 512 * MiB;
constexpr size_t WS_CS_RET = WS_WT_DOWN + 256 * MiB;
constexpr size_t WS_CS_MLA = WS_CS_RET + 16 * MiB;
constexpr size_t WS_H = WS_CS_MLA + 4 * MiB;
constexpr size_t WS_QL = WS_H + 64 * MiB;
constexpr size_t WS_CKV = WS_QL + 16 * MiB;
constexpr size_t WS_KR = WS_CKV + 16 * MiB;
constexpr size_t WS_ACAT = WS_KR + 2 * MiB;
constexpr size_t WS_BCAT = WS_ACAT + 192 * MiB;
constexpr size_t WS_KROT = WS_BCAT + 192 * MiB;
constexpr size_t WS_KZTF = WS_KROT + 64 * MiB;
constexpr size_t WS_KZTB = WS_KZTF + 64 * MiB;
constexpr size_t WS_SG = WS_KZTB + 64 * MiB;
constexpr size_t WS_GA = WS_SG + 64 * MiB;
constexpr size_t WS_GB = WS_GA + 64 * MiB;
constexpr size_t WS_QN = WS_GB + 64 * MiB;
constexpr size_t WS_QR = WS_QN + 32 * MiB;
constexpr size_t WS_KN = WS_QR + 16 * MiB;
constexpr size_t WS_VV = WS_KN + 32 * MiB;
constexpr size_t WS_OA = WS_VV + 32 * MiB;
constexpr size_t WS_ORET = WS_OA + 32 * MiB;
constexpr size_t WS_OB = WS_ORET + 128 * MiB;
constexpr size_t WS_MIXP = WS_OB + 64 * MiB;
constexpr size_t WS_MIXIN = WS_MIXP + 64 * MiB;
constexpr size_t WS_MIX = WS_MIXIN + 64 * MiB;
constexpr size_t WS_H2 = WS_MIX + 128 * MiB;
constexpr size_t WS_TOPI = WS_H2 + 64 * MiB;
constexpr size_t WS_TOPW = WS_TOPI + 1 * MiB;
constexpr size_t WS_DEST = WS_TOPW + 1 * MiB;
constexpr size_t WS_TILE = WS_DEST + 1 * MiB;
constexpr size_t WS_YS_END = WS_TILE + 1 * MiB + 3 * 288 * MiB;
constexpr size_t WS_DECTAB = WS_TILE + 65536;
constexpr size_t WS_SSQP = WS_YS_END;
constexpr size_t WS_XS = WS_TILE + 1 * MiB;
constexpr size_t WS_ACT = WS_XS + 288 * MiB;
constexpr size_t WS_YS = WS_ACT + 288 * MiB;
constexpr size_t WS_ADAP = WS_YS + 288 * MiB + 1 * MiB;
constexpr size_t WS_H8 = WS_ADAP + 2 * MiB;
constexpr size_t WS_WT8IN = WS_H8 + 32 * MiB;
constexpr size_t WS_VT8 = WS_WT8IN + 12 * MiB;
constexpr size_t WS_X1B = WS_VT8 + 32 * MiB;
constexpr size_t WS_END = WS_X1B + 64 * MiB;
constexpr int CW_BAR = 4096;
constexpr int CW_QUEUE = 8192, CW_CVTQ = 8384, CW_AQ = 9216  , CW_COUNTS = 10240, CW_CURSOR = 12288;
constexpr int CW_ADA = 16384;
constexpr int CW_SSQQ = 65536, CW_SSQKV = 81920;
static_assert((CW_SSQKV + T) * 4 <= (int)CTL_BYTES, "ctl");

constexpr int RING_BYTES = 131072, CTRL_OFF = 155648, MISC_OFF = CTRL_OFF, LARG_OFF = CTRL_OFF + 1024, LDS_BYTES = 163840;

__device__ __forceinline__ unsigned cvt_pk_bf16(float lo, float hi) { unsigned r; asm volatile("v_cvt_pk_bf16_f32 %0, %1, %2" : "=v"(r) : "v"(lo), "v"(hi)); return r; }
__device__ __forceinline__ u32x4 pack8(f32x4 a, f32x4 b) { u32x4 w; w.x = cvt_pk_bf16(a[0], a[1]); w.y = cvt_pk_bf16(a[2], a[3]); w.z = cvt_pk_bf16(b[0], b[1]); w.w = cvt_pk_bf16(b[2], b[3]); return w; }
__device__ __forceinline__ unsigned pk4_fp8(float a, float b, float c, float d, float sc) {
    a = __builtin_amdgcn_fmed3f(a * sc, -448.f, 448.f); b = __builtin_amdgcn_fmed3f(b * sc, -448.f, 448.f); c = __builtin_amdgcn_fmed3f(c * sc, -448.f, 448.f); d = __builtin_amdgcn_fmed3f(d * sc, -448.f, 448.f);
    int w = __builtin_amdgcn_cvt_pk_fp8_f32(a, b, 0, false); w = __builtin_amdgcn_cvt_pk_fp8_f32(c, d, w, true); return (unsigned)w;
}
constexpr float W8_SCALE = 1024.f, H8_SCALE = 16.f, A8_SCALE = 8.f;
constexpr float V8_SCALE = 16.f, K8_SCALE = 256.f, CH_UNSCALE = 1.0f / (V8_SCALE * K8_SCALE);
constexpr float GU_UNSCALE = 1.0f / (W8_SCALE * H8_SCALE), DN_UNSCALE = 1.0f / (W8_SCALE * A8_SCALE);
constexpr float M8_SCALE = 64.f, MX_UNSCALE = 1.0f / (W8_SCALE * M8_SCALE);
__device__ __forceinline__ float bf_lo(unsigned w) { return __uint_as_float(w << 16); }
__device__ __forceinline__ float bf_hi(unsigned w) { return __uint_as_float(w & 0xffff0000u); }
__device__ __forceinline__ void unpack8(u32x4 w, f32x4& a, f32x4& b) { a = (f32x4){bf_lo(w.x), bf_hi(w.x), bf_lo(w.y), bf_hi(w.y)}; b = (f32x4){bf_lo(w.z), bf_hi(w.z), bf_lo(w.w), bf_hi(w.w)}; }
__device__ __forceinline__ float wave_sum(float v) {
#pragma unroll
    for (int o = 1; o < 64; o <<= 1) v += __shfl_xor(v, o);
    return v;
}
__device__ __forceinline__ float sigmoidf_(float x) { return __builtin_amdgcn_rcpf(1.0f + __expf(-x)); }
__device__ __forceinline__ float log2_sigmoid(float x) { return -log1pf(expf(-x)) * 1.4426950408889634f; }

#define XB_TMO      128
#define XB_XCNT(j)  (256  + 64 * (j))
#define XB_XSUB(j)  (1280 + 64 * (j))
#define XB_XGEN(j)  (2304 + 64 * (j))
#define XB_TOP      3328
#define XB_TOPGEN   3392
#define XCD_BAR_WORDS 3456
#define XB_SPIN_CAP (1u << 22)
__device__ __forceinline__ unsigned xb_ld(unsigned* p)              { return __hip_atomic_load(p, __ATOMIC_RELAXED, __HIP_MEMORY_SCOPE_AGENT); }
__device__ __forceinline__ unsigned xb_add(unsigned* p, unsigned v) { return __hip_atomic_fetch_add(p, v, __ATOMIC_RELAXED, __HIP_MEMORY_SCOPE_AGENT); }
__device__ __forceinline__ unsigned xb_xcc_id() { return (unsigned)__builtin_amdgcn_s_getreg((3 << 11) | 20) & 0xFu; }
#define XB_SPIN(cond, bar) do { unsigned _sp = 0; while (cond) { __builtin_amdgcn_s_sleep(1); \
    if ((++_sp & 255u) == 0u) { if (xb_ld(&(bar)[XB_TMO])) break; if (_sp > XB_SPIN_CAP) { atomicAdd(&(bar)[XB_TMO], 1u); break; } } } } while (0)
struct XcdBarrier { unsigned* bar; unsigned x; volatile LAS unsigned* st; };
__device__ __forceinline__ XcdBarrier xcd_barrier_post(unsigned* bar, volatile LAS unsigned* st) {
    XcdBarrier b; b.bar = bar; b.x = xb_xcc_id(); b.st = st;
    if (threadIdx.x == 0) (void)xb_add(&bar[XB_XCNT(b.x)], 1u);
    return b;
}
__device__ __forceinline__ void xcd_barrier_complete(unsigned* bar, unsigned x, unsigned& nloc, unsigned& nx) {
    const unsigned G = gridDim.x * gridDim.y * gridDim.z;
    unsigned sum, cnt, mine, sp = 0u;
    for (;;) {
        sum = 0u; cnt = 0u; mine = 0u;
#pragma unroll
        for (unsigned j = 0; j < 16; ++j) { const unsigned c = xb_ld(&bar[XB_XCNT(j)]); sum += c; cnt += (c > 0u) ? 1u : 0u; mine = (j == x) ? c : mine; }
        if (sum == G) break;
        __builtin_amdgcn_s_sleep(1);
        if ((++sp & 255u) == 0u) { if (xb_ld(&bar[XB_TMO])) break; if (sp > XB_SPIN_CAP) { atomicAdd(&bar[XB_TMO], 1u); break; } }
    }
    nloc = mine > 0u ? mine : 1u; nx = cnt > 0u ? cnt : 1u;
}
__device__ __forceinline__ void xcd_barrier(const XcdBarrier& b) {
    asm volatile("s_waitcnt vmcnt(0)" ::: "memory");
    __syncthreads();
    if (threadIdx.x == 0) {
        unsigned* bar = b.bar;
        __builtin_amdgcn_s_waitcnt(0);
        unsigned nloc = b.st[0], nx = b.st[1];
        if (nloc == 0u) { xcd_barrier_complete(bar, b.x, nloc, nx); b.st[0] = nloc; b.st[1] = nx; }
        const unsigned old = xb_add(&bar[XB_XSUB(b.x)], 1u);
        const unsigned gen = old / nloc;
        if (old + 1u == (gen + 1u) * nloc) {
            __builtin_amdgcn_fence(__ATOMIC_RELEASE, "agent");
            asm volatile("s_waitcnt vmcnt(0)" ::: "memory");
            const unsigned og = xb_add(&bar[XB_TOP], 1u);
            const unsigned tg = og / nx;
            if (og + 1u == (tg + 1u) * nx) xb_add(&bar[XB_TOPGEN], 1u);
            else XB_SPIN(xb_ld(&bar[XB_TOPGEN]) == tg, bar);
            __builtin_amdgcn_fence(__ATOMIC_ACQUIRE, "agent");
            xb_add(&bar[XB_XGEN(b.x)], 1u);
            asm volatile("s_waitcnt vmcnt(0)" ::: "memory");
        } else {
            XB_SPIN(xb_ld(&bar[XB_XGEN(b.x)]) == gen, bar);
            __builtin_amdgcn_fence(__ATOMIC_ACQUIRE, "agent");
            asm volatile("s_waitcnt vmcnt(0)" ::: "memory");
        }
    }
    __syncthreads();
}

namespace pg8 {
constexpr int BM = 256, BK = 64, HALF = 128, HTB = HALF * BK * 2, NXCD = 8, WGM = 8;
__host__ __device__ __forceinline__ int lds_byte(int r, int c, int SW = 5) { const int st = (r >> 4) * 2 + (c >> 5), rr = r & 15, cc = c & 31, ob = rr * 64 + cc * 2; return st * 1024 + (ob ^ (((ob >> 9) & 1) << SW)); }
__host__ __device__ __forceinline__ void stage_rc(int b, int& R, int& C, int SW = 5) { const int st = b / 1024, sb = b % 1024, swz = sb ^ (((sb >> 9) & 1) << SW); R = (st >> 1) * 16 + swz / 64; C = (st & 1) * 32 + (swz % 64) / 2; }
__host__ __device__ __forceinline__ int perm32(int rho) { const int n = rho >> 4, i = rho & 15; return 8 * (i >> 2) + 4 * n + (i & 3); }
struct Unit { const char* a; const char* b; int pm, pn, keep, aux; };
__device__ __forceinline__ void tile_order(int wgid, int nM, int nN, int& pm, int& pn) {
    const int nwg = nM * nN; { const int q = nwg / NXCD, r = nwg % NXCD, xcd = wgid % NXCD, off = wgid / NXCD; wgid = (xcd < r ? xcd * (q + 1) : r * (q + 1) + (xcd - r) * q) + off; }
    const int nig = WGM * nN, gid = wgid / nig, fm = gid * WGM, gsz = (nM - fm) < WGM ? (nM - fm) : WGM;
    pm = fm + ((wgid % nig) % gsz); pn = (wgid % nig) / gsz;
}
typedef int v8i __attribute__((ext_vector_type(8)));
typedef int v4i __attribute__((ext_vector_type(4)));
template <class Epi, class Sched, bool F8 = false, bool REMAT = false>
__device__ __forceinline__ void gemm_phase(LAS unsigned char* lds, const int K, const int lda, const int ldb, const Sched& S, const Epi& E) {
    const int tid = threadIdx.x, wid = __builtin_amdgcn_readfirstlane(tid >> 6), lane = tid & 63, wr = wid >> 2, wc = wid & 3, fr = lane & 15, fq = lane >> 4;
    constexpr int ES = F8 ? 1 : 2;
    const int nt = K * ES / (BK * 2);
    unsigned voffA, voffB;
    constexpr bool X4 = F8 && !REMAT;
    constexpr int SW = X4 ? 4 : 5;
    { int R, C; stage_rc(tid * 16, R, C, SW); const int Rb = (R & ~31) + perm32(R & 31); voffA = (unsigned)(R * lda * ES + C * 2); voffB = (unsigned)(Rb * ldb * ES + C * 2); }
    const size_t q64voffA = (size_t)64 * lda * ES, q64voffB = (size_t)64 * ldb * ES;
    const size_t kstep = (size_t)(BK * 2);
    const size_t hstepA = (size_t)HALF * lda * ES, hstepB = (size_t)HALF * ldb * ES;
    const unsigned ldsw = (unsigned)wid * 1024u;
    const int aoff = F8 ? lds_byte(wr * 64 + fr, fq * 16, SW) : lds_byte(wr * 64 + fr, fq * 8), boff = F8 ? lds_byte(wc * 32 + fr, fq * 16, SW) : lds_byte(wc * 32 + fr, fq * 8);
#define PG8_SA(b, h) (((b) * 2 + (h)) * HTB)
#define PG8_SB(b, h) ((4 + (b) * 2 + (h)) * HTB)
    constexpr bool isB_voffA = false, isB_voffB = true; const unsigned pitch_voffA = (unsigned)(lda * ES), pitch_voffB = (unsigned)(ldb * ES);
#define PG8_VOFF(isB, pitch) ({ unsigned _t = threadIdx.x; asm volatile("" : "+v"(_t)); const unsigned _l = _t & 63u, _w = _t >> 6, _sw = (_l * 16u) ^ ((_l >> 5) << SW); unsigned _R = (_w >> 1) * 16u + (_sw >> 6); \
        const unsigned _C = (_w & 1u) * 32u + ((_sw & 63u) >> 1); if (isB) _R = (_R & ~31u) + (unsigned)perm32((int)(_R & 31u)); _R * (pitch) + _C * 2u; })
#define PG8_STAGE(bufoff, gbase, voff) do { _Pragma("unroll") for (int _i = 0; _i < 2; ++_i) { unsigned _vo; if constexpr (REMAT) _vo = PG8_VOFF(isB_##voff, pitch_##voff); else { _vo = (voff); if constexpr (F8) asm volatile("" : "+v"(_vo)); } \
        __builtin_amdgcn_global_load_lds((const unsigned*)((const char*)(gbase) + (_i ? q64##voff : (size_t)0) + _vo), (LAS unsigned*)(lds + (bufoff) + ldsw + _i * 8192), 16, 0, 0); } } while (0)
#define PG8_LD1(addr) ({ v8i _r; if constexpr (F8 && !X4) { _r = *(const LAS v8i*)(addr); } else if constexpr (X4) { const v4i _lo = *(const LAS v4i*)(addr), _hi = *(const LAS v4i*)((addr) + _x16); _r = __builtin_shufflevector(_lo, _hi, 0, 1, 2, 3, 4, 5, 6, 7); } else { const v4i _lo = *(const LAS v4i*)(addr), _hi = *(const LAS v4i*)((addr) + 1024); _r = __builtin_shufflevector(_lo, _hi, 0, 1, 2, 3, 4, 5, 6, 7); } _r; })
#define PG8_X16(off) int _x16 = 0; if constexpr (X4) { int _o = (off); asm volatile("" : "+v"(_o)); _x16 = (_o ^ 16) - _o; }
#define PG8_LDA(dst, b, h) do { PG8_X16(aoff) _Pragma("unroll") for (int m = 0; m < 4; ++m) dst[m] = PG8_LD1(lds + PG8_SA(b, h) + aoff + m * 2048); } while (0)
#define PG8_LDB(dst, b, h) do { PG8_X16(boff) _Pragma("unroll") for (int n = 0; n < 2; ++n) dst[n] = PG8_LD1(lds + PG8_SB(b, h) + boff + n * 2048); } while (0)
#define PG8_H0(x) __builtin_bit_cast(bf16x8, __builtin_shufflevector(x, x, 0, 1, 2, 3))
#define PG8_H1(x) __builtin_bit_cast(bf16x8, __builtin_shufflevector(x, x, 4, 5, 6, 7))
#define PG8_MMA(ai, bj, At, Bt) do { __builtin_amdgcn_s_setprio(1); _Pragma("unroll") for (int m = 0; m < 4; ++m) _Pragma("unroll") for (int n = 0; n < 2; ++n) { \
        if constexpr (F8) acc[ai][bj][m][n] = __builtin_amdgcn_mfma_scale_f32_16x16x128_f8f6f4(Bt[n], At[m], acc[ai][bj][m][n], 0, 0, 0, 0, 0, 0); \
        else { acc[ai][bj][m][n] = __builtin_amdgcn_mfma_f32_16x16x32_bf16(PG8_H0(Bt[n]), PG8_H0(At[m]), acc[ai][bj][m][n], 0, 0, 0); \
               acc[ai][bj][m][n] = __builtin_amdgcn_mfma_f32_16x16x32_bf16(PG8_H1(Bt[n]), PG8_H1(At[m]), acc[ai][bj][m][n], 0, 0, 0); } } \
        __builtin_amdgcn_s_setprio(0); } while (0)
#define PG8_WAIT_V(n) asm volatile("s_waitcnt vmcnt(" #n ")" ::: "memory")
#define PG8_WAIT_L(n) asm volatile("s_waitcnt lgkmcnt(" #n ")" ::: "memory")
#define PG8_BAR __builtin_amdgcn_s_barrier()
#define PG8_SCHED __builtin_amdgcn_sched_barrier(0)
    Unit cur, nxt; int ui = 0;
    if (!S.next(0, cur)) return;
    f32x4 acc[2][2][4][2];
#pragma unroll
    for (int a = 0; a < 2; ++a)
#pragma unroll
        for (int b = 0; b < 2; ++b)
#pragma unroll
            for (int m = 0; m < 4; ++m)
#pragma unroll
                for (int n = 0; n < 2; ++n) acc[a][b][m][n] = (f32x4){0.f, 0.f, 0.f, 0.f};
    v8i At[4], B0[2], B1[2];
    const char* cA = cur.a; const char* cB = cur.b;
    PG8_STAGE(PG8_SB(0, 0), cB, voffB); PG8_STAGE(PG8_SB(0, 1), cB + hstepB, voffB); PG8_STAGE(PG8_SA(0, 0), cA, voffA); PG8_STAGE(PG8_SA(0, 1), cA + hstepA, voffA);
    if (wr == 1) PG8_BAR;
    PG8_WAIT_V(2); PG8_BAR;
    PG8_STAGE(PG8_SB(1, 0), cB + kstep, voffB); PG8_STAGE(PG8_SA(1, 0), cA + kstep, voffA); PG8_STAGE(PG8_SB(1, 1), cB + hstepB + kstep, voffB);
    PG8_WAIT_V(6); PG8_BAR;
    for (;;) {
        const bool has_next = S.next(ui + 1, nxt);
        const char* nA = has_next ? nxt.a : cA; const char* nB = has_next ? nxt.b : cB;
#pragma nounroll
        for (int t = 0; t < nt; t += 2) {
            const bool last = (t == nt - 2);
            const char* a1 = cA + (size_t)(t + 1) * kstep;
            const char* a2 = last ? nA : cA + (size_t)(t + 2) * kstep; const char* b2 = last ? nB : cB + (size_t)(t + 2) * kstep;
            const char* a3 = a2 + kstep; const char* b3 = b2 + kstep;
            PG8_LDB(B0, 0, 0); PG8_LDB(B1, 0, 1); PG8_SCHED; PG8_LDA(At, 0, 0); PG8_STAGE(PG8_SA(1, 1), a1 + hstepA, voffA);
            PG8_WAIT_V(8); PG8_WAIT_L(0); PG8_BAR; PG8_MMA(0, 0, At, B0); PG8_MMA(0, 1, At, B1); PG8_BAR; PG8_SCHED;
            PG8_LDA(At, 0, 1); PG8_STAGE(PG8_SB(0, 0), b2, voffB); PG8_STAGE(PG8_SB(0, 1), b2 + hstepB, voffB); PG8_STAGE(PG8_SA(0, 0), a2, voffA);
            PG8_WAIT_V(8); PG8_WAIT_L(0); PG8_BAR; PG8_MMA(1, 0, At, B0); PG8_MMA(1, 1, At, B1); PG8_BAR; PG8_SCHED;
            PG8_LDB(B0, 1, 0); PG8_LDB(B1, 1, 1); PG8_SCHED; PG8_LDA(At, 1, 0); PG8_STAGE(PG8_SA(0, 1), a2 + hstepA, voffA);
            PG8_WAIT_V(8); PG8_WAIT_L(0); PG8_BAR; PG8_MMA(0, 0, At, B0); PG8_MMA(0, 1, At, B1); PG8_BAR; PG8_SCHED;
            PG8_LDA(At, 1, 1); PG8_STAGE(PG8_SB(1, 0), b3, voffB); PG8_STAGE(PG8_SB(1, 1), b3 + hstepB, voffB); PG8_STAGE(PG8_SA(1, 0), a3, voffA);
            PG8_WAIT_V(8); PG8_WAIT_L(0); PG8_BAR; PG8_MMA(1, 0, At, B0); PG8_MMA(1, 1, At, B1); PG8_BAR; PG8_SCHED;
        }
        if (wr == 0) PG8_BAR;
        { unsigned _t = threadIdx.x; if constexpr (F8) asm volatile("" : "+v"(_t)); E(acc, cur, wr, wc, (int)(_t & 15u), (int)((_t >> 4) & 3u)); }
        if (!has_next) break;
        if (!cur.keep) {
#pragma unroll
            for (int a = 0; a < 2; ++a)
#pragma unroll
                for (int b = 0; b < 2; ++b)
#pragma unroll
                    for (int m = 0; m < 4; ++m)
#pragma unroll
                        for (int n = 0; n < 2; ++n) acc[a][b][m][n] = (f32x4){0.f, 0.f, 0.f, 0.f};
        }
        cur = nxt; cA = nA; cB = nB; ++ui;
        if (wr == 1) PG8_BAR;
    }
    PG8_WAIT_V(0);
    PG8_BAR;
#undef PG8_SA
#undef PG8_SB
#undef PG8_STAGE
#undef PG8_VOFF
#undef PG8_LDA
#undef PG8_LDB
#undef PG8_LD1
#undef PG8_X16
#undef PG8_H0
#undef PG8_H1
#undef PG8_MMA
#undef PG8_WAIT_V
#undef PG8_WAIT_L
#undef PG8_BAR
#undef PG8_SCHED
}
struct GridSched {
    const char* A; const char* Bt; size_t astep, bstep; int nM, nN, G, c;
    __device__ __forceinline__ bool next(int i, Unit& u) const {
        const int L = i * G + c; if (L >= nM * nN) return false;
        int pm, pn; tile_order(L, nM, nN, pm, pn);
        u.a = A + (size_t)pm * astep; u.b = Bt + (size_t)pn * bstep; u.pm = pm; u.pn = pn; u.keep = 0; u.aux = 0; return true;
    }
};
struct InprojSched {
    const char* H; const char* W; int G, c;
    __device__ __forceinline__ bool next(int i, Unit& u) const {
        const int L = i * G + c; if (L >= 1792) return false;
        constexpr size_t TSB = (size_t)256 * 2048 * 2; int pm, pn;
        if (L < 1280) { tile_order(L, 64, 20, pm, pn); pn = pn < 4 ? pn : pn + 1; u.a = H + (size_t)pm * TSB; u.b = W + (size_t)pn * TSB; u.aux = 0; }
        else { tile_order(L - 1280, 8, 64, pm, pn); u.a = W + (size_t)(45 + pm) * TSB; u.b = H + (size_t)pn * TSB; u.aux = 1; }
        u.pm = pm; u.pn = pn; u.keep = 0; return true;
    }
};
struct GridSchedR {
    const char* A; const char* Bt; size_t astep, bstep; int nM, nN, G, c, L0, Lend;
    __device__ __forceinline__ bool next(int i, Unit& u) const {
        const int L = L0 + i * G + c; if (L >= Lend) return false;
        int pm, pn; tile_order(L, nM, nN, pm, pn);
        u.a = A + (size_t)pm * astep; u.b = Bt + (size_t)pn * bstep; u.pm = pm; u.pn = pn; u.keep = 0; u.aux = 0; return true;
    }
};
struct BatchSchedR {
    const char* A; const char* Bt; size_t astep, bstep; int G, c, L0, Lend;
    __device__ __forceinline__ bool next(int i, Unit& u) const {
        const int L = L0 + i * G + c; if (L >= Lend) return false;
        u.a = A + (size_t)L * astep; u.b = Bt + (size_t)L * bstep; u.pm = L; u.pn = 0; u.keep = 0; u.aux = 0; return true;
    }
};
struct BatchSched {
    const char* A; const char* Bt; size_t astep, bstep; int n, G, c;
    __device__ __forceinline__ bool next(int i, Unit& u) const {
        const int L = i * G + c; if (L >= n) return false;
        u.a = A + (size_t)L * astep; u.b = Bt + (size_t)L * bstep; u.pm = L; u.pn = 0; u.keep = 0; u.aux = 0; return true;
    }
};
struct ChainSched {
    const char* A; const char* Bt; int bh, dir;
    __device__ __forceinline__ bool next(int i, Unit& u) const {
        if (i >= NCH) return false;
        const int n = dir ? (NCH - 1 - i) : i, blk = bh * NCH + n;
        u.a = A + (size_t)blk * (256 * 256); u.b = Bt + (size_t)blk * (256 * 256); u.pm = blk; u.pn = i; u.keep = 1; u.aux = n; return true;
    }
};
struct MoeSched {
    const char* A; const char* Bt; const int* tile_e; int ntiles, nN, G, c;
    __device__ __forceinline__ bool next(int i, Unit& u) const {
        const int L = i * G + c; if (L >= ntiles * nN) return false;
        int pm, pn; tile_order(L, ntiles, nN, pm, pn);
        const int e = __builtin_amdgcn_readfirstlane(tile_e[pm]);
        u.a = A + (size_t)pm * (256 * 2048); u.b = Bt + ((size_t)e * nN + pn) * (256 * 2048); u.pm = pm; u.pn = pn; u.keep = 0; u.aux = e; return true;
    }
};
}
using pg8::Unit;

#define EPI_LOOP _Pragma("unroll") for (int ai = 0; ai < 2; ++ai) _Pragma("unroll") for (int m = 0; m < 4; ++m)
#define EPI_ROW (ai * 128 + wr * 64 + m * 16 + fr)
#define EPI_FENCE asm volatile("" ::: "memory")
typedef f32x4 Acc[2][2][4][2];

__device__ __forceinline__ void rot4(const f32x4 x1, const f32x4 x2, const f32x4 csA, const f32x4 csB, f32x4& o1, f32x4& o2) {
    o1[0] = x1[0] * csA[0] - x2[0] * csA[1]; o2[0] = x1[0] * csA[1] + x2[0] * csA[0];
    o1[1] = x1[1] * csA[2] - x2[1] * csA[3]; o2[1] = x1[1] * csA[3] + x2[1] * csA[2];
    o1[2] = x1[2] * csB[0] - x2[2] * csB[1]; o2[2] = x1[2] * csB[1] + x2[2] * csB[0];
    o1[3] = x1[3] * csB[2] - x2[3] * csB[3]; o2[3] = x1[3] * csB[3] + x2[3] * csB[2];
}
__device__ __forceinline__ f32x4 rot_il(const f32x4 v, const f32x4 cs) {
    return (f32x4){v[0] * cs[0] - v[1] * cs[1], v[0] * cs[1] + v[1] * cs[0], v[2] * cs[2] - v[3] * cs[3], v[2] * cs[3] + v[3] * cs[2]};
}

struct EpiInproj {
    bf16_t *QL, *CKV, *KR, *ACAT, *KROT, *SG, *GA, *GB; float *ssqp; const float* cs_ret; const float* cs_mla; const float* dectab; int pn_off; float unscale;
    __device__ __forceinline__ void operator()(Acc& acc, const Unit& u, int wr, int wc, int fr, int fq) const {
        asm volatile("" : "+v"(fr), "+v"(fq));
        const int pn = u.pn + pn_off, tok0 = u.pm * 256, cb = wc * 32 + fq * 8;
        if (pn < 4) {
            bf16_t* dst = QL + (size_t)(pn >> 1) * ((WS_CKV - WS_QL) / 2); float* ssq = ssqp + (size_t)(pn * 4 + wc) * T; const int c0 = (pn & 1) * 256 + cb;
            EPI_LOOP { const int row = tok0 + EPI_ROW; float s = 0.f;
#pragma unroll
                for (int bj = 0; bj < 2; ++bj) { const f32x4 v0 = acc[ai][bj][m][0], v1 = acc[ai][bj][m][1];
                    s += (v0[0] * v0[0] + v0[1] * v0[1]) + (v0[2] * v0[2] + v0[3] * v0[3]) + (v1[0] * v1[0] + v1[1] * v1[1]) + (v1[2] * v1[2] + v1[3] * v1[3]);
                    *(u32x4*)(dst + (size_t)row * 512 + c0 + bj * 128) = pack8(v0, v1); }
                s += __shfl_xor(s, 16); s += __shfl_xor(s, 32);
                if (fq == 0) ssq[row] = s; EPI_FENCE; }
        } else if (pn == 4) {
            if (wc < 2) {
                EPI_LOOP { const int row = tok0 + EPI_ROW; const float* cs = cs_mla + (size_t)row * 64 + cb;
                    const f32x4 csA = *(const f32x4*)cs, csB = *(const f32x4*)(cs + 4);
                    *(u32x4*)(KR + (size_t)row * 64 + cb) = pack8(rot_il(acc[ai][0][m][0], csA), rot_il(acc[ai][0][m][1], csB)); EPI_FENCE; }
            }
        } else if (pn < 21) {
            const bool isq = pn < 13; const int h = isq ? pn - 5 : pn - 13;
            const int blk = ((u.pm >> 4) * 8 + h) * NCH + (u.pm & 15);
            const float lf = dectab[h], lb = dectab[8 + h];
            EPI_LOOP { const int c = EPI_ROW, row = tok0 + c; const float* cs = cs_ret + (size_t)row * 256 + cb * 2;
                f32x4 q1[2], q2[2];
#pragma unroll
                for (int n = 0; n < 2; ++n) { const f32x4 csA = *(const f32x4*)(cs + n * 8), csB = *(const f32x4*)(cs + n * 8 + 4); rot4(acc[ai][0][m][n], acc[ai][1][m][n], csA, csB, q1[n], q2[n]); }
                if (isq) {
                    const float xf = __builtin_amdgcn_exp2f((float)(c + 1) * lf), xb = __builtin_amdgcn_exp2f((float)(CH - c) * lb);
                    bf16_t* base = ACAT + ((size_t)blk * 256 + c) * 768 + cb;
                    *(u32x4*)(base + 256) = pack8(q1[0] * xf, q1[1] * xf); *(u32x4*)(base + 384) = pack8(q2[0] * xf, q2[1] * xf);
                    *(u32x4*)(base + 512) = pack8(q1[0] * xb, q1[1] * xb); *(u32x4*)(base + 640) = pack8(q2[0] * xb, q2[1] * xb);
                } else {
                    bf16_t* base = KROT + ((size_t)blk * 256 + c) * 256 + cb;
                    *(u32x4*)(base) = pack8(q1[0] * 0.0625f, q1[1] * 0.0625f); *(u32x4*)(base + 128) = pack8(q2[0] * 0.0625f, q2[1] * 0.0625f);
                }
                EPI_FENCE; }
        } else {
            const int g = (pn - 21) >> 3, ct = (pn - 21) & 7; bf16_t* dst = SG + (size_t)g * ((WS_GA - WS_SG) / 2);
            EPI_LOOP { const int row = tok0 + EPI_ROW;
#pragma unroll
                for (int bj = 0; bj < 2; ++bj) { f32x4 v[2];
#pragma unroll
                    for (int n = 0; n < 2; ++n)
#pragma unroll
                        for (int j = 0; j < 4; ++j) { const float x = acc[ai][bj][m][n][j] * unscale; const float sg = sigmoidf_(x); v[n][j] = g == 0 ? x * sg : sg; }
                    *(u32x4*)(dst + (size_t)row * 2048 + ct * 256 + bj * 128 + cb) = pack8(v[0], v[1]); }
                EPI_FENCE; }
        }
    }
};
struct EpiVT {
    bf16_t* BCAT; unsigned char* VT8;
    __device__ __forceinline__ void operator()(Acc& acc, const Unit& u, int wr, int wc, int fr, int fq) const {
        asm volatile("" : "+v"(fr), "+v"(fq));
        const int blk = ((u.pn >> 4) * 8 + u.pm) * NCH + (u.pn & 15), cb = wc * 32 + fq * 8;
        EPI_LOOP { bf16_t* base = BCAT + ((size_t)blk * 256 + EPI_ROW) * 768 + cb; unsigned char* b8 = VT8 + ((size_t)blk * 256 + EPI_ROW) * 256 + cb;
#pragma unroll
            for (int bj = 0; bj < 2; ++bj) { const f32x4 v0 = acc[ai][bj][m][0], v1 = acc[ai][bj][m][1]; *(u32x4*)(base + bj * 128) = pack8(v0, v1);
                u32x2 w8; w8.x = pk4_fp8(v0[0], v0[1], v0[2], v0[3], V8_SCALE); w8.y = pk4_fp8(v1[0], v1[1], v1[2], v1[3], V8_SCALE); *(u32x2*)(b8 + bj * 128) = w8; } }
    }
};
struct EpiInprojAll {
    EpiInproj a; EpiVT b;
    __device__ __forceinline__ void operator()(Acc& acc, const Unit& u, int wr, int wc, int fr, int fq) const { if (u.aux) b(acc, u, wr, wc, fr, fq); else a(acc, u, wr, wc, fr, fq); }
};
struct EpiMlaQ {
    bf16_t *QN, *QR; const float* ssq; const float* cs_mla;
    __device__ __forceinline__ void operator()(Acc& acc, const Unit& u, int wr, int wc, int fr, int fq) const {
        asm volatile("" : "+v"(fr), "+v"(fq));
        const int pn = u.pn, tok0 = u.pm * 256, cb = wc * 32 + fq * 8;
        EPI_LOOP { const int row = tok0 + EPI_ROW; float ss = 0.f;
#pragma unroll
            for (int q = 0; q < 8; ++q) ss += ssq[(size_t)q * T + row];
            const float rs = rsqrtf(ss * (1.0f / 512.0f) + RMS_EPS) * QSCALE;
            if (pn < 4) {
#pragma unroll
                for (int bj = 0; bj < 2; ++bj) *(u32x4*)(QN + (size_t)row * 1024 + (2 * pn + bj) * 128 + cb) = pack8(acc[ai][bj][m][0] * rs, acc[ai][bj][m][1] * rs);
            } else {
                const int c0 = (wc & 1) * 32 + fq * 8; const float* cs = cs_mla + (size_t)row * 64 + c0;
                const f32x4 csA = *(const f32x4*)cs, csB = *(const f32x4*)(cs + 4);
#pragma unroll
                for (int bj = 0; bj < 2; ++bj) { const int head = 4 * (pn - 4) + 2 * bj + (wc >> 1);
                    *(u32x4*)(QR + (size_t)row * 512 + head * 64 + c0) = pack8(rot_il(acc[ai][bj][m][0], csA) * rs, rot_il(acc[ai][bj][m][1], csB) * rs); }
            }
            EPI_FENCE; }
    }
};
struct EpiMlaKV {
    bf16_t *KN, *VV; const float* ssq;
    __device__ __forceinline__ void operator()(Acc& acc, const Unit& u, int wr, int wc, int fr, int fq) const {
        asm volatile("" : "+v"(fr), "+v"(fq));
        const int pn = u.pn, tok0 = u.pm * 256, cb = wc * 32 + fq * 8; bf16_t* dst = KN + (size_t)(pn >> 2) * ((WS_VV - WS_KN) / 2); const int hb = 2 * (pn & 3);
        EPI_LOOP { const int row = tok0 + EPI_ROW; float ss = 0.f;
#pragma unroll
            for (int q = 0; q < 8; ++q) ss += ssq[(size_t)q * T + row];
            const float rs = rsqrtf(ss * (1.0f / 512.0f) + RMS_EPS);
#pragma unroll
            for (int bj = 0; bj < 2; ++bj) *(u32x4*)(dst + (size_t)row * 1024 + (hb + bj) * 128 + cb) = pack8(acc[ai][bj][m][0] * rs, acc[ai][bj][m][1] * rs); }
    }
};
struct EpiGa {
    bf16_t* ACAT; const float* dectab;
    __device__ __forceinline__ void operator()(Acc& acc, const Unit& u, int wr, int wc, int fr, int fq) const {
        asm volatile("" : "+v"(fr), "+v"(fq));
        const int blk = u.pm, h = (blk >> 4) & 7, cb = wc * 32 + fq * 8;
        const float lf = dectab[h], lb = dectab[8 + h];
        f32x4 colA[2][2], colB[2][2];
#pragma unroll
        for (int bj = 0; bj < 2; ++bj)
#pragma unroll
            for (int n = 0; n < 2; ++n)
#pragma unroll
                for (int j = 0; j < 4; ++j) { const int mm = bj * 128 + cb + n * 4 + j; colA[bj][n][j] = __builtin_amdgcn_exp2f(-(float)(mm + 1) * lf); colB[bj][n][j] = __builtin_amdgcn_exp2f((float)mm * lb); }
        EPI_LOOP { const int c = EPI_ROW; bf16_t* base = ACAT + ((size_t)blk * 256 + c) * 768 + cb;
            const float rowB = __builtin_amdgcn_exp2f(-(float)c * lb - (float)(c + 1) * lf);
#pragma unroll
            for (int bj = 0; bj < 2; ++bj) { f32x4 v[2];
#pragma unroll
                for (int n = 0; n < 2; ++n)
#pragma unroll
                    for (int j = 0; j < 4; ++j) { const int mm = bj * 128 + cb + n * 4 + j;
                        v[n][j] = acc[ai][bj][m][n][j] * ((c >= mm) ? colA[bj][n][j] : colB[bj][n][j] * rowB); }
                *(u32x4*)(base + bj * 128) = pack8(v[0], v[1]); }
            EPI_FENCE; }
    }
};
struct EpiGb {
    bf16_t* BCAT; const float* dectab; int dir;
    __device__ __forceinline__ void operator()(Acc& acc, const Unit& u, int wr, int wc, int fr, int fq) const {
        asm volatile("" : "+v"(fr), "+v"(fq));
        const int h = (u.pm >> 4) & 7;
        const float gC = __builtin_amdgcn_exp2f((float)CH * dectab[8 * dir + h]);
        if (u.pn < NCH - 1) {
            const int nblk = dir ? u.pm - 1 : u.pm + 1;
            bf16_t* base0 = BCAT + ((size_t)nblk * 256 + wr * 64 + fr) * 768 + 256 + 256 * dir + wc * 32 + fq * 8;
            EPI_LOOP { bf16_t* base = base0 + (size_t)(ai * 128 + m * 16) * 768;
#pragma unroll
                for (int bj = 0; bj < 2; ++bj) *(u32x4*)(base + bj * 128) = pack8(acc[ai][bj][m][0] * CH_UNSCALE, acc[ai][bj][m][1] * CH_UNSCALE); }
        }
        EPI_LOOP {
#pragma unroll
            for (int bj = 0; bj < 2; ++bj) { acc[ai][bj][m][0] *= gC; acc[ai][bj][m][1] *= gC; } }
    }
};
struct EpiGc {
    bf16_t* OB; const bf16_t* SG; const float* gn; LAS unsigned char* lds;
    __device__ __forceinline__ void operator()(Acc& acc, const Unit& u, int wr, int wc, int fr, int fq) const {
        asm volatile("" : "+v"(fr), "+v"(fq));
        const int blk = u.pm, b = blk >> 7, h = (blk >> 4) & 7, n = blk & 15, cb = wc * 32 + fq * 8;
        LAS f32x2* P = (LAS f32x2*)(lds + RING_BYTES);
        EPI_LOOP { float s = 0.f;
#pragma unroll
            for (int bj = 0; bj < 2; ++bj)
#pragma unroll
                for (int nn = 0; nn < 2; ++nn) { const f32x4 x = acc[ai][bj][m][nn]; s += (x[0] + x[1]) + (x[2] + x[3]); }
            s += __shfl_xor(s, 16); s += __shfl_xor(s, 32);
            const float mw = s * (1.0f / 64.0f); float q = 0.f;
#pragma unroll
            for (int bj = 0; bj < 2; ++bj)
#pragma unroll
                for (int nn = 0; nn < 2; ++nn) { const f32x4 d = acc[ai][bj][m][nn] - mw; q += (d[0] * d[0] + d[1] * d[1]) + (d[2] * d[2] + d[3] * d[3]); }
            q += __shfl_xor(q, 16); q += __shfl_xor(q, 32);
            if (fq == 0) P[EPI_ROW * 4 + wc] = (f32x2){mw, q}; }
        asm volatile("s_waitcnt lgkmcnt(0)" ::: "memory"); __builtin_amdgcn_s_barrier(); asm volatile("" ::: "memory");
        EPI_LOOP { const int row = EPI_ROW; const f32x4 p01 = *(const LAS f32x4*)(P + row * 4), p23 = *(const LAS f32x4*)(P + row * 4 + 2);
            const float mean = ((p01[0] + p01[2]) + (p23[0] + p23[2])) * 0.25f;
            const float d0 = p01[0] - mean, d1 = p01[2] - mean, d2 = p23[0] - mean, d3 = p23[2] - mean;
            const float m2 = ((p01[1] + p01[3]) + (p23[1] + p23[3])) + 64.0f * ((d0 * d0 + d1 * d1) + (d2 * d2 + d3 * d3));
            const float rstd = rsqrtf(m2 * (1.0f / 256.0f) + GN_EPS);
            const size_t off = ((size_t)b * SEQ + n * 256 + row) * 2048 + h * 256 + cb;
#pragma unroll
            for (int bj = 0; bj < 2; ++bj) { f32x4 s0, s1; unpack8(*(const u32x4*)(SG + off + bj * 128), s0, s1);
                const f32x4 g0 = *(const f32x4*)(gn + h * 256 + bj * 128 + cb), g1 = *(const f32x4*)(gn + h * 256 + bj * 128 + cb + 4);
                *(u32x4*)(OB + off + bj * 128) = pack8(s0 * ((acc[ai][bj][m][0] - mean) * rstd * g0), s1 * ((acc[ai][bj][m][1] - mean) * rstd * g1)); }
            EPI_FENCE; }
    }
};
struct EpiMixA {
    bf16_t* MIXP; const bf16_t* GA;
    __device__ __forceinline__ void operator()(Acc& acc, const Unit& u, int wr, int wc, int fr, int fq) const {
        asm volatile("" : "+v"(fr), "+v"(fq));
        const int cb = wc * 32 + fq * 8;
        EPI_LOOP { const size_t off = (size_t)(u.pm * 256 + EPI_ROW) * 2048 + u.pn * 256 + cb;
#pragma unroll
            for (int bj = 0; bj < 2; ++bj) { f32x4 g0, g1; unpack8(*(const u32x4*)(GA + off + bj * 128), g0, g1);
                *(u32x4*)(MIXP + off + bj * 128) = pack8(acc[ai][bj][m][0] * g0, acc[ai][bj][m][1] * g1); }
            EPI_FENCE; }
    }
};
struct EpiMixB {
    bf16_t* MIXIN; const bf16_t* MIXP; const bf16_t* GB;
    __device__ __forceinline__ void operator()(Acc& acc, const Unit& u, int wr, int wc, int fr, int fq) const {
        asm volatile("" : "+v"(fr), "+v"(fq));
        const int cb = wc * 32 + fq * 8;
        EPI_LOOP { const size_t off = (size_t)(u.pm * 256 + EPI_ROW) * 2048 + u.pn * 256 + cb;
#pragma unroll
            for (int bj = 0; bj < 2; ++bj) { f32x4 g0, g1, p0, p1; unpack8(*(const u32x4*)(GB + off + bj * 128), g0, g1); unpack8(*(const u32x4*)(MIXP + off + bj * 128), p0, p1);
                const f32x4 y0 = acc[ai][bj][m][0] * g0 + p0, y1 = acc[ai][bj][m][1] * g1 + p1;
                u32x2 w8; w8.x = pk4_fp8(y0[0], y0[1], y0[2], y0[3], M8_SCALE); w8.y = pk4_fp8(y1[0], y1[1], y1[2], y1[3], M8_SCALE); *(u32x2*)((unsigned char*)MIXIN + off + bj * 128) = w8; }
            EPI_FENCE; }
    }
};
struct EpiF32 {
    bf16_t* C;
    __device__ __forceinline__ void operator()(Acc& acc, const Unit& u, int wr, int wc, int fr, int fq) const {
        asm volatile("" : "+v"(fr), "+v"(fq));
        const int cb = wc * 32 + fq * 8;
        EPI_LOOP { bf16_t* base = C + (size_t)(u.pm * 256 + EPI_ROW) * 2048 + u.pn * 256 + cb;
#pragma unroll
            for (int bj = 0; bj < 2; ++bj) *(u32x4*)(base + bj * 128) = pack8(acc[ai][bj][m][0] * MX_UNSCALE, acc[ai][bj][m][1] * MX_UNSCALE); }
    }
};
struct EpiGU {
    bf16_t* ACT; const float* bgu; int skip;
    __device__ __forceinline__ void operator()(Acc& acc, const Unit& u, int wr, int wc, int fr, int fq) const {
        asm volatile("" : "+v"(fr), "+v"(fq));
        if (skip) return;
        const int cb = wc * 32 + fq * 8, col = u.pn * 128 + cb; const float* bg = bgu + (size_t)u.aux * 4096 + col;
        const f32x4 bg0 = *(const f32x4*)bg, bg1 = *(const f32x4*)(bg + 4), bu0 = *(const f32x4*)(bg + 2048), bu1 = *(const f32x4*)(bg + 2052);
        EPI_LOOP { f32x4 v[2];
#pragma unroll
            for (int n = 0; n < 2; ++n)
#pragma unroll
                for (int j = 0; j < 4; ++j) { const float gt = fminf(acc[ai][0][m][n][j] * GU_UNSCALE + (n ? bg1[j] : bg0[j]), 7.0f); const float up = fminf(fmaxf(acc[ai][1][m][n][j] * GU_UNSCALE + (n ? bu1[j] : bu0[j]), -7.0f), 7.0f);
                    v[n][j] = (up + 1.0f) * gt * sigmoidf_(1.702f * gt); }
            u32x2 w8; w8.x = pk4_fp8(v[0][0], v[0][1], v[0][2], v[0][3], A8_SCALE); w8.y = pk4_fp8(v[1][0], v[1][1], v[1][2], v[1][3], A8_SCALE);
            *(u32x2*)((unsigned char*)ACT + (size_t)(u.pm * 256 + EPI_ROW) * 2048 + col) = w8; EPI_FENCE; }
    }
};
struct EpiDown {
    bf16_t* YS; const float* bd;
    __device__ __forceinline__ void operator()(Acc& acc, const Unit& u, int wr, int wc, int fr, int fq) const {
        asm volatile("" : "+v"(fr), "+v"(fq));
        const int cb = wc * 32 + fq * 8; const float* bp = bd + (size_t)u.aux * 2048 + u.pn * 256 + cb;
        f32x4 bv[2][2];
#pragma unroll
        for (int bj = 0; bj < 2; ++bj) { bv[bj][0] = *(const f32x4*)(bp + bj * 128); bv[bj][1] = *(const f32x4*)(bp + bj * 128 + 4); }
        EPI_LOOP { bf16_t* base = YS + (size_t)(u.pm * 256 + EPI_ROW) * 2048 + u.pn * 256 + cb;
#pragma unroll
            for (int bj = 0; bj < 2; ++bj) *(u32x4*)(base + bj * 128) = pack8(acc[ai][bj][m][0] * DN_UNSCALE + bv[bj][0], acc[ai][bj][m][1] * DN_UNSCALE + bv[bj][1]); }
    }
};

namespace att {
constexpr int NW = 8, QBLK = 32, KVBLK = 64;
constexpr float THR = 8.f;
constexpr int SHM_V = KVBLK * 128 * 2, SHM_KN = KVBLK * 128 * 2, SHM_KR = KVBLK * 64 * 2, NVB = 3, SHM_ATTN = NVB * SHM_V + 2 * SHM_KN + 2 * SHM_KR + NW * 64 * 4;
#define KSWZ(row, colB) ((row) * 256 + ((colB) ^ (((row) & 15) << 4)))
#define KSWZR(row, colB) ((row) * 128 + ((colB) ^ ((((row) >> 1) & 7) << 4)))
#define SBAR() __builtin_amdgcn_sched_barrier(0)
__device__ __forceinline__ int crow(int r, int hi) { return (r & 3) + 8 * (r >> 2) + 4 * hi; }
__device__ __forceinline__ void partialSM(f32x16& p0, f32x16& p1, float& m_reg, float& mn, float& alpha) {
    constexpr float C = 1.4426950408889634f;
    float pmax = p0[0];
#pragma unroll
    for (int r = 1; r < 16; ++r) pmax = fmaxf(pmax, p0[r]);
#pragma unroll
    for (int r = 0; r < 16; ++r) pmax = fmaxf(pmax, p1[r]);
    { auto rr = __builtin_amdgcn_permlane32_swap(__float_as_uint(pmax), __float_as_uint(pmax), false, false);
      pmax = fmaxf(__uint_as_float(rr[0]), __uint_as_float(rr[1])); }
    if (__builtin_expect(__all(pmax - m_reg <= THR), 1)) { mn = m_reg; alpha = 1.f; }
    else { mn = fmaxf(m_reg, pmax); alpha = __builtin_amdgcn_exp2f((m_reg - mn) * C); m_reg = mn; }
    const float mnC = -mn * C;
#pragma unroll
    for (int r = 0; r < 16; ++r) p0[r] = fmaf(p0[r], C, mnC);
#pragma unroll
    for (int r = 0; r < 16; ++r) p1[r] = fmaf(p1[r], C, mnC);
#pragma unroll
    for (int r = 0; r < 16; ++r) p0[r] = __builtin_amdgcn_exp2f(p0[r]);
}
__device__ __forceinline__ void finishSM(f32x16& p0, f32x16& p1, float alpha, float& l_reg, bf16x8& pa0, bf16x8& pa1, bf16x8& pa2, bf16x8& pa3) {
#pragma unroll
    for (int r = 0; r < 16; ++r) p1[r] = __builtin_amdgcn_exp2f(p1[r]);
    float ps = 0;
#pragma unroll
    for (int r = 0; r < 16; ++r) ps += p0[r];
#pragma unroll
    for (int r = 0; r < 16; ++r) ps += p1[r];
    { auto rr = __builtin_amdgcn_permlane32_swap(__float_as_uint(ps), __float_as_uint(ps), false, false);
      ps = __uint_as_float(rr[0]) + __uint_as_float(rr[1]); }
    l_reg = l_reg * alpha + ps;
#define PK4(P, BASE, OUT) do { unsigned a0 = cvt_pk_bf16(P[BASE + 0], P[BASE + 1]), a1 = cvt_pk_bf16(P[BASE + 2], P[BASE + 3]);   \
    unsigned b0 = cvt_pk_bf16(P[BASE + 4], P[BASE + 5]), b1 = cvt_pk_bf16(P[BASE + 6], P[BASE + 7]);                              \
    auto r0 = __builtin_amdgcn_permlane32_swap(a0, b0, false, false); auto r1 = __builtin_amdgcn_permlane32_swap(a1, b1, false, false); \
    u32x4 w = {r0[0], r1[0], r0[1], r1[1]}; OUT = *reinterpret_cast<bf16x8*>(&w); } while (0)
    PK4(p0, 0, pa0); PK4(p0, 8, pa1); PK4(p1, 0, pa2); PK4(p1, 8, pa3);
#undef PK4
}
__device__ __forceinline__ void qkt(f32x16& p0, f32x16& p1, const char* Kns, const char* Krs, const bf16x8* qr, int r32, int hi) {
    p0 = f32x16{}; p1 = f32x16{};
#pragma unroll
    for (int d0 = 0; d0 < 12; ++d0) { const int cb = ((d0 & 7) * 16 + hi * 8) * 2;
        const bf16x8 b0 = *reinterpret_cast<const bf16x8*>(d0 < 8 ? Kns + KSWZ(r32, cb) : Krs + KSWZR(r32, cb));
        const bf16x8 b1 = *reinterpret_cast<const bf16x8*>(d0 < 8 ? Kns + KSWZ(32 + r32, cb) : Krs + KSWZR(32 + r32, cb));
        p0 = __builtin_amdgcn_mfma_f32_32x32x16_bf16(b0, qr[d0], p0, 0, 0, 0);
        p1 = __builtin_amdgcn_mfma_f32_32x32x16_bf16(b1, qr[d0], p1, 0, 0, 0); }
}
__device__ __forceinline__ int v_st(int k, int c) { const int kk = (k & ~0xC) | ((k & 4) << 1) | ((k & 8) >> 1); return ((kk >> 3) * 4 + (c >> 5)) * 512 + ((kk & 7) * 32 + (c & 31)) * 2; }
__device__ __forceinline__ int v_rd_base(int lane) { return ((lane & 3) << 3) | (((lane >> 2) & 3) << 6) | (((lane >> 4) & 1) << 5) | (((lane >> 5) & 1) << 8); }
constexpr int v_rd_off(int d0, int ks, int half) { return d0 * 512 + ks * 4096 + half * 2048; }
template <int OFF> __device__ __forceinline__ s16x4 tr_read(int vb) {
    s16x4 r; asm volatile("ds_read_b64_tr_b16 %0, %1 offset:%2" : "=&v"(r) : "v"(vb), "i"(OFF) : "memory"); return r;
}
template <int D0> __device__ __forceinline__ void pv_one(f32x16& od, int vb, bf16x8 pa0, bf16x8 pa1, bf16x8 pa2, bf16x8 pa3) {
    const s16x4 l0 = tr_read<v_rd_off(D0, 0, 0)>(vb), h0 = tr_read<v_rd_off(D0, 0, 1)>(vb), l1 = tr_read<v_rd_off(D0, 1, 0)>(vb), h1 = tr_read<v_rd_off(D0, 1, 1)>(vb);
    const s16x4 l2 = tr_read<v_rd_off(D0, 2, 0)>(vb), h2 = tr_read<v_rd_off(D0, 2, 1)>(vb), l3 = tr_read<v_rd_off(D0, 3, 0)>(vb), h3 = tr_read<v_rd_off(D0, 3, 1)>(vb);
    asm volatile("s_waitcnt lgkmcnt(0)" ::: "memory"); SBAR();
#define PKV(L, H) (bf16x8){L[0], L[1], L[2], L[3], H[0], H[1], H[2], H[3]}
    od = __builtin_amdgcn_mfma_f32_32x32x16_bf16(pa0, PKV(l0, h0), od, 0, 0, 0);
    od = __builtin_amdgcn_mfma_f32_32x32x16_bf16(pa1, PKV(l1, h1), od, 0, 0, 0);
    od = __builtin_amdgcn_mfma_f32_32x32x16_bf16(pa2, PKV(l2, h2), od, 0, 0, 0);
    od = __builtin_amdgcn_mfma_f32_32x32x16_bf16(pa3, PKV(l3, h3), od, 0, 0, 0);
#undef PKV
}
__device__ __forceinline__ void pv_d0(f32x16* o, int vb, bf16x8 pa0, bf16x8 pa1, bf16x8 pa2, bf16x8 pa3) {
    pv_one<0>(o[0], vb, pa0, pa1, pa2, pa3); pv_one<1>(o[1], vb, pa0, pa1, pa2, pa3); pv_one<2>(o[2], vb, pa0, pa1, pa2, pa3); pv_one<3>(o[3], vb, pa0, pa1, pa2, pa3);
}
__device__ __forceinline__ void attn_unit(const bf16_t* __restrict__ Qn, const bf16_t* __restrict__ Qr, const bf16_t* __restrict__ Kn, const bf16_t* __restrict__ Kr,
                                          const bf16_t* __restrict__ Vh, bf16_t* __restrict__ Ob, int seq, char* lds) {
    const int tid = threadIdx.x, wid = __builtin_amdgcn_readfirstlane(tid >> 6), lane = tid & 63, r32 = lane & 31, hi = lane >> 5;
    char* V_lds = lds; char* Kn_lds = lds + NVB * SHM_V; char* Kr_lds = Kn_lds + 2 * SHM_KN;
    float* ws = (float*)(Kr_lds + 2 * SHM_KR) + wid * 64; float* li_l = ws; float* al_l = ws + 32;
    float m_reg = -1e30f, l_reg = 0; f32x16 o[4] = {}; bf16x8 qr[12];
    { const bf16_t* q0 = Qn + (long)(wid * QBLK + r32) * 1024 + hi * 8; const bf16_t* q1 = Qr + (long)(wid * QBLK + r32) * 512 + hi * 8;
#pragma unroll
      for (int d0 = 0; d0 < 8; ++d0) qr[d0] = *reinterpret_cast<const bf16x8*>(q0 + d0 * 16);
#pragma unroll
      for (int d0 = 0; d0 < 4; ++d0) qr[8 + d0] = *reinterpret_cast<const bf16x8*>(q1 + d0 * 16); }
    const int vb0 = (int)(uintptr_t)V_lds + v_rd_base(lane);
    unsigned offV[2], offKn[2], offKr;
#pragma unroll
    for (int t = 0; t < 2; ++t) {
        { const int sub = 2 * (2 * wid + t) + (lane >> 5), kk = (sub >> 2) * 8 + ((lane & 31) >> 2), k = (kk & ~0xC) | ((kk & 4) << 1) | ((kk & 8) >> 1), c = (sub & 3) * 32 + (lane & 3) * 8; offV[t] = (unsigned)(k * 1024 + c) * 2u; }
        { const int row = 4 * (2 * wid + t) + (lane >> 4), colB = ((lane & 15) * 16) ^ ((row & 15) << 4); offKn[t] = (unsigned)(row * 1024) * 2u + (unsigned)colB; } }
    { const int row = 8 * wid + (lane >> 3), colB = ((lane & 7) * 16) ^ (((row >> 1) & 7) << 4); offKr = (unsigned)(row * 64) * 2u + (unsigned)colB; }
#define LASP(p) ((LAS unsigned*)(unsigned)(uintptr_t)(p))
#define SLOAD(k0, b, bv) do { _Pragma("unroll") for (int t = 0; t < 2; ++t) { \
        __builtin_amdgcn_global_load_lds((const unsigned*)((const char*)Vh + (size_t)(k0) * 2048 + offV[t]), LASP(V_lds + (bv) * SHM_V + (2 * wid + t) * 1024), 16, 0, 0); \
        __builtin_amdgcn_global_load_lds((const unsigned*)((const char*)Kn + (size_t)(k0) * 2048 + offKn[t]), LASP(Kn_lds + (b) * SHM_KN + (2 * wid + t) * 1024), 16, 0, 0); } \
        __builtin_amdgcn_global_load_lds((const unsigned*)((const char*)Kr + (size_t)(k0) * 128 + offKr), LASP(Kr_lds + (b) * SHM_KR + wid * 1024), 16, 0, 0); } while (0)
#define SWAIT() asm volatile("s_waitcnt vmcnt(0)" ::: "memory")
#define RESC(a) do { if (__any((a) < 1.f)) { if (hi == 0) al_l[r32] = (a); asm volatile("s_waitcnt lgkmcnt(0)" ::: "memory"); \
    _Pragma("unroll") for (int d = 0; d < 4; ++d) _Pragma("unroll") for (int r = 0; r < 16; ++r) o[d][r] *= al_l[crow(r, hi)]; } } while (0)
    f32x16 p0, p1; float mn, al; bf16x8 pa0, pa1, pa2, pa3; const int NT = seq / KVBLK;
    SLOAD(0, 0, 0); SWAIT(); __syncthreads();
    if (wid < 4) {
        int bv = 0;
        for (int j = 0; j < NT; ++j) {
            const int buf = j & 1, bvn = bv == NVB - 1 ? 0 : bv + 1;
            if (j + 1 < NT) SLOAD((j + 1) * KVBLK, buf ^ 1, bvn);
            SBAR(); qkt(p0, p1, Kn_lds + buf * SHM_KN, Kr_lds + buf * SHM_KR, qr, r32, hi);
            partialSM(p0, p1, m_reg, mn, al);
            RESC(al);
            finishSM(p0, p1, al, l_reg, pa0, pa1, pa2, pa3); SBAR();
            pv_d0(o, vb0 + bv * SHM_V, pa0, pa1, pa2, pa3);
            SWAIT();
            __syncthreads();
            bv = bvn;
        }
    } else {
        int bv = 0, bvp = 0;
        for (int j = 0; j < NT; ++j) {
            const int buf = j & 1, bvn = bv == NVB - 1 ? 0 : bv + 1;
            if (j + 1 < NT) SLOAD((j + 1) * KVBLK, buf ^ 1, bvn);
            if (j > 0) { SBAR(); pv_d0(o, vb0 + bvp * SHM_V, pa0, pa1, pa2, pa3); SBAR(); }
            SBAR(); qkt(p0, p1, Kn_lds + buf * SHM_KN, Kr_lds + buf * SHM_KR, qr, r32, hi);
            partialSM(p0, p1, m_reg, mn, al);
            RESC(al);
            finishSM(p0, p1, al, l_reg, pa0, pa1, pa2, pa3); SBAR();
            SWAIT();
            __syncthreads();
            bvp = bv; bv = bvn;
        }
        SBAR(); pv_d0(o, vb0 + bvp * SHM_V, pa0, pa1, pa2, pa3);
    }
    if (hi == 0) li_l[r32] = l_reg; asm volatile("s_waitcnt lgkmcnt(0)" ::: "memory");
    float rli[16];
#pragma unroll
    for (int r = 0; r < 16; ++r) rli[r] = __builtin_amdgcn_rcpf(li_l[crow(r, hi)]);
    bf16_t* Ow = Ob + (long)(wid * QBLK) * 1024;
#pragma unroll
    for (int r = 0; r < 16; ++r) { const int orow = crow(r, hi);
#pragma unroll
        for (int d0 = 0; d0 < 4; ++d0) Ow[(long)orow * 1024 + d0 * 32 + r32] = (bf16_t)(cvt_pk_bf16(o[d0][r] * rli[r], 0.f) & 0xffffu); }
#undef SLOAD
#undef LASP
#undef SWAIT
#undef RESC
}
}

struct Args { const float* in[26]; float* out; unsigned char* ws; int ph_lo, ph_hi; };
enum { PH_SETUP = 0, PH_H, PH_INPROJ, PH_INPROJ_V, PH_KT, PH_CHAIN, PH_MLAQ, PH_MLAKV, PH_GA, PH_ATTN, PH_GC, PH_MIXA, PH_GN, PH_MIXB, PH_MIX, PH_ROUTER, PH_DISPATCH, PH_GU, PH_DOWN, PH_COMBINE, NPH };
enum { I_X = 0, I_C, I_POS, I_WADA, I_BADA, I_GPREM, I_GPOSTM, I_GPREF, I_GPOSTF, I_WIN, I_QAN, I_WQB, I_KVAN, I_WKVB, I_WMLAO, I_DECF, I_DECB, I_RETGN, I_WRETO, I_WOUT, I_WROUTER, I_BROUTER, I_WGU, I_BGU, I_WDOWN, I_BDOWN };

__device__ __forceinline__ int src_in(int r) {
    if (r < 1024) return r;
    if (r < 1088) { const int j = r - 1024; return 1024 + (j >> 1) + 32 * (j & 1); }
    if (r < 1280) return -1;
    if (r < N_IN_NAT) { const int g = (r - 1280) >> 11, off = (r - 1280) & 2047; const int base = g == 0 ? 1088 : (g == 1 ? 3136 : (g == 2 ? 7232 : (g == 3 ? 9280 : 11328))); return base + off; }
    return 5184 + (r - N_IN_NAT);
}
__device__ __forceinline__ int src_qb(int r) { if (r < 1024) return (r >> 7) * 192 + (r & 127); const int j = r - 1024, h = j >> 6, jj = j & 63; return h * 192 + 128 + (jj >> 1) + 32 * (jj & 1); }
__device__ __forceinline__ int src_kvb(int r) { if (r < 1024) return (r >> 7) * 256 + (r & 127); const int j = r - 1024; return (j >> 7) * 256 + 128 + (j & 127); }
__device__ __forceinline__ int src_gu(int r) { const int t = r >> 8, rr = r & 255; return rr < 128 ? 128 * t + rr : 2048 + 128 * t + rr - 128; }

__device__ __forceinline__ void cvt_item(const float* __restrict__ W, int ldw, int K, bf16_t* __restrict__ WT, const float* __restrict__ kscale, int sc, int k0, int r0, LAS float* scr, int lane) {
    float v[64];
    const float* wp = W + (size_t)k0 * ldw + (sc >= 0 ? sc : 0);
#pragma unroll
    for (int i = 0; i < 64; ++i) v[i] = wp[(size_t)i * ldw];
    if (sc < 0) {
#pragma unroll
        for (int i = 0; i < 64; ++i) v[i] = 0.f;
    }
    if (kscale) {
#pragma unroll
        for (int i = 0; i < 64; ++i) v[i] *= kscale[k0 + i];
    }
#pragma unroll
    for (int i = 0; i < 64; ++i) scr[i * 65 + lane] = v[i];
    asm volatile("s_waitcnt lgkmcnt(0)" ::: "memory");
    const int c = lane & 7;
#pragma unroll
    for (int j = 0; j < 8; ++j) { const int n = (lane >> 3) + 8 * j; const LAS float* s = scr + (8 * c) * 65 + n;
        u32x4 o; o.x = cvt_pk_bf16(s[0 * 65], s[1 * 65]); o.y = cvt_pk_bf16(s[2 * 65], s[3 * 65]); o.z = cvt_pk_bf16(s[4 * 65], s[5 * 65]); o.w = cvt_pk_bf16(s[6 * 65], s[7 * 65]);
        *(u32x4*)(WT + (size_t)(r0 + n) * K + k0 + 8 * c) = o; }
    asm volatile("s_waitcnt lgkmcnt(0)" ::: "memory");
}

constexpr int XT_NT_GU = 32 * 16 * 16, XT_NT_ALL = XT_NT_GU + 32 * 16 * 8;
__device__ __forceinline__ void xt_convert_tiles(int q0, const int qs, const int qe, const float* __restrict__ wgu, const float* __restrict__ wdn, bf16_t* WT_GU, bf16_t* WT_DOWN, LAS unsigned char* lds, const int lane, const int wave) {
    constexpr int NT_GU = XT_NT_GU, TS = 144;
    f32x4 va[16], vb[16], vc[16];
#define XT_SRC(q_, kk_) ((q_) < NT_GU ? wgu + ((size_t)((q_) >> 8) * 2048 + (((q_) >> 4) & 15) * 128 + 16 * wave + (kk_)) * 4096 + (lane < 32 ? 128 * ((q_) & 15) + 4 * lane : 2048 + 128 * ((q_) & 15) + 4 * lane - 128) \
                                  : wdn + ((size_t)(((q_) - NT_GU) >> 7) * 2048 + ((((q_) - NT_GU) >> 3) & 15) * 128 + 16 * wave + (kk_)) * 2048 + 256 * (((q_) - NT_GU) & 7) + 4 * lane)
#define XT_LOAD(v_, q_) do { const float* _p = XT_SRC(q_, 0); const size_t _ld = (q_) < NT_GU ? 4096 : 2048; _Pragma("unroll") for (int kk = 0; kk < 16; ++kk) v_[kk] = __builtin_nontemporal_load((const f32x4*)(_p + kk * _ld)); } while (0)
#define XT_PROC(v_, q_, buf_) do { LAS unsigned char* _T = lds + (buf_) * (256 * TS); \
        _Pragma("unroll") for (int i = 0; i < 4; ++i) { u32x4 w0; \
            w0.x = pk4_fp8(v_[0][i], v_[1][i], v_[2][i], v_[3][i], W8_SCALE); w0.y = pk4_fp8(v_[4][i], v_[5][i], v_[6][i], v_[7][i], W8_SCALE); \
            w0.z = pk4_fp8(v_[8][i], v_[9][i], v_[10][i], v_[11][i], W8_SCALE); w0.w = pk4_fp8(v_[12][i], v_[13][i], v_[14][i], v_[15][i], W8_SCALE); \
            *(LAS u32x4*)(_T + (4 * lane + i) * TS + 16 * wave) = w0; } \
        __syncthreads(); \
        unsigned char* _d = (q_) < NT_GU ? (unsigned char*)WT_GU + ((size_t)((q_) >> 8) * 4096 + 256 * ((q_) & 15)) * 2048 + (((q_) >> 4) & 15) * 128 \
                 : (unsigned char*)WT_DOWN + ((size_t)(((q_) - NT_GU) >> 7) * 2048 + 256 * (((q_) - NT_GU) & 7)) * 2048 + ((((q_) - NT_GU) >> 3) & 15) * 128; \
        _Pragma("unroll") for (int j = 0; j < 4; ++j) { const int row = 32 * wave + 8 * j + (lane >> 3); \
            const u32x4 o = *(const LAS u32x4*)(_T + row * TS + (lane & 7) * 16); __builtin_nontemporal_store(o, (u32x4*)(_d + (size_t)row * 2048 + (lane & 7) * 16)); } } while (0)
    int q = q0;
    if (q < qe) XT_LOAD(va, q);
    if (q + qs < qe) XT_LOAD(vb, q + qs);
    while (q < qe) {
        const int q1 = q + qs, q2 = q1 + qs, q3 = q2 + qs, q4 = q3 + qs;
        if (q2 < qe) XT_LOAD(vc, q2);
        XT_PROC(va, q, 0);
        if (q1 >= qe) break;
        if (q3 < qe) XT_LOAD(va, q3);
        XT_PROC(vb, q1, 1);
        if (q2 >= qe) break;
        if (q4 < qe) XT_LOAD(vb, q4);
        XT_PROC(vc, q2, 2);
        q = q3;
    }
    __syncthreads();
#undef XT_SRC
#undef XT_LOAD
#undef XT_PROC
}
__host__ __device__ constexpr bool is_seam(int k) { return k == PH_SETUP || k == PH_H || k == PH_INPROJ_V || k == PH_KT || k == PH_GA || k == PH_ATTN || k == PH_MIXA || k == PH_MIXB || k == PH_MIX || k == PH_ROUTER || k == PH_DISPATCH || k == PH_GU || k == PH_DOWN; }
__host__ __device__ constexpr int seam_after(int ph) { int k = ph; while (k < NPH && !is_seam(k)) ++k; return k; }
__host__ __device__ constexpr int seam_before(int ph) { int k = ph - 1; while (k >= 0 && !is_seam(k)) --k; return k; }
__device__ __forceinline__ const void* larg(volatile LAS unsigned long long* L, int i) {
    const unsigned long long v = L[i]; const unsigned l0 = __builtin_amdgcn_readfirstlane((unsigned)v), h0 = __builtin_amdgcn_readfirstlane((unsigned)(v >> 32));
    return (const void*)(const __attribute__((address_space(1))) void*)(((unsigned long long)h0 << 32) | l0);
}
__global__ void __launch_bounds__(512, 2) fwd_kernel(Args args) {
    extern __shared__ __attribute__((aligned(16))) unsigned char lds_raw[];
    LAS unsigned char* lds = (LAS unsigned char*)lds_raw;
    volatile LAS unsigned* MISC = (volatile LAS unsigned*)(lds + MISC_OFF);
    const int tid = threadIdx.x;
    const int G = gridDim.x, bx = blockIdx.x, NGW = G * 8;
    volatile LAS unsigned long long* LARG = (volatile LAS unsigned long long*)(lds + LARG_OFF);
    const int lo = args.ph_lo, hi = args.ph_hi;
    for (int u = tid; u < (LDS_BYTES - CTRL_OFF) / 4; u += 512) ((LAS unsigned*)(lds + CTRL_OFF))[u] = 0u;
    __syncthreads();
    if (tid == 0) {
#pragma unroll
        for (int i = 0; i < 26; ++i) LARG[i] = (unsigned long long)args.in[i];
        LARG[26] = (unsigned long long)args.out; LARG[27] = (unsigned long long)args.ws;
    }
    __syncthreads();
    unsigned bar_x = 0u;
    if (hi - lo > 1) bar_x = xcd_barrier_post((unsigned*)(args.ws + WS_CTL) + CW_BAR, MISC + 8).x;
#ifdef PH_ONLY
#define IN(k) ((k) == PH_ONLY && lo <= (k) && (k) < hi)
#else
#define IN(k) (lo <= (k) && (k) < hi)
#endif
#define SEAM(k) do { if (lo <= (k) && (k) + 1 < hi) { XcdBarrier _b; _b.bar = (unsigned*)((unsigned char*)larg(LARG, 27) + WS_CTL) + CW_BAR; _b.x = bar_x; _b.st = MISC + 8; xcd_barrier(_b); } if (STAMP_PHASE >= 0) { const unsigned long long _t = __builtin_amdgcn_s_memrealtime(); if (seam_after(STAMP_PHASE) == (k)) st_dt = _t - st_t0; if (seam_before(STAMP_PHASE) == (k)) st_t0 = _t; } } while (0)
#define INP(i) ((const float*)larg(LARG, (i)))
#ifndef REP_PHASE
#define REP_PHASE (-1)
#endif
#define NREP(k) ((k) == REP_PHASE ? 2 : 1)
#ifndef STAMP_PHASE
#define STAMP_PHASE (-1)
#endif
#ifndef STAMP_MUL
#define STAMP_MUL 4
#endif
    unsigned long long st_t0 = (STAMP_PHASE >= 0 && seam_before(STAMP_PHASE) < 0) ? __builtin_amdgcn_s_memrealtime() : 0ull, st_dt = 0ull;
#define PTRS \
    int tid = threadIdx.x; asm volatile("" : "+v"(tid)); const int lane = tid & 63, wave = __builtin_amdgcn_readfirstlane(tid >> 6), gw = bx * 8 + wave; (void)lane; (void)gw; \
    unsigned char* const ws = (unsigned char*)larg(LARG, 27); unsigned* const ctl = (unsigned*)(ws + WS_CTL); float* const outp = (float*)larg(LARG, 26); \
    float* const ada = (float*)(ctl + CW_ADA); float* const SSQP = (float*)(ws + WS_SSQP); \
    bf16_t* const WT_IN = (bf16_t*)(ws + WS_WT_IN); bf16_t* const WT_QB = (bf16_t*)(ws + WS_WT_QB); bf16_t* const WT_KVB = (bf16_t*)(ws + WS_WT_KVB); bf16_t* const WT_MLAO = (bf16_t*)(ws + WS_WT_MLAO); \
    bf16_t* const WT_RETO = (bf16_t*)(ws + WS_WT_RETO); bf16_t* const WT_OUT = (bf16_t*)(ws + WS_WT_OUT); bf16_t* const WT_GU = (bf16_t*)(ws + WS_WT_GU); bf16_t* const WT_DOWN = (bf16_t*)(ws + WS_WT_DOWN); \
    float* const CS_RET = (float*)(ws + WS_CS_RET); float* const CS_MLA = (float*)(ws + WS_CS_MLA); \
    bf16_t* const Hb = (bf16_t*)(ws + WS_H); bf16_t* const QL = (bf16_t*)(ws + WS_QL); bf16_t* const CKV = (bf16_t*)(ws + WS_CKV); bf16_t* const KR = (bf16_t*)(ws + WS_KR); \
    bf16_t* const ACAT = (bf16_t*)(ws + WS_ACAT); bf16_t* const BCAT = (bf16_t*)(ws + WS_BCAT); bf16_t* const KROT = (bf16_t*)(ws + WS_KROT); bf16_t* const KZTF = (bf16_t*)(ws + WS_KZTF); bf16_t* const KZTB = (bf16_t*)(ws + WS_KZTB); \
    bf16_t* const SG = (bf16_t*)(ws + WS_SG); bf16_t* const GA = (bf16_t*)(ws + WS_GA); bf16_t* const GB = (bf16_t*)(ws + WS_GB); \
    bf16_t* const QN = (bf16_t*)(ws + WS_QN); bf16_t* const QR = (bf16_t*)(ws + WS_QR); bf16_t* const KN = (bf16_t*)(ws + WS_KN); bf16_t* const VV = (bf16_t*)(ws + WS_VV); bf16_t* const OA = (bf16_t*)(ws + WS_OA); \
    float* const ORET = (float*)(ws + WS_ORET); bf16_t* const OB = (bf16_t*)(ws + WS_OB); bf16_t* const MIXP = (bf16_t*)(ws + WS_MIXP); bf16_t* const MIXIN = (bf16_t*)(ws + WS_MIXIN); float* const MIX = (float*)(ws + WS_MIX); \
    bf16_t* const H2 = (bf16_t*)(ws + WS_H2); int* const TOPI = (int*)(ws + WS_TOPI); float* const TOPW = (float*)(ws + WS_TOPW); int* const DEST = (int*)(ws + WS_DEST); int* const TILE = (int*)(ws + WS_TILE); float* const DECTAB = (float*)(ws + WS_DECTAB); \
    bf16_t* const XS = (bf16_t*)(ws + WS_XS); bf16_t* const ACT = (bf16_t*)(ws + WS_ACT); bf16_t* const YS = (bf16_t*)(ws + WS_YS); \
    (void)ctl; (void)outp; (void)ada; (void)SSQP; (void)WT_IN; (void)WT_QB; (void)WT_KVB; (void)WT_MLAO; (void)WT_RETO; (void)WT_OUT; (void)WT_GU; (void)WT_DOWN; (void)CS_RET; (void)CS_MLA; (void)Hb; (void)QL; (void)CKV; (void)KR; \
    (void)ACAT; (void)BCAT; (void)KROT; (void)KZTF; (void)KZTB; (void)SG; (void)GA; (void)GB; (void)QN; (void)QR; (void)KN; (void)VV; (void)OA; (void)ORET; (void)OB; (void)MIXP; (void)MIXIN; (void)MIX; (void)H2; (void)TOPI; (void)TOPW; (void)DEST; (void)TILE; (void)DECTAB; (void)XS; (void)ACT; (void)YS;

    if (IN(PH_SETUP)) for (int rep = 0; rep < NREP(PH_SETUP); ++rep) {
        PTRS
        if (bx == 0 && tid < 16) DECTAB[tid] = log2_sigmoid(tid < 8 ? INP(I_DECF)[tid] : INP(I_DECB)[tid - 8]);
#ifndef SETUP_REP_ADA
#define SETUP_REP_ADA 1
#define SETUP_REP_TAB 1
#define SETUP_REP_CPY 1
#endif
        for (int r2 = 0; r2 < SETUP_REP_ADA; ++r2) {
            const float* wada = INP(I_WADA); const float* cvec = INP(I_C); float* adap = (float*)(ws + WS_ADAP);
            for (int it = gw; it < 192 * 8; it += NGW) {
                const int jb = it % 192, kp = it / 192, j = jb * 64 + lane;
                float a0 = 0.f, a1 = 0.f, a2 = 0.f, a3 = 0.f;
#pragma nounroll
                for (int k0 = kp * 256; k0 < kp * 256 + 256; k0 += 32) {
                    float w[32]; const float* wp = wada + (size_t)k0 * 12288 + j;
#pragma unroll
                    for (int i = 0; i < 32; ++i) { w[i] = __builtin_nontemporal_load(wp); wp += 12288; asm volatile("" : "+v"(wp)); }
#pragma unroll
                    for (int i = 0; i < 32; ++i) { a0 += w[i] * cvec[k0 + i]; a1 += w[i] * cvec[2048 + k0 + i]; a2 += w[i] * cvec[4096 + k0 + i]; a3 += w[i] * cvec[6144 + k0 + i]; }
                }
                float* o = adap + (size_t)kp * 49152 + j;
                o[0] = a0; o[12288] = a1; o[24576] = a2; o[36864] = a3;
            }
        }
        for (int r2 = 0; r2 < SETUP_REP_TAB; ++r2) {
            const int* pos = (const int*)INP(I_POS);
            for (int i = bx * 512 + tid; i < T * 160; i += G * 512) {
                const int tok = i / 160, f = i % 160; const float p = (float)pos[tok];
                float inv; float* dst;
                if (f < 128) { inv = 1.0f / powf(10000.0f, (float)f / 128.0f); dst = CS_RET + (size_t)tok * 256 + f * 2; }
                else { inv = 1.0f / powf(10000.0f, (float)(f - 128) / 32.0f); dst = CS_MLA + (size_t)tok * 64 + (f - 128) * 2; }
                float s, c; sincosf(p * inv, &s, &c); dst[0] = c; dst[1] = s;
            }
        }
        for (int r2 = 0; r2 < SETUP_REP_CPY; ++r2) {
            LAS float* scr = (LAS float*)(lds + wave * 16640);
            constexpr int I_IN = (N_IN_ALL / 64) * 32, I_QB = 24 * 8, I_KVB = 32 * 8, I_MLAO = 32 * 16, I_SQ = 32 * 32;
            constexpr int NITEMS = I_IN + I_QB + I_KVB + I_MLAO + 2 * I_SQ;
            unsigned* cq = ctl + CW_CVTQ + rep + 2 * r2;
#define CVT_GRAB(dst) do { unsigned _v = 0u; if (lane == 0) _v = atomicAdd(cq, 8u); dst = (int)__builtin_amdgcn_readfirstlane(_v); } while (0)
#define CVT_DEC(r_, wp_, dst_, ks_, ldw_, K_, sc_) do { int r = (r_); const float* W_; bf16_t* WT_; const float* kq_ = nullptr; int nkb_, mat_; \
                if (r < I_IN) { W_ = INP(I_WIN); WT_ = WT_IN; ldw_ = 13376; K_ = 2048; nkb_ = 32; mat_ = 2; } \
                else if ((r -= I_IN) < I_QB) { W_ = INP(I_WQB); WT_ = WT_QB; kq_ = INP(I_QAN); ldw_ = 1536; K_ = 512; nkb_ = 8; mat_ = 3; } \
                else if ((r -= I_QB) < I_KVB) { W_ = INP(I_WKVB); WT_ = WT_KVB; kq_ = INP(I_KVAN); ldw_ = 2048; K_ = 512; nkb_ = 8; mat_ = 4; } \
                else if ((r -= I_KVB) < I_MLAO) { W_ = INP(I_WMLAO); WT_ = WT_MLAO; ldw_ = 2048; K_ = 1024; nkb_ = 16; mat_ = 1; } \
                else if ((r -= I_MLAO) < I_SQ) { W_ = INP(I_WRETO); WT_ = WT_RETO; ldw_ = 2048; K_ = 2048; nkb_ = 32; mat_ = 1; } \
                else { r -= I_SQ; W_ = INP(I_WOUT); WT_ = WT_OUT; ldw_ = 2048; K_ = 2048; nkb_ = 32; mat_ = 5; } \
                const int q4_ = r >> 2, kb_ = q4_ % nkb_, nb_ = (q4_ / nkb_) * 4 + (r & 3), rr_ = nb_ * 64 + lane; \
                sc_ = ((mat_ == 1 || mat_ == 5) ? rr_ : (mat_ == 2 ? src_in(rr_) : (mat_ == 3 ? src_qb(rr_) : src_kvb(rr_)))); \
                wp_ = W_ + (size_t)(kb_ * 64) * ldw_ + (sc_ >= 0 ? sc_ : 0); dst_ = WT_ + (size_t)(nb_ * 64) * K_ + kb_ * 64; ks_ = kq_ ? kq_ + kb_ * 64 : nullptr; \
                if (mat_ == 5) { K_ = -1; dst_ = (bf16_t*)((unsigned char*)WT_ + (size_t)(nb_ * 64) * 2048 + kb_ * 64); }   \
                if (mat_ == 2 && nb_ >= 84 && nb_ < 180) { K_ = -1; dst_ = (bf16_t*)(ws + WS_WT8IN + (size_t)((nb_ - 84) * 64) * 2048 + kb_ * 64); } } while (0)
            float v[64];
            const float* wpc; bf16_t* dstc; const float* ksc; int ldwc, Kc, scc;
            const float* wpn = nullptr; bf16_t* dstn = nullptr; const float* ksn = nullptr; int ldwn = 0, Kn = 0, scn = 0;
            constexpr int QCH = 8; static_assert(NITEMS % QCH == 0, "queue chunk");
            int itc, itn, cend; CVT_GRAB(itc); itn = itc + 1; cend = itc + QCH;
            bool hc = itc < NITEMS;
            if (hc) { CVT_DEC(itc, wpc, dstc, ksc, ldwc, Kc, scc);
#pragma unroll
                for (int i = 0; i < 64; ++i) v[i] = __builtin_nontemporal_load(wpc + (size_t)i * ldwc); }
            while (hc) {
                const bool hn = itn < NITEMS;
                if (hn) CVT_DEC(itn, wpn, dstn, ksn, ldwn, Kn, scn);
                const bool need = (itn + 1 >= cend); unsigned raw_nn = 0u; if (need && lane == 0) raw_nn = atomicAdd(cq, (unsigned)QCH);
#pragma unroll
                for (int g = 0; g < 4; ++g) {
#pragma unroll
                    for (int i = 0; i < 16; ++i) { float x = scc >= 0 ? v[16 * g + i] : 0.f; if (ksc) x *= ksc[16 * g + i]; scr[(16 * g + i) * 65 + lane] = x; }
                    if (hn) {
#pragma unroll
                        for (int i = 0; i < 16; ++i) v[16 * g + i] = __builtin_nontemporal_load(wpn + (size_t)(16 * g + i) * ldwn); }
                }
                asm volatile("s_waitcnt lgkmcnt(0)" ::: "memory");
                const int c = lane & 7;
#pragma unroll
                for (int j = 0; j < 8; ++j) { const int n = (lane >> 3) + 8 * j; const LAS float* sp = scr + (8 * c) * 65 + n;
                    if (Kc < 0) { u32x2 o8; o8.x = pk4_fp8(sp[0 * 65], sp[1 * 65], sp[2 * 65], sp[3 * 65], W8_SCALE); o8.y = pk4_fp8(sp[4 * 65], sp[5 * 65], sp[6 * 65], sp[7 * 65], W8_SCALE);
                        *(u32x2*)((unsigned char*)dstc + (size_t)n * 2048 + 8 * c) = o8; }
                    else { u32x4 o; o.x = cvt_pk_bf16(sp[0 * 65], sp[1 * 65]); o.y = cvt_pk_bf16(sp[2 * 65], sp[3 * 65]); o.z = cvt_pk_bf16(sp[4 * 65], sp[5 * 65]); o.w = cvt_pk_bf16(sp[6 * 65], sp[7 * 65]);
                        __builtin_nontemporal_store(o, (u32x4*)(dstc + (size_t)n * Kc + 8 * c)); } }
                asm volatile("s_waitcnt lgkmcnt(0)" ::: "memory");
                wpc = wpn; dstc = dstn; ksc = ksn; ldwc = ldwn; Kc = Kn; scc = scn; hc = hn;
                if (need) { itn = (int)__builtin_amdgcn_readfirstlane(raw_nn); cend = itn + QCH; } else itn = itn + 1;
            }
#undef CVT_GRAB
#undef CVT_DEC
        }
    }
    SEAM(PH_SETUP);
    if (IN(PH_H)) for (int rep = 0; rep < NREP(PH_H); ++rep) {
        PTRS
        const float* g = INP(I_GPREM);
        {
            const float* adap = (const float*)(ws + WS_ADAP); const float* bada = INP(I_BADA); LAS float* AD = (LAS float*)lds;
            if (tid < 192) { const int idx = bx * 192 + tid; if (idx < 49152) { const int j = idx % 12288; float a = 0.f;
#pragma unroll
                for (int pq = 0; pq < 8; ++pq) a += adap[(size_t)pq * 49152 + idx];
                ada[idx] = a + bada[j]; } }
            for (int i = tid; i < 16384; i += 512) { const int b = i >> 12, col = i & 4095; float a = 0.f;
#pragma unroll
                for (int pq = 0; pq < 8; ++pq) a += adap[(size_t)pq * 49152 + b * 12288 + col];
                AD[i] = a + bada[col]; }
            __syncthreads();
        }
        const LAS float* AD = (const LAS float*)lds;
        f32x4 vn[8];
        if (gw < T) { const f32x4* xr = (const f32x4*)(INP(I_X) + (size_t)gw * D) + lane;
#pragma unroll
            for (int j = 0; j < 8; ++j) vn[j] = xr[64 * j]; }
        for (int mrow = gw; mrow < T; mrow += NGW) {
            const int b = mrow / SEQ;
            f32x4 v[8]; float s = 0.f;
#pragma unroll
            for (int j = 0; j < 8; ++j) { v[j] = vn[j]; s += (v[j][0] * v[j][0] + v[j][1] * v[j][1]) + (v[j][2] * v[j][2] + v[j][3] * v[j][3]); }
            if (mrow + NGW < T) { const f32x4* xr = (const f32x4*)(INP(I_X) + (size_t)(mrow + NGW) * D) + lane;
#pragma unroll
                for (int j = 0; j < 8; ++j) vn[j] = xr[64 * j]; }
            const float r = rsqrtf(wave_sum(s) * (1.0f / D) + RMS_EPS);
            u32x2* o8 = (u32x2*)(Hb + (size_t)mrow * D) + lane; unsigned* q8 = (unsigned*)(ws + WS_H8 + (size_t)mrow * D) + lane;
#pragma unroll
            for (int j = 0; j < 8; ++j) { const int col = 256 * j + 4 * lane; const f32x4 gg = *(const f32x4*)(g + col), sh = *(const LAS f32x4*)(AD + b * 4096 + col), sc = *(const LAS f32x4*)(AD + b * 4096 + 2048 + col);
                const f32x4 y = v[j] * r * gg * (sc + 1.0f) + sh; u32x2 w; w.x = cvt_pk_bf16(y[0], y[1]); w.y = cvt_pk_bf16(y[2], y[3]); o8[64 * j] = w; q8[64 * j] = pk4_fp8(y[0], y[1], y[2], y[3], H8_SCALE); }
        }
    }
    SEAM(PH_H);
    if (IN(PH_INPROJ)) for (int rep = 0; rep < NREP(PH_INPROJ); ++rep) {
        PTRS
        {   pg8::InprojSched S{(const char*)Hb, (const char*)WT_IN, G, bx};
            EpiInprojAll E{EpiInproj{QL, CKV, KR, ACAT, KROT, SG, GA, GB, SSQP, CS_RET, CS_MLA, DECTAB, 0, 1.0f}, EpiVT{BCAT, ws + WS_VT8}};
            pg8::gemm_phase(lds, 2048, 2048, 2048, S, E); }
        {
            pg8::GridSched S{(const char*)(ws + WS_H8), (const char*)(ws + WS_WT8IN), (size_t)256 * 2048, (size_t)256 * 2048, T / 256, 24, G, bx};
            EpiInproj E{QL, CKV, KR, ACAT, KROT, SG, GA, GB, SSQP, CS_RET, CS_MLA, DECTAB, 21, GU_UNSCALE};
            pg8::gemm_phase<EpiInproj, pg8::GridSched, true>(lds, 2048, 2048, 2048, S, E); }
    }
    SEAM(PH_INPROJ_V);
    if (IN(PH_KT)) for (int rep = 0; rep < NREP(PH_KT); ++rep) {
        PTRS
        {
            constexpr int TP = 528;
            u32x4 ra[16], rb[16];
#define KT_LOAD(r_, blk_) do { const bf16_t* _s = KROT + ((size_t)(blk_) * 256 + 32 * wave + 16 * (lane >> 5)) * 256 + 8 * (lane & 31); _Pragma("unroll") for (int i = 0; i < 16; ++i) r_[i] = *(const u32x4*)(_s + i * 256); } while (0)
#define KT_PROC(r_, blk_) do { const int _h = ((blk_) >> 4) & 7; const float _lf = DECTAB[_h], _lb = DECTAB[8 + _h]; \
                _Pragma("unroll") for (int e = 0; e < 8; ++e) { u32x4 w0, w1; \
                    _Pragma("unroll") for (int i2 = 0; i2 < 4; ++i2) { const unsigned a0 = r_[2 * i2][e >> 1], a1 = r_[2 * i2 + 1][e >> 1], c0 = r_[8 + 2 * i2][e >> 1], c1 = r_[8 + 2 * i2 + 1][e >> 1]; \
                        w0[i2] = (e & 1) ? ((a0 >> 16) | (a1 & 0xffff0000u)) : ((a0 & 0xffffu) | (a1 << 16)); w1[i2] = (e & 1) ? ((c0 >> 16) | (c1 & 0xffff0000u)) : ((c0 & 0xffffu) | (c1 << 16)); } \
                    LAS unsigned char* _t = lds + (8 * (lane & 31) + e) * TP + (32 * wave + 16 * (lane >> 5)) * 2; *(LAS u32x4*)_t = w0; *(LAS u32x4*)(_t + 16) = w1; } \
                __syncthreads(); \
                f32x4 zf0, zf1, zb0, zb1; \
                _Pragma("unroll") for (int t = 0; t < 4; ++t) { const int p0 = 8 * (lane & 31) + t, p1 = p0 + 4; \
                    zf0[t] = __builtin_amdgcn_exp2f((float)(255 - p0) * _lf); zf1[t] = __builtin_amdgcn_exp2f((float)(255 - p1) * _lf); zb0[t] = __builtin_amdgcn_exp2f((float)p0 * _lb); zb1[t] = __builtin_amdgcn_exp2f((float)p1 * _lb); } \
                _Pragma("unroll") for (int j = 0; j < 16; ++j) { const int row = 32 * wave + 2 * j + (lane >> 5); \
                    const u32x4 w = *(const LAS u32x4*)(lds + row * TP + (lane & 31) * 16); f32x4 x0, x1; unpack8(w, x0, x1); \
                    const size_t o = ((size_t)(blk_) * 256 + row) * 256 + 8 * (lane & 31); \
                    const f32x4 f0 = x0 * zf0, f1 = x1 * zf1, g0 = x0 * zb0, g1 = x1 * zb1; u32x2 wf, wb; \
                    wf.x = pk4_fp8(f0[0], f0[1], f0[2], f0[3], K8_SCALE); wf.y = pk4_fp8(f1[0], f1[1], f1[2], f1[3], K8_SCALE); wb.x = pk4_fp8(g0[0], g0[1], g0[2], g0[3], K8_SCALE); wb.y = pk4_fp8(g1[0], g1[1], g1[2], g1[3], K8_SCALE); \
                    *(u32x2*)((unsigned char*)KZTF + o) = wf; *(u32x2*)((unsigned char*)KZTB + o) = wb; } \
                __syncthreads(); } while (0)
            int blk = bx;
            if (blk < NBLK) KT_LOAD(ra, blk);
            while (blk < NBLK) {
                const int b1 = blk + G; if (b1 < NBLK) KT_LOAD(rb, b1);
                KT_PROC(ra, blk);
                if (b1 >= NBLK) break;
                const int b2 = b1 + G; if (b2 < NBLK) KT_LOAD(ra, b2);
                KT_PROC(rb, b1);
                blk = b2;
            }
#undef KT_LOAD
#undef KT_PROC
        }
    }
    SEAM(PH_KT);
    if (IN(PH_CHAIN)) for (int rep = 0; rep < NREP(PH_CHAIN); ++rep) {
        PTRS
        if (bx < 64) {
            const int bh = bx >> 1, dir = bx & 1;
            {
                const int blk0 = bh * NCH + (dir ? NCH - 1 : 0);
                bf16_t* z = BCAT + ((size_t)blk0 * 256 + (tid >> 1)) * 768 + 256 + 256 * dir + (tid & 1) * 128;
#pragma unroll
                for (int q = 0; q < 16; ++q) *(u32x4*)(z + q * 8) = (u32x4){0u, 0u, 0u, 0u};
            }
            pg8::ChainSched S{(const char*)(ws + WS_VT8), (const char*)(dir ? KZTB : KZTF), bh, dir};
            EpiGb E{BCAT, DECTAB, dir};
            pg8::gemm_phase<EpiGb, pg8::ChainSched, true, true>(lds, 256, 256, 256, S, E);
        }
    }
    if (IN(PH_MLAQ)) for (int rep = 0; rep < NREP(PH_MLAQ); ++rep) {
        PTRS
        if (bx >= 64) { const bool ca = bx < 128;
            pg8::GridSchedR S{(const char*)QL, (const char*)WT_QB, (size_t)256 * 512 * 2, (size_t)256 * 512 * 2, T / 256, 6, ca ? 64 : 128, ca ? bx - 64 : bx - 128, ca ? 0 : 128, ca ? 128 : 384};
            EpiMlaQ E{QN, QR, SSQP, CS_MLA}; pg8::gemm_phase(lds, 512, 512, 512, S, E); }
    }
    if (IN(PH_MLAKV)) for (int rep = 0; rep < NREP(PH_MLAKV); ++rep) {
        PTRS
        if (bx >= 128) {
            pg8::GridSchedR S{(const char*)CKV, (const char*)WT_KVB, (size_t)256 * 512 * 2, (size_t)256 * 512 * 2, T / 256, 8, 128, bx - 128, 0, 512};
            EpiMlaKV E{KN, VV, SSQP + (size_t)8 * T}; pg8::gemm_phase(lds, 512, 512, 512, S, E); }
    }
    if (IN(PH_GA)) for (int rep = 0; rep < NREP(PH_GA); ++rep) {
        PTRS
        if (bx >= 64) { const bool ca = bx < 128;
        {   pg8::BatchSchedR S{(const char*)(ACAT + 256), (const char*)KROT, (size_t)256 * 768 * 2, (size_t)256 * 256 * 2, ca ? 64 : 128, ca ? bx - 64 : bx - 128, ca ? 0 : 256, ca ? 256 : 512};
            EpiGa E{ACAT, DECTAB}; pg8::gemm_phase(lds, 256, 768, 256, S, E); }
        if (ca) {
            pg8::GridSchedR S{(const char*)Hb, (const char*)(WT_IN + (size_t)4 * 256 * 2048), (size_t)256 * 2048 * 2, (size_t)256 * 2048 * 2, T / 256, 1, 64, bx - 64, 0, 64};
            EpiInproj E{QL, CKV, KR, ACAT, KROT, SG, GA, GB, SSQP, CS_RET, CS_MLA, DECTAB, 4, 1.0f}; pg8::gemm_phase(lds, 2048, 2048, 2048, S, E); }
        }
    }
    SEAM(PH_GA);
    if (IN(PH_ATTN)) for (int rep = 0; rep < NREP(PH_ATTN); ++rep) {
        PTRS
        unsigned* queue = ctl + CW_QUEUE + rep; unsigned* cqueue = ctl + CW_QUEUE + 8;
        const float* wgu = INP(I_WGU); const float* wdn = INP(I_WDOWN);
#define CONV_LOOP() do { if (rep == 0) for (;;) { __syncthreads(); if (tid == 0) MISC[1] = atomicAdd(cqueue, 1u); __syncthreads(); const int c = (int)MISC[1]; if (c >= 768) break; \
            xt_convert_tiles(c * 16, 1, c * 16 + 16, wgu, wdn, WT_GU, WT_DOWN, lds, lane, wave); } } while (0)
        if (bx < CONV_WGS) CONV_LOOP();
        int xq = (int)(xb_xcc_id() & 7u), tries = 0;
        for (;;) {
            __syncthreads();
            if (tid == 0) { int a = -1;
                while (tries < 8) { const unsigned v = atomicAdd(ctl + CW_AQ + 64 * xq + rep, 1u); if (v < 64u) { a = xq * 64 + (int)v; break; } xq = (xq + 1) & 7; ++tries; }
                MISC[0] = (unsigned)a; }
            __syncthreads();
            const int a = (int)MISC[0];
            if (a < 0) break;
            const int bh = a >> 4, qb = a & 15, b = bh >> 3, h = bh & 7;
            const size_t tok0 = (size_t)b * SEQ + qb * 256, kt0 = (size_t)b * SEQ;
            att::attn_unit(QN + tok0 * 1024 + h * 128, QR + tok0 * 512 + h * 64, KN + kt0 * 1024 + h * 128, KR + kt0 * 64, VV + kt0 * 1024 + h * 128, OA + tok0 * 1024 + h * 128, SEQ, (char*)lds_raw);
        }
        if (bx >= CONV_WGS) CONV_LOOP();
#undef CONV_LOOP
    }
    SEAM(PH_ATTN);
    if (IN(PH_GC)) for (int rep = 0; rep < NREP(PH_GC); ++rep) {
        PTRS
        {   pg8::BatchSched S{(const char*)ACAT, (const char*)BCAT, (size_t)256 * 768 * 2, (size_t)256 * 768 * 2, NBLK, G, bx};
            EpiGc E{OB, SG, INP(I_RETGN), lds}; pg8::gemm_phase(lds, 768, 768, 768, S, E); }
    }
    if (IN(PH_MIXA)) for (int rep = 0; rep < NREP(PH_MIXA); ++rep) {
        PTRS
        {   pg8::GridSched S{(const char*)OA, (const char*)WT_MLAO, (size_t)256 * 1024 * 2, (size_t)256 * 1024 * 2, T / 256, 8, G, bx};
            EpiMixA E{MIXP, GA}; pg8::gemm_phase(lds, 1024, 1024, 1024, S, E); }
    }
    SEAM(PH_MIXA);
    if (IN(PH_MIXB)) for (int rep = 0; rep < NREP(PH_MIXB); ++rep) {
        PTRS
        pg8::GridSched S{(const char*)OB, (const char*)WT_RETO, (size_t)256 * 2048 * 2, (size_t)256 * 2048 * 2, T / 256, 8, G, bx};
        EpiMixB E{MIXIN, MIXP, GB}; pg8::gemm_phase(lds, 2048, 2048, 2048, S, E);
    }
    SEAM(PH_MIXB);
    if (IN(PH_MIX)) for (int rep = 0; rep < NREP(PH_MIX); ++rep) {
        PTRS
        pg8::GridSched S{(const char*)MIXIN, (const char*)WT_OUT, (size_t)256 * 2048, (size_t)256 * 2048, T / 256, 8, G, bx};
        EpiF32 E{(bf16_t*)MIX}; pg8::gemm_phase<EpiF32, pg8::GridSched, true>(lds, 2048, 2048, 2048, S, E);
    }
    SEAM(PH_MIX);
    if (IN(PH_ROUTER)) for (int rep = 0; rep < NREP(PH_ROUTER); ++rep) {
        PTRS
        const float* gpm = INP(I_GPOSTM); const float* gpf = INP(I_GPREF); const float* wr = INP(I_WROUTER); const float* brt = INP(I_BROUTER);
        LAS float* HROW = (LAS float*)lds;
        LAS float* PART = (LAS float*)(lds + 16 * 2052 * 4);
        unsigned* counts = ctl + CW_COUNTS;
        volatile LAS unsigned* lhist = MISC + 64;
        if (tid < 32) lhist[tid] = 0u;
        __syncthreads();
        const float* wbp = wr + (size_t)(256 * wave + (lane >> 4)) * 32 + (lane & 15);
        f32x4 vA[8], vB[8], xA[8], xB[8];
#define RT_LOAD(base_) do { const int _m = (base_) + 2 * wave; const u32x2* _mr = (const u32x2*)((const bf16_t*)MIX + (size_t)_m * D) + lane; const f32x4* _xr = (const f32x4*)(INP(I_X) + (size_t)_m * D) + lane; \
            _Pragma("unroll") for (int j = 0; j < 8; ++j) { const u32x2 _a = _mr[64 * j], _b = _mr[64 * j + 512]; vA[j] = (f32x4){bf_lo(_a.x), bf_hi(_a.x), bf_lo(_a.y), bf_hi(_a.y)}; vB[j] = (f32x4){bf_lo(_b.x), bf_hi(_b.x), bf_lo(_b.y), bf_hi(_b.y)}; \
                xA[j] = _xr[64 * j]; xB[j] = _xr[64 * j + 512]; } } while (0)
        if (bx * 16 < T) RT_LOAD(bx * 16);
        for (int base = bx * 16; base < T; base += G * 16) {
            {
                const int rrA = 2 * wave, mrowA = base + rrA;
                const int b = mrowA / SEQ; const float* ad = ada + b * 12288;
                float sA = 0.f, sB = 0.f;
#pragma unroll
                for (int j = 0; j < 8; ++j) { sA += (vA[j][0] * vA[j][0] + vA[j][1] * vA[j][1]) + (vA[j][2] * vA[j][2] + vA[j][3] * vA[j][3]); sB += (vB[j][0] * vB[j][0] + vB[j][1] * vB[j][1]) + (vB[j][2] * vB[j][2] + vB[j][3] * vB[j][3]); }
#pragma unroll
                for (int o = 1; o < 64; o <<= 1) { sA += __shfl_xor(sA, o); sB += __shfl_xor(sB, o); }
                const float r1A = rsqrtf(sA * (1.0f / D) + RMS_EPS), r1B = rsqrtf(sB * (1.0f / D) + RMS_EPS); float tA = 0.f, tB = 0.f;
                u32x2* o4 = (u32x2*)((bf16_t*)(ws + WS_X1B) + (size_t)mrowA * D) + lane;
#pragma unroll
                for (int j = 0; j < 8; ++j) { const int col = 256 * j + 4 * lane; const f32x4 gg = *(const f32x4*)(gpm + col), gm = *(const f32x4*)(ad + 4096 + col);
                    vA[j] = xA[j] + gm * (vA[j] * r1A * gg); vB[j] = xB[j] + gm * (vB[j] * r1B * gg);
                    { u32x2 wa, wb; wa.x = cvt_pk_bf16(vA[j][0], vA[j][1]); wa.y = cvt_pk_bf16(vA[j][2], vA[j][3]); wb.x = cvt_pk_bf16(vB[j][0], vB[j][1]); wb.y = cvt_pk_bf16(vB[j][2], vB[j][3]); o4[64 * j] = wa; o4[64 * j + 512] = wb; }
                    tA += (vA[j][0] * vA[j][0] + vA[j][1] * vA[j][1]) + (vA[j][2] * vA[j][2] + vA[j][3] * vA[j][3]); tB += (vB[j][0] * vB[j][0] + vB[j][1] * vB[j][1]) + (vB[j][2] * vB[j][2] + vB[j][3] * vB[j][3]); asm volatile("" ::: "memory"); }
#pragma unroll
                for (int o = 1; o < 64; o <<= 1) { tA += __shfl_xor(tA, o); tB += __shfl_xor(tB, o); }
                const float r2A = rsqrtf(tA * (1.0f / D) + RMS_EPS), r2B = rsqrtf(tB * (1.0f / D) + RMS_EPS);
                unsigned* h8 = (unsigned*)((unsigned char*)H2 + (size_t)mrowA * D) + lane;
#pragma unroll
                for (int j = 0; j < 8; ++j) { const int col = 256 * j + 4 * lane; const f32x4 gg = *(const f32x4*)(gpf + col), sh = *(const f32x4*)(ad + 6144 + col), sc = *(const f32x4*)(ad + 8192 + col);
                    const f32x4 hA = vA[j] * r2A * gg * (sc + 1.0f) + sh, hB = vB[j] * r2B * gg * (sc + 1.0f) + sh;
                    h8[64 * j] = pk4_fp8(hA[0], hA[1], hA[2], hA[3], H8_SCALE); h8[64 * j + 512] = pk4_fp8(hB[0], hB[1], hB[2], hB[3], H8_SCALE);
                    *(LAS f32x4*)(HROW + rrA * 2052 + col) = hA; *(LAS f32x4*)(HROW + (rrA + 1) * 2052 + col) = hB; asm volatile("" ::: "memory"); }
                if (base + G * 16 < T) RT_LOAD(base + G * 16);
            }
            __syncthreads();
            {   f32x4 c0 = (f32x4){0.f, 0.f, 0.f, 0.f}, c1 = (f32x4){0.f, 0.f, 0.f, 0.f};
                const LAS float* ap = HROW + (lane & 15) * 2052 + 256 * wave + (lane >> 4);
#pragma unroll 16
                for (int st = 0; st < 64; ++st) { const float a = ap[4 * st]; c0 = __builtin_amdgcn_mfma_f32_16x16x4f32(a, wbp[st * 128], c0, 0, 0, 0); c1 = __builtin_amdgcn_mfma_f32_16x16x4f32(a, wbp[st * 128 + 16], c1, 0, 0, 0); }
                LAS float* pp = PART + wave * 512 + (4 * (lane >> 4)) * 32 + (lane & 15);
#pragma unroll
                for (int r = 0; r < 4; ++r) { pp[r * 32] = c0[r]; pp[r * 32 + 16] = c1[r]; }
            }
            __syncthreads();
#pragma nounroll
            for (int q = 0; q < 2; ++q) {
                const int rr = 2 * wave + q, mrow = base + rr;
                float lg = 0.f;
                if (lane < 32) {
#pragma unroll
                    for (int w2 = 0; w2 < 8; ++w2) lg += PART[w2 * 512 + rr * 32 + lane];
                    lg += brt[lane]; }
                float val = lane < 32 ? lg : -3.0e38f; float tv[4]; int ti[4];
#pragma unroll
                for (int r = 0; r < 4; ++r) { float bv = val; int bi = lane;
#pragma unroll
                    for (int o = 32; o >= 1; o >>= 1) { const float ov = __shfl_xor(bv, o); const int oi = __shfl_xor(bi, o); if (ov > bv || (ov == bv && oi < bi)) { bv = ov; bi = oi; } }
                    tv[r] = bv; ti[r] = bi; if (lane == bi) val = -3.0e38f; }
                const float e1 = __expf(tv[1] - tv[0]), e2 = __expf(tv[2] - tv[0]), e3 = __expf(tv[3] - tv[0]); const float inv = 1.0f / (1.0f + e1 + e2 + e3);
                if (lane < 4) { const int id = lane == 0 ? ti[0] : (lane == 1 ? ti[1] : (lane == 2 ? ti[2] : ti[3])); const float wv = (lane == 0 ? 1.0f : (lane == 1 ? e1 : (lane == 2 ? e2 : e3))) * inv;
                    TOPI[mrow * 4 + lane] = id; TOPW[mrow * 4 + lane] = wv; if (rep == 0) __hip_atomic_fetch_add((LAS unsigned*)(lhist + id), 1u, __ATOMIC_RELAXED, __HIP_MEMORY_SCOPE_WORKGROUP); }
            }
            __syncthreads();
        }
        if (tid < 32 && rep == 0) { const unsigned c = lhist[tid]; if (c) atomicAdd(counts + 64 * tid, c); }
    }
    SEAM(PH_ROUTER);
    if (IN(PH_DISPATCH)) for (int rep = 0; rep < NREP(PH_DISPATCH); ++rep) {
        PTRS
        unsigned* counts = ctl + CW_COUNTS; unsigned* cursor = ctl + CW_CURSOR;
        volatile LAS unsigned* lhist = MISC + 64; volatile LAS unsigned* lbase = MISC + 96;
        if (tid < 32) lhist[tid] = 0u;
        int pst = 0, pend = 0;
        { const int cnt = lane < 32 ? (int)__hip_atomic_load(counts + 64 * lane, __ATOMIC_RELAXED, __HIP_MEMORY_SCOPE_AGENT) : 0; const int pad = (cnt + 255) & ~255; int inc = pad;
#pragma unroll
          for (int o = 1; o < 32; o <<= 1) { const int t = __shfl_up(inc, o); if ((lane & 31) >= o) inc += t; }
          pend = inc; pst = inc - pad; }
        if (gw == 0) {
            const int ntiles = __shfl(pend, 31) >> 8; if (lane == 0) TILE[0] = ntiles;
            for (int t = lane; t < PMAX / 256; t += 64) { int e = 0;
                for (int q = 0; q < 32; ++q) { const int pe = __shfl(pend, q); e += (pe <= t * 256) ? 1 : 0; }
                TILE[16 + t] = e < 31 ? e : 31; }
        }
        __syncthreads();
        int eid[8], loc[8];
#pragma unroll
        for (int i = 0; i < 8; ++i) { const int mrow = gw + NGW * i; eid[i] = 0; loc[i] = 0;
            if (mrow < T && lane < 4) { eid[i] = TOPI[mrow * 4 + lane]; loc[i] = (int)__hip_atomic_fetch_add((LAS unsigned*)(lhist + eid[i]), 1u, __ATOMIC_RELAXED, __HIP_MEMORY_SCOPE_WORKGROUP); } }
        __syncthreads();
        if (tid < 32) { const unsigned c = lhist[tid]; lbase[tid] = (unsigned)pst + (c ? atomicAdd(cursor + 64 * tid, c) : 0u); }
        __syncthreads();
#pragma unroll
        for (int i = 0; i < 8; ++i) { const int mrow = gw + NGW * i;
            if (mrow < T) {
                int slot = 0;
                if (lane < 4) { slot = (int)lbase[eid[i]] + loc[i]; DEST[mrow * 4 + lane] = slot; }
                const u32x4* src = (const u32x4*)((const unsigned char*)H2 + (size_t)mrow * D) + lane; u32x4 rw[2];
#pragma unroll
                for (int q = 0; q < 2; ++q) rw[q] = src[64 * q];
#pragma unroll
                for (int k = 0; k < 4; ++k) { const int sl = __shfl(slot, k); u32x4* dst = (u32x4*)((unsigned char*)XS + (size_t)sl * D) + lane;
#pragma unroll
                    for (int q = 0; q < 2; ++q) dst[64 * q] = rw[q]; } } }
    }
    SEAM(PH_DISPATCH);
    if (IN(PH_GU)) for (int rep = 0; rep < NREP(PH_GU); ++rep) {
        PTRS
        const int ntiles = __builtin_amdgcn_readfirstlane(TILE[0]);
        pg8::MoeSched S{(const char*)XS, (const char*)WT_GU, TILE + 16, ntiles, 16, G, bx};
        EpiGU E{ACT, INP(I_BGU), rep}; pg8::gemm_phase<EpiGU, pg8::MoeSched, true>(lds, 2048, 2048, 2048, S, E);
    }
    SEAM(PH_GU);
    if (IN(PH_DOWN)) for (int rep = 0; rep < NREP(PH_DOWN); ++rep) {
        PTRS
        const int ntiles = __builtin_amdgcn_readfirstlane(TILE[0]);
        pg8::MoeSched S{(const char*)ACT, (const char*)WT_DOWN, TILE + 16, ntiles, 8, G, bx};
        EpiDown E{YS, INP(I_BDOWN)}; pg8::gemm_phase<EpiDown, pg8::MoeSched, true>(lds, 2048, 2048, 2048, S, E);
    }
    SEAM(PH_DOWN);
    if (IN(PH_COMBINE)) for (int rep = 0; rep < NREP(PH_COMBINE); ++rep) {
        PTRS
        const float* gpo = INP(I_GPOSTF);
        for (int mrow = gw; mrow < T; mrow += NGW) {
            const int b = mrow / SEQ; const float* ad = ada + b * 12288;
            int dk[4]; float wk[4];
#pragma unroll
            for (int k = 0; k < 4; ++k) { dk[k] = DEST[mrow * 4 + k]; wk[k] = TOPW[mrow * 4 + k]; }
            f32x4 f[8]; float s = 0.f;
#pragma unroll
            for (int j = 0; j < 8; ++j) f[j] = (f32x4){0.f, 0.f, 0.f, 0.f};
#pragma unroll
            for (int k = 0; k < 4; ++k) { const u32x2* yr = (const u32x2*)(YS + (size_t)dk[k] * D) + lane;
#pragma unroll
                for (int j = 0; j < 8; ++j) { const u32x2 w = yr[64 * j]; f[j] += (f32x4){bf_lo(w.x), bf_hi(w.x), bf_lo(w.y), bf_hi(w.y)} * wk[k]; } }
#pragma unroll
            for (int j = 0; j < 8; ++j) s += (f[j][0] * f[j][0] + f[j][1] * f[j][1]) + (f[j][2] * f[j][2] + f[j][3] * f[j][3]);
            const float r = rsqrtf(wave_sum(s) * (1.0f / D) + RMS_EPS);
            f32x4* o4 = (f32x4*)(outp + (size_t)mrow * D) + lane; const u32x2* x1 = (const u32x2*)((const bf16_t*)(ws + WS_X1B) + (size_t)mrow * D) + lane;
#pragma unroll
            for (int j = 0; j < 8; ++j) { const int col = 256 * j + 4 * lane; const f32x4 gg = *(const f32x4*)(gpo + col), gf = *(const f32x4*)(ad + 10240 + col); const u32x2 xw = x1[64 * j];
                o4[64 * j] = (f32x4){bf_lo(xw.x), bf_hi(xw.x), bf_lo(xw.y), bf_hi(xw.y)} + gf * (f[j] * r * gg); }
        }
    }
    if (STAMP_PHASE >= 0 && bx == 0) {
        if (seam_after(STAMP_PHASE) >= NPH) st_dt = __builtin_amdgcn_s_memrealtime() - st_t0;
        const unsigned long long t1 = __builtin_amdgcn_s_memrealtime();
        while (__builtin_amdgcn_s_memrealtime() - t1 < st_dt * STAMP_MUL) __builtin_amdgcn_s_sleep(8);
    }
#undef IN
#undef SEAM
}

extern "C" void kernel_launch(void* const* d_in, const int* in_sizes, int n_in, void* d_out, int out_size, void* d_ws, size_t ws_size, hipStream_t stream) {
    static int grid = 0;
    if (grid == 0) {
        if (n_in != 26 || out_size != T * D || ws_size < WS_END) { fprintf(stderr, "kernel_launch: unexpected shapes: n_in %d out %d ws %zu (need %zu)\n", n_in, out_size, ws_size, (size_t)WS_END); grid = -1; return; }
        int dev = 0, cus = 0, per_cu = 0;
        if (hipGetDevice(&dev) != hipSuccess || hipDeviceGetAttribute(&cus, hipDeviceAttributeMultiprocessorCount, dev) != hipSuccess) { grid = -1; return; }
        if (hipFuncSetAttribute((const void*)fwd_kernel, hipFuncAttributeMaxDynamicSharedMemorySize, LDS_BYTES) != hipSuccess) { fprintf(stderr, "kernel_launch: hipFuncSetAttribute failed\n"); grid = -1; return; }
        if (hipOccupancyMaxActiveBlocksPerMultiprocessor(&per_cu, (const void*)fwd_kernel, 512, LDS_BYTES) != hipSuccess || per_cu < 1) fprintf(stderr, "kernel_launch: occupancy query says %d\n", per_cu);
        (void)hipGetLastError();
        grid = cus;
    }
    if (grid < 0) return;
    (void)hipMemsetAsync((char*)d_ws + WS_CTL, 0, CTL_BYTES, stream);
    Args a{};
    for (int i = 0; i < 26; ++i) a.in[i] = (const float*)d_in[i];
    a.out = (float*)d_out; a.ws = (unsigned char*)d_ws;
    if (MK_N_LAUNCHES == 1) { a.ph_lo = 0; a.ph_hi = NPH; hipLaunchKernelGGL(fwd_kernel, dim3(grid), dim3(512), LDS_BYTES, stream, a); }
    else for (int p = 0; p < NPH; ++p) { a.ph_lo = p; a.ph_hi = p + 1; hipLaunchKernelGGL(fwd_kernel, dim3(grid), dim3(512), LDS_BYTES, stream, a); }
    const hipError_t le = hipPeekAtLastError();
    if (le != hipSuccess) fprintf(stderr, "kernel_launch: launch failed: %s\n", hipGetErrorName(le));
}
```

```cpp
#include <hip/hip_runtime.h>
#include <cstdio>
#include <cstdint>

#ifndef MK_N_LAUNCHES
#define MK_N_LAUNCHES 1
#endif

#define LAS __attribute__((address_space(3)))
typedef unsigned short bf16_t;
typedef short bf16x8 __attribute__((ext_vector_type(8)));
typedef short s16x4 __attribute__((ext_vector_type(4)));
typedef float f32x4 __attribute__((ext_vector_type(4)));
typedef float f32x2 __attribute__((ext_vector_type(2)));
typedef float f32x16 __attribute__((ext_vector_type(16)));
typedef unsigned u32x4 __attribute__((ext_vector_type(4)));
typedef unsigned u32x2 __attribute__((ext_vector_type(2)));

constexpr int NB = 4, SEQ = 4096, T = NB * SEQ, D = 2048;
constexpr int CH = 256, NCH = SEQ / CH, NBLK = NB * 8 * NCH;
constexpr int N_IN_NAT = 11520;
constexpr int N_IN_ALL = N_IN_NAT + 2048;
constexpr int NE = 32, PMAX = 73728;
constexpr float RMS_EPS = 1e-6f, GN_EPS = 1e-6f;
constexpr float QSCALE = 0.07216878364870322f;
constexpr int CONV_WGS = 64;

constexpr size_t MiB = 1u << 20;
constexpr size_t WS_CTL = 0, CTL_BYTES = 1 * MiB;
constexpr size_t WS_WT_IN = 1 * MiB;
constexpr size_t WS_WT_QB = WS_WT_IN + 54 * MiB;
constexpr size_t WS_WT_KVB = WS_WT_QB + 2 * MiB;
constexpr size_t WS_WT_MLAO = WS_WT_KVB + 2 * MiB;
constexpr size_t WS_WT_RETO = WS_WT_MLAO + 4 * MiB;
constexpr size_t WS_WT_OUT = WS_WT_RETO + 8 * MiB;
constexpr size_t WS_WT_GU = WS_WT_OUT + 8 * MiB;
constexpr size_t WS_WT_DOWN = WS_WT_GU + 512 * MiB;
constexpr size_t WS_CS_RET = WS_WT_DOWN + 256 * MiB;
constexpr size_t WS_CS_MLA = WS_CS_RET + 16 * MiB;
constexpr size_t WS_H = WS_CS_MLA + 4 * MiB;
constexpr size_t WS_QL = WS_H + 64 * MiB;
constexpr size_t WS_CKV = WS_QL + 16 * MiB;
constexpr size_t WS_KR = WS_CKV + 16 * MiB;
constexpr size_t WS_ACAT = WS_KR + 2 * MiB;
constexpr size_t WS_BCAT = WS_ACAT + 192 * MiB;
constexpr size_t WS_KROT = WS_BCAT + 192 * MiB;
constexpr size_t WS_KZTF = WS_KROT + 64 * MiB;
constexpr size_t WS_KZTB = WS_KZTF + 64 * MiB;
constexpr size_t WS_SG = WS_KZTB + 64 * MiB;
constexpr size_t WS_GA = WS_SG + 64 * MiB;
constexpr size_t WS_GB = WS_GA + 64 * MiB;
constexpr size_t WS_QN = WS_GB + 64 * MiB;
constexpr size_t WS_QR = WS_QN + 32 * MiB;
constexpr size_t WS_KN = WS_QR + 16 * MiB;
constexpr size_t WS_VV = WS_KN + 32 * MiB;
constexpr size_t WS_OA = WS_VV + 32 * MiB;
constexpr size_t WS_ORET = WS_OA + 32 * MiB;
constexpr size_t WS_OB = WS_ORET + 128 * MiB;
constexpr size_t WS_MIXP = WS_OB + 64 * MiB;
constexpr size_t WS_MIXIN = WS_MIXP + 64 * MiB;
constexpr size_t WS_MIX = WS_MIXIN + 64 * MiB;
constexpr size_t WS_H2 = WS_MIX + 128 * MiB;
constexpr size_t WS_TOPI = WS_H2 + 64 * MiB;
constexpr size_t WS_TOPW = WS_TOPI + 1 * MiB;
constexpr size_t WS_DEST = WS_TOPW + 1 * MiB;
constexpr size_t WS_TILE = WS_DEST + 1 * MiB;
constexpr size_t WS_YS_END = WS_TILE + 1 * MiB + 3 * 288 * MiB;
constexpr size_t WS_DECTAB = WS_TILE + 65536;
constexpr size_t WS_SSQP = WS_YS_END;
constexpr size_t WS_XS = WS_TILE + 1 * MiB;
constexpr size_t WS_ACT = WS_XS + 288 * MiB;
constexpr size_t WS_YS = WS_ACT + 288 * MiB;
constexpr size_t WS_ADAP = WS_YS + 288 * MiB + 1 * MiB;
constexpr size_t WS_H8 = WS_ADAP + 2 * MiB;
constexpr size_t WS_WT8IN = WS_H8 + 32 * MiB;
constexpr size_t WS_VT8 = WS_WT8IN + 12 * MiB;
constexpr size_t WS_X1B = WS_VT8 + 32 * MiB;
constexpr size_t WS_END = WS_X1B + 64 * MiB;
constexpr int CW_BAR = 4096;
constexpr int CW_QUEUE = 8192, CW_CVTQ = 8384, CW_AQ = 9216  , CW_COUNTS = 10240, CW_CURSOR = 12288;
constexpr int CW_ADA = 16384;
constexpr int CW_SSQQ = 65536, CW_SSQKV = 81920;
static_assert((CW_SSQKV + T) * 4 <= (int)CTL_BYTES, "ctl");

constexpr int RING_BYTES = 131072, CTRL_OFF = 155648, MISC_OFF = CTRL_OFF, LARG_OFF = CTRL_OFF + 1024, LDS_BYTES = 163840;

__device__ __forceinline__ unsigned cvt_pk_bf16(float lo, float hi) { unsigned r; asm volatile("v_cvt_pk_bf16_f32 %0, %1, %2" : "=v"(r) : "v"(lo), "v"(hi)); return r; }
__device__ __forceinline__ u32x4 pack8(f32x4 a, f32x4 b) { u32x4 w; w.x = cvt_pk_bf16(a[0], a[1]); w.y = cvt_pk_bf16(a[2], a[3]); w.z = cvt_pk_bf16(b[0], b[1]); w.w = cvt_pk_bf16(b[2], b[3]); return w; }
__device__ __forceinline__ unsigned pk4_fp8(float a, float b, float c, float d, float sc) {
    a = __builtin_amdgcn_fmed3f(a * sc, -448.f, 448.f); b = __builtin_amdgcn_fmed3f(b * sc, -448.f, 448.f); c = __builtin_amdgcn_fmed3f(c * sc, -448.f, 448.f); d = __builtin_amdgcn_fmed3f(d * sc, -448.f, 448.f);
    int w = __builtin_amdgcn_cvt_pk_fp8_f32(a, b, 0, false); w = __builtin_amdgcn_cvt_pk_fp8_f32(c, d, w, true); return (unsigned)w;
}
constexpr float W8_SCALE = 1024.f, H8_SCALE = 16.f, A8_SCALE = 8.f;
constexpr float V8_SCALE = 16.f, K8_SCALE = 256.f, CH_UNSCALE = 1.0f / (V8_SCALE * K8_SCALE);
constexpr float GU_UNSCALE = 1.0f / (W8_SCALE * H8_SCALE), DN_UNSCALE = 1.0f / (W8_SCALE * A8_SCALE);
constexpr float M8_SCALE = 64.f, MX_UNSCALE = 1.0f / (W8_SCALE * M8_SCALE);
__device__ __forceinline__ float bf_lo(unsigned w) { return __uint_as_float(w << 16); }
__device__ __forceinline__ float bf_hi(unsigned w) { return __uint_as_float(w & 0xffff0000u); }
__device__ __forceinline__ void unpack8(u32x4 w, f32x4& a, f32x4& b) { a = (f32x4){bf_lo(w.x), bf_hi(w.x), bf_lo(w.y), bf_hi(w.y)}; b = (f32x4){bf_lo(w.z), bf_hi(w.z), bf_lo(w.w), bf_hi(w.w)}; }
__device__ __forceinline__ float wave_sum(float v) {
#pragma unroll
    for (int o = 1; o < 64; o <<= 1) v += __shfl_xor(v, o);
    return v;
}
__device__ __forceinline__ float sigmoidf_(float x) { return __builtin_amdgcn_rcpf(1.0f + __expf(-x)); }
__device__ __forceinline__ float log2_sigmoid(float x) { return -log1pf(expf(-x)) * 1.4426950408889634f; }

#define XB_TMO      128
#define XB_XCNT(j)  (256  + 64 * (j))
#define XB_XSUB(j)  (1280 + 64 * (j))
#define XB_XGEN(j)  (2304 + 64 * (j))
#define XB_TOP      3328
#define XB_TOPGEN   3392
#define XCD_BAR_WORDS 3456
#define XB_SPIN_CAP (1u << 22)
__device__ __forceinline__ unsigned xb_ld(unsigned* p)              { return __hip_atomic_load(p, __ATOMIC_RELAXED, __HIP_MEMORY_SCOPE_AGENT); }
__device__ __forceinline__ unsigned xb_add(unsigned* p, unsigned v) { return __hip_atomic_fetch_add(p, v, __ATOMIC_RELAXED, __HIP_MEMORY_SCOPE_AGENT); }
__device__ __forceinline__ unsigned xb_xcc_id() { return (unsigned)__builtin_amdgcn_s_getreg((3 << 11) | 20) & 0xFu; }
#define XB_SPIN(cond, bar) do { unsigned _sp = 0; while (cond) { __builtin_amdgcn_s_sleep(1); \
    if ((++_sp & 255u) == 0u) { if (xb_ld(&(bar)[XB_TMO])) break; if (_sp > XB_SPIN_CAP) { atomicAdd(&(bar)[XB_TMO], 1u); break; } } } } while (0)
struct XcdBarrier { unsigned* bar; unsigned x; volatile LAS unsigned* st; };
__device__ __forceinline__ XcdBarrier xcd_barrier_post(unsigned* bar, volatile LAS unsigned* st) {
    XcdBarrier b; b.bar = bar; b.x = xb_xcc_id(); b.st = st;
    if (threadIdx.x == 0) (void)xb_add(&bar[XB_XCNT(b.x)], 1u);
    return b;
}
__device__ __forceinline__ void xcd_barrier_complete(unsigned* bar, unsigned x, unsigned& nloc, unsigned& nx) {
    const unsigned G = gridDim.x * gridDim.y * gridDim.z;
    unsigned sum, cnt, mine, sp = 0u;
    for (;;) {
        sum = 0u; cnt = 0u; mine = 0u;
#pragma unroll
        for (unsigned j = 0; j < 16; ++j) { const unsigned c = xb_ld(&bar[XB_XCNT(j)]); sum += c; cnt += (c > 0u) ? 1u : 0u; mine = (j == x) ? c : mine; }
        if (sum == G) break;
        __builtin_amdgcn_s_sleep(1);
        if ((++sp & 255u) == 0u) { if (xb_ld(&bar[XB_TMO])) break; if (sp > XB_SPIN_CAP) { atomicAdd(&bar[XB_TMO], 1u); break; } }
    }
    nloc = mine > 0u ? mine : 1u; nx = cnt > 0u ? cnt : 1u;
}
__device__ __forceinline__ void xcd_barrier(const XcdBarrier& b) {
    asm volatile("s_waitcnt vmcnt(0)" ::: "memory");
    __syncthreads();
    if (threadIdx.x == 0) {
        unsigned* bar = b.bar;
        __builtin_amdgcn_s_waitcnt(0);
        unsigned nloc = b.st[0], nx = b.st[1];
        if (nloc == 0u) { xcd_barrier_complete(bar, b.x, nloc, nx); b.st[0] = nloc; b.st[1] = nx; }
        const unsigned old = xb_add(&bar[XB_XSUB(b.x)], 1u);
        const unsigned gen = old / nloc;
        if (old + 1u == (gen + 1u) * nloc) {
            __builtin_amdgcn_fence(__ATOMIC_RELEASE, "agent");
            asm volatile("s_waitcnt vmcnt(0)" ::: "memory");
            const unsigned og = xb_add(&bar[XB_TOP], 1u);
            const unsigned tg = og / nx;
            if (og + 1u == (tg + 1u) * nx) xb_add(&bar[XB_TOPGEN], 1u);
            else XB_SPIN(xb_ld(&bar[XB_TOPGEN]) == tg, bar);
            __builtin_amdgcn_fence(__ATOMIC_ACQUIRE, "agent");
            xb_add(&bar[XB_XGEN(b.x)], 1u);
            asm volatile("s_waitcnt vmcnt(0)" ::: "memory");
        } else {
            XB_SPIN(xb_ld(&bar[XB_XGEN(b.x)]) == gen, bar);
            __builtin_amdgcn_fence(__ATOMIC_ACQUIRE, "agent");
            asm volatile("s_waitcnt vmcnt(0)" ::: "memory");
        }
    }
    __syncthreads();
}

namespace pg8 {
constexpr int BM = 256, BK = 64, HALF = 128, HTB = HALF * BK * 2, NXCD = 8, WGM = 8;
__host__ __device__ __forceinline__ int lds_byte(int r, int c, int SW = 5) { const int st = (r >> 4) * 2 + (c >> 5), rr = r & 15, cc = c & 31, ob = rr * 64 + cc * 2; return st * 1024 + (ob ^ (((ob >> 9) & 1) << SW)); }
__host__ __device__ __forceinline__ void stage_rc(int b, int& R, int& C, int SW = 5) { const int st = b / 1024, sb = b % 1024, swz = sb ^ (((sb >> 9) & 1) << SW); R = (st >> 1) * 16 + swz / 64; C = (st & 1) * 32 + (swz % 64) / 2; }
__host__ __device__ __forceinline__ int perm32(int rho) { const int n = rho >> 4, i = rho & 15; return 8 * (i >> 2) + 4 * n + (i & 3); }
struct Unit { const char* a; const char* b; int pm, pn, keep, aux; };
__device__ __forceinline__ void tile_order(int wgid, int nM, int nN, int& pm, int& pn) {
    const int nwg = nM * nN; { const int q = nwg / NXCD, r = nwg % NXCD, xcd = wgid % NXCD, off = wgid / NXCD; wgid = (xcd < r ? xcd * (q + 1) : r * (q + 1) + (xcd - r) * q) + off; }
    const int nig = WGM * nN, gid = wgid / nig, fm = gid * WGM, gsz = (nM - fm) < WGM ? (nM - fm) : WGM;
    pm = fm + ((wgid % nig) % gsz); pn = (wgid % nig) / gsz;
}
typedef int v8i __attribute__((ext_vector_type(8)));
typedef int v4i __attribute__((ext_vector_type(4)));
template <class Epi, class Sched, bool F8 = false, bool REMAT = false>
__device__ __forceinline__ void gemm_phase(LAS unsigned char* lds, const int K, const int lda, const int ldb, const Sched& S, const Epi& E) {
    const int tid = threadIdx.x, wid = __builtin_amdgcn_readfirstlane(tid >> 6), lane = tid & 63, wr = wid >> 2, wc = wid & 3, fr = lane & 15, fq = lane >> 4;
    constexpr int ES = F8 ? 1 : 2;
    const int nt = K * ES / (BK * 2);
    unsigned voffA, voffB;
    constexpr bool X4 = F8 && !REMAT;
    constexpr int SW = X4 ? 4 : 5;
    { int R, C; stage_rc(tid * 16, R, C, SW); const int Rb = (R & ~31) + perm32(R & 31); voffA = (unsigned)(R * lda * ES + C * 2); voffB = (unsigned)(Rb * ldb * ES + C * 2); }
    const size_t q64voffA = (size_t)64 * lda * ES, q64voffB = (size_t)64 * ldb * ES;
    const size_t kstep = (size_t)(BK * 2);
    const size_t hstepA = (size_t)HALF * lda * ES, hstepB = (size_t)HALF * ldb * ES;
    const unsigned ldsw = (unsigned)wid * 1024u;
    const int aoff = F8 ? lds_byte(wr * 64 + fr, fq * 16, SW) : lds_byte(wr * 64 + fr, fq * 8), boff = F8 ? lds_byte(wc * 32 + fr, fq * 16, SW) : lds_byte(wc * 32 + fr, fq * 8);
#define PG8_SA(b, h) (((b) * 2 + (h)) * HTB)
#define PG8_SB(b, h) ((4 + (b) * 2 + (h)) * HTB)
    constexpr bool isB_voffA = false, isB_voffB = true; const unsigned pitch_voffA = (unsigned)(lda * ES), pitch_voffB = (unsigned)(ldb * ES);
#define PG8_VOFF(isB, pitch) ({ unsigned _t = threadIdx.x; asm volatile("" : "+v"(_t)); const unsigned _l = _t & 63u, _w = _t >> 6, _sw = (_l * 16u) ^ ((_l >> 5) << SW); unsigned _R = (_w >> 1) * 16u + (_sw >> 6); \
        const unsigned _C = (_w & 1u) * 32u + ((_sw & 63u) >> 1); if (isB) _R = (_R & ~31u) + (unsigned)perm32((int)(_R & 31u)); _R * (pitch) + _C * 2u; })
#define PG8_STAGE(bufoff, gbase, voff) do { _Pragma("unroll") for (int _i = 0; _i < 2; ++_i) { unsigned _vo; if constexpr (REMAT) _vo = PG8_VOFF(isB_##voff, pitch_##voff); else { _vo = (voff); if constexpr (F8) asm volatile("" : "+v"(_vo)); } \
        __builtin_amdgcn_global_load_lds((const unsigned*)((const char*)(gbase) + (_i ? q64##voff : (size_t)0) + _vo), (LAS unsigned*)(lds + (bufoff) + ldsw + _i * 8192), 16, 0, 0); } } while (0)
#define PG8_LD1(addr) ({ v8i _r; if constexpr (F8 && !X4) { _r = *(const LAS v8i*)(addr); } else if constexpr (X4) { const v4i _lo = *(const LAS v4i*)(addr), _hi = *(const LAS v4i*)((addr) + _x16); _r = __builtin_shufflevector(_lo, _hi, 0, 1, 2, 3, 4, 5, 6, 7); } else { const v4i _lo = *(const LAS v4i*)(addr), _hi = *(const LAS v4i*)((addr) + 1024); _r = __builtin_shufflevector(_lo, _hi, 0, 1, 2, 3, 4, 5, 6, 7); } _r; })
#define PG8_X16(off) int _x16 = 0; if constexpr (X4) { int _o = (off); asm volatile("" : "+v"(_o)); _x16 = (_o ^ 16) - _o; }
#define PG8_LDA(dst, b, h) do { PG8_X16(aoff) _Pragma("unroll") for (int m = 0; m < 4; ++m) dst[m] = PG8_LD1(lds + PG8_SA(b, h) + aoff + m * 2048); } while (0)
#define PG8_LDB(dst, b, h) do { PG8_X16(boff) _Pragma("unroll") for (int n = 0; n < 2; ++n) dst[n] = PG8_LD1(lds + PG8_SB(b, h) + boff + n * 2048); } while (0)
#define PG8_H0(x) __builtin_bit_cast(bf16x8, __builtin_shufflevector(x, x, 0, 1, 2, 3))
#define PG8_H1(x) __builtin_bit_cast(bf16x8, __builtin_shufflevector(x, x, 4, 5, 6, 7))
#define PG8_MMA(ai, bj, At, Bt) do { __builtin_amdgcn_s_setprio(1); _Pragma("unroll") for (int m = 0; m < 4; ++m) _Pragma("unroll") for (int n = 0; n < 2; ++n) { \
        if constexpr (F8) acc[ai][bj][m][n] = __builtin_amdgcn_mfma_scale_f32_16x16x128_f8f6f4(Bt[n], At[m], acc[ai][bj][m][n], 0, 0, 0, 0, 0, 0); \
        else { acc[ai][bj][m][n] = __builtin_amdgcn_mfma_f32_16x16x32_bf16(PG8_H0(Bt[n]), PG8_H0(At[m]), acc[ai][bj][m][n], 0, 0, 0); \
               acc[ai][bj][m][n] = __builtin_amdgcn_mfma_f32_16x16x32_bf16(PG8_H1(Bt[n]), PG8_H1(At[m]), acc[ai][bj][m][n], 0, 0, 0); } } \
        __builtin_amdgcn_s_setprio(0); } while (0)
#define PG8_WAIT_V(n) asm volatile("s_waitcnt vmcnt(" #n ")" ::: "memory")
#define PG8_WAIT_L(n) asm volatile("s_waitcnt lgkmcnt(" #n ")" ::: "memory")
#define PG8_BAR __builtin_amdgcn_s_barrier()
#define PG8_SCHED __builtin_amdgcn_sched_barrier(0)
    Unit cur, nxt; int ui = 0;
    if (!S.next(0, cur)) return;
    f32x4 acc[2][2][4][2];
#pragma unroll
    for (int a = 0; a < 2; ++a)
#pragma unroll
        for (int b = 0; b < 2; ++b)
#pragma unroll
            for (int m = 0; m < 4; ++m)
#pragma unroll
                for (int n = 0; n < 2; ++n) acc[a][b][m][n] = (f32x4){0.f, 0.f, 0.f, 0.f};
    v8i At[4], B0[2], B1[2];
    const char* cA = cur.a; const char* cB = cur.b;
    PG8_STAGE(PG8_SB(0, 0), cB, voffB); PG8_STAGE(PG8_SB(0, 1), cB + hstepB, voffB); PG8_STAGE(PG8_SA(0, 0), cA, voffA); PG8_STAGE(PG8_SA(0, 1), cA + hstepA, voffA);
    if (wr == 1) PG8_BAR;
    PG8_WAIT_V(2); PG8_BAR;
    PG8_STAGE(PG8_SB(1, 0), cB + kstep, voffB); PG8_STAGE(PG8_SA(1, 0), cA + kstep, voffA); PG8_STAGE(PG8_SB(1, 1), cB + hstepB + kstep, voffB);
    PG8_WAIT_V(6); PG8_BAR;
    for (;;) {
        const bool has_next = S.next(ui + 1, nxt);
        const char* nA = has_next ? nxt.a : cA; const char* nB = has_next ? nxt.b : cB;
#pragma nounroll
        for (int t = 0; t < nt; t += 2) {
            const bool last = (t == nt - 2);
            const char* a1 = cA + (size_t)(t + 1) * kstep;
            const char* a2 = last ? nA : cA + (size_t)(t + 2) * kstep; const char* b2 = last ? nB : cB + (size_t)(t + 2) * kstep;
            const char* a3 = a2 + kstep; const char* b3 = b2 + kstep;
            PG8_LDB(B0, 0, 0); PG8_LDB(B1, 0, 1); PG8_SCHED; PG8_LDA(At, 0, 0); PG8_STAGE(PG8_SA(1, 1), a1 + hstepA, voffA);
            PG8_WAIT_V(8); PG8_WAIT_L(0); PG8_BAR; PG8_MMA(0, 0, At, B0); PG8_MMA(0, 1, At, B1); PG8_BAR; PG8_SCHED;
            PG8_LDA(At, 0, 1); PG8_STAGE(PG8_SB(0, 0), b2, voffB); PG8_STAGE(PG8_SB(0, 1), b2 + hstepB, voffB); PG8_STAGE(PG8_SA(0, 0), a2, voffA);
            PG8_WAIT_V(8); PG8_WAIT_L(0); PG8_BAR; PG8_MMA(1, 0, At, B0); PG8_MMA(1, 1, At, B1); PG8_BAR; PG8_SCHED;
            PG8_LDB(B0, 1, 0); PG8_LDB(B1, 1, 1); PG8_SCHED; PG8_LDA(At, 1, 0); PG8_STAGE(PG8_SA(0, 1), a2 + hstepA, voffA);
            PG8_WAIT_V(8); PG8_WAIT_L(0); PG8_BAR; PG8_MMA(0, 0, At, B0); PG8_MMA(0, 1, At, B1); PG8_BAR; PG8_SCHED;
            PG8_LDA(At, 1, 1); PG8_STAGE(PG8_SB(1, 0), b3, voffB); PG8_STAGE(PG8_SB(1, 1), b3 + hstepB, voffB); PG8_STAGE(PG8_SA(1, 0), a3, voffA);
            PG8_WAIT_V(8); PG8_WAIT_L(0); PG8_BAR; PG8_MMA(1, 0, At, B0); PG8_MMA(1, 1, At, B1); PG8_BAR; PG8_SCHED;
        }
        if (wr == 0) PG8_BAR;
        { unsigned _t = threadIdx.x; if constexpr (F8) asm volatile("" : "+v"(_t)); E(acc, cur, wr, wc, (int)(_t & 15u), (int)((_t >> 4) & 3u)); }
        if (!has_next) break;
        if (!cur.keep) {
#pragma unroll
            for (int a = 0; a < 2; ++a)
#pragma unroll
                for (int b = 0; b < 2; ++b)
#pragma unroll
                    for (int m = 0; m < 4; ++m)
#pragma unroll
                        for (int n = 0; n < 2; ++n) acc[a][b][m][n] = (f32x4){0.f, 0.f, 0.f, 0.f};
        }
        cur = nxt; cA = nA; cB = nB; ++ui;
        if (wr == 1) PG8_BAR;
    }
    PG8_WAIT_V(0);
    PG8_BAR;
#undef PG8_SA
#undef PG8_SB
#undef PG8_STAGE
#undef PG8_VOFF
#undef PG8_LDA
#undef PG8_LDB
#undef PG8_LD1
#undef PG8_X16
#undef PG8_H0
#undef PG8_H1
#undef PG8_MMA
#undef PG8_WAIT_V
#undef PG8_WAIT_L
#undef PG8_BAR
#undef PG8_SCHED
}
struct GridSched {
    const char* A; const char* Bt; size_t astep, bstep; int nM, nN, G, c;
    __device__ __forceinline__ bool next(int i, Unit& u) const {
        const int L = i * G + c; if (L >= nM * nN) return false;
        int pm, pn; tile_order(L, nM, nN, pm, pn);
        u.a = A + (size_t)pm * astep; u.b = Bt + (size_t)pn * bstep; u.pm = pm; u.pn = pn; u.keep = 0; u.aux = 0; return true;
    }
};
struct InprojSched {
    const char* H; const char* W; int G, c;
    __device__ __forceinline__ bool next(int i, Unit& u) const {
        const int L = i * G + c; if (L >= 1792) return false;
        constexpr size_t TSB = (size_t)256 * 2048 * 2; int pm, pn;
        if (L < 1280) { tile_order(L, 64, 20, pm, pn); pn = pn < 4 ? pn : pn + 1; u.a = H + (size_t)pm * TSB; u.b = W + (size_t)pn * TSB; u.aux = 0; }
        else { tile_order(L - 1280, 8, 64, pm, pn); u.a = W + (size_t)(45 + pm) * TSB; u.b = H + (size_t)pn * TSB; u.aux = 1; }
        u.pm = pm; u.pn = pn; u.keep = 0; return true;
    }
};
struct GridSchedR {
    const char* A; const char* Bt; size_t astep, bstep; int nM, nN, G, c, L0, Lend;
    __device__ __forceinline__ bool next(int i, Unit& u) const {
        const int L = L0 + i * G + c; if (L >= Lend) return false;
        int pm, pn; tile_order(L, nM, nN, pm, pn);
        u.a = A + (size_t)pm * astep; u.b = Bt + (size_t)pn * bstep; u.pm = pm; u.pn = pn; u.keep = 0; u.aux = 0; return true;
    }
};
struct BatchSchedR {
    const char* A; const char* Bt; size_t astep, bstep; int G, c, L0, Lend;
    __device__ __forceinline__ bool next(int i, Unit& u) const {
        const int L = L0 + i * G + c; if (L >= Lend) return false;
        u.a = A + (size_t)L * astep; u.b = Bt + (size_t)L * bstep; u.pm = L; u.pn = 0; u.keep = 0; u.aux = 0; return true;
    }
};
struct BatchSched {
    const char* A; const char* Bt; size_t astep, bstep; int n, G, c;
    __device__ __forceinline__ bool next(int i, Unit& u) const {
        const int L = i * G + c; if (L >= n) return false;
        u.a = A + (size_t)L * astep; u.b = Bt + (size_t)L * bstep; u.pm = L; u.pn = 0; u.keep = 0; u.aux = 0; return true;
    }
};
struct ChainSched {
    const char* A; const char* Bt; int bh, dir;
    __device__ __forceinline__ bool next(int i, Unit& u) const {
        if (i >= NCH) return false;
        const int n = dir ? (NCH - 1 - i) : i, blk = bh * NCH + n;
        u.a = A + (size_t)blk * (256 * 256); u.b = Bt + (size_t)blk * (256 * 256); u.pm = blk; u.pn = i; u.keep = 1; u.aux = n; return true;
    }
};
struct MoeSched {
    const char* A; const char* Bt; const int* tile_e; int ntiles, nN, G, c;
    __device__ __forceinline__ bool next(int i, Unit& u) const {
        const int L = i * G + c; if (L >= ntiles * nN) return false;
        int pm, pn; tile_order(L, ntiles, nN, pm, pn);
        const int e = __builtin_amdgcn_readfirstlane(tile_e[pm]);
        u.a = A + (size_t)pm * (256 * 2048); u.b = Bt + ((size_t)e * nN + pn) * (256 * 2048); u.pm = pm; u.pn = pn; u.keep = 0; u.aux = e; return true;
    }
};
}
using pg8::Unit;

#define EPI_LOOP _Pragma("unroll") for (int ai = 0; ai < 2; ++ai) _Pragma("unroll") for (int m = 0; m < 4; ++m)
#define EPI_ROW (ai * 128 + wr * 64 + m * 16 + fr)
#define EPI_FENCE asm volatile("" ::: "memory")
typedef f32x4 Acc[2][2][4][2];

__device__ __forceinline__ void rot4(const f32x4 x1, const f32x4 x2, const f32x4 csA, const f32x4 csB, f32x4& o1, f32x4& o2) {
    o1[0] = x1[0] * csA[0] - x2[0] * csA[1]; o2[0] = x1[0] * csA[1] + x2[0] * csA[0];
    o1[1] = x1[1] * csA[2] - x2[1] * csA[3]; o2[1] = x1[1] * csA[3] + x2[1] * csA[2];
    o1[2] = x1[2] * csB[0] - x2[2] * csB[1]; o2[2] = x1[2] * csB[1] + x2[2] * csB[0];
    o1[3] = x1[3] * csB[2] - x2[3] * csB[3]; o2[3] = x1[3] * csB[3] + x2[3] * csB[2];
}
__device__ __forceinline__ f32x4 rot_il(const f32x4 v, const f32x4 cs) {
    return (f32x4){v[0] * cs[0] - v[1] * cs[1], v[0] * cs[1] + v[1] * cs[0], v[2] * cs[2] - v[3] * cs[3], v[2] * cs[3] + v[3] * cs[2]};
}

struct EpiInproj {
    bf16_t *QL, *CKV, *KR, *ACAT, *KROT, *SG, *GA, *GB; float *ssqp; const float* cs_ret; const float* cs_mla; const float* dectab; int pn_off; float unscale;
    __device__ __forceinline__ void operator()(Acc& acc, const Unit& u, int wr, int wc, int fr, int fq) const {
        asm volatile("" : "+v"(fr), "+v"(fq));
        const int pn = u.pn + pn_off, tok0 = u.pm * 256, cb = wc * 32 + fq * 8;
        if (pn < 4) {
            bf16_t* dst = QL + (size_t)(pn >> 1) * ((WS_CKV - WS_QL) / 2); float* ssq = ssqp + (size_t)(pn * 4 + wc) * T; const int c0 = (pn & 1) * 256 + cb;
            EPI_LOOP { const int row = tok0 + EPI_ROW; float s = 0.f;
#pragma unroll
                for (int bj = 0; bj < 2; ++bj) { const f32x4 v0 = acc[ai][bj][m][0], v1 = acc[ai][bj][m][1];
                    s += (v0[0] * v0[0] + v0[1] * v0[1]) + (v0[2] * v0[2] + v0[3] * v0[3]) + (v1[0] * v1[0] + v1[1] * v1[1]) + (v1[2] * v1[2] + v1[3] * v1[3]);
                    *(u32x4*)(dst + (size_t)row * 512 + c0 + bj * 128) = pack8(v0, v1); }
                s += __shfl_xor(s, 16); s += __shfl_xor(s, 32);
                if (fq == 0) ssq[row] = s; EPI_FENCE; }
        } else if (pn == 4) {
            if (wc < 2) {
                EPI_LOOP { const int row = tok0 + EPI_ROW; const float* cs = cs_mla + (size_t)row * 64 + cb;
                    const f32x4 csA = *(const f32x4*)cs, csB = *(const f32x4*)(cs + 4);
                    *(u32x4*)(KR + (size_t)row * 64 + cb) = pack8(rot_il(acc[ai][0][m][0], csA), rot_il(acc[ai][0][m][1], csB)); EPI_FENCE; }
            }
        } else if (pn < 21) {
            const bool isq = pn < 13; const int h = isq ? pn - 5 : pn - 13;
            const int blk = ((u.pm >> 4) * 8 + h) * NCH + (u.pm & 15);
            const float lf = dectab[h], lb = dectab[8 + h];
            EPI_LOOP { const int c = EPI_ROW, row = tok0 + c; const float* cs = cs_ret + (size_t)row * 256 + cb * 2;
                f32x4 q1[2], q2[2];
#pragma unroll
                for (int n = 0; n < 2; ++n) { const f32x4 csA = *(const f32x4*)(cs + n * 8), csB = *(const f32x4*)(cs + n * 8 + 4); rot4(acc[ai][0][m][n], acc[ai][1][m][n], csA, csB, q1[n], q2[n]); }
                if (isq) {
                    const float xf = __builtin_amdgcn_exp2f((float)(c + 1) * lf), xb = __builtin_amdgcn_exp2f((float)(CH - c) * lb);
                    bf16_t* base = ACAT + ((size_t)blk * 256 + c) * 768 + cb;
                    *(u32x4*)(base + 256) = pack8(q1[0] * xf, q1[1] * xf); *(u32x4*)(base + 384) = pack8(q2[0] * xf, q2[1] * xf);
                    *(u32x4*)(base + 512) = pack8(q1[0] * xb, q1[1] * xb); *(u32x4*)(base + 640) = pack8(q2[0] * xb, q2[1] * xb);
                } else {
                    bf16_t* base = KROT + ((size_t)blk * 256 + c) * 256 + cb;
                    *(u32x4*)(base) = pack8(q1[0] * 0.0625f, q1[1] * 0.0625f); *(u32x4*)(base + 128) = pack8(q2[0] * 0.0625f, q2[1] * 0.0625f);
                }
                EPI_FENCE; }
        } else {
            const int g = (pn - 21) >> 3, ct = (pn - 21) & 7; bf16_t* dst = SG + (size_t)g * ((WS_GA - WS_SG) / 2);
            EPI_LOOP { const int row = tok0 + EPI_ROW;
#pragma unroll
                for (int bj = 0; bj < 2; ++bj) { f32x4 v[2];
#pragma unroll
                    for (int n = 0; n < 2; ++n)
#pragma unroll
                        for (int j = 0; j < 4; ++j) { const float x = acc[ai][bj][m][n][j] * unscale; const float sg = sigmoidf_(x); v[n][j] = g == 0 ? x * sg : sg; }
                    *(u32x4*)(dst + (size_t)row * 2048 + ct * 256 + bj * 128 + cb) = pack8(v[0], v[1]); }
                EPI_FENCE; }
        }
    }
};
struct EpiVT {
    bf16_t* BCAT; unsigned char* VT8;
    __device__ __forceinline__ void operator()(Acc& acc, const Unit& u, int wr, int wc, int fr, int fq) const {
        asm volatile("" : "+v"(fr), "+v"(fq));
        const int blk = ((u.pn >> 4) * 8 + u.pm) * NCH + (u.pn & 15), cb = wc * 32 + fq * 8;
        EPI_LOOP { bf16_t* base = BCAT + ((size_t)blk * 256 + EPI_ROW) * 768 + cb; unsigned char* b8 = VT8 + ((size_t)blk * 256 + EPI_ROW) * 256 + cb;
#pragma unroll
            for (int bj = 0; bj < 2; ++bj) { const f32x4 v0 = acc[ai][bj][m][0], v1 = acc[ai][bj][m][1]; *(u32x4*)(base + bj * 128) = pack8(v0, v1);
                u32x2 w8; w8.x = pk4_fp8(v0[0], v0[1], v0[2], v0[3], V8_SCALE); w8.y = pk4_fp8(v1[0], v1[1], v1[2], v1[3], V8_SCALE); *(u32x2*)(b8 + bj * 128) = w8; } }
    }
};
struct EpiInprojAll {
    EpiInproj a; EpiVT b;
    __device__ __forceinline__ void operator()(Acc& acc, const Unit& u, int wr, int wc, int fr, int fq) const { if (u.aux) b(acc, u, wr, wc, fr, fq); else a(acc, u, wr, wc, fr, fq); }
};
struct EpiMlaQ {
    bf16_t *QN, *QR; const float* ssq; const float* cs_mla;
    __device__ __forceinline__ void operator()(Acc& acc, const Unit& u, int wr, int wc, int fr, int fq) const {
        asm volatile("" : "+v"(fr), "+v"(fq));
        const int pn = u.pn, tok0 = u.pm * 256, cb = wc * 32 + fq * 8;
        EPI_LOOP { const int row = tok0 + EPI_ROW; float ss = 0.f;
#pragma unroll
            for (int q = 0; q < 8; ++q) ss += ssq[(size_t)q * T + row];
            const float rs = rsqrtf(ss * (1.0f / 512.0f) + RMS_EPS) * QSCALE;
            if (pn < 4) {
#pragma unroll
                for (int bj = 0; bj < 2; ++bj) *(u32x4*)(QN + (size_t)row * 1024 + (2 * pn + bj) * 128 + cb) = pack8(acc[ai][bj][m][0] * rs, acc[ai][bj][m][1] * rs);
            } else {
                const int c0 = (wc & 1) * 32 + fq * 8; const float* cs = cs_mla + (size_t)row * 64 + c0;
                const f32x4 csA = *(const f32x4*)cs, csB = *(const f32x4*)(cs + 4);
#pragma unroll
                for (int bj = 0; bj < 2; ++bj) { const int head = 4 * (pn - 4) + 2 * bj + (wc >> 1);
                    *(u32x4*)(QR + (size_t)row * 512 + head * 64 + c0) = pack8(rot_il(acc[ai][bj][m][0], csA) * rs, rot_il(acc[ai][bj][m][1], csB) * rs); }
            }
            EPI_FENCE; }
    }
};
struct EpiMlaKV {
    bf16_t *KN, *VV; const float* ssq;
    __device__ __forceinline__ void operator()(Acc& acc, const Unit& u, int wr, int wc, int fr, int fq) const {
        asm volatile("" : "+v"(fr), "+v"(fq));
        const int pn = u.pn, tok0 = u.pm * 256, cb = wc * 32 + fq * 8; bf16_t* dst = KN + (size_t)(pn >> 2) * ((WS_VV - WS_KN) / 2); const int hb = 2 * (pn & 3);
        EPI_LOOP { const int row = tok0 + EPI_ROW; float ss = 0.f;
#pragma unroll
            for (int q = 0; q < 8; ++q) ss += ssq[(size_t)q * T + row];
            const float rs = rsqrtf(ss * (1.0f / 512.0f) + RMS_EPS);
#pragma unroll
            for (int bj = 0; bj < 2; ++bj) *(u32x4*)(dst + (size_t)row * 1024 + (hb + bj) * 128 + cb) = pack8(acc[ai][bj][m][0] * rs, acc[ai][bj][m][1] * rs); }
    }
};
struct EpiGa {
    bf16_t* ACAT; const float* dectab;
    __device__ __forceinline__ void operator()(Acc& acc, const Unit& u, int wr, int wc, int fr, int fq) const {
        asm volatile("" : "+v"(fr), "+v"(fq));
        const int blk = u.pm, h = (blk >> 4) & 7, cb = wc * 32 + fq * 8;
        const float lf = dectab[h], lb = dectab[8 + h];
        f32x4 colA[2][2], colB[2][2];
#pragma unroll
        for (int bj = 0; bj < 2; ++bj)
#pragma unroll
            for (int n = 0; n < 2; ++n)
#pragma unroll
                for (int j = 0; j < 4; ++j) { const int mm = bj * 128 + cb + n * 4 + j; colA[bj][n][j] = __builtin_amdgcn_exp2f(-(float)(mm + 1) * lf); colB[bj][n][j] = __builtin_amdgcn_exp2f((float)mm * lb); }
        EPI_LOOP { const int c = EPI_ROW; bf16_t* base = ACAT + ((size_t)blk * 256 + c) * 768 + cb;
            const float rowB = __builtin_amdgcn_exp2f(-(float)c * lb - (float)(c + 1) * lf);
#pragma unroll
            for (int bj = 0; bj < 2; ++bj) { f32x4 v[2];
#pragma unroll
                for (int n = 0; n < 2; ++n)
#pragma unroll
                    for (int j = 0; j < 4; ++j) { const int mm = bj * 128 + cb + n * 4 + j;
                        v[n][j] = acc[ai][bj][m][n][j] * ((c >= mm) ? colA[bj][n][j] : colB[bj][n][j] * rowB); }
                *(u32x4*)(base + bj * 128) = pack8(v[0], v[1]); }
            EPI_FENCE; }
    }
};
struct EpiGb {
    bf16_t* BCAT; const float* dectab; int dir;
    __device__ __forceinline__ void operator()(Acc& acc, const Unit& u, int wr, int wc, int fr, int fq) const {
        asm volatile("" : "+v"(fr), "+v"(fq));
        const int h = (u.pm >> 4) & 7;
        const float gC = __builtin_amdgcn_exp2f((float)CH * dectab[8 * dir + h]);
        if (u.pn < NCH - 1) {
            const int nblk = dir ? u.pm - 1 : u.pm + 1;
            bf16_t* base0 = BCAT + ((size_t)nblk * 256 + wr * 64 + fr) * 768 + 256 + 256 * dir + wc * 32 + fq * 8;
            EPI_LOOP { bf16_t* base = base0 + (size_t)(ai * 128 + m * 16) * 768;
#pragma unroll
                for (int bj = 0; bj < 2; ++bj) *(u32x4*)(base + bj * 128) = pack8(acc[ai][bj][m][0] * CH_UNSCALE, acc[ai][bj][m][1] * CH_UNSCALE); }
        }
        EPI_LOOP {
#pragma unroll
            for (int bj = 0; bj < 2; ++bj) { acc[ai][bj][m][0] *= gC; acc[ai][bj][m][1] *= gC; } }
    }
};
struct EpiGc {
    bf16_t* OB; const bf16_t* SG; const float* gn; LAS unsigned char* lds;
    __device__ __forceinline__ void operator()(Acc& acc, const Unit& u, int wr, int wc, int fr, int fq) const {
        asm volatile("" : "+v"(fr), "+v"(fq));
        const int blk = u.pm, b = blk >> 7, h = (blk >> 4) & 7, n = blk & 15, cb = wc * 32 + fq * 8;
        LAS f32x2* P = (LAS f32x2*)(lds + RING_BYTES);
        EPI_LOOP { float s = 0.f;
#pragma unroll
            for (int bj = 0; bj < 2; ++bj)
#pragma unroll
                for (int nn = 0; nn < 2; ++nn) { const f32x4 x = acc[ai][bj][m][nn]; s += (x[0] + x[1]) + (x[2] + x[3]); }
            s += __shfl_xor(s, 16); s += __shfl_xor(s, 32);
            const float mw = s * (1.0f / 64.0f); float q = 0.f;
#pragma unroll
            for (int bj = 0; bj < 2; ++bj)
#pragma unroll
                for (int nn = 0; nn < 2; ++nn) { const f32x4 d = acc[ai][bj][m][nn] - mw; q += (d[0] * d[0] + d[1] * d[1]) + (d[2] * d[2] + d[3] * d[3]); }
            q += __shfl_xor(q, 16); q += __shfl_xor(q, 32);
            if (fq == 0) P[EPI_ROW * 4 + wc] = (f32x2){mw, q}; }
        asm volatile("s_waitcnt lgkmcnt(0)" ::: "memory"); __builtin_amdgcn_s_barrier(); asm volatile("" ::: "memory");
        EPI_LOOP { const int row = EPI_ROW; const f32x4 p01 = *(const LAS f32x4*)(P + row * 4), p23 = *(const LAS f32x4*)(P + row * 4 + 2);
            const float mean = ((p01[0] + p01[2]) + (p23[0] + p23[2])) * 0.25f;
            const float d0 = p01[0] - mean, d1 = p01[2] - mean, d2 = p23[0] - mean, d3 = p23[2] - mean;
            const float m2 = ((p01[1] + p01[3]) + (p23[1] + p23[3])) + 64.0f * ((d0 * d0 + d1 * d1) + (d2 * d2 + d3 * d3));
            const float rstd = rsqrtf(m2 * (1.0f / 256.0f) + GN_EPS);
            const size_t off = ((size_t)b * SEQ + n * 256 + row) * 2048 + h * 256 + cb;
#pragma unroll
            for (int bj = 0; bj < 2; ++bj) { f32x4 s0, s1; unpack8(*(const u32x4*)(SG + off + bj * 128), s0, s1);
                const f32x4 g0 = *(const f32x4*)(gn + h * 256 + bj * 128 + cb), g1 = *(const f32x4*)(gn + h * 256 + bj * 128 + cb + 4);
                *(u32x4*)(OB + off + bj * 128) = pack8(s0 * ((acc[ai][bj][m][0] - mean) * rstd * g0), s1 * ((acc[ai][bj][m][1] - mean) * rstd * g1)); }
            EPI_FENCE; }
    }
};
struct EpiMixA {
    bf16_t* MIXP; const bf16_t* GA;
    __device__ __forceinline__ void operator()(Acc& acc, const Unit& u, int wr, int wc, int fr, int fq) const {
        asm volatile("" : "+v"(fr), "+v"(fq));
        const int cb = wc * 32 + fq * 8;
        EPI_LOOP { const size_t off = (size_t)(u.pm * 256 + EPI_ROW) * 2048 + u.pn * 256 + cb;
#pragma unroll
            for (int bj = 0; bj < 2; ++bj) { f32x4 g0, g1; unpack8(*(const u32x4*)(GA + off + bj * 128), g0, g1);
                *(u32x4*)(MIXP + off + bj * 128) = pack8(acc[ai][bj][m][0] * g0, acc[ai][bj][m][1] * g1); }
            EPI_FENCE; }
    }
};
struct EpiMixB {
    bf16_t* MIXIN; const bf16_t* MIXP; const bf16_t* GB;
    __device__ __forceinline__ void operator()(Acc& acc, const Unit& u, int wr, int wc, int fr, int fq) const {
        asm volatile("" : "+v"(fr), "+v"(fq));
        const int cb = wc * 32 + fq * 8;
        EPI_LOOP { const size_t off = (size_t)(u.pm * 256 + EPI_ROW) * 2048 + u.pn * 256 + cb;
#pragma unroll
            for (int bj = 0; bj < 2; ++bj) { f32x4 g0, g1, p0, p1; unpack8(*(const u32x4*)(GB + off + bj * 128), g0, g1); unpack8(*(const u32x4*)(MIXP + off + bj * 128), p0, p1);
                const f32x4 y0 = acc[ai][bj][m][0] * g0 + p0, y1 = acc[ai][bj][m][1] * g1 + p1;
                u32x2 w8; w8.x = pk4_fp8(y0[0], y0[1], y0[2], y0[3], M8_SCALE); w8.y = pk4_fp8(y1[0], y1[1], y1[2], y1[3], M8_SCALE); *(u32x2*)((unsigned char*)MIXIN + off + bj * 128) = w8; }
            EPI_FENCE; }
    }
};
struct EpiF32 {
    bf16_t* C;
    __device__ __forceinline__ void operator()(Acc& acc, const Unit& u, int wr, int wc, int fr, int fq) const {
        asm volatile("" : "+v"(fr), "+v"(fq));
        const int cb = wc * 32 + fq * 8;
        EPI_LOOP { bf16_t* base = C + (size_t)(u.pm * 256 + EPI_ROW) * 2048 + u.pn * 256 + cb;
#pragma unroll
            for (int bj = 0; bj < 2; ++bj) *(u32x4*)(base + bj * 128) = pack8(acc[ai][bj][m][0] * MX_UNSCALE, acc[ai][bj][m][1] * MX_UNSCALE); }
    }
};
struct EpiGU {
    bf16_t* ACT; const float* bgu; int skip;
    __device__ __forceinline__ void operator()(Acc& acc, const Unit& u, int wr, int wc, int fr, int fq) const {
        asm volatile("" : "+v"(fr), "+v"(fq));
        if (skip) return;
        const int cb = wc * 32 + fq * 8, col = u.pn * 128 + cb; const float* bg = bgu + (size_t)u.aux * 4096 + col;
        const f32x4 bg0 = *(const f32x4*)bg, bg1 = *(const f32x4*)(bg + 4), bu0 = *(const f32x4*)(bg + 2048), bu1 = *(const f32x4*)(bg + 2052);
        EPI_LOOP { f32x4 v[2];
#pragma unroll
            for (int n = 0; n < 2; ++n)
#pragma unroll
                for (int j = 0; j < 4; ++j) { const float gt = fminf(acc[ai][0][m][n][j] * GU_UNSCALE + (n ? bg1[j] : bg0[j]), 7.0f); const float up = fminf(fmaxf(acc[ai][1][m][n][j] * GU_UNSCALE + (n ? bu1[j] : bu0[j]), -7.0f), 7.0f);
                    v[n][j] = (up + 1.0f) * gt * sigmoidf_(1.702f * gt); }
            u32x2 w8; w8.x = pk4_fp8(v[0][0], v[0][1], v[0][2], v[0][3], A8_SCALE); w8.y = pk4_fp8(v[1][0], v[1][1], v[1][2], v[1][3], A8_SCALE);
            *(u32x2*)((unsigned char*)ACT + (size_t)(u.pm * 256 + EPI_ROW) * 2048 + col) = w8; EPI_FENCE; }
    }
};
struct EpiDown {
    bf16_t* YS; const float* bd;
    __device__ __forceinline__ void operator()(Acc& acc, const Unit& u, int wr, int wc, int fr, int fq) const {
        asm volatile("" : "+v"(fr), "+v"(fq));
        const int cb = wc * 32 + fq * 8; const float* bp = bd + (size_t)u.aux * 2048 + u.pn * 256 + cb;
        f32x4 bv[2][2];
#pragma unroll
        for (int bj = 0; bj < 2; ++bj) { bv[bj][0] = *(const f32x4*)(bp + bj * 128); bv[bj][1] = *(const f32x4*)(bp + bj * 128 + 4); }
        EPI_LOOP { bf16_t* base = YS + (size_t)(u.pm * 256 + EPI_ROW) * 2048 + u.pn * 256 + cb;
#pragma unroll
            for (int bj = 0; bj < 2; ++bj) *(u32x4*)(base + bj * 128) = pack8(acc[ai][bj][m][0] * DN_UNSCALE + bv[bj][0], acc[ai][bj][m][1] * DN_UNSCALE + bv[bj][1]); }
    }
};

namespace att {
constexpr int NW = 8, QBLK = 32, KVBLK = 64;
constexpr float THR = 8.f;
constexpr int SHM_V = KVBLK * 128 * 2, SHM_KN = KVBLK * 128 * 2, SHM_KR = KVBLK * 64 * 2, NVB = 3, SHM_ATTN = NVB * SHM_V + 2 * SHM_KN + 2 * SHM_KR + NW * 64 * 4;
#define KSWZ(row, colB) ((row) * 256 + ((colB) ^ (((row) & 15) << 4)))
#define KSWZR(row, colB) ((row) * 128 + ((colB) ^ ((((row) >> 1) & 7) << 4)))
#define SBAR() __builtin_amdgcn_sched_barrier(0)
__device__ __forceinline__ int crow(int r, int hi) { return (r & 3) + 8 * (r >> 2) + 4 * hi; }
__device__ __forceinline__ void partialSM(f32x16& p0, f32x16& p1, float& m_reg, float& mn, float& alpha) {
    constexpr float C = 1.4426950408889634f;
    float pmax = p0[0];
#pragma unroll
    for (int r = 1; r < 16; ++r) pmax = fmaxf(pmax, p0[r]);
#pragma unroll
    for (int r = 0; r < 16; ++r) pmax = fmaxf(pmax, p1[r]);
    { auto rr = __builtin_amdgcn_permlane32_swap(__float_as_uint(pmax), __float_as_uint(pmax), false, false);
      pmax = fmaxf(__uint_as_float(rr[0]), __uint_as_float(rr[1])); }
    if (__builtin_expect(__all(pmax - m_reg <= THR), 1)) { mn = m_reg; alpha = 1.f; }
    else { mn = fmaxf(m_reg, pmax); alpha = __builtin_amdgcn_exp2f((m_reg - mn) * C); m_reg = mn; }
    const float mnC = -mn * C;
#pragma unroll
    for (int r = 0; r < 16; ++r) p0[r] = fmaf(p0[r], C, mnC);
#pragma unroll
    for (int r = 0; r < 16; ++r) p1[r] = fmaf(p1[r], C, mnC);
#pragma unroll
    for (int r = 0; r < 16; ++r) p0[r] = __builtin_amdgcn_exp2f(p0[r]);
}
__device__ __forceinline__ void finishSM(f32x16& p0, f32x16& p1, float alpha, float& l_reg, bf16x8& pa0, bf16x8& pa1, bf16x8& pa2, bf16x8& pa3) {
#pragma unroll
    for (int r = 0; r < 16; ++r) p1[r] = __builtin_amdgcn_exp2f(p1[r]);
    float ps = 0;
#pragma unroll
    for (int r = 0; r < 16; ++r) ps += p0[r];
#pragma unroll
    for (int r = 0; r < 16; ++r) ps += p1[r];
    { auto rr = __builtin_amdgcn_permlane32_swap(__float_as_uint(ps), __float_as_uint(ps), false, false);
      ps = __uint_as_float(rr[0]) + __uint_as_float(rr[1]); }
    l_reg = l_reg * alpha + ps;
#define PK4(P, BASE, OUT) do { unsigned a0 = cvt_pk_bf16(P[BASE + 0], P[BASE + 1]), a1 = cvt_pk_bf16(P[BASE + 2], P[BASE + 3]);   \
    unsigned b0 = cvt_pk_bf16(P[BASE + 4], P[BASE + 5]), b1 = cvt_pk_bf16(P[BASE + 6], P[BASE + 7]);                              \
    auto r0 = __builtin_amdgcn_permlane32_swap(a0, b0, false, false); auto r1 = __builtin_amdgcn_permlane32_swap(a1, b1, false, false); \
    u32x4 w = {r0[0], r1[0], r0[1], r1[1]}; OUT = *reinterpret_cast<bf16x8*>(&w); } while (0)
    PK4(p0, 0, pa0); PK4(p0, 8, pa1); PK4(p1, 0, pa2); PK4(p1, 8, pa3);
#undef PK4
}
__device__ __forceinline__ void qkt(f32x16& p0, f32x16& p1, const char* Kns, const char* Krs, const bf16x8* qr, int r32, int hi) {
    p0 = f32x16{}; p1 = f32x16{};
#pragma unroll
    for (int d0 = 0; d0 < 12; ++d0) { const int cb = ((d0 & 7) * 16 + hi * 8) * 2;
        const bf16x8 b0 = *reinterpret_cast<const bf16x8*>(d0 < 8 ? Kns + KSWZ(r32, cb) : Krs + KSWZR(r32, cb));
        const bf16x8 b1 = *reinterpret_cast<const bf16x8*>(d0 < 8 ? Kns + KSWZ(32 + r32, cb) : Krs + KSWZR(32 + r32, cb));
        p0 = __builtin_amdgcn_mfma_f32_32x32x16_bf16(b0, qr[d0], p0, 0, 0, 0);
        p1 = __builtin_amdgcn_mfma_f32_32x32x16_bf16(b1, qr[d0], p1, 0, 0, 0); }
}
__device__ __forceinline__ int v_st(int k, int c) { const int kk = (k & ~0xC) | ((k & 4) << 1) | ((k & 8) >> 1); return ((kk >> 3) * 4 + (c >> 5)) * 512 + ((kk & 7) * 32 + (c & 31)) * 2; }
__device__ __forceinline__ int v_rd_base(int lane) { return ((lane & 3) << 3) | (((lane >> 2) & 3) << 6) | (((lane >> 4) & 1) << 5) | (((lane >> 5) & 1) << 8); }
constexpr int v_rd_off(int d0, int ks, int half) { return d0 * 512 + ks * 4096 + half * 2048; }
template <int OFF> __device__ __forceinline__ s16x4 tr_read(int vb) {
    s16x4 r; asm volatile("ds_read_b64_tr_b16 %0, %1 offset:%2" : "=&v"(r) : "v"(vb), "i"(OFF) : "memory"); return r;
}
template <int D0> __device__ __forceinline__ void pv_one(f32x16& od, int vb, bf16x8 pa0, bf16x8 pa1, bf16x8 pa2, bf16x8 pa3) {
    const s16x4 l0 = tr_read<v_rd_off(D0, 0, 0)>(vb), h0 = tr_read<v_rd_off(D0, 0, 1)>(vb), l1 = tr_read<v_rd_off(D0, 1, 0)>(vb), h1 = tr_read<v_rd_off(D0, 1, 1)>(vb);
    const s16x4 l2 = tr_read<v_rd_off(D0, 2, 0)>(vb), h2 = tr_read<v_rd_off(D0, 2, 1)>(vb), l3 = tr_read<v_rd_off(D0, 3, 0)>(vb), h3 = tr_read<v_rd_off(D0, 3, 1)>(vb);
    asm volatile("s_waitcnt lgkmcnt(0)" ::: "memory"); SBAR();
#define PKV(L, H) (bf16x8){L[0], L[1], L[2], L[3], H[0], H[1], H[2], H[3]}
    od = __builtin_amdgcn_mfma_f32_32x32x16_bf16(pa0, PKV(l0, h0), od, 0, 0, 0);
    od = __builtin_amdgcn_mfma_f32_32x32x16_bf16(pa1, PKV(l1, h1), od, 0, 0, 0);
    od = __builtin_amdgcn_mfma_f32_32x32x16_bf16(pa2, PKV(l2, h2), od, 0, 0, 0);
    od = __builtin_amdgcn_mfma_f32_32x32x16_bf16(pa3, PKV(l3, h3), od, 0, 0, 0);
#undef PKV
}
__device__ __forceinline__ void pv_d0(f32x16* o, int vb, bf16x8 pa0, bf16x8 pa1, bf16x8 pa2, bf16x8 pa3) {
    pv_one<0>(o[0], vb, pa0, pa1, pa2, pa3); pv_one<1>(o[1], vb, pa0, pa1, pa2, pa3); pv_one<2>(o[2], vb, pa0, pa1, pa2, pa3); pv_one<3>(o[3], vb, pa0, pa1, pa2, pa3);
}
__device__ __forceinline__ void attn_unit(const bf16_t* __restrict__ Qn, const bf16_t* __restrict__ Qr, const bf16_t* __restrict__ Kn, const bf16_t* __restrict__ Kr,
                                          const bf16_t* __restrict__ Vh, bf16_t* __restrict__ Ob, int seq, char* lds) {
    const int tid = threadIdx.x, wid = __builtin_amdgcn_readfirstlane(tid >> 6), lane = tid & 63, r32 = lane & 31, hi = lane >> 5;
    char* V_lds = lds; char* Kn_lds = lds + NVB * SHM_V; char* Kr_lds = Kn_lds + 2 * SHM_KN;
    float* ws = (float*)(Kr_lds + 2 * SHM_KR) + wid * 64; float* li_l = ws; float* al_l = ws + 32;
    float m_reg = -1e30f, l_reg = 0; f32x16 o[4] = {}; bf16x8 qr[12];
    { const bf16_t* q0 = Qn + (long)(wid * QBLK + r32) * 1024 + hi * 8; const bf16_t* q1 = Qr + (long)(wid * QBLK + r32) * 512 + hi * 8;
#pragma unroll
      for (int d0 = 0; d0 < 8; ++d0) qr[d0] = *reinterpret_cast<const bf16x8*>(q0 + d0 * 16);
#pragma unroll
      for (int d0 = 0; d0 < 4; ++d0) qr[8 + d0] = *reinterpret_cast<const bf16x8*>(q1 + d0 * 16); }
    const int vb0 = (int)(uintptr_t)V_lds + v_rd_base(lane);
    unsigned offV[2], offKn[2], offKr;
#pragma unroll
    for (int t = 0; t < 2; ++t) {
        { const int sub = 2 * (2 * wid + t) + (lane >> 5), kk = (sub >> 2) * 8 + ((lane & 31) >> 2), k = (kk & ~0xC) | ((kk & 4) << 1) | ((kk & 8) >> 1), c = (sub & 3) * 32 + (lane & 3) * 8; offV[t] = (unsigned)(k * 1024 + c) * 2u; }
        { const int row = 4 * (2 * wid + t) + (lane >> 4), colB = ((lane & 15) * 16) ^ ((row & 15) << 4); offKn[t] = (unsigned)(row * 1024) * 2u + (unsigned)colB; } }
    { const int row = 8 * wid + (lane >> 3), colB = ((lane & 7) * 16) ^ (((row >> 1) & 7) << 4); offKr = (unsigned)(row * 64) * 2u + (unsigned)colB; }
#define LASP(p) ((LAS unsigned*)(unsigned)(uintptr_t)(p))
#define SLOAD(k0, b, bv) do { _Pragma("unroll") for (int t = 0; t < 2; ++t) { \
        __builtin_amdgcn_global_load_lds((const unsigned*)((const char*)Vh + (size_t)(k0) * 2048 + offV[t]), LASP(V_lds + (bv) * SHM_V + (2 * wid + t) * 1024), 16, 0, 0); \
        __builtin_amdgcn_global_load_lds((const unsigned*)((const char*)Kn + (size_t)(k0) * 2048 + offKn[t]), LASP(Kn_lds + (b) * SHM_KN + (2 * wid + t) * 1024), 16, 0, 0); } \
        __builtin_amdgcn_global_load_lds((const unsigned*)((const char*)Kr + (size_t)(k0) * 128 + offKr), LASP(Kr_lds + (b) * SHM_KR + wid * 1024), 16, 0, 0); } while (0)
#define SWAIT() asm volatile("s_waitcnt vmcnt(0)" ::: "memory")
#define RESC(a) do { if (__any((a) < 1.f)) { if (hi == 0) al_l[r32] = (a); asm volatile("s_waitcnt lgkmcnt(0)" ::: "memory"); \
    _Pragma("unroll") for (int d = 0; d < 4; ++d) _Pragma("unroll") for (int r = 0; r < 16; ++r) o[d][r] *= al_l[crow(r, hi)]; } } while (0)
    f32x16 p0, p1; float mn, al; bf16x8 pa0, pa1, pa2, pa3; const int NT = seq / KVBLK;
    SLOAD(0, 0, 0); SWAIT(); __syncthreads();
    if (wid < 4) {
        int bv = 0;
        for (int j = 0; j < NT; ++j) {
            const int buf = j & 1, bvn = bv == NVB - 1 ? 0 : bv + 1;
            if (j + 1 < NT) SLOAD((j + 1) * KVBLK, buf ^ 1, bvn);
            SBAR(); qkt(p0, p1, Kn_lds + buf * SHM_KN, Kr_lds + buf * SHM_KR, qr, r32, hi);
            partialSM(p0, p1, m_reg, mn, al);
            RESC(al);
            finishSM(p0, p1, al, l_reg, pa0, pa1, pa2, pa3); SBAR();
            pv_d0(o, vb0 + bv * SHM_V, pa0, pa1, pa2, pa3);
            SWAIT();
            __syncthreads();
            bv = bvn;
        }
    } else {
        int bv = 0, bvp = 0;
        for (int j = 0; j < NT; ++j) {
            const int buf = j & 1, bvn = bv == NVB - 1 ? 0 : bv + 1;
            if (j + 1 < NT) SLOAD((j + 1) * KVBLK, buf ^ 1, bvn);
            if (j > 0) { SBAR(); pv_d0(o, vb0 + bvp * SHM_V, pa0, pa1, pa2, pa3); SBAR(); }
            SBAR(); qkt(p0, p1, Kn_lds + buf * SHM_KN, Kr_lds + buf * SHM_KR, qr, r32, hi);
            partialSM(p0, p1, m_reg, mn, al);
            RESC(al);
            finishSM(p0, p1, al, l_reg, pa0, pa1, pa2, pa3); SBAR();
            SWAIT();
            __syncthreads();
            bvp = bv; bv = bvn;
        }
        SBAR(); pv_d0(o, vb0 + bvp * SHM_V, pa0, pa1, pa2, pa3);
    }
    if (hi == 0) li_l[r32] = l_reg; asm volatile("s_waitcnt lgkmcnt(0)" ::: "memory");
    float rli[16];
#pragma unroll
    for (int r = 0; r < 16; ++r) rli[r] = __builtin_amdgcn_rcpf(li_l[crow(r, hi)]);
    bf16_t* Ow = Ob + (long)(wid * QBLK) * 1024;
#pragma unroll
    for (int r = 0; r < 16; ++r) { const int orow = crow(r, hi);
#pragma unroll
        for (int d0 = 0; d0 < 4; ++d0) Ow[(long)orow * 1024 + d0 * 32 + r32] = (bf16_t)(cvt_pk_bf16(o[d0][r] * rli[r], 0.f) & 0xffffu); }
#undef SLOAD
#undef LASP
#undef SWAIT
#undef RESC
}
}

struct Args { const float* in[26]; float* out; unsigned char* ws; int ph_lo, ph_hi; };
enum { PH_SETUP = 0, PH_H, PH_INPROJ, PH_INPROJ_V, PH_KT, PH_CHAIN, PH_MLAQ, PH_MLAKV, PH_GA, PH_ATTN, PH_GC, PH_MIXA, PH_GN, PH_MIXB, PH_MIX, PH_ROUTER, PH_DISPATCH, PH_GU, PH_DOWN, PH_COMBINE, NPH };
enum { I_X = 0, I_C, I_POS, I_WADA, I_BADA, I_GPREM, I_GPOSTM, I_GPREF, I_GPOSTF, I_WIN, I_QAN, I_WQB, I_KVAN, I_WKVB, I_WMLAO, I_DECF, I_DECB, I_RETGN, I_WRETO, I_WOUT, I_WROUTER, I_BROUTER, I_WGU, I_BGU, I_WDOWN, I_BDOWN };

__device__ __forceinline__ int src_in(int r) {
    if (r < 1024) return r;
    if (r < 1088) { const int j = r - 1024; return 1024 + (j >> 1) + 32 * (j & 1); }
    if (r < 1280) return -1;
    if (r < N_IN_NAT) { const int g = (r - 1280) >> 11, off = (r - 1280) & 2047; const int base = g == 0 ? 1088 : (g == 1 ? 3136 : (g == 2 ? 7232 : (g == 3 ? 9280 : 11328))); return base + off; }
    return 5184 + (r - N_IN_NAT);
}
__device__ __forceinline__ int src_qb(int r) { if (r < 1024) return (r >> 7) * 192 + (r & 127); const int j = r - 1024, h = j >> 6, jj = j & 63; return h * 192 + 128 + (jj >> 1) + 32 * (jj & 1); }
__device__ __forceinline__ int src_kvb(int r) { if (r < 1024) return (r >> 7) * 256 + (r & 127); const int j = r - 1024; return (j >> 7) * 256 + 128 + (j & 127); }
__device__ __forceinline__ int src_gu(int r) { const int t = r >> 8, rr = r & 255; return rr < 128 ? 128 * t + rr : 2048 + 128 * t + rr - 128; }

__device__ __forceinline__ void cvt_item(const float* __restrict__ W, int ldw, int K, bf16_t* __restrict__ WT, const float* __restrict__ kscale, int sc, int k0, int r0, LAS float* scr, int lane) {
    float v[64];
    const float* wp = W + (size_t)k0 * ldw + (sc >= 0 ? sc : 0);
#pragma unroll
    for (int i = 0; i < 64; ++i) v[i] = wp[(size_t)i * ldw];
    if (sc < 0) {
#pragma unroll
        for (int i = 0; i < 64; ++i) v[i] = 0.f;
    }
    if (kscale) {
#pragma unroll
        for (int i = 0; i < 64; ++i) v[i] *= kscale[k0 + i];
    }
#pragma unroll
    for (int i = 0; i < 64; ++i) scr[i * 65 + lane] = v[i];
    asm volatile("s_waitcnt lgkmcnt(0)" ::: "memory");
    const int c = lane & 7;
#pragma unroll
    for (int j = 0; j < 8; ++j) { const int n = (lane >> 3) + 8 * j; const LAS float* s = scr + (8 * c) * 65 + n;
        u32x4 o; o.x = cvt_pk_bf16(s[0 * 65], s[1 * 65]); o.y = cvt_pk_bf16(s[2 * 65], s[3 * 65]); o.z = cvt_pk_bf16(s[4 * 65], s[5 * 65]); o.w = cvt_pk_bf16(s[6 * 65], s[7 * 65]);
        *(u32x4*)(WT + (size_t)(r0 + n) * K + k0 + 8 * c) = o; }
    asm volatile("s_waitcnt lgkmcnt(0)" ::: "memory");
}

constexpr int XT_NT_GU = 32 * 16 * 16, XT_NT_ALL = XT_NT_GU + 32 * 16 * 8;
__device__ __forceinline__ void xt_convert_tiles(int q0, const int qs, const int qe, const float* __restrict__ wgu, const float* __restrict__ wdn, bf16_t* WT_GU, bf16_t* WT_DOWN, LAS unsigned char* lds, const int lane, const int wave) {
    constexpr int NT_GU = XT_NT_GU, TS = 144;
    f32x4 va[16], vb[16], vc[16];
#define XT_SRC(q_, kk_) ((q_) < NT_GU ? wgu + ((size_t)((q_) >> 8) * 2048 + (((q_) >> 4) & 15) * 128 + 16 * wave + (kk_)) * 4096 + (lane < 32 ? 128 * ((q_) & 15) + 4 * lane : 2048 + 128 * ((q_) & 15) + 4 * lane - 128) \
                                  : wdn + ((size_t)(((q_) - NT_GU) >> 7) * 2048 + ((((q_) - NT_GU) >> 3) & 15) * 128 + 16 * wave + (kk_)) * 2048 + 256 * (((q_) - NT_GU) & 7) + 4 * lane)
#define XT_LOAD(v_, q_) do { const float* _p = XT_SRC(q_, 0); const size_t _ld = (q_) < NT_GU ? 4096 : 2048; _Pragma("unroll") for (int kk = 0; kk < 16; ++kk) v_[kk] = __builtin_nontemporal_load((const f32x4*)(_p + kk * _ld)); } while (0)
#define XT_PROC(v_, q_, buf_) do { LAS unsigned char* _T = lds + (buf_) * (256 * TS); \
        _Pragma("unroll") for (int i = 0; i < 4; ++i) { u32x4 w0; \
            w0.x = pk4_fp8(v_[0][i], v_[1][i], v_[2][i], v_[3][i], W8_SCALE); w0.y = pk4_fp8(v_[4][i], v_[5][i], v_[6][i], v_[7][i], W8_SCALE); \
            w0.z = pk4_fp8(v_[8][i], v_[9][i], v_[10][i], v_[11][i], W8_SCALE); w0.w = pk4_fp8(v_[12][i], v_[13][i], v_[14][i], v_[15][i], W8_SCALE); \
            *(LAS u32x4*)(_T + (4 * lane + i) * TS + 16 * wave) = w0; } \
        __syncthreads(); \
        unsigned char* _d = (q_) < NT_GU ? (unsigned char*)WT_GU + ((size_t)((q_) >> 8) * 4096 + 256 * ((q_) & 15)) * 2048 + (((q_) >> 4) & 15) * 128 \
                 : (unsigned char*)WT_DOWN + ((size_t)(((q_) - NT_GU) >> 7) * 2048 + 256 * (((q_) - NT_GU) & 7)) * 2048 + ((((q_) - NT_GU) >> 3) & 15) * 128; \
        _Pragma("unroll") for (int j = 0; j < 4; ++j) { const int row = 32 * wave + 8 * j + (lane >> 3); \
            const u32x4 o = *(const LAS u32x4*)(_T + row * TS + (lane & 7) * 16); __builtin_nontemporal_store(o, (u32x4*)(_d + (size_t)row * 2048 + (lane & 7) * 16)); } } while (0)
    int q = q0;
    if (q < qe) XT_LOAD(va, q);
    if (q + qs < qe) XT_LOAD(vb, q + qs);
    while (q < qe) {
        const int q1 = q + qs, q2 = q1 + qs, q3 = q2 + qs, q4 = q3 + qs;
        if (q2 < qe) XT_LOAD(vc, q2);
        XT_PROC(va, q, 0);
        if (q1 >= qe) break;
        if (q3 < qe) XT_LOAD(va, q3);
        XT_PROC(vb, q1, 1);
        if (q2 >= qe) break;
        if (q4 < qe) XT_LOAD(vb, q4);
        XT_PROC(vc, q2, 2);
        q = q3;
    }
    __syncthreads();
#undef XT_SRC
#undef XT_LOAD
#undef XT_PROC
}
__host__ __device__ constexpr bool is_seam(int k) { return k == PH_SETUP || k == PH_H || k == PH_INPROJ_V || k == PH_KT || k == PH_GA || k == PH_ATTN || k == PH_MIXA || k == PH_MIXB || k == PH_MIX || k == PH_ROUTER || k == PH_DISPATCH || k == PH_GU || k == PH_DOWN; }
__host__ __device__ constexpr int seam_after(int ph) { int k = ph; while (k < NPH && !is_seam(k)) ++k; return k; }
__host__ __device__ constexpr int seam_before(int ph) { int k = ph - 1; while (k >= 0 && !is_seam(k)) --k; return k; }
__device__ __forceinline__ const void* larg(volatile LAS unsigned long long* L, int i) {
    const unsigned long long v = L[i]; const unsigned l0 = __builtin_amdgcn_readfirstlane((unsigned)v), h0 = __builtin_amdgcn_readfirstlane((unsigned)(v >> 32));
    return (const void*)(const __attribute__((address_space(1))) void*)(((unsigned long long)h0 << 32) | l0);
}
__global__ void __launch_bounds__(512, 2) fwd_kernel(Args args) {
    extern __shared__ __attribute__((aligned(16))) unsigned char lds_raw[];
    LAS unsigned char* lds = (LAS unsigned char*)lds_raw;
    volatile LAS unsigned* MISC = (volatile LAS unsigned*)(lds + MISC_OFF);
    const int tid = threadIdx.x;
    const int G = gridDim.x, bx = blockIdx.x, NGW = G * 8;
    volatile LAS unsigned long long* LARG = (volatile LAS unsigned long long*)(lds + LARG_OFF);
    const int lo = args.ph_lo, hi = args.ph_hi;
    for (int u = tid; u < (LDS_BYTES - CTRL_OFF) / 4; u += 512) ((LAS unsigned*)(lds + CTRL_OFF))[u] = 0u;
    __syncthreads();
    if (tid == 0) {
#pragma unroll
        for (int i = 0; i < 26; ++i) LARG[i] = (unsigned long long)args.in[i];
        LARG[26] = (unsigned long long)args.out; LARG[27] = (unsigned long long)args.ws;
    }
    __syncthreads();
    unsigned bar_x = 0u;
    if (hi - lo > 1) bar_x = xcd_barrier_post((unsigned*)(args.ws + WS_CTL) + CW_BAR, MISC + 8).x;
#ifdef PH_ONLY
#define IN(k) ((k) == PH_ONLY && lo <= (k) && (k) < hi)
#else
#define IN(k) (lo <= (k) && (k) < hi)
#endif
#define SEAM(k) do { if (lo <= (k) && (k) + 1 < hi) { XcdBarrier _b; _b.bar = (unsigned*)((unsigned char*)larg(LARG, 27) + WS_CTL) + CW_BAR; _b.x = bar_x; _b.st = MISC + 8; xcd_barrier(_b); } if (STAMP_PHASE >= 0) { const unsigned long long _t = __builtin_amdgcn_s_memrealtime(); if (seam_after(STAMP_PHASE) == (k)) st_dt = _t - st_t0; if (seam_before(STAMP_PHASE) == (k)) st_t0 = _t; } } while (0)
#define INP(i) ((const float*)larg(LARG, (i)))
#ifndef REP_PHASE
#define REP_PHASE (-1)
#endif
#define NREP(k) ((k) == REP_PHASE ? 2 : 1)
#ifndef STAMP_PHASE
#define STAMP_PHASE (-1)
#endif
#ifndef STAMP_MUL
#define STAMP_MUL 4
#endif
    unsigned long long st_t0 = (STAMP_PHASE >= 0 && seam_before(STAMP_PHASE) < 0) ? __builtin_amdgcn_s_memrealtime() : 0ull, st_dt = 0ull;
#define PTRS \
    int tid = threadIdx.x; asm volatile("" : "+v"(tid)); const int lane = tid & 63, wave = __builtin_amdgcn_readfirstlane(tid >> 6), gw = bx * 8 + wave; (void)lane; (void)gw; \
    unsigned char* const ws = (unsigned char*)larg(LARG, 27); unsigned* const ctl = (unsigned*)(ws + WS_CTL); float* const outp = (float*)larg(LARG, 26); \
    float* const ada = (float*)(ctl + CW_ADA); float* const SSQP = (float*)(ws + WS_SSQP); \
    bf16_t* const WT_IN = (bf16_t*)(ws + WS_WT_IN); bf16_t* const WT_QB = (bf16_t*)(ws + WS_WT_QB); bf16_t* const WT_KVB = (bf16_t*)(ws + WS_WT_KVB); bf16_t* const WT_MLAO = (bf16_t*)(ws + WS_WT_MLAO); \
    bf16_t* const WT_RETO = (bf16_t*)(ws + WS_WT_RETO); bf16_t* const WT_OUT = (bf16_t*)(ws + WS_WT_OUT); bf16_t* const WT_GU = (bf16_t*)(ws + WS_WT_GU); bf16_t* const WT_DOWN = (bf16_t*)(ws + WS_WT_DOWN); \
    float* const CS_RET = (float*)(ws + WS_CS_RET); float* const CS_MLA = (float*)(ws + WS_CS_MLA); \
    bf16_t* const Hb = (bf16_t*)(ws + WS_H); bf16_t* const QL = (bf16_t*)(ws + WS_QL); bf16_t* const CKV = (bf16_t*)(ws + WS_CKV); bf16_t* const KR = (bf16_t*)(ws + WS_KR); \
    bf16_t* const ACAT = (bf16_t*)(ws + WS_ACAT); bf16_t* const BCAT = (bf16_t*)(ws + WS_BCAT); bf16_t* const KROT = (bf16_t*)(ws + WS_KROT); bf16_t* const KZTF = (bf16_t*)(ws + WS_KZTF); bf16_t* const KZTB = (bf16_t*)(ws + WS_KZTB); \
    bf16_t* const SG = (bf16_t*)(ws + WS_SG); bf16_t* const GA = (bf16_t*)(ws + WS_GA); bf16_t* const GB = (bf16_t*)(ws + WS_GB); \
    bf16_t* const QN = (bf16_t*)(ws + WS_QN); bf16_t* const QR = (bf16_t*)(ws + WS_QR); bf16_t* const KN = (bf16_t*)(ws + WS_KN); bf16_t* const VV = (bf16_t*)(ws + WS_VV); bf16_t* const OA = (bf16_t*)(ws + WS_OA); \
    float* const ORET = (float*)(ws + WS_ORET); bf16_t* const OB = (bf16_t*)(ws + WS_OB); bf16_t* const MIXP = (bf16_t*)(ws + WS_MIXP); bf16_t* const MIXIN = (bf16_t*)(ws + WS_MIXIN); float* const MIX = (float*)(ws + WS_MIX); \
    bf16_t* const H2 = (bf16_t*)(ws + WS_H2); int* const TOPI = (int*)(ws + WS_TOPI); float* const TOPW = (float*)(ws + WS_TOPW); int* const DEST = (int*)(ws + WS_DEST); int* const TILE = (int*)(ws + WS_TILE); float* const DECTAB = (float*)(ws + WS_DECTAB); \
    bf16_t* const XS = (bf16_t*)(ws + WS_XS); bf16_t* const ACT = (bf16_t*)(ws + WS_ACT); bf16_t* const YS = (bf16_t*)(ws + WS_YS); \
    (void)ctl; (void)outp; (void)ada; (void)SSQP; (void)WT_IN; (void)WT_QB; (void)WT_KVB; (void)WT_MLAO; (void)WT_RETO; (void)WT_OUT; (void)WT_GU; (void)WT_DOWN; (void)CS_RET; (void)CS_MLA; (void)Hb; (void)QL; (void)CKV; (void)KR; \
    (void)ACAT; (void)BCAT; (void)KROT; (void)KZTF; (void)KZTB; (void)SG; (void)GA; (void)GB; (void)QN; (void)QR; (void)KN; (void)VV; (void)OA; (void)ORET; (void)OB; (void)MIXP; (void)MIXIN; (void)MIX; (void)H2; (void)TOPI; (void)TOPW; (void)DEST; (void)TILE; (void)DECTAB; (void)XS; (void)ACT; (void)YS;

    if (IN(PH_SETUP)) for (int rep = 0; rep < NREP(PH_SETUP); ++rep) {
        PTRS
        if (bx == 0 && tid < 16) DECTAB[tid] = log2_sigmoid(tid < 8 ? INP(I_DECF)[tid] : INP(I_DECB)[tid - 8]);
#ifndef SETUP_REP_ADA
#define SETUP_REP_ADA 1
#define SETUP_REP_TAB 1
#define SETUP_REP_CPY 1
#endif
        for (int r2 = 0; r2 < SETUP_REP_ADA; ++r2) {
            const float* wada = INP(I_WADA); const float* cvec = INP(I_C); float* adap = (float*)(ws + WS_ADAP);
            for (int it = gw; it < 192 * 8; it += NGW) {
                const int jb = it % 192, kp = it / 192, j = jb * 64 + lane;
                float a0 = 0.f, a1 = 0.f, a2 = 0.f, a3 = 0.f;
#pragma nounroll
                for (int k0 = kp * 256; k0 < kp * 256 + 256; k0 += 32) {
                    float w[32]; const float* wp = wada + (size_t)k0 * 12288 + j;
#pragma unroll
                    for (int i = 0; i < 32; ++i) { w[i] = __builtin_nontemporal_load(wp); wp += 12288; asm volatile("" : "+v"(wp)); }
#pragma unroll
                    for (int i = 0; i < 32; ++i) { a0 += w[i] * cvec[k0 + i]; a1 += w[i] * cvec[2048 + k0 + i]; a2 += w[i] * cvec[4096 + k0 + i]; a3 += w[i] * cvec[6144 + k0 + i]; }
                }
                float* o = adap + (size_t)kp * 49152 + j;
                o[0] = a0; o[12288] = a1; o[24576] = a2; o[36864] = a3;
            }
        }
        for (int r2 = 0; r2 < SETUP_REP_TAB; ++r2) {
            const int* pos = (const int*)INP(I_POS);
            for (int i = bx * 512 + tid; i < T * 160; i += G * 512) {
                const int tok = i / 160, f = i % 160; const float p = (float)pos[tok];
                float inv; float* dst;
                if (f < 128) { inv = 1.0f / powf(10000.0f, (float)f / 128.0f); dst = CS_RET + (size_t)tok * 256 + f * 2; }
                else { inv = 1.0f / powf(10000.0f, (float)(f - 128) / 32.0f); dst = CS_MLA + (size_t)tok * 64 + (f - 128) * 2; }
                float s, c; sincosf(p * inv, &s, &c); dst[0] = c; dst[1] = s;
            }
        }
        for (int r2 = 0; r2 < SETUP_REP_CPY; ++r2) {
            LAS float* scr = (LAS float*)(lds + wave * 16640);
            constexpr int I_IN = (N_IN_ALL / 64) * 32, I_QB = 24 * 8, I_KVB = 32 * 8, I_MLAO = 32 * 16, I_SQ = 32 * 32;
            constexpr int NITEMS = I_IN + I_QB + I_KVB + I_MLAO + 2 * I_SQ;
            unsigned* cq = ctl + CW_CVTQ + rep + 2 * r2;
#define CVT_GRAB(dst) do { unsigned _v = 0u; if (lane == 0) _v = atomicAdd(cq, 8u); dst = (int)__builtin_amdgcn_readfirstlane(_v); } while (0)
#define CVT_DEC(r_, wp_, dst_, ks_, ldw_, K_, sc_) do { int r = (r_); const float* W_; bf16_t* WT_; const float* kq_ = nullptr; int nkb_, mat_; \
                if (r < I_IN) { W_ = INP(I_WIN); WT_ = WT_IN; ldw_ = 13376; K_ = 2048; nkb_ = 32; mat_ = 2; } \
                else if ((r -= I_IN) < I_QB) { W_ = INP(I_WQB); WT_ = WT_QB; kq_ = INP(I_QAN); ldw_ = 1536; K_ = 512; nkb_ = 8; mat_ = 3; } \
                else if ((r -= I_QB) < I_KVB) { W_ = INP(I_WKVB); WT_ = WT_KVB; kq_ = INP(I_KVAN); ldw_ = 2048; K_ = 512; nkb_ = 8; mat_ = 4; } \
                else if ((r -= I_KVB) < I_MLAO) { W_ = INP(I_WMLAO); WT_ = WT_MLAO; ldw_ = 2048; K_ = 1024; nkb_ = 16; mat_ = 1; } \
                else if ((r -= I_MLAO) < I_SQ) { W_ = INP(I_WRETO); WT_ = WT_RETO; ldw_ = 2048; K_ = 2048; nkb_ = 32; mat_ = 1; } \
                else { r -= I_SQ; W_ = INP(I_WOUT); WT_ = WT_OUT; ldw_ = 2048; K_ = 2048; nkb_ = 32; mat_ = 5; } \
                const int q4_ = r >> 2, kb_ = q4_ % nkb_, nb_ = (q4_ / nkb_) * 4 + (r & 3), rr_ = nb_ * 64 + lane; \
                sc_ = ((mat_ == 1 || mat_ == 5) ? rr_ : (mat_ == 2 ? src_in(rr_) : (mat_ == 3 ? src_qb(rr_) : src_kvb(rr_)))); \
                wp_ = W_ + (size_t)(kb_ * 64) * ldw_ + (sc_ >= 0 ? sc_ : 0); dst_ = WT_ + (size_t)(nb_ * 64) * K_ + kb_ * 64; ks_ = kq_ ? kq_ + kb_ * 64 : nullptr; \
                if (mat_ == 5) { K_ = -1; dst_ = (bf16_t*)((unsigned char*)WT_ + (size_t)(nb_ * 64) * 2048 + kb_ * 64); }   \
                if (mat_ == 2 && nb_ >= 84 && nb_ < 180) { K_ = -1; dst_ = (bf16_t*)(ws + WS_WT8IN + (size_t)((nb_ - 84) * 64) * 2048 + kb_ * 64); } } while (0)
            float v[64];
            const float* wpc; bf16_t* dstc; const float* ksc; int ldwc, Kc, scc;
            const float* wpn = nullptr; bf16_t* dstn = nullptr; const float* ksn = nullptr; int ldwn = 0, Kn = 0, scn = 0;
            constexpr int QCH = 8; static_assert(NITEMS % QCH == 0, "queue chunk");
            int itc, itn, cend; CVT_GRAB(itc); itn = itc + 1; cend = itc + QCH;
            bool hc = itc < NITEMS;
            if (hc) { CVT_DEC(itc, wpc, dstc, ksc, ldwc, Kc, scc);
#pragma unroll
                for (int i = 0; i < 64; ++i) v[i] = __builtin_nontemporal_load(wpc + (size_t)i * ldwc); }
            while (hc) {
                const bool hn = itn < NITEMS;
                if (hn) CVT_DEC(itn, wpn, dstn, ksn, ldwn, Kn, scn);
                const bool need = (itn + 1 >= cend); unsigned raw_nn = 0u; if (need && lane == 0) raw_nn = atomicAdd(cq, (unsigned)QCH);
#pragma unroll
                for (int g = 0; g < 4; ++g) {
#pragma unroll
                    for (int i = 0; i < 16; ++i) { float x = scc >= 0 ? v[16 * g + i] : 0.f; if (ksc) x *= ksc[16 * g + i]; scr[(16 * g + i) * 65 + lane] = x; }
                    if (hn) {
#pragma unroll
                        for (int i = 0; i < 16; ++i) v[16 * g + i] = __builtin_nontemporal_load(wpn + (size_t)(16 * g + i) * ldwn); }
                }
                asm volatile("s_waitcnt lgkmcnt(0)" ::: "memory");
                const int c = lane & 7;
#pragma unroll
                for (int j = 0; j < 8; ++j) { const int n = (lane >> 3) + 8 * j; const LAS float* sp = scr + (8 * c) * 65 + n;
                    if (Kc < 0) { u32x2 o8; o8.x = pk4_fp8(sp[0 * 65], sp[1 * 65], sp[2 * 65], sp[3 * 65], W8_SCALE); o8.y = pk4_fp8(sp[4 * 65], sp[5 * 65], sp[6 * 65], sp[7 * 65], W8_SCALE);
                        *(u32x2*)((unsigned char*)dstc + (size_t)n * 2048 + 8 * c) = o8; }
                    else { u32x4 o; o.x = cvt_pk_bf16(sp[0 * 65], sp[1 * 65]); o.y = cvt_pk_bf16(sp[2 * 65], sp[3 * 65]); o.z = cvt_pk_bf16(sp[4 * 65], sp[5 * 65]); o.w = cvt_pk_bf16(sp[6 * 65], sp[7 * 65]);
                        __builtin_nontemporal_store(o, (u32x4*)(dstc + (size_t)n * Kc + 8 * c)); } }
                asm volatile("s_waitcnt lgkmcnt(0)" ::: "memory");
                wpc = wpn; dstc = dstn; ksc = ksn; ldwc = ldwn; Kc = Kn; scc = scn; hc = hn;
                if (need) { itn = (int)__builtin_amdgcn_readfirstlane(raw_nn); cend = itn + QCH; } else itn = itn + 1;
            }
#undef CVT_GRAB
#undef CVT_DEC
        }
    }
    SEAM(PH_SETUP);
    if (IN(PH_H)) for (int rep = 0; rep < NREP(PH_H); ++rep) {
        PTRS
        const float* g = INP(I_GPREM);
        {
            const float* adap = (const float*)(ws + WS_ADAP); const float* bada = INP(I_BADA); LAS float* AD = (LAS float*)lds;
            if (tid < 192) { const int idx = bx * 192 + tid; if (idx < 49152) { const int j = idx % 12288; float a = 0.f;
#pragma unroll
                for (int pq = 0; pq < 8; ++pq) a += adap[(size_t)pq * 49152 + idx];
                ada[idx] = a + bada[j]; } }
            for (int i = tid; i < 16384; i += 512) { const int b = i >> 12, col = i & 4095; float a = 0.f;
#pragma unroll
                for (int pq = 0; pq < 8; ++pq) a += adap[(size_t)pq * 49152 + b * 12288 + col];
                AD[i] = a + bada[col]; }
            __syncthreads();
        }
        const LAS float* AD = (const LAS float*)lds;
        f32x4 vn[8];
        if (gw < T) { const f32x4* xr = (const f32x4*)(INP(I_X) + (size_t)gw * D) + lane;
#pragma unroll
            for (int j = 0; j < 8; ++j) vn[j] = xr[64 * j]; }
        for (int mrow = gw; mrow < T; mrow += NGW) {
            const int b = mrow / SEQ;
            f32x4 v[8]; float s = 0.f;
#pragma unroll
            for (int j = 0; j < 8; ++j) { v[j] = vn[j]; s += (v[j][0] * v[j][0] + v[j][1] * v[j][1]) + (v[j][2] * v[j][2] + v[j][3] * v[j][3]); }
            if (mrow + NGW < T) { const f32x4* xr = (const f32x4*)(INP(I_X) + (size_t)(mrow + NGW) * D) + lane;
#pragma unroll
                for (int j = 0; j < 8; ++j) vn[j] = xr[64 * j]; }
            const float r = rsqrtf(wave_sum(s) * (1.0f / D) + RMS_EPS);
            u32x2* o8 = (u32x2*)(Hb + (size_t)mrow * D) + lane; unsigned* q8 = (unsigned*)(ws + WS_H8 + (size_t)mrow * D) + lane;
#pragma unroll
            for (int j = 0; j < 8; ++j) { const int col = 256 * j + 4 * lane; const f32x4 gg = *(const f32x4*)(g + col), sh = *(const LAS f32x4*)(AD + b * 4096 + col), sc = *(const LAS f32x4*)(AD + b * 4096 + 2048 + col);
                const f32x4 y = v[j] * r * gg * (sc + 1.0f) + sh; u32x2 w; w.x = cvt_pk_bf16(y[0], y[1]); w.y = cvt_pk_bf16(y[2], y[3]); o8[64 * j] = w; q8[64 * j] = pk4_fp8(y[0], y[1], y[2], y[3], H8_SCALE); }
        }
    }
    SEAM(PH_H);
    if (IN(PH_INPROJ)) for (int rep = 0; rep < NREP(PH_INPROJ); ++rep) {
        PTRS
        {   pg8::InprojSched S{(const char*)Hb, (const char*)WT_IN, G, bx};
            EpiInprojAll E{EpiInproj{QL, CKV, KR, ACAT, KROT, SG, GA, GB, SSQP, CS_RET, CS_MLA, DECTAB, 0, 1.0f}, EpiVT{BCAT, ws + WS_VT8}};
            pg8::gemm_phase(lds, 2048, 2048, 2048, S, E); }
        {
            pg8::GridSched S{(const char*)(ws + WS_H8), (const char*)(ws + WS_WT8IN), (size_t)256 * 2048, (size_t)256 * 2048, T / 256, 24, G, bx};
            EpiInproj E{QL, CKV, KR, ACAT, KROT, SG, GA, GB, SSQP, CS_RET, CS_MLA, DECTAB, 21, GU_UNSCALE};
            pg8::gemm_phase<EpiInproj, pg8::GridSched, true>(lds, 2048, 2048, 2048, S, E); }
    }
    SEAM(PH_INPROJ_V);
    if (IN(PH_KT)) for (int rep = 0; rep < NREP(PH_KT); ++rep) {
        PTRS
        {
            constexpr int TP = 528;
            u32x4 ra[16], rb[16];
#define KT_LOAD(r_, blk_) do { const bf16_t* _s = KROT + ((size_t)(blk_) * 256 + 32 * wave + 16 * (lane >> 5)) * 256 + 8 * (lane & 31); _Pragma("unroll") for (int i = 0; i < 16; ++i) r_[i] = *(const u32x4*)(_s + i * 256); } while (0)
#define KT_PROC(r_, blk_) do { const int _h = ((blk_) >> 4) & 7; const float _lf = DECTAB[_h], _lb = DECTAB[8 + _h]; \
                _Pragma("unroll") for (int e = 0; e < 8; ++e) { u32x4 w0, w1; \
                    _Pragma("unroll") for (int i2 = 0; i2 < 4; ++i2) { const unsigned a0 = r_[2 * i2][e >> 1], a1 = r_[2 * i2 + 1][e >> 1], c0 = r_[8 + 2 * i2][e >> 1], c1 = r_[8 + 2 * i2 + 1][e >> 1]; \
                        w0[i2] = (e & 1) ? ((a0 >> 16) | (a1 & 0xffff0000u)) : ((a0 & 0xffffu) | (a1 << 16)); w1[i2] = (e & 1) ? ((c0 >> 16) | (c1 & 0xffff0000u)) : ((c0 & 0xffffu) | (c1 << 16)); } \
                    LAS unsigned char* _t = lds + (8 * (lane & 31) + e) * TP + (32 * wave + 16 * (lane >> 5)) * 2; *(LAS u32x4*)_t = w0; *(LAS u32x4*)(_t + 16) = w1; } \
                __syncthreads(); \
                f32x4 zf0, zf1, zb0, zb1; \
                _Pragma("unroll") for (int t = 0; t < 4; ++t) { const int p0 = 8 * (lane & 31) + t, p1 = p0 + 4; \
                    zf0[t] = __builtin_amdgcn_exp2f((float)(255 - p0) * _lf); zf1[t] = __builtin_amdgcn_exp2f((float)(255 - p1) * _lf); zb0[t] = __builtin_amdgcn_exp2f((float)p0 * _lb); zb1[t] = __builtin_amdgcn_exp2f((float)p1 * _lb); } \
                _Pragma("unroll") for (int j = 0; j < 16; ++j) { const int row = 32 * wave + 2 * j + (lane >> 5); \
                    const u32x4 w = *(const LAS u32x4*)(lds + row * TP + (lane & 31) * 16); f32x4 x0, x1; unpack8(w, x0, x1); \
                    const size_t o = ((size_t)(blk_) * 256 + row) * 256 + 8 * (lane & 31); \
                    const f32x4 f0 = x0 * zf0, f1 = x1 * zf1, g0 = x0 * zb0, g1 = x1 * zb1; u32x2 wf, wb; \
                    wf.x = pk4_fp8(f0[0], f0[1], f0[2], f0[3], K8_SCALE); wf.y = pk4_fp8(f1[0], f1[1], f1[2], f1[3], K8_SCALE); wb.x = pk4_fp8(g0[0], g0[1], g0[2], g0[3], K8_SCALE); wb.y = pk4_fp8(g1[0], g1[1], g1[2], g1[3], K8_SCALE); \
                    *(u32x2*)((unsigned char*)KZTF + o) = wf; *(u32x2*)((unsigned char*)KZTB + o) = wb; } \
                __syncthreads(); } while (0)
            int blk = bx;
            if (blk < NBLK) KT_LOAD(ra, blk);
            while (blk < NBLK) {
                const int b1 = blk + G; if (b1 < NBLK) KT_LOAD(rb, b1);
                KT_PROC(ra, blk);
                if (b1 >= NBLK) break;
                const int b2 = b1 + G; if (b2 < NBLK) KT_LOAD(ra, b2);
                KT_PROC(rb, b1);
                blk = b2;
            }
#undef KT_LOAD
#undef KT_PROC
        }
    }
    SEAM(PH_KT);
    if (IN(PH_CHAIN)) for (int rep = 0; rep < NREP(PH_CHAIN); ++rep) {
        PTRS
        if (bx < 64) {
            const int bh = bx >> 1, dir = bx & 1;
            {
                const int blk0 = bh * NCH + (dir ? NCH - 1 : 0);
                bf16_t* z = BCAT + ((size_t)blk0 * 256 + (tid >> 1)) * 768 + 256 + 256 * dir + (tid & 1) * 128;
#pragma unroll
                for (int q = 0; q < 16; ++q) *(u32x4*)(z + q * 8) = (u32x4){0u, 0u, 0u, 0u};
            }
            pg8::ChainSched S{(const char*)(ws + WS_VT8), (const char*)(dir ? KZTB : KZTF), bh, dir};
            EpiGb E{BCAT, DECTAB, dir};
            pg8::gemm_phase<EpiGb, pg8::ChainSched, true, true>(lds, 256, 256, 256, S, E);
        }
    }
    if (IN(PH_MLAQ)) for (int rep = 0; rep < NREP(PH_MLAQ); ++rep) {
        PTRS
        if (bx >= 64) { const bool ca = bx < 128;
            pg8::GridSchedR S{(const char*)QL, (const char*)WT_QB, (size_t)256 * 512 * 2, (size_t)256 * 512 * 2, T / 256, 6, ca ? 64 : 128, ca ? bx - 64 : bx - 128, ca ? 0 : 128, ca ? 128 : 384};
            EpiMlaQ E{QN, QR, SSQP, CS_MLA}; pg8::gemm_phase(lds, 512, 512, 512, S, E); }
    }
    if (IN(PH_MLAKV)) for (int rep = 0; rep < NREP(PH_MLAKV); ++rep) {
        PTRS
        if (bx >= 128) {
            pg8::GridSchedR S{(const char*)CKV, (const char*)WT_KVB, (size_t)256 * 512 * 2, (size_t)256 * 512 * 2, T / 256, 8, 128, bx - 128, 0, 512};
            EpiMlaKV E{KN, VV, SSQP + (size_t)8 * T}; pg8::gemm_phase(lds, 512, 512, 512, S, E); }
    }
    if (IN(PH_GA)) for (int rep = 0; rep < NREP(PH_GA); ++rep) {
        PTRS
        if (bx >= 64) { const bool ca = bx < 128;
        {   pg8::BatchSchedR S{(const char*)(ACAT + 256), (const char*)KROT, (size_t)256 * 768 * 2, (size_t)256 * 256 * 2, ca ? 64 : 128, ca ? bx - 64 : bx - 128, ca ? 0 : 256, ca ? 256 : 512};
            EpiGa E{ACAT, DECTAB}; pg8::gemm_phase(lds, 256, 768, 256, S, E); }
        if (ca) {
            pg8::GridSchedR S{(const char*)Hb, (const char*)(WT_IN + (size_t)4 * 256 * 2048), (size_t)256 * 2048 * 2, (size_t)256 * 2048 * 2, T / 256, 1, 64, bx - 64, 0, 64};
            EpiInproj E{QL, CKV, KR, ACAT, KROT, SG, GA, GB, SSQP, CS_RET, CS_MLA, DECTAB, 4, 1.0f}; pg8::gemm_phase(lds, 2048, 2048, 2048, S, E); }
        }
    }
    SEAM(PH_GA);
    if (IN(PH_ATTN)) for (int rep = 0; rep < NREP(PH_ATTN); ++rep) {
        PTRS
        unsigned* queue = ctl + CW_QUEUE + rep; unsigned* cqueue = ctl + CW_QUEUE + 8;
        const float* wgu = INP(I_WGU); const float* wdn = INP(I_WDOWN);
#define CONV_LOOP() do { if (rep == 0) for (;;) { __syncthreads(); if (tid == 0) MISC[1] = atomicAdd(cqueue, 1u); __syncthreads(); const int c = (int)MISC[1]; if (c >= 1536) break; \
            xt_convert_tiles(c * 8, 1, c * 8 + 8, wgu, wdn, WT_GU, WT_DOWN, lds, lane, wave); } } while (0)
        if (bx < CONV_WGS) CONV_LOOP();
        int xq = (int)(xb_xcc_id() & 7u), tries = 0;
        for (;;) {
            __syncthreads();
            if (tid == 0) { int a = -1;
                while (tries < 8) { const unsigned v = atomicAdd(ctl + CW_AQ + 64 * xq + rep, 1u); if (v < 64u) { a = xq * 64 + (int)v; break; } xq = (xq + 1) & 7; ++tries; }
                MISC[0] = (unsigned)a; }
            __syncthreads();
            const int a = (int)MISC[0];
            if (a < 0) break;
            const int bh = a >> 4, qb = a & 15, b = bh >> 3, h = bh & 7;
            const size_t tok0 = (size_t)b * SEQ + qb * 256, kt0 = (size_t)b * SEQ;
            att::attn_unit(QN + tok0 * 1024 + h * 128, QR + tok0 * 512 + h * 64, KN + kt0 * 1024 + h * 128, KR + kt0 * 64, VV + kt0 * 1024 + h * 128, OA + tok0 * 1024 + h * 128, SEQ, (char*)lds_raw);
        }
        if (bx >= CONV_WGS) CONV_LOOP();
#undef CONV_LOOP
    }
    SEAM(PH_ATTN);
    if (IN(PH_GC)) for (int rep = 0; rep < NREP(PH_GC); ++rep) {
        PTRS
        {   pg8::BatchSched S{(const char*)ACAT, (const char*)BCAT, (size_t)256 * 768 * 2, (size_t)256 * 768 * 2, NBLK, G, bx};
            EpiGc E{OB, SG, INP(I_RETGN), lds}; pg8::gemm_phase(lds, 768, 768, 768, S, E); }
    }
    if (IN(PH_MIXA)) for (int rep = 0; rep < NREP(PH_MIXA); ++rep) {
        PTRS
        {   pg8::GridSched S{(const char*)OA, (const char*)WT_MLAO, (size_t)256 * 1024 * 2, (size_t)256 * 1024 * 2, T / 256, 8, G, bx};
            EpiMixA E{MIXP, GA}; pg8::gemm_phase(lds, 1024, 1024, 1024, S, E); }
    }
    SEAM(PH_MIXA);
    if (IN(PH_MIXB)) for (int rep = 0; rep < NREP(PH_MIXB); ++rep) {
        PTRS
        pg8::GridSched S{(const char*)OB, (const char*)WT_RETO, (size_t)256 * 2048 * 2, (size_t)256 * 2048 * 2, T / 256, 8, G, bx};
        EpiMixB E{MIXIN, MIXP, GB}; pg8::gemm_phase(lds, 2048, 2048, 2048, S, E);
    }
    SEAM(PH_MIXB);
    if (IN(PH_MIX)) for (int rep = 0; rep < NREP(PH_MIX); ++rep) {
        PTRS
        pg8::GridSched S{(const char*)MIXIN, (const char*)WT_OUT, (size_t)256 * 2048, (size_t)256 * 2048, T / 256, 8, G, bx};
        EpiF32 E{(bf16_t*)MIX}; pg8::gemm_phase<EpiF32, pg8::GridSched, true>(lds, 2048, 2048, 2048, S, E);
    }
    SEAM(PH_MIX);
    if (IN(PH_ROUTER)) for (int rep = 0; rep < NREP(PH_ROUTER); ++rep) {
        PTRS
        const float* gpm = INP(I_GPOSTM); const float* gpf = INP(I_GPREF); const float* wr = INP(I_WROUTER); const float* brt = INP(I_BROUTER);
        LAS float* HROW = (LAS float*)lds;
        LAS float* PART = (LAS float*)(lds + 16 * 2052 * 4);
        unsigned* counts = ctl + CW_COUNTS;
        volatile LAS unsigned* lhist = MISC + 64;
        if (tid < 32) lhist[tid] = 0u;
        __syncthreads();
        const float* wbp = wr + (size_t)(256 * wave + (lane >> 4)) * 32 + (lane & 15);
        f32x4 vA[8], vB[8], xA[8], xB[8];
#define RT_LOAD(base_) do { const int _m = (base_) + 2 * wave; const u32x2* _mr = (const u32x2*)((const bf16_t*)MIX + (size_t)_m * D) + lane; const f32x4* _xr = (const f32x4*)(INP(I_X) + (size_t)_m * D) + lane; \
            _Pragma("unroll") for (int j = 0; j < 8; ++j) { const u32x2 _a = _mr[64 * j], _b = _mr[64 * j + 512]; vA[j] = (f32x4){bf_lo(_a.x), bf_hi(_a.x), bf_lo(_a.y), bf_hi(_a.y)}; vB[j] = (f32x4){bf_lo(_b.x), bf_hi(_b.x), bf_lo(_b.y), bf_hi(_b.y)}; \
                xA[j] = _xr[64 * j]; xB[j] = _xr[64 * j + 512]; } } while (0)
        if (bx * 16 < T) RT_LOAD(bx * 16);
        for (int base = bx * 16; base < T; base += G * 16) {
            {
                const int rrA = 2 * wave, mrowA = base + rrA;
                const int b = mrowA / SEQ; const float* ad = ada + b * 12288;
                float sA = 0.f, sB = 0.f;
#pragma unroll
                for (int j = 0; j < 8; ++j) { sA += (vA[j][0] * vA[j][0] + vA[j][1] * vA[j][1]) + (vA[j][2] * vA[j][2] + vA[j][3] * vA[j][3]); sB += (vB[j][0] * vB[j][0] + vB[j][1] * vB[j][1]) + (vB[j][2] * vB[j][2] + vB[j][3] * vB[j][3]); }
#pragma unroll
                for (int o = 1; o < 64; o <<= 1) { sA += __shfl_xor(sA, o); sB += __shfl_xor(sB, o); }
                const float r1A = rsqrtf(sA * (1.0f / D) + RMS_EPS), r1B = rsqrtf(sB * (1.0f / D) + RMS_EPS); float tA = 0.f, tB = 0.f;
                u32x2* o4 = (u32x2*)((bf16_t*)(ws + WS_X1B) + (size_t)mrowA * D) + lane;
#pragma unroll
                for (int j = 0; j < 8; ++j) { const int col = 256 * j + 4 * lane; const f32x4 gg = *(const f32x4*)(gpm + col), gm = *(const f32x4*)(ad + 4096 + col);
                    vA[j] = xA[j] + gm * (vA[j] * r1A * gg); vB[j] = xB[j] + gm * (vB[j] * r1B * gg);
                    { u32x2 wa, wb; wa.x = cvt_pk_bf16(vA[j][0], vA[j][1]); wa.y = cvt_pk_bf16(vA[j][2], vA[j][3]); wb.x = cvt_pk_bf16(vB[j][0], vB[j][1]); wb.y = cvt_pk_bf16(vB[j][2], vB[j][3]); o4[64 * j] = wa; o4[64 * j + 512] = wb; }
                    tA += (vA[j][0] * vA[j][0] + vA[j][1] * vA[j][1]) + (vA[j][2] * vA[j][2] + vA[j][3] * vA[j][3]); tB += (vB[j][0] * vB[j][0] + vB[j][1] * vB[j][1]) + (vB[j][2] * vB[j][2] + vB[j][3] * vB[j][3]); asm volatile("" ::: "memory"); }
#pragma unroll
                for (int o = 1; o < 64; o <<= 1) { tA += __shfl_xor(tA, o); tB += __shfl_xor(tB, o); }
                const float r2A = rsqrtf(tA * (1.0f / D) + RMS_EPS), r2B = rsqrtf(tB * (1.0f / D) + RMS_EPS);
                unsigned* h8 = (unsigned*)((unsigned char*)H2 + (size_t)mrowA * D) + lane;
#pragma unroll
                for (int j = 0; j < 8; ++j) { const int col = 256 * j + 4 * lane; const f32x4 gg = *(const f32x4*)(gpf + col), sh = *(const f32x4*)(ad + 6144 + col), sc = *(const f32x4*)(ad + 8192 + col);
                    const f32x4 hA = vA[j] * r2A * gg * (sc + 1.0f) + sh, hB = vB[j] * r2B * gg * (sc + 1.0f) + sh;
                    h8[64 * j] = pk4_fp8(hA[0], hA[1], hA[2], hA[3], H8_SCALE); h8[64 * j + 512] = pk4_fp8(hB[0], hB[1], hB[2], hB[3], H8_SCALE);
                    *(LAS f32x4*)(HROW + rrA * 2052 + col) = hA; *(LAS f32x4*)(HROW + (rrA + 1) * 2052 + col) = hB; asm volatile("" ::: "memory"); }
                if (base + G * 16 < T) RT_LOAD(base + G * 16);
            }
            __syncthreads();
            {   f32x4 c0 = (f32x4){0.f, 0.f, 0.f, 0.f}, c1 = (f32x4){0.f, 0.f, 0.f, 0.f};
                const LAS float* ap = HROW + (lane & 15) * 2052 + 256 * wave + (lane >> 4);
#pragma unroll 16
                for (int st = 0; st < 64; ++st) { const float a = ap[4 * st]; c0 = __builtin_amdgcn_mfma_f32_16x16x4f32(a, wbp[st * 128], c0, 0, 0, 0); c1 = __builtin_amdgcn_mfma_f32_16x16x4f32(a, wbp[st * 128 + 16], c1, 0, 0, 0); }
                LAS float* pp = PART + wave * 512 + (4 * (lane >> 4)) * 32 + (lane & 15);
#pragma unroll
                for (int r = 0; r < 4; ++r) { pp[r * 32] = c0[r]; pp[r * 32 + 16] = c1[r]; }
            }
            __syncthreads();
#pragma nounroll
            for (int q = 0; q < 2; ++q) {
                const int rr = 2 * wave + q, mrow = base + rr;
                float lg = 0.f;
                if (lane < 32) {
#pragma unroll
                    for (int w2 = 0; w2 < 8; ++w2) lg += PART[w2 * 512 + rr * 32 + lane];
                    lg += brt[lane]; }
                float val = lane < 32 ? lg : -3.0e38f; float tv[4]; int ti[4];
#pragma unroll
                for (int r = 0; r < 4; ++r) { float bv = val; int bi = lane;
#pragma unroll
                    for (int o = 32; o >= 1; o >>= 1) { const float ov = __shfl_xor(bv, o); const int oi = __shfl_xor(bi, o); if (ov > bv || (ov == bv && oi < bi)) { bv = ov; bi = oi; } }
                    tv[r] = bv; ti[r] = bi; if (lane == bi) val = -3.0e38f; }
                const float e1 = __expf(tv[1] - tv[0]), e2 = __expf(tv[2] - tv[0]), e3 = __expf(tv[3] - tv[0]); const float inv = 1.0f / (1.0f + e1 + e2 + e3);
                if (lane < 4) { const int id = lane == 0 ? ti[0] : (lane == 1 ? ti[1] : (lane == 2 ? ti[2] : ti[3])); const float wv = (lane == 0 ? 1.0f : (lane == 1 ? e1 : (lane == 2 ? e2 : e3))) * inv;
                    TOPI[mrow * 4 + lane] = id; TOPW[mrow * 4 + lane] = wv; if (rep == 0) __hip_atomic_fetch_add((LAS unsigned*)(lhist + id), 1u, __ATOMIC_RELAXED, __HIP_MEMORY_SCOPE_WORKGROUP); }
            }
            __syncthreads();
        }
        if (tid < 32 && rep == 0) { const unsigned c = lhist[tid]; if (c) atomicAdd(counts + 64 * tid, c); }
    }
    SEAM(PH_ROUTER);
    if (IN(PH_DISPATCH)) for (int rep = 0; rep < NREP(PH_DISPATCH); ++rep) {
        PTRS
        unsigned* counts = ctl + CW_COUNTS; unsigned* cursor = ctl + CW_CURSOR;
        volatile LAS unsigned* lhist = MISC + 64; volatile LAS unsigned* lbase = MISC + 96;
        if (tid < 32) lhist[tid] = 0u;
        int pst = 0, pend = 0;
        { const int cnt = lane < 32 ? (int)__hip_atomic_load(counts + 64 * lane, __ATOMIC_RELAXED, __HIP_MEMORY_SCOPE_AGENT) : 0; const int pad = (cnt + 255) & ~255; int inc = pad;
#pragma unroll
          for (int o = 1; o < 32; o <<= 1) { const int t = __shfl_up(inc, o); if ((lane & 31) >= o) inc += t; }
          pend = inc; pst = inc - pad; }
        if (gw == 0) {
            const int ntiles = __shfl(pend, 31) >> 8; if (lane == 0) TILE[0] = ntiles;
            for (int t = lane; t < PMAX / 256; t += 64) { int e = 0;
                for (int q = 0; q < 32; ++q) { const int pe = __shfl(pend, q); e += (pe <= t * 256) ? 1 : 0; }
                TILE[16 + t] = e < 31 ? e : 31; }
        }
        __syncthreads();
        int eid[8], loc[8];
#pragma unroll
        for (int i = 0; i < 8; ++i) { const int mrow = gw + NGW * i; eid[i] = 0; loc[i] = 0;
            if (mrow < T && lane < 4) { eid[i] = TOPI[mrow * 4 + lane]; loc[i] = (int)__hip_atomic_fetch_add((LAS unsigned*)(lhist + eid[i]), 1u, __ATOMIC_RELAXED, __HIP_MEMORY_SCOPE_WORKGROUP); } }
        __syncthreads();
        if (tid < 32) { const unsigned c = lhist[tid]; lbase[tid] = (unsigned)pst + (c ? atomicAdd(cursor + 64 * tid, c) : 0u); }
        __syncthreads();
#pragma unroll
        for (int i = 0; i < 8; ++i) { const int mrow = gw + NGW * i;
            if (mrow < T) {
                int slot = 0;
                if (lane < 4) { slot = (int)lbase[eid[i]] + loc[i]; DEST[mrow * 4 + lane] = slot; }
                const u32x4* src = (const u32x4*)((const unsigned char*)H2 + (size_t)mrow * D) + lane; u32x4 rw[2];
#pragma unroll
                for (int q = 0; q < 2; ++q) rw[q] = src[64 * q];
#pragma unroll
                for (int k = 0; k < 4; ++k) { const int sl = __shfl(slot, k); u32x4* dst = (u32x4*)((unsigned char*)XS + (size_t)sl * D) + lane;
#pragma unroll
                    for (int q = 0; q < 2; ++q) dst[64 * q] = rw[q]; } } }
    }
    SEAM(PH_DISPATCH);
    if (IN(PH_GU)) for (int rep = 0; rep < NREP(PH_GU); ++rep) {
        PTRS
        const int ntiles = __builtin_amdgcn_readfirstlane(TILE[0]);
        pg8::MoeSched S{(const char*)XS, (const char*)WT_GU, TILE + 16, ntiles, 16, G, bx};
        EpiGU E{ACT, INP(I_BGU), rep}; pg8::gemm_phase<EpiGU, pg8::MoeSched, true>(lds, 2048, 2048, 2048, S, E);
    }
    SEAM(PH_GU);
    if (IN(PH_DOWN)) for (int rep = 0; rep < NREP(PH_DOWN); ++rep) {
        PTRS
        const int ntiles = __builtin_amdgcn_readfirstlane(TILE[0]);
        pg8::MoeSched S{(const char*)ACT, (const char*)WT_DOWN, TILE + 16, ntiles, 8, G, bx};
        EpiDown E{YS, INP(I_BDOWN)}; pg8::gemm_phase<EpiDown, pg8::MoeSched, true>(lds, 2048, 2048, 2048, S, E);
    }
    SEAM(PH_DOWN);
    if (IN(PH_COMBINE)) for (int rep = 0; rep < NREP(PH_COMBINE); ++rep) {
        PTRS
        const float* gpo = INP(I_GPOSTF);
        for (int mrow = gw; mrow < T; mrow += NGW) {
            const int b = mrow / SEQ; const float* ad = ada + b * 12288;
            int dk[4]; float wk[4];
#pragma unroll
            for (int k = 0; k < 4; ++k) { dk[k] = DEST[mrow * 4 + k]; wk[k] = TOPW[mrow * 4 + k]; }
            f32x4 f[8]; float s = 0.f;
#pragma unroll
            for (int j = 0; j < 8; ++j) f[j] = (f32x4){0.f, 0.f, 0.f, 0.f};
#pragma unroll
            for (int k = 0; k < 4; ++k) { const u32x2* yr = (const u32x2*)(YS + (size_t)dk[k] * D) + lane;
#pragma unroll
                for (int j = 0; j < 8; ++j) { const u32x2 w = yr[64 * j]; f[j] += (f32x4){bf_lo(w.x), bf_hi(w.x), bf_lo(w.y), bf_hi(w.y)} * wk[k]; } }
#pragma unroll
            for (int j = 0; j < 8; ++j) s += (f[j][0] * f[j][0] + f[j][1] * f[j][1]) + (f[j][2] * f[j][2] + f[j][3] * f[j][3]);
            const float r = rsqrtf(wave_sum(s) * (1.0f / D) + RMS_EPS);
            f32x4* o4 = (f32x4*)(outp + (size_t)mrow * D) + lane; const u32x2* x1 = (const u32x2*)((const bf16_t*)(ws + WS_X1B) + (size_t)mrow * D) + lane;
#pragma unroll
            for (int j = 0; j < 8; ++j) { const int col = 256 * j + 4 * lane; const f32x4 gg = *(const f32x4*)(gpo + col), gf = *(const f32x4*)(ad + 10240 + col); const u32x2 xw = x1[64 * j];
                o4[64 * j] = (f32x4){bf_lo(xw.x), bf_hi(xw.x), bf_lo(xw.y), bf_hi(xw.y)} + gf * (f[j] * r * gg); }
        }
    }
    if (STAMP_PHASE >= 0 && bx == 0) {
        if (seam_after(STAMP_PHASE) >= NPH) st_dt = __builtin_amdgcn_s_memrealtime() - st_t0;
        const unsigned long long t1 = __builtin_amdgcn_s_memrealtime();
        while (__builtin_amdgcn_s_memrealtime() - t1 < st_dt * STAMP_MUL) __builtin_amdgcn_s_sleep(8);
    }
#undef IN
#undef SEAM
}

extern "C" void kernel_launch(void* const* d_in, const int* in_sizes, int n_in, void* d_out, int out_size, void* d_ws, size_t ws_size, hipStream_t stream) {
    static int grid = 0;
    if (grid == 0) {
        if (n_in != 26 || out_size != T * D || ws_size < WS_END) { fprintf(stderr, "kernel_launch: unexpected shapes: n_in %d out %d ws %zu (need %zu)\n", n_in, out_size, ws_size, (size_t)WS_END); grid = -1; return; }
        int dev = 0, cus = 0, per_cu = 0;
        if (hipGetDevice(&dev) != hipSuccess || hipDeviceGetAttribute(&cus, hipDeviceAttributeMultiprocessorCount, dev) != hipSuccess) { grid = -1; return; }
        if (hipFuncSetAttribute((const void*)fwd_kernel, hipFuncAttributeMaxDynamicSharedMemorySize, LDS_BYTES) != hipSuccess) { fprintf(stderr, "kernel_launch: hipFuncSetAttribute failed\n"); grid = -1; return; }
        if (hipOccupancyMaxActiveBlocksPerMultiprocessor(&per_cu, (const void*)fwd_kernel, 512, LDS_BYTES) != hipSuccess || per_cu < 1) fprintf(stderr, "kernel_launch: occupancy query says %d\n", per_cu);
        (void)hipGetLastError();
        grid = cus;
    }
    if (grid < 0) return;
    (void)hipMemsetAsync((char*)d_ws + WS_CTL, 0, CTL_BYTES, stream);
    Args a{};
    for (int i = 0; i < 26; ++i) a.in[i] = (const float*)d_in[i];
    a.out = (float*)d_out; a.ws = (unsigned char*)d_ws;
    if (MK_N_LAUNCHES == 1) { a.ph_lo = 0; a.ph_hi = NPH; hipLaunchKernelGGL(fwd_kernel, dim3(grid), dim3(512), LDS_BYTES, stream, a); }
    else for (int p = 0; p < NPH; ++p) { a.ph_lo = p; a.ph_hi = p + 1; hipLaunchKernelGGL(fwd_kernel, dim3(grid), dim3(512), LDS_BYTES, stream, a); }
    const hipError_t le = hipPeekAtLastError();
    if (le != hipSuccess) fprintf(stderr, "kernel_launch: launch failed: %s\n", hipGetErrorName(le));
}
```

```cpp
#include <hip/hip_runtime.h>
#include <cstdio>
#include <cstdint>

#ifndef MK_N_LAUNCHES
#define MK_N_LAUNCHES 1
#endif

#define LAS __attribute__((address_space(3)))
typedef unsigned short bf16_t;
typedef short bf16x8 __attribute__((ext_vector_type(8)));
typedef short s16x4 __attribute__((ext_vector_type(4)));
typedef float f32x4 __attribute__((ext_vector_type(4)));
typedef float f32x2 __attribute__((ext_vector_type(2)));
typedef float f32x16 __attribute__((ext_vector_type(16)));
typedef unsigned u32x4 __attribute__((ext_vector_type(4)));
typedef unsigned u32x2 __attribute__((ext_vector_type(2)));

constexpr int NB = 4, SEQ = 4096, T = NB * SEQ, D = 2048;
constexpr int CH = 256, NCH = SEQ / CH, NBLK = NB * 8 * NCH;
constexpr int N_IN_NAT = 11520;
constexpr int N_IN_ALL = N_IN_NAT + 2048;
constexpr int NE = 32, PMAX = 73728;
constexpr float RMS_EPS = 1e-6f, GN_EPS = 1e-6f;
constexpr float QSCALE = 0.07216878364870322f;
constexpr int CONV_WGS = 64;

constexpr size_t MiB = 1u << 20;
constexpr size_t WS_CTL = 0, CTL_BYTES = 1 * MiB;
constexpr size_t WS_WT_IN = 1 * MiB;
constexpr size_t WS_WT_QB = WS_WT_IN + 54 * MiB;
constexpr size_t WS_WT_KVB = WS_WT_QB + 2 * MiB;
constexpr size_t WS_WT_MLAO = WS_WT_KVB + 2 * MiB;
constexpr size_t WS_WT_RETO = WS_WT_MLAO + 4 * MiB;
constexpr size_t WS_WT_OUT = WS_WT_RETO + 8 * MiB;
constexpr size_t WS_WT_GU = WS_WT_OUT + 8 * MiB;
constexpr size_t WS_WT_DOWN = WS_WT_GU + 512 * MiB;
constexpr size_t WS_CS_RET = WS_WT_DOWN + 256 * MiB;
constexpr size_t WS_CS_MLA = WS_CS_RET + 16 * MiB;
constexpr size_t WS_H = WS_CS_MLA + 4 * MiB;
constexpr size_t WS_QL = WS_H + 64 * MiB;
constexpr size_t WS_CKV = WS_QL + 16 * MiB;
constexpr size_t WS_KR = WS_CKV + 16 * MiB;
constexpr size_t WS_ACAT = WS_KR + 2 * MiB;
constexpr size_t WS_BCAT = WS_ACAT + 192 * MiB;
constexpr size_t WS_KROT = WS_BCAT + 192 * MiB;
constexpr size_t WS_KZTF = WS_KROT + 64 * MiB;
constexpr size_t WS_KZTB = WS_KZTF + 64 * MiB;
constexpr size_t WS_SG = WS_KZTB + 64 * MiB;
constexpr size_t WS_GA = WS_SG + 64 * MiB;
constexpr size_t WS_GB = WS_GA + 64 * MiB;
constexpr size_t WS_QN = WS_GB + 64 * MiB;
constexpr size_t WS_QR = WS_QN + 32 * MiB;
constexpr size_t WS_KN = WS_QR + 16 * MiB;
constexpr size_t WS_VV = WS_KN + 32 * MiB;
constexpr size_t WS_OA = WS_VV + 32 * MiB;
constexpr size_t WS_ORET = WS_OA + 32 * MiB;
constexpr size_t WS_OB = WS_ORET + 128 * MiB;
constexpr size_t WS_MIXP = WS_OB + 64 * MiB;
constexpr size_t WS_MIXIN = WS_MIXP + 64 * MiB;
constexpr size_t WS_MIX = WS_MIXIN + 64 * MiB;
constexpr size_t WS_H2 = WS_MIX + 128 * MiB;
constexpr size_t WS_TOPI = WS_H2 + 64 * MiB;
constexpr size_t WS_TOPW = WS_TOPI + 1 * MiB;
constexpr size_t WS_DEST = WS_TOPW + 1 * MiB;
constexpr size_t WS_TILE = WS_DEST + 1 * MiB;
constexpr size_t WS_YS_END = WS_TILE + 1 * MiB + 3 * 288 * MiB;
constexpr size_t WS_DECTAB = WS_TILE + 65536;
constexpr size_t WS_SSQP = WS_YS_END;
constexpr size_t WS_XS = WS_TILE + 1 * MiB;
constexpr size_t WS_ACT = WS_XS + 288 * MiB;
constexpr size_t WS_YS = WS_ACT + 288 * MiB;
constexpr size_t WS_ADAP = WS_YS + 288 * MiB + 1 * MiB;
constexpr size_t WS_H8 = WS_ADAP + 2 * MiB;
constexpr size_t WS_WT8IN = WS_H8 + 32 * MiB;
constexpr size_t WS_VT8 = WS_WT8IN + 12 * MiB;
constexpr size_t WS_X1B = WS_VT8 + 32 * MiB;
constexpr size_t WS_WRT = WS_X1B + 64 * MiB;
constexpr size_t WS_END = WS_WRT + 1 * MiB;
constexpr int CW_BAR = 4096;
constexpr int CW_QUEUE = 8192, CW_CVTQ = 8384, CW_AQ = 9216  , CW_COUNTS = 10240, CW_CURSOR = 12288;
constexpr int CW_ADA = 16384;
constexpr int CW_SSQQ = 65536, CW_SSQKV = 81920;
static_assert((CW_SSQKV + T) * 4 <= (int)CTL_BYTES, "ctl");

constexpr int RING_BYTES = 131072, CTRL_OFF = 155648, MISC_OFF = CTRL_OFF, LARG_OFF = CTRL_OFF + 1024, LDS_BYTES = 163840;

__device__ __forceinline__ unsigned cvt_pk_bf16(float lo, float hi) { unsigned r; asm volatile("v_cvt_pk_bf16_f32 %0, %1, %2" : "=v"(r) : "v"(lo), "v"(hi)); return r; }
__device__ __forceinline__ u32x4 pack8(f32x4 a, f32x4 b) { u32x4 w; w.x = cvt_pk_bf16(a[0], a[1]); w.y = cvt_pk_bf16(a[2], a[3]); w.z = cvt_pk_bf16(b[0], b[1]); w.w = cvt_pk_bf16(b[2], b[3]); return w; }
__device__ __forceinline__ unsigned pk4_fp8(float a, float b, float c, float d, float sc) {
    a = __builtin_amdgcn_fmed3f(a * sc, -448.f, 448.f); b = __builtin_amdgcn_fmed3f(b * sc, -448.f, 448.f); c = __builtin_amdgcn_fmed3f(c * sc, -448.f, 448.f); d = __builtin_amdgcn_fmed3f(d * sc, -448.f, 448.f);
    int w = __builtin_amdgcn_cvt_pk_fp8_f32(a, b, 0, false); w = __builtin_amdgcn_cvt_pk_fp8_f32(c, d, w, true); return (unsigned)w;
}
constexpr float W8_SCALE = 1024.f, H8_SCALE = 16.f, A8_SCALE = 8.f;
constexpr float V8_SCALE = 16.f, K8_SCALE = 256.f, CH_UNSCALE = 1.0f / (V8_SCALE * K8_SCALE);
constexpr float GU_UNSCALE = 1.0f / (W8_SCALE * H8_SCALE), DN_UNSCALE = 1.0f / (W8_SCALE * A8_SCALE);
constexpr float M8_SCALE = 64.f, MX_UNSCALE = 1.0f / (W8_SCALE * M8_SCALE);
__device__ __forceinline__ float bf_lo(unsigned w) { return __uint_as_float(w << 16); }
__device__ __forceinline__ float bf_hi(unsigned w) { return __uint_as_float(w & 0xffff0000u); }
__device__ __forceinline__ void unpack8(u32x4 w, f32x4& a, f32x4& b) { a = (f32x4){bf_lo(w.x), bf_hi(w.x), bf_lo(w.y), bf_hi(w.y)}; b = (f32x4){bf_lo(w.z), bf_hi(w.z), bf_lo(w.w), bf_hi(w.w)}; }
__device__ __forceinline__ float wave_sum(float v) {
#pragma unroll
    for (int o = 1; o < 64; o <<= 1) v += __shfl_xor(v, o);
    return v;
}
__device__ __forceinline__ float sigmoidf_(float x) { return __builtin_amdgcn_rcpf(1.0f + __expf(-x)); }
__device__ __forceinline__ float log2_sigmoid(float x) { return -log1pf(expf(-x)) * 1.4426950408889634f; }

#define XB_TMO      128
#define XB_XCNT(j)  (256  + 64 * (j))
#define XB_XSUB(j)  (1280 + 64 * (j))
#define XB_XGEN(j)  (2304 + 64 * (j))
#define XB_TOP      3328
#define XB_TOPGEN   3392
#define XCD_BAR_WORDS 3456
#define XB_SPIN_CAP (1u << 22)
__device__ __forceinline__ unsigned xb_ld(unsigned* p)              { return __hip_atomic_load(p, __ATOMIC_RELAXED, __HIP_MEMORY_SCOPE_AGENT); }
__device__ __forceinline__ unsigned xb_add(unsigned* p, unsigned v) { return __hip_atomic_fetch_add(p, v, __ATOMIC_RELAXED, __HIP_MEMORY_SCOPE_AGENT); }
__device__ __forceinline__ unsigned xb_xcc_id() { return (unsigned)__builtin_amdgcn_s_getreg((3 << 11) | 20) & 0xFu; }
#define XB_SPIN(cond, bar) do { unsigned _sp = 0; while (cond) { __builtin_amdgcn_s_sleep(1); \
    if ((++_sp & 255u) == 0u) { if (xb_ld(&(bar)[XB_TMO])) break; if (_sp > XB_SPIN_CAP) { atomicAdd(&(bar)[XB_TMO], 1u); break; } } } } while (0)
struct XcdBarrier { unsigned* bar; unsigned x; volatile LAS unsigned* st; };
__device__ __forceinline__ XcdBarrier xcd_barrier_post(unsigned* bar, volatile LAS unsigned* st) {
    XcdBarrier b; b.bar = bar; b.x = xb_xcc_id(); b.st = st;
    if (threadIdx.x == 0) (void)xb_add(&bar[XB_XCNT(b.x)], 1u);
    return b;
}
__device__ __forceinline__ void xcd_barrier_complete(unsigned* bar, unsigned x, unsigned& nloc, unsigned& nx) {
    const unsigned G = gridDim.x * gridDim.y * gridDim.z;
    unsigned sum, cnt, mine, sp = 0u;
    for (;;) {
        sum = 0u; cnt = 0u; mine = 0u;
#pragma unroll
        for (unsigned j = 0; j < 16; ++j) { const unsigned c = xb_ld(&bar[XB_XCNT(j)]); sum += c; cnt += (c > 0u) ? 1u : 0u; mine = (j == x) ? c : mine; }
        if (sum == G) break;
        __builtin_amdgcn_s_sleep(1);
        if ((++sp & 255u) == 0u) { if (xb_ld(&bar[XB_TMO])) break; if (sp > XB_SPIN_CAP) { atomicAdd(&bar[XB_TMO], 1u); break; } }
    }
    nloc = mine > 0u ? mine : 1u; nx = cnt > 0u ? cnt : 1u;
}
__device__ __forceinline__ void xcd_barrier(const XcdBarrier& b) {
    asm volatile("s_waitcnt vmcnt(0)" ::: "memory");
    __syncthreads();
    if (threadIdx.x == 0) {
        unsigned* bar = b.bar;
        __builtin_amdgcn_s_waitcnt(0);
        unsigned nloc = b.st[0], nx = b.st[1];
        if (nloc == 0u) { xcd_barrier_complete(bar, b.x, nloc, nx); b.st[0] = nloc; b.st[1] = nx; }
        const unsigned old = xb_add(&bar[XB_XSUB(b.x)], 1u);
        const unsigned gen = old / nloc;
        if (old + 1u == (gen + 1u) * nloc) {
            __builtin_amdgcn_fence(__ATOMIC_RELEASE, "agent");
            asm volatile("s_waitcnt vmcnt(0)" ::: "memory");
            const unsigned og = xb_add(&bar[XB_TOP], 1u);
            const unsigned tg = og / nx;
            if (og + 1u == (tg + 1u) * nx) xb_add(&bar[XB_TOPGEN], 1u);
            else XB_SPIN(xb_ld(&bar[XB_TOPGEN]) == tg, bar);
            __builtin_amdgcn_fence(__ATOMIC_ACQUIRE, "agent");
            xb_add(&bar[XB_XGEN(b.x)], 1u);
            asm volatile("s_waitcnt vmcnt(0)" ::: "memory");
        } else {
            XB_SPIN(xb_ld(&bar[XB_XGEN(b.x)]) == gen, bar);
            __builtin_amdgcn_fence(__ATOMIC_ACQUIRE, "agent");
            asm volatile("s_waitcnt vmcnt(0)" ::: "memory");
        }
    }
    __syncthreads();
}

namespace pg8 {
constexpr int BM = 256, BK = 64, HALF = 128, HTB = HALF * BK * 2, NXCD = 8, WGM = 8;
__host__ __device__ __forceinline__ int lds_byte(int r, int c, int SW = 5) { const int st = (r >> 4) * 2 + (c >> 5), rr = r & 15, cc = c & 31, ob = rr * 64 + cc * 2; return st * 1024 + (ob ^ (((ob >> 9) & 1) << SW)); }
__host__ __device__ __forceinline__ void stage_rc(int b, int& R, int& C, int SW = 5) { const int st = b / 1024, sb = b % 1024, swz = sb ^ (((sb >> 9) & 1) << SW); R = (st >> 1) * 16 + swz / 64; C = (st & 1) * 32 + (swz % 64) / 2; }
__host__ __device__ __forceinline__ int perm32(int rho) { const int n = rho >> 4, i = rho & 15; return 8 * (i >> 2) + 4 * n + (i & 3); }
struct Unit { const char* a; const char* b; int pm, pn, keep, aux; };
__device__ __forceinline__ void tile_order(int wgid, int nM, int nN, int& pm, int& pn) {
    const int nwg = nM * nN; { const int q = nwg / NXCD, r = nwg % NXCD, xcd = wgid % NXCD, off = wgid / NXCD; wgid = (xcd < r ? xcd * (q + 1) : r * (q + 1) + (xcd - r) * q) + off; }
    const int nig = WGM * nN, gid = wgid / nig, fm = gid * WGM, gsz = (nM - fm) < WGM ? (nM - fm) : WGM;
    pm = fm + ((wgid % nig) % gsz); pn = (wgid % nig) / gsz;
}
typedef int v8i __attribute__((ext_vector_type(8)));
typedef int v4i __attribute__((ext_vector_type(4)));
template <class Epi, class Sched, bool F8 = false, bool REMAT = false>
__device__ __forceinline__ void gemm_phase(LAS unsigned char* lds, const int K, const int lda, const int ldb, const Sched& S, const Epi& E) {
    const int tid = threadIdx.x, wid = __builtin_amdgcn_readfirstlane(tid >> 6), lane = tid & 63, wr = wid >> 2, wc = wid & 3, fr = lane & 15, fq = lane >> 4;
    constexpr int ES = F8 ? 1 : 2;
    const int nt = K * ES / (BK * 2);
    unsigned voffA, voffB;
    constexpr bool X4 = F8 && !REMAT;
    constexpr int SW = X4 ? 4 : 5;
    { int R, C; stage_rc(tid * 16, R, C, SW); const int Rb = (R & ~31) + perm32(R & 31); voffA = (unsigned)(R * lda * ES + C * 2); voffB = (unsigned)(Rb * ldb * ES + C * 2); }
    const size_t q64voffA = (size_t)64 * lda * ES, q64voffB = (size_t)64 * ldb * ES;
    const size_t kstep = (size_t)(BK * 2);
    const size_t hstepA = (size_t)HALF * lda * ES, hstepB = (size_t)HALF * ldb * ES;
    const unsigned ldsw = (unsigned)wid * 1024u;
    const int aoff = F8 ? lds_byte(wr * 64 + fr, fq * 16, SW) : lds_byte(wr * 64 + fr, fq * 8), boff = F8 ? lds_byte(wc * 32 + fr, fq * 16, SW) : lds_byte(wc * 32 + fr, fq * 8);
#define PG8_SA(b, h) (((b) * 2 + (h)) * HTB)
#define PG8_SB(b, h) ((4 + (b) * 2 + (h)) * HTB)
    constexpr bool isB_voffA = false, isB_voffB = true; const unsigned pitch_voffA = (unsigned)(lda * ES), pitch_voffB = (unsigned)(ldb * ES);
#define PG8_VOFF(isB, pitch) ({ unsigned _t = threadIdx.x; asm volatile("" : "+v"(_t)); const unsigned _l = _t & 63u, _w = _t >> 6, _sw = (_l * 16u) ^ ((_l >> 5) << SW); unsigned _R = (_w >> 1) * 16u + (_sw >> 6); \
        const unsigned _C = (_w & 1u) * 32u + ((_sw & 63u) >> 1); if (isB) _R = (_R & ~31u) + (unsigned)perm32((int)(_R & 31u)); _R * (pitch) + _C * 2u; })
#define PG8_STAGE(bufoff, gbase, voff) do { _Pragma("unroll") for (int _i = 0; _i < 2; ++_i) { unsigned _vo; if constexpr (REMAT) _vo = PG8_VOFF(isB_##voff, pitch_##voff); else { _vo = (voff); if constexpr (F8) asm volatile("" : "+v"(_vo)); } \
        __builtin_amdgcn_global_load_lds((const unsigned*)((const char*)(gbase) + (_i ? q64##voff : (size_t)0) + _vo), (LAS unsigned*)(lds + (bufoff) + ldsw + _i * 8192), 16, 0, 0); } } while (0)
#define PG8_LD1(addr) ({ v8i _r; if constexpr (F8 && !X4) { _r = *(const LAS v8i*)(addr); } else if constexpr (X4) { const v4i _lo = *(const LAS v4i*)(addr), _hi = *(const LAS v4i*)((addr) + _x16); _r = __builtin_shufflevector(_lo, _hi, 0, 1, 2, 3, 4, 5, 6, 7); } else { const v4i _lo = *(const LAS v4i*)(addr), _hi = *(const LAS v4i*)((addr) + 1024); _r = __builtin_shufflevector(_lo, _hi, 0, 1, 2, 3, 4, 5, 6, 7); } _r; })
#define PG8_X16(off) int _x16 = 0; if constexpr (X4) { int _o = (off); asm volatile("" : "+v"(_o)); _x16 = (_o ^ 16) - _o; }
#define PG8_LDA(dst, b, h) do { PG8_X16(aoff) _Pragma("unroll") for (int m = 0; m < 4; ++m) dst[m] = PG8_LD1(lds + PG8_SA(b, h) + aoff + m * 2048); } while (0)
#define PG8_LDB(dst, b, h) do { PG8_X16(boff) _Pragma("unroll") for (int n = 0; n < 2; ++n) dst[n] = PG8_LD1(lds + PG8_SB(b, h) + boff + n * 2048); } while (0)
#define PG8_H0(x) __builtin_bit_cast(bf16x8, __builtin_shufflevector(x, x, 0, 1, 2, 3))
#define PG8_H1(x) __builtin_bit_cast(bf16x8, __builtin_shufflevector(x, x, 4, 5, 6, 7))
#define PG8_MMA(ai, bj, At, Bt) do { __builtin_amdgcn_s_setprio(1); _Pragma("unroll") for (int m = 0; m < 4; ++m) _Pragma("unroll") for (int n = 0; n < 2; ++n) { \
        if constexpr (F8) acc[ai][bj][m][n] = __builtin_amdgcn_mfma_scale_f32_16x16x128_f8f6f4(Bt[n], At[m], acc[ai][bj][m][n], 0, 0, 0, 0, 0, 0); \
        else { acc[ai][bj][m][n] = __builtin_amdgcn_mfma_f32_16x16x32_bf16(PG8_H0(Bt[n]), PG8_H0(At[m]), acc[ai][bj][m][n], 0, 0, 0); \
               acc[ai][bj][m][n] = __builtin_amdgcn_mfma_f32_16x16x32_bf16(PG8_H1(Bt[n]), PG8_H1(At[m]), acc[ai][bj][m][n], 0, 0, 0); } } \
        __builtin_amdgcn_s_setprio(0); } while (0)
#define PG8_WAIT_V(n) asm volatile("s_waitcnt vmcnt(" #n ")" ::: "memory")
#define PG8_WAIT_L(n) asm volatile("s_waitcnt lgkmcnt(" #n ")" ::: "memory")
#define PG8_BAR __builtin_amdgcn_s_barrier()
#define PG8_SCHED __builtin_amdgcn_sched_barrier(0)
    Unit cur, nxt; int ui = 0;
    if (!S.next(0, cur)) return;
    f32x4 acc[2][2][4][2];
#pragma unroll
    for (int a = 0; a < 2; ++a)
#pragma unroll
        for (int b = 0; b < 2; ++b)
#pragma unroll
            for (int m = 0; m < 4; ++m)
#pragma unroll
                for (int n = 0; n < 2; ++n) acc[a][b][m][n] = (f32x4){0.f, 0.f, 0.f, 0.f};
    v8i At[4], B0[2], B1[2];
    const char* cA = cur.a; const char* cB = cur.b;
    PG8_STAGE(PG8_SB(0, 0), cB, voffB); PG8_STAGE(PG8_SB(0, 1), cB + hstepB, voffB); PG8_STAGE(PG8_SA(0, 0), cA, voffA); PG8_STAGE(PG8_SA(0, 1), cA + hstepA, voffA);
    if (wr == 1) PG8_BAR;
    PG8_WAIT_V(2); PG8_BAR;
    PG8_STAGE(PG8_SB(1, 0), cB + kstep, voffB); PG8_STAGE(PG8_SA(1, 0), cA + kstep, voffA); PG8_STAGE(PG8_SB(1, 1), cB + hstepB + kstep, voffB);
    PG8_WAIT_V(6); PG8_BAR;
    for (;;) {
        const bool has_next = S.next(ui + 1, nxt);
        const char* nA = has_next ? nxt.a : cA; const char* nB = has_next ? nxt.b : cB;
#pragma nounroll
        for (int t = 0; t < nt; t += 2) {
            const bool last = (t == nt - 2);
            const char* a1 = cA + (size_t)(t + 1) * kstep;
            const char* a2 = last ? nA : cA + (size_t)(t + 2) * kstep; const char* b2 = last ? nB : cB + (size_t)(t + 2) * kstep;
            const char* a3 = a2 + kstep; const char* b3 = b2 + kstep;
            PG8_LDB(B0, 0, 0); PG8_LDB(B1, 0, 1); PG8_SCHED; PG8_LDA(At, 0, 0); PG8_STAGE(PG8_SA(1, 1), a1 + hstepA, voffA);
            PG8_WAIT_V(8); PG8_WAIT_L(0); PG8_BAR; PG8_MMA(0, 0, At, B0); PG8_MMA(0, 1, At, B1); PG8_BAR; PG8_SCHED;
            PG8_LDA(At, 0, 1); PG8_STAGE(PG8_SB(0, 0), b2, voffB); PG8_STAGE(PG8_SB(0, 1), b2 + hstepB, voffB); PG8_STAGE(PG8_SA(0, 0), a2, voffA);
            PG8_WAIT_V(8); PG8_WAIT_L(0); PG8_BAR; PG8_MMA(1, 0, At, B0); PG8_MMA(1, 1, At, B1); PG8_BAR; PG8_SCHED;
            PG8_LDB(B0, 1, 0); PG8_LDB(B1, 1, 1); PG8_SCHED; PG8_LDA(At, 1, 0); PG8_STAGE(PG8_SA(0, 1), a2 + hstepA, voffA);
            PG8_WAIT_V(8); PG8_WAIT_L(0); PG8_BAR; PG8_MMA(0, 0, At, B0); PG8_MMA(0, 1, At, B1); PG8_BAR; PG8_SCHED;
            PG8_LDA(At, 1, 1); PG8_STAGE(PG8_SB(1, 0), b3, voffB); PG8_STAGE(PG8_SB(1, 1), b3 + hstepB, voffB); PG8_STAGE(PG8_SA(1, 0), a3, voffA);
            PG8_WAIT_V(8); PG8_WAIT_L(0); PG8_BAR; PG8_MMA(1, 0, At, B0); PG8_MMA(1, 1, At, B1); PG8_BAR; PG8_SCHED;
        }
        if (wr == 0) PG8_BAR;
        { unsigned _t = threadIdx.x; if constexpr (F8) asm volatile("" : "+v"(_t)); E(acc, cur, wr, wc, (int)(_t & 15u), (int)((_t >> 4) & 3u)); }
        if (!has_next) break;
        if (!cur.keep) {
#pragma unroll
            for (int a = 0; a < 2; ++a)
#pragma unroll
                for (int b = 0; b < 2; ++b)
#pragma unroll
                    for (int m = 0; m < 4; ++m)
#pragma unroll
                        for (int n = 0; n < 2; ++n) acc[a][b][m][n] = (f32x4){0.f, 0.f, 0.f, 0.f};
        }
        cur = nxt; cA = nA; cB = nB; ++ui;
        if (wr == 1) PG8_BAR;
    }
    PG8_WAIT_V(0);
    PG8_BAR;
#undef PG8_SA
#undef PG8_SB
#undef PG8_STAGE
#undef PG8_VOFF
#undef PG8_LDA
#undef PG8_LDB
#undef PG8_LD1
#undef PG8_X16
#undef PG8_H0
#undef PG8_H1
#undef PG8_MMA
#undef PG8_WAIT_V
#undef PG8_WAIT_L
#undef PG8_BAR
#undef PG8_SCHED
}
struct GridSched {
    const char* A; const char* Bt; size_t astep, bstep; int nM, nN, G, c;
    __device__ __forceinline__ bool next(int i, Unit& u) const {
        const int L = i * G + c; if (L >= nM * nN) return false;
        int pm, pn; tile_order(L, nM, nN, pm, pn);
        u.a = A + (size_t)pm * astep; u.b = Bt + (size_t)pn * bstep; u.pm = pm; u.pn = pn; u.keep = 0; u.aux = 0; return true;
    }
};
struct InprojSched {
    const char* H; const char* W; int G, c;
    __device__ __forceinline__ bool next(int i, Unit& u) const {
        const int L = i * G + c; if (L >= 1792) return false;
        constexpr size_t TSB = (size_t)256 * 2048 * 2; int pm, pn;
        if (L < 1280) { tile_order(L, 64, 20, pm, pn); pn = pn < 4 ? pn : pn + 1; u.a = H + (size_t)pm * TSB; u.b = W + (size_t)pn * TSB; u.aux = 0; }
        else { tile_order(L - 1280, 8, 64, pm, pn); u.a = W + (size_t)(45 + pm) * TSB; u.b = H + (size_t)pn * TSB; u.aux = 1; }
        u.pm = pm; u.pn = pn; u.keep = 0; return true;
    }
};
struct GridSchedR {
    const char* A; const char* Bt; size_t astep, bstep; int nM, nN, G, c, L0, Lend;
    __device__ __forceinline__ bool next(int i, Unit& u) const {
        const int L = L0 + i * G + c; if (L >= Lend) return false;
        int pm, pn; tile_order(L, nM, nN, pm, pn);
        u.a = A + (size_t)pm * astep; u.b = Bt + (size_t)pn * bstep; u.pm = pm; u.pn = pn; u.keep = 0; u.aux = 0; return true;
    }
};
struct BatchSchedR {
    const char* A; const char* Bt; size_t astep, bstep; int G, c, L0, Lend;
    __device__ __forceinline__ bool next(int i, Unit& u) const {
        const int L = L0 + i * G + c; if (L >= Lend) return false;
        u.a = A + (size_t)L * astep; u.b = Bt + (size_t)L * bstep; u.pm = L; u.pn = 0; u.keep = 0; u.aux = 0; return true;
    }
};
struct BatchSched {
    const char* A; const char* Bt; size_t astep, bstep; int n, G, c;
    __device__ __forceinline__ bool next(int i, Unit& u) const {
        const int L = i * G + c; if (L >= n) return false;
        u.a = A + (size_t)L * astep; u.b = Bt + (size_t)L * bstep; u.pm = L; u.pn = 0; u.keep = 0; u.aux = 0; return true;
    }
};
struct ChainSched {
    const char* A; const char* Bt; int bh, dir;
    __device__ __forceinline__ bool next(int i, Unit& u) const {
        if (i >= NCH) return false;
        const int n = dir ? (NCH - 1 - i) : i, blk = bh * NCH + n;
        u.a = A + (size_t)blk * (256 * 256); u.b = Bt + (size_t)blk * (256 * 256); u.pm = blk; u.pn = i; u.keep = 1; u.aux = n; return true;
    }
};
struct MoeSched {
    const char* A; const char* Bt; const int* tile_e; int ntiles, nN, G, c;
    __device__ __forceinline__ bool next(int i, Unit& u) const {
        const int L = i * G + c; if (L >= ntiles * nN) return false;
        int pm, pn; tile_order(L, ntiles, nN, pm, pn);
        const int e = __builtin_amdgcn_readfirstlane(tile_e[pm]);
        u.a = A + (size_t)pm * (256 * 2048); u.b = Bt + ((size_t)e * nN + pn) * (256 * 2048); u.pm = pm; u.pn = pn; u.keep = 0; u.aux = e; return true;
    }
};
}
using pg8::Unit;

#define EPI_LOOP _Pragma("unroll") for (int ai = 0; ai < 2; ++ai) _Pragma("unroll") for (int m = 0; m < 4; ++m)
#define EPI_ROW (ai * 128 + wr * 64 + m * 16 + fr)
#define EPI_FENCE asm volatile("" ::: "memory")
typedef f32x4 Acc[2][2][4][2];

__device__ __forceinline__ void rot4(const f32x4 x1, const f32x4 x2, const f32x4 csA, const f32x4 csB, f32x4& o1, f32x4& o2) {
    o1[0] = x1[0] * csA[0] - x2[0] * csA[1]; o2[0] = x1[0] * csA[1] + x2[0] * csA[0];
    o1[1] = x1[1] * csA[2] - x2[1] * csA[3]; o2[1] = x1[1] * csA[3] + x2[1] * csA[2];
    o1[2] = x1[2] * csB[0] - x2[2] * csB[1]; o2[2] = x1[2] * csB[1] + x2[2] * csB[0];
    o1[3] = x1[3] * csB[2] - x2[3] * csB[3]; o2[3] = x1[3] * csB[3] + x2[3] * csB[2];
}
__device__ __forceinline__ f32x4 rot_il(const f32x4 v, const f32x4 cs) {
    return (f32x4){v[0] * cs[0] - v[1] * cs[1], v[0] * cs[1] + v[1] * cs[0], v[2] * cs[2] - v[3] * cs[3], v[2] * cs[3] + v[3] * cs[2]};
}

struct EpiInproj {
    bf16_t *QL, *CKV, *KR, *ACAT, *KROT, *SG, *GA, *GB; float *ssqp; const float* cs_ret; const float* cs_mla; const float* dectab; int pn_off; float unscale;
    __device__ __forceinline__ void operator()(Acc& acc, const Unit& u, int wr, int wc, int fr, int fq) const {
        asm volatile("" : "+v"(fr), "+v"(fq));
        const int pn = u.pn + pn_off, tok0 = u.pm * 256, cb = wc * 32 + fq * 8;
        if (pn < 4) {
            bf16_t* dst = QL + (size_t)(pn >> 1) * ((WS_CKV - WS_QL) / 2); float* ssq = ssqp + (size_t)(pn * 4 + wc) * T; const int c0 = (pn & 1) * 256 + cb;
            EPI_LOOP { const int row = tok0 + EPI_ROW; float s = 0.f;
#pragma unroll
                for (int bj = 0; bj < 2; ++bj) { const f32x4 v0 = acc[ai][bj][m][0], v1 = acc[ai][bj][m][1];
                    s += (v0[0] * v0[0] + v0[1] * v0[1]) + (v0[2] * v0[2] + v0[3] * v0[3]) + (v1[0] * v1[0] + v1[1] * v1[1]) + (v1[2] * v1[2] + v1[3] * v1[3]);
                    *(u32x4*)(dst + (size_t)row * 512 + c0 + bj * 128) = pack8(v0, v1); }
                s += __shfl_xor(s, 16); s += __shfl_xor(s, 32);
                if (fq == 0) ssq[row] = s; EPI_FENCE; }
        } else if (pn == 4) {
            if (wc < 2) {
                EPI_LOOP { const int row = tok0 + EPI_ROW; const float* cs = cs_mla + (size_t)row * 64 + cb;
                    const f32x4 csA = *(const f32x4*)cs, csB = *(const f32x4*)(cs + 4);
                    *(u32x4*)(KR + (size_t)row * 64 + cb) = pack8(rot_il(acc[ai][0][m][0], csA), rot_il(acc[ai][0][m][1], csB)); EPI_FENCE; }
            }
        } else if (pn < 21) {
            const bool isq = pn < 13; const int h = isq ? pn - 5 : pn - 13;
            const int blk = ((u.pm >> 4) * 8 + h) * NCH + (u.pm & 15);
            const float lf = dectab[h], lb = dectab[8 + h];
            EPI_LOOP { const int c = EPI_ROW, row = tok0 + c; const float* cs = cs_ret + (size_t)row * 256 + cb * 2;
                f32x4 q1[2], q2[2];
#pragma unroll
                for (int n = 0; n < 2; ++n) { const f32x4 csA = *(const f32x4*)(cs + n * 8), csB = *(const f32x4*)(cs + n * 8 + 4); rot4(acc[ai][0][m][n], acc[ai][1][m][n], csA, csB, q1[n], q2[n]); }
                if (isq) {
                    const float xf = __builtin_amdgcn_exp2f((float)(c + 1) * lf), xb = __builtin_amdgcn_exp2f((float)(CH - c) * lb);
                    bf16_t* base = ACAT + ((size_t)blk * 256 + c) * 768 + cb;
                    *(u32x4*)(base + 256) = pack8(q1[0] * xf, q1[1] * xf); *(u32x4*)(base + 384) = pack8(q2[0] * xf, q2[1] * xf);
                    *(u32x4*)(base + 512) = pack8(q1[0] * xb, q1[1] * xb); *(u32x4*)(base + 640) = pack8(q2[0] * xb, q2[1] * xb);
                } else {
                    bf16_t* base = KROT + ((size_t)blk * 256 + c) * 256 + cb;
                    *(u32x4*)(base) = pack8(q1[0] * 0.0625f, q1[1] * 0.0625f); *(u32x4*)(base + 128) = pack8(q2[0] * 0.0625f, q2[1] * 0.0625f);
                }
                EPI_FENCE; }
        } else {
            const int g = (pn - 21) >> 3, ct = (pn - 21) & 7; bf16_t* dst = SG + (size_t)g * ((WS_GA - WS_SG) / 2);
            EPI_LOOP { const int row = tok0 + EPI_ROW;
#pragma unroll
                for (int bj = 0; bj < 2; ++bj) { f32x4 v[2];
#pragma unroll
                    for (int n = 0; n < 2; ++n)
#pragma unroll
                        for (int j = 0; j < 4; ++j) { const float x = acc[ai][bj][m][n][j] * unscale; const float sg = sigmoidf_(x); v[n][j] = g == 0 ? x * sg : sg; }
                    *(u32x4*)(dst + (size_t)row * 2048 + ct * 256 + bj * 128 + cb) = pack8(v[0], v[1]); }
                EPI_FENCE; }
        }
    }
};
struct EpiVT {
    bf16_t* BCAT; unsigned char* VT8;
    __device__ __forceinline__ void operator()(Acc& acc, const Unit& u, int wr, int wc, int fr, int fq) const {
        asm volatile("" : "+v"(fr), "+v"(fq));
        const int blk = ((u.pn >> 4) * 8 + u.pm) * NCH + (u.pn & 15), cb = wc * 32 + fq * 8;
        EPI_LOOP { bf16_t* base = BCAT + ((size_t)blk * 256 + EPI_ROW) * 768 + cb; unsigned char* b8 = VT8 + ((size_t)blk * 256 + EPI_ROW) * 256 + cb;
#pragma unroll
            for (int bj = 0; bj < 2; ++bj) { const f32x4 v0 = acc[ai][bj][m][0], v1 = acc[ai][bj][m][1]; *(u32x4*)(base + bj * 128) = pack8(v0, v1);
                u32x2 w8; w8.x = pk4_fp8(v0[0], v0[1], v0[2], v0[3], V8_SCALE); w8.y = pk4_fp8(v1[0], v1[1], v1[2], v1[3], V8_SCALE); *(u32x2*)(b8 + bj * 128) = w8; } }
    }
};
struct EpiInprojAll {
    EpiInproj a; EpiVT b;
    __device__ __forceinline__ void operator()(Acc& acc, const Unit& u, int wr, int wc, int fr, int fq) const { if (u.aux) b(acc, u, wr, wc, fr, fq); else a(acc, u, wr, wc, fr, fq); }
};
struct EpiMlaQ {
    bf16_t *QN, *QR; const float* ssq; const float* cs_mla;
    __device__ __forceinline__ void operator()(Acc& acc, const Unit& u, int wr, int wc, int fr, int fq) const {
        asm volatile("" : "+v"(fr), "+v"(fq));
        const int pn = u.pn, tok0 = u.pm * 256, cb = wc * 32 + fq * 8;
        EPI_LOOP { const int row = tok0 + EPI_ROW; float ss = 0.f;
#pragma unroll
            for (int q = 0; q < 8; ++q) ss += ssq[(size_t)q * T + row];
            const float rs = rsqrtf(ss * (1.0f / 512.0f) + RMS_EPS) * QSCALE;
            if (pn < 4) {
#pragma unroll
                for (int bj = 0; bj < 2; ++bj) *(u32x4*)(QN + (size_t)row * 1024 + (2 * pn + bj) * 128 + cb) = pack8(acc[ai][bj][m][0] * rs, acc[ai][bj][m][1] * rs);
            } else {
                const int c0 = (wc & 1) * 32 + fq * 8; const float* cs = cs_mla + (size_t)row * 64 + c0;
                const f32x4 csA = *(const f32x4*)cs, csB = *(const f32x4*)(cs + 4);
#pragma unroll
                for (int bj = 0; bj < 2; ++bj) { const int head = 4 * (pn - 4) + 2 * bj + (wc >> 1);
                    *(u32x4*)(QR + (size_t)row * 512 + head * 64 + c0) = pack8(rot_il(acc[ai][bj][m][0], csA) * rs, rot_il(acc[ai][bj][m][1], csB) * rs); }
            }
            EPI_FENCE; }
    }
};
struct EpiMlaKV {
    bf16_t *KN, *VV; const float* ssq;
    __device__ __forceinline__ void operator()(Acc& acc, const Unit& u, int wr, int wc, int fr, int fq) const {
        asm volatile("" : "+v"(fr), "+v"(fq));
        const int pn = u.pn, tok0 = u.pm * 256, cb = wc * 32 + fq * 8; bf16_t* dst = KN + (size_t)(pn >> 2) * ((WS_VV - WS_KN) / 2); const int hb = 2 * (pn & 3);
        EPI_LOOP { const int row = tok0 + EPI_ROW; float ss = 0.f;
#pragma unroll
            for (int q = 0; q < 8; ++q) ss += ssq[(size_t)q * T + row];
            const float rs = rsqrtf(ss * (1.0f / 512.0f) + RMS_EPS);
#pragma unroll
            for (int bj = 0; bj < 2; ++bj) *(u32x4*)(dst + (size_t)row * 1024 + (hb + bj) * 128 + cb) = pack8(acc[ai][bj][m][0] * rs, acc[ai][bj][m][1] * rs); }
    }
};
struct EpiGa {
    bf16_t* ACAT; const float* dectab;
    __device__ __forceinline__ void operator()(Acc& acc, const Unit& u, int wr, int wc, int fr, int fq) const {
        asm volatile("" : "+v"(fr), "+v"(fq));
        const int blk = u.pm, h = (blk >> 4) & 7, cb = wc * 32 + fq * 8;
        const float lf = dectab[h], lb = dectab[8 + h];
        f32x4 colA[2][2], colB[2][2];
#pragma unroll
        for (int bj = 0; bj < 2; ++bj)
#pragma unroll
            for (int n = 0; n < 2; ++n)
#pragma unroll
                for (int j = 0; j < 4; ++j) { const int mm = bj * 128 + cb + n * 4 + j; colA[bj][n][j] = __builtin_amdgcn_exp2f(-(float)(mm + 1) * lf); colB[bj][n][j] = __builtin_amdgcn_exp2f((float)mm * lb); }
        EPI_LOOP { const int c = EPI_ROW; bf16_t* base = ACAT + ((size_t)blk * 256 + c) * 768 + cb;
            const float rowB = __builtin_amdgcn_exp2f(-(float)c * lb - (float)(c + 1) * lf);
#pragma unroll
            for (int bj = 0; bj < 2; ++bj) { f32x4 v[2];
#pragma unroll
                for (int n = 0; n < 2; ++n)
#pragma unroll
                    for (int j = 0; j < 4; ++j) { const int mm = bj * 128 + cb + n * 4 + j;
                        v[n][j] = acc[ai][bj][m][n][j] * ((c >= mm) ? colA[bj][n][j] : colB[bj][n][j] * rowB); }
                *(u32x4*)(base + bj * 128) = pack8(v[0], v[1]); }
            EPI_FENCE; }
    }
};
struct EpiGb {
    bf16_t* BCAT; const float* dectab; int dir;
    __device__ __forceinline__ void operator()(Acc& acc, const Unit& u, int wr, int wc, int fr, int fq) const {
        asm volatile("" : "+v"(fr), "+v"(fq));
        const int h = (u.pm >> 4) & 7;
        const float gC = __builtin_amdgcn_exp2f((float)CH * dectab[8 * dir + h]);
        if (u.pn < NCH - 1) {
            const int nblk = dir ? u.pm - 1 : u.pm + 1;
            bf16_t* base0 = BCAT + ((size_t)nblk * 256 + wr * 64 + fr) * 768 + 256 + 256 * dir + wc * 32 + fq * 8;
            EPI_LOOP { bf16_t* base = base0 + (size_t)(ai * 128 + m * 16) * 768;
#pragma unroll
                for (int bj = 0; bj < 2; ++bj) *(u32x4*)(base + bj * 128) = pack8(acc[ai][bj][m][0] * CH_UNSCALE, acc[ai][bj][m][1] * CH_UNSCALE); }
        }
        EPI_LOOP {
#pragma unroll
            for (int bj = 0; bj < 2; ++bj) { acc[ai][bj][m][0] *= gC; acc[ai][bj][m][1] *= gC; } }
    }
};
struct EpiGc {
    bf16_t* OB; const bf16_t* SG; const float* gn; LAS unsigned char* lds;
    __device__ __forceinline__ void operator()(Acc& acc, const Unit& u, int wr, int wc, int fr, int fq) const {
        asm volatile("" : "+v"(fr), "+v"(fq));
        const int blk = u.pm, b = blk >> 7, h = (blk >> 4) & 7, n = blk & 15, cb = wc * 32 + fq * 8;
        LAS f32x2* P = (LAS f32x2*)(lds + RING_BYTES);
        EPI_LOOP { float s = 0.f;
#pragma unroll
            for (int bj = 0; bj < 2; ++bj)
#pragma unroll
                for (int nn = 0; nn < 2; ++nn) { const f32x4 x = acc[ai][bj][m][nn]; s += (x[0] + x[1]) + (x[2] + x[3]); }
            s += __shfl_xor(s, 16); s += __shfl_xor(s, 32);
            const float mw = s * (1.0f / 64.0f); float q = 0.f;
#pragma unroll
            for (int bj = 0; bj < 2; ++bj)
#pragma unroll
                for (int nn = 0; nn < 2; ++nn) { const f32x4 d = acc[ai][bj][m][nn] - mw; q += (d[0] * d[0] + d[1] * d[1]) + (d[2] * d[2] + d[3] * d[3]); }
            q += __shfl_xor(q, 16); q += __shfl_xor(q, 32);
            if (fq == 0) P[EPI_ROW * 4 + wc] = (f32x2){mw, q}; }
        asm volatile("s_waitcnt lgkmcnt(0)" ::: "memory"); __builtin_amdgcn_s_barrier(); asm volatile("" ::: "memory");
        EPI_LOOP { const int row = EPI_ROW; const f32x4 p01 = *(const LAS f32x4*)(P + row * 4), p23 = *(const LAS f32x4*)(P + row * 4 + 2);
            const float mean = ((p01[0] + p01[2]) + (p23[0] + p23[2])) * 0.25f;
            const float d0 = p01[0] - mean, d1 = p01[2] - mean, d2 = p23[0] - mean, d3 = p23[2] - mean;
            const float m2 = ((p01[1] + p01[3]) + (p23[1] + p23[3])) + 64.0f * ((d0 * d0 + d1 * d1) + (d2 * d2 + d3 * d3));
            const float rstd = rsqrtf(m2 * (1.0f / 256.0f) + GN_EPS);
            const size_t off = ((size_t)b * SEQ + n * 256 + row) * 2048 + h * 256 + cb;
#pragma unroll
            for (int bj = 0; bj < 2; ++bj) { f32x4 s0, s1; unpack8(*(const u32x4*)(SG + off + bj * 128), s0, s1);
                const f32x4 g0 = *(const f32x4*)(gn + h * 256 + bj * 128 + cb), g1 = *(const f32x4*)(gn + h * 256 + bj * 128 + cb + 4);
                *(u32x4*)(OB + off + bj * 128) = pack8(s0 * ((acc[ai][bj][m][0] - mean) * rstd * g0), s1 * ((acc[ai][bj][m][1] - mean) * rstd * g1)); }
            EPI_FENCE; }
    }
};
struct EpiMixA {
    bf16_t* MIXP; const bf16_t* GA;
    __device__ __forceinline__ void operator()(Acc& acc, const Unit& u, int wr, int wc, int fr, int fq) const {
        asm volatile("" : "+v"(fr), "+v"(fq));
        const int cb = wc * 32 + fq * 8;
        EPI_LOOP { const size_t off = (size_t)(u.pm * 256 + EPI_ROW) * 2048 + u.pn * 256 + cb;
#pragma unroll
            for (int bj = 0; bj < 2; ++bj) { f32x4 g0, g1; unpack8(*(const u32x4*)(GA + off + bj * 128), g0, g1);
                *(u32x4*)(MIXP + off + bj * 128) = pack8(acc[ai][bj][m][0] * g0, acc[ai][bj][m][1] * g1); }
            EPI_FENCE; }
    }
};
struct EpiMixB {
    bf16_t* MIXIN; const bf16_t* MIXP; const bf16_t* GB;
    __device__ __forceinline__ void operator()(Acc& acc, const Unit& u, int wr, int wc, int fr, int fq) const {
        asm volatile("" : "+v"(fr), "+v"(fq));
        const int cb = wc * 32 + fq * 8;
        EPI_LOOP { const size_t off = (size_t)(u.pm * 256 + EPI_ROW) * 2048 + u.pn * 256 + cb;
#pragma unroll
            for (int bj = 0; bj < 2; ++bj) { f32x4 g0, g1, p0, p1; unpack8(*(const u32x4*)(GB + off + bj * 128), g0, g1); unpack8(*(const u32x4*)(MIXP + off + bj * 128), p0, p1);
                const f32x4 y0 = acc[ai][bj][m][0] * g0 + p0, y1 = acc[ai][bj][m][1] * g1 + p1;
                u32x2 w8; w8.x = pk4_fp8(y0[0], y0[1], y0[2], y0[3], M8_SCALE); w8.y = pk4_fp8(y1[0], y1[1], y1[2], y1[3], M8_SCALE); *(u32x2*)((unsigned char*)MIXIN + off + bj * 128) = w8; }
            EPI_FENCE; }
    }
};
struct EpiF32 {
    bf16_t* C;
    __device__ __forceinline__ void operator()(Acc& acc, const Unit& u, int wr, int wc, int fr, int fq) const {
        asm volatile("" : "+v"(fr), "+v"(fq));
        const int cb = wc * 32 + fq * 8;
        EPI_LOOP { bf16_t* base = C + (size_t)(u.pm * 256 + EPI_ROW) * 2048 + u.pn * 256 + cb;
#pragma unroll
            for (int bj = 0; bj < 2; ++bj) *(u32x4*)(base + bj * 128) = pack8(acc[ai][bj][m][0] * MX_UNSCALE, acc[ai][bj][m][1] * MX_UNSCALE); }
    }
};
struct EpiGU {
    bf16_t* ACT; const float* bgu; int skip;
    __device__ __forceinline__ void operator()(Acc& acc, const Unit& u, int wr, int wc, int fr, int fq) const {
        asm volatile("" : "+v"(fr), "+v"(fq));
        if (skip) return;
        const int cb = wc * 32 + fq * 8, col = u.pn * 128 + cb; const float* bg = bgu + (size_t)u.aux * 4096 + col;
        const f32x4 bg0 = *(const f32x4*)bg, bg1 = *(const f32x4*)(bg + 4), bu0 = *(const f32x4*)(bg + 2048), bu1 = *(const f32x4*)(bg + 2052);
        EPI_LOOP { f32x4 v[2];
#pragma unroll
            for (int n = 0; n < 2; ++n)
#pragma unroll
                for (int j = 0; j < 4; ++j) { const float gt = fminf(acc[ai][0][m][n][j] * GU_UNSCALE + (n ? bg1[j] : bg0[j]), 7.0f); const float up = fminf(fmaxf(acc[ai][1][m][n][j] * GU_UNSCALE + (n ? bu1[j] : bu0[j]), -7.0f), 7.0f);
                    v[n][j] = (up + 1.0f) * gt * sigmoidf_(1.702f * gt); }
            u32x2 w8; w8.x = pk4_fp8(v[0][0], v[0][1], v[0][2], v[0][3], A8_SCALE); w8.y = pk4_fp8(v[1][0], v[1][1], v[1][2], v[1][3], A8_SCALE);
            *(u32x2*)((unsigned char*)ACT + (size_t)(u.pm * 256 + EPI_ROW) * 2048 + col) = w8; EPI_FENCE; }
    }
};
struct EpiDown {
    bf16_t* YS; const float* bd;
    __device__ __forceinline__ void operator()(Acc& acc, const Unit& u, int wr, int wc, int fr, int fq) const {
        asm volatile("" : "+v"(fr), "+v"(fq));
        const int cb = wc * 32 + fq * 8; const float* bp = bd + (size_t)u.aux * 2048 + u.pn * 256 + cb;
        f32x4 bv[2][2];
#pragma unroll
        for (int bj = 0; bj < 2; ++bj) { bv[bj][0] = *(const f32x4*)(bp + bj * 128); bv[bj][1] = *(const f32x4*)(bp + bj * 128 + 4); }
        EPI_LOOP { bf16_t* base = YS + (size_t)(u.pm * 256 + EPI_ROW) * 2048 + u.pn * 256 + cb;
#pragma unroll
            for (int bj = 0; bj < 2; ++bj) *(u32x4*)(base + bj * 128) = pack8(acc[ai][bj][m][0] * DN_UNSCALE + bv[bj][0], acc[ai][bj][m][1] * DN_UNSCALE + bv[bj][1]); }
    }
};

namespace att {
constexpr int NW = 8, QBLK = 32, KVBLK = 64;
constexpr float THR = 8.f;
constexpr int SHM_V = KVBLK * 128 * 2, SHM_KN = KVBLK * 128 * 2, SHM_KR = KVBLK * 64 * 2, NVB = 3, SHM_ATTN = NVB * SHM_V + 2 * SHM_KN + 2 * SHM_KR + NW * 64 * 4;
#define KSWZ(row, colB) ((row) * 256 + ((colB) ^ (((row) & 15) << 4)))
#define KSWZR(row, colB) ((row) * 128 + ((colB) ^ ((((row) >> 1) & 7) << 4)))
#define SBAR() __builtin_amdgcn_sched_barrier(0)
__device__ __forceinline__ int crow(int r, int hi) { return (r & 3) + 8 * (r >> 2) + 4 * hi; }
__device__ __forceinline__ void partialSM(f32x16& p0, f32x16& p1, float& m_reg, float& mn, float& alpha) {
    constexpr float C = 1.4426950408889634f;
    float pmax = p0[0];
#pragma unroll
    for (int r = 1; r < 16; ++r) pmax = fmaxf(pmax, p0[r]);
#pragma unroll
    for (int r = 0; r < 16; ++r) pmax = fmaxf(pmax, p1[r]);
    { auto rr = __builtin_amdgcn_permlane32_swap(__float_as_uint(pmax), __float_as_uint(pmax), false, false);
      pmax = fmaxf(__uint_as_float(rr[0]), __uint_as_float(rr[1])); }
    if (__builtin_expect(__all(pmax - m_reg <= THR), 1)) { mn = m_reg; alpha = 1.f; }
    else { mn = fmaxf(m_reg, pmax); alpha = __builtin_amdgcn_exp2f((m_reg - mn) * C); m_reg = mn; }
    const float mnC = -mn * C;
#pragma unroll
    for (int r = 0; r < 16; ++r) p0[r] = fmaf(p0[r], C, mnC);
#pragma unroll
    for (int r = 0; r < 16; ++r) p1[r] = fmaf(p1[r], C, mnC);
#pragma unroll
    for (int r = 0; r < 16; ++r) p0[r] = __builtin_amdgcn_exp2f(p0[r]);
}
__device__ __forceinline__ void finishSM(f32x16& p0, f32x16& p1, float alpha, float& l_reg, bf16x8& pa0, bf16x8& pa1, bf16x8& pa2, bf16x8& pa3) {
#pragma unroll
    for (int r = 0; r < 16; ++r) p1[r] = __builtin_amdgcn_exp2f(p1[r]);
    float ps = 0;
#pragma unroll
    for (int r = 0; r < 16; ++r) ps += p0[r];
#pragma unroll
    for (int r = 0; r < 16; ++r) ps += p1[r];
    { auto rr = __builtin_amdgcn_permlane32_swap(__float_as_uint(ps), __float_as_uint(ps), false, false);
      ps = __uint_as_float(rr[0]) + __uint_as_float(rr[1]); }
    l_reg = l_reg * alpha + ps;
#define PK4(P, BASE, OUT) do { unsigned a0 = cvt_pk_bf16(P[BASE + 0], P[BASE + 1]), a1 = cvt_pk_bf16(P[BASE + 2], P[BASE + 3]);   \
    unsigned b0 = cvt_pk_bf16(P[BASE + 4], P[BASE + 5]), b1 = cvt_pk_bf16(P[BASE + 6], P[BASE + 7]);                              \
    auto r0 = __builtin_amdgcn_permlane32_swap(a0, b0, false, false); auto r1 = __builtin_amdgcn_permlane32_swap(a1, b1, false, false); \
    u32x4 w = {r0[0], r1[0], r0[1], r1[1]}; OUT = *reinterpret_cast<bf16x8*>(&w); } while (0)
    PK4(p0, 0, pa0); PK4(p0, 8, pa1); PK4(p1, 0, pa2); PK4(p1, 8, pa3);
#undef PK4
}
__device__ __forceinline__ void qkt(f32x16& p0, f32x16& p1, const char* Kns, const char* Krs, const bf16x8* qr, int r32, int hi) {
    p0 = f32x16{}; p1 = f32x16{};
#pragma unroll
    for (int d0 = 0; d0 < 12; ++d0) { const int cb = ((d0 & 7) * 16 + hi * 8) * 2;
        const bf16x8 b0 = *reinterpret_cast<const bf16x8*>(d0 < 8 ? Kns + KSWZ(r32, cb) : Krs + KSWZR(r32, cb));
        const bf16x8 b1 = *reinterpret_cast<const bf16x8*>(d0 < 8 ? Kns + KSWZ(32 + r32, cb) : Krs + KSWZR(32 + r32, cb));
        p0 = __builtin_amdgcn_mfma_f32_32x32x16_bf16(b0, qr[d0], p0, 0, 0, 0);
        p1 = __builtin_amdgcn_mfma_f32_32x32x16_bf16(b1, qr[d0], p1, 0, 0, 0); }
}
__device__ __forceinline__ int v_st(int k, int c) { const int kk = (k & ~0xC) | ((k & 4) << 1) | ((k & 8) >> 1); return ((kk >> 3) * 4 + (c >> 5)) * 512 + ((kk & 7) * 32 + (c & 31)) * 2; }
__device__ __forceinline__ int v_rd_base(int lane) { return ((lane & 3) << 3) | (((lane >> 2) & 3) << 6) | (((lane >> 4) & 1) << 5) | (((lane >> 5) & 1) << 8); }
constexpr int v_rd_off(int d0, int ks, int half) { return d0 * 512 + ks * 4096 + half * 2048; }
template <int OFF> __device__ __forceinline__ s16x4 tr_read(int vb) {
    s16x4 r; asm volatile("ds_read_b64_tr_b16 %0, %1 offset:%2" : "=&v"(r) : "v"(vb), "i"(OFF) : "memory"); return r;
}
template <int D0> __device__ __forceinline__ void pv_one(f32x16& od, int vb, bf16x8 pa0, bf16x8 pa1, bf16x8 pa2, bf16x8 pa3) {
    const s16x4 l0 = tr_read<v_rd_off(D0, 0, 0)>(vb), h0 = tr_read<v_rd_off(D0, 0, 1)>(vb), l1 = tr_read<v_rd_off(D0, 1, 0)>(vb), h1 = tr_read<v_rd_off(D0, 1, 1)>(vb);
    const s16x4 l2 = tr_read<v_rd_off(D0, 2, 0)>(vb), h2 = tr_read<v_rd_off(D0, 2, 1)>(vb), l3 = tr_read<v_rd_off(D0, 3, 0)>(vb), h3 = tr_read<v_rd_off(D0, 3, 1)>(vb);
    asm volatile("s_waitcnt lgkmcnt(0)" ::: "memory"); SBAR();
#define PKV(L, H) (bf16x8){L[0], L[1], L[2], L[3], H[0], H[1], H[2], H[3]}
    od = __builtin_amdgcn_mfma_f32_32x32x16_bf16(pa0, PKV(l0, h0), od, 0, 0, 0);
    od = __builtin_amdgcn_mfma_f32_32x32x16_bf16(pa1, PKV(l1, h1), od, 0, 0, 0);
    od = __builtin_amdgcn_mfma_f32_32x32x16_bf16(pa2, PKV(l2, h2), od, 0, 0, 0);
    od = __builtin_amdgcn_mfma_f32_32x32x16_bf16(pa3, PKV(l3, h3), od, 0, 0, 0);
#undef PKV
}
__device__ __forceinline__ void pv_d0(f32x16* o, int vb, bf16x8 pa0, bf16x8 pa1, bf16x8 pa2, bf16x8 pa3) {
    pv_one<0>(o[0], vb, pa0, pa1, pa2, pa3); pv_one<1>(o[1], vb, pa0, pa1, pa2, pa3); pv_one<2>(o[2], vb, pa0, pa1, pa2, pa3); pv_one<3>(o[3], vb, pa0, pa1, pa2, pa3);
}
__device__ __forceinline__ void attn_unit(const bf16_t* __restrict__ Qn, const bf16_t* __restrict__ Qr, const bf16_t* __restrict__ Kn, const bf16_t* __restrict__ Kr,
                                          const bf16_t* __restrict__ Vh, bf16_t* __restrict__ Ob, int seq, char* lds) {
    const int tid = threadIdx.x, wid = __builtin_amdgcn_readfirstlane(tid >> 6), lane = tid & 63, r32 = lane & 31, hi = lane >> 5;
    char* V_lds = lds; char* Kn_lds = lds + NVB * SHM_V; char* Kr_lds = Kn_lds + 2 * SHM_KN;
    float* ws = (float*)(Kr_lds + 2 * SHM_KR) + wid * 64; float* li_l = ws; float* al_l = ws + 32;
    float m_reg = -1e30f, l_reg = 0; f32x16 o[4] = {}; bf16x8 qr[12];
    { const bf16_t* q0 = Qn + (long)(wid * QBLK + r32) * 1024 + hi * 8; const bf16_t* q1 = Qr + (long)(wid * QBLK + r32) * 512 + hi * 8;
#pragma unroll
      for (int d0 = 0; d0 < 8; ++d0) qr[d0] = *reinterpret_cast<const bf16x8*>(q0 + d0 * 16);
#pragma unroll
      for (int d0 = 0; d0 < 4; ++d0) qr[8 + d0] = *reinterpret_cast<const bf16x8*>(q1 + d0 * 16); }
    const int vb0 = (int)(uintptr_t)V_lds + v_rd_base(lane);
    unsigned offV[2], offKn[2], offKr;
#pragma unroll
    for (int t = 0; t < 2; ++t) {
        { const int sub = 2 * (2 * wid + t) + (lane >> 5), kk = (sub >> 2) * 8 + ((lane & 31) >> 2), k = (kk & ~0xC) | ((kk & 4) << 1) | ((kk & 8) >> 1), c = (sub & 3) * 32 + (lane & 3) * 8; offV[t] = (unsigned)(k * 1024 + c) * 2u; }
        { const int row = 4 * (2 * wid + t) + (lane >> 4), colB = ((lane & 15) * 16) ^ ((row & 15) << 4); offKn[t] = (unsigned)(row * 1024) * 2u + (unsigned)colB; } }
    { const int row = 8 * wid + (lane >> 3), colB = ((lane & 7) * 16) ^ (((row >> 1) & 7) << 4); offKr = (unsigned)(row * 64) * 2u + (unsigned)colB; }
#define LASP(p) ((LAS unsigned*)(unsigned)(uintptr_t)(p))
#define SLOAD(k0, b, bv) do { _Pragma("unroll") for (int t = 0; t < 2; ++t) { \
        __builtin_amdgcn_global_load_lds((const unsigned*)((const char*)Vh + (size_t)(k0) * 2048 + offV[t]), LASP(V_lds + (bv) * SHM_V + (2 * wid + t) * 1024), 16, 0, 0); \
        __builtin_amdgcn_global_load_lds((const unsigned*)((const char*)Kn + (size_t)(k0) * 2048 + offKn[t]), LASP(Kn_lds + (b) * SHM_KN + (2 * wid + t) * 1024), 16, 0, 0); } \
        __builtin_amdgcn_global_load_lds((const unsigned*)((const char*)Kr + (size_t)(k0) * 128 + offKr), LASP(Kr_lds + (b) * SHM_KR + wid * 1024), 16, 0, 0); } while (0)
#define SWAIT() asm volatile("s_waitcnt vmcnt(0)" ::: "memory")
#define RESC(a) do { if (__any((a) < 1.f)) { if (hi == 0) al_l[r32] = (a); asm volatile("s_waitcnt lgkmcnt(0)" ::: "memory"); \
    _Pragma("unroll") for (int d = 0; d < 4; ++d) _Pragma("unroll") for (int r = 0; r < 16; ++r) o[d][r] *= al_l[crow(r, hi)]; } } while (0)
    f32x16 p0, p1; float mn, al; bf16x8 pa0, pa1, pa2, pa3; const int NT = seq / KVBLK;
    SLOAD(0, 0, 0); SWAIT(); __syncthreads();
    if (wid < 4) {
        int bv = 0;
        for (int j = 0; j < NT; ++j) {
            const int buf = j & 1, bvn = bv == NVB - 1 ? 0 : bv + 1;
            if (j + 1 < NT) SLOAD((j + 1) * KVBLK, buf ^ 1, bvn);
            SBAR(); qkt(p0, p1, Kn_lds + buf * SHM_KN, Kr_lds + buf * SHM_KR, qr, r32, hi);
            partialSM(p0, p1, m_reg, mn, al);
            RESC(al);
            finishSM(p0, p1, al, l_reg, pa0, pa1, pa2, pa3); SBAR();
            pv_d0(o, vb0 + bv * SHM_V, pa0, pa1, pa2, pa3);
            SWAIT();
            __syncthreads();
            bv = bvn;
        }
    } else {
        int bv = 0, bvp = 0;
        for (int j = 0; j < NT; ++j) {
            const int buf = j & 1, bvn = bv == NVB - 1 ? 0 : bv + 1;
            if (j + 1 < NT) SLOAD((j + 1) * KVBLK, buf ^ 1, bvn);
            if (j > 0) { SBAR(); pv_d0(o, vb0 + bvp * SHM_V, pa0, pa1, pa2, pa3); SBAR(); }
            SBAR(); qkt(p0, p1, Kn_lds + buf * SHM_KN, Kr_lds + buf * SHM_KR, qr, r32, hi);
            partialSM(p0, p1, m_reg, mn, al);
            RESC(al);
            finishSM(p0, p1, al, l_reg, pa0, pa1, pa2, pa3); SBAR();
            SWAIT();
            __syncthreads();
            bvp = bv; bv = bvn;
        }
        SBAR(); pv_d0(o, vb0 + bvp * SHM_V, pa0, pa1, pa2, pa3);
    }
    if (hi == 0) li_l[r32] = l_reg; asm volatile("s_waitcnt lgkmcnt(0)" ::: "memory");
    float rli[16];
#pragma unroll
    for (int r = 0; r < 16; ++r) rli[r] = __builtin_amdgcn_rcpf(li_l[crow(r, hi)]);
    bf16_t* Ow = Ob + (long)(wid * QBLK) * 1024;
#pragma unroll
    for (int r = 0; r < 16; ++r) { const int orow = crow(r, hi);
#pragma unroll
        for (int d0 = 0; d0 < 4; ++d0) Ow[(long)orow * 1024 + d0 * 32 + r32] = (bf16_t)(cvt_pk_bf16(o[d0][r] * rli[r], 0.f) & 0xffffu); }
#undef SLOAD
#undef LASP
#undef SWAIT
#undef RESC
}
}

struct Args { const float* in[26]; float* out; unsigned char* ws; int ph_lo, ph_hi; };
enum { PH_SETUP = 0, PH_H, PH_INPROJ, PH_INPROJ_V, PH_KT, PH_CHAIN, PH_MLAQ, PH_MLAKV, PH_GA, PH_ATTN, PH_GC, PH_MIXA, PH_GN, PH_MIXB, PH_MIX, PH_ROUTER, PH_DISPATCH, PH_GU, PH_DOWN, PH_COMBINE, NPH };
enum { I_X = 0, I_C, I_POS, I_WADA, I_BADA, I_GPREM, I_GPOSTM, I_GPREF, I_GPOSTF, I_WIN, I_QAN, I_WQB, I_KVAN, I_WKVB, I_WMLAO, I_DECF, I_DECB, I_RETGN, I_WRETO, I_WOUT, I_WROUTER, I_BROUTER, I_WGU, I_BGU, I_WDOWN, I_BDOWN };

__device__ __forceinline__ int src_in(int r) {
    if (r < 1024) return r;
    if (r < 1088) { const int j = r - 1024; return 1024 + (j >> 1) + 32 * (j & 1); }
    if (r < 1280) return -1;
    if (r < N_IN_NAT) { const int g = (r - 1280) >> 11, off = (r - 1280) & 2047; const int base = g == 0 ? 1088 : (g == 1 ? 3136 : (g == 2 ? 7232 : (g == 3 ? 9280 : 11328))); return base + off; }
    return 5184 + (r - N_IN_NAT);
}
__device__ __forceinline__ int src_qb(int r) { if (r < 1024) return (r >> 7) * 192 + (r & 127); const int j = r - 1024, h = j >> 6, jj = j & 63; return h * 192 + 128 + (jj >> 1) + 32 * (jj & 1); }
__device__ __forceinline__ int src_kvb(int r) { if (r < 1024) return (r >> 7) * 256 + (r & 127); const int j = r - 1024; return (j >> 7) * 256 + 128 + (j & 127); }
__device__ __forceinline__ int src_gu(int r) { const int t = r >> 8, rr = r & 255; return rr < 128 ? 128 * t + rr : 2048 + 128 * t + rr - 128; }

__device__ __forceinline__ void cvt_item(const float* __restrict__ W, int ldw, int K, bf16_t* __restrict__ WT, const float* __restrict__ kscale, int sc, int k0, int r0, LAS float* scr, int lane) {
    float v[64];
    const float* wp = W + (size_t)k0 * ldw + (sc >= 0 ? sc : 0);
#pragma unroll
    for (int i = 0; i < 64; ++i) v[i] = wp[(size_t)i * ldw];
    if (sc < 0) {
#pragma unroll
        for (int i = 0; i < 64; ++i) v[i] = 0.f;
    }
    if (kscale) {
#pragma unroll
        for (int i = 0; i < 64; ++i) v[i] *= kscale[k0 + i];
    }
#pragma unroll
    for (int i = 0; i < 64; ++i) scr[i * 65 + lane] = v[i];
    asm volatile("s_waitcnt lgkmcnt(0)" ::: "memory");
    const int c = lane & 7;
#pragma unroll
    for (int j = 0; j < 8; ++j) { const int n = (lane >> 3) + 8 * j; const LAS float* s = scr + (8 * c) * 65 + n;
        u32x4 o; o.x = cvt_pk_bf16(s[0 * 65], s[1 * 65]); o.y = cvt_pk_bf16(s[2 * 65], s[3 * 65]); o.z = cvt_pk_bf16(s[4 * 65], s[5 * 65]); o.w = cvt_pk_bf16(s[6 * 65], s[7 * 65]);
        *(u32x4*)(WT + (size_t)(r0 + n) * K + k0 + 8 * c) = o; }
    asm volatile("s_waitcnt lgkmcnt(0)" ::: "memory");
}

constexpr int XT_NT_GU = 32 * 16 * 16, XT_NT_ALL = XT_NT_GU + 32 * 16 * 8;
__device__ __forceinline__ void xt_convert_tiles(int q0, const int qs, const int qe, const float* __restrict__ wgu, const float* __restrict__ wdn, bf16_t* WT_GU, bf16_t* WT_DOWN, LAS unsigned char* lds, const int lane, const int wave) {
    constexpr int NT_GU = XT_NT_GU, TS = 144;
    f32x4 va[16], vb[16], vc[16];
#define XT_SRC(q_, kk_) ((q_) < NT_GU ? wgu + ((size_t)((q_) >> 8) * 2048 + (((q_) >> 4) & 15) * 128 + 16 * wave + (kk_)) * 4096 + (lane < 32 ? 128 * ((q_) & 15) + 4 * lane : 2048 + 128 * ((q_) & 15) + 4 * lane - 128) \
                                  : wdn + ((size_t)(((q_) - NT_GU) >> 7) * 2048 + ((((q_) - NT_GU) >> 3) & 15) * 128 + 16 * wave + (kk_)) * 2048 + 256 * (((q_) - NT_GU) & 7) + 4 * lane)
#define XT_LOAD(v_, q_) do { const float* _p = XT_SRC(q_, 0); const size_t _ld = (q_) < NT_GU ? 4096 : 2048; _Pragma("unroll") for (int kk = 0; kk < 16; ++kk) v_[kk] = __builtin_nontemporal_load((const f32x4*)(_p + kk * _ld)); } while (0)
#define XT_PROC(v_, q_, buf_) do { LAS unsigned char* _T = lds + (buf_) * (256 * TS); \
        _Pragma("unroll") for (int i = 0; i < 4; ++i) { u32x4 w0; \
            w0.x = pk4_fp8(v_[0][i], v_[1][i], v_[2][i], v_[3][i], W8_SCALE); w0.y = pk4_fp8(v_[4][i], v_[5][i], v_[6][i], v_[7][i], W8_SCALE); \
            w0.z = pk4_fp8(v_[8][i], v_[9][i], v_[10][i], v_[11][i], W8_SCALE); w0.w = pk4_fp8(v_[12][i], v_[13][i], v_[14][i], v_[15][i], W8_SCALE); \
            *(LAS u32x4*)(_T + (4 * lane + i) * TS + 16 * wave) = w0; } \
        __syncthreads(); \
        unsigned char* _d = (q_) < NT_GU ? (unsigned char*)WT_GU + ((size_t)((q_) >> 8) * 4096 + 256 * ((q_) & 15)) * 2048 + (((q_) >> 4) & 15) * 128 \
                 : (unsigned char*)WT_DOWN + ((size_t)(((q_) - NT_GU) >> 7) * 2048 + 256 * (((q_) - NT_GU) & 7)) * 2048 + ((((q_) - NT_GU) >> 3) & 15) * 128; \
        _Pragma("unroll") for (int j = 0; j < 4; ++j) { const int row = 32 * wave + 8 * j + (lane >> 3); \
            const u32x4 o = *(const LAS u32x4*)(_T + row * TS + (lane & 7) * 16); __builtin_nontemporal_store(o, (u32x4*)(_d + (size_t)row * 2048 + (lane & 7) * 16)); } } while (0)
    int q = q0;
    if (q < qe) XT_LOAD(va, q);
    if (q + qs < qe) XT_LOAD(vb, q + qs);
    while (q < qe) {
        const int q1 = q + qs, q2 = q1 + qs, q3 = q2 + qs, q4 = q3 + qs;
        if (q2 < qe) XT_LOAD(vc, q2);
        XT_PROC(va, q, 0);
        if (q1 >= qe) break;
        if (q3 < qe) XT_LOAD(va, q3);
        XT_PROC(vb, q1, 1);
        if (q2 >= qe) break;
        if (q4 < qe) XT_LOAD(vb, q4);
        XT_PROC(vc, q2, 2);
        q = q3;
    }
    __syncthreads();
#undef XT_SRC
#undef XT_LOAD
#undef XT_PROC
}
__host__ __device__ constexpr bool is_seam(int k) { return k == PH_SETUP || k == PH_H || k == PH_INPROJ_V || k == PH_KT || k == PH_GA || k == PH_ATTN || k == PH_MIXA || k == PH_MIXB || k == PH_MIX || k == PH_ROUTER || k == PH_DISPATCH || k == PH_GU || k == PH_DOWN; }
__host__ __device__ constexpr int seam_after(int ph) { int k = ph; while (k < NPH && !is_seam(k)) ++k; return k; }
__host__ __device__ constexpr int seam_before(int ph) { int k = ph - 1; while (k >= 0 && !is_seam(k)) --k; return k; }
__device__ __forceinline__ const void* larg(volatile LAS unsigned long long* L, int i) {
    const unsigned long long v = L[i]; const unsigned l0 = __builtin_amdgcn_readfirstlane((unsigned)v), h0 = __builtin_amdgcn_readfirstlane((unsigned)(v >> 32));
    return (const void*)(const __attribute__((address_space(1))) void*)(((unsigned long long)h0 << 32) | l0);
}
__global__ void __launch_bounds__(512, 2) fwd_kernel(Args args) {
    extern __shared__ __attribute__((aligned(16))) unsigned char lds_raw[];
    LAS unsigned char* lds = (LAS unsigned char*)lds_raw;
    volatile LAS unsigned* MISC = (volatile LAS unsigned*)(lds + MISC_OFF);
    const int tid = threadIdx.x;
    const int G = gridDim.x, bx = blockIdx.x, NGW = G * 8;
    volatile LAS unsigned long long* LARG = (volatile LAS unsigned long long*)(lds + LARG_OFF);
    const int lo = args.ph_lo, hi = args.ph_hi;
    for (int u = tid; u < (LDS_BYTES - CTRL_OFF) / 4; u += 512) ((LAS unsigned*)(lds + CTRL_OFF))[u] = 0u;
    __syncthreads();
    if (tid == 0) {
#pragma unroll
        for (int i = 0; i < 26; ++i) LARG[i] = (unsigned long long)args.in[i];
        LARG[26] = (unsigned long long)args.out; LARG[27] = (unsigned long long)args.ws;
    }
    __syncthreads();
    unsigned bar_x = 0u;
    if (hi - lo > 1) bar_x = xcd_barrier_post((unsigned*)(args.ws + WS_CTL) + CW_BAR, MISC + 8).x;
#ifdef PH_ONLY
#define IN(k) ((k) == PH_ONLY && lo <= (k) && (k) < hi)
#else
#define IN(k) (lo <= (k) && (k) < hi)
#endif
#define SEAM(k) do { if (lo <= (k) && (k) + 1 < hi) { XcdBarrier _b; _b.bar = (unsigned*)((unsigned char*)larg(LARG, 27) + WS_CTL) + CW_BAR; _b.x = bar_x; _b.st = MISC + 8; xcd_barrier(_b); } if (STAMP_PHASE >= 0) { const unsigned long long _t = __builtin_amdgcn_s_memrealtime(); if (seam_after(STAMP_PHASE) == (k)) st_dt = _t - st_t0; if (seam_before(STAMP_PHASE) == (k)) st_t0 = _t; } } while (0)
#define INP(i) ((const float*)larg(LARG, (i)))
#ifndef REP_PHASE
#define REP_PHASE (-1)
#endif
#define NREP(k) ((k) == REP_PHASE ? 2 : 1)
#ifndef STAMP_PHASE
#define STAMP_PHASE (-1)
#endif
#ifndef STAMP_MUL
#define STAMP_MUL 4
#endif
    unsigned long long st_t0 = (STAMP_PHASE >= 0 && seam_before(STAMP_PHASE) < 0) ? __builtin_amdgcn_s_memrealtime() : 0ull, st_dt = 0ull;
#define PTRS \
    int tid = threadIdx.x; asm volatile("" : "+v"(tid)); const int lane = tid & 63, wave = __builtin_amdgcn_readfirstlane(tid >> 6), gw = bx * 8 + wave; (void)lane; (void)gw; \
    unsigned char* const ws = (unsigned char*)larg(LARG, 27); unsigned* const ctl = (unsigned*)(ws + WS_CTL); float* const outp = (float*)larg(LARG, 26); \
    float* const ada = (float*)(ctl + CW_ADA); float* const SSQP = (float*)(ws + WS_SSQP); \
    bf16_t* const WT_IN = (bf16_t*)(ws + WS_WT_IN); bf16_t* const WT_QB = (bf16_t*)(ws + WS_WT_QB); bf16_t* const WT_KVB = (bf16_t*)(ws + WS_WT_KVB); bf16_t* const WT_MLAO = (bf16_t*)(ws + WS_WT_MLAO); \
    bf16_t* const WT_RETO = (bf16_t*)(ws + WS_WT_RETO); bf16_t* const WT_OUT = (bf16_t*)(ws + WS_WT_OUT); bf16_t* const WT_GU = (bf16_t*)(ws + WS_WT_GU); bf16_t* const WT_DOWN = (bf16_t*)(ws + WS_WT_DOWN); \
    float* const CS_RET = (float*)(ws + WS_CS_RET); float* const CS_MLA = (float*)(ws + WS_CS_MLA); \
    bf16_t* const Hb = (bf16_t*)(ws + WS_H); bf16_t* const QL = (bf16_t*)(ws + WS_QL); bf16_t* const CKV = (bf16_t*)(ws + WS_CKV); bf16_t* const KR = (bf16_t*)(ws + WS_KR); \
    bf16_t* const ACAT = (bf16_t*)(ws + WS_ACAT); bf16_t* const BCAT = (bf16_t*)(ws + WS_BCAT); bf16_t* const KROT = (bf16_t*)(ws + WS_KROT); bf16_t* const KZTF = (bf16_t*)(ws + WS_KZTF); bf16_t* const KZTB = (bf16_t*)(ws + WS_KZTB); \
    bf16_t* const SG = (bf16_t*)(ws + WS_SG); bf16_t* const GA = (bf16_t*)(ws + WS_GA); bf16_t* const GB = (bf16_t*)(ws + WS_GB); \
    bf16_t* const QN = (bf16_t*)(ws + WS_QN); bf16_t* const QR = (bf16_t*)(ws + WS_QR); bf16_t* const KN = (bf16_t*)(ws + WS_KN); bf16_t* const VV = (bf16_t*)(ws + WS_VV); bf16_t* const OA = (bf16_t*)(ws + WS_OA); \
    float* const ORET = (float*)(ws + WS_ORET); bf16_t* const OB = (bf16_t*)(ws + WS_OB); bf16_t* const MIXP = (bf16_t*)(ws + WS_MIXP); bf16_t* const MIXIN = (bf16_t*)(ws + WS_MIXIN); float* const MIX = (float*)(ws + WS_MIX); \
    bf16_t* const H2 = (bf16_t*)(ws + WS_H2); int* const TOPI = (int*)(ws + WS_TOPI); float* const TOPW = (float*)(ws + WS_TOPW); int* const DEST = (int*)(ws + WS_DEST); int* const TILE = (int*)(ws + WS_TILE); float* const DECTAB = (float*)(ws + WS_DECTAB); \
    bf16_t* const XS = (bf16_t*)(ws + WS_XS); bf16_t* const ACT = (bf16_t*)(ws + WS_ACT); bf16_t* const YS = (bf16_t*)(ws + WS_YS); \
    (void)ctl; (void)outp; (void)ada; (void)SSQP; (void)WT_IN; (void)WT_QB; (void)WT_KVB; (void)WT_MLAO; (void)WT_RETO; (void)WT_OUT; (void)WT_GU; (void)WT_DOWN; (void)CS_RET; (void)CS_MLA; (void)Hb; (void)QL; (void)CKV; (void)KR; \
    (void)ACAT; (void)BCAT; (void)KROT; (void)KZTF; (void)KZTB; (void)SG; (void)GA; (void)GB; (void)QN; (void)QR; (void)KN; (void)VV; (void)OA; (void)ORET; (void)OB; (void)MIXP; (void)MIXIN; (void)MIX; (void)H2; (void)TOPI; (void)TOPW; (void)DEST; (void)TILE; (void)DECTAB; (void)XS; (void)ACT; (void)YS;

    if (IN(PH_SETUP)) for (int rep = 0; rep < NREP(PH_SETUP); ++rep) {
        PTRS
        if (bx == 0 && tid < 16) DECTAB[tid] = log2_sigmoid(tid < 8 ? INP(I_DECF)[tid] : INP(I_DECB)[tid - 8]);
        {
            const float* wr = INP(I_WROUTER); float* wrt = (float*)(ws + WS_WRT);
            for (int o = bx * 512 + tid; o < 65536; o += G * 512) { const int i = o & 3, ln = (o >> 2) & 63, t = (o >> 8) & 1, st4 = (o >> 9) & 15, w = o >> 13;
                wrt[o] = wr[(size_t)(256 * w + 4 * (4 * st4 + i) + (ln >> 4)) * 32 + (ln & 15) + 16 * t]; }
        }
#ifndef SETUP_REP_ADA
#define SETUP_REP_ADA 1
#define SETUP_REP_TAB 1
#define SETUP_REP_CPY 1
#endif
        for (int r2 = 0; r2 < SETUP_REP_ADA; ++r2) {
            const float* wada = INP(I_WADA); const float* cvec = INP(I_C); float* adap = (float*)(ws + WS_ADAP);
            for (int it = gw; it < 192 * 8; it += NGW) {
                const int jb = it % 192, kp = it / 192, j = jb * 64 + lane;
                float a0 = 0.f, a1 = 0.f, a2 = 0.f, a3 = 0.f;
#pragma nounroll
                for (int k0 = kp * 256; k0 < kp * 256 + 256; k0 += 32) {
                    float w[32]; const float* wp = wada + (size_t)k0 * 12288 + j;
#pragma unroll
                    for (int i = 0; i < 32; ++i) { w[i] = __builtin_nontemporal_load(wp); wp += 12288; asm volatile("" : "+v"(wp)); }
#pragma unroll
                    for (int i = 0; i < 32; ++i) { a0 += w[i] * cvec[k0 + i]; a1 += w[i] * cvec[2048 + k0 + i]; a2 += w[i] * cvec[4096 + k0 + i]; a3 += w[i] * cvec[6144 + k0 + i]; }
                }
                float* o = adap + (size_t)kp * 49152 + j;
                o[0] = a0; o[12288] = a1; o[24576] = a2; o[36864] = a3;
            }
        }
        for (int r2 = 0; r2 < SETUP_REP_TAB; ++r2) {
            const int* pos = (const int*)INP(I_POS);
            for (int i = bx * 512 + tid; i < T * 160; i += G * 512) {
                const int tok = i / 160, f = i % 160; const float p = (float)pos[tok];
                float inv; float* dst;
                if (f < 128) { inv = 1.0f / powf(10000.0f, (float)f / 128.0f); dst = CS_RET + (size_t)tok * 256 + f * 2; }
                else { inv = 1.0f / powf(10000.0f, (float)(f - 128) / 32.0f); dst = CS_MLA + (size_t)tok * 64 + (f - 128) * 2; }
                float s, c; sincosf(p * inv, &s, &c); dst[0] = c; dst[1] = s;
            }
        }
        for (int r2 = 0; r2 < SETUP_REP_CPY; ++r2) {
            LAS float* scr = (LAS float*)(lds + wave * 16640);
            constexpr int I_IN = (N_IN_ALL / 64) * 32, I_QB = 24 * 8, I_KVB = 32 * 8, I_MLAO = 32 * 16, I_SQ = 32 * 32;
            constexpr int NITEMS = I_IN + I_QB + I_KVB + I_MLAO + 2 * I_SQ;
            unsigned* cq = ctl + CW_CVTQ + rep + 2 * r2;
#define CVT_GRAB(dst) do { unsigned _v = 0u; if (lane == 0) _v = atomicAdd(cq, 8u); dst = (int)__builtin_amdgcn_readfirstlane(_v); } while (0)
#define CVT_DEC(r_, wp_, dst_, ks_, ldw_, K_, sc_) do { int r = (r_); const float* W_; bf16_t* WT_; const float* kq_ = nullptr; int nkb_, mat_; \
                if (r < I_IN) { W_ = INP(I_WIN); WT_ = WT_IN; ldw_ = 13376; K_ = 2048; nkb_ = 32; mat_ = 2; } \
                else if ((r -= I_IN) < I_QB) { W_ = INP(I_WQB); WT_ = WT_QB; kq_ = INP(I_QAN); ldw_ = 1536; K_ = 512; nkb_ = 8; mat_ = 3; } \
                else if ((r -= I_QB) < I_KVB) { W_ = INP(I_WKVB); WT_ = WT_KVB; kq_ = INP(I_KVAN); ldw_ = 2048; K_ = 512; nkb_ = 8; mat_ = 4; } \
                else if ((r -= I_KVB) < I_MLAO) { W_ = INP(I_WMLAO); WT_ = WT_MLAO; ldw_ = 2048; K_ = 1024; nkb_ = 16; mat_ = 1; } \
                else if ((r -= I_MLAO) < I_SQ) { W_ = INP(I_WRETO); WT_ = WT_RETO; ldw_ = 2048; K_ = 2048; nkb_ = 32; mat_ = 1; } \
                else { r -= I_SQ; W_ = INP(I_WOUT); WT_ = WT_OUT; ldw_ = 2048; K_ = 2048; nkb_ = 32; mat_ = 5; } \
                const int q4_ = r >> 2, kb_ = q4_ % nkb_, nb_ = (q4_ / nkb_) * 4 + (r & 3), rr_ = nb_ * 64 + lane; \
                sc_ = ((mat_ == 1 || mat_ == 5) ? rr_ : (mat_ == 2 ? src_in(rr_) : (mat_ == 3 ? src_qb(rr_) : src_kvb(rr_)))); \
                wp_ = W_ + (size_t)(kb_ * 64) * ldw_ + (sc_ >= 0 ? sc_ : 0); dst_ = WT_ + (size_t)(nb_ * 64) * K_ + kb_ * 64; ks_ = kq_ ? kq_ + kb_ * 64 : nullptr; \
                if (mat_ == 5) { K_ = -1; dst_ = (bf16_t*)((unsigned char*)WT_ + (size_t)(nb_ * 64) * 2048 + kb_ * 64); }   \
                if (mat_ == 2 && nb_ >= 84 && nb_ < 180) { K_ = -1; dst_ = (bf16_t*)(ws + WS_WT8IN + (size_t)((nb_ - 84) * 64) * 2048 + kb_ * 64); } } while (0)
            float v[64];
            const float* wpc; bf16_t* dstc; const float* ksc; int ldwc, Kc, scc;
            const float* wpn = nullptr; bf16_t* dstn = nullptr; const float* ksn = nullptr; int ldwn = 0, Kn = 0, scn = 0;
            constexpr int QCH = 8; static_assert(NITEMS % QCH == 0, "queue chunk");
            int itc, itn, cend; CVT_GRAB(itc); itn = itc + 1; cend = itc + QCH;
            bool hc = itc < NITEMS;
            if (hc) { CVT_DEC(itc, wpc, dstc, ksc, ldwc, Kc, scc);
#pragma unroll
                for (int i = 0; i < 64; ++i) v[i] = __builtin_nontemporal_load(wpc + (size_t)i * ldwc); }
            while (hc) {
                const bool hn = itn < NITEMS;
                if (hn) CVT_DEC(itn, wpn, dstn, ksn, ldwn, Kn, scn);
                const bool need = (itn + 1 >= cend); unsigned raw_nn = 0u; if (need && lane == 0) raw_nn = atomicAdd(cq, (unsigned)QCH);
#pragma unroll
                for (int g = 0; g < 4; ++g) {
#pragma unroll
                    for (int i = 0; i < 16; ++i) { float x = scc >= 0 ? v[16 * g + i] : 0.f; if (ksc) x *= ksc[16 * g + i]; scr[(16 * g + i) * 65 + lane] = x; }
                    if (hn) {
#pragma unroll
                        for (int i = 0; i < 16; ++i) v[16 * g + i] = __builtin_nontemporal_load(wpn + (size_t)(16 * g + i) * ldwn); }
                }
                asm volatile("s_waitcnt lgkmcnt(0)" ::: "memory");
                const int c = lane & 7;
#pragma unroll
                for (int j = 0; j < 8; ++j) { const int n = (lane >> 3) + 8 * j; const LAS float* sp = scr + (8 * c) * 65 + n;
                    if (Kc < 0) { u32x2 o8; o8.x = pk4_fp8(sp[0 * 65], sp[1 * 65], sp[2 * 65], sp[3 * 65], W8_SCALE); o8.y = pk4_fp8(sp[4 * 65], sp[5 * 65], sp[6 * 65], sp[7 * 65], W8_SCALE);
                        *(u32x2*)((unsigned char*)dstc + (size_t)n * 2048 + 8 * c) = o8; }
                    else { u32x4 o; o.x = cvt_pk_bf16(sp[0 * 65], sp[1 * 65]); o.y = cvt_pk_bf16(sp[2 * 65], sp[3 * 65]); o.z = cvt_pk_bf16(sp[4 * 65], sp[5 * 65]); o.w = cvt_pk_bf16(sp[6 * 65], sp[7 * 65]);
                        __builtin_nontemporal_store(o, (u32x4*)(dstc + (size_t)n * Kc + 8 * c)); } }
                asm volatile("s_waitcnt lgkmcnt(0)" ::: "memory");
                wpc = wpn; dstc = dstn; ksc = ksn; ldwc = ldwn; Kc = Kn; scc = scn; hc = hn;
                if (need) { itn = (int)__builtin_amdgcn_readfirstlane(raw_nn); cend = itn + QCH; } else itn = itn + 1;
            }
#undef CVT_GRAB
#undef CVT_DEC
        }
    }
    SEAM(PH_SETUP);
    if (IN(PH_H)) for (int rep = 0; rep < NREP(PH_H); ++rep) {
        PTRS
        const float* g = INP(I_GPREM);
        {
            const float* adap = (const float*)(ws + WS_ADAP); const float* bada = INP(I_BADA); LAS float* AD = (LAS float*)lds;
            if (tid < 192) { const int idx = bx * 192 + tid; if (idx < 49152) { const int j = idx % 12288; float a = 0.f;
#pragma unroll
                for (int pq = 0; pq < 8; ++pq) a += adap[(size_t)pq * 49152 + idx];
                ada[idx] = a + bada[j]; } }
            for (int i = tid; i < 16384; i += 512) { const int b = i >> 12, col = i & 4095; float a = 0.f;
#pragma unroll
                for (int pq = 0; pq < 8; ++pq) a += adap[(size_t)pq * 49152 + b * 12288 + col];
                AD[i] = a + bada[col]; }
            __syncthreads();
        }
        const LAS float* AD = (const LAS float*)lds;
        f32x4 vn[8];
        if (gw < T) { const f32x4* xr = (const f32x4*)(INP(I_X) + (size_t)gw * D) + lane;
#pragma unroll
            for (int j = 0; j < 8; ++j) vn[j] = xr[64 * j]; }
        for (int mrow = gw; mrow < T; mrow += NGW) {
            const int b = mrow / SEQ;
            f32x4 v[8]; float s = 0.f;
#pragma unroll
            for (int j = 0; j < 8; ++j) { v[j] = vn[j]; s += (v[j][0] * v[j][0] + v[j][1] * v[j][1]) + (v[j][2] * v[j][2] + v[j][3] * v[j][3]); }
            if (mrow + NGW < T) { const f32x4* xr = (const f32x4*)(INP(I_X) + (size_t)(mrow + NGW) * D) + lane;
#pragma unroll
                for (int j = 0; j < 8; ++j) vn[j] = xr[64 * j]; }
            const float r = rsqrtf(wave_sum(s) * (1.0f / D) + RMS_EPS);
            u32x2* o8 = (u32x2*)(Hb + (size_t)mrow * D) + lane; unsigned* q8 = (unsigned*)(ws + WS_H8 + (size_t)mrow * D) + lane;
#pragma unroll
            for (int j = 0; j < 8; ++j) { const int col = 256 * j + 4 * lane; const f32x4 gg = *(const f32x4*)(g + col), sh = *(const LAS f32x4*)(AD + b * 4096 + col), sc = *(const LAS f32x4*)(AD + b * 4096 + 2048 + col);
                const f32x4 y = v[j] * r * gg * (sc + 1.0f) + sh; u32x2 w; w.x = cvt_pk_bf16(y[0], y[1]); w.y = cvt_pk_bf16(y[2], y[3]); o8[64 * j] = w; q8[64 * j] = pk4_fp8(y[0], y[1], y[2], y[3], H8_SCALE); }
        }
    }
    SEAM(PH_H);
    if (IN(PH_INPROJ)) for (int rep = 0; rep < NREP(PH_INPROJ); ++rep) {
        PTRS
        {   pg8::InprojSched S{(const char*)Hb, (const char*)WT_IN, G, bx};
            EpiInprojAll E{EpiInproj{QL, CKV, KR, ACAT, KROT, SG, GA, GB, SSQP, CS_RET, CS_MLA, DECTAB, 0, 1.0f}, EpiVT{BCAT, ws + WS_VT8}};
            pg8::gemm_phase(lds, 2048, 2048, 2048, S, E); }
        {
            pg8::GridSched S{(const char*)(ws + WS_H8), (const char*)(ws + WS_WT8IN), (size_t)256 * 2048, (size_t)256 * 2048, T / 256, 24, G, bx};
            EpiInproj E{QL, CKV, KR, ACAT, KROT, SG, GA, GB, SSQP, CS_RET, CS_MLA, DECTAB, 21, GU_UNSCALE};
            pg8::gemm_phase<EpiInproj, pg8::GridSched, true>(lds, 2048, 2048, 2048, S, E); }
    }
    SEAM(PH_INPROJ_V);
    if (IN(PH_KT)) for (int rep = 0; rep < NREP(PH_KT); ++rep) {
        PTRS
        {
            constexpr int TP = 528;
            u32x4 ra[16], rb[16];
#define KT_LOAD(r_, blk_) do { const bf16_t* _s = KROT + ((size_t)(blk_) * 256 + 32 * wave + 16 * (lane >> 5)) * 256 + 8 * (lane & 31); _Pragma("unroll") for (int i = 0; i < 16; ++i) r_[i] = *(const u32x4*)(_s + i * 256); } while (0)
#define KT_PROC(r_, blk_) do { const int _h = ((blk_) >> 4) & 7; const float _lf = DECTAB[_h], _lb = DECTAB[8 + _h]; \
                _Pragma("unroll") for (int e = 0; e < 8; ++e) { u32x4 w0, w1; \
                    _Pragma("unroll") for (int i2 = 0; i2 < 4; ++i2) { const unsigned a0 = r_[2 * i2][e >> 1], a1 = r_[2 * i2 + 1][e >> 1], c0 = r_[8 + 2 * i2][e >> 1], c1 = r_[8 + 2 * i2 + 1][e >> 1]; \
                        w0[i2] = (e & 1) ? ((a0 >> 16) | (a1 & 0xffff0000u)) : ((a0 & 0xffffu) | (a1 << 16)); w1[i2] = (e & 1) ? ((c0 >> 16) | (c1 & 0xffff0000u)) : ((c0 & 0xffffu) | (c1 << 16)); } \
                    LAS unsigned char* _t = lds + (8 * (lane & 31) + e) * TP + (32 * wave + 16 * (lane >> 5)) * 2; *(LAS u32x4*)_t = w0; *(LAS u32x4*)(_t + 16) = w1; } \
                __syncthreads(); \
                f32x4 zf0, zf1, zb0, zb1; \
                _Pragma("unroll") for (int t = 0; t < 4; ++t) { const int p0 = 8 * (lane & 31) + t, p1 = p0 + 4; \
                    zf0[t] = __builtin_amdgcn_exp2f((float)(255 - p0) * _lf); zf1[t] = __builtin_amdgcn_exp2f((float)(255 - p1) * _lf); zb0[t] = __builtin_amdgcn_exp2f((float)p0 * _lb); zb1[t] = __builtin_amdgcn_exp2f((float)p1 * _lb); } \
                _Pragma("unroll") for (int j = 0; j < 16; ++j) { const int row = 32 * wave + 2 * j + (lane >> 5); \
                    const u32x4 w = *(const LAS u32x4*)(lds + row * TP + (lane & 31) * 16); f32x4 x0, x1; unpack8(w, x0, x1); \
                    const size_t o = ((size_t)(blk_) * 256 + row) * 256 + 8 * (lane & 31); \
                    const f32x4 f0 = x0 * zf0, f1 = x1 * zf1, g0 = x0 * zb0, g1 = x1 * zb1; u32x2 wf, wb; \
                    wf.x = pk4_fp8(f0[0], f0[1], f0[2], f0[3], K8_SCALE); wf.y = pk4_fp8(f1[0], f1[1], f1[2], f1[3], K8_SCALE); wb.x = pk4_fp8(g0[0], g0[1], g0[2], g0[3], K8_SCALE); wb.y = pk4_fp8(g1[0], g1[1], g1[2], g1[3], K8_SCALE); \
                    *(u32x2*)((unsigned char*)KZTF + o) = wf; *(u32x2*)((unsigned char*)KZTB + o) = wb; } \
                __syncthreads(); } while (0)
            int blk = bx;
            if (blk < NBLK) KT_LOAD(ra, blk);
            while (blk < NBLK) {
                const int b1 = blk + G; if (b1 < NBLK) KT_LOAD(rb, b1);
                KT_PROC(ra, blk);
                if (b1 >= NBLK) break;
                const int b2 = b1 + G; if (b2 < NBLK) KT_LOAD(ra, b2);
                KT_PROC(rb, b1);
                blk = b2;
            }
#undef KT_LOAD
#undef KT_PROC
        }
    }
    SEAM(PH_KT);
    if (IN(PH_CHAIN)) for (int rep = 0; rep < NREP(PH_CHAIN); ++rep) {
        PTRS
        if (bx < 64) {
            const int bh = bx >> 1, dir = bx & 1;
            {
                const int blk0 = bh * NCH + (dir ? NCH - 1 : 0);
                bf16_t* z = BCAT + ((size_t)blk0 * 256 + (tid >> 1)) * 768 + 256 + 256 * dir + (tid & 1) * 128;
#pragma unroll
                for (int q = 0; q < 16; ++q) *(u32x4*)(z + q * 8) = (u32x4){0u, 0u, 0u, 0u};
            }
            pg8::ChainSched S{(const char*)(ws + WS_VT8), (const char*)(dir ? KZTB : KZTF), bh, dir};
            EpiGb E{BCAT, DECTAB, dir};
            pg8::gemm_phase<EpiGb, pg8::ChainSched, true, true>(lds, 256, 256, 256, S, E);
        }
    }
    if (IN(PH_MLAQ)) for (int rep = 0; rep < NREP(PH_MLAQ); ++rep) {
        PTRS
        if (bx >= 64) { const bool ca = bx < 128;
            pg8::GridSchedR S{(const char*)QL, (const char*)WT_QB, (size_t)256 * 512 * 2, (size_t)256 * 512 * 2, T / 256, 6, ca ? 64 : 128, ca ? bx - 64 : bx - 128, ca ? 0 : 128, ca ? 128 : 384};
            EpiMlaQ E{QN, QR, SSQP, CS_MLA}; pg8::gemm_phase(lds, 512, 512, 512, S, E); }
    }
    if (IN(PH_MLAKV)) for (int rep = 0; rep < NREP(PH_MLAKV); ++rep) {
        PTRS
        if (bx >= 128) {
            pg8::GridSchedR S{(const char*)CKV, (const char*)WT_KVB, (size_t)256 * 512 * 2, (size_t)256 * 512 * 2, T / 256, 8, 128, bx - 128, 0, 512};
            EpiMlaKV E{KN, VV, SSQP + (size_t)8 * T}; pg8::gemm_phase(lds, 512, 512, 512, S, E); }
    }
    if (IN(PH_GA)) for (int rep = 0; rep < NREP(PH_GA); ++rep) {
        PTRS
        if (bx >= 64) { const bool ca = bx < 128;
        {   pg8::BatchSchedR S{(const char*)(ACAT + 256), (const char*)KROT, (size_t)256 * 768 * 2, (size_t)256 * 256 * 2, ca ? 64 : 128, ca ? bx - 64 : bx - 128, ca ? 0 : 256, ca ? 256 : 512};
            EpiGa E{ACAT, DECTAB}; pg8::gemm_phase(lds, 256, 768, 256, S, E); }
        if (ca) {
            pg8::GridSchedR S{(const char*)Hb, (const char*)(WT_IN + (size_t)4 * 256 * 2048), (size_t)256 * 2048 * 2, (size_t)256 * 2048 * 2, T / 256, 1, 64, bx - 64, 0, 64};
            EpiInproj E{QL, CKV, KR, ACAT, KROT, SG, GA, GB, SSQP, CS_RET, CS_MLA, DECTAB, 4, 1.0f}; pg8::gemm_phase(lds, 2048, 2048, 2048, S, E); }
        }
    }
    SEAM(PH_GA);
    if (IN(PH_ATTN)) for (int rep = 0; rep < NREP(PH_ATTN); ++rep) {
        PTRS
        unsigned* queue = ctl + CW_QUEUE + rep; unsigned* cqueue = ctl + CW_QUEUE + 8;
        const float* wgu = INP(I_WGU); const float* wdn = INP(I_WDOWN);
#define CONV_LOOP() do { if (rep == 0) for (;;) { __syncthreads(); if (tid == 0) MISC[1] = atomicAdd(cqueue, 1u); __syncthreads(); const int c = (int)MISC[1]; if (c >= 1536) break; \
            xt_convert_tiles(c * 8, 1, c * 8 + 8, wgu, wdn, WT_GU, WT_DOWN, lds, lane, wave); } } while (0)
        if (bx < CONV_WGS) CONV_LOOP();
        int xq = (int)(xb_xcc_id() & 7u), tries = 0;
        for (;;) {
            __syncthreads();
            if (tid == 0) { int a = -1;
                while (tries < 8) { const unsigned v = atomicAdd(ctl + CW_AQ + 64 * xq + rep, 1u); if (v < 64u) { a = xq * 64 + (int)v; break; } xq = (xq + 1) & 7; ++tries; }
                MISC[0] = (unsigned)a; }
            __syncthreads();
            const int a = (int)MISC[0];
            if (a < 0) break;
            const int bh = a >> 4, qb = a & 15, b = bh >> 3, h = bh & 7;
            const size_t tok0 = (size_t)b * SEQ + qb * 256, kt0 = (size_t)b * SEQ;
            att::attn_unit(QN + tok0 * 1024 + h * 128, QR + tok0 * 512 + h * 64, KN + kt0 * 1024 + h * 128, KR + kt0 * 64, VV + kt0 * 1024 + h * 128, OA + tok0 * 1024 + h * 128, SEQ, (char*)lds_raw);
        }
        if (bx >= CONV_WGS) CONV_LOOP();
#undef CONV_LOOP
    }
    SEAM(PH_ATTN);
    if (IN(PH_GC)) for (int rep = 0; rep < NREP(PH_GC); ++rep) {
        PTRS
        {   pg8::BatchSched S{(const char*)ACAT, (const char*)BCAT, (size_t)256 * 768 * 2, (size_t)256 * 768 * 2, NBLK, G, bx};
            EpiGc E{OB, SG, INP(I_RETGN), lds}; pg8::gemm_phase(lds, 768, 768, 768, S, E); }
    }
    if (IN(PH_MIXA)) for (int rep = 0; rep < NREP(PH_MIXA); ++rep) {
        PTRS
        {   pg8::GridSched S{(const char*)OA, (const char*)WT_MLAO, (size_t)256 * 1024 * 2, (size_t)256 * 1024 * 2, T / 256, 8, G, bx};
            EpiMixA E{MIXP, GA}; pg8::gemm_phase(lds, 1024, 1024, 1024, S, E); }
    }
    SEAM(PH_MIXA);
    if (IN(PH_MIXB)) for (int rep = 0; rep < NREP(PH_MIXB); ++rep) {
        PTRS
        pg8::GridSched S{(const char*)OB, (const char*)WT_RETO, (size_t)256 * 2048 * 2, (size_t)256 * 2048 * 2, T / 256, 8, G, bx};
        EpiMixB E{MIXIN, MIXP, GB}; pg8::gemm_phase(lds, 2048, 2048, 2048, S, E);
    }
    SEAM(PH_MIXB);
    if (IN(PH_MIX)) for (int rep = 0; rep < NREP(PH_MIX); ++rep) {
        PTRS
        pg8::GridSched S{(const char*)MIXIN, (const char*)WT_OUT, (size_t)256 * 2048, (size_t)256 * 2048, T / 256, 8, G, bx};
        EpiF32 E{(bf16_t*)MIX}; pg8::gemm_phase<EpiF32, pg8::GridSched, true>(lds, 2048, 2048, 2048, S, E);
    }
    SEAM(PH_MIX);
    if (IN(PH_ROUTER)) for (int rep = 0; rep < NREP(PH_ROUTER); ++rep) {
        PTRS
        const float* gpm = INP(I_GPOSTM); const float* gpf = INP(I_GPREF); const float* brt = INP(I_BROUTER);
        LAS float* HROW = (LAS float*)lds;
        LAS float* PART = (LAS float*)(lds + 16 * 2052 * 4);
        unsigned* counts = ctl + CW_COUNTS;
        volatile LAS unsigned* lhist = MISC + 64;
        if (tid < 32) lhist[tid] = 0u;
        __syncthreads();
        f32x4 vA[8], vB[8], xA[8], xB[8]; u32x2 mA[8], mB[8];
#define RT_LOAD(base_) do { const int _m = (base_) + 2 * wave; const u32x2* _mr = (const u32x2*)((const bf16_t*)MIX + (size_t)_m * D) + lane; const f32x4* _xr = (const f32x4*)(INP(I_X) + (size_t)_m * D) + lane; \
            _Pragma("unroll") for (int j = 0; j < 8; ++j) { mA[j] = _mr[64 * j]; mB[j] = _mr[64 * j + 512]; xA[j] = _xr[64 * j]; xB[j] = _xr[64 * j + 512]; } } while (0)
#define RT_PART3(base_) do { _Pragma("nounroll") for (int q = 0; q < 2; ++q) { \
                const int rr = 2 * wave + q, mrow = (base_) + rr; \
                float lg = 0.f; \
                if (lane < 32) { _Pragma("unroll") for (int w2 = 0; w2 < 8; ++w2) lg += PART[w2 * 512 + rr * 32 + lane]; lg += brt[lane]; } \
                float val = lane < 32 ? lg : -3.0e38f; float tv[4]; int ti[4]; \
                _Pragma("unroll") for (int r = 0; r < 4; ++r) { float bv = val; int bi = lane; \
                    _Pragma("unroll") for (int o = 32; o >= 1; o >>= 1) { const float ov = __shfl_xor(bv, o); const int oi = __shfl_xor(bi, o); if (ov > bv || (ov == bv && oi < bi)) { bv = ov; bi = oi; } } \
                    tv[r] = bv; ti[r] = bi; if (lane == bi) val = -3.0e38f; } \
                const float e1 = __expf(tv[1] - tv[0]), e2 = __expf(tv[2] - tv[0]), e3 = __expf(tv[3] - tv[0]); const float inv = 1.0f / (1.0f + e1 + e2 + e3); \
                if (lane < 4) { const int id = lane == 0 ? ti[0] : (lane == 1 ? ti[1] : (lane == 2 ? ti[2] : ti[3])); const float wv = (lane == 0 ? 1.0f : (lane == 1 ? e1 : (lane == 2 ? e2 : e3))) * inv; \
                    TOPI[mrow * 4 + lane] = id; TOPW[mrow * 4 + lane] = wv; if (rep == 0) __hip_atomic_fetch_add((LAS unsigned*)(lhist + id), 1u, __ATOMIC_RELAXED, __HIP_MEMORY_SCOPE_WORKGROUP); } } } while (0)
        if (bx * 16 < T) RT_LOAD(bx * 16);
        int pbase = -1;
        for (int base = bx * 16; base < T; base += G * 16) {
            {
                const int rrA = 2 * wave, mrowA = base + rrA;
                const int b = mrowA / SEQ; const float* ad = ada + b * 12288;
                float sA = 0.f, sB = 0.f;
#pragma unroll
                for (int j = 0; j < 8; ++j) { vA[j] = (f32x4){bf_lo(mA[j].x), bf_hi(mA[j].x), bf_lo(mA[j].y), bf_hi(mA[j].y)}; vB[j] = (f32x4){bf_lo(mB[j].x), bf_hi(mB[j].x), bf_lo(mB[j].y), bf_hi(mB[j].y)}; }
#pragma unroll
                for (int j = 0; j < 8; ++j) { sA += (vA[j][0] * vA[j][0] + vA[j][1] * vA[j][1]) + (vA[j][2] * vA[j][2] + vA[j][3] * vA[j][3]); sB += (vB[j][0] * vB[j][0] + vB[j][1] * vB[j][1]) + (vB[j][2] * vB[j][2] + vB[j][3] * vB[j][3]); }
#pragma unroll
                for (int o = 1; o < 64; o <<= 1) { sA += __shfl_xor(sA, o); sB += __shfl_xor(sB, o); }
                const float r1A = rsqrtf(sA * (1.0f / D) + RMS_EPS), r1B = rsqrtf(sB * (1.0f / D) + RMS_EPS); float tA = 0.f, tB = 0.f;
#pragma unroll
                for (int j = 0; j < 8; ++j) { const int col = 256 * j + 4 * lane; const f32x4 gg = *(const f32x4*)(gpm + col), gm = *(const f32x4*)(ad + 4096 + col);
                    vA[j] = xA[j] + gm * (vA[j] * r1A * gg); vB[j] = xB[j] + gm * (vB[j] * r1B * gg);
                    { u32x2 wa, wb; wa.x = cvt_pk_bf16(vA[j][0], vA[j][1]); wa.y = cvt_pk_bf16(vA[j][2], vA[j][3]); wb.x = cvt_pk_bf16(vB[j][0], vB[j][1]); wb.y = cvt_pk_bf16(vB[j][2], vB[j][3]); mA[j] = wa; mB[j] = wb; }
                    tA += (vA[j][0] * vA[j][0] + vA[j][1] * vA[j][1]) + (vA[j][2] * vA[j][2] + vA[j][3] * vA[j][3]); tB += (vB[j][0] * vB[j][0] + vB[j][1] * vB[j][1]) + (vB[j][2] * vB[j][2] + vB[j][3] * vB[j][3]); asm volatile("" ::: "memory"); }
#pragma unroll
                for (int o = 1; o < 64; o <<= 1) { tA += __shfl_xor(tA, o); tB += __shfl_xor(tB, o); }
                const float r2A = rsqrtf(tA * (1.0f / D) + RMS_EPS), r2B = rsqrtf(tB * (1.0f / D) + RMS_EPS);
                unsigned hpA[8], hpB[8];
#pragma unroll
                for (int j = 0; j < 8; ++j) { const int col = 256 * j + 4 * lane; const f32x4 gg = *(const f32x4*)(gpf + col), sh = *(const f32x4*)(ad + 6144 + col), sc = *(const f32x4*)(ad + 8192 + col);
                    const f32x4 hA = vA[j] * r2A * gg * (sc + 1.0f) + sh, hB = vB[j] * r2B * gg * (sc + 1.0f) + sh;
                    hpA[j] = pk4_fp8(hA[0], hA[1], hA[2], hA[3], H8_SCALE); hpB[j] = pk4_fp8(hB[0], hB[1], hB[2], hB[3], H8_SCALE);
                    *(LAS f32x4*)(HROW + rrA * 2052 + col) = hA; *(LAS f32x4*)(HROW + (rrA + 1) * 2052 + col) = hB; asm volatile("" ::: "memory"); }
                u32x2 sxA[8], sxB[8];
#pragma unroll
                for (int j = 0; j < 8; ++j) { sxA[j] = mA[j]; sxB[j] = mB[j]; }
                if (base + G * 16 < T) RT_LOAD(base + G * 16);
                asm volatile("" ::: "memory");
                u32x2* o4 = (u32x2*)((bf16_t*)(ws + WS_X1B) + (size_t)mrowA * D) + lane; unsigned* h8 = (unsigned*)((unsigned char*)H2 + (size_t)mrowA * D) + lane;
#pragma unroll
                for (int j = 0; j < 8; ++j) { o4[64 * j] = sxA[j]; o4[64 * j + 512] = sxB[j]; h8[64 * j] = hpA[j]; h8[64 * j + 512] = hpB[j]; }
            }
            __syncthreads();
            if (pbase >= 0) RT_PART3(pbase);
            __syncthreads();
            {   f32x4 c0 = (f32x4){0.f, 0.f, 0.f, 0.f}, c1 = (f32x4){0.f, 0.f, 0.f, 0.f};
                const LAS float* ap = HROW + (lane & 15) * 2052 + 256 * wave + (lane >> 4);
                const f32x4* wq = (const f32x4*)(ws + WS_WRT) + (size_t)wave * 2048 + lane;
#pragma unroll 4
                for (int st4 = 0; st4 < 16; ++st4) { const f32x4 b0 = wq[st4 * 128], b1 = wq[st4 * 128 + 64];
#pragma unroll
                    for (int i = 0; i < 4; ++i) { const float a = ap[4 * (4 * st4 + i)]; c0 = __builtin_amdgcn_mfma_f32_16x16x4f32(a, b0[i], c0, 0, 0, 0); c1 = __builtin_amdgcn_mfma_f32_16x16x4f32(a, b1[i], c1, 0, 0, 0); } }
                LAS float* pp = PART + wave * 512 + (4 * (lane >> 4)) * 32 + (lane & 15);
#pragma unroll
                for (int r = 0; r < 4; ++r) { pp[r * 32] = c0[r]; pp[r * 32 + 16] = c1[r]; }
            }
            __syncthreads();
            pbase = base;
        }
        if (pbase >= 0) RT_PART3(pbase);
        __syncthreads();
#undef RT_LOAD
#undef RT_PART3
        if (tid < 32 && rep == 0) { const unsigned c = lhist[tid]; if (c) atomicAdd(counts + 64 * tid, c); }
    }
    SEAM(PH_ROUTER);
    if (IN(PH_DISPATCH)) for (int rep = 0; rep < NREP(PH_DISPATCH); ++rep) {
        PTRS
        unsigned* counts = ctl + CW_COUNTS; unsigned* cursor = ctl + CW_CURSOR;
        volatile LAS unsigned* lhist = MISC + 64; volatile LAS unsigned* lbase = MISC + 96;
        if (tid < 32) lhist[tid] = 0u;
        int pst = 0, pend = 0;
        { const int cnt = lane < 32 ? (int)__hip_atomic_load(counts + 64 * lane, __ATOMIC_RELAXED, __HIP_MEMORY_SCOPE_AGENT) : 0; const int pad = (cnt + 255) & ~255; int inc = pad;
#pragma unroll
          for (int o = 1; o < 32; o <<= 1) { const int t = __shfl_up(inc, o); if ((lane & 31) >= o) inc += t; }
          pend = inc; pst = inc - pad; }
        if (gw == 0) {
            const int ntiles = __shfl(pend, 31) >> 8; if (lane == 0) TILE[0] = ntiles;
            for (int t = lane; t < PMAX / 256; t += 64) { int e = 0;
                for (int q = 0; q < 32; ++q) { const int pe = __shfl(pend, q); e += (pe <= t * 256) ? 1 : 0; }
                TILE[16 + t] = e < 31 ? e : 31; }
        }
        __syncthreads();
        int eid[8], loc[8];
#pragma unroll
        for (int i = 0; i < 8; ++i) { const int mrow = gw + NGW * i; eid[i] = 0; loc[i] = 0;
            if (mrow < T && lane < 4) { eid[i] = TOPI[mrow * 4 + lane]; loc[i] = (int)__hip_atomic_fetch_add((LAS unsigned*)(lhist + eid[i]), 1u, __ATOMIC_RELAXED, __HIP_MEMORY_SCOPE_WORKGROUP); } }
        __syncthreads();
        if (tid < 32) { const unsigned c = lhist[tid]; lbase[tid] = (unsigned)pst + (c ? atomicAdd(cursor + 64 * tid, c) : 0u); }
        __syncthreads();
#pragma unroll
        for (int i = 0; i < 8; ++i) { const int mrow = gw + NGW * i;
            if (mrow < T) {
                int slot = 0;
                if (lane < 4) { slot = (int)lbase[eid[i]] + loc[i]; DEST[mrow * 4 + lane] = slot; }
                const u32x4* src = (const u32x4*)((const unsigned char*)H2 + (size_t)mrow * D) + lane; u32x4 rw[2];
#pragma unroll
                for (int q = 0; q < 2; ++q) rw[q] = src[64 * q];
#pragma unroll
                for (int k = 0; k < 4; ++k) { const int sl = __shfl(slot, k); u32x4* dst = (u32x4*)((unsigned char*)XS + (size_t)sl * D) + lane;
#pragma unroll
                    for (int q = 0; q < 2; ++q) dst[64 * q] = rw[q]; } } }
    }
    SEAM(PH_DISPATCH);
    if (IN(PH_GU)) for (int rep = 0; rep < NREP(PH_GU); ++rep) {
        PTRS
        const int ntiles = __builtin_amdgcn_readfirstlane(TILE[0]);
        pg8::MoeSched S{(const char*)XS, (const char*)WT_GU, TILE + 16, ntiles, 16, G, bx};
        EpiGU E{ACT, INP(I_BGU), rep}; pg8::gemm_phase<EpiGU, pg8::MoeSched, true>(lds, 2048, 2048, 2048, S, E);
    }
    SEAM(PH_GU);
    if (IN(PH_DOWN)) for (int rep = 0; rep < NREP(PH_DOWN); ++rep) {
        PTRS
        const int ntiles = __builtin_amdgcn_readfirstlane(TILE[0]);
        pg8::MoeSched S{(const char*)ACT, (const char*)WT_DOWN, TILE + 16, ntiles, 8, G, bx};
        EpiDown E{YS, INP(I_BDOWN)}; pg8::gemm_phase<EpiDown, pg8::MoeSched, true>(lds, 2048, 2048, 2048, S, E);
    }
    SEAM(PH_DOWN);
    if (IN(PH_COMBINE)) for (int rep = 0; rep < NREP(PH_COMBINE); ++rep) {
        PTRS
        const float* gpo = INP(I_GPOSTF);
        for (int mrow = gw; mrow < T; mrow += NGW) {
            const int b = mrow / SEQ; const float* ad = ada + b * 12288;
            int dk[4]; float wk[4];
#pragma unroll
            for (int k = 0; k < 4; ++k) { dk[k] = DEST[mrow * 4 + k]; wk[k] = TOPW[mrow * 4 + k]; }
            f32x4 f[8]; float s = 0.f;
#pragma unroll
            for (int j = 0; j < 8; ++j) f[j] = (f32x4){0.f, 0.f, 0.f, 0.f};
#pragma unroll
            for (int k = 0; k < 4; ++k) { const u32x2* yr = (const u32x2*)(YS + (size_t)dk[k] * D) + lane;
#pragma unroll
                for (int j = 0; j < 8; ++j) { const u32x2 w = yr[64 * j]; f[j] += (f32x4){bf_lo(w.x), bf_hi(w.x), bf_lo(w.y), bf_hi(w.y)} * wk[k]; } }
#pragma unroll
            for (int j = 0; j < 8; ++j) s += (f[j][0] * f[j][0] + f[j][1] * f[j][1]) + (f[j][2] * f[j][2] + f[j][3] * f[j][3]);
            const float r = rsqrtf(wave_sum(s) * (1.0f / D) + RMS_EPS);
            f32x4* o4 = (f32x4*)(outp + (size_t)mrow * D) + lane; const u32x2* x1 = (const u32x2*)((const bf16_t*)(ws + WS_X1B) + (size_t)mrow * D) + lane;
#pragma unroll
            for (int j = 0; j < 8; ++j) { const int col = 256 * j + 4 * lane; const f32x4 gg = *(const f32x4*)(gpo + col), gf = *(const f32x4*)(ad + 10240 + col); const u32x2 xw = x1[64 * j];
                o4[64 * j] = (f32x4){bf_lo(xw.x), bf_hi(xw.x), bf_lo(xw.y), bf_hi(xw.y)} + gf * (f[j] * r * gg); }
        }
    }
    if (STAMP_PHASE >= 0 && bx == 0) {
        if (seam_after(STAMP_PHASE) >= NPH) st_dt = __builtin_amdgcn_s_memrealtime() - st_t0;
        const unsigned long long t1 = __builtin_amdgcn_s_memrealtime();
        while (__builtin_amdgcn_s_memrealtime() - t1 < st_dt * STAMP_MUL) __builtin_amdgcn_s_sleep(8);
    }
#undef IN
#undef SEAM
}

extern "C" void kernel_launch(void* const* d_in, const int* in_sizes, int n_in, void* d_out, int out_size, void* d_ws, size_t ws_size, hipStream_t stream) {
    static int grid = 0;
    if (grid == 0) {
        if (n_in != 26 || out_size != T * D || ws_size < WS_END) { fprintf(stderr, "kernel_launch: unexpected shapes: n_in %d out %d ws %zu (need %zu)\n", n_in, out_size, ws_size, (size_t)WS_END); grid = -1; return; }
        int dev = 0, cus = 0, per_cu = 0;
        if (hipGetDevice(&dev) != hipSuccess || hipDeviceGetAttribute(&cus, hipDeviceAttributeMultiprocessorCount, dev) != hipSuccess) { grid = -1; return; }
        if (hipFuncSetAttribute((const void*)fwd_kernel, hipFuncAttributeMaxDynamicSharedMemorySize, LDS_BYTES) != hipSuccess) { fprintf(stderr, "kernel_launch: hipFuncSetAttribute failed\n"); grid = -1; return; }
        if (hipOccupancyMaxActiveBlocksPerMultiprocessor(&per_cu, (const void*)fwd_kernel, 512, LDS_BYTES) != hipSuccess || per_cu < 1) fprintf(stderr, "kernel_launch: occupancy query says %d\n", per_cu);
        (void)hipGetLastError();
        grid = cus;
    }
    if (grid < 0) return;
    (void)hipMemsetAsync((char*)d_ws + WS_CTL, 0, CTL_BYTES, stream);
    Args a{};
    for (int i = 0; i < 26; ++i) a.in[i] = (const float*)d_in[i];
    a.out = (float*)d_out; a.ws = (unsigned char*)d_ws;
    if (MK_N_LAUNCHES == 1) { a.ph_lo = 0; a.ph_hi = NPH; hipLaunchKernelGGL(fwd_kernel, dim3(grid), dim3(512), LDS_BYTES, stream, a); }
    else for (int p = 0; p < NPH; ++p) { a.ph_lo = p; a.ph_hi = p + 1; hipLaunchKernelGGL(fwd_kernel, dim3(grid), dim3(512), LDS_BYTES, stream, a); }
    const hipError_t le = hipPeekAtLastError();
    if (le != hipSuccess) fprintf(stderr, "kernel_launch: launch failed: %s\n", hipGetErrorName(le));
}
```

```cpp
#include <hip/hip_runtime.h>
#include <cstdio>
#include <cstdint>

#ifndef MK_N_LAUNCHES
#define MK_N_LAUNCHES 1
#endif

#define LAS __attribute__((address_space(3)))
typedef unsigned short bf16_t;
typedef short bf16x8 __attribute__((ext_vector_type(8)));
typedef short s16x4 __attribute__((ext_vector_type(4)));
typedef float f32x4 __attribute__((ext_vector_type(4)));
typedef float f32x2 __attribute__((ext_vector_type(2)));
typedef float f32x16 __attribute__((ext_vector_type(16)));
typedef unsigned u32x4 __attribute__((ext_vector_type(4)));
typedef unsigned u32x2 __attribute__((ext_vector_type(2)));

constexpr int NB = 4, SEQ = 4096, T = NB * SEQ, D = 2048;
constexpr int CH = 256, NCH = SEQ / CH, NBLK = NB * 8 * NCH;
constexpr int N_IN_NAT = 11520;
constexpr int N_IN_ALL = N_IN_NAT + 2048;
constexpr int NE = 32, PMAX = 73728;
constexpr float RMS_EPS = 1e-6f, GN_EPS = 1e-6f;
constexpr float QSCALE = 0.07216878364870322f;
constexpr int CONV_WGS = 128;

constexpr size_t MiB = 1u << 20;
constexpr size_t WS_CTL = 0, CTL_BYTES = 1 * MiB;
constexpr size_t WS_WT_IN = 1 * MiB;
constexpr size_t WS_WT_QB = WS_WT_IN + 54 * MiB;
constexpr size_t WS_WT_KVB = WS_WT_QB + 2 * MiB;
constexpr size_t WS_WT_MLAO = WS_WT_KVB + 2 * MiB;
constexpr size_t WS_WT_RETO = WS_WT_MLAO + 4 * MiB;
constexpr size_t WS_WT_OUT = WS_WT_RETO + 8 * MiB;
constexpr size_t WS_WT_GU = WS_WT_OUT + 8 * MiB;
constexpr size_t WS_WT_DOWN = WS_WT_GU + 512 * MiB;
constexpr size_t WS_CS_RET = WS_WT_DOWN + 256 * MiB;
constexpr size_t WS_CS_MLA = WS_CS_RET + 16 * MiB;
constexpr size_t WS_H = WS_CS_MLA + 4 * MiB;
constexpr size_t WS_QL = WS_H + 64 * MiB;
constexpr size_t WS_CKV = WS_QL + 16 * MiB;
constexpr size_t WS_KR = WS_CKV + 16 * MiB;
constexpr size_t WS_ACAT = WS_KR + 2 * MiB;
constexpr size_t WS_BCAT = WS_ACAT + 192 * MiB;
constexpr size_t WS_KROT = WS_BCAT + 192 * MiB;
constexpr size_t WS_KZTF = WS_KROT + 64 * MiB;
constexpr size_t WS_KZTB = WS_KZTF + 64 * MiB;
constexpr size_t WS_SG = WS_KZTB + 64 * MiB;
constexpr size_t WS_GA = WS_SG + 64 * MiB;
constexpr size_t WS_GB = WS_GA + 64 * MiB;
constexpr size_t WS_QN = WS_GB + 64 * MiB;
constexpr size_t WS_QR = WS_QN + 32 * MiB;
constexpr size_t WS_KN = WS_QR + 16 * MiB;
constexpr size_t WS_VV = WS_KN + 32 * MiB;
constexpr size_t WS_OA = WS_VV + 32 * MiB;
constexpr size_t WS_ORET = WS_OA + 32 * MiB;
constexpr size_t WS_OB = WS_ORET + 128 * MiB;
constexpr size_t WS_MIXP = WS_OB + 64 * MiB;
constexpr size_t WS_MIXIN = WS_MIXP + 64 * MiB;
constexpr size_t WS_MIX = WS_MIXIN + 64 * MiB;
constexpr size_t WS_H2 = WS_MIX + 128 * MiB;
constexpr size_t WS_TOPI = WS_H2 + 64 * MiB;
constexpr size_t WS_TOPW = WS_TOPI + 1 * MiB;
constexpr size_t WS_DEST = WS_TOPW + 1 * MiB;
constexpr size_t WS_TILE = WS_DEST + 1 * MiB;
constexpr size_t WS_YS_END = WS_TILE + 1 * MiB + 3 * 288 * MiB;
constexpr size_t WS_DECTAB = WS_TILE + 65536;
constexpr size_t WS_SSQP = WS_YS_END;
constexpr size_t WS_XS = WS_TILE + 1 * MiB;
constexpr size_t WS_ACT = WS_XS + 288 * MiB;
constexpr size_t WS_YS = WS_ACT + 288 * MiB;
constexpr size_t WS_ADAP = WS_YS + 288 * MiB + 1 * MiB;
constexpr size_t WS_H8 = WS_ADAP + 2 * MiB;
constexpr size_t WS_WT8IN = WS_H8 + 32 * MiB;
constexpr size_t WS_VT8 = WS_WT8IN + 12 * MiB;
constexpr size_t WS_X1B = WS_VT8 + 32 * MiB;
constexpr size_t WS_WRT = WS_X1B + 64 * MiB;
constexpr size_t WS_WT8B = WS_WRT + 1 * MiB;
constexpr size_t WS_WT8K = WS_WT8B + 14 * MiB;
constexpr size_t WS_END = WS_WT8K + 1 * MiB;
constexpr int CW_BAR = 4096;
constexpr int CW_QUEUE = 8192, CW_CVTQ = 8384, CW_AQ = 9216  , CW_COUNTS = 10240, CW_CURSOR = 12288;
constexpr int CW_ADA = 16384;
constexpr int CW_SSQQ = 65536, CW_SSQKV = 81920;
static_assert((CW_SSQKV + T) * 4 <= (int)CTL_BYTES, "ctl");

constexpr int RING_BYTES = 131072, CTRL_OFF = 155648, MISC_OFF = CTRL_OFF, LARG_OFF = CTRL_OFF + 1024, LDS_BYTES = 163840;

__device__ __forceinline__ unsigned cvt_pk_bf16(float lo, float hi) { unsigned r; asm volatile("v_cvt_pk_bf16_f32 %0, %1, %2" : "=v"(r) : "v"(lo), "v"(hi)); return r; }
__device__ __forceinline__ u32x4 pack8(f32x4 a, f32x4 b) { u32x4 w; w.x = cvt_pk_bf16(a[0], a[1]); w.y = cvt_pk_bf16(a[2], a[3]); w.z = cvt_pk_bf16(b[0], b[1]); w.w = cvt_pk_bf16(b[2], b[3]); return w; }
__device__ __forceinline__ unsigned pk4_fp8(float a, float b, float c, float d, float sc) {
    a = __builtin_amdgcn_fmed3f(a * sc, -448.f, 448.f); b = __builtin_amdgcn_fmed3f(b * sc, -448.f, 448.f); c = __builtin_amdgcn_fmed3f(c * sc, -448.f, 448.f); d = __builtin_amdgcn_fmed3f(d * sc, -448.f, 448.f);
    int w = __builtin_amdgcn_cvt_pk_fp8_f32(a, b, 0, false); w = __builtin_amdgcn_cvt_pk_fp8_f32(c, d, w, true); return (unsigned)w;
}
constexpr float W8_SCALE = 1024.f, H8_SCALE = 16.f, A8_SCALE = 8.f;
constexpr float V8_SCALE = 16.f, K8_SCALE = 256.f, CH_UNSCALE = 1.0f / (V8_SCALE * K8_SCALE);
constexpr float GU_UNSCALE = 1.0f / (W8_SCALE * H8_SCALE), DN_UNSCALE = 1.0f / (W8_SCALE * A8_SCALE);
constexpr float L8_SCALE = 16.f, LW_UNSCALE = 1.0f / (L8_SCALE * W8_SCALE);
constexpr float AV8_SCALE = 16.f, AP8_LOG2 = 5.0f;
constexpr float AQ8_SCALE = 128.f, AK8_SCALE = 16.f, AQK_UNSCALE = 1.0f / (AQ8_SCALE * AK8_SCALE);
constexpr float O8_SCALE = 128.f, MA_UNSCALE = 1.0f / (W8_SCALE * O8_SCALE);
constexpr float B8_SCALE = 16.f, M8_SCALE = 64.f, MB_UNSCALE = 1.0f / (W8_SCALE * B8_SCALE), MX_UNSCALE = 1.0f / (W8_SCALE * M8_SCALE);
__device__ __forceinline__ float bf_lo(unsigned w) { return __uint_as_float(w << 16); }
__device__ __forceinline__ float bf_hi(unsigned w) { return __uint_as_float(w & 0xffff0000u); }
__device__ __forceinline__ void unpack8(u32x4 w, f32x4& a, f32x4& b) { a = (f32x4){bf_lo(w.x), bf_hi(w.x), bf_lo(w.y), bf_hi(w.y)}; b = (f32x4){bf_lo(w.z), bf_hi(w.z), bf_lo(w.w), bf_hi(w.w)}; }
__device__ __forceinline__ float wave_sum(float v) {
#pragma unroll
    for (int o = 1; o < 64; o <<= 1) v += __shfl_xor(v, o);
    return v;
}
__device__ __forceinline__ float sigmoidf_(float x) { return __builtin_amdgcn_rcpf(1.0f + __expf(-x)); }
__device__ __forceinline__ float log2_sigmoid(float x) { return -log1pf(expf(-x)) * 1.4426950408889634f; }

#define XB_TMO      128
#define XB_XCNT(j)  (256  + 64 * (j))
#define XB_XSUB(j)  (1280 + 64 * (j))
#define XB_XGEN(j)  (2304 + 64 * (j))
#define XB_TOP      3328
#define XB_TOPGEN   3392
#define XCD_BAR_WORDS 3456
#define XB_SPIN_CAP (1u << 22)
__device__ __forceinline__ unsigned xb_ld(unsigned* p)              { return __hip_atomic_load(p, __ATOMIC_RELAXED, __HIP_MEMORY_SCOPE_AGENT); }
__device__ __forceinline__ unsigned xb_add(unsigned* p, unsigned v) { return __hip_atomic_fetch_add(p, v, __ATOMIC_RELAXED, __HIP_MEMORY_SCOPE_AGENT); }
__device__ __forceinline__ unsigned xb_xcc_id() { return (unsigned)__builtin_amdgcn_s_getreg((3 << 11) | 20) & 0xFu; }
#define XB_SPIN(cond, bar) do { unsigned _sp = 0; while (cond) { __builtin_amdgcn_s_sleep(1); \
    if ((++_sp & 255u) == 0u) { if (xb_ld(&(bar)[XB_TMO])) break; if (_sp > XB_SPIN_CAP) { atomicAdd(&(bar)[XB_TMO], 1u); break; } } } } while (0)
struct XcdBarrier { unsigned* bar; unsigned x; volatile LAS unsigned* st; };
__device__ __forceinline__ XcdBarrier xcd_barrier_post(unsigned* bar, volatile LAS unsigned* st) {
    XcdBarrier b; b.bar = bar; b.x = xb_xcc_id(); b.st = st;
    if (threadIdx.x == 0) (void)xb_add(&bar[XB_XCNT(b.x)], 1u);
    return b;
}
__device__ __forceinline__ void xcd_barrier_complete(unsigned* bar, unsigned x, unsigned& nloc, unsigned& nx) {
    const unsigned G = gridDim.x * gridDim.y * gridDim.z;
    unsigned sum, cnt, mine, sp = 0u;
    for (;;) {
        sum = 0u; cnt = 0u; mine = 0u;
#pragma unroll
        for (unsigned j = 0; j < 16; ++j) { const unsigned c = xb_ld(&bar[XB_XCNT(j)]); sum += c; cnt += (c > 0u) ? 1u : 0u; mine = (j == x) ? c : mine; }
        if (sum == G) break;
        __builtin_amdgcn_s_sleep(1);
        if ((++sp & 255u) == 0u) { if (xb_ld(&bar[XB_TMO])) break; if (sp > XB_SPIN_CAP) { atomicAdd(&bar[XB_TMO], 1u); break; } }
    }
    nloc = mine > 0u ? mine : 1u; nx = cnt > 0u ? cnt : 1u;
}
__device__ __forceinline__ void xcd_barrier(const XcdBarrier& b) {
    asm volatile("s_waitcnt vmcnt(0)" ::: "memory");
    __syncthreads();
    if (threadIdx.x == 0) {
        unsigned* bar = b.bar;
        __builtin_amdgcn_s_waitcnt(0);
        unsigned nloc = b.st[0], nx = b.st[1];
        if (nloc == 0u) { xcd_barrier_complete(bar, b.x, nloc, nx); b.st[0] = nloc; b.st[1] = nx; }
        const unsigned old = xb_add(&bar[XB_XSUB(b.x)], 1u);
        const unsigned gen = old / nloc;
        if (old + 1u == (gen + 1u) * nloc) {
            __builtin_amdgcn_fence(__ATOMIC_RELEASE, "agent");
            asm volatile("s_waitcnt vmcnt(0)" ::: "memory");
            const unsigned og = xb_add(&bar[XB_TOP], 1u);
            const unsigned tg = og / nx;
            if (og + 1u == (tg + 1u) * nx) xb_add(&bar[XB_TOPGEN], 1u);
            else XB_SPIN(xb_ld(&bar[XB_TOPGEN]) == tg, bar);
            __builtin_amdgcn_fence(__ATOMIC_ACQUIRE, "agent");
            xb_add(&bar[XB_XGEN(b.x)], 1u);
            asm volatile("s_waitcnt vmcnt(0)" ::: "memory");
        } else {
            XB_SPIN(xb_ld(&bar[XB_XGEN(b.x)]) == gen, bar);
            __builtin_amdgcn_fence(__ATOMIC_ACQUIRE, "agent");
            asm volatile("s_waitcnt vmcnt(0)" ::: "memory");
        }
    }
    __syncthreads();
}

namespace pg8 {
constexpr int BM = 256, BK = 64, HALF = 128, HTB = HALF * BK * 2, NXCD = 8, WGM = 8;
__host__ __device__ __forceinline__ int lds_byte(int r, int c, int SW = 5) { const int st = (r >> 4) * 2 + (c >> 5), rr = r & 15, cc = c & 31, ob = rr * 64 + cc * 2; return st * 1024 + (ob ^ (((ob >> 9) & 1) << SW)); }
__host__ __device__ __forceinline__ void stage_rc(int b, int& R, int& C, int SW = 5) { const int st = b / 1024, sb = b % 1024, swz = sb ^ (((sb >> 9) & 1) << SW); R = (st >> 1) * 16 + swz / 64; C = (st & 1) * 32 + (swz % 64) / 2; }
__host__ __device__ __forceinline__ int perm32(int rho) { const int n = rho >> 4, i = rho & 15; return 8 * (i >> 2) + 4 * n + (i & 3); }
struct Unit { const char* a; const char* b; int pm, pn, keep, aux; };
__device__ __forceinline__ void tile_order(int wgid, int nM, int nN, int& pm, int& pn) {
    const int nwg = nM * nN; { const int q = nwg / NXCD, r = nwg % NXCD, xcd = wgid % NXCD, off = wgid / NXCD; wgid = (xcd < r ? xcd * (q + 1) : r * (q + 1) + (xcd - r) * q) + off; }
    const int nig = WGM * nN, gid = wgid / nig, fm = gid * WGM, gsz = (nM - fm) < WGM ? (nM - fm) : WGM;
    pm = fm + ((wgid % nig) % gsz); pn = (wgid % nig) / gsz;
}
typedef int v8i __attribute__((ext_vector_type(8)));
typedef int v4i __attribute__((ext_vector_type(4)));
template <class Epi, class Sched, bool F8 = false, bool REMAT = false>
__device__ __forceinline__ void gemm_phase(LAS unsigned char* lds, const int K, const int lda, const int ldb, const Sched& S, const Epi& E) {
    const int tid = threadIdx.x, wid = __builtin_amdgcn_readfirstlane(tid >> 6), lane = tid & 63, wr = wid >> 2, wc = wid & 3, fr = lane & 15, fq = lane >> 4;
    constexpr int ES = F8 ? 1 : 2;
    const int nt = K * ES / (BK * 2);
    unsigned voffA, voffB;
    constexpr bool X4 = F8 && !REMAT;
    constexpr int SW = X4 ? 4 : 5;
    { int R, C; stage_rc(tid * 16, R, C, SW); const int Rb = (R & ~31) + perm32(R & 31); voffA = (unsigned)(R * lda * ES + C * 2); voffB = (unsigned)(Rb * ldb * ES + C * 2); }
    const size_t q64voffA = (size_t)64 * lda * ES, q64voffB = (size_t)64 * ldb * ES;
    const size_t kstep = (size_t)(BK * 2);
    const size_t hstepA = (size_t)HALF * lda * ES, hstepB = (size_t)HALF * ldb * ES;
    const unsigned ldsw = (unsigned)wid * 1024u;
    const int aoff = F8 ? lds_byte(wr * 64 + fr, fq * 16, SW) : lds_byte(wr * 64 + fr, fq * 8), boff = F8 ? lds_byte(wc * 32 + fr, fq * 16, SW) : lds_byte(wc * 32 + fr, fq * 8);
#define PG8_SA(b, h) (((b) * 2 + (h)) * HTB)
#define PG8_SB(b, h) ((4 + (b) * 2 + (h)) * HTB)
    constexpr bool isB_voffA = false, isB_voffB = true; const unsigned pitch_voffA = (unsigned)(lda * ES), pitch_voffB = (unsigned)(ldb * ES);
#define PG8_VOFF(isB, pitch) ({ unsigned _t = threadIdx.x; asm volatile("" : "+v"(_t)); const unsigned _l = _t & 63u, _w = _t >> 6, _sw = (_l * 16u) ^ ((_l >> 5) << SW); unsigned _R = (_w >> 1) * 16u + (_sw >> 6); \
        const unsigned _C = (_w & 1u) * 32u + ((_sw & 63u) >> 1); if (isB) _R = (_R & ~31u) + (unsigned)perm32((int)(_R & 31u)); _R * (pitch) + _C * 2u; })
#define PG8_STAGE(bufoff, gbase, voff) do { _Pragma("unroll") for (int _i = 0; _i < 2; ++_i) { unsigned _vo; if constexpr (REMAT) _vo = PG8_VOFF(isB_##voff, pitch_##voff); else { _vo = (voff); if constexpr (F8) asm volatile("" : "+v"(_vo)); } \
        __builtin_amdgcn_global_load_lds((const unsigned*)((const char*)(gbase) + (_i ? q64##voff : (size_t)0) + _vo), (LAS unsigned*)(lds + (bufoff) + ldsw + _i * 8192), 16, 0, 0); } } while (0)
#define PG8_LD1(addr) ({ v8i _r; if constexpr (F8 && !X4) { _r = *(const LAS v8i*)(addr); } else if constexpr (X4) { const v4i _lo = *(const LAS v4i*)(addr), _hi = *(const LAS v4i*)((addr) + _x16); _r = __builtin_shufflevector(_lo, _hi, 0, 1, 2, 3, 4, 5, 6, 7); } else { const v4i _lo = *(const LAS v4i*)(addr), _hi = *(const LAS v4i*)((addr) + 1024); _r = __builtin_shufflevector(_lo, _hi, 0, 1, 2, 3, 4, 5, 6, 7); } _r; })
#define PG8_X16(off) int _x16 = 0; if constexpr (X4) { int _o = (off); asm volatile("" : "+v"(_o)); _x16 = (_o ^ 16) - _o; }
#define PG8_LDA(dst, b, h) do { PG8_X16(aoff) _Pragma("unroll") for (int m = 0; m < 4; ++m) dst[m] = PG8_LD1(lds + PG8_SA(b, h) + aoff + m * 2048); } while (0)
#define PG8_LDB(dst, b, h) do { PG8_X16(boff) _Pragma("unroll") for (int n = 0; n < 2; ++n) dst[n] = PG8_LD1(lds + PG8_SB(b, h) + boff + n * 2048); } while (0)
#define PG8_H0(x) __builtin_bit_cast(bf16x8, __builtin_shufflevector(x, x, 0, 1, 2, 3))
#define PG8_H1(x) __builtin_bit_cast(bf16x8, __builtin_shufflevector(x, x, 4, 5, 6, 7))
#define PG8_MMA(ai, bj, At, Bt) do { __builtin_amdgcn_s_setprio(1); _Pragma("unroll") for (int m = 0; m < 4; ++m) _Pragma("unroll") for (int n = 0; n < 2; ++n) { \
        if constexpr (F8) acc[ai][bj][m][n] = __builtin_amdgcn_mfma_scale_f32_16x16x128_f8f6f4(Bt[n], At[m], acc[ai][bj][m][n], 0, 0, 0, 0, 0, 0); \
        else { acc[ai][bj][m][n] = __builtin_amdgcn_mfma_f32_16x16x32_bf16(PG8_H0(Bt[n]), PG8_H0(At[m]), acc[ai][bj][m][n], 0, 0, 0); \
               acc[ai][bj][m][n] = __builtin_amdgcn_mfma_f32_16x16x32_bf16(PG8_H1(Bt[n]), PG8_H1(At[m]), acc[ai][bj][m][n], 0, 0, 0); } } \
        __builtin_amdgcn_s_setprio(0); } while (0)
#define PG8_WAIT_V(n) asm volatile("s_waitcnt vmcnt(" #n ")" ::: "memory")
#define PG8_WAIT_L(n) asm volatile("s_waitcnt lgkmcnt(" #n ")" ::: "memory")
#define PG8_BAR __builtin_amdgcn_s_barrier()
#define PG8_SCHED __builtin_amdgcn_sched_barrier(0)
    Unit cur, nxt; int ui = 0;
    if (!S.next(0, cur)) return;
    f32x4 acc[2][2][4][2];
#pragma unroll
    for (int a = 0; a < 2; ++a)
#pragma unroll
        for (int b = 0; b < 2; ++b)
#pragma unroll
            for (int m = 0; m < 4; ++m)
#pragma unroll
                for (int n = 0; n < 2; ++n) acc[a][b][m][n] = (f32x4){0.f, 0.f, 0.f, 0.f};
    v8i At[4], B0[2], B1[2];
    const char* cA = cur.a; const char* cB = cur.b;
    PG8_STAGE(PG8_SB(0, 0), cB, voffB); PG8_STAGE(PG8_SB(0, 1), cB + hstepB, voffB); PG8_STAGE(PG8_SA(0, 0), cA, voffA); PG8_STAGE(PG8_SA(0, 1), cA + hstepA, voffA);
    if (wr == 1) PG8_BAR;
    PG8_WAIT_V(2); PG8_BAR;
    PG8_STAGE(PG8_SB(1, 0), cB + kstep, voffB); PG8_STAGE(PG8_SA(1, 0), cA + kstep, voffA); PG8_STAGE(PG8_SB(1, 1), cB + hstepB + kstep, voffB);
    PG8_WAIT_V(6); PG8_BAR;
    for (;;) {
        const bool has_next = S.next(ui + 1, nxt);
        const char* nA = has_next ? nxt.a : cA; const char* nB = has_next ? nxt.b : cB;
#pragma nounroll
        for (int t = 0; t < nt; t += 2) {
            const bool last = (t == nt - 2);
            const char* a1 = cA + (size_t)(t + 1) * kstep;
            const char* a2 = last ? nA : cA + (size_t)(t + 2) * kstep; const char* b2 = last ? nB : cB + (size_t)(t + 2) * kstep;
            const char* a3 = a2 + kstep; const char* b3 = b2 + kstep;
            PG8_LDB(B0, 0, 0); PG8_LDB(B1, 0, 1); PG8_SCHED; PG8_LDA(At, 0, 0); PG8_STAGE(PG8_SA(1, 1), a1 + hstepA, voffA);
            PG8_WAIT_V(8); PG8_WAIT_L(0); PG8_BAR; PG8_MMA(0, 0, At, B0); PG8_MMA(0, 1, At, B1); PG8_BAR; PG8_SCHED;
            PG8_LDA(At, 0, 1); PG8_STAGE(PG8_SB(0, 0), b2, voffB); PG8_STAGE(PG8_SB(0, 1), b2 + hstepB, voffB); PG8_STAGE(PG8_SA(0, 0), a2, voffA);
            PG8_WAIT_V(8); PG8_WAIT_L(0); PG8_BAR; PG8_MMA(1, 0, At, B0); PG8_MMA(1, 1, At, B1); PG8_BAR; PG8_SCHED;
            PG8_LDB(B0, 1, 0); PG8_LDB(B1, 1, 1); PG8_SCHED; PG8_LDA(At, 1, 0); PG8_STAGE(PG8_SA(0, 1), a2 + hstepA, voffA);
            PG8_WAIT_V(8); PG8_WAIT_L(0); PG8_BAR; PG8_MMA(0, 0, At, B0); PG8_MMA(0, 1, At, B1); PG8_BAR; PG8_SCHED;
            PG8_LDA(At, 1, 1); PG8_STAGE(PG8_SB(1, 0), b3, voffB); PG8_STAGE(PG8_SB(1, 1), b3 + hstepB, voffB); PG8_STAGE(PG8_SA(1, 0), a3, voffA);
            PG8_WAIT_V(8); PG8_WAIT_L(0); PG8_BAR; PG8_MMA(1, 0, At, B0); PG8_MMA(1, 1, At, B1); PG8_BAR; PG8_SCHED;
        }
        if (wr == 0) PG8_BAR;
        { unsigned _t = threadIdx.x; if constexpr (F8) asm volatile("" : "+v"(_t)); E(acc, cur, wr, wc, (int)(_t & 15u), (int)((_t >> 4) & 3u)); }
        if (!has_next) break;
        if (!cur.keep) {
#pragma unroll
            for (int a = 0; a < 2; ++a)
#pragma unroll
                for (int b = 0; b < 2; ++b)
#pragma unroll
                    for (int m = 0; m < 4; ++m)
#pragma unroll
                        for (int n = 0; n < 2; ++n) acc[a][b][m][n] = (f32x4){0.f, 0.f, 0.f, 0.f};
        }
        cur = nxt; cA = nA; cB = nB; ++ui;
        if (wr == 1) PG8_BAR;
    }
    PG8_WAIT_V(0);
    PG8_BAR;
#undef PG8_SA
#undef PG8_SB
#undef PG8_STAGE
#undef PG8_VOFF
#undef PG8_LDA
#undef PG8_LDB
#undef PG8_LD1
#undef PG8_X16
#undef PG8_H0
#undef PG8_H1
#undef PG8_MMA
#undef PG8_WAIT_V
#undef PG8_WAIT_L
#undef PG8_BAR
#undef PG8_SCHED
}
struct GridSched {
    const char* A; const char* Bt; size_t astep, bstep; int nM, nN, G, c;
    __device__ __forceinline__ bool next(int i, Unit& u) const {
        const int L = i * G + c; if (L >= nM * nN) return false;
        int pm, pn; tile_order(L, nM, nN, pm, pn);
        u.a = A + (size_t)pm * astep; u.b = Bt + (size_t)pn * bstep; u.pm = pm; u.pn = pn; u.keep = 0; u.aux = 0; return true;
    }
};
struct InprojSched {
    const char* H; const char* W; int G, c;
    __device__ __forceinline__ bool next(int i, Unit& u) const {
        const int L = i * G + c; if (L >= 1536) return false;
        constexpr size_t TSB = (size_t)256 * 2048 * 2; int pm, pn;
        if (L < 1024) { tile_order(L, 64, 16, pm, pn); pn += 5; u.a = H + (size_t)pm * TSB; u.b = W + (size_t)pn * TSB; u.aux = 0; }
        else { tile_order(L - 1024, 8, 64, pm, pn); u.a = W + (size_t)(45 + pm) * TSB; u.b = H + (size_t)pn * TSB; u.aux = 1; }
        u.pm = pm; u.pn = pn; u.keep = 0; return true;
    }
};
struct GridSchedR {
    const char* A; const char* Bt; size_t astep, bstep; int nM, nN, G, c, L0, Lend;
    __device__ __forceinline__ bool next(int i, Unit& u) const {
        const int L = L0 + i * G + c; if (L >= Lend) return false;
        int pm, pn; tile_order(L, nM, nN, pm, pn);
        u.a = A + (size_t)pm * astep; u.b = Bt + (size_t)pn * bstep; u.pm = pm; u.pn = pn; u.keep = 0; u.aux = 0; return true;
    }
};
struct GridSchedRS {
    const char* A; const char* Bt; size_t astep, bstep; int nM, nN, G, c, L0, Lend, sw;
    __device__ __forceinline__ bool next(int i, Unit& u) const {
        const int L = L0 + i * G + c; if (L >= Lend) return false;
        int pm, pn; tile_order(L, nM, nN, pm, pn);
        const char* pa = A + (size_t)pm * astep; const char* pb = Bt + (size_t)pn * bstep; const bool swp = pn >= sw;
        u.a = swp ? pb : pa; u.b = swp ? pa : pb; u.pm = pm; u.pn = pn; u.keep = 0; u.aux = swp ? 1 : 0; return true;
    }
};
struct BatchSchedR {
    const char* A; const char* Bt; size_t astep, bstep; int G, c, L0, Lend;
    __device__ __forceinline__ bool next(int i, Unit& u) const {
        const int L = L0 + i * G + c; if (L >= Lend) return false;
        u.a = A + (size_t)L * astep; u.b = Bt + (size_t)L * bstep; u.pm = L; u.pn = 0; u.keep = 0; u.aux = 0; return true;
    }
};
struct BatchSched {
    const char* A; const char* Bt; size_t astep, bstep; int n, G, c;
    __device__ __forceinline__ bool next(int i, Unit& u) const {
        const int L = i * G + c; if (L >= n) return false;
        u.a = A + (size_t)L * astep; u.b = Bt + (size_t)L * bstep; u.pm = L; u.pn = 0; u.keep = 0; u.aux = 0; return true;
    }
};
struct ChainSched {
    const char* A; const char* Bt; int bh, dir;
    __device__ __forceinline__ bool next(int i, Unit& u) const {
        if (i >= NCH) return false;
        const int n = dir ? (NCH - 1 - i) : i, blk = bh * NCH + n;
        u.a = A + (size_t)blk * (256 * 256); u.b = Bt + (size_t)blk * (256 * 256); u.pm = blk; u.pn = i; u.keep = 1; u.aux = n; return true;
    }
};
struct MoeSched {
    const char* A; const char* Bt; const int* tile_e; int ntiles, nN, G, c;
    __device__ __forceinline__ bool next(int i, Unit& u) const {
        const int L = i * G + c; if (L >= ntiles * nN) return false;
        int pm, pn; tile_order(L, ntiles, nN, pm, pn);
        const int e = __builtin_amdgcn_readfirstlane(tile_e[pm]);
        u.a = A + (size_t)pm * (256 * 2048); u.b = Bt + ((size_t)e * nN + pn) * (256 * 2048); u.pm = pm; u.pn = pn; u.keep = 0; u.aux = e; return true;
    }
};
}
using pg8::Unit;

#define EPI_LOOP _Pragma("unroll") for (int ai = 0; ai < 2; ++ai) _Pragma("unroll") for (int m = 0; m < 4; ++m)
#define EPI_ROW (ai * 128 + wr * 64 + m * 16 + fr)
#define EPI_FENCE asm volatile("" ::: "memory")
typedef f32x4 Acc[2][2][4][2];

__device__ __forceinline__ void rot4(const f32x4 x1, const f32x4 x2, const f32x4 csA, const f32x4 csB, f32x4& o1, f32x4& o2) {
    o1[0] = x1[0] * csA[0] - x2[0] * csA[1]; o2[0] = x1[0] * csA[1] + x2[0] * csA[0];
    o1[1] = x1[1] * csA[2] - x2[1] * csA[3]; o2[1] = x1[1] * csA[3] + x2[1] * csA[2];
    o1[2] = x1[2] * csB[0] - x2[2] * csB[1]; o2[2] = x1[2] * csB[1] + x2[2] * csB[0];
    o1[3] = x1[3] * csB[2] - x2[3] * csB[3]; o2[3] = x1[3] * csB[3] + x2[3] * csB[2];
}
__device__ __forceinline__ f32x4 rot_il(const f32x4 v, const f32x4 cs) {
    return (f32x4){v[0] * cs[0] - v[1] * cs[1], v[0] * cs[1] + v[1] * cs[0], v[2] * cs[2] - v[3] * cs[3], v[2] * cs[3] + v[3] * cs[2]};
}

struct EpiInproj {
    bf16_t *QL, *CKV, *KR, *ACAT, *KROT, *SG, *GA, *GB; float *ssqp; const float* cs_ret; const float* cs_mla; const float* dectab; int pn_off; float unscale; int lo4;
    __device__ __forceinline__ void operator()(Acc& acc, const Unit& u, int wr, int wc, int fr, int fq) const {
        asm volatile("" : "+v"(fr), "+v"(fq));
        const int pn = (lo4 && u.pn < 4) ? u.pn : u.pn + pn_off, tok0 = u.pm * 256, cb = wc * 32 + fq * 8;
        if (pn < 4) {
            unsigned char* dst = (unsigned char*)QL + (size_t)(pn >> 1) * (WS_CKV - WS_QL); float* ssq = ssqp + (size_t)(pn * 4 + wc) * T; const int c0 = (pn & 1) * 256 + cb;
            EPI_LOOP { const int row = tok0 + EPI_ROW; float s = 0.f;
#pragma unroll
                for (int bj = 0; bj < 2; ++bj) { const f32x4 v0 = acc[ai][bj][m][0] * unscale, v1 = acc[ai][bj][m][1] * unscale;
                    s += (v0[0] * v0[0] + v0[1] * v0[1]) + (v0[2] * v0[2] + v0[3] * v0[3]) + (v1[0] * v1[0] + v1[1] * v1[1]) + (v1[2] * v1[2] + v1[3] * v1[3]);
                    u32x2 w8; w8.x = pk4_fp8(v0[0], v0[1], v0[2], v0[3], L8_SCALE); w8.y = pk4_fp8(v1[0], v1[1], v1[2], v1[3], L8_SCALE); *(u32x2*)(dst + (size_t)row * 512 + c0 + bj * 128) = w8; }
                s += __shfl_xor(s, 16); s += __shfl_xor(s, 32);
                if (fq == 0) ssq[row] = s; EPI_FENCE; }
        } else if (pn == 4) {
            if (wc < 2) {
                EPI_LOOP { const int row = tok0 + EPI_ROW; const float* cs = cs_mla + (size_t)row * 64 + cb;
                    const f32x4 csA = *(const f32x4*)cs, csB = *(const f32x4*)(cs + 4);
                    const f32x4 y0 = rot_il(acc[ai][0][m][0] * unscale, csA), y1 = rot_il(acc[ai][0][m][1] * unscale, csB); u32x2 w8; w8.x = pk4_fp8(y0[0], y0[1], y0[2], y0[3], AK8_SCALE); w8.y = pk4_fp8(y1[0], y1[1], y1[2], y1[3], AK8_SCALE);
                    *(u32x2*)((unsigned char*)KR + (size_t)row * 64 + cb) = w8; EPI_FENCE; }
            }
        } else if (pn < 21) {
            const bool isq = pn < 13; const int h = isq ? pn - 5 : pn - 13;
            const int blk = ((u.pm >> 4) * 8 + h) * NCH + (u.pm & 15);
            const float lf = dectab[h], lb = dectab[8 + h];
            EPI_LOOP { const int c = EPI_ROW, row = tok0 + c; const float* cs = cs_ret + (size_t)row * 256 + cb * 2;
                f32x4 q1[2], q2[2];
#pragma unroll
                for (int n = 0; n < 2; ++n) { const f32x4 csA = *(const f32x4*)(cs + n * 8), csB = *(const f32x4*)(cs + n * 8 + 4); rot4(acc[ai][0][m][n], acc[ai][1][m][n], csA, csB, q1[n], q2[n]); }
                if (isq) {
                    const float xf = __builtin_amdgcn_exp2f((float)(c + 1) * lf), xb = __builtin_amdgcn_exp2f((float)(CH - c) * lb);
                    bf16_t* base = ACAT + ((size_t)blk * 256 + c) * 768 + cb;
                    *(u32x4*)(base + 256) = pack8(q1[0] * xf, q1[1] * xf); *(u32x4*)(base + 384) = pack8(q2[0] * xf, q2[1] * xf);
                    *(u32x4*)(base + 512) = pack8(q1[0] * xb, q1[1] * xb); *(u32x4*)(base + 640) = pack8(q2[0] * xb, q2[1] * xb);
                } else {
                    bf16_t* base = KROT + ((size_t)blk * 256 + c) * 256 + cb;
                    *(u32x4*)(base) = pack8(q1[0] * 0.0625f, q1[1] * 0.0625f); *(u32x4*)(base + 128) = pack8(q2[0] * 0.0625f, q2[1] * 0.0625f);
                }
                EPI_FENCE; }
        } else {
            const int g = (pn - 21) >> 3, ct = (pn - 21) & 7; bf16_t* dst = SG + (size_t)g * ((WS_GA - WS_SG) / 2);
            EPI_LOOP { const int row = tok0 + EPI_ROW;
#pragma unroll
                for (int bj = 0; bj < 2; ++bj) { f32x4 v[2];
#pragma unroll
                    for (int n = 0; n < 2; ++n) { const f32x4 x = acc[ai][bj][m][n] * unscale; f32x4 e = x * (-1.4426950408889634f);
#pragma unroll
                        for (int j = 0; j < 4; ++j) e[j] = __builtin_amdgcn_exp2f(e[j]);
                        e = e + 1.0f;
#pragma unroll
                        for (int j = 0; j < 4; ++j) e[j] = __builtin_amdgcn_rcpf(e[j]);
                        v[n] = g == 0 ? x * e : e; }
                    *(u32x4*)(dst + (size_t)row * 2048 + ct * 256 + bj * 128 + cb) = pack8(v[0], v[1]); }
                EPI_FENCE; }
        }
    }
};
struct EpiVT {
    bf16_t* BCAT; unsigned char* VT8;
    __device__ __forceinline__ void operator()(Acc& acc, const Unit& u, int wr, int wc, int fr, int fq) const {
        asm volatile("" : "+v"(fr), "+v"(fq));
        const int blk = ((u.pn >> 4) * 8 + u.pm) * NCH + (u.pn & 15), cb = wc * 32 + fq * 8;
        EPI_LOOP { bf16_t* base = BCAT + ((size_t)blk * 256 + EPI_ROW) * 768 + cb; unsigned char* b8 = VT8 + ((size_t)blk * 256 + EPI_ROW) * 256 + cb;
#pragma unroll
            for (int bj = 0; bj < 2; ++bj) { const f32x4 v0 = acc[ai][bj][m][0], v1 = acc[ai][bj][m][1]; *(u32x4*)(base + bj * 128) = pack8(v0, v1);
                u32x2 w8; w8.x = pk4_fp8(v0[0], v0[1], v0[2], v0[3], V8_SCALE); w8.y = pk4_fp8(v1[0], v1[1], v1[2], v1[3], V8_SCALE); *(u32x2*)(b8 + bj * 128) = w8; } }
    }
};
struct EpiInprojAll {
    EpiInproj a; EpiVT b;
    __device__ __forceinline__ void operator()(Acc& acc, const Unit& u, int wr, int wc, int fr, int fq) const { if (u.aux) b(acc, u, wr, wc, fr, fq); else a(acc, u, wr, wc, fr, fq); }
};
struct EpiMlaQ {
    bf16_t *QN, *QR; const float* ssq; const float* cs_mla;
    __device__ __forceinline__ void operator()(Acc& acc, const Unit& u, int wr, int wc, int fr, int fq) const {
        asm volatile("" : "+v"(fr), "+v"(fq));
        const int pn = u.pn, tok0 = u.pm * 256, cb = wc * 32 + fq * 8;
        EPI_LOOP { const int row = tok0 + EPI_ROW; float ss = 0.f;
#pragma unroll
            for (int q = 0; q < 8; ++q) ss += ssq[(size_t)q * T + row];
            const float rs = rsqrtf(ss * (1.0f / 512.0f) + RMS_EPS) * (QSCALE * LW_UNSCALE);
            if (pn < 4) {
#pragma unroll
                for (int bj = 0; bj < 2; ++bj) { const f32x4 y0 = acc[ai][bj][m][0] * rs, y1 = acc[ai][bj][m][1] * rs; u32x2 w8; w8.x = pk4_fp8(y0[0], y0[1], y0[2], y0[3], AQ8_SCALE); w8.y = pk4_fp8(y1[0], y1[1], y1[2], y1[3], AQ8_SCALE);
                    *(u32x2*)((unsigned char*)QN + (size_t)row * 1024 + (2 * pn + bj) * 128 + cb) = w8; }
            } else {
                const int c0 = (wc & 1) * 32 + fq * 8; const float* cs = cs_mla + (size_t)row * 64 + c0;
                const f32x4 csA = *(const f32x4*)cs, csB = *(const f32x4*)(cs + 4);
#pragma unroll
                for (int bj = 0; bj < 2; ++bj) { const int head = 4 * (pn - 4) + 2 * bj + (wc >> 1);
                    const f32x4 y0 = rot_il(acc[ai][bj][m][0], csA) * rs, y1 = rot_il(acc[ai][bj][m][1], csB) * rs; u32x2 w8; w8.x = pk4_fp8(y0[0], y0[1], y0[2], y0[3], AQ8_SCALE); w8.y = pk4_fp8(y1[0], y1[1], y1[2], y1[3], AQ8_SCALE);
                    *(u32x2*)((unsigned char*)QR + (size_t)row * 512 + head * 64 + c0) = w8; }
            }
            EPI_FENCE; }
    }
};
struct EpiMlaKV {
    bf16_t *KN; unsigned char* VT; const float* ssq;
    __device__ __forceinline__ void operator()(Acc& acc, const Unit& u, int wr, int wc, int fr, int fq) const {
        asm volatile("" : "+v"(fr), "+v"(fq));
        const int pn = u.pn, tok0 = u.pm * 256, cb = wc * 32 + fq * 8;
        if (u.aux == 0) {
            const int hb = 2 * (pn & 3);
            EPI_LOOP { const int row = tok0 + EPI_ROW; float ss = 0.f;
#pragma unroll
                for (int q = 0; q < 8; ++q) ss += ssq[(size_t)q * T + row];
                const float rs = rsqrtf(ss * (1.0f / 512.0f) + RMS_EPS) * LW_UNSCALE;
#pragma unroll
                for (int bj = 0; bj < 2; ++bj) { const f32x4 y0 = acc[ai][bj][m][0] * rs, y1 = acc[ai][bj][m][1] * rs; u32x2 w8; w8.x = pk4_fp8(y0[0], y0[1], y0[2], y0[3], AK8_SCALE); w8.y = pk4_fp8(y1[0], y1[1], y1[2], y1[3], AK8_SCALE);
                    *(u32x2*)((unsigned char*)KN + (size_t)row * 1024 + (hb + bj) * 128 + cb) = w8; } }
        } else {
            f32x4 rsv[2][2];
#pragma unroll
            for (int bj = 0; bj < 2; ++bj)
#pragma unroll
                for (int n = 0; n < 2; ++n) { f32x4 ss = (f32x4){0.f, 0.f, 0.f, 0.f}; const float* sp = ssq + tok0 + bj * 128 + cb + 4 * n;
#pragma unroll
                    for (int q = 0; q < 8; ++q) ss += *(const f32x4*)(sp + (size_t)q * T);
#pragma unroll
                    for (int j = 0; j < 4; ++j) rsv[bj][n][j] = rsqrtf(ss[j] * (1.0f / 512.0f) + RMS_EPS) * LW_UNSCALE; }
            const int b = tok0 / SEQ, kp0 = tok0 % SEQ;
            EPI_LOOP { const int f = EPI_ROW, head = 2 * (pn - 4) + (f >> 7), col = f & 127;
                unsigned char* rowp = VT + ((size_t)(b * 8 + head) * 128 + col) * 4096 + kp0 + 64 * (wc >> 1) + 4 * (4 * (wc & 1) + fq);
#pragma unroll
                for (int bj = 0; bj < 2; ++bj)
#pragma unroll
                    for (int n = 0; n < 2; ++n) { const f32x4 y = acc[ai][bj][m][n] * rsv[bj][n]; *(unsigned*)(rowp + 128 * bj + 32 * n) = pk4_fp8(y[0], y[1], y[2], y[3], AV8_SCALE); } }
        }
    }
};
struct EpiGa {
    bf16_t* ACAT; const float* dectab;
    __device__ __forceinline__ void operator()(Acc& acc, const Unit& u, int wr, int wc, int fr, int fq) const {
        asm volatile("" : "+v"(fr), "+v"(fq));
        const int blk = u.pm, h = (blk >> 4) & 7, cb = wc * 32 + fq * 8;
        const float lf = dectab[h], lb = dectab[8 + h];
        f32x4 colA[2][2], colB[2][2];
#pragma unroll
        for (int bj = 0; bj < 2; ++bj)
#pragma unroll
            for (int n = 0; n < 2; ++n)
#pragma unroll
                for (int j = 0; j < 4; ++j) { const int mm = bj * 128 + cb + n * 4 + j; colA[bj][n][j] = __builtin_amdgcn_exp2f(-(float)(mm + 1) * lf); colB[bj][n][j] = __builtin_amdgcn_exp2f((float)mm * lb); }
        EPI_LOOP { const int c = EPI_ROW; bf16_t* base = ACAT + ((size_t)blk * 256 + c) * 768 + cb;
            const float rowB = __builtin_amdgcn_exp2f(-(float)c * lb - (float)(c + 1) * lf);
#pragma unroll
            for (int bj = 0; bj < 2; ++bj) { f32x4 v[2];
#pragma unroll
                for (int n = 0; n < 2; ++n)
#pragma unroll
                    for (int j = 0; j < 4; ++j) { const int mm = bj * 128 + cb + n * 4 + j;
                        v[n][j] = acc[ai][bj][m][n][j] * ((c >= mm) ? colA[bj][n][j] : colB[bj][n][j] * rowB); }
                *(u32x4*)(base + bj * 128) = pack8(v[0], v[1]); }
            EPI_FENCE; }
    }
};
struct EpiGb {
    bf16_t* BCAT; const float* dectab; int dir;
    __device__ __forceinline__ void operator()(Acc& acc, const Unit& u, int wr, int wc, int fr, int fq) const {
        asm volatile("" : "+v"(fr), "+v"(fq));
        const int h = (u.pm >> 4) & 7;
        const float gC = __builtin_amdgcn_exp2f((float)CH * dectab[8 * dir + h]);
        if (u.pn < NCH - 1) {
            const int nblk = dir ? u.pm - 1 : u.pm + 1;
            bf16_t* base0 = BCAT + ((size_t)nblk * 256 + wr * 64 + fr) * 768 + 256 + 256 * dir + wc * 32 + fq * 8;
            EPI_LOOP { bf16_t* base = base0 + (size_t)(ai * 128 + m * 16) * 768;
#pragma unroll
                for (int bj = 0; bj < 2; ++bj) *(u32x4*)(base + bj * 128) = pack8(acc[ai][bj][m][0] * CH_UNSCALE, acc[ai][bj][m][1] * CH_UNSCALE); }
        }
        EPI_LOOP {
#pragma unroll
            for (int bj = 0; bj < 2; ++bj) { acc[ai][bj][m][0] *= gC; acc[ai][bj][m][1] *= gC; } }
    }
};
struct EpiGc {
    bf16_t* OB; const bf16_t* SG; const float* gn; LAS unsigned char* lds;
    __device__ __forceinline__ void operator()(Acc& acc, const Unit& u, int wr, int wc, int fr, int fq) const {
        asm volatile("" : "+v"(fr), "+v"(fq));
        const int blk = u.pm, b = blk >> 7, h = (blk >> 4) & 7, n = blk & 15, cb = wc * 32 + fq * 8;
        LAS f32x2* P = (LAS f32x2*)(lds + RING_BYTES);
        EPI_LOOP { float s = 0.f;
#pragma unroll
            for (int bj = 0; bj < 2; ++bj)
#pragma unroll
                for (int nn = 0; nn < 2; ++nn) { const f32x4 x = acc[ai][bj][m][nn]; s += (x[0] + x[1]) + (x[2] + x[3]); }
            s += __shfl_xor(s, 16); s += __shfl_xor(s, 32);
            const float mw = s * (1.0f / 64.0f); float q = 0.f;
#pragma unroll
            for (int bj = 0; bj < 2; ++bj)
#pragma unroll
                for (int nn = 0; nn < 2; ++nn) { const f32x4 d = acc[ai][bj][m][nn] - mw; q += (d[0] * d[0] + d[1] * d[1]) + (d[2] * d[2] + d[3] * d[3]); }
            q += __shfl_xor(q, 16); q += __shfl_xor(q, 32);
            if (fq == 0) P[EPI_ROW * 4 + wc] = (f32x2){mw, q}; }
        asm volatile("s_waitcnt lgkmcnt(0)" ::: "memory"); __builtin_amdgcn_s_barrier(); asm volatile("" ::: "memory");
        EPI_LOOP { const int row = EPI_ROW; const f32x4 p01 = *(const LAS f32x4*)(P + row * 4), p23 = *(const LAS f32x4*)(P + row * 4 + 2);
            const float mean = ((p01[0] + p01[2]) + (p23[0] + p23[2])) * 0.25f;
            const float d0 = p01[0] - mean, d1 = p01[2] - mean, d2 = p23[0] - mean, d3 = p23[2] - mean;
            const float m2 = ((p01[1] + p01[3]) + (p23[1] + p23[3])) + 64.0f * ((d0 * d0 + d1 * d1) + (d2 * d2 + d3 * d3));
            const float rstd = rsqrtf(m2 * (1.0f / 256.0f) + GN_EPS);
            const size_t off = ((size_t)b * SEQ + n * 256 + row) * 2048 + h * 256 + cb;
#pragma unroll
            for (int bj = 0; bj < 2; ++bj) { f32x4 s0, s1; unpack8(*(const u32x4*)(SG + off + bj * 128), s0, s1);
                const f32x4 g0 = *(const f32x4*)(gn + h * 256 + bj * 128 + cb), g1 = *(const f32x4*)(gn + h * 256 + bj * 128 + cb + 4);
                const f32x4 y0 = s0 * ((acc[ai][bj][m][0] - mean) * rstd * g0), y1 = s1 * ((acc[ai][bj][m][1] - mean) * rstd * g1);
                u32x2 w8; w8.x = pk4_fp8(y0[0], y0[1], y0[2], y0[3], B8_SCALE); w8.y = pk4_fp8(y1[0], y1[1], y1[2], y1[3], B8_SCALE); *(u32x2*)((unsigned char*)OB + off + bj * 128) = w8; }
            EPI_FENCE; }
    }
};
struct EpiMixA {
    bf16_t* MIXP; const bf16_t* GA;
    __device__ __forceinline__ void operator()(Acc& acc, const Unit& u, int wr, int wc, int fr, int fq) const {
        asm volatile("" : "+v"(fr), "+v"(fq));
        const int cb = wc * 32 + fq * 8;
        EPI_LOOP { const size_t off = (size_t)(u.pm * 256 + EPI_ROW) * 2048 + u.pn * 256 + cb;
#pragma unroll
            for (int bj = 0; bj < 2; ++bj) { f32x4 g0, g1; unpack8(*(const u32x4*)(GA + off + bj * 128), g0, g1);
                *(u32x4*)(MIXP + off + bj * 128) = pack8(acc[ai][bj][m][0] * MA_UNSCALE * g0, acc[ai][bj][m][1] * MA_UNSCALE * g1); }
            EPI_FENCE; }
    }
};
struct EpiMixB {
    bf16_t* MIXIN; const bf16_t* MIXP; const bf16_t* GB;
    __device__ __forceinline__ void operator()(Acc& acc, const Unit& u, int wr, int wc, int fr, int fq) const {
        asm volatile("" : "+v"(fr), "+v"(fq));
        const int cb = wc * 32 + fq * 8;
        EPI_LOOP { const size_t off = (size_t)(u.pm * 256 + EPI_ROW) * 2048 + u.pn * 256 + cb;
#pragma unroll
            for (int bj = 0; bj < 2; ++bj) { f32x4 g0, g1, p0, p1; unpack8(*(const u32x4*)(GB + off + bj * 128), g0, g1); unpack8(*(const u32x4*)(MIXP + off + bj * 128), p0, p1);
                const f32x4 y0 = acc[ai][bj][m][0] * MB_UNSCALE * g0 + p0, y1 = acc[ai][bj][m][1] * MB_UNSCALE * g1 + p1;
                u32x2 w8; w8.x = pk4_fp8(y0[0], y0[1], y0[2], y0[3], M8_SCALE); w8.y = pk4_fp8(y1[0], y1[1], y1[2], y1[3], M8_SCALE); *(u32x2*)((unsigned char*)MIXIN + off + bj * 128) = w8; }
            EPI_FENCE; }
    }
};
struct EpiF32 {
    bf16_t* C;
    __device__ __forceinline__ void operator()(Acc& acc, const Unit& u, int wr, int wc, int fr, int fq) const {
        asm volatile("" : "+v"(fr), "+v"(fq));
        const int cb = wc * 32 + fq * 8;
        EPI_LOOP { bf16_t* base = C + (size_t)(u.pm * 256 + EPI_ROW) * 2048 + u.pn * 256 + cb;
#pragma unroll
            for (int bj = 0; bj < 2; ++bj) *(u32x4*)(base + bj * 128) = pack8(acc[ai][bj][m][0] * MX_UNSCALE, acc[ai][bj][m][1] * MX_UNSCALE); }
    }
};
struct EpiGU {
    bf16_t* ACT; const float* bgu; int skip;
    __device__ __forceinline__ void operator()(Acc& acc, const Unit& u, int wr, int wc, int fr, int fq) const {
        asm volatile("" : "+v"(fr), "+v"(fq));
        if (skip) return;
        const int cb = wc * 32 + fq * 8, col = u.pn * 128 + cb; const float* bg = bgu + (size_t)u.aux * 4096 + col;
        const f32x4 bg0 = *(const f32x4*)bg, bg1 = *(const f32x4*)(bg + 4), bu0 = *(const f32x4*)(bg + 2048), bu1 = *(const f32x4*)(bg + 2052);
        EPI_LOOP { u32x2 w8;
#pragma unroll
            for (int n = 0; n < 2; ++n) { f32x4 gt = acc[ai][0][m][n] * GU_UNSCALE + (n ? bg1 : bg0), up = acc[ai][1][m][n] * GU_UNSCALE + (n ? bu1 : bu0);
#pragma unroll
                for (int j = 0; j < 4; ++j) { gt[j] = fminf(gt[j], 7.0f); up[j] = __builtin_amdgcn_fmed3f(up[j], -7.0f, 7.0f); }
                f32x4 e = gt * (-1.702f * 1.4426950408889634f);
#pragma unroll
                for (int j = 0; j < 4; ++j) e[j] = __builtin_amdgcn_exp2f(e[j]);
                e = e + 1.0f;
#pragma unroll
                for (int j = 0; j < 4; ++j) e[j] = __builtin_amdgcn_rcpf(e[j]);
                const f32x4 v = (up * A8_SCALE + A8_SCALE) * gt * e;
                int w = __builtin_amdgcn_cvt_pk_fp8_f32(v[0], v[1], 0, false); w = __builtin_amdgcn_cvt_pk_fp8_f32(v[2], v[3], w, true); if (n == 0) w8.x = (unsigned)w; else w8.y = (unsigned)w; }
            *(u32x2*)((unsigned char*)ACT + (size_t)(u.pm * 256 + EPI_ROW) * 2048 + col) = w8; EPI_FENCE; }
    }
};
struct EpiDown {
    bf16_t* YS; const float* bd;
    __device__ __forceinline__ void operator()(Acc& acc, const Unit& u, int wr, int wc, int fr, int fq) const {
        asm volatile("" : "+v"(fr), "+v"(fq));
        const int cb = wc * 32 + fq * 8; const float* bp = bd + (size_t)u.aux * 2048 + u.pn * 256 + cb;
        f32x4 bv[2][2];
#pragma unroll
        for (int bj = 0; bj < 2; ++bj) { bv[bj][0] = *(const f32x4*)(bp + bj * 128); bv[bj][1] = *(const f32x4*)(bp + bj * 128 + 4); }
        EPI_LOOP { bf16_t* base = YS + (size_t)(u.pm * 256 + EPI_ROW) * 2048 + u.pn * 256 + cb;
#pragma unroll
            for (int bj = 0; bj < 2; ++bj) *(u32x4*)(base + bj * 128) = pack8(acc[ai][bj][m][0] * DN_UNSCALE + bv[bj][0], acc[ai][bj][m][1] * DN_UNSCALE + bv[bj][1]); }
    }
};

namespace att {
constexpr int NW = 8, QBLK = 32, KVBLK = 64;
constexpr float THR = 2.f;
constexpr int SHM_V = 128 * KVBLK  , SHM_KN = KVBLK * 128  , SHM_KR = KVBLK * 64  , NVB = 3, SHM_ATTN = NVB * SHM_V + 2 * SHM_KN + 2 * SHM_KR + NW * 64 * 4;
#define KSWZ(row, colB) ((row) * 128 + ((colB) ^ ((((row) >> 1) & 7) << 4)))
#define KSWZR(row, colB) ((row) * 64 + ((colB) ^ ((((row) >> 2) & 3) << 4)))
#define SBAR() __builtin_amdgcn_sched_barrier(0)
__device__ __forceinline__ int crow(int r, int hi) { return (r & 3) + 8 * (r >> 2) + 4 * hi; }
__device__ __forceinline__ void partialSM(f32x16& p0, f32x16& p1, float& m_reg, float& mn, float& alpha) {
    constexpr float C = 1.4426950408889634f * AQK_UNSCALE;
    float pmax = p0[0];
#pragma unroll
    for (int r = 1; r < 16; ++r) pmax = fmaxf(pmax, p0[r]);
#pragma unroll
    for (int r = 0; r < 16; ++r) pmax = fmaxf(pmax, p1[r]);
    { auto rr = __builtin_amdgcn_permlane32_swap(__float_as_uint(pmax), __float_as_uint(pmax), false, false);
      pmax = fmaxf(__uint_as_float(rr[0]), __uint_as_float(rr[1])); }
    if (__builtin_expect(__all(pmax - m_reg <= THR * (AQ8_SCALE * AK8_SCALE)), 1)) { mn = m_reg; alpha = 1.f; }
    else { mn = fmaxf(m_reg, pmax); alpha = __builtin_amdgcn_exp2f((m_reg - mn) * C); m_reg = mn; }
    const float mnC = AP8_LOG2 - mn * C;
#pragma unroll
    for (int r = 0; r < 16; ++r) p0[r] = fmaf(p0[r], C, mnC);
#pragma unroll
    for (int r = 0; r < 16; ++r) p1[r] = fmaf(p1[r], C, mnC);
#pragma unroll
    for (int r = 0; r < 16; ++r) p0[r] = __builtin_amdgcn_exp2f(p0[r]);
}
typedef int av8i __attribute__((ext_vector_type(8)));
typedef int av4i __attribute__((ext_vector_type(4)));
__device__ __forceinline__ void finishSM(f32x16& p0, f32x16& p1, float alpha, float& l_reg, av8i& pk) {
#pragma unroll
    for (int r = 0; r < 16; ++r) p1[r] = __builtin_amdgcn_exp2f(p1[r]);
    float ps = 0;
#pragma unroll
    for (int r = 0; r < 16; ++r) ps += p0[r];
#pragma unroll
    for (int r = 0; r < 16; ++r) ps += p1[r];
    { auto rr = __builtin_amdgcn_permlane32_swap(__float_as_uint(ps), __float_as_uint(ps), false, false);
      ps = __uint_as_float(rr[0]) + __uint_as_float(rr[1]); }
    l_reg = l_reg * alpha + ps;
#pragma unroll
    for (int i = 0; i < 4; ++i) { int w = __builtin_amdgcn_cvt_pk_fp8_f32(p0[4 * i], p0[4 * i + 1], 0, false); pk[i] = __builtin_amdgcn_cvt_pk_fp8_f32(p0[4 * i + 2], p0[4 * i + 3], w, true);
        int x = __builtin_amdgcn_cvt_pk_fp8_f32(p1[4 * i], p1[4 * i + 1], 0, false); pk[4 + i] = __builtin_amdgcn_cvt_pk_fp8_f32(p1[4 * i + 2], p1[4 * i + 3], x, true); }
}
__device__ __forceinline__ void qkt(f32x16& p0, f32x16& p1, const char* Kns, const char* Krs, const av8i* qf, int r32, int hi) {
    p0 = f32x16{}; p1 = f32x16{};
    const int kbn = r32 * 128 + ((hi << 5) ^ (((r32 >> 1) & 7) << 4)), kbr = r32 * 64 + ((hi << 5) ^ (((r32 >> 2) & 3) << 4));
#pragma unroll
    for (int g = 0; g < 3; ++g) {
        const char* kb = g < 2 ? Kns : Krs; const int o0 = g < 2 ? (kbn ^ (g << 6)) : kbr, o1 = o0 ^ 16, half = g < 2 ? 32 * 128 : 32 * 64;
        const av4i a0l = *reinterpret_cast<const av4i*>(kb + o0), a0h = *reinterpret_cast<const av4i*>(kb + o1), a1l = *reinterpret_cast<const av4i*>(kb + half + o0), a1h = *reinterpret_cast<const av4i*>(kb + half + o1);
        const av8i a0 = __builtin_shufflevector(a0l, a0h, 0, 1, 2, 3, 4, 5, 6, 7), a1 = __builtin_shufflevector(a1l, a1h, 0, 1, 2, 3, 4, 5, 6, 7);
        p0 = __builtin_amdgcn_mfma_scale_f32_32x32x64_f8f6f4(a0, qf[g], p0, 0, 0, 0, 0, 0, 0);
        p1 = __builtin_amdgcn_mfma_scale_f32_32x32x64_f8f6f4(a1, qf[g], p1, 0, 0, 0, 0, 0, 0); }
}
__device__ __forceinline__ void pv_d0(f32x16* o, const char* Vt, av8i pk, int r32, int hi) {
    const int vbs = r32 * 64 + ((hi << 5) ^ (((r32 >> 2) & 3) << 4));
    av4i lo[4], hh[4];
#pragma unroll
    for (int d0 = 0; d0 < 4; ++d0) { lo[d0] = *reinterpret_cast<const av4i*>(Vt + d0 * 2048 + vbs); hh[d0] = *reinterpret_cast<const av4i*>(Vt + d0 * 2048 + (vbs ^ 16)); }
#pragma unroll
    for (int d0 = 0; d0 < 4; ++d0) o[d0] = __builtin_amdgcn_mfma_scale_f32_32x32x64_f8f6f4(pk, __builtin_shufflevector(lo[d0], hh[d0], 0, 1, 2, 3, 4, 5, 6, 7), o[d0], 0, 0, 0, 0, 0, 0);
}
__device__ __forceinline__ void attn_unit(const bf16_t* __restrict__ Qn, const bf16_t* __restrict__ Qr, const bf16_t* __restrict__ Kn, const bf16_t* __restrict__ Kr,
                                          const bf16_t* __restrict__ Vh, bf16_t* __restrict__ Ob, int seq, char* lds) {
    const int tid = threadIdx.x, wid = __builtin_amdgcn_readfirstlane(tid >> 6), lane = tid & 63, r32 = lane & 31, hi = lane >> 5;
    char* V_lds = lds; char* Kn_lds = lds + NVB * SHM_V; char* Kr_lds = Kn_lds + 2 * SHM_KN;
    float* ws = (float*)(Kr_lds + 2 * SHM_KR) + wid * 64; float* li_l = ws; float* al_l = ws + 32;
    float m_reg = -1e30f, l_reg = 0; f32x16 o[4] = {}; av8i qr[3];
    { const unsigned char* q0 = (const unsigned char*)Qn + (long)(wid * QBLK + r32) * 1024 + hi * 32; const unsigned char* q1 = (const unsigned char*)Qr + (long)(wid * QBLK + r32) * 512 + hi * 32;
      qr[0] = *reinterpret_cast<const av8i*>(q0); qr[1] = *reinterpret_cast<const av8i*>(q0 + 64); qr[2] = *reinterpret_cast<const av8i*>(q1); }
    unsigned offV, offKn, offKr;
    { const int row = 16 * wid + (lane >> 2), colB = ((lane & 3) * 16) ^ (((row >> 2) & 3) << 4); offV = (unsigned)(row * 4096) + (unsigned)colB; }
    { const int row = 8 * wid + (lane >> 3), colB = ((lane & 7) * 16) ^ (((row >> 1) & 7) << 4); offKn = (unsigned)(row * 1024) + (unsigned)colB; }
    { const int row = 16 * (wid & 3) + (lane >> 2), colB = ((lane & 3) * 16) ^ (((row >> 2) & 3) << 4); offKr = (unsigned)(row * 64) + (unsigned)colB; }
#define LASP(p) ((LAS unsigned*)(unsigned)(uintptr_t)(p))
#define SLOAD(k0, b, bv) do { \
        __builtin_amdgcn_global_load_lds((const unsigned*)((const char*)Vh + (size_t)(k0) + offV), LASP(V_lds + (bv) * SHM_V + wid * 1024), 16, 0, 0); \
        __builtin_amdgcn_global_load_lds((const unsigned*)((const char*)Kn + (size_t)(k0) * 1024 + offKn), LASP(Kn_lds + (b) * SHM_KN + wid * 1024), 16, 0, 0); \
        if (wid < 4) __builtin_amdgcn_global_load_lds((const unsigned*)((const char*)Kr + (size_t)(k0) * 64 + offKr), LASP(Kr_lds + (b) * SHM_KR + wid * 1024), 16, 0, 0); } while (0)
#define SWAIT() asm volatile("s_waitcnt vmcnt(0)" ::: "memory")
#define RESC(a) do { if (__any((a) < 1.f)) { if (hi == 0) al_l[r32] = (a); asm volatile("s_waitcnt lgkmcnt(0)" ::: "memory"); \
    _Pragma("unroll") for (int d = 0; d < 4; ++d) _Pragma("unroll") for (int r = 0; r < 16; ++r) o[d][r] *= al_l[crow(r, hi)]; } } while (0)
    f32x16 p0, p1; float mn, al; av8i pk; const int NT = seq / KVBLK;
    SLOAD(0, 0, 0); SWAIT(); __syncthreads();
    if (wid < 4) {
        int bv = 0;
        for (int j = 0; j < NT; ++j) {
            const int buf = j & 1, bvn = bv == NVB - 1 ? 0 : bv + 1;
            if (j + 1 < NT) SLOAD((j + 1) * KVBLK, buf ^ 1, bvn);
            SBAR(); qkt(p0, p1, Kn_lds + buf * SHM_KN, Kr_lds + buf * SHM_KR, qr, r32, hi);
            partialSM(p0, p1, m_reg, mn, al);
            RESC(al);
            finishSM(p0, p1, al, l_reg, pk); SBAR();
            pv_d0(o, V_lds + bv * SHM_V, pk, r32, hi);
            SWAIT();
            __syncthreads();
            bv = bvn;
        }
    } else {
        int bv = 0, bvp = 0;
        for (int j = 0; j < NT; ++j) {
            const int buf = j & 1, bvn = bv == NVB - 1 ? 0 : bv + 1;
            if (j + 1 < NT) SLOAD((j + 1) * KVBLK, buf ^ 1, bvn);
            if (j > 0) { SBAR(); pv_d0(o, V_lds + bvp * SHM_V, pk, r32, hi); SBAR(); }
            SBAR(); qkt(p0, p1, Kn_lds + buf * SHM_KN, Kr_lds + buf * SHM_KR, qr, r32, hi);
            partialSM(p0, p1, m_reg, mn, al);
            RESC(al);
            finishSM(p0, p1, al, l_reg, pk); SBAR();
            SWAIT();
            __syncthreads();
            bvp = bv; bv = bvn;
        }
        SBAR(); pv_d0(o, V_lds + bvp * SHM_V, pk, r32, hi);
    }
    if (hi == 0) li_l[r32] = l_reg; asm volatile("s_waitcnt lgkmcnt(0)" ::: "memory");
    float rli[16];
#pragma unroll
    for (int r = 0; r < 16; ++r) rli[r] = __builtin_amdgcn_rcpf(li_l[crow(r, hi)]) * (1.0f / AV8_SCALE);
    unsigned char* Ow = (unsigned char*)Ob + (long)(wid * QBLK) * 1024;
#pragma unroll
    for (int r = 0; r < 16; ++r) { const int orow = crow(r, hi); const float sc = rli[r] * O8_SCALE;
#pragma unroll
        for (int d0 = 0; d0 < 4; ++d0) Ow[(long)orow * 1024 + d0 * 32 + r32] = (unsigned char)(__builtin_amdgcn_cvt_pk_fp8_f32(__builtin_amdgcn_fmed3f(o[d0][r] * sc, -448.f, 448.f), 0.f, 0, false) & 0xff); }
#undef SLOAD
#undef LASP
#undef SWAIT
#undef RESC
}
}

struct Args { const float* in[26]; float* out; unsigned char* ws; int ph_lo, ph_hi; };
enum { PH_SETUP = 0, PH_H, PH_INPROJ, PH_INPROJ_V, PH_KT, PH_CHAIN, PH_MLAQ, PH_MLAKV, PH_GA, PH_ATTN, PH_GC, PH_MIXA, PH_GN, PH_MIXB, PH_MIX, PH_ROUTER, PH_DISPATCH, PH_GU, PH_DOWN, PH_COMBINE, NPH };
enum { I_X = 0, I_C, I_POS, I_WADA, I_BADA, I_GPREM, I_GPOSTM, I_GPREF, I_GPOSTF, I_WIN, I_QAN, I_WQB, I_KVAN, I_WKVB, I_WMLAO, I_DECF, I_DECB, I_RETGN, I_WRETO, I_WOUT, I_WROUTER, I_BROUTER, I_WGU, I_BGU, I_WDOWN, I_BDOWN };

__device__ __forceinline__ int src_in(int r) {
    if (r < 1024) return r;
    if (r < 1088) { const int j = r - 1024; return 1024 + (j >> 1) + 32 * (j & 1); }
    if (r < 1280) return -1;
    if (r < N_IN_NAT) { const int g = (r - 1280) >> 11, off = (r - 1280) & 2047; const int base = g == 0 ? 1088 : (g == 1 ? 3136 : (g == 2 ? 7232 : (g == 3 ? 9280 : 11328))); return base + off; }
    return 5184 + (r - N_IN_NAT);
}
__device__ __forceinline__ int src_qb(int r) { if (r < 1024) return (r >> 7) * 192 + (r & 127); const int j = r - 1024, h = j >> 6, jj = j & 63; return h * 192 + 128 + (jj >> 1) + 32 * (jj & 1); }
__device__ __forceinline__ int src_kvb(int r) { if (r < 1024) return (r >> 7) * 256 + (r & 127); const int j = r - 1024; return (j >> 7) * 256 + 128 + (j & 127); }
__device__ __forceinline__ int src_gu(int r) { const int t = r >> 8, rr = r & 255; return rr < 128 ? 128 * t + rr : 2048 + 128 * t + rr - 128; }

__device__ __forceinline__ void cvt_item(const float* __restrict__ W, int ldw, int K, bf16_t* __restrict__ WT, const float* __restrict__ kscale, int sc, int k0, int r0, LAS float* scr, int lane) {
    float v[64];
    const float* wp = W + (size_t)k0 * ldw + (sc >= 0 ? sc : 0);
#pragma unroll
    for (int i = 0; i < 64; ++i) v[i] = wp[(size_t)i * ldw];
    if (sc < 0) {
#pragma unroll
        for (int i = 0; i < 64; ++i) v[i] = 0.f;
    }
    if (kscale) {
#pragma unroll
        for (int i = 0; i < 64; ++i) v[i] *= kscale[k0 + i];
    }
#pragma unroll
    for (int i = 0; i < 64; ++i) scr[i * 65 + lane] = v[i];
    asm volatile("s_waitcnt lgkmcnt(0)" ::: "memory");
    const int c = lane & 7;
#pragma unroll
    for (int j = 0; j < 8; ++j) { const int n = (lane >> 3) + 8 * j; const LAS float* s = scr + (8 * c) * 65 + n;
        u32x4 o; o.x = cvt_pk_bf16(s[0 * 65], s[1 * 65]); o.y = cvt_pk_bf16(s[2 * 65], s[3 * 65]); o.z = cvt_pk_bf16(s[4 * 65], s[5 * 65]); o.w = cvt_pk_bf16(s[6 * 65], s[7 * 65]);
        *(u32x4*)(WT + (size_t)(r0 + n) * K + k0 + 8 * c) = o; }
    asm volatile("s_waitcnt lgkmcnt(0)" ::: "memory");
}

constexpr int XT_NT_GU = 32 * 16 * 16, XT_NT_ALL = XT_NT_GU + 32 * 16 * 8;
__device__ __forceinline__ void xt_convert_tiles(int q0, const int qs, const int qe, const float* __restrict__ wgu, const float* __restrict__ wdn, bf16_t* WT_GU, bf16_t* WT_DOWN, LAS unsigned char* lds, const int lane, const int wave) {
    constexpr int NT_GU = XT_NT_GU, TS = 144;
    f32x4 va[16], vb[16], vc[16];
#define XT_SRC(q_, kk_) ((q_) < NT_GU ? wgu + ((size_t)((q_) >> 8) * 2048 + (((q_) >> 4) & 15) * 128 + 16 * wave + (kk_)) * 4096 + (lane < 32 ? 128 * ((q_) & 15) + 4 * lane : 2048 + 128 * ((q_) & 15) + 4 * lane - 128) \
                                  : wdn + ((size_t)(((q_) - NT_GU) >> 7) * 2048 + ((((q_) - NT_GU) >> 3) & 15) * 128 + 16 * wave + (kk_)) * 2048 + 256 * (((q_) - NT_GU) & 7) + 4 * lane)
#define XT_LOAD(v_, q_) do { const float* _p = XT_SRC(q_, 0); const size_t _ld = (q_) < NT_GU ? 4096 : 2048; _Pragma("unroll") for (int kk = 0; kk < 16; ++kk) v_[kk] = __builtin_nontemporal_load((const f32x4*)(_p + kk * _ld)); } while (0)
#define XT_PROC(v_, q_, buf_) do { LAS unsigned char* _T = lds + (buf_) * (256 * TS); \
        _Pragma("unroll") for (int i = 0; i < 4; ++i) { u32x4 w0; \
            w0.x = pk4_fp8(v_[0][i], v_[1][i], v_[2][i], v_[3][i], W8_SCALE); w0.y = pk4_fp8(v_[4][i], v_[5][i], v_[6][i], v_[7][i], W8_SCALE); \
            w0.z = pk4_fp8(v_[8][i], v_[9][i], v_[10][i], v_[11][i], W8_SCALE); w0.w = pk4_fp8(v_[12][i], v_[13][i], v_[14][i], v_[15][i], W8_SCALE); \
            *(LAS u32x4*)(_T + (4 * lane + i) * TS + 16 * wave) = w0; } \
        __syncthreads(); \
        unsigned char* _d = (q_) < NT_GU ? (unsigned char*)WT_GU + ((size_t)((q_) >> 8) * 4096 + 256 * ((q_) & 15)) * 2048 + (((q_) >> 4) & 15) * 128 \
                 : (unsigned char*)WT_DOWN + ((size_t)(((q_) - NT_GU) >> 7) * 2048 + 256 * (((q_) - NT_GU) & 7)) * 2048 + ((((q_) - NT_GU) >> 3) & 15) * 128; \
        _Pragma("unroll") for (int j = 0; j < 4; ++j) { const int row = 32 * wave + 8 * j + (lane >> 3); \
            const u32x4 o = *(const LAS u32x4*)(_T + row * TS + (lane & 7) * 16); __builtin_nontemporal_store(o, (u32x4*)(_d + (size_t)row * 2048 + (lane & 7) * 16)); } } while (0)
    int q = q0;
    if (q < qe) XT_LOAD(va, q);
    if (q + qs < qe) XT_LOAD(vb, q + qs);
    while (q < qe) {
        const int q1 = q + qs, q2 = q1 + qs, q3 = q2 + qs, q4 = q3 + qs;
        if (q2 < qe) XT_LOAD(vc, q2);
        XT_PROC(va, q, 0);
        if (q1 >= qe) break;
        if (q3 < qe) XT_LOAD(va, q3);
        XT_PROC(vb, q1, 1);
        if (q2 >= qe) break;
        if (q4 < qe) XT_LOAD(vb, q4);
        XT_PROC(vc, q2, 2);
        q = q3;
    }
    __syncthreads();
#undef XT_SRC
#undef XT_LOAD
#undef XT_PROC
}
__host__ __device__ constexpr bool is_seam(int k) { return k == PH_SETUP || k == PH_H || k == PH_INPROJ_V || k == PH_KT || k == PH_GA || k == PH_ATTN || k == PH_MIXA || k == PH_MIXB || k == PH_MIX || k == PH_ROUTER || k == PH_DISPATCH || k == PH_GU || k == PH_DOWN; }
__host__ __device__ constexpr int seam_after(int ph) { int k = ph; while (k < NPH && !is_seam(k)) ++k; return k; }
__host__ __device__ constexpr int seam_before(int ph) { int k = ph - 1; while (k >= 0 && !is_seam(k)) --k; return k; }
__device__ __forceinline__ const void* larg(volatile LAS unsigned long long* L, int i) {
    const unsigned long long v = L[i]; const unsigned l0 = __builtin_amdgcn_readfirstlane((unsigned)v), h0 = __builtin_amdgcn_readfirstlane((unsigned)(v >> 32));
    return (const void*)(const __attribute__((address_space(1))) void*)(((unsigned long long)h0 << 32) | l0);
}
__global__ void __launch_bounds__(512, 2) fwd_kernel(Args args) {
    extern __shared__ __attribute__((aligned(16))) unsigned char lds_raw[];
    LAS unsigned char* lds = (LAS unsigned char*)lds_raw;
    volatile LAS unsigned* MISC = (volatile LAS unsigned*)(lds + MISC_OFF);
    const int tid = threadIdx.x;
    const int G = gridDim.x, bx = blockIdx.x, NGW = G * 8;
    volatile LAS unsigned long long* LARG = (volatile LAS unsigned long long*)(lds + LARG_OFF);
    const int lo = args.ph_lo, hi = args.ph_hi;
    for (int u = tid; u < (LDS_BYTES - CTRL_OFF) / 4; u += 512) ((LAS unsigned*)(lds + CTRL_OFF))[u] = 0u;
    __syncthreads();
    if (tid == 0) {
#pragma unroll
        for (int i = 0; i < 26; ++i) LARG[i] = (unsigned long long)args.in[i];
        LARG[26] = (unsigned long long)args.out; LARG[27] = (unsigned long long)args.ws;
    }
    __syncthreads();
    unsigned bar_x = 0u;
    if (hi - lo > 1) bar_x = xcd_barrier_post((unsigned*)(args.ws + WS_CTL) + CW_BAR, MISC + 8).x;
#ifdef PH_ONLY
#define IN(k) ((k) == PH_ONLY && lo <= (k) && (k) < hi)
#else
#define IN(k) (lo <= (k) && (k) < hi)
#endif
#define SEAM(k) do { if (lo <= (k) && (k) + 1 < hi) { XcdBarrier _b; _b.bar = (unsigned*)((unsigned char*)larg(LARG, 27) + WS_CTL) + CW_BAR; _b.x = bar_x; _b.st = MISC + 8; xcd_barrier(_b); } if (STAMP_PHASE >= 0) { const unsigned long long _t = __builtin_amdgcn_s_memrealtime(); if (seam_after(STAMP_PHASE) == (k)) st_dt = _t - st_t0; if (seam_before(STAMP_PHASE) == (k)) st_t0 = _t; } } while (0)
#define INP(i) ((const float*)larg(LARG, (i)))
#ifndef REP_PHASE
#define REP_PHASE (-1)
#endif
#define NREP(k) ((k) == REP_PHASE ? 2 : 1)
#ifndef STAMP_PHASE
#define STAMP_PHASE (-1)
#endif
#ifndef STAMP_MUL
#define STAMP_MUL 4
#endif
    unsigned long long st_t0 = (STAMP_PHASE >= 0 && seam_before(STAMP_PHASE) < 0) ? __builtin_amdgcn_s_memrealtime() : 0ull, st_dt = 0ull;
#define PTRS \
    int tid = threadIdx.x; asm volatile("" : "+v"(tid)); const int lane = tid & 63, wave = __builtin_amdgcn_readfirstlane(tid >> 6), gw = bx * 8 + wave; (void)lane; (void)gw; \
    unsigned char* const ws = (unsigned char*)larg(LARG, 27); unsigned* const ctl = (unsigned*)(ws + WS_CTL); float* const outp = (float*)larg(LARG, 26); \
    float* const ada = (float*)(ctl + CW_ADA); float* const SSQP = (float*)(ws + WS_SSQP); \
    bf16_t* const WT_IN = (bf16_t*)(ws + WS_WT_IN); bf16_t* const WT_QB = (bf16_t*)(ws + WS_WT_QB); bf16_t* const WT_KVB = (bf16_t*)(ws + WS_WT_KVB); bf16_t* const WT_MLAO = (bf16_t*)(ws + WS_WT_MLAO); \
    bf16_t* const WT_RETO = (bf16_t*)(ws + WS_WT_RETO); bf16_t* const WT_OUT = (bf16_t*)(ws + WS_WT_OUT); bf16_t* const WT_GU = (bf16_t*)(ws + WS_WT_GU); bf16_t* const WT_DOWN = (bf16_t*)(ws + WS_WT_DOWN); \
    float* const CS_RET = (float*)(ws + WS_CS_RET); float* const CS_MLA = (float*)(ws + WS_CS_MLA); \
    bf16_t* const Hb = (bf16_t*)(ws + WS_H); bf16_t* const QL = (bf16_t*)(ws + WS_QL); bf16_t* const CKV = (bf16_t*)(ws + WS_CKV); bf16_t* const KR = (bf16_t*)(ws + WS_KR); \
    bf16_t* const ACAT = (bf16_t*)(ws + WS_ACAT); bf16_t* const BCAT = (bf16_t*)(ws + WS_BCAT); bf16_t* const KROT = (bf16_t*)(ws + WS_KROT); bf16_t* const KZTF = (bf16_t*)(ws + WS_KZTF); bf16_t* const KZTB = (bf16_t*)(ws + WS_KZTB); \
    bf16_t* const SG = (bf16_t*)(ws + WS_SG); bf16_t* const GA = (bf16_t*)(ws + WS_GA); bf16_t* const GB = (bf16_t*)(ws + WS_GB); \
    bf16_t* const QN = (bf16_t*)(ws + WS_QN); bf16_t* const QR = (bf16_t*)(ws + WS_QR); bf16_t* const KN = (bf16_t*)(ws + WS_KN); bf16_t* const VV = (bf16_t*)(ws + WS_VV); bf16_t* const OA = (bf16_t*)(ws + WS_OA); \
    float* const ORET = (float*)(ws + WS_ORET); bf16_t* const OB = (bf16_t*)(ws + WS_OB); bf16_t* const MIXP = (bf16_t*)(ws + WS_MIXP); bf16_t* const MIXIN = (bf16_t*)(ws + WS_MIXIN); float* const MIX = (float*)(ws + WS_MIX); \
    bf16_t* const H2 = (bf16_t*)(ws + WS_H2); int* const TOPI = (int*)(ws + WS_TOPI); float* const TOPW = (float*)(ws + WS_TOPW); int* const DEST = (int*)(ws + WS_DEST); int* const TILE = (int*)(ws + WS_TILE); float* const DECTAB = (float*)(ws + WS_DECTAB); \
    bf16_t* const XS = (bf16_t*)(ws + WS_XS); bf16_t* const ACT = (bf16_t*)(ws + WS_ACT); bf16_t* const YS = (bf16_t*)(ws + WS_YS); \
    (void)ctl; (void)outp; (void)ada; (void)SSQP; (void)WT_IN; (void)WT_QB; (void)WT_KVB; (void)WT_MLAO; (void)WT_RETO; (void)WT_OUT; (void)WT_GU; (void)WT_DOWN; (void)CS_RET; (void)CS_MLA; (void)Hb; (void)QL; (void)CKV; (void)KR; \
    (void)ACAT; (void)BCAT; (void)KROT; (void)KZTF; (void)KZTB; (void)SG; (void)GA; (void)GB; (void)QN; (void)QR; (void)KN; (void)VV; (void)OA; (void)ORET; (void)OB; (void)MIXP; (void)MIXIN; (void)MIX; (void)H2; (void)TOPI; (void)TOPW; (void)DEST; (void)TILE; (void)DECTAB; (void)XS; (void)ACT; (void)YS;

    if (IN(PH_SETUP)) for (int rep = 0; rep < NREP(PH_SETUP); ++rep) {
        PTRS
        if (bx == 0 && tid < 16) DECTAB[tid] = log2_sigmoid(tid < 8 ? INP(I_DECF)[tid] : INP(I_DECB)[tid - 8]);
        {
            const float* wr = INP(I_WROUTER); float* wrt = (float*)(ws + WS_WRT);
            for (int o = bx * 512 + tid; o < 65536; o += G * 512) { const int i = o & 3, ln = (o >> 2) & 63, t = (o >> 8) & 1, st4 = (o >> 9) & 15, w = o >> 13;
                wrt[o] = wr[(size_t)(256 * w + 4 * (4 * st4 + i) + (ln >> 4)) * 32 + (ln & 15) + 16 * t]; }
        }
#ifndef SETUP_REP_ADA
#define SETUP_REP_ADA 1
#define SETUP_REP_TAB 1
#define SETUP_REP_CPY 1
#endif
        for (int r2 = 0; r2 < SETUP_REP_ADA; ++r2) {
            const float* wada = INP(I_WADA); const float* cvec = INP(I_C); float* adap = (float*)(ws + WS_ADAP);
            for (int it = gw; it < 192 * 8; it += NGW) {
                const int jb = it % 192, kp = it / 192, j = jb * 64 + lane;
                float a0 = 0.f, a1 = 0.f, a2 = 0.f, a3 = 0.f;
#pragma nounroll
                for (int k0 = kp * 256; k0 < kp * 256 + 256; k0 += 32) {
                    float w[32]; const float* wp = wada + (size_t)k0 * 12288 + j;
#pragma unroll
                    for (int i = 0; i < 32; ++i) { w[i] = __builtin_nontemporal_load(wp); wp += 12288; asm volatile("" : "+v"(wp)); }
#pragma unroll
                    for (int i = 0; i < 32; ++i) { a0 += w[i] * cvec[k0 + i]; a1 += w[i] * cvec[2048 + k0 + i]; a2 += w[i] * cvec[4096 + k0 + i]; a3 += w[i] * cvec[6144 + k0 + i]; }
                }
                float* o = adap + (size_t)kp * 49152 + j;
                o[0] = a0; o[12288] = a1; o[24576] = a2; o[36864] = a3;
            }
        }
        for (int r2 = 0; r2 < SETUP_REP_TAB; ++r2) {
            const int* pos = (const int*)INP(I_POS);
            for (int i = bx * 512 + tid; i < T * 160; i += G * 512) {
                const int tok = i / 160, f = i % 160; const float p = (float)pos[tok];
                float inv; float* dst;
                if (f < 128) { inv = 1.0f / powf(10000.0f, (float)f / 128.0f); dst = CS_RET + (size_t)tok * 256 + f * 2; }
                else { inv = 1.0f / powf(10000.0f, (float)(f - 128) / 32.0f); dst = CS_MLA + (size_t)tok * 64 + (f - 128) * 2; }
                float s, c; sincosf(p * inv, &s, &c); dst[0] = c; dst[1] = s;
            }
        }
        for (int r2 = 0; r2 < SETUP_REP_CPY; ++r2) {
            LAS float* scr = (LAS float*)(lds + wave * 16640);
            constexpr int I_IN = (N_IN_ALL / 64) * 32, I_QB = 24 * 8, I_KVB = 32 * 8, I_MLAO = 32 * 16, I_SQ = 32 * 32;
            constexpr int NITEMS = I_IN + I_QB + I_KVB + I_MLAO + 2 * I_SQ;
            unsigned* cq = ctl + CW_CVTQ + rep + 2 * r2;
#define CVT_GRAB(dst) do { unsigned _v = 0u; if (lane == 0) _v = atomicAdd(cq, 8u); dst = (int)__builtin_amdgcn_readfirstlane(_v); } while (0)
#define CVT_DEC(r_, wp_, dst_, ks_, ldw_, K_, sc_) do { int r = (r_); const float* W_; bf16_t* WT_; const float* kq_ = nullptr; int nkb_, mat_; \
                if (r < I_IN) { W_ = INP(I_WIN); WT_ = WT_IN; ldw_ = 13376; K_ = 2048; nkb_ = 32; mat_ = 2; } \
                else if ((r -= I_IN) < I_QB) { W_ = INP(I_WQB); WT_ = WT_QB; kq_ = INP(I_QAN); ldw_ = 1536; K_ = 512; nkb_ = 8; mat_ = 3; } \
                else if ((r -= I_QB) < I_KVB) { W_ = INP(I_WKVB); WT_ = WT_KVB; kq_ = INP(I_KVAN); ldw_ = 2048; K_ = 512; nkb_ = 8; mat_ = 4; } \
                else if ((r -= I_KVB) < I_MLAO) { W_ = INP(I_WMLAO); WT_ = WT_MLAO; ldw_ = 2048; K_ = 1024; nkb_ = 16; mat_ = 6; } \
                else if ((r -= I_MLAO) < I_SQ) { W_ = INP(I_WRETO); WT_ = WT_RETO; ldw_ = 2048; K_ = 2048; nkb_ = 32; mat_ = 5; } \
                else { r -= I_SQ; W_ = INP(I_WOUT); WT_ = WT_OUT; ldw_ = 2048; K_ = 2048; nkb_ = 32; mat_ = 5; } \
                const int q4_ = r >> 2, kb_ = q4_ % nkb_, nb_ = (q4_ / nkb_) * 4 + (r & 3), rr_ = nb_ * 64 + lane; \
                sc_ = ((mat_ == 1 || mat_ == 5 || mat_ == 6) ? rr_ : (mat_ == 2 ? src_in(rr_) : (mat_ == 3 ? src_qb(rr_) : src_kvb(rr_)))); \
                wp_ = W_ + (size_t)(kb_ * 64) * ldw_ + (sc_ >= 0 ? sc_ : 0); dst_ = WT_ + (size_t)(nb_ * 64) * K_ + kb_ * 64; ks_ = kq_ ? kq_ + kb_ * 64 : nullptr; \
                if (mat_ == 3 || mat_ == 4) { K_ = -3; dst_ = (bf16_t*)((unsigned char*)WT_ + (size_t)(nb_ * 64) * 512 + kb_ * 64); }   \
                if (mat_ == 6) { K_ = -2; dst_ = (bf16_t*)((unsigned char*)WT_ + (size_t)(nb_ * 64) * 1024 + kb_ * 64); }   \
                if (mat_ == 5) { K_ = -1; dst_ = (bf16_t*)((unsigned char*)WT_ + (size_t)(nb_ * 64) * 2048 + kb_ * 64); }   \
                if (mat_ == 2 && (nb_ < 16 || (nb_ >= 84 && nb_ < 180))) { K_ = -1; dst_ = (bf16_t*)(ws + WS_WT8B + (size_t)((nb_ < 16 ? nb_ : nb_ - 68) * 64) * 2048 + kb_ * 64); } \
                if (mat_ == 2 && nb_ >= 16 && nb_ < 20) { K_ = -1; dst_ = (bf16_t*)(ws + WS_WT8K + (size_t)((nb_ - 16) * 64) * 2048 + kb_ * 64); } } while (0)
            float v[64];
            const float* wpc; bf16_t* dstc; const float* ksc; int ldwc, Kc, scc;
            const float* wpn = nullptr; bf16_t* dstn = nullptr; const float* ksn = nullptr; int ldwn = 0, Kn = 0, scn = 0;
            constexpr int QCH = 8; static_assert(NITEMS % QCH == 0, "queue chunk");
            int itc, itn, cend; CVT_GRAB(itc); itn = itc + 1; cend = itc + QCH;
            bool hc = itc < NITEMS;
            if (hc) { CVT_DEC(itc, wpc, dstc, ksc, ldwc, Kc, scc);
#pragma unroll
                for (int i = 0; i < 64; ++i) v[i] = __builtin_nontemporal_load(wpc + (size_t)i * ldwc); }
            while (hc) {
                const bool hn = itn < NITEMS;
                if (hn) CVT_DEC(itn, wpn, dstn, ksn, ldwn, Kn, scn);
                const bool need = (itn + 1 >= cend); unsigned raw_nn = 0u; if (need && lane == 0) raw_nn = atomicAdd(cq, (unsigned)QCH);
#pragma unroll
                for (int g = 0; g < 4; ++g) {
#pragma unroll
                    for (int i = 0; i < 16; ++i) { float x = scc >= 0 ? v[16 * g + i] : 0.f; if (ksc) x *= ksc[16 * g + i]; scr[(16 * g + i) * 65 + lane] = x; }
                    if (hn) {
#pragma unroll
                        for (int i = 0; i < 16; ++i) v[16 * g + i] = __builtin_nontemporal_load(wpn + (size_t)(16 * g + i) * ldwn); }
                }
                asm volatile("s_waitcnt lgkmcnt(0)" ::: "memory");
                const int c = lane & 7;
#pragma unroll
                for (int j = 0; j < 8; ++j) { const int n = (lane >> 3) + 8 * j; const LAS float* sp = scr + (8 * c) * 65 + n;
                    if (Kc < 0) { u32x2 o8; o8.x = pk4_fp8(sp[0 * 65], sp[1 * 65], sp[2 * 65], sp[3 * 65], W8_SCALE); o8.y = pk4_fp8(sp[4 * 65], sp[5 * 65], sp[6 * 65], sp[7 * 65], W8_SCALE);
                        *(u32x2*)((unsigned char*)dstc + (size_t)n * (Kc == -1 ? 2048 : (Kc == -2 ? 1024 : 512)) + 8 * c) = o8; }
                    else { u32x4 o; o.x = cvt_pk_bf16(sp[0 * 65], sp[1 * 65]); o.y = cvt_pk_bf16(sp[2 * 65], sp[3 * 65]); o.z = cvt_pk_bf16(sp[4 * 65], sp[5 * 65]); o.w = cvt_pk_bf16(sp[6 * 65], sp[7 * 65]);
                        __builtin_nontemporal_store(o, (u32x4*)(dstc + (size_t)n * Kc + 8 * c)); } }
                asm volatile("s_waitcnt lgkmcnt(0)" ::: "memory");
                wpc = wpn; dstc = dstn; ksc = ksn; ldwc = ldwn; Kc = Kn; scc = scn; hc = hn;
                if (need) { itn = (int)__builtin_amdgcn_readfirstlane(raw_nn); cend = itn + QCH; } else itn = itn + 1;
            }
#undef CVT_GRAB
#undef CVT_DEC
        }
    }
    SEAM(PH_SETUP);
    if (IN(PH_H)) for (int rep = 0; rep < NREP(PH_H); ++rep) {
        PTRS
        const float* g = INP(I_GPREM);
        {
            const float* adap = (const float*)(ws + WS_ADAP); const float* bada = INP(I_BADA); LAS float* AD = (LAS float*)lds;
            if (tid < 192) { const int idx = bx * 192 + tid; if (idx < 49152) { const int j = idx % 12288; float a = 0.f;
#pragma unroll
                for (int pq = 0; pq < 8; ++pq) a += adap[(size_t)pq * 49152 + idx];
                ada[idx] = a + bada[j]; } }
            for (int i = tid; i < 16384; i += 512) { const int b = i >> 12, col = i & 4095; float a = 0.f;
#pragma unroll
                for (int pq = 0; pq < 8; ++pq) a += adap[(size_t)pq * 49152 + b * 12288 + col];
                AD[i] = a + bada[col]; }
            __syncthreads();
        }
        const LAS float* AD = (const LAS float*)lds;
        f32x4 vn[8];
        if (gw < T) { const f32x4* xr = (const f32x4*)(INP(I_X) + (size_t)gw * D) + lane;
#pragma unroll
            for (int j = 0; j < 8; ++j) vn[j] = xr[64 * j]; }
        for (int mrow = gw; mrow < T; mrow += NGW) {
            const int b = mrow / SEQ;
            f32x4 v[8]; float s = 0.f;
#pragma unroll
            for (int j = 0; j < 8; ++j) { v[j] = vn[j]; s += (v[j][0] * v[j][0] + v[j][1] * v[j][1]) + (v[j][2] * v[j][2] + v[j][3] * v[j][3]); }
            if (mrow + NGW < T) { const f32x4* xr = (const f32x4*)(INP(I_X) + (size_t)(mrow + NGW) * D) + lane;
#pragma unroll
                for (int j = 0; j < 8; ++j) vn[j] = xr[64 * j]; }
            const float r = rsqrtf(wave_sum(s) * (1.0f / D) + RMS_EPS);
            u32x2* o8 = (u32x2*)(Hb + (size_t)mrow * D) + lane; unsigned* q8 = (unsigned*)(ws + WS_H8 + (size_t)mrow * D) + lane;
#pragma unroll
            for (int j = 0; j < 8; ++j) { const int col = 256 * j + 4 * lane; const f32x4 gg = *(const f32x4*)(g + col), sh = *(const LAS f32x4*)(AD + b * 4096 + col), sc = *(const LAS f32x4*)(AD + b * 4096 + 2048 + col);
                const f32x4 y = v[j] * r * gg * (sc + 1.0f) + sh; u32x2 w; w.x = cvt_pk_bf16(y[0], y[1]); w.y = cvt_pk_bf16(y[2], y[3]); o8[64 * j] = w; q8[64 * j] = pk4_fp8(y[0], y[1], y[2], y[3], H8_SCALE); }
        }
    }
    SEAM(PH_H);
    if (IN(PH_INPROJ)) for (int rep = 0; rep < NREP(PH_INPROJ); ++rep) {
        PTRS
        {   pg8::InprojSched S{(const char*)Hb, (const char*)WT_IN, G, bx};
            EpiInprojAll E{EpiInproj{QL, CKV, KR, ACAT, KROT, SG, GA, GB, SSQP, CS_RET, CS_MLA, DECTAB, 0, 1.0f}, EpiVT{BCAT, ws + WS_VT8}};
            pg8::gemm_phase(lds, 2048, 2048, 2048, S, E); }
        {
            pg8::GridSched S{(const char*)(ws + WS_H8), (const char*)(ws + WS_WT8B), (size_t)256 * 2048, (size_t)256 * 2048, T / 256, 28, G, bx};
            EpiInproj E{QL, CKV, KR, ACAT, KROT, SG, GA, GB, SSQP, CS_RET, CS_MLA, DECTAB, 17, GU_UNSCALE, 1};
            pg8::gemm_phase<EpiInproj, pg8::GridSched, true>(lds, 2048, 2048, 2048, S, E); }
    }
    SEAM(PH_INPROJ_V);
    if (IN(PH_KT)) for (int rep = 0; rep < NREP(PH_KT); ++rep) {
        PTRS
        {
            constexpr int TP = 528;
            u32x4 ra[16], rb[16];
#define KT_LOAD(r_, blk_) do { const bf16_t* _s = KROT + ((size_t)(blk_) * 256 + 32 * wave + 16 * (lane >> 5)) * 256 + 8 * (lane & 31); _Pragma("unroll") for (int i = 0; i < 16; ++i) r_[i] = *(const u32x4*)(_s + i * 256); } while (0)
#define KT_PROC(r_, blk_) do { const int _h = ((blk_) >> 4) & 7; const float _lf = DECTAB[_h], _lb = DECTAB[8 + _h]; \
                _Pragma("unroll") for (int e = 0; e < 8; ++e) { u32x4 w0, w1; \
                    _Pragma("unroll") for (int i2 = 0; i2 < 4; ++i2) { const unsigned a0 = r_[2 * i2][e >> 1], a1 = r_[2 * i2 + 1][e >> 1], c0 = r_[8 + 2 * i2][e >> 1], c1 = r_[8 + 2 * i2 + 1][e >> 1]; \
                        w0[i2] = (e & 1) ? ((a0 >> 16) | (a1 & 0xffff0000u)) : ((a0 & 0xffffu) | (a1 << 16)); w1[i2] = (e & 1) ? ((c0 >> 16) | (c1 & 0xffff0000u)) : ((c0 & 0xffffu) | (c1 << 16)); } \
                    LAS unsigned char* _t = lds + (8 * (lane & 31) + e) * TP + (32 * wave + 16 * (lane >> 5)) * 2; *(LAS u32x4*)_t = w0; *(LAS u32x4*)(_t + 16) = w1; } \
                __syncthreads(); \
                f32x4 zf0, zf1, zb0, zb1; \
                _Pragma("unroll") for (int t = 0; t < 4; ++t) { const int p0 = 8 * (lane & 31) + t, p1 = p0 + 4; \
                    zf0[t] = __builtin_amdgcn_exp2f((float)(255 - p0) * _lf); zf1[t] = __builtin_amdgcn_exp2f((float)(255 - p1) * _lf); zb0[t] = __builtin_amdgcn_exp2f((float)p0 * _lb); zb1[t] = __builtin_amdgcn_exp2f((float)p1 * _lb); } \
                _Pragma("unroll") for (int j = 0; j < 16; ++j) { const int row = 32 * wave + 2 * j + (lane >> 5); \
                    const u32x4 w = *(const LAS u32x4*)(lds + row * TP + (lane & 31) * 16); f32x4 x0, x1; unpack8(w, x0, x1); \
                    const size_t o = ((size_t)(blk_) * 256 + row) * 256 + 8 * (lane & 31); \
                    const f32x4 f0 = x0 * zf0, f1 = x1 * zf1, g0 = x0 * zb0, g1 = x1 * zb1; u32x2 wf, wb; \
                    wf.x = pk4_fp8(f0[0], f0[1], f0[2], f0[3], K8_SCALE); wf.y = pk4_fp8(f1[0], f1[1], f1[2], f1[3], K8_SCALE); wb.x = pk4_fp8(g0[0], g0[1], g0[2], g0[3], K8_SCALE); wb.y = pk4_fp8(g1[0], g1[1], g1[2], g1[3], K8_SCALE); \
                    *(u32x2*)((unsigned char*)KZTF + o) = wf; *(u32x2*)((unsigned char*)KZTB + o) = wb; } \
                __syncthreads(); } while (0)
            int blk = bx;
            if (blk < NBLK) KT_LOAD(ra, blk);
            while (blk < NBLK) {
                const int b1 = blk + G; if (b1 < NBLK) KT_LOAD(rb, b1);
                KT_PROC(ra, blk);
                if (b1 >= NBLK) break;
                const int b2 = b1 + G; if (b2 < NBLK) KT_LOAD(ra, b2);
                KT_PROC(rb, b1);
                blk = b2;
            }
#undef KT_LOAD
#undef KT_PROC
        }
    }
    SEAM(PH_KT);
    if (IN(PH_CHAIN)) for (int rep = 0; rep < NREP(PH_CHAIN); ++rep) {
        PTRS
        if (bx < 64) {
            const int bh = bx >> 1, dir = bx & 1;
            {
                const int blk0 = bh * NCH + (dir ? NCH - 1 : 0);
                bf16_t* z = BCAT + ((size_t)blk0 * 256 + (tid >> 1)) * 768 + 256 + 256 * dir + (tid & 1) * 128;
#pragma unroll
                for (int q = 0; q < 16; ++q) *(u32x4*)(z + q * 8) = (u32x4){0u, 0u, 0u, 0u};
            }
            pg8::ChainSched S{(const char*)(ws + WS_VT8), (const char*)(dir ? KZTB : KZTF), bh, dir};
            EpiGb E{BCAT, DECTAB, dir};
            pg8::gemm_phase<EpiGb, pg8::ChainSched, true, true>(lds, 256, 256, 256, S, E);
        }
    }
    if (IN(PH_MLAQ)) for (int rep = 0; rep < NREP(PH_MLAQ); ++rep) {
        PTRS
        if (bx >= 64) { const bool ca = bx < 128;
            pg8::GridSchedR S{(const char*)QL, (const char*)WT_QB, (size_t)256 * 512, (size_t)256 * 512, T / 256, 6, ca ? 64 : 128, ca ? bx - 64 : bx - 128, ca ? 0 : 128, ca ? 128 : 384};
            EpiMlaQ E{QN, QR, SSQP, CS_MLA}; pg8::gemm_phase<EpiMlaQ, pg8::GridSchedR, true>(lds, 512, 512, 512, S, E); }
    }
    if (IN(PH_MLAKV)) for (int rep = 0; rep < NREP(PH_MLAKV); ++rep) {
        PTRS
        if (bx >= 128) {
            pg8::GridSchedRS S{(const char*)CKV, (const char*)WT_KVB, (size_t)256 * 512, (size_t)256 * 512, T / 256, 8, 128, bx - 128, 0, 512, 4};
            EpiMlaKV E{KN, (unsigned char*)VV, SSQP + (size_t)8 * T}; pg8::gemm_phase<EpiMlaKV, pg8::GridSchedRS, true>(lds, 512, 512, 512, S, E); }
    }
    if (IN(PH_GA)) for (int rep = 0; rep < NREP(PH_GA); ++rep) {
        PTRS
        if (bx >= 64) { const bool ca = bx < 128;
        {   pg8::BatchSchedR S{(const char*)(ACAT + 256), (const char*)KROT, (size_t)256 * 768 * 2, (size_t)256 * 256 * 2, ca ? 64 : 128, ca ? bx - 64 : bx - 128, ca ? 0 : 256, ca ? 256 : 512};
            EpiGa E{ACAT, DECTAB}; pg8::gemm_phase(lds, 256, 768, 256, S, E); }
        if (ca) {
            pg8::GridSchedR S{(const char*)(ws + WS_H8), (const char*)(ws + WS_WT8K), (size_t)256 * 2048, (size_t)256 * 2048, T / 256, 1, 64, bx - 64, 0, 64};
            EpiInproj E{QL, CKV, KR, ACAT, KROT, SG, GA, GB, SSQP, CS_RET, CS_MLA, DECTAB, 4, GU_UNSCALE}; pg8::gemm_phase<EpiInproj, pg8::GridSchedR, true>(lds, 2048, 2048, 2048, S, E); }
        }
    }
    SEAM(PH_GA);
    if (IN(PH_ATTN)) for (int rep = 0; rep < NREP(PH_ATTN); ++rep) {
        PTRS
        unsigned* queue = ctl + CW_QUEUE + rep; unsigned* cqueue = ctl + CW_QUEUE + 8;
        const float* wgu = INP(I_WGU); const float* wdn = INP(I_WDOWN);
#define CONV_LOOP() do { if (rep == 0) for (;;) { __syncthreads(); if (tid == 0) MISC[1] = atomicAdd(cqueue, 1u); __syncthreads(); const int c = (int)MISC[1]; if (c >= 1536) break; \
            xt_convert_tiles(c * 8, 1, c * 8 + 8, wgu, wdn, WT_GU, WT_DOWN, lds, lane, wave); } } while (0)
        if (bx < CONV_WGS) CONV_LOOP();
        int xq = (int)(xb_xcc_id() & 7u), tries = 0;
        for (;;) {
            __syncthreads();
            if (tid == 0) { int a = -1;
                while (tries < 8) { const unsigned v = atomicAdd(ctl + CW_AQ + 64 * xq + rep, 1u); if (v < 64u) { a = xq * 64 + (int)v; break; } xq = (xq + 1) & 7; ++tries; }
                MISC[0] = (unsigned)a; }
            __syncthreads();
            const int a = (int)MISC[0];
            if (a < 0) break;
            const int bh = a >> 4, qb = a & 15, b = bh >> 3, h = bh & 7;
            const size_t tok0 = (size_t)b * SEQ + qb * 256, kt0 = (size_t)b * SEQ;
            att::attn_unit((const bf16_t*)((const unsigned char*)QN + tok0 * 1024 + h * 128), (const bf16_t*)((const unsigned char*)QR + tok0 * 512 + h * 64), (const bf16_t*)((const unsigned char*)KN + kt0 * 1024 + h * 128), (const bf16_t*)((const unsigned char*)KR + kt0 * 64), (const bf16_t*)((const unsigned char*)VV + (size_t)(b * 8 + h) * 128 * 4096), (bf16_t*)((unsigned char*)OA + tok0 * 1024 + h * 128), SEQ, (char*)lds_raw);
        }
        if (bx >= CONV_WGS) CONV_LOOP();
#undef CONV_LOOP
    }
    SEAM(PH_ATTN);
    if (IN(PH_GC)) for (int rep = 0; rep < NREP(PH_GC); ++rep) {
        PTRS
        {   pg8::BatchSched S{(const char*)ACAT, (const char*)BCAT, (size_t)256 * 768 * 2, (size_t)256 * 768 * 2, NBLK, G, bx};
            EpiGc E{OB, SG, INP(I_RETGN), lds}; pg8::gemm_phase(lds, 768, 768, 768, S, E); }
    }
    if (IN(PH_MIXA)) for (int rep = 0; rep < NREP(PH_MIXA); ++rep) {
        PTRS
        {   pg8::GridSched S{(const char*)OA, (const char*)WT_MLAO, (size_t)256 * 1024, (size_t)256 * 1024, T / 256, 8, G, bx};
            EpiMixA E{MIXP, GA}; pg8::gemm_phase<EpiMixA, pg8::GridSched, true>(lds, 1024, 1024, 1024, S, E); }
    }
    SEAM(PH_MIXA);
    if (IN(PH_MIXB)) for (int rep = 0; rep < NREP(PH_MIXB); ++rep) {
        PTRS
        pg8::GridSched S{(const char*)OB, (const char*)WT_RETO, (size_t)256 * 2048, (size_t)256 * 2048, T / 256, 8, G, bx};
        EpiMixB E{MIXIN, MIXP, GB}; pg8::gemm_phase<EpiMixB, pg8::GridSched, true>(lds, 2048, 2048, 2048, S, E);
    }
    SEAM(PH_MIXB);
    if (IN(PH_MIX)) for (int rep = 0; rep < NREP(PH_MIX); ++rep) {
        PTRS
        pg8::GridSched S{(const char*)MIXIN, (const char*)WT_OUT, (size_t)256 * 2048, (size_t)256 * 2048, T / 256, 8, G, bx};
        EpiF32 E{(bf16_t*)MIX}; pg8::gemm_phase<EpiF32, pg8::GridSched, true>(lds, 2048, 2048, 2048, S, E);
    }
    SEAM(PH_MIX);
    if (IN(PH_ROUTER)) for (int rep = 0; rep < NREP(PH_ROUTER); ++rep) {
        PTRS
        const float* gpm = INP(I_GPOSTM); const float* gpf = INP(I_GPREF); const float* brt = INP(I_BROUTER);
        LAS float* HROW = (LAS float*)lds;
        LAS float* PART = (LAS float*)(lds + 16 * 2052 * 4);
        unsigned* counts = ctl + CW_COUNTS;
        volatile LAS unsigned* lhist = MISC + 64;
        if (tid < 32) lhist[tid] = 0u;
        __syncthreads();
        f32x4 vA[8], vB[8], xA[8], xB[8]; u32x2 mA[8], mB[8];
#define RT_LOAD(base_) do { const int _m = (base_) + 2 * wave; const u32x2* _mr = (const u32x2*)((const bf16_t*)MIX + (size_t)_m * D) + lane; const f32x4* _xr = (const f32x4*)(INP(I_X) + (size_t)_m * D) + lane; \
            _Pragma("unroll") for (int j = 0; j < 8; ++j) { mA[j] = _mr[64 * j]; mB[j] = _mr[64 * j + 512]; xA[j] = _xr[64 * j]; xB[j] = _xr[64 * j + 512]; } } while (0)
#define RT_PART3(base_) do { _Pragma("nounroll") for (int q = 0; q < 2; ++q) { \
                const int rr = 2 * wave + q, mrow = (base_) + rr; \
                float lg = 0.f; \
                if (lane < 32) { _Pragma("unroll") for (int w2 = 0; w2 < 8; ++w2) lg += PART[w2 * 512 + rr * 32 + lane]; lg += brt[lane]; } \
                float val = lane < 32 ? lg : -3.0e38f; float tv[4]; int ti[4]; \
                _Pragma("unroll") for (int r = 0; r < 4; ++r) { float bv = val; int bi = lane; \
                    _Pragma("unroll") for (int o = 32; o >= 1; o >>= 1) { const float ov = __shfl_xor(bv, o); const int oi = __shfl_xor(bi, o); if (ov > bv || (ov == bv && oi < bi)) { bv = ov; bi = oi; } } \
                    tv[r] = bv; ti[r] = bi; if (lane == bi) val = -3.0e38f; } \
                const float e1 = __expf(tv[1] - tv[0]), e2 = __expf(tv[2] - tv[0]), e3 = __expf(tv[3] - tv[0]); const float inv = 1.0f / (1.0f + e1 + e2 + e3); \
                if (lane < 4) { const int id = lane == 0 ? ti[0] : (lane == 1 ? ti[1] : (lane == 2 ? ti[2] : ti[3])); const float wv = (lane == 0 ? 1.0f : (lane == 1 ? e1 : (lane == 2 ? e2 : e3))) * inv; \
                    TOPI[mrow * 4 + lane] = id; TOPW[mrow * 4 + lane] = wv; if (rep == 0) __hip_atomic_fetch_add((LAS unsigned*)(lhist + id), 1u, __ATOMIC_RELAXED, __HIP_MEMORY_SCOPE_WORKGROUP); } } } while (0)
        if (bx * 16 < T) RT_LOAD(bx * 16);
        int pbase = -1;
        for (int base = bx * 16; base < T; base += G * 16) {
            {
                const int rrA = 2 * wave, mrowA = base + rrA;
                const int b = mrowA / SEQ; const float* ad = ada + b * 12288;
                float sA = 0.f, sB = 0.f;
#pragma unroll
                for (int j = 0; j < 8; ++j) { vA[j] = (f32x4){bf_lo(mA[j].x), bf_hi(mA[j].x), bf_lo(mA[j].y), bf_hi(mA[j].y)}; vB[j] = (f32x4){bf_lo(mB[j].x), bf_hi(mB[j].x), bf_lo(mB[j].y), bf_hi(mB[j].y)}; }
#pragma unroll
                for (int j = 0; j < 8; ++j) { sA += (vA[j][0] * vA[j][0] + vA[j][1] * vA[j][1]) + (vA[j][2] * vA[j][2] + vA[j][3] * vA[j][3]); sB += (vB[j][0] * vB[j][0] + vB[j][1] * vB[j][1]) + (vB[j][2] * vB[j][2] + vB[j][3] * vB[j][3]); }
#pragma unroll
                for (int o = 1; o < 64; o <<= 1) { sA += __shfl_xor(sA, o); sB += __shfl_xor(sB, o); }
                const float r1A = rsqrtf(sA * (1.0f / D) + RMS_EPS), r1B = rsqrtf(sB * (1.0f / D) + RMS_EPS); float tA = 0.f, tB = 0.f;
#pragma unroll
                for (int j = 0; j < 8; ++j) { const int col = 256 * j + 4 * lane; const f32x4 gg = *(const f32x4*)(gpm + col), gm = *(const f32x4*)(ad + 4096 + col);
                    vA[j] = xA[j] + gm * (vA[j] * r1A * gg); vB[j] = xB[j] + gm * (vB[j] * r1B * gg);
                    { u32x2 wa, wb; wa.x = cvt_pk_bf16(vA[j][0], vA[j][1]); wa.y = cvt_pk_bf16(vA[j][2], vA[j][3]); wb.x = cvt_pk_bf16(vB[j][0], vB[j][1]); wb.y = cvt_pk_bf16(vB[j][2], vB[j][3]); mA[j] = wa; mB[j] = wb; }
                    tA += (vA[j][0] * vA[j][0] + vA[j][1] * vA[j][1]) + (vA[j][2] * vA[j][2] + vA[j][3] * vA[j][3]); tB += (vB[j][0] * vB[j][0] + vB[j][1] * vB[j][1]) + (vB[j][2] * vB[j][2] + vB[j][3] * vB[j][3]); asm volatile("" ::: "memory"); }
#pragma unroll
                for (int o = 1; o < 64; o <<= 1) { tA += __shfl_xor(tA, o); tB += __shfl_xor(tB, o); }
                const float r2A = rsqrtf(tA * (1.0f / D) + RMS_EPS), r2B = rsqrtf(tB * (1.0f / D) + RMS_EPS);
                unsigned hpA[8], hpB[8];
#pragma unroll
                for (int j = 0; j < 8; ++j) { const int col = 256 * j + 4 * lane; const f32x4 gg = *(const f32x4*)(gpf + col), sh = *(const f32x4*)(ad + 6144 + col), sc = *(const f32x4*)(ad + 8192 + col);
                    const f32x4 hA = vA[j] * r2A * gg * (sc + 1.0f) + sh, hB = vB[j] * r2B * gg * (sc + 1.0f) + sh;
                    hpA[j] = pk4_fp8(hA[0], hA[1], hA[2], hA[3], H8_SCALE); hpB[j] = pk4_fp8(hB[0], hB[1], hB[2], hB[3], H8_SCALE);
                    *(LAS f32x4*)(HROW + rrA * 2052 + col) = hA; *(LAS f32x4*)(HROW + (rrA + 1) * 2052 + col) = hB; asm volatile("" ::: "memory"); }
                u32x2 sxA[8], sxB[8];
#pragma unroll
                for (int j = 0; j < 8; ++j) { sxA[j] = mA[j]; sxB[j] = mB[j]; }
                if (base + G * 16 < T) RT_LOAD(base + G * 16);
                asm volatile("" ::: "memory");
                u32x2* o4 = (u32x2*)((bf16_t*)(ws + WS_X1B) + (size_t)mrowA * D) + lane; unsigned* h8 = (unsigned*)((unsigned char*)H2 + (size_t)mrowA * D) + lane;
#pragma unroll
                for (int j = 0; j < 8; ++j) { o4[64 * j] = sxA[j]; o4[64 * j + 512] = sxB[j]; h8[64 * j] = hpA[j]; h8[64 * j + 512] = hpB[j]; }
            }
            __syncthreads();
            if (pbase >= 0) RT_PART3(pbase);
            __syncthreads();
            {   f32x4 c0 = (f32x4){0.f, 0.f, 0.f, 0.f}, c1 = (f32x4){0.f, 0.f, 0.f, 0.f};
                const LAS float* ap = HROW + (lane & 15) * 2052 + 256 * wave + (lane >> 4);
                const f32x4* wq = (const f32x4*)(ws + WS_WRT) + (size_t)wave * 2048 + lane;
#pragma unroll 4
                for (int st4 = 0; st4 < 16; ++st4) { const f32x4 b0 = wq[st4 * 128], b1 = wq[st4 * 128 + 64];
#pragma unroll
                    for (int i = 0; i < 4; ++i) { const float a = ap[4 * (4 * st4 + i)]; c0 = __builtin_amdgcn_mfma_f32_16x16x4f32(a, b0[i], c0, 0, 0, 0); c1 = __builtin_amdgcn_mfma_f32_16x16x4f32(a, b1[i], c1, 0, 0, 0); } }
                LAS float* pp = PART + wave * 512 + (4 * (lane >> 4)) * 32 + (lane & 15);
#pragma unroll
                for (int r = 0; r < 4; ++r) { pp[r * 32] = c0[r]; pp[r * 32 + 16] = c1[r]; }
            }
            __syncthreads();
            pbase = base;
        }
        if (pbase >= 0) RT_PART3(pbase);
        __syncthreads();
#undef RT_LOAD
#undef RT_PART3
        if (tid < 32 && rep == 0) { const unsigned c = lhist[tid]; if (c) atomicAdd(counts + 64 * tid, c); }
    }
    SEAM(PH_ROUTER);
    if (IN(PH_DISPATCH)) for (int rep = 0; rep < NREP(PH_DISPATCH); ++rep) {
        PTRS
        unsigned* counts = ctl + CW_COUNTS; unsigned* cursor = ctl + CW_CURSOR;
        volatile LAS unsigned* lhist = MISC + 64; volatile LAS unsigned* lbase = MISC + 96;
        if (tid < 32) lhist[tid] = 0u;
        int pst = 0, pend = 0;
        { const int cnt = lane < 32 ? (int)__hip_atomic_load(counts + 64 * lane, __ATOMIC_RELAXED, __HIP_MEMORY_SCOPE_AGENT) : 0; const int pad = (cnt + 255) & ~255; int inc = pad;
#pragma unroll
          for (int o = 1; o < 32; o <<= 1) { const int t = __shfl_up(inc, o); if ((lane & 31) >= o) inc += t; }
          pend = inc; pst = inc - pad; }
        if (gw == 0) {
            const int ntiles = __shfl(pend, 31) >> 8; if (lane == 0) TILE[0] = ntiles;
            for (int t = lane; t < PMAX / 256; t += 64) { int e = 0;
                for (int q = 0; q < 32; ++q) { const int pe = __shfl(pend, q); e += (pe <= t * 256) ? 1 : 0; }
                TILE[16 + t] = e < 31 ? e : 31; }
        }
        __syncthreads();
        int eid[8], loc[8];
#pragma unroll
        for (int i = 0; i < 8; ++i) { const int mrow = gw + NGW * i; eid[i] = 0; loc[i] = 0;
            if (mrow < T && lane < 4) { eid[i] = TOPI[mrow * 4 + lane]; loc[i] = (int)__hip_atomic_fetch_add((LAS unsigned*)(lhist + eid[i]), 1u, __ATOMIC_RELAXED, __HIP_MEMORY_SCOPE_WORKGROUP); } }
        __syncthreads();
        if (tid < 32) { const unsigned c = lhist[tid]; lbase[tid] = (unsigned)pst + (c ? atomicAdd(cursor + 64 * tid, c) : 0u); }
        __syncthreads();
#pragma unroll
        for (int i = 0; i < 8; ++i) { const int mrow = gw + NGW * i;
            if (mrow < T) {
                int slot = 0;
                if (lane < 4) { slot = (int)lbase[eid[i]] + loc[i]; DEST[mrow * 4 + lane] = slot; }
                const u32x4* src = (const u32x4*)((const unsigned char*)H2 + (size_t)mrow * D) + lane; u32x4 rw[2];
#pragma unroll
                for (int q = 0; q < 2; ++q) rw[q] = src[64 * q];
#pragma unroll
                for (int k = 0; k < 4; ++k) { const int sl = __shfl(slot, k); u32x4* dst = (u32x4*)((unsigned char*)XS + (size_t)sl * D) + lane;
#pragma unroll
                    for (int q = 0; q < 2; ++q) dst[64 * q] = rw[q]; } } }
    }
    SEAM(PH_DISPATCH);
    if (IN(PH_GU)) for (int rep = 0; rep < NREP(PH_GU); ++rep) {
        PTRS
        const int ntiles = __builtin_amdgcn_readfirstlane(TILE[0]);
        pg8::MoeSched S{(const char*)XS, (const char*)WT_GU, TILE + 16, ntiles, 16, G, bx};
        EpiGU E{ACT, INP(I_BGU), rep}; pg8::gemm_phase<EpiGU, pg8::MoeSched, true>(lds, 2048, 2048, 2048, S, E);
    }
    SEAM(PH_GU);
    if (IN(PH_DOWN)) for (int rep = 0; rep < NREP(PH_DOWN); ++rep) {
        PTRS
        const int ntiles = __builtin_amdgcn_readfirstlane(TILE[0]);
        pg8::MoeSched S{(const char*)ACT, (const char*)WT_DOWN, TILE + 16, ntiles, 8, G, bx};
        EpiDown E{YS, INP(I_BDOWN)}; pg8::gemm_phase<EpiDown, pg8::MoeSched, true>(lds, 2048, 2048, 2048, S, E);
    }
    SEAM(PH_DOWN);
    if (IN(PH_COMBINE)) for (int rep = 0; rep < NREP(PH_COMBINE); ++rep) {
        PTRS
        const float* gpo = INP(I_GPOSTF);
        for (int mrow = gw; mrow < T; mrow += NGW) {
            const int b = mrow / SEQ; const float* ad = ada + b * 12288;
            int dk[4]; float wk[4];
#pragma unroll
            for (int k = 0; k < 4; ++k) { dk[k] = DEST[mrow * 4 + k]; wk[k] = TOPW[mrow * 4 + k]; }
            f32x4 f[8]; float s = 0.f;
#pragma unroll
            for (int j = 0; j < 8; ++j) f[j] = (f32x4){0.f, 0.f, 0.f, 0.f};
#pragma unroll
            for (int k = 0; k < 4; ++k) { const u32x2* yr = (const u32x2*)(YS + (size_t)dk[k] * D) + lane;
#pragma unroll
                for (int j = 0; j < 8; ++j) { const u32x2 w = yr[64 * j]; f[j] += (f32x4){bf_lo(w.x), bf_hi(w.x), bf_lo(w.y), bf_hi(w.y)} * wk[k]; } }
#pragma unroll
            for (int j = 0; j < 8; ++j) s += (f[j][0] * f[j][0] + f[j][1] * f[j][1]) + (f[j][2] * f[j][2] + f[j][3] * f[j][3]);
            const float r = rsqrtf(wave_sum(s) * (1.0f / D) + RMS_EPS);
            f32x4* o4 = (f32x4*)(outp + (size_t)mrow * D) + lane; const u32x2* x1 = (const u32x2*)((const bf16_t*)(ws + WS_X1B) + (size_t)mrow * D) + lane;
#pragma unroll
            for (int j = 0; j < 8; ++j) { const int col = 256 * j + 4 * lane; const f32x4 gg = *(const f32x4*)(gpo + col), gf = *(const f32x4*)(ad + 10240 + col); const u32x2 xw = x1[64 * j];
                o4[64 * j] = (f32x4){bf_lo(xw.x), bf_hi(xw.x), bf_lo(xw.y), bf_hi(xw.y)} + gf * (f[j] * r * gg); }
        }
    }
    if (STAMP_PHASE >= 0 && bx == 0) {
        if (seam_after(STAMP_PHASE) >= NPH) st_dt = __builtin_amdgcn_s_memrealtime() - st_t0;
        const unsigned long long t1 = __builtin_amdgcn_s_memrealtime();
        while (__builtin_amdgcn_s_memrealtime() - t1 < st_dt * STAMP_MUL) __builtin_amdgcn_s_sleep(8);
    }
#undef IN
#undef SEAM
}

extern "C" void kernel_launch(void* const* d_in, const int* in_sizes, int n_in, void* d_out, int out_size, void* d_ws, size_t ws_size, hipStream_t stream) {
    static int grid = 0;
    if (grid == 0) {
        if (n_in != 26 || out_size != T * D || ws_size < WS_END) { fprintf(stderr, "kernel_launch: unexpected shapes: n_in %d out %d ws %zu (need %zu)\n", n_in, out_size, ws_size, (size_t)WS_END); grid = -1; return; }
        int dev = 0, cus = 0, per_cu = 0;
        if (hipGetDevice(&dev) != hipSuccess || hipDeviceGetAttribute(&cus, hipDeviceAttributeMultiprocessorCount, dev) != hipSuccess) { grid = -1; return; }
        if (hipFuncSetAttribute((const void*)fwd_kernel, hipFuncAttributeMaxDynamicSharedMemorySize, LDS_BYTES) != hipSuccess) { fprintf(stderr, "kernel_launch: hipFuncSetAttribute failed\n"); grid = -1; return; }
        if (hipOccupancyMaxActiveBlocksPerMultiprocessor(&per_cu, (const void*)fwd_kernel, 512, LDS_BYTES) != hipSuccess || per_cu < 1) fprintf(stderr, "kernel_launch: occupancy query says %d\n", per_cu);
        (void)hipGetLastError();
        grid = cus;
    }
    if (grid < 0) return;
    (void)hipMemsetAsync((char*)d_ws + WS_CTL, 0, CTL_BYTES, stream);
    Args a{};
    for (int i = 0; i < 26; ++i) a.in[i] = (const float*)d_in[i];
    a.out = (float*)d_out; a.ws = (unsigned char*)d_ws;
    if (MK_N_LAUNCHES == 1) { a.ph_lo = 0; a.ph_hi = NPH; hipLaunchKernelGGL(fwd_kernel, dim3(grid), dim3(512), LDS_BYTES, stream, a); }
    else for (int p = 0; p < NPH; ++p) { a.ph_lo = p; a.ph_hi = p + 1; hipLaunchKernelGGL(fwd_kernel, dim3(grid), dim3(512), LDS_BYTES, stream, a); }
    const hipError_t le = hipPeekAtLastError();
    if (le != hipSuccess) fprintf(stderr, "kernel_launch: launch failed: %s\n", hipGetErrorName(le));
}
```
